# Optimizing an MI355X kernel written in HIP

```python
import numpy as np
import jax
import jax.numpy as jnp
from jax import lax

D_MODEL = 1024
BATCH = 8
SEQ = 4096
DEPTH = 2

N_GROUPS = 4
HEAD_DIM = 64
GROUP_HEADS = D_MODEL // (N_GROUPS * HEAD_DIM)
GROUP_WIDTH = GROUP_HEADS * HEAD_DIM
MIX_WIDTH = N_GROUPS * GROUP_WIDTH
D_FF = 256 * ((8 * D_MODEL + 3 * 256 - 1) // (3 * 256))
N_ADA = 9
FFN_RESIDUAL_WEIGHT = 0.5
ROPE_THETA = 10000.0
RMS_EPS = 1e-6
NEG_INF = -1e30

MOBA_BLOCK = 256
MOBA_TOPK = 3
MOBA_QBLK = 32

MLA_Q_LORA = D_MODEL // 4
MLA_KV_LORA = D_MODEL // 8
MLA_NOPE = HEAD_DIM
MLA_ROPE = HEAD_DIM // 2
MLA_V = HEAD_DIM
MLA_QBLK = 128

NSA_CMP_LEN = 32
NSA_CMP_STRIDE = 16
NSA_CMP_HIDDEN = 4 * HEAD_DIM
NSA_SEL_BLOCK = 64
NSA_SEL_TOPN = 16
NSA_WINDOW = 512
NSA_FORCE_SCORE = 1e4
NSA_QBLK = 64

DSA_TOPK = 256
DSA_IDX_HEADS = 8
DSA_IDX_DIM = 32
DSA_QBLK = 64

IN_SIZES = (
    GROUP_WIDTH, GROUP_WIDTH, GROUP_WIDTH,
    MLA_Q_LORA, MLA_KV_LORA, MLA_ROPE,
    GROUP_WIDTH, HEAD_DIM, HEAD_DIM, HEAD_DIM, HEAD_DIM,
    HEAD_DIM, HEAD_DIM, 3 * GROUP_HEADS,
    GROUP_WIDTH, HEAD_DIM, HEAD_DIM,
    DSA_IDX_HEADS * DSA_IDX_DIM, DSA_IDX_DIM, DSA_IDX_HEADS,
)
N_IN = sum(IN_SIZES)

kernel_name = 'hybrid_moba_mla_nsa_dsa_macaron'


def rms_norm(x, g):
    x32 = x.astype(jnp.float32)
    y = x32 * lax.rsqrt(jnp.mean(x32 * x32, axis=-1, keepdims=True) + RMS_EPS)
    return (y * g.astype(jnp.float32)).astype(x.dtype)


def modulate(xn, shift, scale):
    return xn * (1 + scale) + shift


def swiglu(h, w_gate, w_up, w_down):
    return (jax.nn.silu(h @ w_gate) * (h @ w_up)) @ w_down


def rope_tables(n_pos, dim, dtype):
    inv_freq = 1.0 / (ROPE_THETA ** (np.arange(0, dim, 2, dtype=np.float32) / dim))
    ang = jnp.arange(n_pos, dtype=jnp.float32)[:, None] * jnp.asarray(inv_freq, jnp.float32)[None, :]
    return jnp.cos(ang).astype(dtype), jnp.sin(ang).astype(dtype)


def apply_rope(x, cos, sin):
    x1, x2 = jnp.split(x, 2, axis=-1)
    return jnp.concatenate([x1 * cos - x2 * sin, x2 * cos + x1 * sin], axis=-1)


def masked_softmax(s, mask):
    p = jax.nn.softmax(jnp.where(mask, s.astype(jnp.float32), NEG_INF), axis=-1)
    return jnp.where(mask, p, 0.0)


def map_query_blocks(fn, n_pos, qblk):
    starts = jnp.arange(n_pos // qblk, dtype=jnp.int32) * qblk
    out = lax.map(fn, starts)
    out = jnp.moveaxis(out, 0, 1)
    return out.reshape(out.shape[0], n_pos, *out.shape[3:])


def moba_attention(q, k, v, cos, sin):
    B, T, H, dh = q.shape
    q = apply_rope(q, cos[:, None], sin[:, None])
    k = apply_rope(k, cos[:, None], sin[:, None])
    nb = -(-T // MOBA_BLOCK)
    pad = nb * MOBA_BLOCK - T

    def to_blocks(t):
        t = jnp.pad(t, ((0, 0), (0, pad), (0, 0), (0, 0)))
        return t.reshape(B, nb, MOBA_BLOCK, H, dh).transpose(0, 3, 1, 2, 4)

    kb, vb = to_blocks(k), to_blocks(v)
    k_mean = jnp.mean(kb.astype(jnp.float32), axis=3).astype(q.dtype)
    topk = min(MOBA_TOPK, nb - 1)
    scale = dh ** -0.5
    b_ix = jnp.arange(B)[:, None, None, None]
    h_ix = jnp.arange(H)[None, :, None, None]
    blk_ids = jnp.arange(nb)
    offs = jnp.arange(MOBA_BLOCK)

    def block_fn(q0):
        qc = lax.dynamic_slice_in_dim(q, q0, MOBA_QBLK, axis=1)
        tq = q0 + jnp.arange(MOBA_QBLK)
        own = q0 // MOBA_BLOCK
        k_own = lax.dynamic_index_in_dim(kb, own, axis=2, keepdims=False)
        v_own = lax.dynamic_index_in_dim(vb, own, axis=2, keepdims=False)
        s_own = jnp.einsum('bqhd,bhkd->bhqk', qc, k_own) * scale
        m_own = jnp.broadcast_to((own * MOBA_BLOCK + offs)[None, :] <= tq[:, None], s_own.shape)
        if topk == 0:
            p = masked_softmax(s_own, m_own).astype(v.dtype)
            return jnp.einsum('bhqk,bhkd->bqhd', p, v_own)
        gate = jnp.einsum('bqhd,bhnd->bhqn', qc, k_mean).astype(jnp.float32)
        gate = jnp.where(blk_ids < own, gate, NEG_INF)
        _, idx = lax.top_k(gate, topk)
        k_sel = kb[b_ix, h_ix, idx]
        v_sel = vb[b_ix, h_ix, idx]
        s_sel = (jnp.einsum('bqhd,bhqnkd->bhqnk', qc, k_sel) * scale).reshape(B, H, MOBA_QBLK, topk * MOBA_BLOCK)
        m_sel = jnp.broadcast_to((idx < own)[..., None], (B, H, MOBA_QBLK, topk, MOBA_BLOCK)).reshape(s_sel.shape)
        p = masked_softmax(jnp.concatenate([s_sel, s_own], axis=-1),
                           jnp.concatenate([m_sel, m_own], axis=-1)).astype(v.dtype)
        p_sel = p[..., :topk * MOBA_BLOCK].reshape(B, H, MOBA_QBLK, topk, MOBA_BLOCK)
        p_own = p[..., topk * MOBA_BLOCK:]
        return (jnp.einsum('bhqnk,bhqnkd->bqhd', p_sel, v_sel)
                + jnp.einsum('bhqk,bhkd->bqhd', p_own, v_own))

    return map_query_blocks(block_fn, T, MOBA_QBLK)


def mla_attention(c_q, c_kv, k_rope, q_norm, w_uq, kv_norm, w_uk, w_uv, cos_r, sin_r):
    B, T, _ = c_q.shape
    H = GROUP_HEADS
    q = (rms_norm(c_q, q_norm) @ w_uq).reshape(B, T, H, MLA_NOPE + MLA_ROPE)
    q_nope = q[..., :MLA_NOPE]
    q_pe = apply_rope(q[..., MLA_NOPE:], cos_r[:, None], sin_r[:, None])
    ckv = rms_norm(c_kv, kv_norm)
    k_nope = (ckv @ w_uk).reshape(B, T, H, MLA_NOPE)
    v = (ckv @ w_uv).reshape(B, T, H, MLA_V)
    k_pe = apply_rope(k_rope, cos_r, sin_r)
    scale = (MLA_NOPE + MLA_ROPE) ** -0.5
    kpos = jnp.arange(T)

    def block_fn(q0):
        qn = lax.dynamic_slice_in_dim(q_nope, q0, MLA_QBLK, axis=1)
        qp = lax.dynamic_slice_in_dim(q_pe, q0, MLA_QBLK, axis=1)
        tq = q0 + jnp.arange(MLA_QBLK)
        s = (jnp.einsum('bqhd,bshd->bhqs', qn, k_nope)
             + jnp.einsum('bqhr,bsr->bhqs', qp, k_pe)) * scale
        p = masked_softmax(s, kpos[None, :] <= tq[:, None]).astype(v.dtype)
        return jnp.einsum('bhqs,bshd->bqhd', p, v)

    return map_query_blocks(block_fn, T, MLA_QBLK)


def nsa_attention(q, kc, vc, ks, vs, kw, vw, gate_logits, pe_k, pe_v,
                  cmp_k_w1, cmp_k_w2, cmp_v_w1, cmp_v_w2, cos, sin):
    B, T, H, dh = q.shape
    q = apply_rope(q, cos[:, None], sin[:, None])
    kc, ks, kw = (apply_rope(t, cos, sin) for t in (kc, ks, kw))
    n_cmp = (T - NSA_CMP_LEN) // NSA_CMP_STRIDE + 1
    cmp_start = np.arange(n_cmp) * NSA_CMP_STRIDE
    win_idx = cmp_start[:, None] + np.arange(NSA_CMP_LEN)[None, :]

    def compress(t, pe, w1, w2):
        blocks = (t[:, win_idx] + pe).reshape(B, n_cmp, NSA_CMP_LEN * dh)
        return jax.nn.silu(blocks @ w1) @ w2

    k_cmp = compress(kc, pe_k, cmp_k_w1, cmp_k_w2)
    v_cmp = compress(vc, pe_v, cmp_v_w1, cmp_v_w2)
    cmp_end = jnp.asarray(cmp_start + NSA_CMP_LEN - 1)
    n_sel = T // NSA_SEL_BLOCK
    sel_start = np.arange(n_sel) * NSA_SEL_BLOCK
    overlap = ((cmp_start[:, None] < sel_start[None, :] + NSA_SEL_BLOCK)
               & (cmp_start[:, None] + NSA_CMP_LEN > sel_start[None, :]))
    cmp_to_sel = jnp.asarray(overlap, jnp.float32)
    topn = min(NSA_SEL_TOPN, n_sel)
    ksb = ks.reshape(B, n_sel, NSA_SEL_BLOCK, dh)
    vsb = vs.reshape(B, n_sel, NSA_SEL_BLOCK, dh)
    kw_pad = jnp.pad(kw, ((0, 0), (NSA_WINDOW, 0), (0, 0)))
    vw_pad = jnp.pad(vw, ((0, 0), (NSA_WINDOW, 0), (0, 0)))
    gates = jax.nn.sigmoid(gate_logits.reshape(B, T, H, 3))
    scale = dh ** -0.5
    b_ix = jnp.arange(B)[:, None, None]
    sel_ids = jnp.arange(n_sel)
    sel_offs = jnp.arange(NSA_SEL_BLOCK)
    win_offs = jnp.arange(NSA_WINDOW + NSA_QBLK)

    def block_fn(q0):
        qc = lax.dynamic_slice_in_dim(q, q0, NSA_QBLK, axis=1)
        tq = q0 + jnp.arange(NSA_QBLK)
        s_c = jnp.einsum('bqhd,bnd->bhqn', qc, k_cmp) * scale
        p_c = masked_softmax(s_c, cmp_end[None, :] <= tq[:, None])
        o_c = jnp.einsum('bhqn,bnd->bqhd', p_c.astype(v_cmp.dtype), v_cmp)
        imp = jnp.einsum('bhqn,ns->bqs', p_c, cmp_to_sel)
        own = tq // NSA_SEL_BLOCK
        causal = sel_ids[None, :] <= own[:, None]
        forced = causal & ((sel_ids[None, :] == 0) | (sel_ids[None, :] >= own[:, None] - 1))
        imp = jnp.where(forced, NSA_FORCE_SCORE, jnp.where(causal, imp, -NSA_FORCE_SCORE))
        _, idx = lax.top_k(imp, topn)
        k_sel = ksb[b_ix, idx]
        v_sel = vsb[b_ix, idx]
        s_s = (jnp.einsum('bqhd,bqnkd->bhqnk', qc, k_sel) * scale).reshape(B, H, NSA_QBLK, topn * NSA_SEL_BLOCK)
        pos = idx[..., None] * NSA_SEL_BLOCK + sel_offs
        m_s = (pos <= tq[None, :, None, None]).reshape(B, 1, NSA_QBLK, topn * NSA_SEL_BLOCK)
        p_s = masked_softmax(s_s, m_s).astype(v_sel.dtype).reshape(B, H, NSA_QBLK, topn, NSA_SEL_BLOCK)
        o_s = jnp.einsum('bhqnk,bqnkd->bqhd', p_s, v_sel)
        kwc = lax.dynamic_slice_in_dim(kw_pad, q0, NSA_WINDOW + NSA_QBLK, axis=1)
        vwc = lax.dynamic_slice_in_dim(vw_pad, q0, NSA_WINDOW + NSA_QBLK, axis=1)
        kpos = q0 - NSA_WINDOW + win_offs
        m_w = ((kpos[None, :] <= tq[:, None]) & (kpos[None, :] > tq[:, None] - NSA_WINDOW)
               & (kpos[None, :] >= 0))
        s_w = jnp.einsum('bqhd,bkd->bhqk', qc, kwc) * scale
        p_w = masked_softmax(s_w, m_w).astype(vwc.dtype)
        o_w = jnp.einsum('bhqk,bkd->bqhd', p_w, vwc)
        g = lax.dynamic_slice_in_dim(gates, q0, NSA_QBLK, axis=1)
        return g[..., 0:1] * o_c + g[..., 1:2] * o_s + g[..., 2:3] * o_w

    return map_query_blocks(block_fn, T, NSA_QBLK)


def dsa_attention(q, k, v, iq, ik, iw, cos, sin):
    B, T, H, dh = q.shape
    q = apply_rope(q, cos[:, None], sin[:, None])
    k = apply_rope(k, cos, sin)
    iq = iq.reshape(B, T, DSA_IDX_HEADS, DSA_IDX_DIM)
    topk = min(DSA_TOPK, T // 4)
    idx_scale = (DSA_IDX_HEADS * DSA_IDX_DIM) ** -0.5
    scale = dh ** -0.5
    b_ix = jnp.arange(B)[:, None, None]
    kpos = jnp.arange(T)

    def block_fn(q0):
        qc = lax.dynamic_slice_in_dim(q, q0, DSA_QBLK, axis=1)
        iqc = lax.dynamic_slice_in_dim(iq, q0, DSA_QBLK, axis=1)
        iwc = lax.dynamic_slice_in_dim(iw, q0, DSA_QBLK, axis=1)
        tq = q0 + jnp.arange(DSA_QBLK)
        score = jnp.einsum('bqh,bqhs->bqs', iwc,
                           jax.nn.relu(jnp.einsum('bqhd,bsd->bqhs', iqc, ik))).astype(jnp.float32) * idx_scale
        score = jnp.where(kpos[None, None, :] <= tq[None, :, None], score, NEG_INF)
        _, idx = lax.top_k(score, topk)
        k_sel = k[b_ix, idx]
        v_sel = v[b_ix, idx]
        s = jnp.einsum('bqhd,bqkd->bhqk', qc, k_sel) * scale
        p = masked_softmax(s, (idx <= tq[None, :, None])[:, None]).astype(v_sel.dtype)
        return jnp.einsum('bhqk,bqkd->bqhd', p, v_sel)

    return map_query_blocks(block_fn, T, DSA_QBLK)


def hybrid_mixer(h, w_in, mla_q_norm, mla_w_uq, mla_kv_norm, mla_w_uk, mla_w_uv,
                 nsa_pe_k, nsa_pe_v, nsa_cmp_k_w1, nsa_cmp_k_w2, nsa_cmp_v_w1, nsa_cmp_v_w2,
                 group_norm, w_out, cos, sin, cos_r, sin_r):
    B, T, _ = h.shape
    splits = np.cumsum(IN_SIZES)[:-1].tolist()
    (mq, mk, mv, cq, ckv, kr, nq, nkc, nvc, nks, nvs, nkw, nvw, ngate,
     dq, dk, dv, diq, dik, diw) = jnp.split(h @ w_in, splits, axis=-1)

    def heads(t):
        return t.reshape(B, T, GROUP_HEADS, HEAD_DIM)

    o_moba = moba_attention(heads(mq), heads(mk), heads(mv), cos, sin)
    o_mla = mla_attention(cq, ckv, kr, mla_q_norm, mla_w_uq, mla_kv_norm, mla_w_uk, mla_w_uv, cos_r, sin_r)
    o_nsa = nsa_attention(heads(nq), nkc, nvc, nks, nvs, nkw, nvw, ngate, nsa_pe_k, nsa_pe_v,
                          nsa_cmp_k_w1, nsa_cmp_k_w2, nsa_cmp_v_w1, nsa_cmp_v_w2, cos, sin)
    o_dsa = dsa_attention(heads(dq), dk, dv, diq, dik, diw, cos, sin)
    groups = [o.reshape(B, T, GROUP_WIDTH) for o in (o_moba, o_mla, o_nsa, o_dsa)]
    y = jnp.concatenate([rms_norm(o, group_norm[i]) for i, o in enumerate(groups)], axis=-1)
    return y @ w_out


def setup_inputs(seed: int = 0) -> dict:
    key = jax.random.key(seed)
    keys = list(jax.random.split(key, 32))

    def nrm(shape, scale):
        return jax.random.normal(keys.pop(), shape, jnp.float32) * scale

    def gain(shape):
        return 1.0 + nrm(shape, 0.05)

    L = DEPTH
    cmp_in = NSA_CMP_LEN * HEAD_DIM
    return {
        'x': nrm((BATCH, SEQ, D_MODEL), 1.0),
        'c': nrm((BATCH, D_MODEL), 1.0),
        'ada_w': nrm((L, D_MODEL, N_ADA * D_MODEL), 0.5 * D_MODEL ** -0.5),
        'ada_b': nrm((L, N_ADA * D_MODEL), 0.02),
        'ffn1_norm': gain((L, D_MODEL)),
        'ffn1_w_gate': nrm((L, D_MODEL, D_FF), D_MODEL ** -0.5),
        'ffn1_w_up': nrm((L, D_MODEL, D_FF), D_MODEL ** -0.5),
        'ffn1_w_down': nrm((L, D_FF, D_MODEL), D_FF ** -0.5),
        'mix_norm': gain((L, D_MODEL)),
        'w_in': nrm((L, D_MODEL, N_IN), D_MODEL ** -0.5),
        'mla_q_norm': gain((L, MLA_Q_LORA)),
        'mla_w_uq': nrm((L, MLA_Q_LORA, GROUP_HEADS * (MLA_NOPE + MLA_ROPE)), MLA_Q_LORA ** -0.5),
        'mla_kv_norm': gain((L, MLA_KV_LORA)),
        'mla_w_uk': nrm((L, MLA_KV_LORA, GROUP_HEADS * MLA_NOPE), MLA_KV_LORA ** -0.5),
        'mla_w_uv': nrm((L, MLA_KV_LORA, GROUP_HEADS * MLA_V), MLA_KV_LORA ** -0.5),
        'nsa_pe_k': nrm((L, NSA_CMP_LEN, HEAD_DIM), 0.5),
        'nsa_pe_v': nrm((L, NSA_CMP_LEN, HEAD_DIM), 0.5),
        'nsa_cmp_k_w1': nrm((L, cmp_in, NSA_CMP_HIDDEN), cmp_in ** -0.5),
        'nsa_cmp_k_w2': nrm((L, NSA_CMP_HIDDEN, HEAD_DIM), NSA_CMP_HIDDEN ** -0.5),
        'nsa_cmp_v_w1': nrm((L, cmp_in, NSA_CMP_HIDDEN), cmp_in ** -0.5),
        'nsa_cmp_v_w2': nrm((L, NSA_CMP_HIDDEN, HEAD_DIM), NSA_CMP_HIDDEN ** -0.5),
        'group_norm': gain((L, N_GROUPS, GROUP_WIDTH)),
        'w_out': nrm((L, MIX_WIDTH, D_MODEL), MIX_WIDTH ** -0.5),
        'ffn2_norm': gain((L, D_MODEL)),
        'ffn2_w_gate': nrm((L, D_MODEL, D_FF), D_MODEL ** -0.5),
        'ffn2_w_up': nrm((L, D_MODEL, D_FF), D_MODEL ** -0.5),
        'ffn2_w_down': nrm((L, D_FF, D_MODEL), D_FF ** -0.5),
        'final_norm': gain((D_MODEL,)),
    }


def reference(x, c, ada_w, ada_b, ffn1_norm, ffn1_w_gate, ffn1_w_up, ffn1_w_down, mix_norm, w_in,
              mla_q_norm, mla_w_uq, mla_kv_norm, mla_w_uk, mla_w_uv,
              nsa_pe_k, nsa_pe_v, nsa_cmp_k_w1, nsa_cmp_k_w2, nsa_cmp_v_w1, nsa_cmp_v_w2,
              group_norm, w_out, ffn2_norm, ffn2_w_gate, ffn2_w_up, ffn2_w_down, final_norm):
    B, T, D = x.shape
    cos, sin = rope_tables(T, HEAD_DIM, x.dtype)
    cos_r, sin_r = rope_tables(T, MLA_ROPE, x.dtype)
    c_act = jax.nn.silu(c)
    for l in range(DEPTH):
        sh1, sc1, g1, sh2, sc2, g2, sh3, sc3, g3 = jnp.split(
            (c_act @ ada_w[l] + ada_b[l])[:, None, :], N_ADA, axis=-1)
        h = modulate(rms_norm(x, ffn1_norm[l]), sh1, sc1)
        x = x + FFN_RESIDUAL_WEIGHT * g1 * swiglu(h, ffn1_w_gate[l], ffn1_w_up[l], ffn1_w_down[l])
        h = modulate(rms_norm(x, mix_norm[l]), sh2, sc2)
        x = x + g2 * hybrid_mixer(h, w_in[l], mla_q_norm[l], mla_w_uq[l], mla_kv_norm[l], mla_w_uk[l], mla_w_uv[l],
                                  nsa_pe_k[l], nsa_pe_v[l], nsa_cmp_k_w1[l], nsa_cmp_k_w2[l],
                                  nsa_cmp_v_w1[l], nsa_cmp_v_w2[l], group_norm[l], w_out[l],
                                  cos, sin, cos_r, sin_r)
        h = modulate(rms_norm(x, ffn2_norm[l]), sh3, sc3)
        x = x + FFN_RESIDUAL_WEIGHT * g3 * swiglu(h, ffn2_w_gate[l], ffn2_w_up[l], ffn2_w_down[l])
    return rms_norm(x, final_norm)
```

```cpp
#include <hip/hip_runtime.h>
#include <cstdio>
#include <cstdint>
#include <cmath>
namespace pg8 {
#define PG8_LAS __attribute__((address_space(3)))
typedef unsigned short bf16_t;
typedef short bf16x8 __attribute__((ext_vector_type(8)));
typedef float f32x4 __attribute__((ext_vector_type(4)));
typedef unsigned u32x4 __attribute__((ext_vector_type(4)));
constexpr int BM = 256, BK = 64, HALF = 128, HTB = HALF * BK * 2  , STAGE_BYTES = 8 * HTB, NXCD = 8, WGM = 8;

__host__ __device__ __forceinline__ int lds_byte(int r, int c) { const int st = (r >> 4) * 2 + (c >> 5), rr = r & 15, cc = c & 31, ob = rr * 64 + cc * 2; return st * 1024 + (ob ^ (((ob >> 9) & 1) << 5)); }
__host__ __device__ __forceinline__ void stage_rc(int b, int& R, int& C) { const int st = b / 1024, sb = b % 1024, swz = sb ^ (((sb >> 9) & 1) << 5); R = (st >> 1) * 16 + swz / 64; C = (st & 1) * 32 + (swz % 64) / 2; }
__host__ __device__ __forceinline__ int perm32(int rho) { const int n = rho >> 4, i = rho & 15; return 8 * (i >> 2) + 4 * n + (i & 3); }

struct Unit { int pm, pn; };
struct Gemm { const bf16_t* A; const bf16_t* Bt; int M, N, K; };

struct StaticOrder {
    int nM, nN, nwg, G, c;
    __host__ __device__ void init(int M, int N, int G_, int c_) { nM = M / BM; nN = N / BM; nwg = nM * nN; G = G_; c = c_; }
    __host__ __device__ bool next(int i, Unit& u) const {
        const long L = (long)i * G + c; if (L >= nwg) return false;
        int wgid = (int)L; { const int q = nwg / NXCD, r = nwg % NXCD, xcd = wgid % NXCD, off = wgid / NXCD; wgid = (xcd < r ? xcd * (q + 1) : r * (q + 1) + (xcd - r) * q) + off; }
        const int nig = WGM * nN, gid = wgid / nig, fm = gid * WGM, gsz = (nM - fm) < WGM ? (nM - fm) : WGM;
        u.pm = fm + ((wgid % nig) % gsz); u.pn = (wgid % nig) / gsz; return true;
    }
    __device__ __forceinline__ void a_ready(const Unit&) const {}
    __device__ __forceinline__ void done(const Unit&) const {}
};

__device__ __forceinline__ unsigned cvt_pk_bf16(float lo, float hi) { unsigned r; asm volatile("v_cvt_pk_bf16_f32 %0, %1, %2" : "=v"(r) : "v"(lo), "v"(hi)); return r; }
typedef float f32x2 __attribute__((ext_vector_type(2)));
typedef unsigned u32x2 __attribute__((ext_vector_type(2)));
__device__ __forceinline__ float silu_f(float x) { return x * __builtin_amdgcn_rcpf(1.0f + __builtin_amdgcn_exp2f(-1.4426950408889634f * x)); }

struct EpiSwiGLU {
    static constexpr bool PERM = false, AFTER_DRAIN = false;
    bf16_t* H; int ldh;
    __device__ __forceinline__ void operator()(const f32x4 (&acc)[2][2][4][2], const Unit& u, int wr, int wc, int fr, int fq) const {
        const int row0 = u.pm * BM + wr * 64 + fr;
        const int hc0 = u.pn * 128 + wc * 16 + 4 * fq;
#pragma unroll
        for (int ai = 0; ai < 2; ++ai)
#pragma unroll
            for (int m = 0; m < 4; ++m) {
                bf16_t* rowp = H + (size_t)(row0 + ai * HALF + m * 16) * ldh + hc0;
#pragma unroll
                for (int bj = 0; bj < 2; ++bj) {
                    const f32x4 g = acc[ai][bj][m][0], uu = acc[ai][bj][m][1];
                    u32x2 w; w.x = cvt_pk_bf16(silu_f(g[0]) * uu[0], silu_f(g[1]) * uu[1]); w.y = cvt_pk_bf16(silu_f(g[2]) * uu[2], silu_f(g[3]) * uu[3]);
                    *(u32x2*)(rowp + bj * 64) = w;
                }
            }
    }
};

struct EpiResid {
    static constexpr bool PERM = false, AFTER_DRAIN = false;
    const float* xin; float* xout; const float* gate; float coef;
    __device__ __forceinline__ void operator()(const f32x4 (&acc)[2][2][4][2], const Unit& u, int wr, int wc, int fr, int fq) const {
        const int b = (u.pm * BM) >> 12;
        const float* gv = gate + (size_t)b * 9216;
        const int row0 = u.pm * BM + wr * 64 + fr, col0 = u.pn * BM + wc * 32 + 4 * fq;
        f32x4 g[2][2];
#pragma unroll
        for (int bj = 0; bj < 2; ++bj)
#pragma unroll
            for (int n = 0; n < 2; ++n) g[bj][n] = *(const f32x4*)(gv + col0 + bj * HALF + n * 16) * coef;
#pragma unroll
        for (int ai = 0; ai < 2; ++ai)
#pragma unroll
            for (int m = 0; m < 4; ++m) {
                const size_t off = (size_t)(row0 + ai * HALF + m * 16) * 1024 + col0;
#pragma unroll
                for (int bj = 0; bj < 2; ++bj)
#pragma unroll
                    for (int n = 0; n < 2; ++n) { const f32x4 xi = *(const f32x4*)(xin + off + bj * HALF + n * 16); *(f32x4*)(xout + off + bj * HALF + n * 16) = xi + g[bj][n] * acc[ai][bj][m][n]; }
                if (m & 1) asm volatile("" ::: "memory");
            }
    }
};

struct ProjDesc { int kind, dfreq0, nstride, rep, repstride, bpitch, fpitch, pad; bf16_t* bp; float* fp; };
template <class DescFn> struct EpiProj {
    static constexpr bool PERM = false, AFTER_DRAIN = false;
    DescFn df; const float* cs64; const float* cs32; const float* rowscale;
    __device__ __forceinline__ void operator()(const f32x4 (&acc)[2][2][4][2], const Unit& u, int wr, int wc, int fr, int fq) const {
        const int row0 = u.pm * BM + wr * 64 + fr;
#pragma unroll
        for (int bj = 0; bj < 2; ++bj) {
            const int G = u.pn * 8 + bj * 4 + wc;
            const ProjDesc d = df(G);
            if (d.kind != 0) {
#pragma unroll
                for (int ai = 0; ai < 2; ++ai)
#pragma unroll
                    for (int m = 0; m < 4; ++m) {
                        const int row = row0 + ai * HALF + m * 16;
                        f32x4 v0 = acc[ai][bj][m][0], v1 = acc[ai][bj][m][1];
                        if (rowscale) { const float rs = rowscale[row]; v0 = v0 * rs; v1 = v1 * rs; }
                        if (d.kind >= 2) {
                            const int pos = row & 4095;
                            const float* cs = (d.kind == 2) ? cs64 + ((size_t)pos * 32 + d.dfreq0 + 4 * fq) * 2 : cs32 + ((size_t)pos * 16 + 4 * fq) * 2;
                            const f32x4 a = *(const f32x4*)cs, b2 = *(const f32x4*)(cs + 4);
                            const f32x4 c = {a[0], a[2], b2[0], b2[2]}, s = {a[1], a[3], b2[1], b2[3]};
                            const f32x4 o0 = v0 * c - v1 * s, o1 = v1 * c + v0 * s; v0 = o0; v1 = o1;
                        }
                        if (d.bp) {
                            u32x2 w0, w1; w0.x = cvt_pk_bf16(v0[0], v0[1]); w0.y = cvt_pk_bf16(v0[2], v0[3]); w1.x = cvt_pk_bf16(v1[0], v1[1]); w1.y = cvt_pk_bf16(v1[2], v1[3]);
                            bf16_t* p = d.bp + (size_t)row * d.bpitch + 4 * fq;
                            for (int rp = 0; rp < d.rep; ++rp) { *(u32x2*)(p + rp * d.repstride) = w0; *(u32x2*)(p + rp * d.repstride + d.nstride) = w1; }
                        }
                        if (d.fp) { float* p = d.fp + (size_t)row * d.fpitch + 4 * fq; *(f32x4*)p = v0; *(f32x4*)(p + d.nstride) = v1; }
                        asm volatile("" ::: "memory");
                    }
            }
        }
    }
};

template <class Epi, class Sched, bool ALIGN_EPI = false, bool SP2 = false>
__device__ __forceinline__ void gemm_phase(PG8_LAS unsigned char* lds, const Gemm g, const Sched& S, const Epi& E) {
    int tid_ = threadIdx.x; asm volatile("" : "+v"(tid_));
    const int tid = tid_, wid = __builtin_amdgcn_readfirstlane(tid >> 6), lane = tid & 63, wr = wid >> 2, wc = wid & 3, fr = lane & 15, fq = lane >> 4;
    const int K = g.K, nt = K / BK;
    unsigned voffA[2], voffB[2];
#pragma unroll
    for (int i = 0; i < 2; ++i) { int R, C; stage_rc(tid * 16 + i * 8192, R, C); const int Rb = Epi::PERM ? ((R & ~31) + perm32(R & 31)) : R;
        voffA[i] = (unsigned)(R * K + C) * 2u; voffB[i] = (unsigned)(Rb * K + C) * 2u; }
    const size_t kstep = (size_t)(BK * 2);
    const size_t hstep = (size_t)HALF * K * 2;
    const size_t tstep = 2 * hstep;
    const unsigned ldsw = (unsigned)wid * 1024u;
    const int aoff = lds_byte(wr * 64 + fr, fq * 8), boff = lds_byte(wc * 32 + fr, fq * 8);
#define PG8_SA(b, h) (((b) * 2 + (h)) * HTB)
#define PG8_SB(b, h) ((4 + (b) * 2 + (h)) * HTB)
#define PG8_STAGE(bufoff, gbase, voff) do { _Pragma("unroll") for (int _i = 0; _i < 2; ++_i) \
        __builtin_amdgcn_global_load_lds((const unsigned*)((const char*)(gbase) + (voff)[_i]), (PG8_LAS unsigned*)(lds + (bufoff) + ldsw + _i * 8192), 16, 0, 0); } while (0)
#define PG8_LDA(dst, b, h) do { _Pragma("unroll") for (int m = 0; m < 4; ++m) _Pragma("unroll") for (int k = 0; k < 2; ++k) dst[m][k] = *(const PG8_LAS bf16x8*)(lds + PG8_SA(b, h) + aoff + m * 2048 + k * 1024); } while (0)
#define PG8_LDB(dst, b, h) do { _Pragma("unroll") for (int n = 0; n < 2; ++n) _Pragma("unroll") for (int k = 0; k < 2; ++k) dst[n][k] = *(const PG8_LAS bf16x8*)(lds + PG8_SB(b, h) + boff + n * 2048 + k * 1024); } while (0)
#define PG8_MMA(ai, bj, At, Bt) do { __builtin_amdgcn_s_setprio(1); _Pragma("unroll") for (int m = 0; m < 4; ++m) _Pragma("unroll") for (int n = 0; n < 2; ++n) _Pragma("unroll") for (int k = 0; k < 2; ++k) \
        acc[ai][bj][m][n] = __builtin_amdgcn_mfma_f32_16x16x32_bf16(Bt[n][k], At[m][k], acc[ai][bj][m][n], 0, 0, 0); __builtin_amdgcn_s_setprio(0); } while (0)
#define PG8_WAIT_V(n) asm volatile("s_waitcnt vmcnt(" #n ")" ::: "memory")
#define PG8_WAIT_L(n) asm volatile("s_waitcnt lgkmcnt(" #n ")" ::: "memory")
#define PG8_BAR __builtin_amdgcn_s_barrier()
#define PG8_SCHED __builtin_amdgcn_sched_barrier(0)
    Unit cur, nxt; int ui = 0;
    if (!S.next(0, cur)) return;
    f32x4 acc[2][2][4][2];
#pragma unroll
    for (int a = 0; a < 2; ++a)
#pragma unroll
        for (int b = 0; b < 2; ++b)
#pragma unroll
            for (int m = 0; m < 4; ++m)
#pragma unroll
                for (int n = 0; n < 2; ++n) acc[a][b][m][n] = (f32x4){0.f, 0.f, 0.f, 0.f};
    bf16x8 At[4][2], B0[2][2], B1[2][2];
    const char* cA = (const char*)g.A + (size_t)cur.pm * tstep; const char* cB = (const char*)g.Bt + (size_t)cur.pn * tstep;
    S.a_ready(cur);
    if constexpr (SP2) {
        PG8_STAGE(PG8_SB(0, 0), cB, voffB); PG8_STAGE(PG8_SB(0, 1), cB + hstep, voffB); PG8_STAGE(PG8_SA(0, 0), cA, voffA); PG8_STAGE(PG8_SA(0, 1), cA + hstep, voffA);
        if (wr == 1) PG8_BAR;
        PG8_WAIT_V(2); PG8_BAR;
        PG8_STAGE(PG8_SB(1, 0), cB + kstep, voffB); PG8_STAGE(PG8_SA(1, 0), cA + kstep, voffA); PG8_STAGE(PG8_SB(1, 1), cB + hstep + kstep, voffB);
        PG8_WAIT_V(6); PG8_BAR;
    } else {
        PG8_STAGE(PG8_SB(0, 0), cB, voffB); PG8_STAGE(PG8_SA(0, 0), cA, voffA); PG8_STAGE(PG8_SB(0, 1), cB + hstep, voffB); PG8_STAGE(PG8_SA(0, 1), cA + hstep, voffA);
        if (wr == 1) PG8_BAR;
        PG8_WAIT_V(4); PG8_BAR;
        PG8_STAGE(PG8_SB(1, 0), cB + kstep, voffB); PG8_STAGE(PG8_SA(1, 0), cA + kstep, voffA); PG8_STAGE(PG8_SB(1, 1), cB + hstep + kstep, voffB);
        PG8_WAIT_V(6); PG8_BAR;
    }
    for (;;) {
        const bool has_next = S.next(ui + 1, nxt);
        const char* nA = has_next ? (const char*)g.A + (size_t)nxt.pm * tstep : cA; const char* nB = has_next ? (const char*)g.Bt + (size_t)nxt.pn * tstep : cB;
        for (int t = 0; t < nt; t += 2) {
            const bool last = (t == nt - 2);
            const char* a1 = cA + (size_t)(t + 1) * kstep;
            const char* a2 = last ? nA : cA + (size_t)(t + 2) * kstep; const char* b2 = last ? nB : cB + (size_t)(t + 2) * kstep;
            const char* a3 = a2 + kstep; const char* b3 = b2 + kstep;
            if (last && has_next) S.a_ready(nxt);
            if constexpr (SP2) {
            PG8_LDB(B0, 0, 0); PG8_LDB(B1, 0, 1); PG8_SCHED; PG8_LDA(At, 0, 0); PG8_STAGE(PG8_SA(1, 1), a1 + hstep, voffA);
            PG8_WAIT_V(8); PG8_WAIT_L(0); PG8_BAR; PG8_MMA(0, 0, At, B0); PG8_MMA(0, 1, At, B1); PG8_BAR; PG8_SCHED;
            PG8_LDA(At, 0, 1); PG8_STAGE(PG8_SB(0, 0), b2, voffB); PG8_STAGE(PG8_SB(0, 1), b2 + hstep, voffB); PG8_STAGE(PG8_SA(0, 0), a2, voffA);
            PG8_WAIT_V(8); PG8_WAIT_L(0); PG8_BAR; PG8_MMA(1, 0, At, B0); PG8_MMA(1, 1, At, B1); PG8_BAR; PG8_SCHED;
            PG8_LDB(B0, 1, 0); PG8_LDB(B1, 1, 1); PG8_SCHED; PG8_LDA(At, 1, 0); PG8_STAGE(PG8_SA(0, 1), a2 + hstep, voffA);
            PG8_WAIT_V(8); PG8_WAIT_L(0); PG8_BAR; PG8_MMA(0, 0, At, B0); PG8_MMA(0, 1, At, B1); PG8_BAR; PG8_SCHED;
            PG8_LDA(At, 1, 1); PG8_STAGE(PG8_SB(1, 0), b3, voffB); PG8_STAGE(PG8_SB(1, 1), b3 + hstep, voffB); PG8_STAGE(PG8_SA(1, 0), a3, voffA);
            PG8_WAIT_V(8); PG8_WAIT_L(0); PG8_BAR; PG8_MMA(1, 0, At, B0); PG8_MMA(1, 1, At, B1); PG8_BAR; PG8_SCHED;
            } else {
            PG8_LDB(B0, 0, 0); PG8_SCHED; PG8_LDA(At, 0, 0); PG8_STAGE(PG8_SA(1, 1), a1 + hstep, voffA);
            PG8_WAIT_L(8); PG8_BAR; PG8_WAIT_L(0); PG8_MMA(0, 0, At, B0); PG8_BAR; PG8_SCHED;
            PG8_LDB(B1, 0, 1); PG8_STAGE(PG8_SB(0, 0), b2, voffB);
            PG8_BAR; PG8_WAIT_L(0); PG8_MMA(0, 1, At, B1); PG8_BAR;
            PG8_LDA(At, 0, 1); PG8_STAGE(PG8_SA(0, 0), a2, voffA);
            PG8_BAR; PG8_WAIT_L(0); PG8_MMA(1, 0, At, B0); PG8_BAR; PG8_SCHED;
            PG8_STAGE(PG8_SB(0, 1), b2 + hstep, voffB);
            PG8_WAIT_V(6); PG8_BAR; PG8_MMA(1, 1, At, B1); PG8_BAR;
            PG8_LDB(B0, 1, 0); PG8_SCHED; PG8_LDA(At, 1, 0); PG8_STAGE(PG8_SA(0, 1), a2 + hstep, voffA);
            PG8_WAIT_L(8); PG8_BAR; PG8_WAIT_L(0); PG8_MMA(0, 0, At, B0); PG8_BAR; PG8_SCHED;
            PG8_LDB(B1, 1, 1); PG8_STAGE(PG8_SB(1, 0), b3, voffB);
            PG8_BAR; PG8_WAIT_L(0); PG8_MMA(0, 1, At, B1); PG8_BAR;
            PG8_LDA(At, 1, 1); PG8_STAGE(PG8_SA(1, 0), a3, voffA);
            PG8_BAR; PG8_WAIT_L(0); PG8_MMA(1, 0, At, B0); PG8_BAR; PG8_SCHED;
            PG8_STAGE(PG8_SB(1, 1), b3 + hstep, voffB);
            PG8_WAIT_V(6); PG8_BAR; PG8_MMA(1, 1, At, B1); PG8_BAR;
            }
        }
        if constexpr (ALIGN_EPI) { if (wr == 0) PG8_BAR; }
        if constexpr (!Epi::AFTER_DRAIN) { E(acc, cur, wr, wc, fr, fq); S.done(cur); }
        if (!has_next) break;
#pragma unroll
        for (int a = 0; a < 2; ++a)
#pragma unroll
            for (int b = 0; b < 2; ++b)
#pragma unroll
                for (int m = 0; m < 4; ++m)
#pragma unroll
                    for (int n = 0; n < 2; ++n) acc[a][b][m][n] = (f32x4){0.f, 0.f, 0.f, 0.f};
        cur = nxt; cA = nA; cB = nB; ++ui;
        if constexpr (ALIGN_EPI) { if (wr == 1) PG8_BAR; }
    }
    PG8_WAIT_V(0);
    if constexpr (!ALIGN_EPI) { if (wr == 0) PG8_BAR; }
    PG8_BAR;
    if constexpr (Epi::AFTER_DRAIN) { E.fused(acc, cur, wr, wc, fr, fq, lds, wid, lane); S.done(cur); }
#undef PG8_SA
#undef PG8_SB
#undef PG8_STAGE
#undef PG8_LDA
#undef PG8_LDB
#undef PG8_MMA
#undef PG8_WAIT_V
#undef PG8_WAIT_L
#undef PG8_BAR
#undef PG8_SCHED
}
}
#define GAS __attribute__((address_space(1)))
#define LAS __attribute__((address_space(3)))
typedef unsigned short bf16;
typedef unsigned v4u __attribute__((ext_vector_type(4)));
typedef float f32x4 __attribute__((ext_vector_type(4)));
typedef short bf16x8 __attribute__((ext_vector_type(8)));
typedef GAS unsigned gu32;
typedef GAS unsigned long long gu64;
#define RLX_AGENT __ATOMIC_RELAXED, __HIP_MEMORY_SCOPE_AGENT
#define LDS_WAIT() asm volatile("s_waitcnt lgkmcnt(0)" ::: "memory")
#define VM_WAIT() asm volatile("s_waitcnt vmcnt(0)" ::: "memory")
__device__ __forceinline__ unsigned long long rt() { return __builtin_amdgcn_s_memrealtime(); }
__device__ __forceinline__ unsigned f2bf(float f) { unsigned u = __builtin_bit_cast(unsigned, f); return (u + 0x7fffu + ((u >> 16) & 1u)) >> 16; }
__device__ __forceinline__ unsigned pk2(float lo, float hi) { return f2bf(lo) | (f2bf(hi) << 16); }

#define XB_TMO      128
#define XB_XCNT(j)  (256  + 64 * (j))
#define XB_XSUB(j)  (1280 + 64 * (j))
#define XB_XGEN(j)  (2304 + 64 * (j))
#define XB_TOP      3328
#define XB_TOPGEN   3392
#define XCD_BAR_WORDS 3456
#define XB_SPIN_CAP (1u << 24)

__device__ __forceinline__ unsigned xb_ld(unsigned* p)              { return __hip_atomic_load(p, __ATOMIC_RELAXED, __HIP_MEMORY_SCOPE_AGENT); }
__device__ __forceinline__ unsigned xb_add(unsigned* p, unsigned v) { return __hip_atomic_fetch_add(p, v, __ATOMIC_RELAXED, __HIP_MEMORY_SCOPE_AGENT); }
__device__ __forceinline__ unsigned xb_xcc_id() { return (unsigned)__builtin_amdgcn_s_getreg((3 << 11) | 20) & 0xFu; }
#define XB_SPIN(cond, bar) do { unsigned _sp = 0; while (cond) { __builtin_amdgcn_s_sleep(1); \
    if ((++_sp & 255u) == 0u) { if (xb_ld(&(bar)[XB_TMO])) break; if (_sp > XB_SPIN_CAP) { atomicAdd(&(bar)[XB_TMO], 1u); break; } } } } while (0)

struct XcdBarrier {
    unsigned* bar; unsigned x;
    volatile LAS unsigned* st;
};

__device__ __forceinline__ XcdBarrier xcd_barrier_post(unsigned* bar, volatile LAS unsigned* st) {
    XcdBarrier b; b.bar = bar; b.x = xb_xcc_id(); b.st = st;
    if (threadIdx.x == 0) (void)xb_add(&bar[XB_XCNT(b.x)], 1u);
    return b;
}
__device__ __forceinline__ void xcd_barrier_complete(unsigned* bar, unsigned x, unsigned& nloc, unsigned& nx) {
    const unsigned G = gridDim.x * gridDim.y * gridDim.z;
    unsigned sum, cnt, mine, sp = 0u;
    for (;;) {
        sum = 0u; cnt = 0u; mine = 0u;
#pragma unroll
        for (unsigned j = 0; j < 16; ++j) { const unsigned c = xb_ld(&bar[XB_XCNT(j)]); sum += c; cnt += (c > 0u) ? 1u : 0u; mine = (j == x) ? c : mine; }
        if (sum == G) break;
        __builtin_amdgcn_s_sleep(1);
        if ((++sp & 255u) == 0u) { if (xb_ld(&bar[XB_TMO])) break; if (sp > XB_SPIN_CAP) { atomicAdd(&bar[XB_TMO], 1u); break; } }
    }
    nloc = mine > 0u ? mine : 1u; nx = cnt > 0u ? cnt : 1u;
}

__device__ __forceinline__ void xcd_barrier(const XcdBarrier& b) {
    asm volatile("s_waitcnt vmcnt(0)" ::: "memory");
    __syncthreads();
    if (threadIdx.x == 0) {
        unsigned* bar = b.bar;
        __builtin_amdgcn_s_waitcnt(0);
        unsigned nloc = b.st[0], nx = b.st[1];
        if (nloc == 0u) { xcd_barrier_complete(bar, b.x, nloc, nx); b.st[0] = nloc; b.st[1] = nx; }
        const unsigned old = xb_add(&bar[XB_XSUB(b.x)], 1u);
        const unsigned gen = old / nloc;
        if (old + 1u == (gen + 1u) * nloc) {
            __builtin_amdgcn_fence(__ATOMIC_RELEASE, "agent");
            asm volatile("s_waitcnt vmcnt(0)" ::: "memory");
            const unsigned og = xb_add(&bar[XB_TOP], 1u);
            const unsigned tg = og / nx;
            if (og + 1u == (tg + 1u) * nx) xb_add(&bar[XB_TOPGEN], 1u);
            else XB_SPIN(xb_ld(&bar[XB_TOPGEN]) == tg, bar);
            __builtin_amdgcn_fence(__ATOMIC_ACQUIRE, "agent");
            xb_add(&bar[XB_XGEN(b.x)], 1u);
            asm volatile("s_waitcnt vmcnt(0)" ::: "memory");
        } else {
            XB_SPIN(xb_ld(&bar[XB_XGEN(b.x)]) == gen, bar);
            __builtin_amdgcn_fence(__ATOMIC_ACQUIRE, "agent");
            asm volatile("s_waitcnt vmcnt(0)" ::: "memory");
        }
    }
    __syncthreads();
}
constexpr int NWAVES = 8;
constexpr int BATCH = 8, T = 4096, D = 1024, M = BATCH * T, FF = 2816, NGU = 2 * FF, NINP = 2560, NIN_SRC = 2516, NL = 2;
constexpr float RMS_EPS = 1e-6f;
constexpr size_t MiB = 1u << 20;
constexpr size_t WS_CTL = 0, CTL_ZERO_BYTES = 1 * MiB;
constexpr size_t WS_CS64 = 1 * MiB;
constexpr size_t WS_CS32 = 2 * MiB;
constexpr size_t WS_ADA = 2 * MiB + 512 * 1024;
constexpr size_t WS_KMEAN = 3 * MiB + 256 * 1024;
constexpr size_t WS_RSTDQ = 3 * MiB + 512 * 1024;
constexpr size_t WS_RSTDKV = 3 * MiB + 768 * 1024;
constexpr size_t WS_KCMP = 4 * MiB;
constexpr size_t WS_VCMP = 4 * MiB + 512 * 1024;
constexpr size_t WS_CMPH = 5 * MiB;
constexpr size_t WS_WTS = 10 * MiB, WTS_LAYER = 46 * MiB;
constexpr size_t WO_GU1 = 0, WO_D1 = 11 * MiB, WO_GU2 = 17 * MiB, WO_D2 = 28 * MiB, WO_IN = 34 * MiB, WO_OUT = 39 * MiB, WO_UQ = 41 * MiB, WO_UKV = 41 * MiB + 512 * 1024;
constexpr size_t WS_H = 104 * MiB;
constexpr size_t WS_BIG = 168 * MiB;
constexpr size_t WS_HID = WS_BIG;
constexpr size_t WS_QM_BF = 168 * MiB, WS_KM_BF = 184 * MiB, WS_VM_BF = 200 * MiB, WS_QM_F = 216 * MiB, WS_KM_F = 248 * MiB;
constexpr size_t WS_CQ = 280 * MiB, WS_CKV = 296 * MiB;
constexpr size_t WS_QN = 304 * MiB, WS_KC = 320 * MiB, WS_VC = 324 * MiB, WS_KS = 328 * MiB, WS_VS = 332 * MiB, WS_KW = 336 * MiB, WS_VW = 340 * MiB;
constexpr size_t WS_QD = 344 * MiB, WS_KD = 360 * MiB, WS_VD = 364 * MiB, WS_IQ = 368 * MiB, WS_IK = 400 * MiB, WS_GW = 404 * MiB;
constexpr size_t WS_QMLA = 408 * MiB, WS_KMLA = 432 * MiB, WS_VMLA = 456 * MiB;
constexpr size_t WS_DSAMASK = 472 * MiB;
constexpr size_t WS_END = 512 * MiB;
constexpr int CW_BAR = 4096;
constexpr int RING_OFF = 0, RING_BYTES = 131072;
constexpr int LDSCTL_OFF = RING_BYTES, MISC_OFF = LDSCTL_OFF + 320;
constexpr int XTRA_OFF = 132096, XTRA_WAVE = 2112;
constexpr int LDS_BYTES = 155648;
static_assert(XTRA_OFF + NWAVES * XTRA_WAVE <= LDS_BYTES && MISC_OFF + 128 <= XTRA_OFF, "LDS map");

struct Args { const float* in[28]; float* out; unsigned char* ws; int ph_lo, ph_hi; };
struct Frame {
    LAS unsigned char* lds;
    volatile LAS unsigned* MISC;
    gu32* ctl;
    unsigned char* ws;
    int G;
    const Args* A;
    float* out;
};
enum { I_X = 0, I_C, I_ADAW, I_ADAB, I_F1N, I_F1G, I_F1U, I_F1D, I_MIXN, I_WIN, I_QNORM, I_WUQ, I_KVNORM, I_WUK, I_WUV, I_PEK, I_PEV, I_CK1, I_CK2, I_CV1, I_CV2, I_GN, I_WOUT, I_F2N, I_F2G, I_F2U, I_F2D, I_FINN };

__device__ __forceinline__ int opaque_v(int v) { asm volatile("" : "+v"(v)); return v; }
__device__ __forceinline__ int cur_tid() { return opaque_v((int)threadIdx.x); }
__device__ __forceinline__ int cur_lane() { return opaque_v((int)threadIdx.x) & 63; }
__device__ __forceinline__ int cur_wave() { return __builtin_amdgcn_readfirstlane(opaque_v((int)threadIdx.x) >> 6); }
__device__ __forceinline__ float wave_sum(float v) {
#pragma unroll
    for (int o = 1; o < 64; o <<= 1) v += __shfl_xor(v, o);
    return v;
}
__device__ __forceinline__ float wave_max(float v) {
#pragma unroll
    for (int o = 1; o < 64; o <<= 1) v = fmaxf(v, __shfl_xor(v, o));
    return v;
}
__device__ __forceinline__ float bf2f(unsigned short b) { return __uint_as_float((unsigned)b << 16); }
__device__ __forceinline__ void unpack8(const v4u w, float* f) {
    f[0] = __uint_as_float(w.x << 16); f[1] = __uint_as_float(w.x & 0xffff0000u); f[2] = __uint_as_float(w.y << 16); f[3] = __uint_as_float(w.y & 0xffff0000u);
    f[4] = __uint_as_float(w.z << 16); f[5] = __uint_as_float(w.z & 0xffff0000u); f[6] = __uint_as_float(w.w << 16); f[7] = __uint_as_float(w.w & 0xffff0000u);
}
__device__ __forceinline__ float sigmoid_f(float x) { return 1.0f / (1.0f + __expf(-x)); }

__device__ __forceinline__ int perm64(int j) { return 32 * ((j & 31) >> 4) + 16 * (j >> 5) + (j & 15); }
__device__ __forceinline__ int win_src_col(int c) {
    if (c < 512) return (c & ~63) + perm64(c & 63);
    if (c < 1184) return c;
    if (c < 1504) { const int r = c - 1184; return 1184 + (r & ~63) + perm64(r & 63); }
    if (c < 1568) return c;
    if (c < 1632) return 1568 + perm64(c - 1568);
    if (c < 1696) return c;
    if (c < 1760) return 1696 + perm64(c - 1696);
    if (c < 1824) return c;
    if (c < 2144) { const int r = c - 1824; return 1836 + (r & ~63) + perm64(r & 63); }
    if (c < 2208) return 2156 + (c - 2144);
    if (c < 2464) return 2220 + (c - 2208);
    if (c < 2496) return 2476 + (c - 2464);
    if (c < 2508) return 1824 + (c - 2496);
    if (c < 2516) return 2508 + (c - 2508);
    return -1;
}
constexpr int WK_K[8] = {1024, 2816, 1024, 2816, 1024, 1024, 256, 128};
constexpr int WK_N[8] = {5632, 1024, 5632, 1024, 2560, 1024, 512, 512};
__device__ __forceinline__ size_t wk_off(int kind) { return kind == 0 ? WO_GU1 : kind == 1 ? WO_D1 : kind == 2 ? WO_GU2 : kind == 3 ? WO_D2 : kind == 4 ? WO_IN : kind == 5 ? WO_OUT : kind == 6 ? WO_UQ : WO_UKV; }
__device__ __forceinline__ const float* wsrc(const Frame& F, int kind, int l, int R, int& stride) {
    switch (kind) {
    case 0: case 2: { const int G = R >> 5, w = R & 31, j = 16 * G + (w & 15); stride = FF;
        const float* g = F.A->in[kind == 0 ? I_F1G : I_F2G] + (size_t)l * D * FF; const float* u = F.A->in[kind == 0 ? I_F1U : I_F2U] + (size_t)l * D * FF; return ((w >> 4) ? u : g) + j; }
    case 1: case 3: stride = D; return F.A->in[kind == 1 ? I_F1D : I_F2D] + (size_t)l * FF * D + R;
    case 4: { stride = NIN_SRC; const int s = win_src_col(R); return s < 0 ? nullptr : F.A->in[I_WIN] + (size_t)l * D * NIN_SRC + s; }
    case 5: stride = D; return F.A->in[I_WOUT] + (size_t)l * D * D + R;
    case 6: stride = 384; return R < 384 ? F.A->in[I_WUQ] + (size_t)l * 256 * 384 + R : nullptr;
    default: stride = 256; return R < 256 ? F.A->in[I_WUK] + (size_t)l * 128 * 256 + R : F.A->in[I_WUV] + (size_t)l * 128 * 256 + (R - 256);
    }
}

struct WinDesc {
    unsigned char* ws;
    __device__ __forceinline__ pg8::ProjDesc operator()(int G) const {
        pg8::ProjDesc d; d.kind = 0; d.dfreq0 = 0; d.nstride = 16; d.rep = 1; d.repstride = 0; d.bpitch = 0; d.fpitch = 0; d.pad = 0; d.bp = nullptr; d.fp = nullptr;
        const int c = 32 * G;
#define ROPE64(rel, BOFF, BP, FOFF, FP) do { const int hh_ = (rel) >> 6, g_ = ((rel) >> 5) & 1; d.kind = 2; d.dfreq0 = 16 * g_; d.nstride = 32; \
            d.bp = (bf16*)(ws + (BOFF)) + hh_ * 64 + 16 * g_; d.bpitch = (BP); if (FP) { d.fp = (float*)(ws + (FOFF)) + hh_ * 64 + 16 * g_; d.fpitch = (FP); } } while (0)
#define PLAINB(rel, BOFF, BP) do { d.kind = 1; d.bp = (bf16*)(ws + (BOFF)) + (rel); d.bpitch = (BP); } while (0)
#define PLAINF(rel, FOFF, FP) do { d.kind = 1; d.fp = (float*)(ws + (FOFF)) + (rel); d.fpitch = (FP); } while (0)
        if (c < 256) ROPE64(c, WS_QM_BF, 256, WS_QM_F, 256);
        else if (c < 512) ROPE64(c - 256, WS_KM_BF, 256, WS_KM_F, 256);
        else if (c < 768) PLAINB(c - 512, WS_VM_BF, 256);
        else if (c < 1024) PLAINB(c - 768, WS_CQ, 256);
        else if (c < 1152) PLAINB(c - 1024, WS_CKV, 128);
        else if (c < 1184) { d.kind = 3; d.nstride = 16; d.bp = (bf16*)(ws + WS_KMLA) + 64; d.bpitch = 384; d.rep = 4; d.repstride = 96; }
        else if (c < 1440) ROPE64(c - 1184, WS_QN, 256, 0, 0);
        else if (c < 1504) ROPE64(c - 1440, WS_KC, 64, 0, 0);
        else if (c < 1568) PLAINB(c - 1504, WS_VC, 64);
        else if (c < 1632) ROPE64(c - 1568, WS_KS, 64, 0, 0);
        else if (c < 1696) PLAINB(c - 1632, WS_VS, 64);
        else if (c < 1760) ROPE64(c - 1696, WS_KW, 64, 0, 0);
        else if (c < 1824) PLAINB(c - 1760, WS_VW, 64);
        else if (c < 2080) ROPE64(c - 1824, WS_QD, 256, 0, 0);
        else if (c < 2144) ROPE64(c - 2080, WS_KD, 64, 0, 0);
        else if (c < 2208) PLAINB(c - 2144, WS_VD, 64);
        else if (c < 2464) PLAINF(c - 2208, WS_IQ, 256);
        else if (c < 2496) PLAINF(c - 2464, WS_IK, 32);
        else if (c < 2528) PLAINF(c - 2496, WS_GW, 32);
#undef ROPE64
#undef PLAINB
#undef PLAINF
        return d;
    }
};
struct MlaQDesc {
    unsigned char* ws;
    __device__ __forceinline__ pg8::ProjDesc operator()(int G) const {
        pg8::ProjDesc d; d.kind = 0; d.dfreq0 = 0; d.nstride = 16; d.rep = 1; d.repstride = 0; d.bpitch = 384; d.fpitch = 0; d.pad = 0; d.bp = nullptr; d.fp = nullptr;
        if (G < 12) { const int hh = G / 3, part = G - 3 * hh; d.kind = (part == 2) ? 3 : 1; d.bp = (bf16*)(ws + WS_QMLA) + hh * 96 + 32 * part; }
        return d;
    }
};
struct MlaKvDesc {
    unsigned char* ws;
    __device__ __forceinline__ pg8::ProjDesc operator()(int G) const {
        pg8::ProjDesc d; d.kind = 1; d.dfreq0 = 0; d.nstride = 16; d.rep = 1; d.repstride = 0; d.bpitch = 0; d.fpitch = 0; d.pad = 0; d.bp = nullptr; d.fp = nullptr;
        const int c = 32 * G;
        if (c < 256) { d.bp = (bf16*)(ws + WS_KMLA) + (c >> 6) * 96 + (c & 63); d.bpitch = 384; }
        else { d.bp = (bf16*)(ws + WS_VMLA) + (c - 256); d.bpitch = 256; }
        return d;
    }
};

__device__ __forceinline__ void p0_prologue(Frame& F) {
    const int tid = cur_tid();
    const int wave = cur_wave(), gw = blockIdx.x * NWAVES + wave, NGW = F.G * NWAVES, lane = cur_lane();
    {
        LAS float* scr = (LAS float*)(F.lds + RING_OFF + wave * 16384);
        constexpr int PER_LAYER = 2816 + 1408 + 2816 + 1408 + 1280 + 512 + 64 + 32;
        for (int it = gw; it < NL * PER_LAYER; it += NGW) {
            const int l = it / PER_LAYER; int r = it - l * PER_LAYER; int kind = 0;
            { const int cnt[8] = {2816, 1408, 2816, 1408, 1280, 512, 64, 32};
#pragma unroll
              for (int q = 0; q < 7; ++q) { if (kind == q && r >= cnt[q]) { r -= cnt[q]; kind = q + 1; } } }
            const int K = kind == 0 || kind == 2 || kind == 4 || kind == 5 ? 1024 : (kind == 1 || kind == 3) ? 2816 : kind == 6 ? 256 : 128;
            const int N = kind == 0 || kind == 2 ? 5632 : kind == 4 ? 2560 : (kind == 6 || kind == 7) ? 512 : 1024;
            const int nblk = N / 32, kb = r / nblk, nb = r - kb * nblk, k0 = 64 * kb, n0 = 32 * nb;
            int stride; const float* colp = wsrc(F, kind, l, n0 + (lane & 31), stride);
            const float* ksc = kind == 6 ? F.A->in[I_QNORM] + l * 256 : kind == 7 ? F.A->in[I_KVNORM] + l * 128 : nullptr;
            bf16* WT = (bf16*)(F.ws + WS_WTS + (size_t)l * WTS_LAYER + wk_off(kind));
#pragma unroll 8
            for (int i = 0; i < 32; ++i) { const int kk = 2 * i + (lane >> 5); float v = colp ? colp[(size_t)(k0 + kk) * stride] : 0.f; if (ksc) v *= ksc[k0 + kk]; scr[kk * 33 + (lane & 31)] = v; }
            LDS_WAIT(); asm volatile("" ::: "memory");
            const int c = lane & 7;
#pragma unroll
            for (int j = 0; j < 4; ++j) { const int n = (lane >> 3) + 8 * j; const LAS float* s = scr + (8 * c) * 33 + n;
                v4u o; o.x = pk2(s[0 * 33], s[1 * 33]); o.y = pk2(s[2 * 33], s[3 * 33]); o.z = pk2(s[4 * 33], s[5 * 33]); o.w = pk2(s[6 * 33], s[7 * 33]);
                *(GAS v4u*)(WT + (size_t)(n0 + n) * K + k0 + 8 * c) = o; }
            LDS_WAIT(); asm volatile("" ::: "memory");
        }
    }
    for (int i = blockIdx.x * 512 + tid; i < 4096 * 48; i += F.G * 512) {
        const int pos = i / 48, j = i - pos * 48;
        float invf; float* dst;
        if (j < 32) { invf = 1.0f / (float)pow(10000.0, (double)j / 32.0); dst = (float*)(F.ws + WS_CS64) + ((size_t)pos * 32 + j) * 2; }
        else { invf = 1.0f / (float)pow(10000.0, (double)(j - 32) / 16.0); dst = (float*)(F.ws + WS_CS32) + ((size_t)pos * 16 + (j - 32)) * 2; }
        const float ang = (float)pos * invf;
        dst[0] = (float)cos((double)ang); dst[1] = (float)sin((double)ang);
    }
    {
        __syncthreads();
        LAS float* cact = (LAS float*)(F.lds + RING_OFF);
        LAS float* red = (LAS float*)(F.lds + RING_OFF + 32768);
        for (int i = tid; i < 8 * 1024; i += 512) { const float cv = F.A->in[I_C][i]; cact[i] = cv / (1.0f + __expf(-cv)); }
        __syncthreads();
        for (int task = blockIdx.x; task < NL * 144; task += F.G) {
            const int l = task / 144, n0 = (task - l * 144) * 64;
            const float* W = F.A->in[I_ADAW] + (size_t)l * 1024 * 9216 + n0 + lane;
            float acc[8];
#pragma unroll
            for (int b = 0; b < 8; ++b) acc[b] = 0.f;
            const int kbeg = wave * 128;
#pragma unroll 4
            for (int k = kbeg; k < kbeg + 128; ++k) { const float wv = W[(size_t)k * 9216];
#pragma unroll
                for (int b = 0; b < 8; ++b) acc[b] += cact[b * 1024 + k] * wv; }
#pragma unroll
            for (int b = 0; b < 8; ++b) red[(wave * 8 + b) * 64 + lane] = acc[b];
            __syncthreads();
            { const int b = wave; float s = F.A->in[I_ADAB][(size_t)l * 9216 + n0 + lane];
#pragma unroll
              for (int w = 0; w < 8; ++w) s += red[(w * 8 + b) * 64 + lane];
              ((float*)(F.ws + WS_ADA))[((size_t)l * 8 + b) * 9216 + n0 + lane] = s; }
            __syncthreads();
        }
    }
}

__device__ __forceinline__ void norm_mod_phase(Frame& F, const float* xsrc, const float* gain, const float* sh, const float* sc, bf16* hout) {
    const int wave = cur_wave(), gw = blockIdx.x * NWAVES + wave, NGW = F.G * NWAVES, lane = cur_lane();
    f32x4 g[4];
#pragma unroll
    for (int j = 0; j < 4; ++j) g[j] = *(const f32x4*)(gain + 4 * lane + 256 * j);
    for (int row = gw; row < M; row += NGW) {
        const f32x4* xr = (const f32x4*)(xsrc + (size_t)row * D) + lane;
        f32x4 v[4]; float s = 0.f;
#pragma unroll
        for (int j = 0; j < 4; ++j) { v[j] = xr[64 * j]; s += (v[j].x * v[j].x + v[j].y * v[j].y) + (v[j].z * v[j].z + v[j].w * v[j].w); }
        const float rstd = 1.0f / sqrtf(wave_sum(s) * (1.f / D) + RMS_EPS);
        const int b = row >> 12;
        const float* shb = sh + (size_t)b * 9216 + 4 * lane; const float* scb = sc + (size_t)b * 9216 + 4 * lane;
        unsigned long long* o8 = (unsigned long long*)(hout + (size_t)row * D) + lane;
#pragma unroll
        for (int j = 0; j < 4; ++j) { const f32x4 s4 = *(const f32x4*)(shb + 256 * j), c4 = *(const f32x4*)(scb + 256 * j);
            const f32x4 y = v[j] * rstd * g[j] * (c4 + 1.0f) + s4;
            o8[64 * j] = (unsigned long long)pk2(y.x, y.y) | ((unsigned long long)pk2(y.z, y.w) << 32); }
    }
}
__device__ __forceinline__ void final_norm_phase(Frame& F, float* x, const float* gain) {
    const int wave = cur_wave(), gw = blockIdx.x * NWAVES + wave, NGW = F.G * NWAVES, lane = cur_lane();
    f32x4 g[4];
#pragma unroll
    for (int j = 0; j < 4; ++j) g[j] = *(const f32x4*)(gain + 4 * lane + 256 * j);
    for (int row = gw; row < M; row += NGW) {
        f32x4* xr = (f32x4*)(x + (size_t)row * D) + lane;
        f32x4 v[4]; float s = 0.f;
#pragma unroll
        for (int j = 0; j < 4; ++j) { v[j] = xr[64 * j]; s += (v[j].x * v[j].x + v[j].y * v[j].y) + (v[j].z * v[j].z + v[j].w * v[j].w); }
        const float rstd = 1.0f / sqrtf(wave_sum(s) * (1.f / D) + RMS_EPS);
#pragma unroll
        for (int j = 0; j < 4; ++j) xr[64 * j] = v[j] * rstd * g[j];
    }
}
__device__ __forceinline__ void group_norm_phase(Frame& F, bf16* Y, const float* gn) {
    const int wave = cur_wave(), gw = blockIdx.x * NWAVES + wave, NGW = F.G * NWAVES, lane = cur_lane();
    f32x4 g[4];
#pragma unroll
    for (int j = 0; j < 4; ++j) g[j] = *(const f32x4*)(gn + 256 * j + 4 * lane);
    for (int row = gw; row < M; row += NGW) {
        unsigned long long* yr = (unsigned long long*)(Y + (size_t)row * D) + lane;
#pragma unroll
        for (int j = 0; j < 4; ++j) {
            const unsigned long long w = yr[64 * j];
            const float a0 = __uint_as_float((unsigned)w << 16), a1 = __uint_as_float((unsigned)w & 0xffff0000u), a2 = __uint_as_float((unsigned)(w >> 32) << 16), a3 = __uint_as_float((unsigned)(w >> 32) & 0xffff0000u);
            const float ss = wave_sum((a0 * a0 + a1 * a1) + (a2 * a2 + a3 * a3));
            const float rstd = 1.0f / sqrtf(ss * (1.f / 256.f) + RMS_EPS);
            yr[64 * j] = (unsigned long long)pk2(a0 * rstd * g[j].x, a1 * rstd * g[j].y) | ((unsigned long long)pk2(a2 * rstd * g[j].z, a3 * rstd * g[j].w) << 32);
        }
    }
}
__device__ __forceinline__ int mbcnt64(unsigned long long m) { return (int)__builtin_amdgcn_mbcnt_hi((unsigned)(m >> 32), __builtin_amdgcn_mbcnt_lo((unsigned)m, 0u)); }
__device__ __forceinline__ unsigned fkey(float x) { const unsigned u = __float_as_uint(x); return (u & 0x80000000u) ? ~u : (u | 0x80000000u); }
__device__ __forceinline__ float reduce64(const float (&o)[64], int lane) {
    float r5[32], r4[16], r3[8], r2[4], r1[2];
    { const bool hi = (lane & 32) != 0;
#pragma unroll
      for (int i = 0; i < 32; ++i) { const float a = o[i], b = o[i + 32]; r5[i] = (hi ? b : a) + __shfl_xor(hi ? a : b, 32); } }
    { const bool hi = (lane & 16) != 0;
#pragma unroll
      for (int i = 0; i < 16; ++i) { const float a = r5[i], b = r5[i + 16]; r4[i] = (hi ? b : a) + __shfl_xor(hi ? a : b, 16); } }
    { const bool hi = (lane & 8) != 0;
#pragma unroll
      for (int i = 0; i < 8; ++i) { const float a = r4[i], b = r4[i + 8]; r3[i] = (hi ? b : a) + __shfl_xor(hi ? a : b, 8); } }
    { const bool hi = (lane & 4) != 0;
#pragma unroll
      for (int i = 0; i < 4; ++i) { const float a = r3[i], b = r3[i + 4]; r2[i] = (hi ? b : a) + __shfl_xor(hi ? a : b, 4); } }
    { const bool hi = (lane & 2) != 0;
#pragma unroll
      for (int i = 0; i < 2; ++i) { const float a = r2[i], b = r2[i + 2]; r1[i] = (hi ? b : a) + __shfl_xor(hi ? a : b, 2); } }
    const bool hi = (lane & 1) != 0;
    return (hi ? r1[1] : r1[0]) + __shfl_xor(hi ? r1[0] : r1[1], 1);
}
struct KVbf {
    const bf16* K; const bf16* V; int kp, vp;
    template <int DQ> __device__ __forceinline__ float dot(int row, const LAS float* q) const {
        const v4u* p = (const v4u*)(K + (size_t)row * kp); float s = 0.f;
#pragma unroll
        for (int c = 0; c < DQ / 8; ++c) { float f[8]; unpack8(p[c], f); const f32x4 q0 = *(const LAS f32x4*)(q + 8 * c), q1 = *(const LAS f32x4*)(q + 8 * c + 4);
            s += (q0.x * f[0] + q0.y * f[1]) + (q0.z * f[2] + q0.w * f[3]) + (q1.x * f[4] + q1.y * f[5]) + (q1.z * f[6] + q1.w * f[7]); }
        return s;
    }
    __device__ __forceinline__ void axpy(int row, float pw, float (&o)[64]) const {
        const v4u* p = (const v4u*)(V + (size_t)row * vp);
#pragma unroll
        for (int c = 0; c < 8; ++c) { float f[8]; unpack8(p[c], f);
#pragma unroll
            for (int e = 0; e < 8; ++e) o[8 * c + e] += pw * f[e]; }
    }
};
struct KVf32 {
    const float* K; const float* V; int kp, vp;
    template <int DQ> __device__ __forceinline__ float dot(int row, const LAS float* q) const {
        const f32x4* p = (const f32x4*)(K + (size_t)row * kp); float s = 0.f;
#pragma unroll
        for (int c = 0; c < DQ / 4; ++c) { const f32x4 f = p[c]; const f32x4 qv = *(const LAS f32x4*)(q + 4 * c); s += (qv.x * f.x + qv.y * f.y) + (qv.z * f.z + qv.w * f.w); }
        return s;
    }
    __device__ __forceinline__ void axpy(int row, float pw, float (&o)[64]) const {
        const f32x4* p = (const f32x4*)(V + (size_t)row * vp);
#pragma unroll
        for (int c = 0; c < 16; ++c) { const f32x4 f = p[c]; o[4 * c] += pw * f.x; o[4 * c + 1] += pw * f.y; o[4 * c + 2] += pw * f.z; o[4 * c + 3] += pw * f.w; }
    }
};
template <int DQ, class KV, class KeyFn>
__device__ __forceinline__ float wave_attend(const LAS float* q, float scale, int nslots, const KeyFn& keyf, const KV& kv, int lane) {
    float m = -INFINITY;
    for (int s = 0; s < nslots; ++s) { const int key = keyf(s); if (key >= 0) m = fmaxf(m, kv.template dot<DQ>(key, q) * scale); }
    const float Mx = wave_max(m);
    float o[64];
#pragma unroll
    for (int d = 0; d < 64; ++d) o[d] = 0.f;
    float l = 0.f;
    if (Mx > -INFINITY) {
        for (int s = 0; s < nslots; ++s) { const int key = keyf(s);
            if (key >= 0) { const float p = __expf(kv.template dot<DQ>(key, q) * scale - Mx); l += p; kv.axpy(key, p, o); } }
    }
    l = wave_sum(l);
    const float r = reduce64(o, lane);
    return l > 0.f ? r / l : 0.f;
}
__device__ __forceinline__ void task_bt(int i, int& t, int& rest) { const int tt = i & 2047, j = i >> 11; t = (j & 1) ? 4095 - tt : tt; rest = j >> 1; }

__device__ __forceinline__ void m1_phase(Frame& F, int l) {
    const int wave = cur_wave(), gw = blockIdx.x * NWAVES + wave, NGW = F.G * NWAVES, lane = cur_lane();
    const bf16* CQ = (const bf16*)(F.ws + WS_CQ); const bf16* CKV = (const bf16*)(F.ws + WS_CKV);
    float* rq = (float*)(F.ws + WS_RSTDQ); float* rkv = (float*)(F.ws + WS_RSTDKV);
    for (int row = gw; row < M; row += NGW) {
        const unsigned long long w = ((const unsigned long long*)(CQ + (size_t)row * 256))[lane];
        const float a0 = __uint_as_float((unsigned)w << 16), a1 = __uint_as_float((unsigned)w & 0xffff0000u), a2 = __uint_as_float((unsigned)(w >> 32) << 16), a3 = __uint_as_float((unsigned)(w >> 32) & 0xffff0000u);
        const float s1 = wave_sum((a0 * a0 + a1 * a1) + (a2 * a2 + a3 * a3));
        const unsigned w2 = ((const unsigned*)(CKV + (size_t)row * 128))[lane];
        const float b0 = __uint_as_float(w2 << 16), b1 = __uint_as_float(w2 & 0xffff0000u);
        const float s2 = wave_sum(b0 * b0 + b1 * b1);
        if (lane == 0) { rq[row] = 1.0f / sqrtf(s1 * (1.f / 256.f) + RMS_EPS); rkv[row] = 1.0f / sqrtf(s2 * (1.f / 128.f) + RMS_EPS); }
    }
    const float* KMF = (const float*)(F.ws + WS_KM_F); float* kmean = (float*)(F.ws + WS_KMEAN);
    for (int task = gw; task < 512; task += NGW) {
        const int b = task >> 6, blk = (task >> 2) & 15, h = task & 3;
        const float* p = KMF + ((size_t)(b * T + blk * 256)) * 256 + h * 64 + lane; float s = 0.f;
#pragma unroll 8
        for (int i = 0; i < 256; ++i) s += p[(size_t)i * 256];
        kmean[((b * 4 + h) * 16 + blk) * 64 + lane] = s * (1.f / 256.f);
    }
    float* cmph = (float*)(F.ws + WS_CMPH);
    for (int task = gw; task < 2 * 8 * 255 * 4; task += NGW) {
        const int kv = task / 8160, r1 = task - kv * 8160, b = r1 / 1020, r2 = r1 - b * 1020, n = r2 >> 2, jout = (r2 & 3) * 64 + lane;
        const bf16* X = (const bf16*)(F.ws + (kv ? WS_VC : WS_KC)) + ((size_t)(b * T + 16 * n)) * 64;
        const float* pe = F.A->in[kv ? I_PEV : I_PEK] + (size_t)l * 2048;
        const float* w1 = F.A->in[kv ? I_CV1 : I_CK1] + (size_t)l * 2048 * 256 + jout;
        float acc = 0.f;
        for (int ll = 0; ll < 32; ++ll) {
            const float ad = bf2f(X[ll * 64 + lane]) + pe[ll * 64 + lane];
            const float* wr = w1 + (size_t)(ll * 64) * 256;
#pragma unroll 16
            for (int d = 0; d < 64; ++d) acc += __shfl(ad, d) * wr[(size_t)d * 256];
        }
        cmph[((size_t)(kv * 8 + b) * 256 + n) * 256 + jout] = acc / (1.0f + __expf(-acc));
    }
}
__device__ __forceinline__ void cmp2_phase(Frame& F, int l) {
    const int wave = cur_wave(), gw = blockIdx.x * NWAVES + wave, NGW = F.G * NWAVES, lane = cur_lane();
    const float* cmph = (const float*)(F.ws + WS_CMPH);
    for (int task = gw; task < 2 * 8 * 255; task += NGW) {
        const int kv = task / 2040, r1 = task - kv * 2040, b = r1 / 255, n = r1 - b * 255;
        const float* hp = cmph + ((size_t)(kv * 8 + b) * 256 + n) * 256;
        const float* w2 = F.A->in[kv ? I_CV2 : I_CK2] + (size_t)l * 256 * 64 + lane;
        float acc = 0.f;
#pragma unroll 8
        for (int j = 0; j < 256; ++j) acc += hp[j] * w2[j * 64];
        ((float*)(F.ws + (kv ? WS_VCMP : WS_KCMP)))[((size_t)b * 256 + n) * 64 + lane] = acc;
    }
}
__device__ __forceinline__ void mla_rows_phase(Frame& F) {
    const int wave = cur_wave(), gw = blockIdx.x * NWAVES + wave, NGW = F.G * NWAVES, lane = cur_lane();
    const bf16* Q = (const bf16*)(F.ws + WS_QMLA); bf16* Y = (bf16*)(F.ws + WS_H);
    LAS float* q = (LAS float*)(F.lds + RING_OFF + wave * 16384 + 4096);
    for (int i = gw; i < M * 4; i += NGW) {
        int t, bh; task_bt(i, t, bh); const int b = bh >> 2, h = bh & 3, row = b * T + t;
        if (lane < 48) { const unsigned w = ((const unsigned*)(Q + (size_t)row * 384 + h * 96))[lane]; q[2 * lane] = __uint_as_float(w << 16); q[2 * lane + 1] = __uint_as_float(w & 0xffff0000u); }
        LDS_WAIT(); asm volatile("" ::: "memory");
        KVbf kv{(const bf16*)(F.ws + WS_KMLA) + h * 96, (const bf16*)(F.ws + WS_VMLA) + h * 64, 384, 256};
        const int base = b * T;
        auto keyf = [&](int s) { const int p = lane + 64 * s; return p <= t ? base + p : -1; };
        const float r = wave_attend<96>(q, 0.10206207261596577f, (t >> 6) + 1, keyf, kv, lane);
        Y[(size_t)row * 1024 + 256 + h * 64 + lane] = (bf16)f2bf(r);
        LDS_WAIT(); asm volatile("" ::: "memory");
    }
}
__device__ __forceinline__ void moba_rows_phase(Frame& F) {
    const int wave = cur_wave(), gw = blockIdx.x * NWAVES + wave, NGW = F.G * NWAVES, lane = cur_lane();
    const float* QF = (const float*)(F.ws + WS_QM_F); const float* kmean = (const float*)(F.ws + WS_KMEAN); bf16* Y = (bf16*)(F.ws + WS_H);
    LAS float* q = (LAS float*)(F.lds + RING_OFF + wave * 16384 + 4096);
    for (int i = gw; i < M * 4; i += NGW) {
        int t, bh; task_bt(i, t, bh); const int b = bh >> 2, h = bh & 3, row = b * T + t, own = t >> 8;
        q[lane] = QF[(size_t)row * 256 + h * 64 + lane];
        LDS_WAIT(); asm volatile("" ::: "memory");
        float g = -INFINITY;
        if (lane < own) { KVf32 km{kmean + (size_t)((b * 4 + h) * 16) * 64, nullptr, 64, 64}; g = km.dot<64>(lane, q); }
        unsigned selmask = 0u;
        for (int r = 0; r < 3; ++r) { const float mx = wave_max(g); if (!(mx > -INFINITY)) break;
            const unsigned long long ball = __ballot(g == mx); const int sl = __ffsll((long long)ball) - 1; selmask |= 1u << sl; if (lane == sl) g = -INFINITY; }
        KVbf kv{(const bf16*)(F.ws + WS_KM_BF) + h * 64, (const bf16*)(F.ws + WS_VM_BF) + h * 64, 256, 256};
        const int base = b * T;
        auto keyf = [&](int s) { const int blk = s >> 2, p = 64 * s + lane; return blk == own ? (p <= t ? base + p : -1) : (((selmask >> blk) & 1u) ? base + p : -1); };
        const float r = wave_attend<64>(q, 0.125f, 4 * own + 4, keyf, kv, lane);
        Y[(size_t)row * 1024 + h * 64 + lane] = (bf16)f2bf(r);
        LDS_WAIT(); asm volatile("" ::: "memory");
    }
}
__device__ __forceinline__ void nsa_tokens_phase(Frame& F) {
    const int wave = cur_wave(), gw = blockIdx.x * NWAVES + wave, NGW = F.G * NWAVES, lane = cur_lane();
    const bf16* QN = (const bf16*)(F.ws + WS_QN); bf16* Y = (bf16*)(F.ws + WS_H);
    const float* kcmp = (const float*)(F.ws + WS_KCMP); const float* vcmp = (const float*)(F.ws + WS_VCMP); const float* GWp = (const float*)(F.ws + WS_GW);
    LAS float* ps = (LAS float*)(F.lds + RING_OFF + wave * 16384);
    LAS float* ocs = ps + 256;
    LAS float* svl = ps + 512;
    LAS float* q = (LAS float*)(F.lds + RING_OFF + wave * 16384 + 4096);
    for (int i = gw; i < M; i += NGW) {
        int t, b; task_bt(i, t, b); const int row = b * T + t, own = t >> 6, base = b * T;
#pragma unroll
        for (int k = 0; k < 4; ++k) ps[lane + 64 * k] = 0.f;
#pragma unroll 1
        for (int h = 0; h < 4; ++h) {
            LDS_WAIT(); asm volatile("" ::: "memory");
            q[lane] = bf2f(QN[(size_t)row * 256 + h * 64 + lane]);
            LDS_WAIT(); asm volatile("" ::: "memory");
            KVf32 kc{kcmp + (size_t)b * 256 * 64, vcmp + (size_t)b * 256 * 64, 64, 64};
            float ml = -INFINITY;
#pragma unroll 1
            for (int k = 0; k < 4; ++k) { const int n = lane + 64 * k; const bool valid = (n < 255) && (16 * n + 31 <= t);
                float sv = -INFINITY; if (valid) sv = kc.dot<64>(n, q) * 0.125f; svl[n] = sv; ml = fmaxf(ml, sv); }
            const float Mx = wave_max(ml);
            float o[64];
#pragma unroll
            for (int d = 0; d < 64; ++d) o[d] = 0.f;
#ifndef NSA_NO_C
            if (Mx > -INFINITY) {
                float ls = 0.f;
#pragma unroll 1
                for (int k = 0; k < 4; ++k) { const float sv = svl[lane + 64 * k]; const float p = sv > -INFINITY ? __expf(sv - Mx) : 0.f; ls += p; svl[lane + 64 * k] = p; }
                const float inv = 1.0f / wave_sum(ls);
#pragma unroll 1
                for (int k = 0; k < 4; ++k) { const float p = svl[lane + 64 * k] * inv; ps[lane + 64 * k] += p; if (p > 0.f) kc.axpy(lane + 64 * k, p, o); }
            }
#endif
            ocs[h * 64 + lane] = reduce64(o, lane);
        }
        LDS_WAIT(); asm volatile("" ::: "memory");
        float imp = (ps[4 * lane] + ps[4 * lane + 1]) + (ps[4 * lane + 2] + ps[4 * lane + 3]); if (lane > 0) imp += ps[4 * lane - 1];
        LDS_WAIT(); asm volatile("" ::: "memory");
        const bool causal = lane <= own, forced = causal && (lane == 0 || lane >= own - 1);
        float val = forced ? 1e4f : (causal ? imp : -INFINITY);
        unsigned long long selmask = 0ull;
        for (int r = 0; r < 16; ++r) { const float mx = wave_max(val); if (!(mx > -INFINITY)) break;
            const unsigned long long ball = __ballot(val == mx); const int sl = __ffsll((long long)ball) - 1; selmask |= 1ull << sl; if (lane == sl) val = -INFINITY; }
#pragma unroll
        for (int h = 0; h < 4; ++h) {
            LDS_WAIT(); asm volatile("" ::: "memory");
            q[lane] = bf2f(QN[(size_t)row * 256 + h * 64 + lane]);
            LDS_WAIT(); asm volatile("" ::: "memory");
            KVbf ks{(const bf16*)(F.ws + WS_KS), (const bf16*)(F.ws + WS_VS), 64, 64};
            auto keys = [&](int s) { const int p = 64 * s + lane; return (((selmask >> s) & 1ull) && p <= t) ? base + p : -1; };
#ifdef NSA_NO_S
            float os = q[3];
#else
            float os = wave_attend<64>(q, 0.125f, own + 1, keys, ks, lane);
            asm volatile("" : "+v"(os) :: "memory");
#endif
            KVbf kw{(const bf16*)(F.ws + WS_KW), (const bf16*)(F.ws + WS_VW), 64, 64};
            auto keyw = [&](int s) { const int p = t - 511 + lane + 64 * s; return p >= 0 ? base + p : -1; };
#ifdef NSA_NO_W
            float ow = q[5];
#else
            float ow = wave_attend<64>(q, 0.125f, 8, keyw, kw, lane);
            asm volatile("" : "+v"(ow) :: "memory");
#endif
            const float* gp = GWp + (size_t)row * 32 + h * 3;
            const float g0 = sigmoid_f(gp[0]), g1 = sigmoid_f(gp[1]), g2 = sigmoid_f(gp[2]);
            Y[(size_t)row * 1024 + 512 + h * 64 + lane] = (bf16)f2bf(g0 * ocs[h * 64 + lane] + g1 * os + g2 * ow);
        }
    }
}
__device__ __forceinline__ void dsa_tokens_phase(Frame& F) {
    const int wave = cur_wave(), gw = blockIdx.x * NWAVES + wave, NGW = F.G * NWAVES, lane = cur_lane();
    const float* IQ = (const float*)(F.ws + WS_IQ); const float* IK = (const float*)(F.ws + WS_IK); const float* GWp = (const float*)(F.ws + WS_GW);
    const bf16* QD = (const bf16*)(F.ws + WS_QD); bf16* Y = (bf16*)(F.ws + WS_H);
    LAS float* sc = (LAS float*)(F.lds + RING_OFF + wave * 16384);
    LAS unsigned* hist = (LAS unsigned*)(F.lds + XTRA_OFF + wave * XTRA_WAVE);
    LAS unsigned short* idx = (LAS unsigned short*)hist;
    LAS float* xq = (LAS float*)(F.lds + XTRA_OFF + wave * XTRA_WAVE + 1024);
    for (int i = gw; i < M; i += NGW) {
        int t, b; task_bt(i, t, b); const int row = b * T + t, base = b * T, n = t + 1;
#pragma unroll
        for (int k = 0; k < 4; ++k) xq[lane + 64 * k] = IQ[(size_t)row * 256 + lane + 64 * k];
        if (lane < 8) xq[256 + lane] = GWp[(size_t)row * 32 + 12 + lane];
        LDS_WAIT(); asm volatile("" ::: "memory");
        for (int k0 = 0; k0 < n; k0 += 64) {
            const int key = k0 + lane;
            if (key < n) {
                float ik[32];
                { const f32x4* kp = (const f32x4*)(IK + (size_t)(base + key) * 32);
#pragma unroll
                  for (int c = 0; c < 8; ++c) { const f32x4 f = kp[c]; ik[4 * c] = f.x; ik[4 * c + 1] = f.y; ik[4 * c + 2] = f.z; ik[4 * c + 3] = f.w; } }
                float score = 0.f;
#pragma unroll
                for (int h = 0; h < 8; ++h) { float ds = 0.f;
#pragma unroll
                    for (int c = 0; c < 8; ++c) { const f32x4 qv = *(const LAS f32x4*)(xq + h * 32 + 4 * c); ds += (qv.x * ik[4 * c] + qv.y * ik[4 * c + 1]) + (qv.z * ik[4 * c + 2] + qv.w * ik[4 * c + 3]); }
                    score += xq[256 + h] * fmaxf(ds, 0.f); }
                sc[key] = score * 0.0625f + 0.0f;
            }
        }
        LDS_WAIT(); asm volatile("" ::: "memory");
        int nsel = n;
        if (n > 256) {
            unsigned prefix = 0u, pmask = 0u; int kk = 256;
            for (int pass = 0; pass < 4; ++pass) {
                const int shift = 24 - 8 * pass;
#pragma unroll
                for (int k = 0; k < 4; ++k) hist[lane + 64 * k] = 0u;
                LDS_WAIT(); asm volatile("" ::: "memory");
                for (int k0 = 0; k0 < n; k0 += 64) { const int key = k0 + lane;
                    if (key < n) { const unsigned u = fkey(sc[key]); if ((u & pmask) == prefix) __hip_atomic_fetch_add(hist + ((u >> shift) & 255u), 1u, __ATOMIC_RELAXED, __HIP_MEMORY_SCOPE_WORKGROUP); } }
                LDS_WAIT(); asm volatile("" ::: "memory");
                const int h0 = (int)hist[4 * lane], h1 = (int)hist[4 * lane + 1], h2 = (int)hist[4 * lane + 2], h3 = (int)hist[4 * lane + 3];
                const int tot = (h0 + h1) + (h2 + h3); int incl = tot;
#pragma unroll
                for (int o = 1; o < 64; o <<= 1) { const int v = __shfl_down(incl, o); if (lane + o < 64) incl += v; }
                int run = incl - tot, found = -1, newk = 0;
                if (run < kk && run + h3 >= kk) { found = 4 * lane + 3; newk = kk - run; } run += h3;
                if (found < 0 && run < kk && run + h2 >= kk) { found = 4 * lane + 2; newk = kk - run; } run += h2;
                if (found < 0 && run < kk && run + h1 >= kk) { found = 4 * lane + 1; newk = kk - run; } run += h1;
                if (found < 0 && run < kk && run + h0 >= kk) { found = 4 * lane; newk = kk - run; }
                const unsigned long long ball = __ballot(found >= 0); const int src = __ffsll((long long)ball) - 1;
                const int bin = __shfl(found, src); kk = __shfl(newk, src);
                prefix |= (unsigned)bin << shift; pmask |= 255u << shift;
                LDS_WAIT(); asm volatile("" ::: "memory");
            }
            int eqseen = 0, cnt = 0;
            for (int k0 = 0; k0 < n; k0 += 64) { const int key = k0 + lane; const bool inb = key < n; const unsigned u = inb ? fkey(sc[key]) : 0u;
                const bool gt = inb && u > prefix, eq = inb && u == prefix;
                const unsigned long long be = __ballot(eq); const bool sel = gt || (eq && (eqseen + mbcnt64(be)) < kk);
                const unsigned long long bs = __ballot(sel); if (sel) idx[cnt + mbcnt64(bs)] = (unsigned short)key;
                eqseen += __popcll(be); cnt += __popcll(bs); }
            nsel = cnt;
            LDS_WAIT(); asm volatile("" ::: "memory");
        }
        int kidx[4];
#pragma unroll
        for (int k = 0; k < 4; ++k) { const int p = lane + 64 * k; kidx[k] = p < nsel ? base + (n > 256 ? (int)idx[p] : p) : -1; }
        LDS_WAIT(); asm volatile("" ::: "memory");
#pragma unroll 1
        for (int h = 0; h < 4; ++h) {
            LDS_WAIT(); asm volatile("" ::: "memory");
            xq[lane] = bf2f(QD[(size_t)row * 256 + h * 64 + lane]);
            LDS_WAIT(); asm volatile("" ::: "memory");
            KVbf kd{(const bf16*)(F.ws + WS_KD), (const bf16*)(F.ws + WS_VD), 64, 64};
            auto keyf = [&](int s) { return s == 0 ? kidx[0] : s == 1 ? kidx[1] : s == 2 ? kidx[2] : kidx[3]; };
            const float r = wave_attend<64>(xq, 0.125f, 4, keyf, kd, lane);
            Y[(size_t)row * 1024 + 768 + h * 64 + lane] = (bf16)f2bf(r);
        }
        LDS_WAIT(); asm volatile("" ::: "memory");
    }
}
#ifndef PHMASK
#define PHMASK 0xFFFFFFFFu
#endif
#define EN(b) ((PHMASK >> (b)) & 1u)
__global__ void __launch_bounds__(NWAVES * 64, 2) fwd_kernel(Args args) {
    extern __shared__ __attribute__((aligned(16))) unsigned char lds[];
    Frame F;
    F.lds = (LAS unsigned char*)lds;
    F.MISC = (volatile LAS unsigned*)(F.lds + MISC_OFF);
    F.G = gridDim.x;
    F.ws = args.ws; F.ctl = (gu32*)(args.ws + WS_CTL); F.out = args.out;
    F.A = &args;
    for (int u = threadIdx.x; u < (XTRA_OFF - LDSCTL_OFF) / 4; u += NWAVES * 64) ((LAS unsigned*)(F.lds + LDSCTL_OFF))[u] = 0u;
    __syncthreads();
    XcdBarrier bar = xcd_barrier_post((unsigned*)(F.ctl + CW_BAR), F.MISC + 8);
    const int lo = args.ph_lo, hi = args.ph_hi;
#define IN(k) (lo <= (k) && (k) < hi)
#define SEAM(k) do { if (IN(k) && IN((k) + 1)) xcd_barrier(bar); } while (0)
    unsigned char* ws = F.ws;
    bf16 *H, *HID; const float *cs64, *cs32, *ada;

    if (EN(0) && IN(0)) p0_prologue(F);
    SEAM(0);
    int ph = 1;
    for (int s = 0; s < 4; ++s) {
        const int l = s >> 1, second = s & 1;
        { unsigned char* w_ = args.ws; asm volatile("" : "+s"(w_)); ws = w_; F.ws = w_; }
        H = (bf16*)(ws + WS_H); HID = (bf16*)(ws + WS_HID); cs64 = (const float*)(ws + WS_CS64); cs32 = (const float*)(ws + WS_CS32); ada = (const float*)(ws + WS_ADA);
        const unsigned char* wl = ws + WS_WTS + (size_t)l * WTS_LAYER;
        const float* adal = ada + (size_t)l * 8 * 9216;
        const float* xsrc = (s == 0) ? args.in[I_X] : F.out;
        if (EN(1) && IN(ph)) norm_mod_phase(F, xsrc, args.in[second ? I_F2N : I_F1N] + l * D, adal + (second ? 6 : 0) * 1024, adal + (second ? 7 : 1) * 1024, H);
        SEAM(ph); ++ph;
        if (EN(2) && IN(ph)) {
            pg8::Gemm g{H, (const bf16*)(wl + (second ? WO_GU2 : WO_GU1)), M, NGU, D}; pg8::StaticOrder S; S.init(M, NGU, F.G, (int)blockIdx.x);
            pg8::EpiSwiGLU E{HID, FF};
            pg8::gemm_phase<pg8::EpiSwiGLU, pg8::StaticOrder, true, true>(F.lds + RING_OFF, g, S, E);
        }
        SEAM(ph); ++ph;
        if (EN(3) && IN(ph)) {
            pg8::Gemm g{HID, (const bf16*)(wl + (second ? WO_D2 : WO_D1)), M, D, FF}; pg8::StaticOrder S; S.init(M, D, F.G, (int)blockIdx.x);
            pg8::EpiResid E{xsrc, F.out, adal + (second ? 8 : 2) * 1024, 0.5f};
            pg8::gemm_phase<pg8::EpiResid, pg8::StaticOrder, true, true>(F.lds + RING_OFF, g, S, E);
        }
        SEAM(ph); ++ph;
        if (second) continue;
        if (EN(4) && IN(ph)) norm_mod_phase(F, F.out, args.in[I_MIXN] + l * D, adal + 3 * 1024, adal + 4 * 1024, H);
        SEAM(ph); ++ph;
        if (EN(5) && IN(ph)) {
            pg8::Gemm g{H, (const bf16*)(wl + WO_IN), M, NINP, D}; pg8::StaticOrder S; S.init(M, NINP, F.G, (int)blockIdx.x);
            pg8::EpiProj<WinDesc> E{WinDesc{ws}, cs64, cs32, nullptr};
            pg8::gemm_phase<pg8::EpiProj<WinDesc>, pg8::StaticOrder, true, true>(F.lds + RING_OFF, g, S, E);
        }
        SEAM(ph); ++ph;
        if (EN(6) && IN(ph)) m1_phase(F, l);
        SEAM(ph); ++ph;
        if (IN(ph)) {
            if (EN(7)) { int kq = 256; asm volatile("" : "+s"(kq)); pg8::Gemm g{(const bf16*)(ws + WS_CQ), (const bf16*)(wl + WO_UQ), M, 512, kq}; pg8::StaticOrder S; S.init(M, 512, F.G, (int)blockIdx.x);
              pg8::EpiProj<MlaQDesc> E{MlaQDesc{ws}, cs64, cs32, (const float*)(ws + WS_RSTDQ)};
              pg8::gemm_phase<pg8::EpiProj<MlaQDesc>, pg8::StaticOrder, true, true>(F.lds + RING_OFF, g, S, E); }
            if (EN(8)) { int kq = 128; asm volatile("" : "+s"(kq)); pg8::Gemm g{(const bf16*)(ws + WS_CKV), (const bf16*)(wl + WO_UKV), M, 512, kq}; pg8::StaticOrder S; S.init(M, 512, F.G, (int)blockIdx.x);
              pg8::EpiProj<MlaKvDesc> E{MlaKvDesc{ws}, cs64, cs32, (const float*)(ws + WS_RSTDKV)};
              pg8::gemm_phase<pg8::EpiProj<MlaKvDesc>, pg8::StaticOrder, true, true>(F.lds + RING_OFF, g, S, E); }
            if (EN(9)) cmp2_phase(F, l);
            if (EN(10)) dsa_tokens_phase(F);
        }
        SEAM(ph); ++ph;
        if (IN(ph)) { if (EN(11)) moba_rows_phase(F); if (EN(12)) mla_rows_phase(F); if (EN(13)) nsa_tokens_phase(F); }
        SEAM(ph); ++ph;
        if (EN(14) && IN(ph)) group_norm_phase(F, H, args.in[I_GN] + l * 1024);
        SEAM(ph); ++ph;
        if (EN(15) && IN(ph)) {
            pg8::Gemm g{H, (const bf16*)(wl + WO_OUT), M, D, D}; pg8::StaticOrder S; S.init(M, D, F.G, (int)blockIdx.x);
            pg8::EpiResid E{F.out, F.out, adal + 5 * 1024, 1.0f};
            pg8::gemm_phase<pg8::EpiResid, pg8::StaticOrder, true, true>(F.lds + RING_OFF, g, S, E);
        }
        SEAM(ph); ++ph;
    }
    if (EN(16) && IN(ph)) final_norm_phase(F, F.out, args.in[I_FINN]);
#undef IN
#undef SEAM
}
constexpr int N_PHASES = 1 + 4 * 3 + 2 * 7 + 1;

extern "C" void kernel_launch(void* const* d_in, const int* in_sizes, int n_in, void* d_out, int out_size, void* d_ws, size_t ws_size, hipStream_t stream) {
    static int grid = 0;
    if (grid == 0) {
        if (n_in != 28 || in_sizes[0] != M * D || out_size != M * D || ws_size < WS_END) { fprintf(stderr, "kernel_launch: unexpected problem shape (n_in %d, in0 %d, out %d, ws %zu); nothing launched\n", n_in, n_in > 0 ? in_sizes[0] : -1, out_size, ws_size); grid = -1; return; }
        int dev = 0, cus = 0, per_cu = 0;
        if (hipGetDevice(&dev) != hipSuccess || hipDeviceGetAttribute(&cus, hipDeviceAttributeMultiprocessorCount, dev) != hipSuccess) { grid = -1; return; }
        if (hipFuncSetAttribute((const void*)fwd_kernel, hipFuncAttributeMaxDynamicSharedMemorySize, LDS_BYTES) != hipSuccess) { fprintf(stderr, "kernel_launch: hipFuncSetAttribute failed\n"); grid = -1; return; }
        if (hipOccupancyMaxActiveBlocksPerMultiprocessor(&per_cu, (const void*)fwd_kernel, NWAVES * 64, LDS_BYTES) != hipSuccess || per_cu < 1) { fprintf(stderr, "kernel_launch: occupancy query says %d\n", per_cu); }
        (void)hipGetLastError();
        grid = cus;
    }
    if (grid < 0) return;
    if (hipMemsetAsync((char*)d_ws + WS_CTL, 0, CTL_ZERO_BYTES, stream) != hipSuccess) return;
    Args a{};
    for (int i = 0; i < 28; ++i) a.in[i] = (const float*)d_in[i];
    a.out = (float*)d_out; a.ws = (unsigned char*)d_ws; a.ph_lo = 0; a.ph_hi = N_PHASES;
    hipLaunchKernelGGL(fwd_kernel, dim3(grid), dim3(NWAVES * 64), LDS_BYTES, stream, a);
}
```

```cpp
#include <hip/hip_runtime.h>
#include <cstdio>
#include <cstdint>
#include <cmath>
#ifndef NO_FLASH
#define FLASH_MLA 1
#define FLASH_MOBA 1
#define FLASH_NSA 1
#define FLASH_DSA 1
#endif
namespace pg8 {
#define PG8_LAS __attribute__((address_space(3)))
typedef unsigned short bf16_t;
typedef short bf16x8 __attribute__((ext_vector_type(8)));
typedef float f32x4 __attribute__((ext_vector_type(4)));
typedef unsigned u32x4 __attribute__((ext_vector_type(4)));
constexpr int BM = 256, BK = 64, HALF = 128, HTB = HALF * BK * 2  , STAGE_BYTES = 8 * HTB, NXCD = 8, WGM = 8;

__host__ __device__ __forceinline__ int lds_byte(int r, int c) { const int st = (r >> 4) * 2 + (c >> 5), rr = r & 15, cc = c & 31, ob = rr * 64 + cc * 2; return st * 1024 + (ob ^ (((ob >> 9) & 1) << 5)); }
__host__ __device__ __forceinline__ void stage_rc(int b, int& R, int& C) { const int st = b / 1024, sb = b % 1024, swz = sb ^ (((sb >> 9) & 1) << 5); R = (st >> 1) * 16 + swz / 64; C = (st & 1) * 32 + (swz % 64) / 2; }
__host__ __device__ __forceinline__ int perm32(int rho) { const int n = rho >> 4, i = rho & 15; return 8 * (i >> 2) + 4 * n + (i & 3); }

struct Unit { int pm, pn; };
struct Gemm { const bf16_t* A; const bf16_t* Bt; int M, N, K; int lda = 0; };

struct StaticOrder {
    int nM, nN, nwg, G, c;
    __host__ __device__ void init(int M, int N, int G_, int c_) { nM = M / BM; nN = N / BM; nwg = nM * nN; G = G_; c = c_; }
    __host__ __device__ bool next(int i, Unit& u) const {
        const long L = (long)i * G + c; if (L >= nwg) return false;
        int wgid = (int)L; { const int q = nwg / NXCD, r = nwg % NXCD, xcd = wgid % NXCD, off = wgid / NXCD; wgid = (xcd < r ? xcd * (q + 1) : r * (q + 1) + (xcd - r) * q) + off; }
        const int nig = WGM * nN, gid = wgid / nig, fm = gid * WGM, gsz = (nM - fm) < WGM ? (nM - fm) : WGM;
        u.pm = fm + ((wgid % nig) % gsz); u.pn = (wgid % nig) / gsz; return true;
    }
    __device__ __forceinline__ void a_ready(const Unit&) const {}
    __device__ __forceinline__ void done(const Unit&) const {}
};

__device__ __forceinline__ unsigned cvt_pk_bf16(float lo, float hi) { unsigned r; asm volatile("v_cvt_pk_bf16_f32 %0, %1, %2" : "=v"(r) : "v"(lo), "v"(hi)); return r; }
typedef float f32x2 __attribute__((ext_vector_type(2)));
typedef unsigned u32x2 __attribute__((ext_vector_type(2)));
__device__ __forceinline__ float silu_f(float x) { return x * __builtin_amdgcn_rcpf(1.0f + __builtin_amdgcn_exp2f(-1.4426950408889634f * x)); }

struct EpiSwiGLU {
    static constexpr bool PERM = false, AFTER_DRAIN = false;
    bf16_t* H; int ldh;
    __device__ __forceinline__ void operator()(const f32x4 (&acc)[2][2][4][2], const Unit& u, int wr, int wc, int fr, int fq) const {
        const int row0 = u.pm * BM + wr * 64 + fr;
        const int hc0 = u.pn * 128 + wc * 16 + 4 * fq;
#pragma unroll
        for (int ai = 0; ai < 2; ++ai)
#pragma unroll
            for (int m = 0; m < 4; ++m) {
                bf16_t* rowp = H + (size_t)(row0 + ai * HALF + m * 16) * ldh + hc0;
#pragma unroll
                for (int bj = 0; bj < 2; ++bj) {
                    const f32x4 g = acc[ai][bj][m][0], uu = acc[ai][bj][m][1];
                    u32x2 w; w.x = cvt_pk_bf16(silu_f(g[0]) * uu[0], silu_f(g[1]) * uu[1]); w.y = cvt_pk_bf16(silu_f(g[2]) * uu[2], silu_f(g[3]) * uu[3]);
                    *(u32x2*)(rowp + bj * 64) = w;
                }
            }
    }
};

struct EpiResid {
    static constexpr bool PERM = false, AFTER_DRAIN = false;
    const float* xin; float* xout; const float* gate; float coef;
    __device__ __forceinline__ void operator()(const f32x4 (&acc)[2][2][4][2], const Unit& u, int wr, int wc, int fr, int fq) const {
        const int b = (u.pm * BM) >> 12;
        const float* gv = gate + (size_t)b * 9216;
        const int row0 = u.pm * BM + wr * 64 + fr, col0 = u.pn * BM + wc * 32 + 4 * fq;
        f32x4 g[2][2];
#pragma unroll
        for (int bj = 0; bj < 2; ++bj)
#pragma unroll
            for (int n = 0; n < 2; ++n) g[bj][n] = *(const f32x4*)(gv + col0 + bj * HALF + n * 16) * coef;
#pragma unroll
        for (int ai = 0; ai < 2; ++ai)
#pragma unroll
            for (int m = 0; m < 4; ++m) {
                const size_t off = (size_t)(row0 + ai * HALF + m * 16) * 1024 + col0;
#pragma unroll
                for (int bj = 0; bj < 2; ++bj)
#pragma unroll
                    for (int n = 0; n < 2; ++n) { const f32x4 xi = *(const f32x4*)(xin + off + bj * HALF + n * 16); *(f32x4*)(xout + off + bj * HALF + n * 16) = xi + g[bj][n] * acc[ai][bj][m][n]; }
                if (m & 1) asm volatile("" ::: "memory");
            }
    }
};

struct ProjDesc { int kind, dfreq0, nstride, rep, repstride, bpitch, fpitch, pad; bf16_t* bp; float* fp; };
template <class DescFn> struct EpiProj {
    static constexpr bool PERM = false, AFTER_DRAIN = false;
    DescFn df; const float* cs64; const float* cs32; const float* rowscale;
    __device__ __forceinline__ void operator()(const f32x4 (&acc)[2][2][4][2], const Unit& u, int wr, int wc, int fr, int fq) const {
        const int row0 = u.pm * BM + wr * 64 + fr;
#pragma unroll
        for (int bj = 0; bj < 2; ++bj) {
            const int G = u.pn * 8 + bj * 4 + wc;
            const ProjDesc d = df(G);
            if (d.kind != 0) {
#pragma unroll
                for (int ai = 0; ai < 2; ++ai)
#pragma unroll
                    for (int m = 0; m < 4; ++m) {
                        const int row = row0 + ai * HALF + m * 16;
                        f32x4 v0 = acc[ai][bj][m][0], v1 = acc[ai][bj][m][1];
                        if (rowscale) { const float rs = rowscale[row]; v0 = v0 * rs; v1 = v1 * rs; }
                        if (d.kind >= 2) {
                            const int pos = row & 4095;
                            const float* cs = (d.kind == 2) ? cs64 + ((size_t)pos * 32 + d.dfreq0 + 4 * fq) * 2 : cs32 + ((size_t)pos * 16 + 4 * fq) * 2;
                            const f32x4 a = *(const f32x4*)cs, b2 = *(const f32x4*)(cs + 4);
                            const f32x4 c = {a[0], a[2], b2[0], b2[2]}, s = {a[1], a[3], b2[1], b2[3]};
                            const f32x4 o0 = v0 * c - v1 * s, o1 = v1 * c + v0 * s; v0 = o0; v1 = o1;
                        }
                        if (d.bp) {
                            u32x2 w0, w1; w0.x = cvt_pk_bf16(v0[0], v0[1]); w0.y = cvt_pk_bf16(v0[2], v0[3]); w1.x = cvt_pk_bf16(v1[0], v1[1]); w1.y = cvt_pk_bf16(v1[2], v1[3]);
                            bf16_t* p = d.bp + (size_t)row * d.bpitch + 4 * fq;
                            for (int rp = 0; rp < d.rep; ++rp) { *(u32x2*)(p + rp * d.repstride) = w0; *(u32x2*)(p + rp * d.repstride + d.nstride) = w1; }
                        }
                        if (d.fp) { float* p = d.fp + (size_t)row * d.fpitch + 4 * fq;
                            if (d.pad) {
                                typedef unsigned u32x4v __attribute__((ext_vector_type(4)));
                                u32x4v w0, w1;
#pragma unroll
                                for (int q = 0; q < 2; ++q) { const f32x4 v = q ? v1 : v0;
                                    const unsigned h01 = cvt_pk_bf16(v[0], v[1]), h23 = cvt_pk_bf16(v[2], v[3]);
                                    const unsigned l01 = cvt_pk_bf16(v[0] - __uint_as_float(h01 << 16), v[1] - __uint_as_float(h01 & 0xffff0000u)), l23 = cvt_pk_bf16(v[2] - __uint_as_float(h23 << 16), v[3] - __uint_as_float(h23 & 0xffff0000u));
                                    u32x4v w; w.x = (h01 & 0xffffu) | (l01 << 16); w.y = (h01 >> 16) | (l01 & 0xffff0000u); w.z = (h23 & 0xffffu) | (l23 << 16); w.w = (h23 >> 16) | (l23 & 0xffff0000u);
                                    if (q) w1 = w; else w0 = w; }
                                *(u32x4v*)p = w0; *(u32x4v*)(p + d.nstride) = w1;
                            } else { *(f32x4*)p = v0; *(f32x4*)(p + d.nstride) = v1; } }
                        asm volatile("" ::: "memory");
                    }
            }
        }
    }
};


struct EpiCmpH {
    static constexpr bool PERM = false, AFTER_DRAIN = false;
    float* out; const float* bias;
    __device__ __forceinline__ void operator()(const f32x4 (&acc)[2][2][4][2], const Unit& u, int wr, int wc, int fr, int fq) const {
        const int row0 = u.pm * BM + wr * 64 + fr, col0 = wc * 32 + 4 * fq;
        f32x4 bv[2][2];
#pragma unroll
        for (int bj = 0; bj < 2; ++bj)
#pragma unroll
            for (int n = 0; n < 2; ++n) bv[bj][n] = *(const f32x4*)(bias + col0 + bj * HALF + n * 16);
#pragma unroll
        for (int ai = 0; ai < 2; ++ai)
#pragma unroll
            for (int m = 0; m < 4; ++m) {
                float* rowp = out + (size_t)(row0 + ai * HALF + m * 16) * 256 + col0;
#pragma unroll
                for (int bj = 0; bj < 2; ++bj)
#pragma unroll
                    for (int n = 0; n < 2; ++n) { const f32x4 v = acc[ai][bj][m][n] + bv[bj][n];
                        f32x4 o; o[0] = silu_f(v[0]); o[1] = silu_f(v[1]); o[2] = silu_f(v[2]); o[3] = silu_f(v[3]); *(f32x4*)(rowp + bj * HALF + n * 16) = o; }
            }
    }
};
struct RangeOrder {
    int nM, c0;
    __device__ __forceinline__ bool next(int i, Unit& u) const { const int idx = (int)blockIdx.x - c0; if (i > 0 || idx < 0 || idx >= nM) return false; u.pm = idx; u.pn = 0; return true; }
    __device__ __forceinline__ void a_ready(const Unit&) const {}
    __device__ __forceinline__ void done(const Unit&) const {}
};
template <class Epi, class Sched, bool ALIGN_EPI = false, bool SP2 = false>
__device__ __forceinline__ void gemm_phase(PG8_LAS unsigned char* lds, const Gemm g, const Sched& S, const Epi& E) {
    int tid_ = threadIdx.x; asm volatile("" : "+v"(tid_));
    const int tid = tid_, wid = __builtin_amdgcn_readfirstlane(tid >> 6), lane = tid & 63, wr = wid >> 2, wc = wid & 3, fr = lane & 15, fq = lane >> 4;
    const int K = g.K, nt = K / BK, lda = g.lda ? g.lda : g.K;
    unsigned voffA[2], voffB[2];
#pragma unroll
    for (int i = 0; i < 2; ++i) { int R, C; stage_rc(tid * 16 + i * 8192, R, C); const int Rb = Epi::PERM ? ((R & ~31) + perm32(R & 31)) : R;
        voffA[i] = (unsigned)(R * lda + C) * 2u; voffB[i] = (unsigned)(Rb * K + C) * 2u; }
    const size_t kstep = (size_t)(BK * 2);
    const size_t hstepB = (size_t)HALF * K * 2, hstepA = (size_t)HALF * lda * 2;
    const size_t tstepB = 2 * hstepB, tstepA = 2 * hstepA;
    const unsigned ldsw = (unsigned)wid * 1024u;
    const int aoff = lds_byte(wr * 64 + fr, fq * 8), boff = lds_byte(wc * 32 + fr, fq * 8);
#define PG8_SA(b, h) (((b) * 2 + (h)) * HTB)
#define PG8_SB(b, h) ((4 + (b) * 2 + (h)) * HTB)
#define PG8_STAGE(bufoff, gbase, voff) do { _Pragma("unroll") for (int _i = 0; _i < 2; ++_i) \
        __builtin_amdgcn_global_load_lds((const unsigned*)((const char*)(gbase) + (voff)[_i]), (PG8_LAS unsigned*)(lds + (bufoff) + ldsw + _i * 8192), 16, 0, 0); } while (0)
#define PG8_LDA(dst, b, h) do { _Pragma("unroll") for (int m = 0; m < 4; ++m) _Pragma("unroll") for (int k = 0; k < 2; ++k) dst[m][k] = *(const PG8_LAS bf16x8*)(lds + PG8_SA(b, h) + aoff + m * 2048 + k * 1024); } while (0)
#define PG8_LDB(dst, b, h) do { _Pragma("unroll") for (int n = 0; n < 2; ++n) _Pragma("unroll") for (int k = 0; k < 2; ++k) dst[n][k] = *(const PG8_LAS bf16x8*)(lds + PG8_SB(b, h) + boff + n * 2048 + k * 1024); } while (0)
#define PG8_MMA(ai, bj, At, Bt) do { __builtin_amdgcn_s_setprio(1); _Pragma("unroll") for (int m = 0; m < 4; ++m) _Pragma("unroll") for (int n = 0; n < 2; ++n) _Pragma("unroll") for (int k = 0; k < 2; ++k) \
        acc[ai][bj][m][n] = __builtin_amdgcn_mfma_f32_16x16x32_bf16(Bt[n][k], At[m][k], acc[ai][bj][m][n], 0, 0, 0); __builtin_amdgcn_s_setprio(0); } while (0)
#define PG8_WAIT_V(n) asm volatile("s_waitcnt vmcnt(" #n ")" ::: "memory")
#define PG8_WAIT_L(n) asm volatile("s_waitcnt lgkmcnt(" #n ")" ::: "memory")
#define PG8_BAR __builtin_amdgcn_s_barrier()
#define PG8_SCHED __builtin_amdgcn_sched_barrier(0)
    Unit cur, nxt; int ui = 0;
    if (!S.next(0, cur)) return;
    f32x4 acc[2][2][4][2];
#pragma unroll
    for (int a = 0; a < 2; ++a)
#pragma unroll
        for (int b = 0; b < 2; ++b)
#pragma unroll
            for (int m = 0; m < 4; ++m)
#pragma unroll
                for (int n = 0; n < 2; ++n) acc[a][b][m][n] = (f32x4){0.f, 0.f, 0.f, 0.f};
    bf16x8 At[4][2], B0[2][2], B1[2][2];
    const char* cA = (const char*)g.A + (size_t)cur.pm * tstepA; const char* cB = (const char*)g.Bt + (size_t)cur.pn * tstepB;
    S.a_ready(cur);
    if constexpr (SP2) {
        PG8_STAGE(PG8_SB(0, 0), cB, voffB); PG8_STAGE(PG8_SB(0, 1), cB + hstepB, voffB); PG8_STAGE(PG8_SA(0, 0), cA, voffA); PG8_STAGE(PG8_SA(0, 1), cA + hstepA, voffA);
        if (wr == 1) PG8_BAR;
        PG8_WAIT_V(2); PG8_BAR;
        PG8_STAGE(PG8_SB(1, 0), cB + kstep, voffB); PG8_STAGE(PG8_SA(1, 0), cA + kstep, voffA); PG8_STAGE(PG8_SB(1, 1), cB + hstepB + kstep, voffB);
        PG8_WAIT_V(6); PG8_BAR;
    } else {
        PG8_STAGE(PG8_SB(0, 0), cB, voffB); PG8_STAGE(PG8_SA(0, 0), cA, voffA); PG8_STAGE(PG8_SB(0, 1), cB + hstepB, voffB); PG8_STAGE(PG8_SA(0, 1), cA + hstepA, voffA);
        if (wr == 1) PG8_BAR;
        PG8_WAIT_V(4); PG8_BAR;
        PG8_STAGE(PG8_SB(1, 0), cB + kstep, voffB); PG8_STAGE(PG8_SA(1, 0), cA + kstep, voffA); PG8_STAGE(PG8_SB(1, 1), cB + hstepB + kstep, voffB);
        PG8_WAIT_V(6); PG8_BAR;
    }
    for (;;) {
        const bool has_next = S.next(ui + 1, nxt);
        const char* nA = has_next ? (const char*)g.A + (size_t)nxt.pm * tstepA : cA; const char* nB = has_next ? (const char*)g.Bt + (size_t)nxt.pn * tstepB : cB;
        for (int t = 0; t < nt; t += 2) {
            const bool last = (t == nt - 2);
            const char* a1 = cA + (size_t)(t + 1) * kstep;
            const char* a2 = last ? nA : cA + (size_t)(t + 2) * kstep; const char* b2 = last ? nB : cB + (size_t)(t + 2) * kstep;
            const char* a3 = a2 + kstep; const char* b3 = b2 + kstep;
            if (last && has_next) S.a_ready(nxt);
            if constexpr (SP2) {
            PG8_LDB(B0, 0, 0); PG8_LDB(B1, 0, 1); PG8_SCHED; PG8_LDA(At, 0, 0); PG8_STAGE(PG8_SA(1, 1), a1 + hstepA, voffA);
            PG8_WAIT_V(8); PG8_WAIT_L(0); PG8_BAR; PG8_MMA(0, 0, At, B0); PG8_MMA(0, 1, At, B1); PG8_BAR; PG8_SCHED;
            PG8_LDA(At, 0, 1); PG8_STAGE(PG8_SB(0, 0), b2, voffB); PG8_STAGE(PG8_SB(0, 1), b2 + hstepB, voffB); PG8_STAGE(PG8_SA(0, 0), a2, voffA);
            PG8_WAIT_V(8); PG8_WAIT_L(0); PG8_BAR; PG8_MMA(1, 0, At, B0); PG8_MMA(1, 1, At, B1); PG8_BAR; PG8_SCHED;
            PG8_LDB(B0, 1, 0); PG8_LDB(B1, 1, 1); PG8_SCHED; PG8_LDA(At, 1, 0); PG8_STAGE(PG8_SA(0, 1), a2 + hstepA, voffA);
            PG8_WAIT_V(8); PG8_WAIT_L(0); PG8_BAR; PG8_MMA(0, 0, At, B0); PG8_MMA(0, 1, At, B1); PG8_BAR; PG8_SCHED;
            PG8_LDA(At, 1, 1); PG8_STAGE(PG8_SB(1, 0), b3, voffB); PG8_STAGE(PG8_SB(1, 1), b3 + hstepB, voffB); PG8_STAGE(PG8_SA(1, 0), a3, voffA);
            PG8_WAIT_V(8); PG8_WAIT_L(0); PG8_BAR; PG8_MMA(1, 0, At, B0); PG8_MMA(1, 1, At, B1); PG8_BAR; PG8_SCHED;
            } else {
            PG8_LDB(B0, 0, 0); PG8_SCHED; PG8_LDA(At, 0, 0); PG8_STAGE(PG8_SA(1, 1), a1 + hstepA, voffA);
            PG8_WAIT_L(8); PG8_BAR; PG8_WAIT_L(0); PG8_MMA(0, 0, At, B0); PG8_BAR; PG8_SCHED;
            PG8_LDB(B1, 0, 1); PG8_STAGE(PG8_SB(0, 0), b2, voffB);
            PG8_BAR; PG8_WAIT_L(0); PG8_MMA(0, 1, At, B1); PG8_BAR;
            PG8_LDA(At, 0, 1); PG8_STAGE(PG8_SA(0, 0), a2, voffA);
            PG8_BAR; PG8_WAIT_L(0); PG8_MMA(1, 0, At, B0); PG8_BAR; PG8_SCHED;
            PG8_STAGE(PG8_SB(0, 1), b2 + hstepB, voffB);
            PG8_WAIT_V(6); PG8_BAR; PG8_MMA(1, 1, At, B1); PG8_BAR;
            PG8_LDB(B0, 1, 0); PG8_SCHED; PG8_LDA(At, 1, 0); PG8_STAGE(PG8_SA(0, 1), a2 + hstepA, voffA);
            PG8_WAIT_L(8); PG8_BAR; PG8_WAIT_L(0); PG8_MMA(0, 0, At, B0); PG8_BAR; PG8_SCHED;
            PG8_LDB(B1, 1, 1); PG8_STAGE(PG8_SB(1, 0), b3, voffB);
            PG8_BAR; PG8_WAIT_L(0); PG8_MMA(0, 1, At, B1); PG8_BAR;
            PG8_LDA(At, 1, 1); PG8_STAGE(PG8_SA(1, 0), a3, voffA);
            PG8_BAR; PG8_WAIT_L(0); PG8_MMA(1, 0, At, B0); PG8_BAR; PG8_SCHED;
            PG8_STAGE(PG8_SB(1, 1), b3 + hstepB, voffB);
            PG8_WAIT_V(6); PG8_BAR; PG8_MMA(1, 1, At, B1); PG8_BAR;
            }
        }
        if constexpr (ALIGN_EPI) { if (wr == 0) PG8_BAR; }
        if constexpr (!Epi::AFTER_DRAIN) { E(acc, cur, wr, wc, fr, fq); S.done(cur); }
        if (!has_next) break;
#pragma unroll
        for (int a = 0; a < 2; ++a)
#pragma unroll
            for (int b = 0; b < 2; ++b)
#pragma unroll
                for (int m = 0; m < 4; ++m)
#pragma unroll
                    for (int n = 0; n < 2; ++n) acc[a][b][m][n] = (f32x4){0.f, 0.f, 0.f, 0.f};
        cur = nxt; cA = nA; cB = nB; ++ui;
        if constexpr (ALIGN_EPI) { if (wr == 1) PG8_BAR; }
    }
    PG8_WAIT_V(0);
    if constexpr (!ALIGN_EPI) { if (wr == 0) PG8_BAR; }
    PG8_BAR;
    if constexpr (Epi::AFTER_DRAIN) { E.fused(acc, cur, wr, wc, fr, fq, lds, wid, lane); S.done(cur); }
#undef PG8_SA
#undef PG8_SB
#undef PG8_STAGE
#undef PG8_LDA
#undef PG8_LDB
#undef PG8_MMA
#undef PG8_WAIT_V
#undef PG8_WAIT_L
#undef PG8_BAR
#undef PG8_SCHED
}
}
#define GAS __attribute__((address_space(1)))
#define LAS __attribute__((address_space(3)))
typedef unsigned short bf16;
typedef unsigned v4u __attribute__((ext_vector_type(4)));
typedef float f32x4 __attribute__((ext_vector_type(4)));
typedef short bf16x8 __attribute__((ext_vector_type(8)));
typedef GAS unsigned gu32;
typedef GAS unsigned long long gu64;
#define RLX_AGENT __ATOMIC_RELAXED, __HIP_MEMORY_SCOPE_AGENT
#define LDS_WAIT() asm volatile("s_waitcnt lgkmcnt(0)" ::: "memory")
#define VM_WAIT() asm volatile("s_waitcnt vmcnt(0)" ::: "memory")
__device__ __forceinline__ unsigned long long rt() { return __builtin_amdgcn_s_memrealtime(); }
__device__ __forceinline__ unsigned f2bf(float f) { unsigned u = __builtin_bit_cast(unsigned, f); return (u + 0x7fffu + ((u >> 16) & 1u)) >> 16; }
__device__ __forceinline__ unsigned pk2(float lo, float hi) { return f2bf(lo) | (f2bf(hi) << 16); }

#define XB_TMO      128
#define XB_XCNT(j)  (256  + 64 * (j))
#define XB_XSUB(j)  (1280 + 64 * (j))
#define XB_XGEN(j)  (2304 + 64 * (j))
#define XB_TOP      3328
#define XB_TOPGEN   3392
#define XCD_BAR_WORDS 3456
#define XB_SPIN_CAP (1u << 24)

__device__ __forceinline__ unsigned xb_ld(unsigned* p)              { return __hip_atomic_load(p, __ATOMIC_RELAXED, __HIP_MEMORY_SCOPE_AGENT); }
__device__ __forceinline__ unsigned xb_add(unsigned* p, unsigned v) { return __hip_atomic_fetch_add(p, v, __ATOMIC_RELAXED, __HIP_MEMORY_SCOPE_AGENT); }
__device__ __forceinline__ unsigned xb_xcc_id() { return (unsigned)__builtin_amdgcn_s_getreg((3 << 11) | 20) & 0xFu; }
#define XB_SPIN(cond, bar) do { unsigned _sp = 0; while (cond) { __builtin_amdgcn_s_sleep(1); \
    if ((++_sp & 255u) == 0u) { if (xb_ld(&(bar)[XB_TMO])) break; if (_sp > XB_SPIN_CAP) { atomicAdd(&(bar)[XB_TMO], 1u); break; } } } } while (0)

struct XcdBarrier {
    unsigned* bar; unsigned x;
    volatile LAS unsigned* st;
};

__device__ __forceinline__ XcdBarrier xcd_barrier_post(unsigned* bar, volatile LAS unsigned* st) {
    XcdBarrier b; b.bar = bar; b.x = xb_xcc_id(); b.st = st;
    if (threadIdx.x == 0) (void)xb_add(&bar[XB_XCNT(b.x)], 1u);
    return b;
}
__device__ __forceinline__ void xcd_barrier_complete(unsigned* bar, unsigned x, unsigned& nloc, unsigned& nx) {
    const unsigned G = gridDim.x * gridDim.y * gridDim.z;
    unsigned sum, cnt, mine, sp = 0u;
    for (;;) {
        sum = 0u; cnt = 0u; mine = 0u;
#pragma unroll
        for (unsigned j = 0; j < 16; ++j) { const unsigned c = xb_ld(&bar[XB_XCNT(j)]); sum += c; cnt += (c > 0u) ? 1u : 0u; mine = (j == x) ? c : mine; }
        if (sum == G) break;
        __builtin_amdgcn_s_sleep(1);
        if ((++sp & 255u) == 0u) { if (xb_ld(&bar[XB_TMO])) break; if (sp > XB_SPIN_CAP) { atomicAdd(&bar[XB_TMO], 1u); break; } }
    }
    nloc = mine > 0u ? mine : 1u; nx = cnt > 0u ? cnt : 1u;
}

__device__ __forceinline__ void xcd_barrier(const XcdBarrier& b) {
    asm volatile("s_waitcnt vmcnt(0)" ::: "memory");
    __syncthreads();
    if (threadIdx.x == 0) {
        unsigned* bar = b.bar; asm volatile("" : "+s"(bar));
        __builtin_amdgcn_s_waitcnt(0);
        unsigned nloc = b.st[0], nx = b.st[1];
        if (nloc == 0u) { xcd_barrier_complete(bar, b.x, nloc, nx); b.st[0] = nloc; b.st[1] = nx; }
        const unsigned old = xb_add(&bar[XB_XSUB(b.x)], 1u);
        const unsigned gen = old / nloc;
        if (old + 1u == (gen + 1u) * nloc) {
            __builtin_amdgcn_fence(__ATOMIC_RELEASE, "agent");
            asm volatile("s_waitcnt vmcnt(0)" ::: "memory");
            const unsigned og = xb_add(&bar[XB_TOP], 1u);
            const unsigned tg = og / nx;
            if (og + 1u == (tg + 1u) * nx) xb_add(&bar[XB_TOPGEN], 1u);
            else XB_SPIN(xb_ld(&bar[XB_TOPGEN]) == tg, bar);
            __builtin_amdgcn_fence(__ATOMIC_ACQUIRE, "agent");
            xb_add(&bar[XB_XGEN(b.x)], 1u);
            asm volatile("s_waitcnt vmcnt(0)" ::: "memory");
        } else {
            XB_SPIN(xb_ld(&bar[XB_XGEN(b.x)]) == gen, bar);
            __builtin_amdgcn_fence(__ATOMIC_ACQUIRE, "agent");
            asm volatile("s_waitcnt vmcnt(0)" ::: "memory");
        }
    }
    __syncthreads();
}
constexpr int NWAVES = 8;
constexpr int BATCH = 8, T = 4096, D = 1024, M = BATCH * T, FF = 2816, NGU = 2 * FF, NINP = 2560, NIN_SRC = 2516, NL = 2;
constexpr float RMS_EPS = 1e-6f;
constexpr size_t MiB = 1u << 20;
constexpr size_t WS_CTL = 0, CTL_ZERO_BYTES = 1 * MiB;
constexpr size_t WS_CS64 = 1 * MiB;
constexpr size_t WS_CS32 = 2 * MiB;
constexpr size_t WS_ADA = 2 * MiB + 512 * 1024;
constexpr size_t WS_CMPB = 3 * MiB + 128 * 1024;
constexpr size_t WS_KMEAN = 3 * MiB + 256 * 1024;
constexpr size_t WS_RSTDQ = 3 * MiB + 512 * 1024;
constexpr size_t WS_RSTDKV = 3 * MiB + 768 * 1024;
constexpr size_t WS_KCMP = 4 * MiB;
constexpr size_t WS_VCMP = 4 * MiB + 512 * 1024;
constexpr size_t WS_CMPH = 5 * MiB;
constexpr size_t WS_WTS = 10 * MiB, WTS_LAYER = 46 * MiB;
constexpr size_t WO_GU1 = 0, WO_D1 = 11 * MiB, WO_GU2 = 17 * MiB, WO_D2 = 28 * MiB, WO_IN = 34 * MiB, WO_OUT = 39 * MiB, WO_UQ = 41 * MiB, WO_UKV = 41 * MiB + 512 * 1024, WO_C1K = 42 * MiB, WO_C1V = 43 * MiB;
constexpr size_t WS_H = 104 * MiB;
constexpr size_t WS_BIG = 168 * MiB;
constexpr size_t WS_HID = WS_BIG;
constexpr size_t WS_QM_BF = 168 * MiB, WS_KM_BF = 184 * MiB, WS_VM_BF = 200 * MiB, WS_QM_F = 216 * MiB, WS_KM_F = 248 * MiB;
constexpr size_t WS_CQ = 280 * MiB, WS_CKV = 296 * MiB;
constexpr size_t WS_QN = 304 * MiB, WS_KC = 320 * MiB, WS_VC = 324 * MiB, WS_KS = 328 * MiB, WS_VS = 332 * MiB, WS_KW = 336 * MiB, WS_VW = 340 * MiB;
constexpr size_t WS_QD = 344 * MiB, WS_KD = 360 * MiB, WS_VD = 364 * MiB, WS_IQ = 368 * MiB, WS_IK = 400 * MiB, WS_GW = 404 * MiB;
constexpr size_t WS_QMLA = 408 * MiB, WS_KMLA = 432 * MiB, WS_VMLA = 456 * MiB;
constexpr size_t WS_DSAMASK = 472 * MiB;
constexpr size_t WS_OC = 488 * MiB;
constexpr size_t WS_KCMPB = 9 * MiB + 256 * 1024, WS_VCMPB = 9 * MiB + 512 * 1024;
constexpr size_t WS_NSEL = 9 * MiB;
constexpr size_t WS_END = 512 * MiB;
constexpr int CW_BAR = 4096;
constexpr int RING_OFF = 0, RING_BYTES = 131072;
constexpr int LDSCTL_OFF = RING_BYTES, MISC_OFF = LDSCTL_OFF + 320;
constexpr int XTRA_OFF = 132096, XTRA_WAVE = 2112;
constexpr int LDS_BYTES = 155648;
static_assert(XTRA_OFF + NWAVES * XTRA_WAVE <= LDS_BYTES && MISC_OFF + 128 <= XTRA_OFF, "LDS map");

struct Args { const float* in[28]; float* out; unsigned char* ws; int ph_lo, ph_hi; };
struct Frame {
    LAS unsigned char* lds;
    volatile LAS unsigned* MISC;
    gu32* ctl;
    unsigned char* ws;
    int G;
    const Args* A;
    float* out;
};
enum { I_X = 0, I_C, I_ADAW, I_ADAB, I_F1N, I_F1G, I_F1U, I_F1D, I_MIXN, I_WIN, I_QNORM, I_WUQ, I_KVNORM, I_WUK, I_WUV, I_PEK, I_PEV, I_CK1, I_CK2, I_CV1, I_CV2, I_GN, I_WOUT, I_F2N, I_F2G, I_F2U, I_F2D, I_FINN };

__device__ __forceinline__ int opaque_v(int v) { asm volatile("" : "+v"(v)); return v; }
__device__ __forceinline__ int cur_tid() { return opaque_v((int)threadIdx.x); }
__device__ __forceinline__ int cur_lane() { return opaque_v((int)threadIdx.x) & 63; }
__device__ __forceinline__ int cur_wave() { return __builtin_amdgcn_readfirstlane(opaque_v((int)threadIdx.x) >> 6); }
template <int CTRL> __device__ __forceinline__ float dpp_f(float v) { return __int_as_float(__builtin_amdgcn_update_dpp(0, __float_as_int(v), CTRL, 0xf, 0xf, false)); }
__device__ __forceinline__ float wave_sum(float v) {
    v += dpp_f<0xB1>(v); v += dpp_f<0x4E>(v); v += dpp_f<0x141>(v); v += dpp_f<0x140>(v);
    const float r0 = __int_as_float(__builtin_amdgcn_readlane(__float_as_int(v), 0)), r1 = __int_as_float(__builtin_amdgcn_readlane(__float_as_int(v), 16));
    const float r2 = __int_as_float(__builtin_amdgcn_readlane(__float_as_int(v), 32)), r3 = __int_as_float(__builtin_amdgcn_readlane(__float_as_int(v), 48));
    return (r0 + r1) + (r2 + r3);
}
__device__ __forceinline__ float wave_max(float v) {
    v = fmaxf(v, dpp_f<0xB1>(v)); v = fmaxf(v, dpp_f<0x4E>(v)); v = fmaxf(v, dpp_f<0x141>(v)); v = fmaxf(v, dpp_f<0x140>(v));
    const float r0 = __int_as_float(__builtin_amdgcn_readlane(__float_as_int(v), 0)), r1 = __int_as_float(__builtin_amdgcn_readlane(__float_as_int(v), 16));
    const float r2 = __int_as_float(__builtin_amdgcn_readlane(__float_as_int(v), 32)), r3 = __int_as_float(__builtin_amdgcn_readlane(__float_as_int(v), 48));
    return fmaxf(fmaxf(r0, r1), fmaxf(r2, r3));
}
__device__ __forceinline__ float bf2f(unsigned short b) { return __uint_as_float((unsigned)b << 16); }
__device__ __forceinline__ void unpack8(const v4u w, float* f) {
    f[0] = __uint_as_float(w.x << 16); f[1] = __uint_as_float(w.x & 0xffff0000u); f[2] = __uint_as_float(w.y << 16); f[3] = __uint_as_float(w.y & 0xffff0000u);
    f[4] = __uint_as_float(w.z << 16); f[5] = __uint_as_float(w.z & 0xffff0000u); f[6] = __uint_as_float(w.w << 16); f[7] = __uint_as_float(w.w & 0xffff0000u);
}
__device__ __forceinline__ float sigmoid_f(float x) { return 1.0f / (1.0f + __expf(-x)); }

__device__ __forceinline__ int perm64(int j) { return 32 * ((j & 31) >> 4) + 16 * (j >> 5) + (j & 15); }
__device__ __forceinline__ int win_src_col(int c) {
    if (c < 512) return (c & ~63) + perm64(c & 63);
    if (c < 1184) return c;
    if (c < 1504) { const int r = c - 1184; return 1184 + (r & ~63) + perm64(r & 63); }
    if (c < 1568) return c;
    if (c < 1632) return 1568 + perm64(c - 1568);
    if (c < 1696) return c;
    if (c < 1760) return 1696 + perm64(c - 1696);
    if (c < 1824) return c;
    if (c < 2144) { const int r = c - 1824; return 1836 + (r & ~63) + perm64(r & 63); }
    if (c < 2208) return 2156 + (c - 2144);
    if (c < 2464) return 2220 + (c - 2208);
    if (c < 2496) return 2476 + (c - 2464);
    if (c < 2508) return 1824 + (c - 2496);
    if (c < 2516) return 2508 + (c - 2508);
    return -1;
}
constexpr int WK_K[8] = {1024, 2816, 1024, 2816, 1024, 1024, 256, 128};
constexpr int WK_N[8] = {5632, 1024, 5632, 1024, 2560, 1024, 512, 512};
__device__ __forceinline__ size_t wk_off(int kind) { return kind == 0 ? WO_GU1 : kind == 1 ? WO_D1 : kind == 2 ? WO_GU2 : kind == 3 ? WO_D2 : kind == 4 ? WO_IN : kind == 5 ? WO_OUT : kind == 6 ? WO_UQ : kind == 7 ? WO_UKV : kind == 8 ? WO_C1K : WO_C1V; }
__device__ __forceinline__ const float* wsrc(const Frame& F, int kind, int l, int R, int& stride) {
    switch (kind) {
    case 0: case 2: { const int G = R >> 5, w = R & 31, j = 16 * G + (w & 15); stride = FF;
        const float* g = F.A->in[kind == 0 ? I_F1G : I_F2G] + (size_t)l * D * FF; const float* u = F.A->in[kind == 0 ? I_F1U : I_F2U] + (size_t)l * D * FF; return ((w >> 4) ? u : g) + j; }
    case 1: case 3: stride = D; return F.A->in[kind == 1 ? I_F1D : I_F2D] + (size_t)l * FF * D + R;
    case 4: { stride = NIN_SRC; const int s = win_src_col(R); return s < 0 ? nullptr : F.A->in[I_WIN] + (size_t)l * D * NIN_SRC + s; }
    case 5: stride = D; return F.A->in[I_WOUT] + (size_t)l * D * D + R;
    case 6: stride = 384; return R < 384 ? F.A->in[I_WUQ] + (size_t)l * 256 * 384 + R : nullptr;
    case 7: stride = 256; return R < 256 ? F.A->in[I_WUK] + (size_t)l * 128 * 256 + R : F.A->in[I_WUV] + (size_t)l * 128 * 256 + (R - 256);
    default: stride = 256; return F.A->in[kind == 8 ? I_CK1 : I_CV1] + (size_t)l * 2048 * 256 + R;
    }
}

struct WinDesc {
    unsigned char* ws;
    __device__ __forceinline__ pg8::ProjDesc operator()(int G) const {
        pg8::ProjDesc d; d.kind = 0; d.dfreq0 = 0; d.nstride = 16; d.rep = 1; d.repstride = 0; d.bpitch = 0; d.fpitch = 0; d.pad = 0; d.bp = nullptr; d.fp = nullptr;
        const int c = 32 * G;
#define ROPE64(rel, BOFF, BP, FOFF, FP) do { const int hh_ = (rel) >> 6, g_ = ((rel) >> 5) & 1; d.kind = 2; d.dfreq0 = 16 * g_; d.nstride = 32; \
            d.bp = (bf16*)(ws + (BOFF)) + hh_ * 64 + 16 * g_; d.bpitch = (BP); if (FP) { d.fp = (float*)(ws + (FOFF)) + hh_ * 64 + 16 * g_; d.fpitch = (FP); } } while (0)
#define PLAINB(rel, BOFF, BP) do { d.kind = 1; d.bp = (bf16*)(ws + (BOFF)) + (rel); d.bpitch = (BP); } while (0)
#define PLAINF(rel, FOFF, FP) do { d.kind = 1; d.fp = (float*)(ws + (FOFF)) + (rel); d.fpitch = (FP); } while (0)
        if (c < 256) ROPE64(c, WS_QM_BF, 256, WS_QM_F, 256);
        else if (c < 512) ROPE64(c - 256, WS_KM_BF, 256, WS_KM_F, 256);
        else if (c < 768) PLAINB(c - 512, WS_VM_BF, 256);
        else if (c < 1024) PLAINB(c - 768, WS_CQ, 256);
        else if (c < 1152) PLAINB(c - 1024, WS_CKV, 128);
        else if (c < 1184) { d.kind = 3; d.nstride = 16; d.bp = (bf16*)(ws + WS_KMLA) + 64; d.bpitch = 384; d.rep = 4; d.repstride = 96; }
        else if (c < 1440) ROPE64(c - 1184, WS_QN, 256, 0, 0);
        else if (c < 1504) ROPE64(c - 1440, WS_KC, 64, 0, 0);
        else if (c < 1568) PLAINB(c - 1504, WS_VC, 64);
        else if (c < 1632) ROPE64(c - 1568, WS_KS, 64, 0, 0);
        else if (c < 1696) PLAINB(c - 1632, WS_VS, 64);
        else if (c < 1760) ROPE64(c - 1696, WS_KW, 64, 0, 0);
        else if (c < 1824) PLAINB(c - 1760, WS_VW, 64);
        else if (c < 2080) ROPE64(c - 1824, WS_QD, 256, 0, 0);
        else if (c < 2144) ROPE64(c - 2080, WS_KD, 64, 0, 0);
        else if (c < 2208) PLAINB(c - 2144, WS_VD, 64);
        else if (c < 2464) PLAINF(c - 2208, WS_IQ, 256);
        else if (c < 2496) { PLAINF(c - 2464, WS_IK, 32); d.pad = 1; }
        else if (c < 2528) PLAINF(c - 2496, WS_GW, 32);
#undef ROPE64
#undef PLAINB
#undef PLAINF
        return d;
    }
};
struct MlaQDesc {
    unsigned char* ws;
    __device__ __forceinline__ pg8::ProjDesc operator()(int G) const {
        pg8::ProjDesc d; d.kind = 0; d.dfreq0 = 0; d.nstride = 16; d.rep = 1; d.repstride = 0; d.bpitch = 384; d.fpitch = 0; d.pad = 0; d.bp = nullptr; d.fp = nullptr;
        if (G < 12) { const int hh = G / 3, part = G - 3 * hh; d.kind = (part == 2) ? 3 : 1; d.bp = (bf16*)(ws + WS_QMLA) + hh * 96 + 32 * part; }
        return d;
    }
};
struct MlaKvDesc {
    unsigned char* ws;
    __device__ __forceinline__ pg8::ProjDesc operator()(int G) const {
        pg8::ProjDesc d; d.kind = 1; d.dfreq0 = 0; d.nstride = 16; d.rep = 1; d.repstride = 0; d.bpitch = 0; d.fpitch = 0; d.pad = 0; d.bp = nullptr; d.fp = nullptr;
        const int c = 32 * G;
        if (c < 256) { d.bp = (bf16*)(ws + WS_KMLA) + (c >> 6) * 96 + (c & 63); d.bpitch = 384; }
        else { d.bp = (bf16*)(ws + WS_VMLA) + (c - 256); d.bpitch = 256; }
        return d;
    }
};

__device__ __forceinline__ void p0_prologue(Frame& F) {
    const int tid = cur_tid();
    const int wave = cur_wave(), gw = blockIdx.x * NWAVES + wave, NGW = F.G * NWAVES, lane = cur_lane();
    {
        LAS float* scr = (LAS float*)(F.lds + RING_OFF + wave * 16384);
        constexpr int PER_LAYER = 2816 + 1408 + 2816 + 1408 + 1280 + 512 + 64 + 32 + 256 + 256;
        for (int it = gw; it < NL * PER_LAYER; it += NGW) {
            const int l = it / PER_LAYER; int r = it - l * PER_LAYER; int kind = 0;
            { const int cnt[10] = {2816, 1408, 2816, 1408, 1280, 512, 64, 32, 256, 256};
#pragma unroll
              for (int q = 0; q < 9; ++q) { if (kind == q && r >= cnt[q]) { r -= cnt[q]; kind = q + 1; } } }
            const int K = kind == 0 || kind == 2 || kind == 4 || kind == 5 ? 1024 : (kind == 1 || kind == 3) ? 2816 : kind == 6 ? 256 : kind == 7 ? 128 : 2048;
            const int N = kind == 0 || kind == 2 ? 5632 : kind == 4 ? 2560 : (kind == 6 || kind == 7) ? 512 : kind >= 8 ? 256 : 1024;
            const int nblk = N / 32, kb = r / nblk, nb = r - kb * nblk, k0 = 64 * kb, n0 = 32 * nb;
            int stride; const float* colp = wsrc(F, kind, l, n0 + (lane & 31), stride);
            const float* ksc = kind == 6 ? F.A->in[I_QNORM] + l * 256 : kind == 7 ? F.A->in[I_KVNORM] + l * 128 : nullptr;
            bf16* WT = (bf16*)(F.ws + WS_WTS + (size_t)l * WTS_LAYER + wk_off(kind));
            float vv[32];
#pragma unroll
            for (int i = 0; i < 32; ++i) { const int kk = 2 * i + (lane >> 5); vv[i] = colp ? colp[(size_t)(k0 + kk) * stride] : 0.f; }
#pragma unroll
            for (int i = 0; i < 32; ++i) { const int kk = 2 * i + (lane >> 5); float v = vv[i]; if (ksc) v *= ksc[k0 + kk]; scr[kk * 33 + (lane & 31)] = v; }
            LDS_WAIT(); asm volatile("" ::: "memory");
            const int c = lane & 7;
#pragma unroll
            for (int j = 0; j < 4; ++j) { const int n = (lane >> 3) + 8 * j; const LAS float* s = scr + (8 * c) * 33 + n;
                v4u o; o.x = pk2(s[0 * 33], s[1 * 33]); o.y = pk2(s[2 * 33], s[3 * 33]); o.z = pk2(s[4 * 33], s[5 * 33]); o.w = pk2(s[6 * 33], s[7 * 33]);
                *(GAS v4u*)(WT + (size_t)(n0 + n) * K + k0 + 8 * c) = o; }
            LDS_WAIT(); asm volatile("" ::: "memory");
        }
    }
    for (int i = blockIdx.x * 512 + tid; i < 4096 * 48; i += F.G * 512) {
        const int pos = i / 48, j = i - pos * 48;
        float invf; float* dst;
        if (j < 32) { invf = 1.0f / (float)pow(10000.0, (double)j / 32.0); dst = (float*)(F.ws + WS_CS64) + ((size_t)pos * 32 + j) * 2; }
        else { invf = 1.0f / (float)pow(10000.0, (double)(j - 32) / 16.0); dst = (float*)(F.ws + WS_CS32) + ((size_t)pos * 16 + (j - 32)) * 2; }
        const float ang = (float)pos * invf;
        dst[0] = (float)cos((double)ang); dst[1] = (float)sin((double)ang);
    }
    {
        LAS float* red = (LAS float*)(F.lds + RING_OFF + 8 * 16384 - 2048);
        for (int task = blockIdx.x; task < NL * 2 * 4; task += F.G) {
            const int l = task >> 3, kvq = task & 7, kv = kvq >> 2, j = (kvq & 3) * 64 + lane;
            const float* pe = F.A->in[kv ? I_PEV : I_PEK] + (size_t)l * 2048 + wave * 256; const float* w1 = F.A->in[kv ? I_CV1 : I_CK1] + (size_t)l * 2048 * 256 + (size_t)wave * 256 * 256 + j;
            float acc = 0.f;
#pragma unroll 32
            for (int k = 0; k < 256; ++k) acc += pe[k] * w1[(size_t)k * 256];
            __syncthreads();
            red[wave * 64 + lane] = acc;
            __syncthreads();
            if (wave == 0) { float s = 0.f;
#pragma unroll
                for (int w = 0; w < 8; ++w) s += red[w * 64 + lane];
                ((float*)(F.ws + WS_CMPB))[(l * 2 + kv) * 256 + j] = s; }
        }
    }
    {
        __syncthreads();
        LAS float* cact = (LAS float*)(F.lds + RING_OFF);
        LAS float* red = (LAS float*)(F.lds + RING_OFF + 32768);
        for (int i = tid; i < 8 * 1024; i += 512) { const float cv = F.A->in[I_C][i]; cact[i] = cv / (1.0f + __expf(-cv)); }
        __syncthreads();
        for (int task = blockIdx.x; task < NL * 144; task += F.G) {
            const int l = task / 144, n0 = (task - l * 144) * 64;
            const float* W = F.A->in[I_ADAW] + (size_t)l * 1024 * 9216 + n0 + lane;
            float acc[8];
#pragma unroll
            for (int b = 0; b < 8; ++b) acc[b] = 0.f;
            const int kbeg = wave * 128;
#pragma unroll 16
            for (int k = kbeg; k < kbeg + 128; ++k) { const float wv = W[(size_t)k * 9216];
#pragma unroll
                for (int b = 0; b < 8; ++b) acc[b] += cact[b * 1024 + k] * wv; }
#pragma unroll
            for (int b = 0; b < 8; ++b) red[(wave * 8 + b) * 64 + lane] = acc[b];
            __syncthreads();
            { const int b = wave; float s = F.A->in[I_ADAB][(size_t)l * 9216 + n0 + lane];
#pragma unroll
              for (int w = 0; w < 8; ++w) s += red[(w * 8 + b) * 64 + lane];
              ((float*)(F.ws + WS_ADA))[((size_t)l * 8 + b) * 9216 + n0 + lane] = s; }
            __syncthreads();
        }
    }
}

__device__ __forceinline__ void norm_mod_phase(Frame& F, const float* xsrc, const float* gain, const float* sh, const float* sc, bf16* hout) {
    const int wave = cur_wave(), gw = blockIdx.x * NWAVES + wave, NGW = F.G * NWAVES, lane = cur_lane();
    f32x4 g[4];
#pragma unroll
    for (int j = 0; j < 4; ++j) g[j] = *(const f32x4*)(gain + 4 * lane + 256 * j);
    for (int row0 = gw; row0 < M; row0 += 2 * NGW) {
        const int row1 = row0 + NGW; const bool has1 = row1 < M; const int r1 = has1 ? row1 : row0;
        const f32x4* xa = (const f32x4*)(xsrc + (size_t)row0 * D) + lane; const f32x4* xb = (const f32x4*)(xsrc + (size_t)r1 * D) + lane;
        f32x4 va[4], vb[4]; float sa = 0.f, sb = 0.f;
#pragma unroll
        for (int j = 0; j < 4; ++j) { va[j] = xa[64 * j]; vb[j] = xb[64 * j]; }
#pragma unroll
        for (int j = 0; j < 4; ++j) { sa += (va[j].x * va[j].x + va[j].y * va[j].y) + (va[j].z * va[j].z + va[j].w * va[j].w); sb += (vb[j].x * vb[j].x + vb[j].y * vb[j].y) + (vb[j].z * vb[j].z + vb[j].w * vb[j].w); }
        const float rsa = 1.0f / sqrtf(wave_sum(sa) * (1.f / D) + RMS_EPS), rsb = 1.0f / sqrtf(wave_sum(sb) * (1.f / D) + RMS_EPS);
#pragma unroll
        for (int q = 0; q < 2; ++q) {
            if (q == 1 && !has1) break;
            const int row = q ? row1 : row0; const int b = row >> 12; const float rstd = q ? rsb : rsa;
            const float* shb = sh + (size_t)b * 9216 + 4 * lane; const float* scb = sc + (size_t)b * 9216 + 4 * lane;
            unsigned long long* o8 = (unsigned long long*)(hout + (size_t)row * D) + lane;
#pragma unroll
            for (int j = 0; j < 4; ++j) { const f32x4 s4 = *(const f32x4*)(shb + 256 * j), c4 = *(const f32x4*)(scb + 256 * j);
                const f32x4 y = (q ? vb[j] : va[j]) * rstd * g[j] * (c4 + 1.0f) + s4;
                o8[64 * j] = (unsigned long long)pk2(y.x, y.y) | ((unsigned long long)pk2(y.z, y.w) << 32); }
        }
    }
}
__device__ __forceinline__ void final_norm_phase(Frame& F, float* x, const float* gain) {
    const int wave = cur_wave(), gw = blockIdx.x * NWAVES + wave, NGW = F.G * NWAVES, lane = cur_lane();
    f32x4 g[4];
#pragma unroll
    for (int j = 0; j < 4; ++j) g[j] = *(const f32x4*)(gain + 4 * lane + 256 * j);
    for (int row0 = gw; row0 < M; row0 += 2 * NGW) {
        const int row1 = row0 + NGW; const bool has1 = row1 < M; const int r1 = has1 ? row1 : row0;
        f32x4* xa = (f32x4*)(x + (size_t)row0 * D) + lane; f32x4* xb = (f32x4*)(x + (size_t)r1 * D) + lane;
        f32x4 va[4], vb[4]; float sa = 0.f, sb = 0.f;
#pragma unroll
        for (int j = 0; j < 4; ++j) { va[j] = xa[64 * j]; vb[j] = xb[64 * j]; }
#pragma unroll
        for (int j = 0; j < 4; ++j) { sa += (va[j].x * va[j].x + va[j].y * va[j].y) + (va[j].z * va[j].z + va[j].w * va[j].w); sb += (vb[j].x * vb[j].x + vb[j].y * vb[j].y) + (vb[j].z * vb[j].z + vb[j].w * vb[j].w); }
        const float rsa = 1.0f / sqrtf(wave_sum(sa) * (1.f / D) + RMS_EPS), rsb = 1.0f / sqrtf(wave_sum(sb) * (1.f / D) + RMS_EPS);
#pragma unroll
        for (int j = 0; j < 4; ++j) xa[64 * j] = va[j] * rsa * g[j];
        if (has1) {
#pragma unroll
            for (int j = 0; j < 4; ++j) xb[64 * j] = vb[j] * rsb * g[j]; }
    }
}
__device__ __forceinline__ void group_norm_phase(Frame& F, bf16* Y, const float* gn) {
    const int wave = cur_wave(), gw = blockIdx.x * NWAVES + wave, NGW = F.G * NWAVES, lane = cur_lane();
    f32x4 g[4];
#pragma unroll
    for (int j = 0; j < 4; ++j) g[j] = *(const f32x4*)(gn + 256 * j + 4 * lane);
    for (int row0 = gw; row0 < M; row0 += 4 * NGW) {
        unsigned long long w[4][4];
#pragma unroll
        for (int q = 0; q < 4; ++q) { const int row = row0 + q * NGW < M ? row0 + q * NGW : row0; const unsigned long long* yr = (const unsigned long long*)(Y + (size_t)row * D) + lane;
#pragma unroll
            for (int j = 0; j < 4; ++j) w[q][j] = yr[64 * j]; }
#pragma unroll
        for (int q = 0; q < 4; ++q) {
            const int row = row0 + q * NGW; if (row >= M) break;
            unsigned long long* yr = (unsigned long long*)(Y + (size_t)row * D) + lane;
#pragma unroll
            for (int j = 0; j < 4; ++j) {
                const unsigned long long ww = w[q][j];
                const float a0 = __uint_as_float((unsigned)ww << 16), a1 = __uint_as_float((unsigned)ww & 0xffff0000u), a2 = __uint_as_float((unsigned)(ww >> 32) << 16), a3 = __uint_as_float((unsigned)(ww >> 32) & 0xffff0000u);
                const float ss = wave_sum((a0 * a0 + a1 * a1) + (a2 * a2 + a3 * a3));
                const float rstd = 1.0f / sqrtf(ss * (1.f / 256.f) + RMS_EPS);
                yr[64 * j] = (unsigned long long)pk2(a0 * rstd * g[j].x, a1 * rstd * g[j].y) | ((unsigned long long)pk2(a2 * rstd * g[j].z, a3 * rstd * g[j].w) << 32);
            }
        }
    }
}
__device__ __forceinline__ unsigned long long causal_word(int d) { return d >= 63 ? ~0ull : (d < 0 ? 0ull : ((2ull << d) - 1ull)); }
__device__ __forceinline__ int mbcnt64(unsigned long long m) { return (int)__builtin_amdgcn_mbcnt_hi((unsigned)(m >> 32), __builtin_amdgcn_mbcnt_lo((unsigned)m, 0u)); }
__device__ __forceinline__ unsigned fkey(float x) { const unsigned u = __float_as_uint(x); return (u & 0x80000000u) ? ~u : (u | 0x80000000u); }
__device__ __forceinline__ float reduce64(const float (&o)[64], int lane) {
    float r5[32], r4[16], r3[8], r2[4], r1[2];
    { const bool hi = (lane & 32) != 0;
#pragma unroll
      for (int i = 0; i < 32; ++i) { const float a = o[i], b = o[i + 32]; r5[i] = (hi ? b : a) + __shfl_xor(hi ? a : b, 32); } }
    { const bool hi = (lane & 16) != 0;
#pragma unroll
      for (int i = 0; i < 16; ++i) { const float a = r5[i], b = r5[i + 16]; r4[i] = (hi ? b : a) + __shfl_xor(hi ? a : b, 16); } }
    { const bool hi = (lane & 8) != 0;
#pragma unroll
      for (int i = 0; i < 8; ++i) { const float a = r4[i], b = r4[i + 8]; r3[i] = (hi ? b : a) + __shfl_xor(hi ? a : b, 8); } }
    { const bool hi = (lane & 4) != 0;
#pragma unroll
      for (int i = 0; i < 4; ++i) { const float a = r3[i], b = r3[i + 4]; r2[i] = (hi ? b : a) + __shfl_xor(hi ? a : b, 4); } }
    { const bool hi = (lane & 2) != 0;
#pragma unroll
      for (int i = 0; i < 2; ++i) { const float a = r2[i], b = r2[i + 2]; r1[i] = (hi ? b : a) + __shfl_xor(hi ? a : b, 2); } }
    const bool hi = (lane & 1) != 0;
    return (hi ? r1[1] : r1[0]) + __shfl_xor(hi ? r1[0] : r1[1], 1);
}
struct KVbf {
    const bf16* K; const bf16* V; int kp, vp;
    template <int DQ> __device__ __forceinline__ float dot(int row, const LAS float* q) const {
        const v4u* p = (const v4u*)(K + (size_t)row * kp); float s = 0.f;
#pragma unroll
        for (int c = 0; c < DQ / 8; ++c) { float f[8]; unpack8(p[c], f); const f32x4 q0 = *(const LAS f32x4*)(q + 8 * c), q1 = *(const LAS f32x4*)(q + 8 * c + 4);
            s += (q0.x * f[0] + q0.y * f[1]) + (q0.z * f[2] + q0.w * f[3]) + (q1.x * f[4] + q1.y * f[5]) + (q1.z * f[6] + q1.w * f[7]); }
        return s;
    }
    __device__ __forceinline__ void axpy(int row, float pw, float (&o)[64]) const {
        const v4u* p = (const v4u*)(V + (size_t)row * vp);
#pragma unroll
        for (int c = 0; c < 8; ++c) { float f[8]; unpack8(p[c], f);
#pragma unroll
            for (int e = 0; e < 8; ++e) o[8 * c + e] += pw * f[e]; }
    }
};
struct KVf32 {
    const float* K; const float* V; int kp, vp;
    template <int DQ> __device__ __forceinline__ float dot(int row, const LAS float* q) const {
        const f32x4* p = (const f32x4*)(K + (size_t)row * kp); float s = 0.f;
#pragma unroll
        for (int c = 0; c < DQ / 4; ++c) { const f32x4 f = p[c]; const f32x4 qv = *(const LAS f32x4*)(q + 4 * c); s += (qv.x * f.x + qv.y * f.y) + (qv.z * f.z + qv.w * f.w); }
        return s;
    }
    __device__ __forceinline__ void axpy(int row, float pw, float (&o)[64]) const {
        const f32x4* p = (const f32x4*)(V + (size_t)row * vp);
#pragma unroll
        for (int c = 0; c < 16; ++c) { const f32x4 f = p[c]; o[4 * c] += pw * f.x; o[4 * c + 1] += pw * f.y; o[4 * c + 2] += pw * f.z; o[4 * c + 3] += pw * f.w; }
    }
};
template <int DQ, class KV, class KeyFn>
__device__ __forceinline__ float wave_attend(const LAS float* q, float scale, int nslots, const KeyFn& keyf, const KV& kv, int lane) {
    float m = -INFINITY;
    for (int s = 0; s < nslots; ++s) { const int key = keyf(s); if (key >= 0) m = fmaxf(m, kv.template dot<DQ>(key, q) * scale); }
    const float Mx = wave_max(m);
    float o[64];
#pragma unroll
    for (int d = 0; d < 64; ++d) o[d] = 0.f;
    float l = 0.f;
    if (Mx > -INFINITY) {
        for (int s = 0; s < nslots; ++s) { const int key = keyf(s);
            if (key >= 0) { const float p = __expf(kv.template dot<DQ>(key, q) * scale - Mx); l += p; kv.axpy(key, p, o); } }
    }
    l = wave_sum(l);
    const float r = reduce64(o, lane);
    return l > 0.f ? r / l : 0.f;
}
__device__ __forceinline__ void task_bt(int i, int& t, int& rest) { const int tt = i & 2047, j = i >> 11; t = (j & 1) ? 4095 - tt : tt; rest = j >> 1; }

__device__ __forceinline__ void m1_phase(Frame& F, int l) {
    const int wave = cur_wave(), gw = blockIdx.x * NWAVES + wave, NGW = F.G * NWAVES, lane = cur_lane();
    const bf16* CQ = (const bf16*)(F.ws + WS_CQ); const bf16* CKV = (const bf16*)(F.ws + WS_CKV);
    float* rq = (float*)(F.ws + WS_RSTDQ); float* rkv = (float*)(F.ws + WS_RSTDKV);
    for (int row0 = gw; row0 < M; row0 += 4 * NGW) {
        unsigned long long wq[4]; unsigned wk[4];
#pragma unroll
        for (int q = 0; q < 4; ++q) { const int row = row0 + q * NGW < M ? row0 + q * NGW : row0; wq[q] = ((const unsigned long long*)(CQ + (size_t)row * 256))[lane]; wk[q] = ((const unsigned*)(CKV + (size_t)row * 128))[lane]; }
#pragma unroll
        for (int q = 0; q < 4; ++q) {
            const int row = row0 + q * NGW; if (row >= M) break;
            const unsigned long long w = wq[q];
            const float a0 = __uint_as_float((unsigned)w << 16), a1 = __uint_as_float((unsigned)w & 0xffff0000u), a2 = __uint_as_float((unsigned)(w >> 32) << 16), a3 = __uint_as_float((unsigned)(w >> 32) & 0xffff0000u);
            const float s1 = wave_sum((a0 * a0 + a1 * a1) + (a2 * a2 + a3 * a3));
            const float b0 = __uint_as_float(wk[q] << 16), b1 = __uint_as_float(wk[q] & 0xffff0000u);
            const float s2 = wave_sum(b0 * b0 + b1 * b1);
            if (lane == 0) { rq[row] = 1.0f / sqrtf(s1 * (1.f / 256.f) + RMS_EPS); rkv[row] = 1.0f / sqrtf(s2 * (1.f / 128.f) + RMS_EPS); }
        }
    }
    const float* KMF = (const float*)(F.ws + WS_KM_F); float* kmean = (float*)(F.ws + WS_KMEAN);
    for (int task = gw; task < 512; task += NGW) {
        const int b = task >> 6, blk = (task >> 2) & 15, h = task & 3;
        const float* p = KMF + ((size_t)(b * T + blk * 256)) * 256 + h * 64 + lane; float s = 0.f;
#pragma unroll 32
        for (int i = 0; i < 256; ++i) s += p[(size_t)i * 256];
        kmean[((b * 4 + h) * 16 + blk) * 64 + lane] = s * (1.f / 256.f);
    }
}
__device__ __forceinline__ void cmp2_phase(Frame& F, int l) {
    const int wave = cur_wave(), gw = blockIdx.x * NWAVES + wave, NGW = F.G * NWAVES, lane = cur_lane();
    const float* cmph = (const float*)(F.ws + WS_CMPH);
    for (int task = gw; task < 2 * 8 * 255; task += NGW) {
        const int kv = task / 2040, r1 = task - kv * 2040, b = r1 / 255, n = r1 - b * 255;
        const float* hp = cmph + ((size_t)(kv * 8 + b) * 256 + n) * 256;
        const float* w2 = F.A->in[kv ? I_CV2 : I_CK2] + (size_t)l * 256 * 64 + lane;
        float acc = 0.f;
#pragma unroll 32
        for (int j = 0; j < 256; ++j) acc += hp[j] * w2[j * 64];
        ((float*)(F.ws + (kv ? WS_VCMP : WS_KCMP)))[((size_t)b * 256 + n) * 64 + lane] = acc;
        ((bf16*)(F.ws + (kv ? WS_VCMPB : WS_KCMPB)))[((size_t)b * 256 + n) * 64 + lane] = (bf16)f2bf(acc);
    }
    for (int task = gw; task < 16; task += NGW) ((bf16*)(F.ws + ((task & 1) ? WS_VCMPB : WS_KCMPB)))[((size_t)(task >> 1) * 256 + 255) * 64 + lane] = 0;
}
__device__ __forceinline__ void mla_rows_phase(Frame& F) {
    const int wave = cur_wave(), gw = blockIdx.x * NWAVES + wave, NGW = F.G * NWAVES, lane = cur_lane();
    const bf16* Q = (const bf16*)(F.ws + WS_QMLA); bf16* Y = (bf16*)(F.ws + WS_H);
    LAS float* q = (LAS float*)(F.lds + RING_OFF + wave * 16384 + 4096);
    for (int i = gw; i < M * 4; i += NGW) {
        int t, bh; task_bt(i, t, bh); const int b = bh >> 2, h = bh & 3, row = b * T + t;
        if (lane < 48) { const unsigned w = ((const unsigned*)(Q + (size_t)row * 384 + h * 96))[lane]; q[2 * lane] = __uint_as_float(w << 16); q[2 * lane + 1] = __uint_as_float(w & 0xffff0000u); }
        LDS_WAIT(); asm volatile("" ::: "memory");
        KVbf kv{(const bf16*)(F.ws + WS_KMLA) + h * 96, (const bf16*)(F.ws + WS_VMLA) + h * 64, 384, 256};
        const int base = b * T;
        auto keyf = [&](int s) { const int p = lane + 64 * s; return p <= t ? base + p : -1; };
        const float r = wave_attend<96>(q, 0.10206207261596577f, (t >> 6) + 1, keyf, kv, lane);
        Y[(size_t)row * 1024 + 256 + h * 64 + lane] = (bf16)f2bf(r);
        LDS_WAIT(); asm volatile("" ::: "memory");
    }
}
__device__ __forceinline__ void moba_rows_phase(Frame& F) {
    const int wave = cur_wave(), gw = blockIdx.x * NWAVES + wave, NGW = F.G * NWAVES, lane = cur_lane();
    const float* QF = (const float*)(F.ws + WS_QM_F); const float* kmean = (const float*)(F.ws + WS_KMEAN); bf16* Y = (bf16*)(F.ws + WS_H);
    LAS float* q = (LAS float*)(F.lds + RING_OFF + wave * 16384 + 4096);
    for (int i = gw; i < M * 4; i += NGW) {
        int t, bh; task_bt(i, t, bh); const int b = bh >> 2, h = bh & 3, row = b * T + t, own = t >> 8;
        q[lane] = QF[(size_t)row * 256 + h * 64 + lane];
        LDS_WAIT(); asm volatile("" ::: "memory");
        float g = -INFINITY;
        if (lane < own) { KVf32 km{kmean + (size_t)((b * 4 + h) * 16) * 64, nullptr, 64, 64}; g = km.dot<64>(lane, q); }
        unsigned selmask = 0u;
        for (int r = 0; r < 3; ++r) { const float mx = wave_max(g); if (!(mx > -INFINITY)) break;
            const unsigned long long ball = __ballot(g == mx); const int sl = __ffsll((long long)ball) - 1; selmask |= 1u << sl; if (lane == sl) g = -INFINITY; }
        KVbf kv{(const bf16*)(F.ws + WS_KM_BF) + h * 64, (const bf16*)(F.ws + WS_VM_BF) + h * 64, 256, 256};
        const int base = b * T;
        auto keyf = [&](int s) { const int blk = s >> 2, p = 64 * s + lane; return blk == own ? (p <= t ? base + p : -1) : (((selmask >> blk) & 1u) ? base + p : -1); };
        const float r = wave_attend<64>(q, 0.125f, 4 * own + 4, keyf, kv, lane);
        Y[(size_t)row * 1024 + h * 64 + lane] = (bf16)f2bf(r);
        LDS_WAIT(); asm volatile("" ::: "memory");
    }
}
__device__ __forceinline__ void nsa_tokens_phase(Frame& F) {
    const int wave = cur_wave(), gw = blockIdx.x * NWAVES + wave, NGW = F.G * NWAVES, lane = cur_lane();
    const bf16* QN = (const bf16*)(F.ws + WS_QN); bf16* Y = (bf16*)(F.ws + WS_H);
    const float* kcmp = (const float*)(F.ws + WS_KCMP); const float* vcmp = (const float*)(F.ws + WS_VCMP); const float* GWp = (const float*)(F.ws + WS_GW);
    LAS float* ps = (LAS float*)(F.lds + RING_OFF + wave * 16384);
    LAS float* ocs = ps + 256;
    LAS float* svl = ps + 512;
    LAS float* q = (LAS float*)(F.lds + RING_OFF + wave * 16384 + 4096);
    for (int i = gw; i < M; i += NGW) {
        int t, b; task_bt(i, t, b); const int row = b * T + t, own = t >> 6, base = b * T;
#pragma unroll
        for (int k = 0; k < 4; ++k) ps[lane + 64 * k] = 0.f;
#pragma unroll 1
        for (int h = 0; h < 4; ++h) {
            LDS_WAIT(); asm volatile("" ::: "memory");
            q[lane] = bf2f(QN[(size_t)row * 256 + h * 64 + lane]);
            LDS_WAIT(); asm volatile("" ::: "memory");
            KVf32 kc{kcmp + (size_t)b * 256 * 64, vcmp + (size_t)b * 256 * 64, 64, 64};
            float ml = -INFINITY;
#pragma unroll 1
            for (int k = 0; k < 4; ++k) { const int n = lane + 64 * k; const bool valid = (n < 255) && (16 * n + 31 <= t);
                float sv = -INFINITY; if (valid) sv = kc.dot<64>(n, q) * 0.125f; svl[n] = sv; ml = fmaxf(ml, sv); }
            const float Mx = wave_max(ml);
            float o[64];
#pragma unroll
            for (int d = 0; d < 64; ++d) o[d] = 0.f;
#ifndef NSA_NO_C
            if (Mx > -INFINITY) {
                float ls = 0.f;
#pragma unroll 1
                for (int k = 0; k < 4; ++k) { const float sv = svl[lane + 64 * k]; const float p = sv > -INFINITY ? __expf(sv - Mx) : 0.f; ls += p; svl[lane + 64 * k] = p; }
                const float inv = 1.0f / wave_sum(ls);
#pragma unroll 1
                for (int k = 0; k < 4; ++k) { const float p = svl[lane + 64 * k] * inv; ps[lane + 64 * k] += p; if (p > 0.f) kc.axpy(lane + 64 * k, p, o); }
            }
#endif
            ocs[h * 64 + lane] = reduce64(o, lane);
        }
        LDS_WAIT(); asm volatile("" ::: "memory");
        float imp = (ps[4 * lane] + ps[4 * lane + 1]) + (ps[4 * lane + 2] + ps[4 * lane + 3]); if (lane > 0) imp += ps[4 * lane - 1];
        LDS_WAIT(); asm volatile("" ::: "memory");
        const bool causal = lane <= own, forced = causal && (lane == 0 || lane >= own - 1);
        float val = forced ? 1e4f : (causal ? imp : -INFINITY);
        unsigned long long selmask = 0ull;
        for (int r = 0; r < 16; ++r) { const float mx = wave_max(val); if (!(mx > -INFINITY)) break;
            const unsigned long long ball = __ballot(val == mx); const int sl = __ffsll((long long)ball) - 1; selmask |= 1ull << sl; if (lane == sl) val = -INFINITY; }
#ifdef FLASH_NSA
        if (lane == 0) ((unsigned long long*)(F.ws + WS_NSEL))[row] = selmask;
#pragma unroll
        for (int h = 0; h < 4; ++h) ((bf16*)(F.ws + WS_OC))[(size_t)row * 256 + h * 64 + lane] = (bf16)f2bf(ocs[h * 64 + lane]);
        LDS_WAIT(); asm volatile("" ::: "memory");
        continue;
#endif
#pragma unroll 1
        for (int h = 0; h < 4; ++h) {
            LDS_WAIT(); asm volatile("" ::: "memory");
            q[lane] = bf2f(QN[(size_t)row * 256 + h * 64 + lane]);
            LDS_WAIT(); asm volatile("" ::: "memory");
            KVbf ks{(const bf16*)(F.ws + WS_KS), (const bf16*)(F.ws + WS_VS), 64, 64};
            auto keys = [&](int s) { const int p = 64 * s + lane; return (((selmask >> s) & 1ull) && p <= t) ? base + p : -1; };
#ifdef NSA_NO_S
            float os = q[3];
#else
            float os = wave_attend<64>(q, 0.125f, own + 1, keys, ks, lane);
            asm volatile("" : "+v"(os) :: "memory");
#endif
            KVbf kw{(const bf16*)(F.ws + WS_KW), (const bf16*)(F.ws + WS_VW), 64, 64};
            auto keyw = [&](int s) { const int p = t - 511 + lane + 64 * s; return p >= 0 ? base + p : -1; };
#ifdef NSA_NO_W
            float ow = q[5];
#else
            float ow = wave_attend<64>(q, 0.125f, 8, keyw, kw, lane);
            asm volatile("" : "+v"(ow) :: "memory");
#endif
            const float* gp = GWp + (size_t)row * 32 + h * 3;
            const float g0 = sigmoid_f(gp[0]), g1 = sigmoid_f(gp[1]), g2 = sigmoid_f(gp[2]);
            Y[(size_t)row * 1024 + 512 + h * 64 + lane] = (bf16)f2bf(g0 * ocs[h * 64 + lane] + g1 * os + g2 * ow);
        }
    }
}
__device__ __forceinline__ void dsa_tokens_phase(Frame& F) {
    const int wave = cur_wave(), gw = blockIdx.x * NWAVES + wave, NGW = F.G * NWAVES, lane = cur_lane();
    const float* IQ = (const float*)(F.ws + WS_IQ); const float* IK = (const float*)(F.ws + WS_IK); const float* GWp = (const float*)(F.ws + WS_GW);
    const bf16* QD = (const bf16*)(F.ws + WS_QD); bf16* Y = (bf16*)(F.ws + WS_H);
    LAS float* sc = (LAS float*)(F.lds + RING_OFF + wave * 16384);
    LAS unsigned* hist = (LAS unsigned*)(F.lds + XTRA_OFF + wave * XTRA_WAVE);
    LAS unsigned short* idx = (LAS unsigned short*)hist;
    LAS float* xq = (LAS float*)(F.lds + XTRA_OFF + wave * XTRA_WAVE + 1024);
    for (int i = gw; i < M; i += NGW) {
        int t, b; task_bt(i, t, b); const int row = b * T + t, base = b * T, n = t + 1;
#pragma unroll
        for (int k = 0; k < 4; ++k) xq[lane + 64 * k] = IQ[(size_t)row * 256 + lane + 64 * k];
        if (lane < 8) xq[256 + lane] = GWp[(size_t)row * 32 + 12 + lane];
        LDS_WAIT(); asm volatile("" ::: "memory");
        for (int k0 = 0; k0 < n; k0 += 64) {
            const int key = k0 + lane;
            if (key < n) {
                float ik[32];
                { const f32x4* kp = (const f32x4*)(IK + (size_t)(base + key) * 32);
#pragma unroll
                  for (int c = 0; c < 8; ++c) { const f32x4 f = kp[c]; ik[4 * c] = f.x; ik[4 * c + 1] = f.y; ik[4 * c + 2] = f.z; ik[4 * c + 3] = f.w; } }
                float score = 0.f;
#pragma unroll
                for (int h = 0; h < 8; ++h) { float ds = 0.f;
#pragma unroll
                    for (int c = 0; c < 8; ++c) { const f32x4 qv = *(const LAS f32x4*)(xq + h * 32 + 4 * c); ds += (qv.x * ik[4 * c] + qv.y * ik[4 * c + 1]) + (qv.z * ik[4 * c + 2] + qv.w * ik[4 * c + 3]); }
                    score += xq[256 + h] * fmaxf(ds, 0.f); }
                sc[key] = score * 0.0625f + 0.0f;
            }
        }
        LDS_WAIT(); asm volatile("" ::: "memory");
        int nsel = n;
        if (n > 256) {
            unsigned prefix = 0u, pmask = 0u; int kk = 256;
            for (int pass = 0; pass < 4; ++pass) {
                const int shift = 24 - 8 * pass;
#pragma unroll
                for (int k = 0; k < 4; ++k) hist[lane + 64 * k] = 0u;
                LDS_WAIT(); asm volatile("" ::: "memory");
                for (int k0 = 0; k0 < n; k0 += 64) { const int key = k0 + lane;
                    if (key < n) { const unsigned u = fkey(sc[key]); if ((u & pmask) == prefix) __hip_atomic_fetch_add(hist + ((u >> shift) & 255u), 1u, __ATOMIC_RELAXED, __HIP_MEMORY_SCOPE_WORKGROUP); } }
                LDS_WAIT(); asm volatile("" ::: "memory");
                const int h0 = (int)hist[4 * lane], h1 = (int)hist[4 * lane + 1], h2 = (int)hist[4 * lane + 2], h3 = (int)hist[4 * lane + 3];
                const int tot = (h0 + h1) + (h2 + h3); int incl = tot;
#pragma unroll
                for (int o = 1; o < 64; o <<= 1) { const int v = __shfl_down(incl, o); if (lane + o < 64) incl += v; }
                int run = incl - tot, found = -1, newk = 0;
                if (run < kk && run + h3 >= kk) { found = 4 * lane + 3; newk = kk - run; } run += h3;
                if (found < 0 && run < kk && run + h2 >= kk) { found = 4 * lane + 2; newk = kk - run; } run += h2;
                if (found < 0 && run < kk && run + h1 >= kk) { found = 4 * lane + 1; newk = kk - run; } run += h1;
                if (found < 0 && run < kk && run + h0 >= kk) { found = 4 * lane; newk = kk - run; }
                const unsigned long long ball = __ballot(found >= 0); const int src = __ffsll((long long)ball) - 1;
                const int bin = __shfl(found, src); kk = __shfl(newk, src);
                prefix |= (unsigned)bin << shift; pmask |= 255u << shift;
                LDS_WAIT(); asm volatile("" ::: "memory");
            }
            int eqseen = 0, cnt = 0;
            for (int k0 = 0; k0 < n; k0 += 64) { const int key = k0 + lane; const bool inb = key < n; const unsigned u = inb ? fkey(sc[key]) : 0u;
                const bool gt = inb && u > prefix, eq = inb && u == prefix;
                const unsigned long long be = __ballot(eq); const bool sel = gt || (eq && (eqseen + mbcnt64(be)) < kk);
                const unsigned long long bs = __ballot(sel); if (sel) idx[cnt + mbcnt64(bs)] = (unsigned short)key;
#ifdef FLASH_DSA
                if (lane == 0) ((unsigned long long*)(F.ws + WS_DSAMASK))[(size_t)row * 64 + (k0 >> 6)] = bs;
#endif
                eqseen += __popcll(be); cnt += __popcll(bs); }
            nsel = cnt;
            LDS_WAIT(); asm volatile("" ::: "memory");
        }
#ifdef FLASH_DSA
        if (n <= 256) { for (int k0 = 0; k0 < n; k0 += 64) if (lane == 0) ((unsigned long long*)(F.ws + WS_DSAMASK))[(size_t)row * 64 + (k0 >> 6)] = causal_word(t - k0); }
        continue;
#endif
        int kidx[4];
#pragma unroll
        for (int k = 0; k < 4; ++k) { const int p = lane + 64 * k; kidx[k] = p < nsel ? base + (n > 256 ? (int)idx[p] : p) : -1; }
        LDS_WAIT(); asm volatile("" ::: "memory");
#pragma unroll 1
        for (int h = 0; h < 4; ++h) {
            LDS_WAIT(); asm volatile("" ::: "memory");
            xq[lane] = bf2f(QD[(size_t)row * 256 + h * 64 + lane]);
            LDS_WAIT(); asm volatile("" ::: "memory");
            KVbf kd{(const bf16*)(F.ws + WS_KD), (const bf16*)(F.ws + WS_VD), 64, 64};
            auto keyf = [&](int s) { return s == 0 ? kidx[0] : s == 1 ? kidx[1] : s == 2 ? kidx[2] : kidx[3]; };
            const float r = wave_attend<64>(xq, 0.125f, 4, keyf, kd, lane);
            Y[(size_t)row * 1024 + 768 + h * 64 + lane] = (bf16)f2bf(r);
        }
        LDS_WAIT(); asm volatile("" ::: "memory");
    }
}
typedef float f32x16 __attribute__((ext_vector_type(16)));
__device__ __forceinline__ float xhalf_max(float v) { const auto rr = __builtin_amdgcn_permlane32_swap(__float_as_uint(v), __float_as_uint(v), false, false); return fmaxf(__uint_as_float(rr[0]), __uint_as_float(rr[1])); }
__device__ __forceinline__ float xhalf_sum(float v) { const auto rr = __builtin_amdgcn_permlane32_swap(__float_as_uint(v), __float_as_uint(v), false, false); return __uint_as_float(rr[0]) + __uint_as_float(rr[1]); }
__device__ __forceinline__ float xhalf_other(float v, int hh) { const auto rr = __builtin_amdgcn_permlane32_swap(__float_as_uint(v), __float_as_uint(v), false, false); return __uint_as_float(hh ? rr[0] : rr[1]); }
constexpr int FL_KP96 = 208, FL_KP64 = 144, FL_VP = 144;
constexpr int FL_KBUF = 0, FL_KBUF_SZ = 64 * FL_KP96, FL_VBUF = 2 * FL_KBUF_SZ, FL_VBUF_SZ = 64 * FL_VP;
constexpr int FL_TL = FL_VBUF + 2 * FL_VBUF_SZ, FL_TLN = FL_TL + 64, FL_ORM = FL_TLN + 8, FL_SEL = FL_TL + 128;
constexpr int FL_END = FL_SEL + 512;
static_assert(FL_END <= RING_BYTES, "flash LDS map");
struct FlashKV { const bf16* K; const bf16* V; int kp, vp; };


template <int MODE>
__device__ __forceinline__ void fl_softmax(f32x16& p0, f32x16& p1, const unsigned long long word, const int h, const float sc2, float& m, float& lsum, f32x16& o0, f32x16& o1) {
    if (MODE == 2) {
        const unsigned wlo = (unsigned)word >> (4 * h), whi = (unsigned)(word >> 32) >> (4 * h);
#pragma unroll
        for (int i = 0; i < 16; ++i) { const int bit = (i & 3) + 8 * (i >> 2);
            p0[i] = (wlo & (1u << bit)) ? p0[i] : -INFINITY; p1[i] = (whi & (1u << bit)) ? p1[i] : -INFINITY; }
    }
    float mx, mx2;
    asm("v_max3_f32 %0, %1, %2, %3" : "=v"(mx) : "v"(p0[0]), "v"(p0[1]), "v"(p0[2]));
    asm("v_max3_f32 %0, %1, %2, %3" : "=v"(mx2) : "v"(p1[0]), "v"(p1[1]), "v"(p1[2]));
#pragma unroll
    for (int i = 3; i < 15; i += 2) { asm("v_max3_f32 %0, %1, %2, %3" : "=v"(mx) : "v"(mx), "v"(p0[i]), "v"(p0[i + 1])); asm("v_max3_f32 %0, %1, %2, %3" : "=v"(mx2) : "v"(mx2), "v"(p1[i]), "v"(p1[i + 1])); }
    asm("v_max3_f32 %0, %1, %2, %3" : "=v"(mx) : "v"(mx), "v"(p0[15]), "v"(p1[15]));
    asm("v_max_f32_e32 %0, %1, %2" : "=v"(mx) : "v"(mx), "v"(mx2));
    const bool rowon = (MODE != 1) || (word != 0ull);
    if (MODE == 1) mx = rowon ? mx : -INFINITY;
    mx = xhalf_max(mx);
    const float mn = fmaxf(m, mx * sc2);
    if (__any(mn > m)) { const float alpha = __builtin_amdgcn_exp2f(m - mn); lsum *= alpha;
#pragma unroll
        for (int i = 0; i < 16; ++i) { o0[i] *= alpha; o1[i] *= alpha; } }
    m = mn;
    const float nm = rowon ? -mn : -INFINITY;
    float ps = 0.f;
#pragma unroll
    for (int i = 0; i < 16; ++i) { p0[i] = __builtin_amdgcn_exp2f(__builtin_fmaf(p0[i], sc2, nm)); p1[i] = __builtin_amdgcn_exp2f(__builtin_fmaf(p1[i], sc2, nm)); ps += p0[i] + p1[i]; }
    lsum += ps;
}
template <int DQK, class MaskFn>
__device__ __forceinline__ void flash_unit(LAS unsigned char* lds, const FlashKV kv, const bf16* qrow, const float sc2  , const int ntiles,
                                           const MaskFn& maskf, f32x16& o0, f32x16& o1, float& lsum) {
    constexpr int KP = (DQK == 96) ? FL_KP96 : FL_KP64, NKS = DQK / 16, CPR = DQK / 8;
    const int tid = cur_tid(), lane = tid & 63, r = lane & 31, h = lane >> 5;
    const LAS unsigned char* tl = lds + FL_TL;
    bf16x8 qf[NKS];
#pragma unroll
    for (int ks = 0; ks < NKS; ++ks) qf[ks] = *(const GAS bf16x8*)(qrow + 16 * ks + 8 * h);
    const int kr0 = tid / CPR, kc0 = tid - kr0 * CPR;
    const int kr1 = (tid + 512) / CPR, kc1 = (tid + 512) - kr1 * CPR;
    const bool has2 = (DQK == 96) && (tid < 256);
    const int vr = tid >> 3, vc = tid & 7;
    struct StageRegs { v4u k0, k1, v; };
    StageRegs S0, S1; S0.k1 = (v4u){0u, 0u, 0u, 0u}; S1.k1 = (v4u){0u, 0u, 0u, 0u};
    auto gload = [&](StageRegs& S, int tile) {
        const size_t rowb = (size_t)tile * 64;
        S.k0 = *(const GAS v4u*)(kv.K + (rowb + kr0) * kv.kp + 8 * kc0);
        if (DQK == 96) S.k1 = *(const GAS v4u*)(kv.K + (rowb + (has2 ? kr1 : kr0)) * kv.kp + 8 * (has2 ? kc1 : kc0));
        S.v = *(const GAS v4u*)(kv.V + (rowb + vr) * kv.vp + 8 * vc);
    };
    auto lstore = [&](const StageRegs& S, int buf) {
        LAS unsigned char* Kb = lds + FL_KBUF + buf * FL_KBUF_SZ; LAS unsigned char* Vb = lds + FL_VBUF + buf * FL_VBUF_SZ;
        *(LAS v4u*)(Kb + kr0 * KP + 16 * kc0) = S.k0;
        if (has2) *(LAS v4u*)(Kb + kr1 * KP + 16 * kc1) = S.k1;
        *(LAS v4u*)(Vb + vr * FL_VP + 16 * vc) = S.v;
    };
    float m = -1e30f; lsum = 0.f;
    __syncthreads();
#pragma unroll
    for (int i = 0; i < 16; ++i) { o0[i] = 0.f; o1[i] = 0.f; }
    unsigned long long wnext = 0ull;
    if (ntiles > 0) { wnext = maskf((int)tl[0]); gload(S0, (int)tl[0]); lstore(S0, 0); }
    if (ntiles > 0) gload(S1, (int)tl[ntiles > 1 ? 1 : 0]);
#pragma unroll
    for (int ks = 0; ks < NKS; ++ks) asm volatile("" :: "v"(qf[ks]));
    __syncthreads();
    auto step = [&](const int it, StageRegs& Sload, const StageRegs& Sstore) __attribute__((always_inline)) {
        const int cur = it & 1;
        const unsigned long long word = wnext;
        wnext = maskf((int)tl[it + 1 < ntiles ? it + 1 : ntiles - 1]);
        gload(Sload, (int)tl[it + 2 < ntiles ? it + 2 : ntiles - 1]);
        if (!__all(word == 0ull)) {
            const LAS unsigned char* Kb = lds + FL_KBUF + cur * FL_KBUF_SZ; const LAS unsigned char* Vb = lds + FL_VBUF + cur * FL_VBUF_SZ;
            f32x16 p0, p1;
#pragma unroll
            for (int i = 0; i < 16; ++i) { p0[i] = 0.f; p1[i] = 0.f; }
#pragma unroll
            for (int ks = 0; ks < NKS; ++ks) {
                const bf16x8 a0 = *(const LAS bf16x8*)(Kb + r * KP + (16 * ks + 8 * h) * 2), a1 = *(const LAS bf16x8*)(Kb + (32 + r) * KP + (16 * ks + 8 * h) * 2);
                p0 = __builtin_amdgcn_mfma_f32_32x32x16_bf16(a0, qf[ks], p0, 0, 0, 0);
                p1 = __builtin_amdgcn_mfma_f32_32x32x16_bf16(a1, qf[ks], p1, 0, 0, 0);
            }
            if (__all(word == ~0ull)) fl_softmax<0>(p0, p1, word, h, sc2, m, lsum, o0, o1);
            else if (__all(word == ~0ull || word == 0ull)) fl_softmax<1>(p0, p1, word, h, sc2, m, lsum, o0, o1);
            else fl_softmax<2>(p0, p1, word, h, sc2, m, lsum, o0, o1);
            bf16x8 pf[4];
#pragma unroll
            for (int s = 0; s < 4; ++s) { v4u w;
                if (s < 2) { w.x = pg8::cvt_pk_bf16(p0[8 * s], p0[8 * s + 1]); w.y = pg8::cvt_pk_bf16(p0[8 * s + 2], p0[8 * s + 3]); w.z = pg8::cvt_pk_bf16(p0[8 * s + 4], p0[8 * s + 5]); w.w = pg8::cvt_pk_bf16(p0[8 * s + 6], p0[8 * s + 7]); }
                else { const int s2 = s - 2; w.x = pg8::cvt_pk_bf16(p1[8 * s2], p1[8 * s2 + 1]); w.y = pg8::cvt_pk_bf16(p1[8 * s2 + 2], p1[8 * s2 + 3]); w.z = pg8::cvt_pk_bf16(p1[8 * s2 + 4], p1[8 * s2 + 5]); w.w = pg8::cvt_pk_bf16(p1[8 * s2 + 6], p1[8 * s2 + 7]); }
                pf[s] = __builtin_bit_cast(bf16x8, w); }
            {
                typedef short v4i16_t __attribute__((ext_vector_type(4)));
                const LAS unsigned char* vbase = Vb + (4 * h + ((lane & 15) >> 2)) * FL_VP + (16 * ((lane >> 4) & 1) + 4 * (lane & 3)) * 2;
#pragma unroll
                for (int s = 0; s < 4; ++s) {
#pragma unroll
                    for (int db = 0; db < 2; ++db) {
                        const LAS unsigned char* vp_ = vbase + (32 * (s >> 1) + 16 * (s & 1)) * FL_VP + 64 * db;
                        const v4i16_t lo = __builtin_amdgcn_ds_read_tr16_b64_v4i16((LAS v4i16_t*)vp_), hi = __builtin_amdgcn_ds_read_tr16_b64_v4i16((LAS v4i16_t*)(vp_ + 8 * FL_VP));
                        const bf16x8 a = {lo[0], lo[1], lo[2], lo[3], hi[0], hi[1], hi[2], hi[3]};
                        if (db == 0) o0 = __builtin_amdgcn_mfma_f32_32x32x16_bf16(a, pf[s], o0, 0, 0, 0);
                        else o1 = __builtin_amdgcn_mfma_f32_32x32x16_bf16(a, pf[s], o1, 0, 0, 0);
                    }
                }
            }
        }
        if (it + 1 < ntiles) lstore(Sstore, cur ^ 1);
        __syncthreads();
    };
    for (int it = 0; it < ntiles; it += 2) { step(it, S0, S1); if (it + 1 < ntiles) step(it + 1, S1, S0); }
}
__device__ __forceinline__ void flash_store(bf16* yrow  , const f32x16& o0, const f32x16& o1, float inv, int h) {
#pragma unroll
    for (int g = 0; g < 4; ++g) {
        typedef unsigned u32x2v __attribute__((ext_vector_type(2)));
        u32x2v w0, w1;
        w0.x = pg8::cvt_pk_bf16(o0[4 * g] * inv, o0[4 * g + 1] * inv); w0.y = pg8::cvt_pk_bf16(o0[4 * g + 2] * inv, o0[4 * g + 3] * inv);
        w1.x = pg8::cvt_pk_bf16(o1[4 * g] * inv, o1[4 * g + 1] * inv); w1.y = pg8::cvt_pk_bf16(o1[4 * g + 2] * inv, o1[4 * g + 3] * inv);
        *(u32x2v*)(yrow + 8 * g + 4 * h) = w0; *(u32x2v*)(yrow + 32 + 8 * g + 4 * h) = w1;
    }
}

__device__ __forceinline__ void mla_flash_phase(Frame& F) {
    const int tid = cur_tid(), wave = cur_wave(), lane = tid & 63, r = lane & 31, h2 = lane >> 5;
    bf16* Y = (bf16*)(F.ws + WS_H);
    for (int pass = 0; pass < 2; ++pass) {
        for (int u0 = blockIdx.x; u0 < 256; u0 += F.G) {
            const int u = pass ? 511 - u0 : u0, qb = u >> 5, bh = u & 31, b = bh >> 2, hd = bh & 3;
            const int t = 256 * qb + 32 * wave + r; const size_t row = (size_t)b * T + t;
            LAS unsigned char* tl = F.lds + FL_TL;
            if (tid < 64) tl[tid] = (unsigned char)tid;
            const int ntiles = 4 * qb + 4;
            FlashKV kv{(const bf16*)(F.ws + WS_KMLA) + (size_t)b * T * 384 + hd * 96, (const bf16*)(F.ws + WS_VMLA) + (size_t)b * T * 256 + hd * 64, 384, 256};
            auto maskf = [&](int tile) { return causal_word(t - 64 * tile); };
            f32x16 o0, o1; float ls;
            flash_unit<96>(F.lds, kv, (const bf16*)(F.ws + WS_QMLA) + row * 384 + hd * 96, 0.10206207261596577f * 1.4426950408889634f, ntiles, maskf, o0, o1, ls);
            ls = xhalf_sum(ls);
            flash_store(Y + row * 1024 + 256 + hd * 64, o0, o1, ls > 0.f ? 1.0f / ls : 0.f, h2);
        }
    }
}

__device__ __forceinline__ void moba_flash_phase(Frame& F) {
    const int tid = cur_tid(), wave = cur_wave(), lane = tid & 63, r = lane & 31, h2 = lane >> 5;
    bf16* Y = (bf16*)(F.ws + WS_H);
    const float* QF = (const float*)(F.ws + WS_QM_F); const float* kmean = (const float*)(F.ws + WS_KMEAN);
    LAS unsigned short* msel = (LAS unsigned short*)(F.lds + FL_SEL); LAS unsigned* orm = (LAS unsigned*)(F.lds + FL_ORM); LAS unsigned char* tl = F.lds + FL_TL; LAS int* tln = (LAS int*)(F.lds + FL_TLN);
    for (int pass = 0; pass < 2; ++pass) {
        for (int u0 = blockIdx.x; u0 < 256; u0 += F.G) {
            const int u = pass ? 511 - u0 : u0, own = u >> 5, bh = u & 31, b = bh >> 2, hd = bh & 3;
            if (tid == 0) orm[0] = 0u;
            __syncthreads();
            if (tid < 256) {
                const float* qp = QF + ((size_t)b * T + 256 * own + tid) * 256 + hd * 64;
                const float* km = kmean + (size_t)((b * 4 + hd) * 16) * 64;
                f32x4 qv[16];
#pragma unroll
                for (int c = 0; c < 16; ++c) qv[c] = *(const f32x4*)(qp + 4 * c);
                float g[15];
#pragma unroll
                for (int j = 0; j < 15; ++j) { g[j] = 0.f;
                    if (j < own) { float a = 0.f;
#pragma unroll
                        for (int c = 0; c < 16; ++c) { const f32x4 kv4 = *(const f32x4*)(km + j * 64 + 4 * c); a += (qv[c].x * kv4.x + qv[c].y * kv4.y) + (qv[c].z * kv4.z + qv[c].w * kv4.w); }
                        g[j] = a; } }
                unsigned sel = 0u;
#pragma unroll
                for (int rr = 0; rr < 3; ++rr) { float best = -INFINITY; int bi = -1;
#pragma unroll
                    for (int j = 0; j < 15; ++j) if (j < own && !((sel >> j) & 1u) && g[j] > best) { best = g[j]; bi = j; }
                    if (bi >= 0) sel |= 1u << bi; }
                msel[tid] = (unsigned short)sel;
                __hip_atomic_fetch_or(orm, sel, __ATOMIC_RELAXED, __HIP_MEMORY_SCOPE_WORKGROUP);
            }
            __syncthreads();
            if (tid == 0) { const unsigned om = orm[0]; int n = 0;
                for (int j = 0; j < own; ++j) if ((om >> j) & 1u) { for (int q4 = 0; q4 < 4; ++q4) tl[n++] = (unsigned char)(4 * j + q4); }
                for (int q4 = 0; q4 < 4; ++q4) tl[n++] = (unsigned char)(4 * own + q4);
                tln[0] = n; }
            __syncthreads();
            const int ntiles = tln[0];
            const int tq = 32 * wave + r, t = 256 * own + tq; const size_t row = (size_t)b * T + t;
            const unsigned mysel = msel[tq];
            FlashKV kv{(const bf16*)(F.ws + WS_KM_BF) + (size_t)b * T * 256 + hd * 64, (const bf16*)(F.ws + WS_VM_BF) + (size_t)b * T * 256 + hd * 64, 256, 256};
            auto maskf = [&](int tile) { const int blk = tile >> 2; return blk == own ? causal_word(t - 64 * tile) : (((mysel >> blk) & 1u) ? ~0ull : 0ull); };
            f32x16 o0, o1; float ls;
            flash_unit<64>(F.lds, kv, (const bf16*)(F.ws + WS_QM_BF) + row * 256 + hd * 64, 0.125f * 1.4426950408889634f, ntiles, maskf, o0, o1, ls);
            ls = xhalf_sum(ls);
            flash_store(Y + row * 1024 + hd * 64, o0, o1, ls > 0.f ? 1.0f / ls : 0.f, h2);
        }
    }
}
__device__ __forceinline__ void dsa_flash_phase(Frame& F) {
    const int tid = cur_tid(), wave = cur_wave(), lane = tid & 63, r = lane & 31, h2 = lane >> 5;
    bf16* Y = (bf16*)(F.ws + WS_H);
    const unsigned long long* BM = (const unsigned long long*)(F.ws + WS_DSAMASK);
    for (int pass = 0; pass < 2; ++pass) {
        for (int u0 = blockIdx.x; u0 < 256; u0 += F.G) {
            const int u = pass ? 511 - u0 : u0, tb = u >> 3, b = u & 7, hd = wave >> 1;
            const int t = 64 * tb + 32 * (wave & 1) + r; const size_t row = (size_t)b * T + t;
            LAS unsigned char* tl = F.lds + FL_TL;
            __syncthreads();
            if (tid < 64) tl[tid] = (unsigned char)tid;
            const int ntiles = tb + 1;
            FlashKV kv{(const bf16*)(F.ws + WS_KD) + (size_t)b * T * 64, (const bf16*)(F.ws + WS_VD) + (size_t)b * T * 64, 64, 64};
            const unsigned long long* bmrow = BM + row * 64;
            auto maskf = [&](int tile) { return bmrow[tile]; };
            f32x16 o0, o1; float ls;
            flash_unit<64>(F.lds, kv, (const bf16*)(F.ws + WS_QD) + row * 256 + hd * 64, 0.125f * 1.4426950408889634f, ntiles, maskf, o0, o1, ls);
            ls = xhalf_sum(ls);
            flash_store(Y + row * 1024 + 768 + hd * 64, o0, o1, ls > 0.f ? 1.0f / ls : 0.f, h2);
        }
    }
}
__device__ __forceinline__ void nsa_flash_phase(Frame& F) {
    const int tid = cur_tid(), wave = cur_wave(), lane = tid & 63, r = lane & 31, h2 = lane >> 5;
    bf16* Y = (bf16*)(F.ws + WS_H);
    const unsigned long long* NSEL = (const unsigned long long*)(F.ws + WS_NSEL); const bf16* OC = (const bf16*)(F.ws + WS_OC); const float* GWp = (const float*)(F.ws + WS_GW);
    LAS unsigned* orm = (LAS unsigned*)(F.lds + FL_ORM); LAS unsigned char* tl = F.lds + FL_TL; LAS int* tln = (LAS int*)(F.lds + FL_TLN);
    for (int pass = 0; pass < 2; ++pass) {
        for (int u0 = blockIdx.x; u0 < 256; u0 += F.G) {
            const int u = pass ? 511 - u0 : u0, tb = u >> 3, b = u & 7, hd = wave >> 1;
            const int t = 64 * tb + 32 * (wave & 1) + r; const size_t row = (size_t)b * T + t;
            const unsigned long long mysel = NSEL[row];
            __syncthreads();
            if (tid < 2) orm[tid] = 0u;
            __syncthreads();
            if (wave < 2) { __hip_atomic_fetch_or(orm, (unsigned)mysel, __ATOMIC_RELAXED, __HIP_MEMORY_SCOPE_WORKGROUP); __hip_atomic_fetch_or(orm + 1, (unsigned)(mysel >> 32), __ATOMIC_RELAXED, __HIP_MEMORY_SCOPE_WORKGROUP); }
            __syncthreads();
            if (tid == 0) { const unsigned long long om = (unsigned long long)orm[0] | ((unsigned long long)orm[1] << 32); int n = 0;
                for (int j = 0; j <= tb; ++j) if ((om >> j) & 1ull) tl[n++] = (unsigned char)j;
                tln[0] = n; }
            __syncthreads();
            const int nsel_tiles = tln[0];
            const bf16* qrow = (const bf16*)(F.ws + WS_QN) + row * 256 + hd * 64;
            const float* gp = GWp + row * 32 + hd * 3;
            const float g0 = sigmoid_f(gp[0]), g1 = sigmoid_f(gp[1]), g2 = sigmoid_f(gp[2]);
            LAS float* stash = (LAS float*)(F.lds + 49152) + wave * 2048 + lane;
            {
                FlashKV kv{(const bf16*)(F.ws + WS_KS) + (size_t)b * T * 64, (const bf16*)(F.ws + WS_VS) + (size_t)b * T * 64, 64, 64};
                auto maskf = [&](int tile) { return ((mysel >> tile) & 1ull) ? causal_word(t - 64 * tile) : 0ull; };
                f32x16 o0, o1; float ls;
                flash_unit<64>(F.lds, kv, qrow, 0.125f * 1.4426950408889634f, nsel_tiles, maskf, o0, o1, ls);
                ls = xhalf_sum(ls); const float sc = ls > 0.f ? g1 / ls : 0.f;
                const bf16* ocr = OC + row * 256 + hd * 64;
#pragma unroll
                for (int g = 0; g < 4; ++g) { const unsigned long long w0 = *(const unsigned long long*)(ocr + 8 * g + 4 * h2), w1 = *(const unsigned long long*)(ocr + 32 + 8 * g + 4 * h2);
                    stash[(4 * g) * 64] = sc * o0[4 * g] + g0 * __uint_as_float((unsigned)w0 << 16); stash[(4 * g + 1) * 64] = sc * o0[4 * g + 1] + g0 * __uint_as_float((unsigned)w0 & 0xffff0000u);
                    stash[(4 * g + 2) * 64] = sc * o0[4 * g + 2] + g0 * __uint_as_float((unsigned)(w0 >> 32) << 16); stash[(4 * g + 3) * 64] = sc * o0[4 * g + 3] + g0 * __uint_as_float((unsigned)(w0 >> 32) & 0xffff0000u);
                    stash[(16 + 4 * g) * 64] = sc * o1[4 * g] + g0 * __uint_as_float((unsigned)w1 << 16); stash[(16 + 4 * g + 1) * 64] = sc * o1[4 * g + 1] + g0 * __uint_as_float((unsigned)w1 & 0xffff0000u);
                    stash[(16 + 4 * g + 2) * 64] = sc * o1[4 * g + 2] + g0 * __uint_as_float((unsigned)(w1 >> 32) << 16); stash[(16 + 4 * g + 3) * 64] = sc * o1[4 * g + 3] + g0 * __uint_as_float((unsigned)(w1 >> 32) & 0xffff0000u); }
            }
            f32x16 a0, a1;
            {
                __syncthreads();
                const int t0 = tb >= 8 ? tb - 8 : 0;
                if (tid < 64) tl[tid] = (unsigned char)(t0 + tid);
                FlashKV kv{(const bf16*)(F.ws + WS_KW) + (size_t)b * T * 64, (const bf16*)(F.ws + WS_VW) + (size_t)b * T * 64, 64, 64};
                auto maskf = [&](int tile) { return causal_word(t - 64 * tile) & ~causal_word(t - 512 - 64 * tile); };
                f32x16 o0, o1; float ls;
                flash_unit<64>(F.lds, kv, qrow, 0.125f * 1.4426950408889634f, tb - t0 + 1, maskf, o0, o1, ls);
                ls = xhalf_sum(ls); const float sc = ls > 0.f ? g2 / ls : 0.f;
#pragma unroll
                for (int i = 0; i < 16; ++i) { a0[i] = sc * o0[i] + stash[i * 64]; a1[i] = sc * o1[i] + stash[(16 + i) * 64]; }
            }
            flash_store(Y + row * 1024 + 512 + hd * 64, a0, a1, 1.0f, h2);
        }
    }
}

__device__ __forceinline__ int hist_pick(LAS unsigned* hist, int& kk, const int lane) {
    const int h0 = (int)hist[4 * lane], h1 = (int)hist[4 * lane + 1], h2 = (int)hist[4 * lane + 2], h3 = (int)hist[4 * lane + 3];
    const int tot = (h0 + h1) + (h2 + h3); int incl = tot;
#pragma unroll
    for (int o = 1; o < 64; o <<= 1) { const int v = __shfl_down(incl, o); if (lane + o < 64) incl += v; }
    int run = incl - tot, found = -1, newk = 0;
    if (run < kk && run + h3 >= kk) { found = 4 * lane + 3; newk = kk - run; } run += h3;
    if (found < 0 && run < kk && run + h2 >= kk) { found = 4 * lane + 2; newk = kk - run; } run += h2;
    if (found < 0 && run < kk && run + h1 >= kk) { found = 4 * lane + 1; newk = kk - run; } run += h1;
    if (found < 0 && run < kk && run + h0 >= kk) { found = 4 * lane; newk = kk - run; }
    const unsigned long long ball = __ballot(found >= 0); const int src = __ffsll((long long)ball) - 1;
    const int bin = __shfl(found, src); kk = __shfl(newk, src);
    return bin;
}
__device__ __forceinline__ float unfkey(unsigned u) { return __uint_as_float((u & 0x80000000u) ? (u ^ 0x80000000u) : ~u); }
__device__ __forceinline__ void radix_select_write(LAS float* sc, LAS unsigned* hist, unsigned long long* bmrow, const int t, const int lane) {
    const int n = t + 1;
    if (n <= 256) { for (int k0 = 0; k0 < n; k0 += 64) if (lane == 0) bmrow[k0 >> 6] = causal_word(t - k0); return; }
#define RS_LOAD4(k0) float x_[4]; { _Pragma("unroll") for (int j_ = 0; j_ < 4; ++j_) { const float v_ = sc[(k0) + 64 * j_ + lane]; x_[j_] = (lane < n - (k0) - 64 * j_) ? v_ : -INFINITY; } }
    float mn = INFINITY, mx = -INFINITY;
    for (int k0 = 0; k0 < n; k0 += 256) { RS_LOAD4(k0);
#pragma unroll
        for (int j = 0; j < 4; ++j) { mx = fmaxf(mx, x_[j]); mn = fminf(mn, x_[j] > -INFINITY ? x_[j] : INFINITY); } }
    mn = -wave_max(-mn); mx = wave_max(mx);
    const float qs = mx > mn ? 255.99f / (mx - mn) : 1.0f, qo = -mn * qs;
#pragma unroll
    for (int k = 0; k < 4; ++k) hist[lane + 64 * k] = 0u;
    LDS_WAIT(); asm volatile("" ::: "memory");
#ifdef SEL_DUP_HIST
    for (int rep3_ = 0; rep3_ < 2; ++rep3_) {
#pragma unroll
    for (int k = 0; k < 4; ++k) hist[lane + 64 * k] = 0u;
    LDS_WAIT(); asm volatile("" ::: "memory");
#endif
    for (int k0 = 0; k0 < n; k0 += 256) { RS_LOAD4(k0);
#pragma unroll
        for (int j = 0; j < 4; ++j) { int q = (int)__builtin_fmaf(x_[j], qs, qo); q = q > 255 ? 255 : (q < 0 ? 0 : q); __hip_atomic_fetch_add(hist + q, 1u, __ATOMIC_RELAXED, __HIP_MEMORY_SCOPE_WORKGROUP); } }
    LDS_WAIT(); asm volatile("" ::: "memory");
#ifdef SEL_DUP_HIST
    }
#endif
    int kk = 256;
    const int B = hist_pick(hist, kk, lane);
    const int cntB = (int)hist[B];
    LDS_WAIT(); asm volatile("" ::: "memory");
#ifdef FORCE_FALLBACK
    if (cntB > 0) {
#else
    if (cntB > 128) {
#endif
        unsigned prefix = 0u, pmask = 0u;
#pragma unroll 1
        for (int pass = 0; pass < 4; ++pass) {
            const int shift = 24 - 8 * pass;
#pragma unroll
            for (int k = 0; k < 4; ++k) hist[lane + 64 * k] = 0u;
            LDS_WAIT(); asm volatile("" ::: "memory");
            for (int k0 = 0; k0 < n; k0 += 256) { RS_LOAD4(k0);
#pragma unroll
                for (int j = 0; j < 4; ++j) { int q = (int)__builtin_fmaf(x_[j], qs, qo); q = q > 255 ? 255 : (q < 0 ? 0 : q);
                    if (q == B) { const unsigned u = fkey(x_[j]); if ((u & pmask) == prefix) __hip_atomic_fetch_add(hist + ((u >> shift) & 255u), 1u, __ATOMIC_RELAXED, __HIP_MEMORY_SCOPE_WORKGROUP); } } }
            LDS_WAIT(); asm volatile("" ::: "memory");
            const int bin = hist_pick(hist, kk, lane);
            prefix |= (unsigned)bin << shift; pmask |= 255u << shift;
            LDS_WAIT(); asm volatile("" ::: "memory");
        }
        int eqseen = 0;
        for (int k0 = 0; k0 < n; k0 += 256) { RS_LOAD4(k0);
#pragma unroll
            for (int j = 0; j < 4; ++j) { int q = (int)__builtin_fmaf(x_[j], qs, qo); q = q > 255 ? 255 : (q < 0 ? 0 : q);
                const unsigned u = fkey(x_[j]); const bool valid = x_[j] > -INFINITY;
                const bool gt = valid && (q > B || (q == B && u > prefix)), eq = valid && q == B && u == prefix;
                const unsigned long long be = __ballot(eq); const bool sel = gt || (eq && (eqseen + mbcnt64(be)) < kk);
                const unsigned long long bs = __ballot(sel);
                if (lane == 0 && k0 + 64 * j < n) bmrow[(k0 >> 6) + j] = bs;
                eqseen += __popcll(be); } }
        return;
    }
    LAS unsigned* bmw = hist + 256;
    LAS unsigned* cand = (LAS unsigned*)sc;
    int ncand = 0;
    for (int k0 = 0; k0 < n; k0 += 256) { RS_LOAD4(k0);
        asm volatile("" ::: "memory");
#pragma unroll
        for (int j = 0; j < 4; ++j) { int q = (int)__builtin_fmaf(x_[j], qs, qo); q = q > 255 ? 255 : (q < 0 ? 0 : q);
            const bool valid = x_[j] > -INFINITY; const bool gt = valid && q > B, inb = valid && q == B;
            const unsigned long long bg = __ballot(gt), bi = __ballot(inb);
            if (lane == 0) { bmw[2 * ((k0 >> 6) + j)] = (unsigned)bg; bmw[2 * ((k0 >> 6) + j) + 1] = (unsigned)(bg >> 32); }
            if (inb) { const int c = ncand + mbcnt64(bi); cand[2 * c] = (unsigned)(k0 + 64 * j + lane); cand[2 * c + 1] = fkey(x_[j]); }
            ncand += __popcll(bi); }
        LDS_WAIT(); asm volatile("" ::: "memory"); }
#undef RS_LOAD4
    {
        const int c0 = lane, c1 = lane + 64;
        const unsigned k0_ = c0 < ncand ? cand[2 * c0 + 1] : 0u, k1_ = c1 < ncand ? cand[2 * c1 + 1] : 0u;
        const unsigned i0_ = c0 < ncand ? cand[2 * c0] : 0u, i1_ = c1 < ncand ? cand[2 * c1] : 0u;
        int r0 = 0, r1 = 0;
#ifdef SEL_DUP_RANK
        for (int rep3_ = 0; rep3_ < 2; ++rep3_) { r0 = 0; r1 = 0;
#endif
        for (int j = 0; j < ncand; ++j) { const unsigned kj = cand[2 * j + 1];
            r0 += (kj > k0_ || (kj == k0_ && j < c0)) ? 1 : 0; r1 += (kj > k1_ || (kj == k1_ && j < c1)) ? 1 : 0; }
#ifdef SEL_DUP_RANK
        asm volatile("" : "+v"(r0), "+v"(r1)); }
#endif
        if (c0 < ncand && r0 < kk) __hip_atomic_fetch_or(bmw + 2 * (i0_ >> 6) + ((i0_ >> 5) & 1u), 1u << (i0_ & 31u), __ATOMIC_RELAXED, __HIP_MEMORY_SCOPE_WORKGROUP);
        if (c1 < ncand && r1 < kk) __hip_atomic_fetch_or(bmw + 2 * (i1_ >> 6) + ((i1_ >> 5) & 1u), 1u << (i1_ & 31u), __ATOMIC_RELAXED, __HIP_MEMORY_SCOPE_WORKGROUP);
    }
    LDS_WAIT(); asm volatile("" ::: "memory");
    if (lane < ((n + 63) >> 6)) bmrow[lane] = (unsigned long long)bmw[2 * lane] | ((unsigned long long)bmw[2 * lane + 1] << 32);
    LDS_WAIT(); asm volatile("" ::: "memory");
}
__device__ __forceinline__ void split8(const f32x4 a, const f32x4 b, bf16x8& hi, bf16x8& lo) {
    v4u h, l;
    h.x = pg8::cvt_pk_bf16(a.x, a.y); h.y = pg8::cvt_pk_bf16(a.z, a.w); h.z = pg8::cvt_pk_bf16(b.x, b.y); h.w = pg8::cvt_pk_bf16(b.z, b.w);
    l.x = pg8::cvt_pk_bf16(a.x - __uint_as_float(h.x << 16), a.y - __uint_as_float(h.x & 0xffff0000u)); l.y = pg8::cvt_pk_bf16(a.z - __uint_as_float(h.y << 16), a.w - __uint_as_float(h.y & 0xffff0000u));
    l.z = pg8::cvt_pk_bf16(b.x - __uint_as_float(h.z << 16), b.y - __uint_as_float(h.z & 0xffff0000u)); l.w = pg8::cvt_pk_bf16(b.z - __uint_as_float(h.w << 16), b.w - __uint_as_float(h.w & 0xffff0000u));
    hi = __builtin_bit_cast(bf16x8, h); lo = __builtin_bit_cast(bf16x8, l);
}
__device__ __forceinline__ void dsa_select_phase(Frame& F) {
    const int tid = cur_tid(), wave = cur_wave(), lane = tid & 63, r = lane & 31, hh = lane >> 5;
    const float* IQ = (const float*)(F.ws + WS_IQ); const float* IK = (const float*)(F.ws + WS_IK); const float* GWp = (const float*)(F.ws + WS_GW);
    LAS float* sc = (LAS float*)(F.lds + RING_OFF);
    LAS unsigned* hist = (LAS unsigned*)(F.lds + XTRA_OFF + wave * XTRA_WAVE);
    f32x4 araw[2][2][2], wraw[2][4];
    auto load_a = [&](int pass_, int u0_) {
        const int b_ = u0_ >> 8, w8_ = u0_ & 255, tb8_ = pass_ ? 511 - w8_ : w8_; const size_t rowb = (size_t)b_ * T + 8 * tb8_;
#pragma unroll
        for (int gq = 0; gq < 2; ++gq) {
            const float* qp = IQ + (rowb + 4 * gq + (r >> 3)) * 256 + (r & 7) * 32 + 8 * hh;
#pragma unroll
            for (int ks = 0; ks < 2; ++ks) { araw[gq][ks][0] = *(const f32x4*)(qp + 16 * ks); araw[gq][ks][1] = *(const f32x4*)(qp + 16 * ks + 4); }
#pragma unroll
            for (int tk = 0; tk < 4; ++tk) wraw[gq][tk] = *(const f32x4*)(GWp + (rowb + 4 * gq + tk) * 32 + 12 + 4 * hh);
        }
    };
    if ((int)blockIdx.x < 2048) load_a(0, (int)blockIdx.x);
    for (int pass = 0; pass < 2; ++pass) {
        for (int u0 = blockIdx.x; u0 < 2048; u0 += F.G) {
            const int b = u0 >> 8, w8 = u0 & 255, tb8 = pass ? 511 - w8 : w8, t0 = 8 * tb8, nmax = t0 + 8;
            const size_t base = (size_t)b * T;
            bf16x8 ahi[2][2], alo[2][2]; float iw[2][4][4];
#pragma unroll
            for (int gq = 0; gq < 2; ++gq) {
#pragma unroll
                for (int ks = 0; ks < 2; ++ks) split8(araw[gq][ks][0], araw[gq][ks][1], ahi[gq][ks], alo[gq][ks]);
#pragma unroll
                for (int tk = 0; tk < 4; ++tk) { const f32x4 w4 = wraw[gq][tk]; iw[gq][tk][0] = w4.x; iw[gq][tk][1] = w4.y; iw[gq][tk][2] = w4.z; iw[gq][tk][3] = w4.w; }
            }
            const int nkb = (nmax + 31) >> 5;
            v4u nbA[4], nbB[4];
#define DS_LOADB(dst, kb_) do { const GAS unsigned* kp_ = (const GAS unsigned*)(IK + (base + 32 * (kb_) + r) * 32 + 8 * hh); dst[0] = *(const GAS v4u*)kp_; dst[1] = *(const GAS v4u*)(kp_ + 4); dst[2] = *(const GAS v4u*)(kp_ + 16); dst[3] = *(const GAS v4u*)(kp_ + 20); } while (0)
#define DS_UNPK(a, b, hi_, lo_) do { v4u h_, l_; h_.x = __builtin_amdgcn_perm(a.y, a.x, 0x05040100u); l_.x = __builtin_amdgcn_perm(a.y, a.x, 0x07060302u); h_.y = __builtin_amdgcn_perm(a.w, a.z, 0x05040100u); l_.y = __builtin_amdgcn_perm(a.w, a.z, 0x07060302u); \
            h_.z = __builtin_amdgcn_perm(b.y, b.x, 0x05040100u); l_.z = __builtin_amdgcn_perm(b.y, b.x, 0x07060302u); h_.w = __builtin_amdgcn_perm(b.w, b.z, 0x05040100u); l_.w = __builtin_amdgcn_perm(b.w, b.z, 0x07060302u); \
            hi_ = __builtin_bit_cast(bf16x8, h_); lo_ = __builtin_bit_cast(bf16x8, l_); } while (0)
#ifdef DSA_DUP_SCORE
            for (int rep2_ = 0; rep2_ < 2; ++rep2_) {
#endif
            if (wave < nkb) DS_LOADB(nbA, wave);
            if (wave + 8 < nkb) DS_LOADB(nbB, wave + 8);
            for (int kb = wave; kb < nkb; kb += 16) {
                const bool hasB = kb + 8 < nkb;
                bf16x8 bhiA[2], bloA[2], bhiB[2], bloB[2];
                DS_UNPK(nbA[0], nbA[1], bhiA[0], bloA[0]); DS_UNPK(nbA[2], nbA[3], bhiA[1], bloA[1]);
                if (hasB) { DS_UNPK(nbB[0], nbB[1], bhiB[0], bloB[0]); DS_UNPK(nbB[2], nbB[3], bhiB[1], bloB[1]); }
                else { bhiB[0] = bhiA[0]; bhiB[1] = bhiA[1]; bloB[0] = bloA[0]; bloB[1] = bloA[1]; }
                if (kb + 16 < nkb) DS_LOADB(nbA, kb + 16);
                if (kb + 24 < nkb) DS_LOADB(nbB, kb + 24);
                f32x16 cA0, cA1, cB0, cB1;
#pragma unroll
                for (int i = 0; i < 16; ++i) { cA0[i] = 0.f; cA1[i] = 0.f; cB0[i] = 0.f; cB1[i] = 0.f; }
#pragma unroll
                for (int ks = 0; ks < 2; ++ks) {
                    cA0 = __builtin_amdgcn_mfma_f32_32x32x16_bf16(ahi[0][ks], bhiA[ks], cA0, 0, 0, 0); cA1 = __builtin_amdgcn_mfma_f32_32x32x16_bf16(ahi[1][ks], bhiA[ks], cA1, 0, 0, 0);
                    cB0 = __builtin_amdgcn_mfma_f32_32x32x16_bf16(ahi[0][ks], bhiB[ks], cB0, 0, 0, 0); cB1 = __builtin_amdgcn_mfma_f32_32x32x16_bf16(ahi[1][ks], bhiB[ks], cB1, 0, 0, 0);
                    cA0 = __builtin_amdgcn_mfma_f32_32x32x16_bf16(ahi[0][ks], bloA[ks], cA0, 0, 0, 0); cA1 = __builtin_amdgcn_mfma_f32_32x32x16_bf16(ahi[1][ks], bloA[ks], cA1, 0, 0, 0);
                    cB0 = __builtin_amdgcn_mfma_f32_32x32x16_bf16(ahi[0][ks], bloB[ks], cB0, 0, 0, 0); cB1 = __builtin_amdgcn_mfma_f32_32x32x16_bf16(ahi[1][ks], bloB[ks], cB1, 0, 0, 0);
                    cA0 = __builtin_amdgcn_mfma_f32_32x32x16_bf16(alo[0][ks], bhiA[ks], cA0, 0, 0, 0); cA1 = __builtin_amdgcn_mfma_f32_32x32x16_bf16(alo[1][ks], bhiA[ks], cA1, 0, 0, 0);
                    cB0 = __builtin_amdgcn_mfma_f32_32x32x16_bf16(alo[0][ks], bhiB[ks], cB0, 0, 0, 0); cB1 = __builtin_amdgcn_mfma_f32_32x32x16_bf16(alo[1][ks], bhiB[ks], cB1, 0, 0, 0);
                }
#define DS_EPI(c, gq, kb_) do { float s4_[4]; _Pragma("unroll") for (int tk = 0; tk < 4; ++tk) { \
                        const float v_ = (iw[gq][tk][0] * fmaxf(c[4 * tk], 0.f) + iw[gq][tk][1] * fmaxf(c[4 * tk + 1], 0.f)) + (iw[gq][tk][2] * fmaxf(c[4 * tk + 2], 0.f) + iw[gq][tk][3] * fmaxf(c[4 * tk + 3], 0.f)); \
                        s4_[tk] = xhalf_sum(v_) * 0.0625f + 0.0f; } \
                    LAS float* dst_ = sc + (4 * (gq) + 2 * hh) * 4096 + 32 * (kb_) + r; dst_[0] = hh ? s4_[2] : s4_[0]; dst_[4096] = hh ? s4_[3] : s4_[1]; } while (0)
                DS_EPI(cA0, 0, kb); DS_EPI(cA1, 1, kb);
                if (hasB) { DS_EPI(cB0, 0, kb + 8); DS_EPI(cB1, 1, kb + 8); }
#undef DS_EPI
            }
#ifdef DSA_DUP_SCORE
            }
#endif
#undef DS_LOADB
#undef DS_UNPK
            { int pn_ = pass, un_ = u0 + F.G; if (un_ >= 2048) { pn_ = pass + 1; un_ = blockIdx.x; } if (pn_ < 2 && un_ < 2048) load_a(pn_, un_); }
            __syncthreads();
#ifdef DSA_DUP_SEL
            for (int rep2_ = 0; rep2_ < 2; ++rep2_)
#endif
            radix_select_write(sc + wave * 4096, hist, (unsigned long long*)(F.ws + WS_DSAMASK) + (base + t0 + wave) * 64, t0 + wave, lane);
            __syncthreads();
        }
    }
}

constexpr int NS_K = 0, NS_KP = 144, NS_V = 256 * NS_KP, NS_VP = 520, NS_IMP = NS_V + 64 * NS_VP, NS_IP = 68, NS_END = NS_IMP + 64 * NS_IP * 4;
static_assert(NS_END <= RING_BYTES, "nsa select LDS map");
__device__ __forceinline__ void nsa_select_phase(Frame& F) {
    const int tid = cur_tid(), wave = cur_wave(), lane = tid & 63, r = lane & 31, hh = lane >> 5;
    LAS unsigned char* lds = F.lds;
    LAS float* imp = (LAS float*)(lds + NS_IMP);
    for (int pass = 0; pass < 2; ++pass) {
        for (int u0 = blockIdx.x; u0 < 256; u0 += F.G) {
            const int u = pass ? 511 - u0 : u0, tb = u >> 3, b = u & 7;
            __syncthreads();
            {
                const bf16* Kc = (const bf16*)(F.ws + WS_KCMPB) + (size_t)b * 256 * 64; const bf16* Vc = (const bf16*)(F.ws + WS_VCMPB) + (size_t)b * 256 * 64;
#pragma unroll
                for (int j = 0; j < 4; ++j) { const int ch = tid + 512 * j, row = ch >> 3, c8 = ch & 7;
                    *(LAS v4u*)(lds + NS_K + row * NS_KP + 16 * c8) = *(const v4u*)(Kc + row * 64 + 8 * c8);
                    const v4u vv = *(const v4u*)(Vc + row * 64 + 8 * c8);
                    LAS unsigned short* vt = (LAS unsigned short*)(lds + NS_V + (8 * c8) * NS_VP) + row;
                    vt[0 * (NS_VP / 2)] = (unsigned short)(vv.x & 0xffffu); vt[1 * (NS_VP / 2)] = (unsigned short)(vv.x >> 16); vt[2 * (NS_VP / 2)] = (unsigned short)(vv.y & 0xffffu); vt[3 * (NS_VP / 2)] = (unsigned short)(vv.y >> 16);
                    vt[4 * (NS_VP / 2)] = (unsigned short)(vv.z & 0xffffu); vt[5 * (NS_VP / 2)] = (unsigned short)(vv.z >> 16); vt[6 * (NS_VP / 2)] = (unsigned short)(vv.w & 0xffffu); vt[7 * (NS_VP / 2)] = (unsigned short)(vv.w >> 16); }
                for (int i = tid; i < 64 * NS_IP; i += 512) imp[i] = 0.f;
            }
            __syncthreads();
            const int tl_ = 8 * wave + (r >> 2), hd = r & 3, t = 64 * tb + tl_; const size_t row = (size_t)b * T + t;
            const bf16* qrow = (const bf16*)(F.ws + WS_QN) + row * 256 + hd * 64;
            bf16x8 qf[4];
#pragma unroll
            for (int ks = 0; ks < 4; ++ks) qf[ks] = *(const bf16x8*)(qrow + 16 * ks + 8 * hh);
            const int nmax = (t - 31) >> 4;
            const int ntile = ((4 * tb + 2) >> 6) + 1;
            const float sc2 = 0.125f * 1.4426950408889634f;
            auto scores = [&](int tile, f32x16& p0, f32x16& p1) {
#pragma unroll
                for (int i = 0; i < 16; ++i) { p0[i] = 0.f; p1[i] = 0.f; }
                const LAS unsigned char* Kb = lds + NS_K + (64 * tile) * NS_KP;
#pragma unroll
                for (int ks = 0; ks < 4; ++ks) {
                    const bf16x8 a0 = *(const LAS bf16x8*)(Kb + r * NS_KP + (16 * ks + 8 * hh) * 2), a1 = *(const LAS bf16x8*)(Kb + (32 + r) * NS_KP + (16 * ks + 8 * hh) * 2);
                    p0 = __builtin_amdgcn_mfma_f32_32x32x16_bf16(a0, qf[ks], p0, 0, 0, 0);
                    p1 = __builtin_amdgcn_mfma_f32_32x32x16_bf16(a1, qf[ks], p1, 0, 0, 0);
                }
            };
            float m = -1e30f, l = 0.f;
            for (int tile = 0; tile < ntile; ++tile) {
                const unsigned long long word = causal_word(nmax - 64 * tile);
                f32x16 p0, p1; scores(tile, p0, p1);
                const unsigned wlo = (unsigned)word >> (4 * hh), whi = (unsigned)(word >> 32) >> (4 * hh);
                float mx = -1e30f;
#pragma unroll
                for (int i = 0; i < 16; ++i) { const int bit = (i & 3) + 8 * (i >> 2);
                    p0[i] = ((wlo >> bit) & 1u) ? p0[i] * sc2 : -1e30f; p1[i] = ((whi >> bit) & 1u) ? p1[i] * sc2 : -1e30f; mx = fmaxf(mx, fmaxf(p0[i], p1[i])); }
                mx = xhalf_max(mx);
                const float mn = fmaxf(m, mx), alpha = __builtin_amdgcn_exp2f(m - mn); m = mn;
                float ps = 0.f;
#pragma unroll
                for (int i = 0; i < 16; ++i) { const int bit = (i & 3) + 8 * (i >> 2);
                    ps += (((wlo >> bit) & 1u) ? __builtin_amdgcn_exp2f(p0[i] - mn) : 0.f) + (((whi >> bit) & 1u) ? __builtin_amdgcn_exp2f(p1[i] - mn) : 0.f); }
                l = l * alpha + ps;
            }
            l = xhalf_sum(l);
            const float inv = l > 0.f ? 1.0f / l : 0.f;
            f32x16 o0, o1;
#pragma unroll
            for (int i = 0; i < 16; ++i) { o0[i] = 0.f; o1[i] = 0.f; }
            float carry = 0.f;
            for (int tile = 0; tile < ntile; ++tile) {
                const unsigned long long word = causal_word(nmax - 64 * tile);
                f32x16 p0, p1; scores(tile, p0, p1);
                const unsigned wlo = (unsigned)word >> (4 * hh), whi = (unsigned)(word >> 32) >> (4 * hh);
#pragma unroll
                for (int i = 0; i < 16; ++i) { const int bit = (i & 3) + 8 * (i >> 2);
                    p0[i] = ((wlo >> bit) & 1u) ? __builtin_amdgcn_exp2f(p0[i] * sc2 - m) * inv : 0.f; p1[i] = ((whi >> bit) & 1u) ? __builtin_amdgcn_exp2f(p1[i] * sc2 - m) * inv : 0.f; }
#pragma unroll
                for (int blk = 0; blk < 2; ++blk) {
                    float tot[4];
#pragma unroll
                    for (int g = 0; g < 4; ++g) {
                        const float a = blk ? p1[4 * g] : p0[4 * g], b1 = blk ? p1[4 * g + 1] : p0[4 * g + 1], c1 = blk ? p1[4 * g + 2] : p0[4 * g + 2], d1 = blk ? p1[4 * g + 3] : p0[4 * g + 3];
                        const float mainv = (a + b1) + (c1 + d1);
                        const float recv = xhalf_other(d1, hh);
                        const float below = hh ? recv : carry;
                        tot[g] = mainv + below;
                        carry = recv;
                    }
#pragma unroll
                    for (int g = 0; g < 4; ++g) { float v = tot[g]; v += dpp_f<0xB1>(v); v += dpp_f<0x4E>(v);
                        if (hd == 0) imp[tl_ * NS_IP + 16 * tile + 8 * blk + 2 * g + hh] = v; }
                }
                bf16x8 pf[4];
#pragma unroll
                for (int s = 0; s < 4; ++s) { v4u w;
                    if (s < 2) { w.x = pg8::cvt_pk_bf16(p0[8 * s], p0[8 * s + 1]); w.y = pg8::cvt_pk_bf16(p0[8 * s + 2], p0[8 * s + 3]); w.z = pg8::cvt_pk_bf16(p0[8 * s + 4], p0[8 * s + 5]); w.w = pg8::cvt_pk_bf16(p0[8 * s + 6], p0[8 * s + 7]); }
                    else { const int s2 = s - 2; w.x = pg8::cvt_pk_bf16(p1[8 * s2], p1[8 * s2 + 1]); w.y = pg8::cvt_pk_bf16(p1[8 * s2 + 2], p1[8 * s2 + 3]); w.z = pg8::cvt_pk_bf16(p1[8 * s2 + 4], p1[8 * s2 + 5]); w.w = pg8::cvt_pk_bf16(p1[8 * s2 + 6], p1[8 * s2 + 7]); }
                    pf[s] = __builtin_bit_cast(bf16x8, w); }
#pragma unroll
                for (int s = 0; s < 4; ++s) {
                    const int kb = 64 * tile + 32 * (s >> 1) + 16 * (s & 1) + 4 * hh;
#pragma unroll
                    for (int db = 0; db < 2; ++db) {
                        const LAS unsigned char* vp_ = lds + NS_V + (32 * db + r) * NS_VP + kb * 2;
                        typedef unsigned u32x2v __attribute__((ext_vector_type(2)));
                        const u32x2v lo = *(const LAS u32x2v*)vp_, hi = *(const LAS u32x2v*)(vp_ + 16);
                        v4u aw; aw.x = lo.x; aw.y = lo.y; aw.z = hi.x; aw.w = hi.y;
                        const bf16x8 a = __builtin_bit_cast(bf16x8, aw);
                        if (db == 0) o0 = __builtin_amdgcn_mfma_f32_32x32x16_bf16(a, pf[s], o0, 0, 0, 0);
                        else o1 = __builtin_amdgcn_mfma_f32_32x32x16_bf16(a, pf[s], o1, 0, 0, 0);
                    }
                }
            }
            flash_store((bf16*)(F.ws + WS_OC) + row * 256 + hd * 64, o0, o1, 1.0f, hh);
            LDS_WAIT(); asm volatile("" ::: "memory");
            for (int k = 0; k < 8; ++k) {
                const int tk = 64 * tb + 8 * wave + k, own = tk >> 6;
                const float iv = imp[(8 * wave + k) * NS_IP + lane];
                const bool causal = lane <= own, forced = causal && (lane == 0 || lane >= own - 1);
                const float val = forced ? 1e4f : (causal ? iv : -INFINITY);
                const unsigned kv_ = fkey(val); const unsigned klo = (kv_ << 6) | (unsigned)(63 - lane), khi = kv_ >> 26;
                int rank = 0;
#pragma unroll
                for (int j = 0; j < 64; ++j) { const unsigned jlo = (unsigned)__builtin_amdgcn_readlane((int)klo, j), jhi = (unsigned)__builtin_amdgcn_readlane((int)khi, j);
                    rank += (jhi > khi || (jhi == khi && jlo > klo)) ? 1 : 0; }
                const unsigned long long selm = __ballot(causal && rank < 16);
                if (lane == 0) ((unsigned long long*)(F.ws + WS_NSEL))[(size_t)b * T + tk] = selm;
            }
        }
    }
}
#ifndef PHMASK
#define PHMASK 0xFFFFFFFFu
#endif
#define EN(b) ((PHMASK >> (b)) & 1u)
#ifndef DUPMASK
#define DUPMASK 0u
#endif
#define REP(b) for (int rep_ = 0; rep_ < (((DUPMASK >> (b)) & 1u) ? 2 : 1); ++rep_)
__global__ void __launch_bounds__(NWAVES * 64, 2) fwd_kernel(Args args) {
    extern __shared__ __attribute__((aligned(16))) unsigned char lds[];
    Frame F;
    F.lds = (LAS unsigned char*)lds;
    F.MISC = (volatile LAS unsigned*)(F.lds + MISC_OFF);
    F.G = gridDim.x;
    F.ws = args.ws; F.ctl = (gu32*)(args.ws + WS_CTL); F.out = args.out;
    F.A = &args;
    for (int u = threadIdx.x; u < (XTRA_OFF - LDSCTL_OFF) / 4; u += NWAVES * 64) ((LAS unsigned*)(F.lds + LDSCTL_OFF))[u] = 0u;
    __syncthreads();
    XcdBarrier bar = xcd_barrier_post((unsigned*)(F.ctl + CW_BAR), F.MISC + 8);
#ifdef PHASE_RANGES
    const int lo = args.ph_lo, hi = args.ph_hi;
#endif
#ifdef PHASE_RANGES
#define IN(k) (lo <= (k) && (k) < hi)
#else
#define IN(k) true
#endif
#ifdef DUP_BAR
#define SEAM(k) do { if (IN(k) && IN((k) + 1)) { xcd_barrier(bar); xcd_barrier(bar); } } while (0)
#else
#define SEAM(k) do { if (IN(k) && IN((k) + 1)) xcd_barrier(bar); } while (0)
#endif
    unsigned char* ws = F.ws;
    bf16 *H, *HID; const float *cs64, *cs32, *ada;

    if (EN(0) && IN(0)) REP(0) p0_prologue(F);
    SEAM(0);
    int ph = 1;
    auto half_layer = [&](const int s) __attribute__((always_inline)) {
        const int l = s >> 1, second = s & 1;
        { unsigned char* w_ = args.ws; asm volatile("" : "+s"(w_)); ws = w_; F.ws = w_; }
        H = (bf16*)(ws + WS_H); HID = (bf16*)(ws + WS_HID); cs64 = (const float*)(ws + WS_CS64); cs32 = (const float*)(ws + WS_CS32); ada = (const float*)(ws + WS_ADA);
        const unsigned char* wl = ws + WS_WTS + (size_t)l * WTS_LAYER;
        const float* adal = ada + (size_t)l * 8 * 9216;
        const float* xsrc = (s == 0) ? args.in[I_X] : F.out;
        if (EN(1) && IN(ph)) REP(1) norm_mod_phase(F, xsrc, args.in[second ? I_F2N : I_F1N] + l * D, adal + (second ? 6 : 0) * 1024, adal + (second ? 7 : 1) * 1024, H);
        SEAM(ph); ++ph;
        if (EN(2) && IN(ph)) REP(2) {
            pg8::Gemm g{H, (const bf16*)(wl + (second ? WO_GU2 : WO_GU1)), M, NGU, D}; pg8::StaticOrder S; S.init(M, NGU, F.G, (int)blockIdx.x);
            pg8::EpiSwiGLU E{HID, FF};
            pg8::gemm_phase<pg8::EpiSwiGLU, pg8::StaticOrder, true, true>(F.lds + RING_OFF, g, S, E);
        }
        SEAM(ph); ++ph;
        if (EN(3) && IN(ph)) REP(3) {
            pg8::Gemm g{HID, (const bf16*)(wl + (second ? WO_D2 : WO_D1)), M, D, FF}; pg8::StaticOrder S; S.init(M, D, F.G, (int)blockIdx.x);
            pg8::EpiResid E{rep_ ? F.out : xsrc, F.out, adal + (second ? 8 : 2) * 1024, rep_ ? 0.f : 0.5f};
            pg8::gemm_phase<pg8::EpiResid, pg8::StaticOrder, true, true>(F.lds + RING_OFF, g, S, E);
        }
        SEAM(ph); ++ph;
        if (second) return;
        if (EN(4) && IN(ph)) REP(4) norm_mod_phase(F, F.out, args.in[I_MIXN] + l * D, adal + 3 * 1024, adal + 4 * 1024, H);
        SEAM(ph); ++ph;
        if (EN(5) && IN(ph)) REP(5) {
            pg8::Gemm g{H, (const bf16*)(wl + WO_IN), M, NINP, D}; pg8::StaticOrder S; S.init(M, NINP, F.G, (int)blockIdx.x);
            pg8::EpiProj<WinDesc> E{WinDesc{ws}, cs64, cs32, nullptr};
            pg8::gemm_phase<pg8::EpiProj<WinDesc>, pg8::StaticOrder, true, true>(F.lds + RING_OFF, g, S, E);
        }
        SEAM(ph); ++ph;
        if (EN(6) && IN(ph)) REP(6) {
            m1_phase(F, l);
            { int kq = 2048; asm volatile("" : "+s"(kq)); pg8::Gemm g{(const bf16*)(ws + WS_KC), (const bf16*)(wl + WO_C1K), 2048, 256, kq, 1024}; pg8::RangeOrder S{8, 0};
              pg8::EpiCmpH E{(float*)(ws + WS_CMPH), (const float*)(ws + WS_CMPB) + (l * 2 + 0) * 256};
              pg8::gemm_phase<pg8::EpiCmpH, pg8::RangeOrder, false, true>(F.lds + RING_OFF, g, S, E); }
            { int kq = 2048; asm volatile("" : "+s"(kq)); pg8::Gemm g{(const bf16*)(ws + WS_VC), (const bf16*)(wl + WO_C1V), 2048, 256, kq, 1024}; pg8::RangeOrder S{8, 8};
              pg8::EpiCmpH E{(float*)(ws + WS_CMPH) + (size_t)8 * 256 * 256, (const float*)(ws + WS_CMPB) + (l * 2 + 1) * 256};
              pg8::gemm_phase<pg8::EpiCmpH, pg8::RangeOrder, false, true>(F.lds + RING_OFF, g, S, E); }
        }
        SEAM(ph); ++ph;
        if (IN(ph)) {
            if (EN(7)) REP(7) { int kq = 256; asm volatile("" : "+s"(kq)); pg8::Gemm g{(const bf16*)(ws + WS_CQ), (const bf16*)(wl + WO_UQ), M, 512, kq}; pg8::StaticOrder S; S.init(M, 512, F.G, (int)blockIdx.x);
              pg8::EpiProj<MlaQDesc> E{MlaQDesc{ws}, cs64, cs32, (const float*)(ws + WS_RSTDQ)};
              pg8::gemm_phase<pg8::EpiProj<MlaQDesc>, pg8::StaticOrder, true, true>(F.lds + RING_OFF, g, S, E); }
            if (EN(8)) REP(7) { int kq = 128; asm volatile("" : "+s"(kq)); pg8::Gemm g{(const bf16*)(ws + WS_CKV), (const bf16*)(wl + WO_UKV), M, 512, kq}; pg8::StaticOrder S; S.init(M, 512, F.G, (int)blockIdx.x);
              pg8::EpiProj<MlaKvDesc> E{MlaKvDesc{ws}, cs64, cs32, (const float*)(ws + WS_RSTDKV)};
              pg8::gemm_phase<pg8::EpiProj<MlaKvDesc>, pg8::StaticOrder, true, true>(F.lds + RING_OFF, g, S, E); }
            if (EN(9)) REP(9) cmp2_phase(F, l);
#ifdef FLASH_DSA
            if (EN(10)) REP(10) dsa_select_phase(F);
#else
            if (EN(10)) REP(10) dsa_tokens_phase(F);
#endif
        }
        SEAM(ph); ++ph;
#ifdef FLASH_NSA
        if (IN(ph)) { if (EN(13)) REP(13) nsa_select_phase(F); }
        SEAM(ph); ++ph;
#endif
        if (IN(ph)) {
#ifdef FLASH_MOBA
            if (EN(11)) REP(11) moba_flash_phase(F);
#else
            if (EN(11)) moba_rows_phase(F);
#endif
#ifdef FLASH_MLA
            if (EN(12)) REP(12) mla_flash_phase(F);
#else
            if (EN(12)) mla_rows_phase(F);
#endif
#ifdef FLASH_NSA
            if (EN(13)) REP(14) nsa_flash_phase(F);
#else
            if (EN(13)) nsa_tokens_phase(F);
#endif
#ifdef FLASH_DSA
            if (EN(10)) REP(15) dsa_flash_phase(F);
#endif
        }
        SEAM(ph); ++ph;
        if (EN(14) && IN(ph)) group_norm_phase(F, H, args.in[I_GN] + l * 1024);
        SEAM(ph); ++ph;
        if (EN(15) && IN(ph)) REP(16) {
            pg8::Gemm g{H, (const bf16*)(wl + WO_OUT), M, D, D}; pg8::StaticOrder S; S.init(M, D, F.G, (int)blockIdx.x);
            pg8::EpiResid E{F.out, F.out, adal + 5 * 1024, rep_ ? 0.f : 1.0f};
            pg8::gemm_phase<pg8::EpiResid, pg8::StaticOrder, true, true>(F.lds + RING_OFF, g, S, E);
        }
        SEAM(ph); ++ph;
    };
    half_layer(0); half_layer(1);
#ifdef DUP_LAYER0
    half_layer(0); half_layer(1);
#endif
    half_layer(2); half_layer(3);
    if (EN(16) && IN(ph)) final_norm_phase(F, F.out, args.in[I_FINN]);
#undef IN
#undef SEAM
}
#ifdef FLASH_NSA
constexpr int N_PHASES = 1 + 4 * 3 + 2 * 8 + 1;
#else
constexpr int N_PHASES = 1 + 4 * 3 + 2 * 7 + 1;
#endif

extern "C" void kernel_launch(void* const* d_in, const int* in_sizes, int n_in, void* d_out, int out_size, void* d_ws, size_t ws_size, hipStream_t stream) {
    static int grid = 0;
    if (grid == 0) {
        if (n_in != 28 || in_sizes[0] != M * D || out_size != M * D || ws_size < WS_END) { fprintf(stderr, "kernel_launch: unexpected problem shape (n_in %d, in0 %d, out %d, ws %zu); nothing launched\n", n_in, n_in > 0 ? in_sizes[0] : -1, out_size, ws_size); grid = -1; return; }
        int dev = 0, cus = 0, per_cu = 0;
        if (hipGetDevice(&dev) != hipSuccess || hipDeviceGetAttribute(&cus, hipDeviceAttributeMultiprocessorCount, dev) != hipSuccess) { grid = -1; return; }
        if (hipFuncSetAttribute((const void*)fwd_kernel, hipFuncAttributeMaxDynamicSharedMemorySize, LDS_BYTES) != hipSuccess) { fprintf(stderr, "kernel_launch: hipFuncSetAttribute failed\n"); grid = -1; return; }
        if (hipOccupancyMaxActiveBlocksPerMultiprocessor(&per_cu, (const void*)fwd_kernel, NWAVES * 64, LDS_BYTES) != hipSuccess || per_cu < 1) { fprintf(stderr, "kernel_launch: occupancy query says %d\n", per_cu); }
        (void)hipGetLastError();
        grid = cus;
    }
    if (grid < 0) return;
    if (hipMemsetAsync((char*)d_ws + WS_CTL, 0, CTL_ZERO_BYTES, stream) != hipSuccess) return;
    Args a{};
    for (int i = 0; i < 28; ++i) a.in[i] = (const float*)d_in[i];
    a.out = (float*)d_out; a.ws = (unsigned char*)d_ws; a.ph_lo = 0; a.ph_hi = N_PHASES + 64;
    hipLaunchKernelGGL(fwd_kernel, dim3(grid), dim3(NWAVES * 64), LDS_BYTES, stream, a);
}
```

```cpp
#include <hip/hip_runtime.h>
#include <cstdio>
#include <cstdint>
#include <cmath>
#ifndef NO_FLASH
#define FLASH_MLA 1
#define FLASH_MOBA 1
#define FLASH_NSA 1
#define FLASH_DSA 1
#endif
namespace pg8 {
#define PG8_LAS __attribute__((address_space(3)))
typedef unsigned short bf16_t;
typedef short bf16x8 __attribute__((ext_vector_type(8)));
typedef float f32x4 __attribute__((ext_vector_type(4)));
typedef unsigned u32x4 __attribute__((ext_vector_type(4)));
constexpr int BM = 256, BK = 64, HALF = 128, HTB = HALF * BK * 2  , STAGE_BYTES = 8 * HTB, NXCD = 8, WGM = 8;

__host__ __device__ __forceinline__ int lds_byte(int r, int c) { const int st = (r >> 4) * 2 + (c >> 5), rr = r & 15, cc = c & 31, ob = rr * 64 + cc * 2; return st * 1024 + (ob ^ (((ob >> 9) & 1) << 5)); }
__host__ __device__ __forceinline__ void stage_rc(int b, int& R, int& C) { const int st = b / 1024, sb = b % 1024, swz = sb ^ (((sb >> 9) & 1) << 5); R = (st >> 1) * 16 + swz / 64; C = (st & 1) * 32 + (swz % 64) / 2; }
__host__ __device__ __forceinline__ int perm32(int rho) { const int n = rho >> 4, i = rho & 15; return 8 * (i >> 2) + 4 * n + (i & 3); }

struct Unit { int pm, pn; };
struct Gemm { const bf16_t* A; const bf16_t* Bt; int M, N, K; int lda = 0; };

struct StaticOrder {
    int nM, nN, nwg, G, c;
    __host__ __device__ void init(int M, int N, int G_, int c_) { nM = M / BM; nN = N / BM; nwg = nM * nN; G = G_; c = c_; }
    __host__ __device__ bool next(int i, Unit& u) const {
        const long L = (long)i * G + c; if (L >= nwg) return false;
        int wgid = (int)L; { const int q = nwg / NXCD, r = nwg % NXCD, xcd = wgid % NXCD, off = wgid / NXCD; wgid = (xcd < r ? xcd * (q + 1) : r * (q + 1) + (xcd - r) * q) + off; }
        const int nig = WGM * nN, gid = wgid / nig, fm = gid * WGM, gsz = (nM - fm) < WGM ? (nM - fm) : WGM;
        u.pm = fm + ((wgid % nig) % gsz); u.pn = (wgid % nig) / gsz; return true;
    }
    __device__ __forceinline__ void a_ready(const Unit&) const {}
    __device__ __forceinline__ void done(const Unit&) const {}
};

__device__ __forceinline__ unsigned cvt_pk_bf16(float lo, float hi) { unsigned r; asm volatile("v_cvt_pk_bf16_f32 %0, %1, %2" : "=v"(r) : "v"(lo), "v"(hi)); return r; }
typedef float f32x2 __attribute__((ext_vector_type(2)));
typedef unsigned u32x2 __attribute__((ext_vector_type(2)));
__device__ __forceinline__ float silu_f(float x) { return x * __builtin_amdgcn_rcpf(1.0f + __builtin_amdgcn_exp2f(-1.4426950408889634f * x)); }

struct EpiSwiGLU {
    static constexpr bool PERM = false, AFTER_DRAIN = false;
    bf16_t* H; int ldh;
    __device__ __forceinline__ void operator()(const f32x4 (&acc)[2][2][4][2], const Unit& u, int wr, int wc, int fr, int fq) const {
        const int row0 = u.pm * BM + wr * 64 + fr;
        const int hc0 = u.pn * 128 + wc * 16 + 4 * fq;
#pragma unroll
        for (int ai = 0; ai < 2; ++ai)
#pragma unroll
            for (int m = 0; m < 4; ++m) {
                bf16_t* rowp = H + (size_t)(row0 + ai * HALF + m * 16) * ldh + hc0;
#pragma unroll
                for (int bj = 0; bj < 2; ++bj) {
                    const f32x4 g = acc[ai][bj][m][0], uu = acc[ai][bj][m][1];
                    u32x2 w; w.x = cvt_pk_bf16(silu_f(g[0]) * uu[0], silu_f(g[1]) * uu[1]); w.y = cvt_pk_bf16(silu_f(g[2]) * uu[2], silu_f(g[3]) * uu[3]);
                    *(u32x2*)(rowp + bj * 64) = w;
                }
            }
    }
};

template <bool XIN_BF16> struct EpiResid {
    static constexpr bool PERM = false, AFTER_DRAIN = false;
    const void* xin; bf16_t* xout; const float* gate; float coef;
    __device__ __forceinline__ void operator()(const f32x4 (&acc)[2][2][4][2], const Unit& u, int wr, int wc, int fr, int fq) const {
        const int b = (u.pm * BM) >> 12;
        const float* gv = gate + (size_t)b * 9216;
        const int row0 = u.pm * BM + wr * 64 + fr, col0 = u.pn * BM + wc * 32 + 4 * fq;
        f32x4 g[2][2];
#pragma unroll
        for (int bj = 0; bj < 2; ++bj)
#pragma unroll
            for (int n = 0; n < 2; ++n) g[bj][n] = *(const f32x4*)(gv + col0 + bj * HALF + n * 16) * coef;
#pragma unroll
        for (int ai = 0; ai < 2; ++ai)
#pragma unroll
            for (int m = 0; m < 4; ++m) {
                const size_t off = (size_t)(row0 + ai * HALF + m * 16) * 1024 + col0;
#pragma unroll
                for (int bj = 0; bj < 2; ++bj)
#pragma unroll
                    for (int n = 0; n < 2; ++n) {
                        f32x4 xi;
                        if (XIN_BF16) { const u32x2 w = *(const u32x2*)((const bf16_t*)xin + off + bj * HALF + n * 16);
                            xi[0] = __uint_as_float(w.x << 16); xi[1] = __uint_as_float(w.x & 0xffff0000u); xi[2] = __uint_as_float(w.y << 16); xi[3] = __uint_as_float(w.y & 0xffff0000u); }
                        else xi = *(const f32x4*)((const float*)xin + off + bj * HALF + n * 16);
                        const f32x4 xo = xi + g[bj][n] * acc[ai][bj][m][n];
                        u32x2 wo; wo.x = cvt_pk_bf16(xo[0], xo[1]); wo.y = cvt_pk_bf16(xo[2], xo[3]);
                        *(u32x2*)(xout + off + bj * HALF + n * 16) = wo; }
                if (m & 1) asm volatile("" ::: "memory");
            }
    }
};

struct ProjDesc { int kind, dfreq0, nstride, rep, repstride, bpitch, fpitch, pad; bf16_t* bp; float* fp; };
template <class DescFn> struct EpiProj {
    static constexpr bool PERM = false, AFTER_DRAIN = false;
    DescFn df; const float* cs64; const float* cs32; const float* rowscale;
    __device__ __forceinline__ void operator()(const f32x4 (&acc)[2][2][4][2], const Unit& u, int wr, int wc, int fr, int fq) const {
        const int row0 = u.pm * BM + wr * 64 + fr;
#pragma unroll
        for (int bj = 0; bj < 2; ++bj) {
            const int G = u.pn * 8 + bj * 4 + wc;
            const ProjDesc d = df(G);
            if (d.kind != 0) {
#pragma unroll
                for (int ai = 0; ai < 2; ++ai)
#pragma unroll
                    for (int m = 0; m < 4; ++m) {
                        const int row = row0 + ai * HALF + m * 16;
                        f32x4 v0 = acc[ai][bj][m][0], v1 = acc[ai][bj][m][1];
                        if (rowscale) { const float rs = rowscale[row]; v0 = v0 * rs; v1 = v1 * rs; }
                        if (d.kind >= 2) {
                            const int pos = row & 4095;
                            const float* cs = (d.kind == 2) ? cs64 + ((size_t)pos * 32 + d.dfreq0 + 4 * fq) * 2 : cs32 + ((size_t)pos * 16 + 4 * fq) * 2;
                            const f32x4 a = *(const f32x4*)cs, b2 = *(const f32x4*)(cs + 4);
                            const f32x4 c = {a[0], a[2], b2[0], b2[2]}, s = {a[1], a[3], b2[1], b2[3]};
                            const f32x4 o0 = v0 * c - v1 * s, o1 = v1 * c + v0 * s; v0 = o0; v1 = o1;
                        }
                        if (d.bp) {
                            u32x2 w0, w1; w0.x = cvt_pk_bf16(v0[0], v0[1]); w0.y = cvt_pk_bf16(v0[2], v0[3]); w1.x = cvt_pk_bf16(v1[0], v1[1]); w1.y = cvt_pk_bf16(v1[2], v1[3]);
                            bf16_t* p = d.bp + (size_t)row * d.bpitch + 4 * fq;
                            for (int rp = 0; rp < d.rep; ++rp) { *(u32x2*)(p + rp * d.repstride) = w0; *(u32x2*)(p + rp * d.repstride + d.nstride) = w1; }
                        }
                        if (d.fp) { float* p = d.fp + (size_t)row * d.fpitch + 4 * fq;
                            if (d.pad) {
                                typedef unsigned u32x4v __attribute__((ext_vector_type(4)));
                                u32x4v w0, w1;
#pragma unroll
                                for (int q = 0; q < 2; ++q) { const f32x4 v = q ? v1 : v0;
                                    const unsigned h01 = cvt_pk_bf16(v[0], v[1]), h23 = cvt_pk_bf16(v[2], v[3]);
                                    const unsigned l01 = cvt_pk_bf16(v[0] - __uint_as_float(h01 << 16), v[1] - __uint_as_float(h01 & 0xffff0000u)), l23 = cvt_pk_bf16(v[2] - __uint_as_float(h23 << 16), v[3] - __uint_as_float(h23 & 0xffff0000u));
                                    u32x4v w; w.x = (h01 & 0xffffu) | (l01 << 16); w.y = (h01 >> 16) | (l01 & 0xffff0000u); w.z = (h23 & 0xffffu) | (l23 << 16); w.w = (h23 >> 16) | (l23 & 0xffff0000u);
                                    if (q) w1 = w; else w0 = w; }
                                *(u32x4v*)p = w0; *(u32x4v*)(p + d.nstride) = w1;
                            } else { *(f32x4*)p = v0; *(f32x4*)(p + d.nstride) = v1; } }
                        asm volatile("" ::: "memory");
                    }
            }
        }
    }
};


struct EpiCmpH {
    static constexpr bool PERM = false, AFTER_DRAIN = false;
    float* out; const float* bias;
    __device__ __forceinline__ void operator()(const f32x4 (&acc)[2][2][4][2], const Unit& u, int wr, int wc, int fr, int fq) const {
        const int row0 = u.pm * BM + wr * 64 + fr, col0 = wc * 32 + 4 * fq;
        f32x4 bv[2][2];
#pragma unroll
        for (int bj = 0; bj < 2; ++bj)
#pragma unroll
            for (int n = 0; n < 2; ++n) bv[bj][n] = *(const f32x4*)(bias + col0 + bj * HALF + n * 16);
#pragma unroll
        for (int ai = 0; ai < 2; ++ai)
#pragma unroll
            for (int m = 0; m < 4; ++m) {
                float* rowp = out + (size_t)(row0 + ai * HALF + m * 16) * 256 + col0;
#pragma unroll
                for (int bj = 0; bj < 2; ++bj)
#pragma unroll
                    for (int n = 0; n < 2; ++n) { const f32x4 v = acc[ai][bj][m][n] + bv[bj][n];
                        f32x4 o; o[0] = silu_f(v[0]); o[1] = silu_f(v[1]); o[2] = silu_f(v[2]); o[3] = silu_f(v[3]); *(f32x4*)(rowp + bj * HALF + n * 16) = o; }
            }
    }
};
struct RangeOrder {
    int nM, c0;
    __device__ __forceinline__ bool next(int i, Unit& u) const { const int idx = (int)blockIdx.x - c0; if (i > 0 || idx < 0 || idx >= nM) return false; u.pm = idx; u.pn = 0; return true; }
    __device__ __forceinline__ void a_ready(const Unit&) const {}
    __device__ __forceinline__ void done(const Unit&) const {}
};
template <class Epi, class Sched, bool ALIGN_EPI = false, bool SP2 = false>
__device__ __forceinline__ void gemm_phase(PG8_LAS unsigned char* lds, const Gemm g, const Sched& S, const Epi& E) {
    int tid_ = threadIdx.x; asm volatile("" : "+v"(tid_));
    const int tid = tid_, wid = __builtin_amdgcn_readfirstlane(tid >> 6), lane = tid & 63, wr = wid >> 2, wc = wid & 3, fr = lane & 15, fq = lane >> 4;
    const int K = g.K, nt = K / BK, lda = g.lda ? g.lda : g.K;
    unsigned voffA[2], voffB[2];
#pragma unroll
    for (int i = 0; i < 2; ++i) { int R, C; stage_rc(tid * 16 + i * 8192, R, C); const int Rb = Epi::PERM ? ((R & ~31) + perm32(R & 31)) : R;
        voffA[i] = (unsigned)(R * lda + C) * 2u; voffB[i] = (unsigned)(Rb * K + C) * 2u; }
    const size_t kstep = (size_t)(BK * 2);
    const size_t hstepB = (size_t)HALF * K * 2, hstepA = (size_t)HALF * lda * 2;
    const size_t tstepB = 2 * hstepB, tstepA = 2 * hstepA;
    const unsigned ldsw = (unsigned)wid * 1024u;
    const int aoff = lds_byte(wr * 64 + fr, fq * 8), boff = lds_byte(wc * 32 + fr, fq * 8);
#define PG8_SA(b, h) (((b) * 2 + (h)) * HTB)
#define PG8_SB(b, h) ((4 + (b) * 2 + (h)) * HTB)
#define PG8_STAGE(bufoff, gbase, voff) do { _Pragma("unroll") for (int _i = 0; _i < 2; ++_i) \
        __builtin_amdgcn_global_load_lds((const unsigned*)((const char*)(gbase) + (voff)[_i]), (PG8_LAS unsigned*)(lds + (bufoff) + ldsw + _i * 8192), 16, 0, 0); } while (0)
#define PG8_LDA(dst, b, h) do { _Pragma("unroll") for (int m = 0; m < 4; ++m) _Pragma("unroll") for (int k = 0; k < 2; ++k) dst[m][k] = *(const PG8_LAS bf16x8*)(lds + PG8_SA(b, h) + aoff + m * 2048 + k * 1024); } while (0)
#define PG8_LDB(dst, b, h) do { _Pragma("unroll") for (int n = 0; n < 2; ++n) _Pragma("unroll") for (int k = 0; k < 2; ++k) dst[n][k] = *(const PG8_LAS bf16x8*)(lds + PG8_SB(b, h) + boff + n * 2048 + k * 1024); } while (0)
#define PG8_MMA(ai, bj, At, Bt) do { __builtin_amdgcn_s_setprio(1); _Pragma("unroll") for (int m = 0; m < 4; ++m) _Pragma("unroll") for (int n = 0; n < 2; ++n) _Pragma("unroll") for (int k = 0; k < 2; ++k) \
        acc[ai][bj][m][n] = __builtin_amdgcn_mfma_f32_16x16x32_bf16(Bt[n][k], At[m][k], acc[ai][bj][m][n], 0, 0, 0); __builtin_amdgcn_s_setprio(0); } while (0)
#define PG8_WAIT_V(n) asm volatile("s_waitcnt vmcnt(" #n ")" ::: "memory")
#define PG8_WAIT_L(n) asm volatile("s_waitcnt lgkmcnt(" #n ")" ::: "memory")
#define PG8_BAR __builtin_amdgcn_s_barrier()
#define PG8_SCHED __builtin_amdgcn_sched_barrier(0)
    Unit cur, nxt; int ui = 0;
    if (!S.next(0, cur)) return;
    f32x4 acc[2][2][4][2];
#pragma unroll
    for (int a = 0; a < 2; ++a)
#pragma unroll
        for (int b = 0; b < 2; ++b)
#pragma unroll
            for (int m = 0; m < 4; ++m)
#pragma unroll
                for (int n = 0; n < 2; ++n) acc[a][b][m][n] = (f32x4){0.f, 0.f, 0.f, 0.f};
    bf16x8 At[4][2], B0[2][2], B1[2][2];
    const char* cA = (const char*)g.A + (size_t)cur.pm * tstepA; const char* cB = (const char*)g.Bt + (size_t)cur.pn * tstepB;
    S.a_ready(cur);
    if constexpr (SP2) {
        PG8_STAGE(PG8_SB(0, 0), cB, voffB); PG8_STAGE(PG8_SB(0, 1), cB + hstepB, voffB); PG8_STAGE(PG8_SA(0, 0), cA, voffA); PG8_STAGE(PG8_SA(0, 1), cA + hstepA, voffA);
        if (wr == 1) PG8_BAR;
        PG8_WAIT_V(2); PG8_BAR;
        PG8_STAGE(PG8_SB(1, 0), cB + kstep, voffB); PG8_STAGE(PG8_SA(1, 0), cA + kstep, voffA); PG8_STAGE(PG8_SB(1, 1), cB + hstepB + kstep, voffB);
        PG8_WAIT_V(6); PG8_BAR;
    } else {
        PG8_STAGE(PG8_SB(0, 0), cB, voffB); PG8_STAGE(PG8_SA(0, 0), cA, voffA); PG8_STAGE(PG8_SB(0, 1), cB + hstepB, voffB); PG8_STAGE(PG8_SA(0, 1), cA + hstepA, voffA);
        if (wr == 1) PG8_BAR;
        PG8_WAIT_V(4); PG8_BAR;
        PG8_STAGE(PG8_SB(1, 0), cB + kstep, voffB); PG8_STAGE(PG8_SA(1, 0), cA + kstep, voffA); PG8_STAGE(PG8_SB(1, 1), cB + hstepB + kstep, voffB);
        PG8_WAIT_V(6); PG8_BAR;
    }
    for (;;) {
        const bool has_next = S.next(ui + 1, nxt);
        const char* nA = has_next ? (const char*)g.A + (size_t)nxt.pm * tstepA : cA; const char* nB = has_next ? (const char*)g.Bt + (size_t)nxt.pn * tstepB : cB;
        for (int t = 0; t < nt; t += 2) {
            const bool last = (t == nt - 2);
            const char* a1 = cA + (size_t)(t + 1) * kstep;
            const char* a2 = last ? nA : cA + (size_t)(t + 2) * kstep; const char* b2 = last ? nB : cB + (size_t)(t + 2) * kstep;
            const char* a3 = a2 + kstep; const char* b3 = b2 + kstep;
            if (last && has_next) S.a_ready(nxt);
            if constexpr (SP2) {
            PG8_LDB(B0, 0, 0); PG8_LDB(B1, 0, 1); PG8_SCHED; PG8_LDA(At, 0, 0); PG8_STAGE(PG8_SA(1, 1), a1 + hstepA, voffA);
            PG8_WAIT_V(8); PG8_WAIT_L(0); PG8_BAR; PG8_MMA(0, 0, At, B0); PG8_MMA(0, 1, At, B1); PG8_BAR; PG8_SCHED;
            PG8_LDA(At, 0, 1); PG8_STAGE(PG8_SB(0, 0), b2, voffB); PG8_STAGE(PG8_SB(0, 1), b2 + hstepB, voffB); PG8_STAGE(PG8_SA(0, 0), a2, voffA);
            PG8_WAIT_V(8); PG8_WAIT_L(0); PG8_BAR; PG8_MMA(1, 0, At, B0); PG8_MMA(1, 1, At, B1); PG8_BAR; PG8_SCHED;
            PG8_LDB(B0, 1, 0); PG8_LDB(B1, 1, 1); PG8_SCHED; PG8_LDA(At, 1, 0); PG8_STAGE(PG8_SA(0, 1), a2 + hstepA, voffA);
            PG8_WAIT_V(8); PG8_WAIT_L(0); PG8_BAR; PG8_MMA(0, 0, At, B0); PG8_MMA(0, 1, At, B1); PG8_BAR; PG8_SCHED;
            PG8_LDA(At, 1, 1); PG8_STAGE(PG8_SB(1, 0), b3, voffB); PG8_STAGE(PG8_SB(1, 1), b3 + hstepB, voffB); PG8_STAGE(PG8_SA(1, 0), a3, voffA);
            PG8_WAIT_V(8); PG8_WAIT_L(0); PG8_BAR; PG8_MMA(1, 0, At, B0); PG8_MMA(1, 1, At, B1); PG8_BAR; PG8_SCHED;
            } else {
            PG8_LDB(B0, 0, 0); PG8_SCHED; PG8_LDA(At, 0, 0); PG8_STAGE(PG8_SA(1, 1), a1 + hstepA, voffA);
            PG8_WAIT_L(8); PG8_BAR; PG8_WAIT_L(0); PG8_MMA(0, 0, At, B0); PG8_BAR; PG8_SCHED;
            PG8_LDB(B1, 0, 1); PG8_STAGE(PG8_SB(0, 0), b2, voffB);
            PG8_BAR; PG8_WAIT_L(0); PG8_MMA(0, 1, At, B1); PG8_BAR;
            PG8_LDA(At, 0, 1); PG8_STAGE(PG8_SA(0, 0), a2, voffA);
            PG8_BAR; PG8_WAIT_L(0); PG8_MMA(1, 0, At, B0); PG8_BAR; PG8_SCHED;
            PG8_STAGE(PG8_SB(0, 1), b2 + hstepB, voffB);
            PG8_WAIT_V(6); PG8_BAR; PG8_MMA(1, 1, At, B1); PG8_BAR;
            PG8_LDB(B0, 1, 0); PG8_SCHED; PG8_LDA(At, 1, 0); PG8_STAGE(PG8_SA(0, 1), a2 + hstepA, voffA);
            PG8_WAIT_L(8); PG8_BAR; PG8_WAIT_L(0); PG8_MMA(0, 0, At, B0); PG8_BAR; PG8_SCHED;
            PG8_LDB(B1, 1, 1); PG8_STAGE(PG8_SB(1, 0), b3, voffB);
            PG8_BAR; PG8_WAIT_L(0); PG8_MMA(0, 1, At, B1); PG8_BAR;
            PG8_LDA(At, 1, 1); PG8_STAGE(PG8_SA(1, 0), a3, voffA);
            PG8_BAR; PG8_WAIT_L(0); PG8_MMA(1, 0, At, B0); PG8_BAR; PG8_SCHED;
            PG8_STAGE(PG8_SB(1, 1), b3 + hstepB, voffB);
            PG8_WAIT_V(6); PG8_BAR; PG8_MMA(1, 1, At, B1); PG8_BAR;
            }
        }
        if constexpr (ALIGN_EPI) { if (wr == 0) PG8_BAR; }
        if constexpr (!Epi::AFTER_DRAIN) { E(acc, cur, wr, wc, fr, fq); S.done(cur); }
        if (!has_next) break;
#pragma unroll
        for (int a = 0; a < 2; ++a)
#pragma unroll
            for (int b = 0; b < 2; ++b)
#pragma unroll
                for (int m = 0; m < 4; ++m)
#pragma unroll
                    for (int n = 0; n < 2; ++n) acc[a][b][m][n] = (f32x4){0.f, 0.f, 0.f, 0.f};
        cur = nxt; cA = nA; cB = nB; ++ui;
        if constexpr (ALIGN_EPI) { if (wr == 1) PG8_BAR; }
    }
    PG8_WAIT_V(0);
    if constexpr (!ALIGN_EPI) { if (wr == 0) PG8_BAR; }
    PG8_BAR;
    if constexpr (Epi::AFTER_DRAIN) { E.fused(acc, cur, wr, wc, fr, fq, lds, wid, lane); S.done(cur); }
#undef PG8_SA
#undef PG8_SB
#undef PG8_STAGE
#undef PG8_LDA
#undef PG8_LDB
#undef PG8_MMA
#undef PG8_WAIT_V
#undef PG8_WAIT_L
#undef PG8_BAR
#undef PG8_SCHED
}
}
#define GAS __attribute__((address_space(1)))
#define LAS __attribute__((address_space(3)))
typedef unsigned short bf16;
typedef unsigned v4u __attribute__((ext_vector_type(4)));
typedef float f32x4 __attribute__((ext_vector_type(4)));
typedef short bf16x8 __attribute__((ext_vector_type(8)));
typedef GAS unsigned gu32;
typedef GAS unsigned long long gu64;
#define RLX_AGENT __ATOMIC_RELAXED, __HIP_MEMORY_SCOPE_AGENT
#define LDS_WAIT() asm volatile("s_waitcnt lgkmcnt(0)" ::: "memory")
#define VM_WAIT() asm volatile("s_waitcnt vmcnt(0)" ::: "memory")
__device__ __forceinline__ unsigned long long rt() { return __builtin_amdgcn_s_memrealtime(); }
__device__ __forceinline__ unsigned f2bf(float f) { unsigned u = __builtin_bit_cast(unsigned, f); return (u + 0x7fffu + ((u >> 16) & 1u)) >> 16; }
__device__ __forceinline__ unsigned pk2(float lo, float hi) { return f2bf(lo) | (f2bf(hi) << 16); }

#define XB_TMO      128
#define XB_XCNT(j)  (256  + 64 * (j))
#define XB_XSUB(j)  (1280 + 64 * (j))
#define XB_XGEN(j)  (2304 + 64 * (j))
#define XB_TOP      3328
#define XB_TOPGEN   3392
#define XCD_BAR_WORDS 3456
#define XB_SPIN_CAP (1u << 24)

__device__ __forceinline__ unsigned xb_ld(unsigned* p)              { return __hip_atomic_load(p, __ATOMIC_RELAXED, __HIP_MEMORY_SCOPE_AGENT); }
__device__ __forceinline__ unsigned xb_add(unsigned* p, unsigned v) { return __hip_atomic_fetch_add(p, v, __ATOMIC_RELAXED, __HIP_MEMORY_SCOPE_AGENT); }
__device__ __forceinline__ unsigned xb_xcc_id() { return (unsigned)__builtin_amdgcn_s_getreg((3 << 11) | 20) & 0xFu; }
#define XB_SPIN(cond, bar) do { unsigned _sp = 0; while (cond) { __builtin_amdgcn_s_sleep(1); \
    if ((++_sp & 255u) == 0u) { if (xb_ld(&(bar)[XB_TMO])) break; if (_sp > XB_SPIN_CAP) { atomicAdd(&(bar)[XB_TMO], 1u); break; } } } } while (0)

struct XcdBarrier {
    unsigned* bar; unsigned x;
    volatile LAS unsigned* st;
};

__device__ __forceinline__ XcdBarrier xcd_barrier_post(unsigned* bar, volatile LAS unsigned* st) {
    XcdBarrier b; b.bar = bar; b.x = xb_xcc_id(); b.st = st;
    if (threadIdx.x == 0) (void)xb_add(&bar[XB_XCNT(b.x)], 1u);
    return b;
}
__device__ __forceinline__ void xcd_barrier_complete(unsigned* bar, unsigned x, unsigned& nloc, unsigned& nx) {
    const unsigned G = gridDim.x * gridDim.y * gridDim.z;
    unsigned sum, cnt, mine, sp = 0u;
    for (;;) {
        sum = 0u; cnt = 0u; mine = 0u;
#pragma unroll
        for (unsigned j = 0; j < 16; ++j) { const unsigned c = xb_ld(&bar[XB_XCNT(j)]); sum += c; cnt += (c > 0u) ? 1u : 0u; mine = (j == x) ? c : mine; }
        if (sum == G) break;
        __builtin_amdgcn_s_sleep(1);
        if ((++sp & 255u) == 0u) { if (xb_ld(&bar[XB_TMO])) break; if (sp > XB_SPIN_CAP) { atomicAdd(&bar[XB_TMO], 1u); break; } }
    }
    nloc = mine > 0u ? mine : 1u; nx = cnt > 0u ? cnt : 1u;
}

__device__ __forceinline__ void xcd_barrier(const XcdBarrier& b) {
    asm volatile("s_waitcnt vmcnt(0)" ::: "memory");
    __syncthreads();
    if (threadIdx.x == 0) {
        unsigned* bar = b.bar; asm volatile("" : "+s"(bar));
        __builtin_amdgcn_s_waitcnt(0);
        unsigned nloc = b.st[0], nx = b.st[1];
        if (nloc == 0u) { xcd_barrier_complete(bar, b.x, nloc, nx); b.st[0] = nloc; b.st[1] = nx; }
        const unsigned old = xb_add(&bar[XB_XSUB(b.x)], 1u);
        const unsigned gen = old / nloc;
        if (old + 1u == (gen + 1u) * nloc) {
            __builtin_amdgcn_fence(__ATOMIC_RELEASE, "agent");
            asm volatile("s_waitcnt vmcnt(0)" ::: "memory");
            const unsigned og = xb_add(&bar[XB_TOP], 1u);
            const unsigned tg = og / nx;
            if (og + 1u == (tg + 1u) * nx) xb_add(&bar[XB_TOPGEN], 1u);
            else XB_SPIN(xb_ld(&bar[XB_TOPGEN]) == tg, bar);
            __builtin_amdgcn_fence(__ATOMIC_ACQUIRE, "agent");
            xb_add(&bar[XB_XGEN(b.x)], 1u);
            asm volatile("s_waitcnt vmcnt(0)" ::: "memory");
        } else {
            XB_SPIN(xb_ld(&bar[XB_XGEN(b.x)]) == gen, bar);
            __builtin_amdgcn_fence(__ATOMIC_ACQUIRE, "agent");
            asm volatile("s_waitcnt vmcnt(0)" ::: "memory");
        }
    }
    __syncthreads();
}
constexpr int NWAVES = 8;
constexpr int BATCH = 8, T = 4096, D = 1024, M = BATCH * T, FF = 2816, NGU = 2 * FF, NINP = 2560, NIN_SRC = 2516, NL = 2;
constexpr float RMS_EPS = 1e-6f;
constexpr size_t MiB = 1u << 20;
constexpr size_t WS_CTL = 0, CTL_ZERO_BYTES = 1 * MiB;
constexpr size_t WS_CS64 = 1 * MiB;
constexpr size_t WS_CS32 = 2 * MiB;
constexpr size_t WS_ADA = 2 * MiB + 512 * 1024;
constexpr size_t WS_CMPB = 3 * MiB + 128 * 1024;
constexpr size_t WS_KMEAN = 3 * MiB + 256 * 1024;
constexpr size_t WS_RSTDQ = 3 * MiB + 512 * 1024;
constexpr size_t WS_RSTDKV = 3 * MiB + 768 * 1024;
constexpr size_t WS_KCMP = 4 * MiB;
constexpr size_t WS_VCMP = 4 * MiB + 512 * 1024;
constexpr size_t WS_CMPH = 5 * MiB;
constexpr size_t WS_WTS = 10 * MiB, WTS_LAYER = 46 * MiB;
constexpr size_t WO_GU1 = 0, WO_D1 = 11 * MiB, WO_GU2 = 17 * MiB, WO_D2 = 28 * MiB, WO_IN = 34 * MiB, WO_OUT = 39 * MiB, WO_UQ = 41 * MiB, WO_UKV = 41 * MiB + 512 * 1024, WO_C1K = 42 * MiB, WO_C1V = 43 * MiB;
constexpr size_t WS_XB = 104 * MiB;
constexpr size_t WS_BIG = 168 * MiB;
constexpr size_t WS_HID = WS_BIG;
constexpr size_t WS_QM_BF = 168 * MiB, WS_KM_BF = 184 * MiB, WS_VM_BF = 200 * MiB, WS_QM_F = 216 * MiB, WS_KM_F = 248 * MiB;
constexpr size_t WS_CQ = 280 * MiB, WS_CKV = 296 * MiB;
constexpr size_t WS_QN = 304 * MiB, WS_KC = 320 * MiB, WS_VC = 324 * MiB, WS_KS = 328 * MiB, WS_VS = 332 * MiB, WS_KW = 336 * MiB, WS_VW = 340 * MiB;
constexpr size_t WS_QD = 344 * MiB, WS_KD = 360 * MiB, WS_VD = 364 * MiB, WS_IQ = 368 * MiB, WS_IK = 400 * MiB, WS_GW = 404 * MiB;
constexpr size_t WS_QMLA = 408 * MiB, WS_KMLA = 432 * MiB, WS_VMLA = 456 * MiB;
constexpr size_t WS_DSAMASK = 472 * MiB;
constexpr size_t WS_OC = 488 * MiB;
constexpr size_t WS_KCMPB = 9 * MiB + 256 * 1024, WS_VCMPB = 9 * MiB + 512 * 1024;
constexpr size_t WS_NSEL = 9 * MiB;
constexpr size_t WS_END = 512 * MiB;
constexpr int CW_BAR = 4096;
constexpr int RING_OFF = 0, RING_BYTES = 131072;
constexpr int LDSCTL_OFF = RING_BYTES, MISC_OFF = LDSCTL_OFF + 320;
constexpr int XTRA_OFF = 132096, XTRA_WAVE = 2112;
constexpr int LDS_BYTES = 155648;
static_assert(XTRA_OFF + NWAVES * XTRA_WAVE <= LDS_BYTES && MISC_OFF + 128 <= XTRA_OFF, "LDS map");

struct Args { const float* in[28]; float* out; unsigned char* ws; int ph_lo, ph_hi; };
struct Frame {
    LAS unsigned char* lds;
    volatile LAS unsigned* MISC;
    gu32* ctl;
    unsigned char* ws;
    int G;
    const Args* A;
    float* out;
};
enum { I_X = 0, I_C, I_ADAW, I_ADAB, I_F1N, I_F1G, I_F1U, I_F1D, I_MIXN, I_WIN, I_QNORM, I_WUQ, I_KVNORM, I_WUK, I_WUV, I_PEK, I_PEV, I_CK1, I_CK2, I_CV1, I_CV2, I_GN, I_WOUT, I_F2N, I_F2G, I_F2U, I_F2D, I_FINN };

__device__ __forceinline__ int opaque_v(int v) { asm volatile("" : "+v"(v)); return v; }
__device__ __forceinline__ int cur_tid() { return opaque_v((int)threadIdx.x); }
__device__ __forceinline__ int cur_lane() { return opaque_v((int)threadIdx.x) & 63; }
__device__ __forceinline__ int cur_wave() { return __builtin_amdgcn_readfirstlane(opaque_v((int)threadIdx.x) >> 6); }
template <int CTRL> __device__ __forceinline__ float dpp_f(float v) { return __int_as_float(__builtin_amdgcn_update_dpp(0, __float_as_int(v), CTRL, 0xf, 0xf, false)); }
__device__ __forceinline__ float wave_sum(float v) {
    v += dpp_f<0xB1>(v); v += dpp_f<0x4E>(v); v += dpp_f<0x141>(v); v += dpp_f<0x140>(v);
    const float r0 = __int_as_float(__builtin_amdgcn_readlane(__float_as_int(v), 0)), r1 = __int_as_float(__builtin_amdgcn_readlane(__float_as_int(v), 16));
    const float r2 = __int_as_float(__builtin_amdgcn_readlane(__float_as_int(v), 32)), r3 = __int_as_float(__builtin_amdgcn_readlane(__float_as_int(v), 48));
    return (r0 + r1) + (r2 + r3);
}
__device__ __forceinline__ float wave_max(float v) {
    v = fmaxf(v, dpp_f<0xB1>(v)); v = fmaxf(v, dpp_f<0x4E>(v)); v = fmaxf(v, dpp_f<0x141>(v)); v = fmaxf(v, dpp_f<0x140>(v));
    const float r0 = __int_as_float(__builtin_amdgcn_readlane(__float_as_int(v), 0)), r1 = __int_as_float(__builtin_amdgcn_readlane(__float_as_int(v), 16));
    const float r2 = __int_as_float(__builtin_amdgcn_readlane(__float_as_int(v), 32)), r3 = __int_as_float(__builtin_amdgcn_readlane(__float_as_int(v), 48));
    return fmaxf(fmaxf(r0, r1), fmaxf(r2, r3));
}
__device__ __forceinline__ float bf2f(unsigned short b) { return __uint_as_float((unsigned)b << 16); }
__device__ __forceinline__ void unpack8(const v4u w, float* f) {
    f[0] = __uint_as_float(w.x << 16); f[1] = __uint_as_float(w.x & 0xffff0000u); f[2] = __uint_as_float(w.y << 16); f[3] = __uint_as_float(w.y & 0xffff0000u);
    f[4] = __uint_as_float(w.z << 16); f[5] = __uint_as_float(w.z & 0xffff0000u); f[6] = __uint_as_float(w.w << 16); f[7] = __uint_as_float(w.w & 0xffff0000u);
}
__device__ __forceinline__ float sigmoid_f(float x) { return 1.0f / (1.0f + __expf(-x)); }

__device__ __forceinline__ int perm64(int j) { return 32 * ((j & 31) >> 4) + 16 * (j >> 5) + (j & 15); }
__device__ __forceinline__ int win_src_col(int c) {
    if (c < 512) return (c & ~63) + perm64(c & 63);
    if (c < 1184) return c;
    if (c < 1504) { const int r = c - 1184; return 1184 + (r & ~63) + perm64(r & 63); }
    if (c < 1568) return c;
    if (c < 1632) return 1568 + perm64(c - 1568);
    if (c < 1696) return c;
    if (c < 1760) return 1696 + perm64(c - 1696);
    if (c < 1824) return c;
    if (c < 2144) { const int r = c - 1824; return 1836 + (r & ~63) + perm64(r & 63); }
    if (c < 2208) return 2156 + (c - 2144);
    if (c < 2464) return 2220 + (c - 2208);
    if (c < 2496) return 2476 + (c - 2464);
    if (c < 2508) return 1824 + (c - 2496);
    if (c < 2516) return 2508 + (c - 2508);
    return -1;
}
constexpr int WK_K[8] = {1024, 2816, 1024, 2816, 1024, 1024, 256, 128};
constexpr int WK_N[8] = {5632, 1024, 5632, 1024, 2560, 1024, 512, 512};
__device__ __forceinline__ size_t wk_off(int kind) { return kind == 0 ? WO_GU1 : kind == 1 ? WO_D1 : kind == 2 ? WO_GU2 : kind == 3 ? WO_D2 : kind == 4 ? WO_IN : kind == 5 ? WO_OUT : kind == 6 ? WO_UQ : kind == 7 ? WO_UKV : kind == 8 ? WO_C1K : WO_C1V; }
__device__ __forceinline__ const float* wsrc(const Frame& F, int kind, int l, int R, int& stride) {
    switch (kind) {
    case 0: case 2: { const int G = R >> 5, w = R & 31, j = 16 * G + (w & 15); stride = FF;
        const float* g = F.A->in[kind == 0 ? I_F1G : I_F2G] + (size_t)l * D * FF; const float* u = F.A->in[kind == 0 ? I_F1U : I_F2U] + (size_t)l * D * FF; return ((w >> 4) ? u : g) + j; }
    case 1: case 3: stride = D; return F.A->in[kind == 1 ? I_F1D : I_F2D] + (size_t)l * FF * D + R;
    case 4: { stride = NIN_SRC; const int s = win_src_col(R); return s < 0 ? nullptr : F.A->in[I_WIN] + (size_t)l * D * NIN_SRC + s; }
    case 5: stride = D; return F.A->in[I_WOUT] + (size_t)l * D * D + R;
    case 6: stride = 384; return R < 384 ? F.A->in[I_WUQ] + (size_t)l * 256 * 384 + R : nullptr;
    case 7: stride = 256; return R < 256 ? F.A->in[I_WUK] + (size_t)l * 128 * 256 + R : F.A->in[I_WUV] + (size_t)l * 128 * 256 + (R - 256);
    default: stride = 256; return F.A->in[kind == 8 ? I_CK1 : I_CV1] + (size_t)l * 2048 * 256 + R;
    }
}

struct WinDesc {
    unsigned char* ws;
    __device__ __forceinline__ pg8::ProjDesc operator()(int G) const {
        pg8::ProjDesc d; d.kind = 0; d.dfreq0 = 0; d.nstride = 16; d.rep = 1; d.repstride = 0; d.bpitch = 0; d.fpitch = 0; d.pad = 0; d.bp = nullptr; d.fp = nullptr;
        const int c = 32 * G;
#define ROPE64(rel, BOFF, BP, FOFF, FP) do { const int hh_ = (rel) >> 6, g_ = ((rel) >> 5) & 1; d.kind = 2; d.dfreq0 = 16 * g_; d.nstride = 32; \
            d.bp = (bf16*)(ws + (BOFF)) + hh_ * 64 + 16 * g_; d.bpitch = (BP); if (FP) { d.fp = (float*)(ws + (FOFF)) + hh_ * 64 + 16 * g_; d.fpitch = (FP); } } while (0)
#define PLAINB(rel, BOFF, BP) do { d.kind = 1; d.bp = (bf16*)(ws + (BOFF)) + (rel); d.bpitch = (BP); } while (0)
#define PLAINF(rel, FOFF, FP) do { d.kind = 1; d.fp = (float*)(ws + (FOFF)) + (rel); d.fpitch = (FP); } while (0)
        if (c < 256) ROPE64(c, WS_QM_BF, 256, WS_QM_F, 256);
        else if (c < 512) ROPE64(c - 256, WS_KM_BF, 256, WS_KM_F, 256);
        else if (c < 768) PLAINB(c - 512, WS_VM_BF, 256);
        else if (c < 1024) PLAINB(c - 768, WS_CQ, 256);
        else if (c < 1152) PLAINB(c - 1024, WS_CKV, 128);
        else if (c < 1184) { d.kind = 3; d.nstride = 16; d.bp = (bf16*)(ws + WS_KMLA) + 64; d.bpitch = 384; d.rep = 4; d.repstride = 96; }
        else if (c < 1440) ROPE64(c - 1184, WS_QN, 256, 0, 0);
        else if (c < 1504) ROPE64(c - 1440, WS_KC, 64, 0, 0);
        else if (c < 1568) PLAINB(c - 1504, WS_VC, 64);
        else if (c < 1632) ROPE64(c - 1568, WS_KS, 64, 0, 0);
        else if (c < 1696) PLAINB(c - 1632, WS_VS, 64);
        else if (c < 1760) ROPE64(c - 1696, WS_KW, 64, 0, 0);
        else if (c < 1824) PLAINB(c - 1760, WS_VW, 64);
        else if (c < 2080) ROPE64(c - 1824, WS_QD, 256, 0, 0);
        else if (c < 2144) ROPE64(c - 2080, WS_KD, 64, 0, 0);
        else if (c < 2208) PLAINB(c - 2144, WS_VD, 64);
        else if (c < 2464) PLAINF(c - 2208, WS_IQ, 256);
        else if (c < 2496) { PLAINF(c - 2464, WS_IK, 32); d.pad = 1; }
        else if (c < 2528) PLAINF(c - 2496, WS_GW, 32);
#undef ROPE64
#undef PLAINB
#undef PLAINF
        return d;
    }
};
struct MlaQDesc {
    unsigned char* ws;
    __device__ __forceinline__ pg8::ProjDesc operator()(int G) const {
        pg8::ProjDesc d; d.kind = 0; d.dfreq0 = 0; d.nstride = 16; d.rep = 1; d.repstride = 0; d.bpitch = 384; d.fpitch = 0; d.pad = 0; d.bp = nullptr; d.fp = nullptr;
        if (G < 12) { const int hh = G / 3, part = G - 3 * hh; d.kind = (part == 2) ? 3 : 1; d.bp = (bf16*)(ws + WS_QMLA) + hh * 96 + 32 * part; }
        return d;
    }
};
struct MlaKvDesc {
    unsigned char* ws;
    __device__ __forceinline__ pg8::ProjDesc operator()(int G) const {
        pg8::ProjDesc d; d.kind = 1; d.dfreq0 = 0; d.nstride = 16; d.rep = 1; d.repstride = 0; d.bpitch = 0; d.fpitch = 0; d.pad = 0; d.bp = nullptr; d.fp = nullptr;
        const int c = 32 * G;
        if (c < 256) { d.bp = (bf16*)(ws + WS_KMLA) + (c >> 6) * 96 + (c & 63); d.bpitch = 384; }
        else { d.bp = (bf16*)(ws + WS_VMLA) + (c - 256); d.bpitch = 256; }
        return d;
    }
};

__device__ __forceinline__ void p0_prologue(Frame& F) {
    const int tid = cur_tid();
    const int wave = cur_wave(), gw = blockIdx.x * NWAVES + wave, NGW = F.G * NWAVES, lane = cur_lane();
    {
        LAS float* scr = (LAS float*)(F.lds + RING_OFF + wave * 16384);
        constexpr int PER_LAYER = 2816 + 1408 + 2816 + 1408 + 1280 + 512 + 64 + 32 + 256 + 256;
        for (int it = gw; it < NL * PER_LAYER; it += NGW) {
            const int l = it / PER_LAYER; int r = it - l * PER_LAYER; int kind = 0;
            { const int cnt[10] = {2816, 1408, 2816, 1408, 1280, 512, 64, 32, 256, 256};
#pragma unroll
              for (int q = 0; q < 9; ++q) { if (kind == q && r >= cnt[q]) { r -= cnt[q]; kind = q + 1; } } }
            const int K = kind == 0 || kind == 2 || kind == 4 || kind == 5 ? 1024 : (kind == 1 || kind == 3) ? 2816 : kind == 6 ? 256 : kind == 7 ? 128 : 2048;
            const int N = kind == 0 || kind == 2 ? 5632 : kind == 4 ? 2560 : (kind == 6 || kind == 7) ? 512 : kind >= 8 ? 256 : 1024;
            const int nblk = N / 32, kb = r / nblk, nb = r - kb * nblk, k0 = 64 * kb, n0 = 32 * nb;
            int stride; const float* colp = wsrc(F, kind, l, n0 + (lane & 31), stride);
            const float* ksc = kind == 6 ? F.A->in[I_QNORM] + l * 256 : kind == 7 ? F.A->in[I_KVNORM] + l * 128 : nullptr;
            bf16* WT = (bf16*)(F.ws + WS_WTS + (size_t)l * WTS_LAYER + wk_off(kind));
            float vv[32];
#pragma unroll
            for (int i = 0; i < 32; ++i) { const int kk = 2 * i + (lane >> 5); vv[i] = colp ? colp[(size_t)(k0 + kk) * stride] : 0.f; }
#pragma unroll
            for (int i = 0; i < 32; ++i) { const int kk = 2 * i + (lane >> 5); float v = vv[i]; if (ksc) v *= ksc[k0 + kk]; scr[kk * 33 + (lane & 31)] = v; }
            LDS_WAIT(); asm volatile("" ::: "memory");
            const int c = lane & 7;
#pragma unroll
            for (int j = 0; j < 4; ++j) { const int n = (lane >> 3) + 8 * j; const LAS float* s = scr + (8 * c) * 33 + n;
                v4u o; o.x = pk2(s[0 * 33], s[1 * 33]); o.y = pk2(s[2 * 33], s[3 * 33]); o.z = pk2(s[4 * 33], s[5 * 33]); o.w = pk2(s[6 * 33], s[7 * 33]);
                *(GAS v4u*)(WT + (size_t)(n0 + n) * K + k0 + 8 * c) = o; }
            LDS_WAIT(); asm volatile("" ::: "memory");
        }
    }
    for (int i = blockIdx.x * 512 + tid; i < 4096 * 48; i += F.G * 512) {
        const int pos = i / 48, j = i - pos * 48;
        float invf; float* dst;
        if (j < 32) { invf = 1.0f / (float)pow(10000.0, (double)j / 32.0); dst = (float*)(F.ws + WS_CS64) + ((size_t)pos * 32 + j) * 2; }
        else { invf = 1.0f / (float)pow(10000.0, (double)(j - 32) / 16.0); dst = (float*)(F.ws + WS_CS32) + ((size_t)pos * 16 + (j - 32)) * 2; }
        const float ang = (float)pos * invf;
        dst[0] = (float)cos((double)ang); dst[1] = (float)sin((double)ang);
    }
    {
        LAS float* red = (LAS float*)(F.lds + RING_OFF + 8 * 16384 - 2048);
        for (int task = blockIdx.x; task < NL * 2 * 4; task += F.G) {
            const int l = task >> 3, kvq = task & 7, kv = kvq >> 2, j = (kvq & 3) * 64 + lane;
            const float* pe = F.A->in[kv ? I_PEV : I_PEK] + (size_t)l * 2048 + wave * 256; const float* w1 = F.A->in[kv ? I_CV1 : I_CK1] + (size_t)l * 2048 * 256 + (size_t)wave * 256 * 256 + j;
            float acc = 0.f;
#pragma unroll 32
            for (int k = 0; k < 256; ++k) acc += pe[k] * w1[(size_t)k * 256];
            __syncthreads();
            red[wave * 64 + lane] = acc;
            __syncthreads();
            if (wave == 0) { float s = 0.f;
#pragma unroll
                for (int w = 0; w < 8; ++w) s += red[w * 64 + lane];
                ((float*)(F.ws + WS_CMPB))[(l * 2 + kv) * 256 + j] = s; }
        }
    }
    {
        __syncthreads();
        LAS float* cact = (LAS float*)(F.lds + RING_OFF);
        LAS float* red = (LAS float*)(F.lds + RING_OFF + 32768);
        for (int i = tid; i < 8 * 1024; i += 512) { const float cv = F.A->in[I_C][i]; cact[i] = cv / (1.0f + __expf(-cv)); }
        __syncthreads();
        for (int task = blockIdx.x; task < NL * 144; task += F.G) {
            const int l = task / 144, n0 = (task - l * 144) * 64;
            const float* W = F.A->in[I_ADAW] + (size_t)l * 1024 * 9216 + n0 + lane;
            float acc[8];
#pragma unroll
            for (int b = 0; b < 8; ++b) acc[b] = 0.f;
            const int kbeg = wave * 128;
#pragma unroll 16
            for (int k = kbeg; k < kbeg + 128; ++k) { const float wv = W[(size_t)k * 9216];
#pragma unroll
                for (int b = 0; b < 8; ++b) acc[b] += cact[b * 1024 + k] * wv; }
#pragma unroll
            for (int b = 0; b < 8; ++b) red[(wave * 8 + b) * 64 + lane] = acc[b];
            __syncthreads();
            { const int b = wave; float s = F.A->in[I_ADAB][(size_t)l * 9216 + n0 + lane];
#pragma unroll
              for (int w = 0; w < 8; ++w) s += red[(w * 8 + b) * 64 + lane];
              ((float*)(F.ws + WS_ADA))[((size_t)l * 8 + b) * 9216 + n0 + lane] = s; }
            __syncthreads();
        }
    }
}

template <bool XBF> __device__ __forceinline__ void load_row16(const void* xsrc, int row, int lane, f32x4 (&v)[4]) {
    if (XBF) { const unsigned long long* xr = (const unsigned long long*)((const bf16*)xsrc + (size_t)row * D) + lane;
#pragma unroll
        for (int j = 0; j < 4; ++j) { const unsigned long long w = xr[64 * j];
            v[j] = (f32x4){__uint_as_float((unsigned)w << 16), __uint_as_float((unsigned)w & 0xffff0000u), __uint_as_float((unsigned)(w >> 32) << 16), __uint_as_float((unsigned)(w >> 32) & 0xffff0000u)}; } }
    else { const f32x4* xr = (const f32x4*)((const float*)xsrc + (size_t)row * D) + lane;
#pragma unroll
        for (int j = 0; j < 4; ++j) v[j] = xr[64 * j]; }
}
template <bool XBF>
__device__ __forceinline__ void norm_mod_phase(Frame& F, const void* xsrc, const float* gain, const float* sh, const float* sc, bf16* hout) {
    const int wave = cur_wave(), gw = blockIdx.x * NWAVES + wave, NGW = F.G * NWAVES, lane = cur_lane();
    f32x4 g[4];
#pragma unroll
    for (int j = 0; j < 4; ++j) g[j] = *(const f32x4*)(gain + 4 * lane + 256 * j);
    for (int row0 = gw; row0 < M; row0 += 2 * NGW) {
        const int row1 = row0 + NGW; const bool has1 = row1 < M; const int r1 = has1 ? row1 : row0;
        f32x4 va[4], vb[4]; float sa = 0.f, sb = 0.f;
        load_row16<XBF>(xsrc, row0, lane, va); load_row16<XBF>(xsrc, r1, lane, vb);
#pragma unroll
        for (int j = 0; j < 4; ++j) { sa += (va[j].x * va[j].x + va[j].y * va[j].y) + (va[j].z * va[j].z + va[j].w * va[j].w); sb += (vb[j].x * vb[j].x + vb[j].y * vb[j].y) + (vb[j].z * vb[j].z + vb[j].w * vb[j].w); }
        const float rsa = 1.0f / sqrtf(wave_sum(sa) * (1.f / D) + RMS_EPS), rsb = 1.0f / sqrtf(wave_sum(sb) * (1.f / D) + RMS_EPS);
#pragma unroll
        for (int q = 0; q < 2; ++q) {
            if (q == 1 && !has1) break;
            const int row = q ? row1 : row0; const int b = row >> 12; const float rstd = q ? rsb : rsa;
            const float* shb = sh + (size_t)b * 9216 + 4 * lane; const float* scb = sc + (size_t)b * 9216 + 4 * lane;
            unsigned long long* o8 = (unsigned long long*)(hout + (size_t)row * D) + lane;
#pragma unroll
            for (int j = 0; j < 4; ++j) { const f32x4 s4 = *(const f32x4*)(shb + 256 * j), c4 = *(const f32x4*)(scb + 256 * j);
                const f32x4 y = (q ? vb[j] : va[j]) * rstd * g[j] * (c4 + 1.0f) + s4;
                o8[64 * j] = (unsigned long long)pk2(y.x, y.y) | ((unsigned long long)pk2(y.z, y.w) << 32); }
        }
    }
}
__device__ __forceinline__ void final_norm_phase(Frame& F, const bf16* xb, float* out, const float* gain) {
    const int wave = cur_wave(), gw = blockIdx.x * NWAVES + wave, NGW = F.G * NWAVES, lane = cur_lane();
    f32x4 g[4];
#pragma unroll
    for (int j = 0; j < 4; ++j) g[j] = *(const f32x4*)(gain + 4 * lane + 256 * j);
    for (int row0 = gw; row0 < M; row0 += 2 * NGW) {
        const int row1 = row0 + NGW; const bool has1 = row1 < M; const int r1 = has1 ? row1 : row0;
        f32x4 va[4], vb[4]; float sa = 0.f, sb = 0.f;
        load_row16<true>(xb, row0, lane, va); load_row16<true>(xb, r1, lane, vb);
#pragma unroll
        for (int j = 0; j < 4; ++j) { sa += (va[j].x * va[j].x + va[j].y * va[j].y) + (va[j].z * va[j].z + va[j].w * va[j].w); sb += (vb[j].x * vb[j].x + vb[j].y * vb[j].y) + (vb[j].z * vb[j].z + vb[j].w * vb[j].w); }
        const float rsa = 1.0f / sqrtf(wave_sum(sa) * (1.f / D) + RMS_EPS), rsb = 1.0f / sqrtf(wave_sum(sb) * (1.f / D) + RMS_EPS);
        f32x4* xa = (f32x4*)(out + (size_t)row0 * D) + lane;
#pragma unroll
        for (int j = 0; j < 4; ++j) xa[64 * j] = va[j] * rsa * g[j];
        if (has1) { f32x4* xo = (f32x4*)(out + (size_t)row1 * D) + lane;
#pragma unroll
            for (int j = 0; j < 4; ++j) xo[64 * j] = vb[j] * rsb * g[j]; }
    }
}
__device__ __forceinline__ void group_norm_phase(Frame& F, bf16* Y, const float* gn) {
    const int wave = cur_wave(), gw = blockIdx.x * NWAVES + wave, NGW = F.G * NWAVES, lane = cur_lane();
    f32x4 g[4];
#pragma unroll
    for (int j = 0; j < 4; ++j) g[j] = *(const f32x4*)(gn + 256 * j + 4 * lane);
    for (int row0 = gw; row0 < M; row0 += 4 * NGW) {
        unsigned long long w[4][4];
#pragma unroll
        for (int q = 0; q < 4; ++q) { const int row = row0 + q * NGW < M ? row0 + q * NGW : row0; const unsigned long long* yr = (const unsigned long long*)(Y + (size_t)row * D) + lane;
#pragma unroll
            for (int j = 0; j < 4; ++j) w[q][j] = yr[64 * j]; }
#pragma unroll
        for (int q = 0; q < 4; ++q) {
            const int row = row0 + q * NGW; if (row >= M) break;
            unsigned long long* yr = (unsigned long long*)(Y + (size_t)row * D) + lane;
#pragma unroll
            for (int j = 0; j < 4; ++j) {
                const unsigned long long ww = w[q][j];
                const float a0 = __uint_as_float((unsigned)ww << 16), a1 = __uint_as_float((unsigned)ww & 0xffff0000u), a2 = __uint_as_float((unsigned)(ww >> 32) << 16), a3 = __uint_as_float((unsigned)(ww >> 32) & 0xffff0000u);
                const float ss = wave_sum((a0 * a0 + a1 * a1) + (a2 * a2 + a3 * a3));
                const float rstd = 1.0f / sqrtf(ss * (1.f / 256.f) + RMS_EPS);
                yr[64 * j] = (unsigned long long)pk2(a0 * rstd * g[j].x, a1 * rstd * g[j].y) | ((unsigned long long)pk2(a2 * rstd * g[j].z, a3 * rstd * g[j].w) << 32);
            }
        }
    }
}
__device__ __forceinline__ unsigned long long causal_word(int d) { return d >= 63 ? ~0ull : (d < 0 ? 0ull : ((2ull << d) - 1ull)); }
__device__ __forceinline__ int mbcnt64(unsigned long long m) { return (int)__builtin_amdgcn_mbcnt_hi((unsigned)(m >> 32), __builtin_amdgcn_mbcnt_lo((unsigned)m, 0u)); }
__device__ __forceinline__ unsigned fkey(float x) { const unsigned u = __float_as_uint(x); return (u & 0x80000000u) ? ~u : (u | 0x80000000u); }
__device__ __forceinline__ float reduce64(const float (&o)[64], int lane) {
    float r5[32], r4[16], r3[8], r2[4], r1[2];
    { const bool hi = (lane & 32) != 0;
#pragma unroll
      for (int i = 0; i < 32; ++i) { const float a = o[i], b = o[i + 32]; r5[i] = (hi ? b : a) + __shfl_xor(hi ? a : b, 32); } }
    { const bool hi = (lane & 16) != 0;
#pragma unroll
      for (int i = 0; i < 16; ++i) { const float a = r5[i], b = r5[i + 16]; r4[i] = (hi ? b : a) + __shfl_xor(hi ? a : b, 16); } }
    { const bool hi = (lane & 8) != 0;
#pragma unroll
      for (int i = 0; i < 8; ++i) { const float a = r4[i], b = r4[i + 8]; r3[i] = (hi ? b : a) + __shfl_xor(hi ? a : b, 8); } }
    { const bool hi = (lane & 4) != 0;
#pragma unroll
      for (int i = 0; i < 4; ++i) { const float a = r3[i], b = r3[i + 4]; r2[i] = (hi ? b : a) + __shfl_xor(hi ? a : b, 4); } }
    { const bool hi = (lane & 2) != 0;
#pragma unroll
      for (int i = 0; i < 2; ++i) { const float a = r2[i], b = r2[i + 2]; r1[i] = (hi ? b : a) + __shfl_xor(hi ? a : b, 2); } }
    const bool hi = (lane & 1) != 0;
    return (hi ? r1[1] : r1[0]) + __shfl_xor(hi ? r1[0] : r1[1], 1);
}
struct KVbf {
    const bf16* K; const bf16* V; int kp, vp;
    template <int DQ> __device__ __forceinline__ float dot(int row, const LAS float* q) const {
        const v4u* p = (const v4u*)(K + (size_t)row * kp); float s = 0.f;
#pragma unroll
        for (int c = 0; c < DQ / 8; ++c) { float f[8]; unpack8(p[c], f); const f32x4 q0 = *(const LAS f32x4*)(q + 8 * c), q1 = *(const LAS f32x4*)(q + 8 * c + 4);
            s += (q0.x * f[0] + q0.y * f[1]) + (q0.z * f[2] + q0.w * f[3]) + (q1.x * f[4] + q1.y * f[5]) + (q1.z * f[6] + q1.w * f[7]); }
        return s;
    }
    __device__ __forceinline__ void axpy(int row, float pw, float (&o)[64]) const {
        const v4u* p = (const v4u*)(V + (size_t)row * vp);
#pragma unroll
        for (int c = 0; c < 8; ++c) { float f[8]; unpack8(p[c], f);
#pragma unroll
            for (int e = 0; e < 8; ++e) o[8 * c + e] += pw * f[e]; }
    }
};
struct KVf32 {
    const float* K; const float* V; int kp, vp;
    template <int DQ> __device__ __forceinline__ float dot(int row, const LAS float* q) const {
        const f32x4* p = (const f32x4*)(K + (size_t)row * kp); float s = 0.f;
#pragma unroll
        for (int c = 0; c < DQ / 4; ++c) { const f32x4 f = p[c]; const f32x4 qv = *(const LAS f32x4*)(q + 4 * c); s += (qv.x * f.x + qv.y * f.y) + (qv.z * f.z + qv.w * f.w); }
        return s;
    }
    __device__ __forceinline__ void axpy(int row, float pw, float (&o)[64]) const {
        const f32x4* p = (const f32x4*)(V + (size_t)row * vp);
#pragma unroll
        for (int c = 0; c < 16; ++c) { const f32x4 f = p[c]; o[4 * c] += pw * f.x; o[4 * c + 1] += pw * f.y; o[4 * c + 2] += pw * f.z; o[4 * c + 3] += pw * f.w; }
    }
};
template <int DQ, class KV, class KeyFn>
__device__ __forceinline__ float wave_attend(const LAS float* q, float scale, int nslots, const KeyFn& keyf, const KV& kv, int lane) {
    float m = -INFINITY;
    for (int s = 0; s < nslots; ++s) { const int key = keyf(s); if (key >= 0) m = fmaxf(m, kv.template dot<DQ>(key, q) * scale); }
    const float Mx = wave_max(m);
    float o[64];
#pragma unroll
    for (int d = 0; d < 64; ++d) o[d] = 0.f;
    float l = 0.f;
    if (Mx > -INFINITY) {
        for (int s = 0; s < nslots; ++s) { const int key = keyf(s);
            if (key >= 0) { const float p = __expf(kv.template dot<DQ>(key, q) * scale - Mx); l += p; kv.axpy(key, p, o); } }
    }
    l = wave_sum(l);
    const float r = reduce64(o, lane);
    return l > 0.f ? r / l : 0.f;
}
__device__ __forceinline__ void task_bt(int i, int& t, int& rest) { const int tt = i & 2047, j = i >> 11; t = (j & 1) ? 4095 - tt : tt; rest = j >> 1; }

__device__ __forceinline__ void m1_phase(Frame& F, int l) {
    const int wave = cur_wave(), gw = blockIdx.x * NWAVES + wave, NGW = F.G * NWAVES, lane = cur_lane();
    const bf16* CQ = (const bf16*)(F.ws + WS_CQ); const bf16* CKV = (const bf16*)(F.ws + WS_CKV);
    float* rq = (float*)(F.ws + WS_RSTDQ); float* rkv = (float*)(F.ws + WS_RSTDKV);
    for (int row0 = gw; row0 < M; row0 += 4 * NGW) {
        unsigned long long wq[4]; unsigned wk[4];
#pragma unroll
        for (int q = 0; q < 4; ++q) { const int row = row0 + q * NGW < M ? row0 + q * NGW : row0; wq[q] = ((const unsigned long long*)(CQ + (size_t)row * 256))[lane]; wk[q] = ((const unsigned*)(CKV + (size_t)row * 128))[lane]; }
#pragma unroll
        for (int q = 0; q < 4; ++q) {
            const int row = row0 + q * NGW; if (row >= M) break;
            const unsigned long long w = wq[q];
            const float a0 = __uint_as_float((unsigned)w << 16), a1 = __uint_as_float((unsigned)w & 0xffff0000u), a2 = __uint_as_float((unsigned)(w >> 32) << 16), a3 = __uint_as_float((unsigned)(w >> 32) & 0xffff0000u);
            const float s1 = wave_sum((a0 * a0 + a1 * a1) + (a2 * a2 + a3 * a3));
            const float b0 = __uint_as_float(wk[q] << 16), b1 = __uint_as_float(wk[q] & 0xffff0000u);
            const float s2 = wave_sum(b0 * b0 + b1 * b1);
            if (lane == 0) { rq[row] = 1.0f / sqrtf(s1 * (1.f / 256.f) + RMS_EPS); rkv[row] = 1.0f / sqrtf(s2 * (1.f / 128.f) + RMS_EPS); }
        }
    }
    const float* KMF = (const float*)(F.ws + WS_KM_F); float* kmean = (float*)(F.ws + WS_KMEAN);
    for (int task = gw; task < 512; task += NGW) {
        const int b = task >> 6, blk = (task >> 2) & 15, h = task & 3;
        const float* p = KMF + ((size_t)(b * T + blk * 256)) * 256 + h * 64 + lane; float s = 0.f;
#pragma unroll 32
        for (int i = 0; i < 256; ++i) s += p[(size_t)i * 256];
        kmean[((b * 4 + h) * 16 + blk) * 64 + lane] = s * (1.f / 256.f);
    }
}
__device__ __forceinline__ void cmp2_phase(Frame& F, int l) {
    const int wave = cur_wave(), gw = blockIdx.x * NWAVES + wave, NGW = F.G * NWAVES, lane = cur_lane();
    const float* cmph = (const float*)(F.ws + WS_CMPH);
    for (int task = gw; task < 2 * 8 * 255; task += NGW) {
        const int kv = task / 2040, r1 = task - kv * 2040, b = r1 / 255, n = r1 - b * 255;
        const float* hp = cmph + ((size_t)(kv * 8 + b) * 256 + n) * 256;
        const float* w2 = F.A->in[kv ? I_CV2 : I_CK2] + (size_t)l * 256 * 64 + lane;
        float acc = 0.f;
#pragma unroll 32
        for (int j = 0; j < 256; ++j) acc += hp[j] * w2[j * 64];
        ((float*)(F.ws + (kv ? WS_VCMP : WS_KCMP)))[((size_t)b * 256 + n) * 64 + lane] = acc;
        ((bf16*)(F.ws + (kv ? WS_VCMPB : WS_KCMPB)))[((size_t)b * 256 + n) * 64 + lane] = (bf16)f2bf(acc);
    }
    for (int task = gw; task < 16; task += NGW) ((bf16*)(F.ws + ((task & 1) ? WS_VCMPB : WS_KCMPB)))[((size_t)(task >> 1) * 256 + 255) * 64 + lane] = 0;
}
__device__ __forceinline__ void mla_rows_phase(Frame& F) {
    const int wave = cur_wave(), gw = blockIdx.x * NWAVES + wave, NGW = F.G * NWAVES, lane = cur_lane();
    const bf16* Q = (const bf16*)(F.ws + WS_QMLA); bf16* Y = (bf16*)F.out + (size_t)M * D;
    LAS float* q = (LAS float*)(F.lds + RING_OFF + wave * 16384 + 4096);
    for (int i = gw; i < M * 4; i += NGW) {
        int t, bh; task_bt(i, t, bh); const int b = bh >> 2, h = bh & 3, row = b * T + t;
        if (lane < 48) { const unsigned w = ((const unsigned*)(Q + (size_t)row * 384 + h * 96))[lane]; q[2 * lane] = __uint_as_float(w << 16); q[2 * lane + 1] = __uint_as_float(w & 0xffff0000u); }
        LDS_WAIT(); asm volatile("" ::: "memory");
        KVbf kv{(const bf16*)(F.ws + WS_KMLA) + h * 96, (const bf16*)(F.ws + WS_VMLA) + h * 64, 384, 256};
        const int base = b * T;
        auto keyf = [&](int s) { const int p = lane + 64 * s; return p <= t ? base + p : -1; };
        const float r = wave_attend<96>(q, 0.10206207261596577f, (t >> 6) + 1, keyf, kv, lane);
        Y[(size_t)row * 1024 + 256 + h * 64 + lane] = (bf16)f2bf(r);
        LDS_WAIT(); asm volatile("" ::: "memory");
    }
}
__device__ __forceinline__ void moba_rows_phase(Frame& F) {
    const int wave = cur_wave(), gw = blockIdx.x * NWAVES + wave, NGW = F.G * NWAVES, lane = cur_lane();
    const float* QF = (const float*)(F.ws + WS_QM_F); const float* kmean = (const float*)(F.ws + WS_KMEAN); bf16* Y = (bf16*)F.out + (size_t)M * D;
    LAS float* q = (LAS float*)(F.lds + RING_OFF + wave * 16384 + 4096);
    for (int i = gw; i < M * 4; i += NGW) {
        int t, bh; task_bt(i, t, bh); const int b = bh >> 2, h = bh & 3, row = b * T + t, own = t >> 8;
        q[lane] = QF[(size_t)row * 256 + h * 64 + lane];
        LDS_WAIT(); asm volatile("" ::: "memory");
        float g = -INFINITY;
        if (lane < own) { KVf32 km{kmean + (size_t)((b * 4 + h) * 16) * 64, nullptr, 64, 64}; g = km.dot<64>(lane, q); }
        unsigned selmask = 0u;
        for (int r = 0; r < 3; ++r) { const float mx = wave_max(g); if (!(mx > -INFINITY)) break;
            const unsigned long long ball = __ballot(g == mx); const int sl = __ffsll((long long)ball) - 1; selmask |= 1u << sl; if (lane == sl) g = -INFINITY; }
        KVbf kv{(const bf16*)(F.ws + WS_KM_BF) + h * 64, (const bf16*)(F.ws + WS_VM_BF) + h * 64, 256, 256};
        const int base = b * T;
        auto keyf = [&](int s) { const int blk = s >> 2, p = 64 * s + lane; return blk == own ? (p <= t ? base + p : -1) : (((selmask >> blk) & 1u) ? base + p : -1); };
        const float r = wave_attend<64>(q, 0.125f, 4 * own + 4, keyf, kv, lane);
        Y[(size_t)row * 1024 + h * 64 + lane] = (bf16)f2bf(r);
        LDS_WAIT(); asm volatile("" ::: "memory");
    }
}
__device__ __forceinline__ void nsa_tokens_phase(Frame& F) {
    const int wave = cur_wave(), gw = blockIdx.x * NWAVES + wave, NGW = F.G * NWAVES, lane = cur_lane();
    const bf16* QN = (const bf16*)(F.ws + WS_QN); bf16* Y = (bf16*)F.out + (size_t)M * D;
    const float* kcmp = (const float*)(F.ws + WS_KCMP); const float* vcmp = (const float*)(F.ws + WS_VCMP); const float* GWp = (const float*)(F.ws + WS_GW);
    LAS float* ps = (LAS float*)(F.lds + RING_OFF + wave * 16384);
    LAS float* ocs = ps + 256;
    LAS float* svl = ps + 512;
    LAS float* q = (LAS float*)(F.lds + RING_OFF + wave * 16384 + 4096);
    for (int i = gw; i < M; i += NGW) {
        int t, b; task_bt(i, t, b); const int row = b * T + t, own = t >> 6, base = b * T;
#pragma unroll
        for (int k = 0; k < 4; ++k) ps[lane + 64 * k] = 0.f;
#pragma unroll 1
        for (int h = 0; h < 4; ++h) {
            LDS_WAIT(); asm volatile("" ::: "memory");
            q[lane] = bf2f(QN[(size_t)row * 256 + h * 64 + lane]);
            LDS_WAIT(); asm volatile("" ::: "memory");
            KVf32 kc{kcmp + (size_t)b * 256 * 64, vcmp + (size_t)b * 256 * 64, 64, 64};
            float ml = -INFINITY;
#pragma unroll 1
            for (int k = 0; k < 4; ++k) { const int n = lane + 64 * k; const bool valid = (n < 255) && (16 * n + 31 <= t);
                float sv = -INFINITY; if (valid) sv = kc.dot<64>(n, q) * 0.125f; svl[n] = sv; ml = fmaxf(ml, sv); }
            const float Mx = wave_max(ml);
            float o[64];
#pragma unroll
            for (int d = 0; d < 64; ++d) o[d] = 0.f;
#ifndef NSA_NO_C
            if (Mx > -INFINITY) {
                float ls = 0.f;
#pragma unroll 1
                for (int k = 0; k < 4; ++k) { const float sv = svl[lane + 64 * k]; const float p = sv > -INFINITY ? __expf(sv - Mx) : 0.f; ls += p; svl[lane + 64 * k] = p; }
                const float inv = 1.0f / wave_sum(ls);
#pragma unroll 1
                for (int k = 0; k < 4; ++k) { const float p = svl[lane + 64 * k] * inv; ps[lane + 64 * k] += p; if (p > 0.f) kc.axpy(lane + 64 * k, p, o); }
            }
#endif
            ocs[h * 64 + lane] = reduce64(o, lane);
        }
        LDS_WAIT(); asm volatile("" ::: "memory");
        float imp = (ps[4 * lane] + ps[4 * lane + 1]) + (ps[4 * lane + 2] + ps[4 * lane + 3]); if (lane > 0) imp += ps[4 * lane - 1];
        LDS_WAIT(); asm volatile("" ::: "memory");
        const bool causal = lane <= own, forced = causal && (lane == 0 || lane >= own - 1);
        float val = forced ? 1e4f : (causal ? imp : -INFINITY);
        unsigned long long selmask = 0ull;
        for (int r = 0; r < 16; ++r) { const float mx = wave_max(val); if (!(mx > -INFINITY)) break;
            const unsigned long long ball = __ballot(val == mx); const int sl = __ffsll((long long)ball) - 1; selmask |= 1ull << sl; if (lane == sl) val = -INFINITY; }
#ifdef FLASH_NSA
        if (lane == 0) ((unsigned long long*)(F.ws + WS_NSEL))[row] = selmask;
#pragma unroll
        for (int h = 0; h < 4; ++h) ((bf16*)(F.ws + WS_OC))[(size_t)row * 256 + h * 64 + lane] = (bf16)f2bf(ocs[h * 64 + lane]);
        LDS_WAIT(); asm volatile("" ::: "memory");
        continue;
#endif
#pragma unroll 1
        for (int h = 0; h < 4; ++h) {
            LDS_WAIT(); asm volatile("" ::: "memory");
            q[lane] = bf2f(QN[(size_t)row * 256 + h * 64 + lane]);
            LDS_WAIT(); asm volatile("" ::: "memory");
            KVbf ks{(const bf16*)(F.ws + WS_KS), (const bf16*)(F.ws + WS_VS), 64, 64};
            auto keys = [&](int s) { const int p = 64 * s + lane; return (((selmask >> s) & 1ull) && p <= t) ? base + p : -1; };
#ifdef NSA_NO_S
            float os = q[3];
#else
            float os = wave_attend<64>(q, 0.125f, own + 1, keys, ks, lane);
            asm volatile("" : "+v"(os) :: "memory");
#endif
            KVbf kw{(const bf16*)(F.ws + WS_KW), (const bf16*)(F.ws + WS_VW), 64, 64};
            auto keyw = [&](int s) { const int p = t - 511 + lane + 64 * s; return p >= 0 ? base + p : -1; };
#ifdef NSA_NO_W
            float ow = q[5];
#else
            float ow = wave_attend<64>(q, 0.125f, 8, keyw, kw, lane);
            asm volatile("" : "+v"(ow) :: "memory");
#endif
            const float* gp = GWp + (size_t)row * 32 + h * 3;
            const float g0 = sigmoid_f(gp[0]), g1 = sigmoid_f(gp[1]), g2 = sigmoid_f(gp[2]);
            Y[(size_t)row * 1024 + 512 + h * 64 + lane] = (bf16)f2bf(g0 * ocs[h * 64 + lane] + g1 * os + g2 * ow);
        }
    }
}
__device__ __forceinline__ void dsa_tokens_phase(Frame& F) {
    const int wave = cur_wave(), gw = blockIdx.x * NWAVES + wave, NGW = F.G * NWAVES, lane = cur_lane();
    const float* IQ = (const float*)(F.ws + WS_IQ); const float* IK = (const float*)(F.ws + WS_IK); const float* GWp = (const float*)(F.ws + WS_GW);
    const bf16* QD = (const bf16*)(F.ws + WS_QD); bf16* Y = (bf16*)F.out + (size_t)M * D;
    LAS float* sc = (LAS float*)(F.lds + RING_OFF + wave * 16384);
    LAS unsigned* hist = (LAS unsigned*)(F.lds + XTRA_OFF + wave * XTRA_WAVE);
    LAS unsigned short* idx = (LAS unsigned short*)hist;
    LAS float* xq = (LAS float*)(F.lds + XTRA_OFF + wave * XTRA_WAVE + 1024);
    for (int i = gw; i < M; i += NGW) {
        int t, b; task_bt(i, t, b); const int row = b * T + t, base = b * T, n = t + 1;
#pragma unroll
        for (int k = 0; k < 4; ++k) xq[lane + 64 * k] = IQ[(size_t)row * 256 + lane + 64 * k];
        if (lane < 8) xq[256 + lane] = GWp[(size_t)row * 32 + 12 + lane];
        LDS_WAIT(); asm volatile("" ::: "memory");
        for (int k0 = 0; k0 < n; k0 += 64) {
            const int key = k0 + lane;
            if (key < n) {
                float ik[32];
                { const f32x4* kp = (const f32x4*)(IK + (size_t)(base + key) * 32);
#pragma unroll
                  for (int c = 0; c < 8; ++c) { const f32x4 f = kp[c]; ik[4 * c] = f.x; ik[4 * c + 1] = f.y; ik[4 * c + 2] = f.z; ik[4 * c + 3] = f.w; } }
                float score = 0.f;
#pragma unroll
                for (int h = 0; h < 8; ++h) { float ds = 0.f;
#pragma unroll
                    for (int c = 0; c < 8; ++c) { const f32x4 qv = *(const LAS f32x4*)(xq + h * 32 + 4 * c); ds += (qv.x * ik[4 * c] + qv.y * ik[4 * c + 1]) + (qv.z * ik[4 * c + 2] + qv.w * ik[4 * c + 3]); }
                    score += xq[256 + h] * fmaxf(ds, 0.f); }
                sc[key] = score * 0.0625f + 0.0f;
            }
        }
        LDS_WAIT(); asm volatile("" ::: "memory");
        int nsel = n;
        if (n > 256) {
            unsigned prefix = 0u, pmask = 0u; int kk = 256;
            for (int pass = 0; pass < 4; ++pass) {
                const int shift = 24 - 8 * pass;
#pragma unroll
                for (int k = 0; k < 4; ++k) hist[lane + 64 * k] = 0u;
                LDS_WAIT(); asm volatile("" ::: "memory");
                for (int k0 = 0; k0 < n; k0 += 64) { const int key = k0 + lane;
                    if (key < n) { const unsigned u = fkey(sc[key]); if ((u & pmask) == prefix) __hip_atomic_fetch_add(hist + ((u >> shift) & 255u), 1u, __ATOMIC_RELAXED, __HIP_MEMORY_SCOPE_WORKGROUP); } }
                LDS_WAIT(); asm volatile("" ::: "memory");
                const int h0 = (int)hist[4 * lane], h1 = (int)hist[4 * lane + 1], h2 = (int)hist[4 * lane + 2], h3 = (int)hist[4 * lane + 3];
                const int tot = (h0 + h1) + (h2 + h3); int incl = tot;
#pragma unroll
                for (int o = 1; o < 64; o <<= 1) { const int v = __shfl_down(incl, o); if (lane + o < 64) incl += v; }
                int run = incl - tot, found = -1, newk = 0;
                if (run < kk && run + h3 >= kk) { found = 4 * lane + 3; newk = kk - run; } run += h3;
                if (found < 0 && run < kk && run + h2 >= kk) { found = 4 * lane + 2; newk = kk - run; } run += h2;
                if (found < 0 && run < kk && run + h1 >= kk) { found = 4 * lane + 1; newk = kk - run; } run += h1;
                if (found < 0 && run < kk && run + h0 >= kk) { found = 4 * lane; newk = kk - run; }
                const unsigned long long ball = __ballot(found >= 0); const int src = __ffsll((long long)ball) - 1;
                const int bin = __shfl(found, src); kk = __shfl(newk, src);
                prefix |= (unsigned)bin << shift; pmask |= 255u << shift;
                LDS_WAIT(); asm volatile("" ::: "memory");
            }
            int eqseen = 0, cnt = 0;
            for (int k0 = 0; k0 < n; k0 += 64) { const int key = k0 + lane; const bool inb = key < n; const unsigned u = inb ? fkey(sc[key]) : 0u;
                const bool gt = inb && u > prefix, eq = inb && u == prefix;
                const unsigned long long be = __ballot(eq); const bool sel = gt || (eq && (eqseen + mbcnt64(be)) < kk);
                const unsigned long long bs = __ballot(sel); if (sel) idx[cnt + mbcnt64(bs)] = (unsigned short)key;
#ifdef FLASH_DSA
                if (lane == 0) ((unsigned long long*)(F.ws + WS_DSAMASK))[(size_t)row * 64 + (k0 >> 6)] = bs;
#endif
                eqseen += __popcll(be); cnt += __popcll(bs); }
            nsel = cnt;
            LDS_WAIT(); asm volatile("" ::: "memory");
        }
#ifdef FLASH_DSA
        if (n <= 256) { for (int k0 = 0; k0 < n; k0 += 64) if (lane == 0) ((unsigned long long*)(F.ws + WS_DSAMASK))[(size_t)row * 64 + (k0 >> 6)] = causal_word(t - k0); }
        continue;
#endif
        int kidx[4];
#pragma unroll
        for (int k = 0; k < 4; ++k) { const int p = lane + 64 * k; kidx[k] = p < nsel ? base + (n > 256 ? (int)idx[p] : p) : -1; }
        LDS_WAIT(); asm volatile("" ::: "memory");
#pragma unroll 1
        for (int h = 0; h < 4; ++h) {
            LDS_WAIT(); asm volatile("" ::: "memory");
            xq[lane] = bf2f(QD[(size_t)row * 256 + h * 64 + lane]);
            LDS_WAIT(); asm volatile("" ::: "memory");
            KVbf kd{(const bf16*)(F.ws + WS_KD), (const bf16*)(F.ws + WS_VD), 64, 64};
            auto keyf = [&](int s) { return s == 0 ? kidx[0] : s == 1 ? kidx[1] : s == 2 ? kidx[2] : kidx[3]; };
            const float r = wave_attend<64>(xq, 0.125f, 4, keyf, kd, lane);
            Y[(size_t)row * 1024 + 768 + h * 64 + lane] = (bf16)f2bf(r);
        }
        LDS_WAIT(); asm volatile("" ::: "memory");
    }
}
typedef float f32x16 __attribute__((ext_vector_type(16)));
__device__ __forceinline__ float xhalf_max(float v) { const auto rr = __builtin_amdgcn_permlane32_swap(__float_as_uint(v), __float_as_uint(v), false, false); return fmaxf(__uint_as_float(rr[0]), __uint_as_float(rr[1])); }
__device__ __forceinline__ float xhalf_sum(float v) { const auto rr = __builtin_amdgcn_permlane32_swap(__float_as_uint(v), __float_as_uint(v), false, false); return __uint_as_float(rr[0]) + __uint_as_float(rr[1]); }
__device__ __forceinline__ float xhalf_other(float v, int hh) { const auto rr = __builtin_amdgcn_permlane32_swap(__float_as_uint(v), __float_as_uint(v), false, false); return __uint_as_float(hh ? rr[0] : rr[1]); }
constexpr int FL_KP96 = 208, FL_KP64 = 144, FL_VP = 144;
constexpr int FL_KBUF = 0, FL_KBUF_SZ = 64 * FL_KP96, FL_VBUF = 2 * FL_KBUF_SZ, FL_VBUF_SZ = 64 * FL_VP;
constexpr int FL_TL = FL_VBUF + 2 * FL_VBUF_SZ, FL_TLN = FL_TL + 64, FL_ORM = FL_TLN + 8, FL_SEL = FL_TL + 128;
constexpr int FL_END = FL_SEL + 512;
static_assert(FL_END <= RING_BYTES, "flash LDS map");
struct FlashKV { const bf16* K; const bf16* V; int kp, vp; };


template <int MODE>
__device__ __forceinline__ void fl_softmax(f32x16& p0, f32x16& p1, const unsigned long long word, const int h, const float sc2, float& m, float& lsum, f32x16& o0, f32x16& o1) {
    if (MODE == 2) {
        const unsigned wlo = (unsigned)word >> (4 * h), whi = (unsigned)(word >> 32) >> (4 * h);
#pragma unroll
        for (int i = 0; i < 16; ++i) { const int bit = (i & 3) + 8 * (i >> 2);
            p0[i] = (wlo & (1u << bit)) ? p0[i] : -INFINITY; p1[i] = (whi & (1u << bit)) ? p1[i] : -INFINITY; }
    }
    float mx, mx2;
    asm("v_max3_f32 %0, %1, %2, %3" : "=v"(mx) : "v"(p0[0]), "v"(p0[1]), "v"(p0[2]));
    asm("v_max3_f32 %0, %1, %2, %3" : "=v"(mx2) : "v"(p1[0]), "v"(p1[1]), "v"(p1[2]));
#pragma unroll
    for (int i = 3; i < 15; i += 2) { asm("v_max3_f32 %0, %1, %2, %3" : "=v"(mx) : "v"(mx), "v"(p0[i]), "v"(p0[i + 1])); asm("v_max3_f32 %0, %1, %2, %3" : "=v"(mx2) : "v"(mx2), "v"(p1[i]), "v"(p1[i + 1])); }
    asm("v_max3_f32 %0, %1, %2, %3" : "=v"(mx) : "v"(mx), "v"(p0[15]), "v"(p1[15]));
    asm("v_max_f32_e32 %0, %1, %2" : "=v"(mx) : "v"(mx), "v"(mx2));
    const bool rowon = (MODE != 1) || (word != 0ull);
    if (MODE == 1) mx = rowon ? mx : -INFINITY;
    mx = xhalf_max(mx);
    const float mn = fmaxf(m, mx * sc2);
    if (__any(mn > m)) { const float alpha = __builtin_amdgcn_exp2f(m - mn); lsum *= alpha;
#pragma unroll
        for (int i = 0; i < 16; ++i) { o0[i] *= alpha; o1[i] *= alpha; } }
    m = mn;
    const float nm = rowon ? -mn : -INFINITY;
    float ps = 0.f;
#pragma unroll
    for (int i = 0; i < 16; ++i) { p0[i] = __builtin_amdgcn_exp2f(__builtin_fmaf(p0[i], sc2, nm)); p1[i] = __builtin_amdgcn_exp2f(__builtin_fmaf(p1[i], sc2, nm)); ps += p0[i] + p1[i]; }
    lsum += ps;
}
template <int DQK, class MaskFn>
__device__ __forceinline__ void flash_unit(LAS unsigned char* lds, const FlashKV kv, const bf16* qrow, const float sc2  , const int ntiles,
                                           const MaskFn& maskf, f32x16& o0, f32x16& o1, float& lsum) {
    constexpr int KP = (DQK == 96) ? FL_KP96 : FL_KP64, NKS = DQK / 16, CPR = DQK / 8;
    const int tid = cur_tid(), lane = tid & 63, r = lane & 31, h = lane >> 5;
    const LAS unsigned char* tl = lds + FL_TL;
    bf16x8 qf[NKS];
#pragma unroll
    for (int ks = 0; ks < NKS; ++ks) qf[ks] = *(const GAS bf16x8*)(qrow + 16 * ks + 8 * h);
    const int kr0 = tid / CPR, kc0 = tid - kr0 * CPR;
    const int kr1 = (tid + 512) / CPR, kc1 = (tid + 512) - kr1 * CPR;
    const bool has2 = (DQK == 96) && (tid < 256);
    const int vr = tid >> 3, vc = tid & 7;
    struct StageRegs { v4u k0, k1, v; };
    StageRegs S0, S1; S0.k1 = (v4u){0u, 0u, 0u, 0u}; S1.k1 = (v4u){0u, 0u, 0u, 0u};
    auto gload = [&](StageRegs& S, int tile) {
        const size_t rowb = (size_t)tile * 64;
        S.k0 = *(const GAS v4u*)(kv.K + (rowb + kr0) * kv.kp + 8 * kc0);
        if (DQK == 96) S.k1 = *(const GAS v4u*)(kv.K + (rowb + (has2 ? kr1 : kr0)) * kv.kp + 8 * (has2 ? kc1 : kc0));
        S.v = *(const GAS v4u*)(kv.V + (rowb + vr) * kv.vp + 8 * vc);
    };
    auto lstore = [&](const StageRegs& S, int buf) {
        LAS unsigned char* Kb = lds + FL_KBUF + buf * FL_KBUF_SZ; LAS unsigned char* Vb = lds + FL_VBUF + buf * FL_VBUF_SZ;
        *(LAS v4u*)(Kb + kr0 * KP + 16 * kc0) = S.k0;
        if (has2) *(LAS v4u*)(Kb + kr1 * KP + 16 * kc1) = S.k1;
        *(LAS v4u*)(Vb + vr * FL_VP + 16 * vc) = S.v;
    };
    float m = -1e30f; lsum = 0.f;
    __syncthreads();
#pragma unroll
    for (int i = 0; i < 16; ++i) { o0[i] = 0.f; o1[i] = 0.f; }
    unsigned long long wnext = 0ull;
    if (ntiles > 0) { wnext = maskf((int)tl[0]); gload(S0, (int)tl[0]); lstore(S0, 0); }
    if (ntiles > 0) gload(S1, (int)tl[ntiles > 1 ? 1 : 0]);
#pragma unroll
    for (int ks = 0; ks < NKS; ++ks) asm volatile("" :: "v"(qf[ks]));
    __syncthreads();
    auto step = [&](const int it, StageRegs& Sload, const StageRegs& Sstore) __attribute__((always_inline)) {
        const int cur = it & 1;
        const unsigned long long word = wnext;
        wnext = maskf((int)tl[it + 1 < ntiles ? it + 1 : ntiles - 1]);
        gload(Sload, (int)tl[it + 2 < ntiles ? it + 2 : ntiles - 1]);
        if (!__all(word == 0ull)) {
            const LAS unsigned char* Kb = lds + FL_KBUF + cur * FL_KBUF_SZ; const LAS unsigned char* Vb = lds + FL_VBUF + cur * FL_VBUF_SZ;
            f32x16 p0, p1;
#pragma unroll
            for (int i = 0; i < 16; ++i) { p0[i] = 0.f; p1[i] = 0.f; }
#pragma unroll
            for (int ks = 0; ks < NKS; ++ks) {
                const bf16x8 a0 = *(const LAS bf16x8*)(Kb + r * KP + (16 * ks + 8 * h) * 2), a1 = *(const LAS bf16x8*)(Kb + (32 + r) * KP + (16 * ks + 8 * h) * 2);
                p0 = __builtin_amdgcn_mfma_f32_32x32x16_bf16(a0, qf[ks], p0, 0, 0, 0);
                p1 = __builtin_amdgcn_mfma_f32_32x32x16_bf16(a1, qf[ks], p1, 0, 0, 0);
            }
            if (__all(word == ~0ull)) fl_softmax<0>(p0, p1, word, h, sc2, m, lsum, o0, o1);
            else if (__all(word == ~0ull || word == 0ull)) fl_softmax<1>(p0, p1, word, h, sc2, m, lsum, o0, o1);
            else fl_softmax<2>(p0, p1, word, h, sc2, m, lsum, o0, o1);
            bf16x8 pf[4];
#pragma unroll
            for (int s = 0; s < 4; ++s) { v4u w;
                if (s < 2) { w.x = pg8::cvt_pk_bf16(p0[8 * s], p0[8 * s + 1]); w.y = pg8::cvt_pk_bf16(p0[8 * s + 2], p0[8 * s + 3]); w.z = pg8::cvt_pk_bf16(p0[8 * s + 4], p0[8 * s + 5]); w.w = pg8::cvt_pk_bf16(p0[8 * s + 6], p0[8 * s + 7]); }
                else { const int s2 = s - 2; w.x = pg8::cvt_pk_bf16(p1[8 * s2], p1[8 * s2 + 1]); w.y = pg8::cvt_pk_bf16(p1[8 * s2 + 2], p1[8 * s2 + 3]); w.z = pg8::cvt_pk_bf16(p1[8 * s2 + 4], p1[8 * s2 + 5]); w.w = pg8::cvt_pk_bf16(p1[8 * s2 + 6], p1[8 * s2 + 7]); }
                pf[s] = __builtin_bit_cast(bf16x8, w); }
            {
                typedef short v4i16_t __attribute__((ext_vector_type(4)));
                const LAS unsigned char* vbase = Vb + (4 * h + ((lane & 15) >> 2)) * FL_VP + (16 * ((lane >> 4) & 1) + 4 * (lane & 3)) * 2;
#pragma unroll
                for (int s = 0; s < 4; ++s) {
#pragma unroll
                    for (int db = 0; db < 2; ++db) {
                        const LAS unsigned char* vp_ = vbase + (32 * (s >> 1) + 16 * (s & 1)) * FL_VP + 64 * db;
                        const v4i16_t lo = __builtin_amdgcn_ds_read_tr16_b64_v4i16((LAS v4i16_t*)vp_), hi = __builtin_amdgcn_ds_read_tr16_b64_v4i16((LAS v4i16_t*)(vp_ + 8 * FL_VP));
                        const bf16x8 a = {lo[0], lo[1], lo[2], lo[3], hi[0], hi[1], hi[2], hi[3]};
                        if (db == 0) o0 = __builtin_amdgcn_mfma_f32_32x32x16_bf16(a, pf[s], o0, 0, 0, 0);
                        else o1 = __builtin_amdgcn_mfma_f32_32x32x16_bf16(a, pf[s], o1, 0, 0, 0);
                    }
                }
            }
        }
        if (it + 1 < ntiles) lstore(Sstore, cur ^ 1);
        __syncthreads();
    };
    for (int it = 0; it < ntiles; it += 2) { step(it, S0, S1); if (it + 1 < ntiles) step(it + 1, S1, S0); }
}
__device__ __forceinline__ void flash_store(bf16* yrow  , const f32x16& o0, const f32x16& o1, float inv, int h) {
#pragma unroll
    for (int g = 0; g < 4; ++g) {
        typedef unsigned u32x2v __attribute__((ext_vector_type(2)));
        u32x2v w0, w1;
        w0.x = pg8::cvt_pk_bf16(o0[4 * g] * inv, o0[4 * g + 1] * inv); w0.y = pg8::cvt_pk_bf16(o0[4 * g + 2] * inv, o0[4 * g + 3] * inv);
        w1.x = pg8::cvt_pk_bf16(o1[4 * g] * inv, o1[4 * g + 1] * inv); w1.y = pg8::cvt_pk_bf16(o1[4 * g + 2] * inv, o1[4 * g + 3] * inv);
        *(u32x2v*)(yrow + 8 * g + 4 * h) = w0; *(u32x2v*)(yrow + 32 + 8 * g + 4 * h) = w1;
    }
}

__device__ __forceinline__ void mla_flash_phase(Frame& F) {
    const int tid = cur_tid(), wave = cur_wave(), lane = tid & 63, r = lane & 31, h2 = lane >> 5;
    bf16* Y = (bf16*)F.out + (size_t)M * D;
    for (int pass = 0; pass < 2; ++pass) {
        for (int u0 = blockIdx.x; u0 < 256; u0 += F.G) {
            const int u = pass ? 511 - u0 : u0, qb = u >> 5, bh = u & 31, b = bh >> 2, hd = bh & 3;
            const int t = 256 * qb + 32 * wave + r; const size_t row = (size_t)b * T + t;
            LAS unsigned char* tl = F.lds + FL_TL;
            if (tid < 64) tl[tid] = (unsigned char)tid;
            const int ntiles = 4 * qb + 4;
            FlashKV kv{(const bf16*)(F.ws + WS_KMLA) + (size_t)b * T * 384 + hd * 96, (const bf16*)(F.ws + WS_VMLA) + (size_t)b * T * 256 + hd * 64, 384, 256};
            auto maskf = [&](int tile) { return causal_word(t - 64 * tile); };
            f32x16 o0, o1; float ls;
            flash_unit<96>(F.lds, kv, (const bf16*)(F.ws + WS_QMLA) + row * 384 + hd * 96, 0.10206207261596577f * 1.4426950408889634f, ntiles, maskf, o0, o1, ls);
            ls = xhalf_sum(ls);
            flash_store(Y + row * 1024 + 256 + hd * 64, o0, o1, ls > 0.f ? 1.0f / ls : 0.f, h2);
        }
    }
}

__device__ __forceinline__ void moba_flash_phase(Frame& F) {
    const int tid = cur_tid(), wave = cur_wave(), lane = tid & 63, r = lane & 31, h2 = lane >> 5;
    bf16* Y = (bf16*)F.out + (size_t)M * D;
    const float* QF = (const float*)(F.ws + WS_QM_F); const float* kmean = (const float*)(F.ws + WS_KMEAN);
    LAS unsigned short* msel = (LAS unsigned short*)(F.lds + FL_SEL); LAS unsigned* orm = (LAS unsigned*)(F.lds + FL_ORM); LAS unsigned char* tl = F.lds + FL_TL; LAS int* tln = (LAS int*)(F.lds + FL_TLN);
    for (int pass = 0; pass < 2; ++pass) {
        for (int u0 = blockIdx.x; u0 < 256; u0 += F.G) {
            const int u = pass ? 511 - u0 : u0, own = u >> 5, bh = u & 31, b = bh >> 2, hd = bh & 3;
            if (tid == 0) orm[0] = 0u;
            __syncthreads();
            if (tid < 256) {
                const float* qp = QF + ((size_t)b * T + 256 * own + tid) * 256 + hd * 64;
                const float* km = kmean + (size_t)((b * 4 + hd) * 16) * 64;
                f32x4 qv[16];
#pragma unroll
                for (int c = 0; c < 16; ++c) qv[c] = *(const f32x4*)(qp + 4 * c);
                float g[15];
#pragma unroll
                for (int j = 0; j < 15; ++j) { g[j] = 0.f;
                    if (j < own) { float a = 0.f;
#pragma unroll
                        for (int c = 0; c < 16; ++c) { const f32x4 kv4 = *(const f32x4*)(km + j * 64 + 4 * c); a += (qv[c].x * kv4.x + qv[c].y * kv4.y) + (qv[c].z * kv4.z + qv[c].w * kv4.w); }
                        g[j] = a; } }
                unsigned sel = 0u;
#pragma unroll
                for (int rr = 0; rr < 3; ++rr) { float best = -INFINITY; int bi = -1;
#pragma unroll
                    for (int j = 0; j < 15; ++j) if (j < own && !((sel >> j) & 1u) && g[j] > best) { best = g[j]; bi = j; }
                    if (bi >= 0) sel |= 1u << bi; }
                msel[tid] = (unsigned short)sel;
                __hip_atomic_fetch_or(orm, sel, __ATOMIC_RELAXED, __HIP_MEMORY_SCOPE_WORKGROUP);
            }
            __syncthreads();
            if (tid == 0) { const unsigned om = orm[0]; int n = 0;
                for (int j = 0; j < own; ++j) if ((om >> j) & 1u) { for (int q4 = 0; q4 < 4; ++q4) tl[n++] = (unsigned char)(4 * j + q4); }
                for (int q4 = 0; q4 < 4; ++q4) tl[n++] = (unsigned char)(4 * own + q4);
                tln[0] = n; }
            __syncthreads();
            const int ntiles = tln[0];
            const int tq = 32 * wave + r, t = 256 * own + tq; const size_t row = (size_t)b * T + t;
            const unsigned mysel = msel[tq];
            FlashKV kv{(const bf16*)(F.ws + WS_KM_BF) + (size_t)b * T * 256 + hd * 64, (const bf16*)(F.ws + WS_VM_BF) + (size_t)b * T * 256 + hd * 64, 256, 256};
            auto maskf = [&](int tile) { const int blk = tile >> 2; return blk == own ? causal_word(t - 64 * tile) : (((mysel >> blk) & 1u) ? ~0ull : 0ull); };
            f32x16 o0, o1; float ls;
            flash_unit<64>(F.lds, kv, (const bf16*)(F.ws + WS_QM_BF) + row * 256 + hd * 64, 0.125f * 1.4426950408889634f, ntiles, maskf, o0, o1, ls);
            ls = xhalf_sum(ls);
            flash_store(Y + row * 1024 + hd * 64, o0, o1, ls > 0.f ? 1.0f / ls : 0.f, h2);
        }
    }
}
__device__ __forceinline__ void dsa_flash_phase(Frame& F) {
    const int tid = cur_tid(), wave = cur_wave(), lane = tid & 63, r = lane & 31, h2 = lane >> 5;
    bf16* Y = (bf16*)F.out + (size_t)M * D;
    const unsigned long long* BM = (const unsigned long long*)(F.ws + WS_DSAMASK);
    for (int pass = 0; pass < 2; ++pass) {
        for (int u0 = blockIdx.x; u0 < 256; u0 += F.G) {
            const int u = pass ? 511 - u0 : u0, tb = u >> 3, b = u & 7, hd = wave >> 1;
            const int t = 64 * tb + 32 * (wave & 1) + r; const size_t row = (size_t)b * T + t;
            LAS unsigned char* tl = F.lds + FL_TL;
            __syncthreads();
            if (tid < 64) tl[tid] = (unsigned char)tid;
            const int ntiles = tb + 1;
            FlashKV kv{(const bf16*)(F.ws + WS_KD) + (size_t)b * T * 64, (const bf16*)(F.ws + WS_VD) + (size_t)b * T * 64, 64, 64};
            const unsigned long long* bmrow = BM + row * 64;
            auto maskf = [&](int tile) { return bmrow[tile]; };
            f32x16 o0, o1; float ls;
            flash_unit<64>(F.lds, kv, (const bf16*)(F.ws + WS_QD) + row * 256 + hd * 64, 0.125f * 1.4426950408889634f, ntiles, maskf, o0, o1, ls);
            ls = xhalf_sum(ls);
            flash_store(Y + row * 1024 + 768 + hd * 64, o0, o1, ls > 0.f ? 1.0f / ls : 0.f, h2);
        }
    }
}
__device__ __forceinline__ void nsa_flash_phase(Frame& F) {
    const int tid = cur_tid(), wave = cur_wave(), lane = tid & 63, r = lane & 31, h2 = lane >> 5;
    bf16* Y = (bf16*)F.out + (size_t)M * D;
    const unsigned long long* NSEL = (const unsigned long long*)(F.ws + WS_NSEL); const bf16* OC = (const bf16*)(F.ws + WS_OC); const float* GWp = (const float*)(F.ws + WS_GW);
    LAS unsigned* orm = (LAS unsigned*)(F.lds + FL_ORM); LAS unsigned char* tl = F.lds + FL_TL; LAS int* tln = (LAS int*)(F.lds + FL_TLN);
    for (int pass = 0; pass < 2; ++pass) {
        for (int u0 = blockIdx.x; u0 < 256; u0 += F.G) {
            const int u = pass ? 511 - u0 : u0, tb = u >> 3, b = u & 7, hd = wave >> 1;
            const int t = 64 * tb + 32 * (wave & 1) + r; const size_t row = (size_t)b * T + t;
            const unsigned long long mysel = NSEL[row];
            __syncthreads();
            if (tid < 2) orm[tid] = 0u;
            __syncthreads();
            if (wave < 2) { __hip_atomic_fetch_or(orm, (unsigned)mysel, __ATOMIC_RELAXED, __HIP_MEMORY_SCOPE_WORKGROUP); __hip_atomic_fetch_or(orm + 1, (unsigned)(mysel >> 32), __ATOMIC_RELAXED, __HIP_MEMORY_SCOPE_WORKGROUP); }
            __syncthreads();
            if (tid == 0) { const unsigned long long om = (unsigned long long)orm[0] | ((unsigned long long)orm[1] << 32); int n = 0;
                for (int j = 0; j <= tb; ++j) if ((om >> j) & 1ull) tl[n++] = (unsigned char)j;
                tln[0] = n; }
            __syncthreads();
            const int nsel_tiles = tln[0];
            const bf16* qrow = (const bf16*)(F.ws + WS_QN) + row * 256 + hd * 64;
            const float* gp = GWp + row * 32 + hd * 3;
            const float g0 = sigmoid_f(gp[0]), g1 = sigmoid_f(gp[1]), g2 = sigmoid_f(gp[2]);
            LAS float* stash = (LAS float*)(F.lds + 49152) + wave * 2048 + lane;
            {
                FlashKV kv{(const bf16*)(F.ws + WS_KS) + (size_t)b * T * 64, (const bf16*)(F.ws + WS_VS) + (size_t)b * T * 64, 64, 64};
                auto maskf = [&](int tile) { return ((mysel >> tile) & 1ull) ? causal_word(t - 64 * tile) : 0ull; };
                f32x16 o0, o1; float ls;
                flash_unit<64>(F.lds, kv, qrow, 0.125f * 1.4426950408889634f, nsel_tiles, maskf, o0, o1, ls);
                ls = xhalf_sum(ls); const float sc = ls > 0.f ? g1 / ls : 0.f;
                const bf16* ocr = OC + row * 256 + hd * 64;
#pragma unroll
                for (int g = 0; g < 4; ++g) { const unsigned long long w0 = *(const unsigned long long*)(ocr + 8 * g + 4 * h2), w1 = *(const unsigned long long*)(ocr + 32 + 8 * g + 4 * h2);
                    stash[(4 * g) * 64] = sc * o0[4 * g] + g0 * __uint_as_float((unsigned)w0 << 16); stash[(4 * g + 1) * 64] = sc * o0[4 * g + 1] + g0 * __uint_as_float((unsigned)w0 & 0xffff0000u);
                    stash[(4 * g + 2) * 64] = sc * o0[4 * g + 2] + g0 * __uint_as_float((unsigned)(w0 >> 32) << 16); stash[(4 * g + 3) * 64] = sc * o0[4 * g + 3] + g0 * __uint_as_float((unsigned)(w0 >> 32) & 0xffff0000u);
                    stash[(16 + 4 * g) * 64] = sc * o1[4 * g] + g0 * __uint_as_float((unsigned)w1 << 16); stash[(16 + 4 * g + 1) * 64] = sc * o1[4 * g + 1] + g0 * __uint_as_float((unsigned)w1 & 0xffff0000u);
                    stash[(16 + 4 * g + 2) * 64] = sc * o1[4 * g + 2] + g0 * __uint_as_float((unsigned)(w1 >> 32) << 16); stash[(16 + 4 * g + 3) * 64] = sc * o1[4 * g + 3] + g0 * __uint_as_float((unsigned)(w1 >> 32) & 0xffff0000u); }
            }
            f32x16 a0, a1;
            {
                __syncthreads();
                const int t0 = tb >= 8 ? tb - 8 : 0;
                if (tid < 64) tl[tid] = (unsigned char)(t0 + tid);
                FlashKV kv{(const bf16*)(F.ws + WS_KW) + (size_t)b * T * 64, (const bf16*)(F.ws + WS_VW) + (size_t)b * T * 64, 64, 64};
                auto maskf = [&](int tile) { return causal_word(t - 64 * tile) & ~causal_word(t - 512 - 64 * tile); };
                f32x16 o0, o1; float ls;
                flash_unit<64>(F.lds, kv, qrow, 0.125f * 1.4426950408889634f, tb - t0 + 1, maskf, o0, o1, ls);
                ls = xhalf_sum(ls); const float sc = ls > 0.f ? g2 / ls : 0.f;
#pragma unroll
                for (int i = 0; i < 16; ++i) { a0[i] = sc * o0[i] + stash[i * 64]; a1[i] = sc * o1[i] + stash[(16 + i) * 64]; }
            }
            flash_store(Y + row * 1024 + 512 + hd * 64, a0, a1, 1.0f, h2);
        }
    }
}

__device__ __forceinline__ int hist_pick(LAS unsigned* hist, int& kk, const int lane) {
    const int h0 = (int)hist[4 * lane], h1 = (int)hist[4 * lane + 1], h2 = (int)hist[4 * lane + 2], h3 = (int)hist[4 * lane + 3];
    const int tot = (h0 + h1) + (h2 + h3); int incl = tot;
#pragma unroll
    for (int o = 1; o < 64; o <<= 1) { const int v = __shfl_down(incl, o); if (lane + o < 64) incl += v; }
    int run = incl - tot, found = -1, newk = 0;
    if (run < kk && run + h3 >= kk) { found = 4 * lane + 3; newk = kk - run; } run += h3;
    if (found < 0 && run < kk && run + h2 >= kk) { found = 4 * lane + 2; newk = kk - run; } run += h2;
    if (found < 0 && run < kk && run + h1 >= kk) { found = 4 * lane + 1; newk = kk - run; } run += h1;
    if (found < 0 && run < kk && run + h0 >= kk) { found = 4 * lane; newk = kk - run; }
    const unsigned long long ball = __ballot(found >= 0); const int src = __ffsll((long long)ball) - 1;
    const int bin = __shfl(found, src); kk = __shfl(newk, src);
    return bin;
}
__device__ __forceinline__ float unfkey(unsigned u) { return __uint_as_float((u & 0x80000000u) ? (u ^ 0x80000000u) : ~u); }
__device__ __forceinline__ void radix_select_write(LAS float* sc, LAS unsigned* hist, unsigned long long* bmrow, const int t, const int lane) {
    const int n = t + 1;
    if (n <= 256) { for (int k0 = 0; k0 < n; k0 += 64) if (lane == 0) bmrow[k0 >> 6] = causal_word(t - k0); return; }
#define RS_LOAD4(k0) float x_[4]; { _Pragma("unroll") for (int j_ = 0; j_ < 4; ++j_) { const float v_ = sc[(k0) + 64 * j_ + lane]; x_[j_] = (lane < n - (k0) - 64 * j_) ? v_ : -INFINITY; } }
    float mn = INFINITY, mx = -INFINITY;
    for (int k0 = 0; k0 < n; k0 += 256) { RS_LOAD4(k0);
#pragma unroll
        for (int j = 0; j < 4; ++j) { mx = fmaxf(mx, x_[j]); mn = fminf(mn, x_[j] > -INFINITY ? x_[j] : INFINITY); } }
    mn = -wave_max(-mn); mx = wave_max(mx);
    const float qs = mx > mn ? 255.99f / (mx - mn) : 1.0f, qo = -mn * qs;
#pragma unroll
    for (int k = 0; k < 4; ++k) hist[lane + 64 * k] = 0u;
    LDS_WAIT(); asm volatile("" ::: "memory");
#ifdef SEL_DUP_HIST
    for (int rep3_ = 0; rep3_ < 2; ++rep3_) {
#pragma unroll
    for (int k = 0; k < 4; ++k) hist[lane + 64 * k] = 0u;
    LDS_WAIT(); asm volatile("" ::: "memory");
#endif
    for (int k0 = 0; k0 < n; k0 += 256) { RS_LOAD4(k0);
#pragma unroll
        for (int j = 0; j < 4; ++j) { int q = (int)__builtin_fmaf(x_[j], qs, qo); q = q > 255 ? 255 : (q < 0 ? 0 : q); __hip_atomic_fetch_add(hist + q, 1u, __ATOMIC_RELAXED, __HIP_MEMORY_SCOPE_WORKGROUP); } }
    LDS_WAIT(); asm volatile("" ::: "memory");
#ifdef SEL_DUP_HIST
    }
#endif
    int kk = 256;
    const int B = hist_pick(hist, kk, lane);
    const int cntB = (int)hist[B];
    LDS_WAIT(); asm volatile("" ::: "memory");
#ifdef FORCE_FALLBACK
    if (cntB > 0) {
#else
    if (cntB > 128) {
#endif
        unsigned prefix = 0u, pmask = 0u;
#pragma unroll 1
        for (int pass = 0; pass < 4; ++pass) {
            const int shift = 24 - 8 * pass;
#pragma unroll
            for (int k = 0; k < 4; ++k) hist[lane + 64 * k] = 0u;
            LDS_WAIT(); asm volatile("" ::: "memory");
            for (int k0 = 0; k0 < n; k0 += 256) { RS_LOAD4(k0);
#pragma unroll
                for (int j = 0; j < 4; ++j) { int q = (int)__builtin_fmaf(x_[j], qs, qo); q = q > 255 ? 255 : (q < 0 ? 0 : q);
                    if (q == B) { const unsigned u = fkey(x_[j]); if ((u & pmask) == prefix) __hip_atomic_fetch_add(hist + ((u >> shift) & 255u), 1u, __ATOMIC_RELAXED, __HIP_MEMORY_SCOPE_WORKGROUP); } } }
            LDS_WAIT(); asm volatile("" ::: "memory");
            const int bin = hist_pick(hist, kk, lane);
            prefix |= (unsigned)bin << shift; pmask |= 255u << shift;
            LDS_WAIT(); asm volatile("" ::: "memory");
        }
        int eqseen = 0;
        for (int k0 = 0; k0 < n; k0 += 256) { RS_LOAD4(k0);
#pragma unroll
            for (int j = 0; j < 4; ++j) { int q = (int)__builtin_fmaf(x_[j], qs, qo); q = q > 255 ? 255 : (q < 0 ? 0 : q);
                const unsigned u = fkey(x_[j]); const bool valid = x_[j] > -INFINITY;
                const bool gt = valid && (q > B || (q == B && u > prefix)), eq = valid && q == B && u == prefix;
                const unsigned long long be = __ballot(eq); const bool sel = gt || (eq && (eqseen + mbcnt64(be)) < kk);
                const unsigned long long bs = __ballot(sel);
                if (lane == 0 && k0 + 64 * j < n) bmrow[(k0 >> 6) + j] = bs;
                eqseen += __popcll(be); } }
        return;
    }
    LAS unsigned* bmw = hist + 256;
    LAS unsigned* cand = (LAS unsigned*)sc;
    int ncand = 0;
    for (int k0 = 0; k0 < n; k0 += 256) { RS_LOAD4(k0);
        asm volatile("" ::: "memory");
#pragma unroll
        for (int j = 0; j < 4; ++j) { int q = (int)__builtin_fmaf(x_[j], qs, qo); q = q > 255 ? 255 : (q < 0 ? 0 : q);
            const bool valid = x_[j] > -INFINITY; const bool gt = valid && q > B, inb = valid && q == B;
            const unsigned long long bg = __ballot(gt), bi = __ballot(inb);
            if (lane == 0) { bmw[2 * ((k0 >> 6) + j)] = (unsigned)bg; bmw[2 * ((k0 >> 6) + j) + 1] = (unsigned)(bg >> 32); }
            if (inb) { const int c = ncand + mbcnt64(bi); cand[2 * c] = (unsigned)(k0 + 64 * j + lane); cand[2 * c + 1] = fkey(x_[j]); }
            ncand += __popcll(bi); }
        LDS_WAIT(); asm volatile("" ::: "memory"); }
#undef RS_LOAD4
    {
        const int c0 = lane, c1 = lane + 64;
        const unsigned k0_ = c0 < ncand ? cand[2 * c0 + 1] : 0u, k1_ = c1 < ncand ? cand[2 * c1 + 1] : 0u;
        const unsigned i0_ = c0 < ncand ? cand[2 * c0] : 0u, i1_ = c1 < ncand ? cand[2 * c1] : 0u;
        int r0 = 0, r1 = 0;
#ifdef SEL_DUP_RANK
        for (int rep3_ = 0; rep3_ < 2; ++rep3_) { r0 = 0; r1 = 0;
#endif
        for (int j = 0; j < ncand; ++j) { const unsigned kj = cand[2 * j + 1];
            r0 += (kj > k0_ || (kj == k0_ && j < c0)) ? 1 : 0; r1 += (kj > k1_ || (kj == k1_ && j < c1)) ? 1 : 0; }
#ifdef SEL_DUP_RANK
        asm volatile("" : "+v"(r0), "+v"(r1)); }
#endif
        if (c0 < ncand && r0 < kk) __hip_atomic_fetch_or(bmw + 2 * (i0_ >> 6) + ((i0_ >> 5) & 1u), 1u << (i0_ & 31u), __ATOMIC_RELAXED, __HIP_MEMORY_SCOPE_WORKGROUP);
        if (c1 < ncand && r1 < kk) __hip_atomic_fetch_or(bmw + 2 * (i1_ >> 6) + ((i1_ >> 5) & 1u), 1u << (i1_ & 31u), __ATOMIC_RELAXED, __HIP_MEMORY_SCOPE_WORKGROUP);
    }
    LDS_WAIT(); asm volatile("" ::: "memory");
    if (lane < ((n + 63) >> 6)) bmrow[lane] = (unsigned long long)bmw[2 * lane] | ((unsigned long long)bmw[2 * lane + 1] << 32);
    LDS_WAIT(); asm volatile("" ::: "memory");
}
__device__ __forceinline__ void split8(const f32x4 a, const f32x4 b, bf16x8& hi, bf16x8& lo) {
    v4u h, l;
    h.x = pg8::cvt_pk_bf16(a.x, a.y); h.y = pg8::cvt_pk_bf16(a.z, a.w); h.z = pg8::cvt_pk_bf16(b.x, b.y); h.w = pg8::cvt_pk_bf16(b.z, b.w);
    l.x = pg8::cvt_pk_bf16(a.x - __uint_as_float(h.x << 16), a.y - __uint_as_float(h.x & 0xffff0000u)); l.y = pg8::cvt_pk_bf16(a.z - __uint_as_float(h.y << 16), a.w - __uint_as_float(h.y & 0xffff0000u));
    l.z = pg8::cvt_pk_bf16(b.x - __uint_as_float(h.z << 16), b.y - __uint_as_float(h.z & 0xffff0000u)); l.w = pg8::cvt_pk_bf16(b.z - __uint_as_float(h.w << 16), b.w - __uint_as_float(h.w & 0xffff0000u));
    hi = __builtin_bit_cast(bf16x8, h); lo = __builtin_bit_cast(bf16x8, l);
}
__device__ __forceinline__ void dsa_select_phase(Frame& F) {
    const int tid = cur_tid(), wave = cur_wave(), lane = tid & 63, r = lane & 31, hh = lane >> 5;
    const float* IQ = (const float*)(F.ws + WS_IQ); const float* IK = (const float*)(F.ws + WS_IK); const float* GWp = (const float*)(F.ws + WS_GW);
    LAS float* sc = (LAS float*)(F.lds + RING_OFF);
    LAS unsigned* hist = (LAS unsigned*)(F.lds + XTRA_OFF + wave * XTRA_WAVE);
    f32x4 araw[2][2][2], wraw[2][4];
    auto load_a = [&](int pass_, int u0_) {
        const int b_ = u0_ >> 8, w8_ = u0_ & 255, tb8_ = pass_ ? 511 - w8_ : w8_; const size_t rowb = (size_t)b_ * T + 8 * tb8_;
#pragma unroll
        for (int gq = 0; gq < 2; ++gq) {
            const float* qp = IQ + (rowb + 4 * gq + (r >> 3)) * 256 + (r & 7) * 32 + 8 * hh;
#pragma unroll
            for (int ks = 0; ks < 2; ++ks) { araw[gq][ks][0] = *(const f32x4*)(qp + 16 * ks); araw[gq][ks][1] = *(const f32x4*)(qp + 16 * ks + 4); }
#pragma unroll
            for (int tk = 0; tk < 4; ++tk) wraw[gq][tk] = *(const f32x4*)(GWp + (rowb + 4 * gq + tk) * 32 + 12 + 4 * hh);
        }
    };
    if ((int)blockIdx.x < 2048) load_a(0, (int)blockIdx.x);
    for (int pass = 0; pass < 2; ++pass) {
        for (int u0 = blockIdx.x; u0 < 2048; u0 += F.G) {
            const int b = u0 >> 8, w8 = u0 & 255, tb8 = pass ? 511 - w8 : w8, t0 = 8 * tb8, nmax = t0 + 8;
            const size_t base = (size_t)b * T;
            bf16x8 ahi[2][2], alo[2][2]; float iw[2][4][4];
#pragma unroll
            for (int gq = 0; gq < 2; ++gq) {
#pragma unroll
                for (int ks = 0; ks < 2; ++ks) split8(araw[gq][ks][0], araw[gq][ks][1], ahi[gq][ks], alo[gq][ks]);
#pragma unroll
                for (int tk = 0; tk < 4; ++tk) { const f32x4 w4 = wraw[gq][tk]; iw[gq][tk][0] = w4.x; iw[gq][tk][1] = w4.y; iw[gq][tk][2] = w4.z; iw[gq][tk][3] = w4.w; }
            }
            const int nkb = (nmax + 31) >> 5;
            v4u nbA[4], nbB[4];
#define DS_LOADB(dst, kb_) do { const GAS unsigned* kp_ = (const GAS unsigned*)(IK + (base + 32 * (kb_) + r) * 32 + 8 * hh); dst[0] = *(const GAS v4u*)kp_; dst[1] = *(const GAS v4u*)(kp_ + 4); dst[2] = *(const GAS v4u*)(kp_ + 16); dst[3] = *(const GAS v4u*)(kp_ + 20); } while (0)
#define DS_UNPK(a, b, hi_, lo_) do { v4u h_, l_; h_.x = __builtin_amdgcn_perm(a.y, a.x, 0x05040100u); l_.x = __builtin_amdgcn_perm(a.y, a.x, 0x07060302u); h_.y = __builtin_amdgcn_perm(a.w, a.z, 0x05040100u); l_.y = __builtin_amdgcn_perm(a.w, a.z, 0x07060302u); \
            h_.z = __builtin_amdgcn_perm(b.y, b.x, 0x05040100u); l_.z = __builtin_amdgcn_perm(b.y, b.x, 0x07060302u); h_.w = __builtin_amdgcn_perm(b.w, b.z, 0x05040100u); l_.w = __builtin_amdgcn_perm(b.w, b.z, 0x07060302u); \
            hi_ = __builtin_bit_cast(bf16x8, h_); lo_ = __builtin_bit_cast(bf16x8, l_); } while (0)
#ifdef DSA_DUP_SCORE
            for (int rep2_ = 0; rep2_ < 2; ++rep2_) {
#endif
            if (wave < nkb) DS_LOADB(nbA, wave);
            if (wave + 8 < nkb) DS_LOADB(nbB, wave + 8);
            for (int kb = wave; kb < nkb; kb += 16) {
                const bool hasB = kb + 8 < nkb;
                bf16x8 bhiA[2], bloA[2], bhiB[2], bloB[2];
                DS_UNPK(nbA[0], nbA[1], bhiA[0], bloA[0]); DS_UNPK(nbA[2], nbA[3], bhiA[1], bloA[1]);
                if (hasB) { DS_UNPK(nbB[0], nbB[1], bhiB[0], bloB[0]); DS_UNPK(nbB[2], nbB[3], bhiB[1], bloB[1]); }
                else { bhiB[0] = bhiA[0]; bhiB[1] = bhiA[1]; bloB[0] = bloA[0]; bloB[1] = bloA[1]; }
                if (kb + 16 < nkb) DS_LOADB(nbA, kb + 16);
                if (kb + 24 < nkb) DS_LOADB(nbB, kb + 24);
                f32x16 cA0, cA1, cB0, cB1;
#pragma unroll
                for (int i = 0; i < 16; ++i) { cA0[i] = 0.f; cA1[i] = 0.f; cB0[i] = 0.f; cB1[i] = 0.f; }
#pragma unroll
                for (int ks = 0; ks < 2; ++ks) {
                    cA0 = __builtin_amdgcn_mfma_f32_32x32x16_bf16(ahi[0][ks], bhiA[ks], cA0, 0, 0, 0); cA1 = __builtin_amdgcn_mfma_f32_32x32x16_bf16(ahi[1][ks], bhiA[ks], cA1, 0, 0, 0);
                    cB0 = __builtin_amdgcn_mfma_f32_32x32x16_bf16(ahi[0][ks], bhiB[ks], cB0, 0, 0, 0); cB1 = __builtin_amdgcn_mfma_f32_32x32x16_bf16(ahi[1][ks], bhiB[ks], cB1, 0, 0, 0);
                    cA0 = __builtin_amdgcn_mfma_f32_32x32x16_bf16(ahi[0][ks], bloA[ks], cA0, 0, 0, 0); cA1 = __builtin_amdgcn_mfma_f32_32x32x16_bf16(ahi[1][ks], bloA[ks], cA1, 0, 0, 0);
                    cB0 = __builtin_amdgcn_mfma_f32_32x32x16_bf16(ahi[0][ks], bloB[ks], cB0, 0, 0, 0); cB1 = __builtin_amdgcn_mfma_f32_32x32x16_bf16(ahi[1][ks], bloB[ks], cB1, 0, 0, 0);
                    cA0 = __builtin_amdgcn_mfma_f32_32x32x16_bf16(alo[0][ks], bhiA[ks], cA0, 0, 0, 0); cA1 = __builtin_amdgcn_mfma_f32_32x32x16_bf16(alo[1][ks], bhiA[ks], cA1, 0, 0, 0);
                    cB0 = __builtin_amdgcn_mfma_f32_32x32x16_bf16(alo[0][ks], bhiB[ks], cB0, 0, 0, 0); cB1 = __builtin_amdgcn_mfma_f32_32x32x16_bf16(alo[1][ks], bhiB[ks], cB1, 0, 0, 0);
                }
#define DS_EPI(c, gq, kb_) do { float s4_[4]; _Pragma("unroll") for (int tk = 0; tk < 4; ++tk) { \
                        const float v_ = (iw[gq][tk][0] * fmaxf(c[4 * tk], 0.f) + iw[gq][tk][1] * fmaxf(c[4 * tk + 1], 0.f)) + (iw[gq][tk][2] * fmaxf(c[4 * tk + 2], 0.f) + iw[gq][tk][3] * fmaxf(c[4 * tk + 3], 0.f)); \
                        s4_[tk] = xhalf_sum(v_) * 0.0625f + 0.0f; } \
                    LAS float* dst_ = sc + (4 * (gq) + 2 * hh) * 4096 + 32 * (kb_) + r; dst_[0] = hh ? s4_[2] : s4_[0]; dst_[4096] = hh ? s4_[3] : s4_[1]; } while (0)
                DS_EPI(cA0, 0, kb); DS_EPI(cA1, 1, kb);
                if (hasB) { DS_EPI(cB0, 0, kb + 8); DS_EPI(cB1, 1, kb + 8); }
#undef DS_EPI
            }
#ifdef DSA_DUP_SCORE
            }
#endif
#undef DS_LOADB
#undef DS_UNPK
            { int pn_ = pass, un_ = u0 + F.G; if (un_ >= 2048) { pn_ = pass + 1; un_ = blockIdx.x; } if (pn_ < 2 && un_ < 2048) load_a(pn_, un_); }
            __syncthreads();
#ifdef DSA_DUP_SEL
            for (int rep2_ = 0; rep2_ < 2; ++rep2_)
#endif
            radix_select_write(sc + wave * 4096, hist, (unsigned long long*)(F.ws + WS_DSAMASK) + (base + t0 + wave) * 64, t0 + wave, lane);
            __syncthreads();
        }
    }
}

constexpr int NS_K = 0, NS_KP = 144, NS_V = 256 * NS_KP, NS_VP = 520, NS_IMP = NS_V + 64 * NS_VP, NS_IP = 68, NS_END = NS_IMP + 64 * NS_IP * 4;
static_assert(NS_END <= RING_BYTES, "nsa select LDS map");
__device__ __forceinline__ void nsa_select_phase(Frame& F) {
    const int tid = cur_tid(), wave = cur_wave(), lane = tid & 63, r = lane & 31, hh = lane >> 5;
    LAS unsigned char* lds = F.lds;
    LAS float* imp = (LAS float*)(lds + NS_IMP);
    for (int pass = 0; pass < 2; ++pass) {
        for (int u0 = blockIdx.x; u0 < 256; u0 += F.G) {
            const int u = pass ? 511 - u0 : u0, tb = u >> 3, b = u & 7;
            __syncthreads();
            {
                const bf16* Kc = (const bf16*)(F.ws + WS_KCMPB) + (size_t)b * 256 * 64; const bf16* Vc = (const bf16*)(F.ws + WS_VCMPB) + (size_t)b * 256 * 64;
#pragma unroll
                for (int j = 0; j < 4; ++j) { const int ch = tid + 512 * j, row = ch >> 3, c8 = ch & 7;
                    *(LAS v4u*)(lds + NS_K + row * NS_KP + 16 * c8) = *(const v4u*)(Kc + row * 64 + 8 * c8);
                    const v4u vv = *(const v4u*)(Vc + row * 64 + 8 * c8);
                    LAS unsigned short* vt = (LAS unsigned short*)(lds + NS_V + (8 * c8) * NS_VP) + row;
                    vt[0 * (NS_VP / 2)] = (unsigned short)(vv.x & 0xffffu); vt[1 * (NS_VP / 2)] = (unsigned short)(vv.x >> 16); vt[2 * (NS_VP / 2)] = (unsigned short)(vv.y & 0xffffu); vt[3 * (NS_VP / 2)] = (unsigned short)(vv.y >> 16);
                    vt[4 * (NS_VP / 2)] = (unsigned short)(vv.z & 0xffffu); vt[5 * (NS_VP / 2)] = (unsigned short)(vv.z >> 16); vt[6 * (NS_VP / 2)] = (unsigned short)(vv.w & 0xffffu); vt[7 * (NS_VP / 2)] = (unsigned short)(vv.w >> 16); }
                for (int i = tid; i < 64 * NS_IP; i += 512) imp[i] = 0.f;
            }
            __syncthreads();
            const int tl_ = 8 * wave + (r >> 2), hd = r & 3, t = 64 * tb + tl_; const size_t row = (size_t)b * T + t;
            const bf16* qrow = (const bf16*)(F.ws + WS_QN) + row * 256 + hd * 64;
            bf16x8 qf[4];
#pragma unroll
            for (int ks = 0; ks < 4; ++ks) qf[ks] = *(const bf16x8*)(qrow + 16 * ks + 8 * hh);
            const int nmax = (t - 31) >> 4;
            const int ntile = ((4 * tb + 2) >> 6) + 1;
            const float sc2 = 0.125f * 1.4426950408889634f;
            auto scores = [&](int tile, f32x16& p0, f32x16& p1) {
#pragma unroll
                for (int i = 0; i < 16; ++i) { p0[i] = 0.f; p1[i] = 0.f; }
                const LAS unsigned char* Kb = lds + NS_K + (64 * tile) * NS_KP;
#pragma unroll
                for (int ks = 0; ks < 4; ++ks) {
                    const bf16x8 a0 = *(const LAS bf16x8*)(Kb + r * NS_KP + (16 * ks + 8 * hh) * 2), a1 = *(const LAS bf16x8*)(Kb + (32 + r) * NS_KP + (16 * ks + 8 * hh) * 2);
                    p0 = __builtin_amdgcn_mfma_f32_32x32x16_bf16(a0, qf[ks], p0, 0, 0, 0);
                    p1 = __builtin_amdgcn_mfma_f32_32x32x16_bf16(a1, qf[ks], p1, 0, 0, 0);
                }
            };
            float m = -1e30f, l = 0.f;
            for (int tile = 0; tile < ntile; ++tile) {
                const unsigned long long word = causal_word(nmax - 64 * tile);
                f32x16 p0, p1; scores(tile, p0, p1);
                const unsigned wlo = (unsigned)word >> (4 * hh), whi = (unsigned)(word >> 32) >> (4 * hh);
                float mx = -1e30f;
#pragma unroll
                for (int i = 0; i < 16; ++i) { const int bit = (i & 3) + 8 * (i >> 2);
                    p0[i] = ((wlo >> bit) & 1u) ? p0[i] * sc2 : -1e30f; p1[i] = ((whi >> bit) & 1u) ? p1[i] * sc2 : -1e30f; mx = fmaxf(mx, fmaxf(p0[i], p1[i])); }
                mx = xhalf_max(mx);
                const float mn = fmaxf(m, mx), alpha = __builtin_amdgcn_exp2f(m - mn); m = mn;
                float ps = 0.f;
#pragma unroll
                for (int i = 0; i < 16; ++i) { const int bit = (i & 3) + 8 * (i >> 2);
                    ps += (((wlo >> bit) & 1u) ? __builtin_amdgcn_exp2f(p0[i] - mn) : 0.f) + (((whi >> bit) & 1u) ? __builtin_amdgcn_exp2f(p1[i] - mn) : 0.f); }
                l = l * alpha + ps;
            }
            l = xhalf_sum(l);
            const float inv = l > 0.f ? 1.0f / l : 0.f;
            f32x16 o0, o1;
#pragma unroll
            for (int i = 0; i < 16; ++i) { o0[i] = 0.f; o1[i] = 0.f; }
            float carry = 0.f;
            for (int tile = 0; tile < ntile; ++tile) {
                const unsigned long long word = causal_word(nmax - 64 * tile);
                f32x16 p0, p1; scores(tile, p0, p1);
                const unsigned wlo = (unsigned)word >> (4 * hh), whi = (unsigned)(word >> 32) >> (4 * hh);
#pragma unroll
                for (int i = 0; i < 16; ++i) { const int bit = (i & 3) + 8 * (i >> 2);
                    p0[i] = ((wlo >> bit) & 1u) ? __builtin_amdgcn_exp2f(p0[i] * sc2 - m) * inv : 0.f; p1[i] = ((whi >> bit) & 1u) ? __builtin_amdgcn_exp2f(p1[i] * sc2 - m) * inv : 0.f; }
#pragma unroll
                for (int blk = 0; blk < 2; ++blk) {
                    float tot[4];
#pragma unroll
                    for (int g = 0; g < 4; ++g) {
                        const float a = blk ? p1[4 * g] : p0[4 * g], b1 = blk ? p1[4 * g + 1] : p0[4 * g + 1], c1 = blk ? p1[4 * g + 2] : p0[4 * g + 2], d1 = blk ? p1[4 * g + 3] : p0[4 * g + 3];
                        const float mainv = (a + b1) + (c1 + d1);
                        const float recv = xhalf_other(d1, hh);
                        const float below = hh ? recv : carry;
                        tot[g] = mainv + below;
                        carry = recv;
                    }
#pragma unroll
                    for (int g = 0; g < 4; ++g) { float v = tot[g]; v += dpp_f<0xB1>(v); v += dpp_f<0x4E>(v);
                        if (hd == 0) imp[tl_ * NS_IP + 16 * tile + 8 * blk + 2 * g + hh] = v; }
                }
                bf16x8 pf[4];
#pragma unroll
                for (int s = 0; s < 4; ++s) { v4u w;
                    if (s < 2) { w.x = pg8::cvt_pk_bf16(p0[8 * s], p0[8 * s + 1]); w.y = pg8::cvt_pk_bf16(p0[8 * s + 2], p0[8 * s + 3]); w.z = pg8::cvt_pk_bf16(p0[8 * s + 4], p0[8 * s + 5]); w.w = pg8::cvt_pk_bf16(p0[8 * s + 6], p0[8 * s + 7]); }
                    else { const int s2 = s - 2; w.x = pg8::cvt_pk_bf16(p1[8 * s2], p1[8 * s2 + 1]); w.y = pg8::cvt_pk_bf16(p1[8 * s2 + 2], p1[8 * s2 + 3]); w.z = pg8::cvt_pk_bf16(p1[8 * s2 + 4], p1[8 * s2 + 5]); w.w = pg8::cvt_pk_bf16(p1[8 * s2 + 6], p1[8 * s2 + 7]); }
                    pf[s] = __builtin_bit_cast(bf16x8, w); }
#pragma unroll
                for (int s = 0; s < 4; ++s) {
                    const int kb = 64 * tile + 32 * (s >> 1) + 16 * (s & 1) + 4 * hh;
#pragma unroll
                    for (int db = 0; db < 2; ++db) {
                        const LAS unsigned char* vp_ = lds + NS_V + (32 * db + r) * NS_VP + kb * 2;
                        typedef unsigned u32x2v __attribute__((ext_vector_type(2)));
                        const u32x2v lo = *(const LAS u32x2v*)vp_, hi = *(const LAS u32x2v*)(vp_ + 16);
                        v4u aw; aw.x = lo.x; aw.y = lo.y; aw.z = hi.x; aw.w = hi.y;
                        const bf16x8 a = __builtin_bit_cast(bf16x8, aw);
                        if (db == 0) o0 = __builtin_amdgcn_mfma_f32_32x32x16_bf16(a, pf[s], o0, 0, 0, 0);
                        else o1 = __builtin_amdgcn_mfma_f32_32x32x16_bf16(a, pf[s], o1, 0, 0, 0);
                    }
                }
            }
            flash_store((bf16*)(F.ws + WS_OC) + row * 256 + hd * 64, o0, o1, 1.0f, hh);
            LDS_WAIT(); asm volatile("" ::: "memory");
            for (int k = 0; k < 8; ++k) {
                const int tk = 64 * tb + 8 * wave + k, own = tk >> 6;
                const float iv = imp[(8 * wave + k) * NS_IP + lane];
                const bool causal = lane <= own, forced = causal && (lane == 0 || lane >= own - 1);
                const float val = forced ? 1e4f : (causal ? iv : -INFINITY);
                const unsigned kv_ = fkey(val); const unsigned klo = (kv_ << 6) | (unsigned)(63 - lane), khi = kv_ >> 26;
                int rank = 0;
#pragma unroll
                for (int j = 0; j < 64; ++j) { const unsigned jlo = (unsigned)__builtin_amdgcn_readlane((int)klo, j), jhi = (unsigned)__builtin_amdgcn_readlane((int)khi, j);
                    rank += (jhi > khi || (jhi == khi && jlo > klo)) ? 1 : 0; }
                const unsigned long long selm = __ballot(causal && rank < 16);
                if (lane == 0) ((unsigned long long*)(F.ws + WS_NSEL))[(size_t)b * T + tk] = selm;
            }
        }
    }
}
#ifndef PHMASK
#define PHMASK 0xFFFFFFFFu
#endif
#define EN(b) ((PHMASK >> (b)) & 1u)
#ifndef DUPMASK
#define DUPMASK 0u
#endif
#define REP(b) for (int rep_ = 0; rep_ < (((DUPMASK >> (b)) & 1u) ? 2 : 1); ++rep_)
__global__ void __launch_bounds__(NWAVES * 64, 2) fwd_kernel(Args args) {
    extern __shared__ __attribute__((aligned(16))) unsigned char lds[];
    Frame F;
    F.lds = (LAS unsigned char*)lds;
    F.MISC = (volatile LAS unsigned*)(F.lds + MISC_OFF);
    F.G = gridDim.x;
    F.ws = args.ws; F.ctl = (gu32*)(args.ws + WS_CTL); F.out = args.out;
    F.A = &args;
    for (int u = threadIdx.x; u < (XTRA_OFF - LDSCTL_OFF) / 4; u += NWAVES * 64) ((LAS unsigned*)(F.lds + LDSCTL_OFF))[u] = 0u;
    __syncthreads();
    XcdBarrier bar = xcd_barrier_post((unsigned*)(F.ctl + CW_BAR), F.MISC + 8);
#ifdef PHASE_RANGES
    const int lo = args.ph_lo, hi = args.ph_hi;
#endif
#ifdef PHASE_RANGES
#define IN(k) (lo <= (k) && (k) < hi)
#else
#define IN(k) true
#endif
#ifdef DUP_BAR
#define SEAM(k) do { if (IN(k) && IN((k) + 1)) { xcd_barrier(bar); xcd_barrier(bar); } } while (0)
#else
#define SEAM(k) do { if (IN(k) && IN((k) + 1)) xcd_barrier(bar); } while (0)
#endif
    unsigned char* ws = F.ws;
    bf16 *H, *HID; const float *cs64, *cs32, *ada;

    if (EN(0) && IN(0)) REP(0) p0_prologue(F);
    SEAM(0);
    int ph = 1;
    auto half_layer = [&](const int s) __attribute__((always_inline)) {
        const int l = s >> 1, second = s & 1;
        { unsigned char* w_ = args.ws; asm volatile("" : "+s"(w_)); ws = w_; F.ws = w_; }
        H = (bf16*)F.out + (size_t)M * D; HID = (bf16*)(ws + WS_HID); cs64 = (const float*)(ws + WS_CS64); cs32 = (const float*)(ws + WS_CS32); ada = (const float*)(ws + WS_ADA);
        const unsigned char* wl = ws + WS_WTS + (size_t)l * WTS_LAYER;
        const float* adal = ada + (size_t)l * 8 * 9216;
        bf16* XB = (bf16*)(ws + WS_XB);
        if (EN(1) && IN(ph)) {
            if (s == 0) norm_mod_phase<false>(F, args.in[I_X], args.in[I_F1N] + l * D, adal + 0 * 1024, adal + 1 * 1024, H);
            else norm_mod_phase<true>(F, XB, args.in[second ? I_F2N : I_F1N] + l * D, adal + (second ? 6 : 0) * 1024, adal + (second ? 7 : 1) * 1024, H);
        }
        SEAM(ph); ++ph;
        if (EN(2) && IN(ph)) REP(2) {
            pg8::Gemm g{H, (const bf16*)(wl + (second ? WO_GU2 : WO_GU1)), M, NGU, D}; pg8::StaticOrder S; S.init(M, NGU, F.G, (int)blockIdx.x);
            pg8::EpiSwiGLU E{HID, FF};
            pg8::gemm_phase<pg8::EpiSwiGLU, pg8::StaticOrder, true, true>(F.lds + RING_OFF, g, S, E);
        }
        SEAM(ph); ++ph;
        if (EN(3) && IN(ph)) {
            pg8::Gemm g{HID, (const bf16*)(wl + (second ? WO_D2 : WO_D1)), M, D, FF}; pg8::StaticOrder S; S.init(M, D, F.G, (int)blockIdx.x);
            if (s == 0) { pg8::EpiResid<false> E{args.in[I_X], XB, adal + 2 * 1024, 0.5f};
                pg8::gemm_phase<pg8::EpiResid<false>, pg8::StaticOrder, true, true>(F.lds + RING_OFF, g, S, E); }
            else { pg8::EpiResid<true> E{XB, XB, adal + (second ? 8 : 2) * 1024, 0.5f};
                pg8::gemm_phase<pg8::EpiResid<true>, pg8::StaticOrder, true, true>(F.lds + RING_OFF, g, S, E); }
        }
        SEAM(ph); ++ph;
        if (second) return;
        if (EN(4) && IN(ph)) norm_mod_phase<true>(F, XB, args.in[I_MIXN] + l * D, adal + 3 * 1024, adal + 4 * 1024, H);
        SEAM(ph); ++ph;
        if (EN(5) && IN(ph)) REP(5) {
            pg8::Gemm g{H, (const bf16*)(wl + WO_IN), M, NINP, D}; pg8::StaticOrder S; S.init(M, NINP, F.G, (int)blockIdx.x);
            pg8::EpiProj<WinDesc> E{WinDesc{ws}, cs64, cs32, nullptr};
            pg8::gemm_phase<pg8::EpiProj<WinDesc>, pg8::StaticOrder, true, true>(F.lds + RING_OFF, g, S, E);
        }
        SEAM(ph); ++ph;
        if (EN(6) && IN(ph)) REP(6) {
            m1_phase(F, l);
            { int kq = 2048; asm volatile("" : "+s"(kq)); pg8::Gemm g{(const bf16*)(ws + WS_KC), (const bf16*)(wl + WO_C1K), 2048, 256, kq, 1024}; pg8::RangeOrder S{8, 0};
              pg8::EpiCmpH E{(float*)(ws + WS_CMPH), (const float*)(ws + WS_CMPB) + (l * 2 + 0) * 256};
              pg8::gemm_phase<pg8::EpiCmpH, pg8::RangeOrder, false, true>(F.lds + RING_OFF, g, S, E); }
            { int kq = 2048; asm volatile("" : "+s"(kq)); pg8::Gemm g{(const bf16*)(ws + WS_VC), (const bf16*)(wl + WO_C1V), 2048, 256, kq, 1024}; pg8::RangeOrder S{8, 8};
              pg8::EpiCmpH E{(float*)(ws + WS_CMPH) + (size_t)8 * 256 * 256, (const float*)(ws + WS_CMPB) + (l * 2 + 1) * 256};
              pg8::gemm_phase<pg8::EpiCmpH, pg8::RangeOrder, false, true>(F.lds + RING_OFF, g, S, E); }
        }
        SEAM(ph); ++ph;
        if (IN(ph)) {
            if (EN(7)) REP(7) { int kq = 256; asm volatile("" : "+s"(kq)); pg8::Gemm g{(const bf16*)(ws + WS_CQ), (const bf16*)(wl + WO_UQ), M, 512, kq}; pg8::StaticOrder S; S.init(M, 512, F.G, (int)blockIdx.x);
              pg8::EpiProj<MlaQDesc> E{MlaQDesc{ws}, cs64, cs32, (const float*)(ws + WS_RSTDQ)};
              pg8::gemm_phase<pg8::EpiProj<MlaQDesc>, pg8::StaticOrder, true, true>(F.lds + RING_OFF, g, S, E); }
            if (EN(8)) REP(7) { int kq = 128; asm volatile("" : "+s"(kq)); pg8::Gemm g{(const bf16*)(ws + WS_CKV), (const bf16*)(wl + WO_UKV), M, 512, kq}; pg8::StaticOrder S; S.init(M, 512, F.G, (int)blockIdx.x);
              pg8::EpiProj<MlaKvDesc> E{MlaKvDesc{ws}, cs64, cs32, (const float*)(ws + WS_RSTDKV)};
              pg8::gemm_phase<pg8::EpiProj<MlaKvDesc>, pg8::StaticOrder, true, true>(F.lds + RING_OFF, g, S, E); }
            if (EN(9)) REP(9) cmp2_phase(F, l);
#ifdef FLASH_DSA
            if (EN(10)) REP(10) dsa_select_phase(F);
#else
            if (EN(10)) REP(10) dsa_tokens_phase(F);
#endif
        }
        SEAM(ph); ++ph;
#ifdef FLASH_NSA
        if (IN(ph)) { if (EN(13)) REP(13) nsa_select_phase(F); }
        SEAM(ph); ++ph;
#endif
        if (IN(ph)) {
#ifdef FLASH_MOBA
            if (EN(11)) REP(11) moba_flash_phase(F);
#else
            if (EN(11)) moba_rows_phase(F);
#endif
#ifdef FLASH_MLA
            if (EN(12)) REP(12) mla_flash_phase(F);
#else
            if (EN(12)) mla_rows_phase(F);
#endif
#ifdef FLASH_NSA
            if (EN(13)) REP(14) nsa_flash_phase(F);
#else
            if (EN(13)) nsa_tokens_phase(F);
#endif
#ifdef FLASH_DSA
            if (EN(10)) REP(15) dsa_flash_phase(F);
#endif
        }
        SEAM(ph); ++ph;
        if (EN(14) && IN(ph)) group_norm_phase(F, H, args.in[I_GN] + l * 1024);
        SEAM(ph); ++ph;
        if (EN(15) && IN(ph)) {
            pg8::Gemm g{H, (const bf16*)(wl + WO_OUT), M, D, D}; pg8::StaticOrder S; S.init(M, D, F.G, (int)blockIdx.x);
            pg8::EpiResid<true> E{XB, XB, adal + 5 * 1024, 1.0f};
            pg8::gemm_phase<pg8::EpiResid<true>, pg8::StaticOrder, true, true>(F.lds + RING_OFF, g, S, E);
        }
        SEAM(ph); ++ph;
    };
    half_layer(0); half_layer(1);
#ifdef DUP_LAYER0
    half_layer(0); half_layer(1);
#endif
    half_layer(2); half_layer(3);
    if (EN(16) && IN(ph)) final_norm_phase(F, (const bf16*)(args.ws + WS_XB), F.out, args.in[I_FINN]);
#undef IN
#undef SEAM
}
#ifdef FLASH_NSA
constexpr int N_PHASES = 1 + 4 * 3 + 2 * 8 + 1;
#else
constexpr int N_PHASES = 1 + 4 * 3 + 2 * 7 + 1;
#endif

extern "C" void kernel_launch(void* const* d_in, const int* in_sizes, int n_in, void* d_out, int out_size, void* d_ws, size_t ws_size, hipStream_t stream) {
    static int grid = 0;
    if (grid == 0) {
        if (n_in != 28 || in_sizes[0] != M * D || out_size != M * D || ws_size < WS_END) { fprintf(stderr, "kernel_launch: unexpected problem shape (n_in %d, in0 %d, out %d, ws %zu); nothing launched\n", n_in, n_in > 0 ? in_sizes[0] : -1, out_size, ws_size); grid = -1; return; }
        int dev = 0, cus = 0, per_cu = 0;
        if (hipGetDevice(&dev) != hipSuccess || hipDeviceGetAttribute(&cus, hipDeviceAttributeMultiprocessorCount, dev) != hipSuccess) { grid = -1; return; }
        if (hipFuncSetAttribute((const void*)fwd_kernel, hipFuncAttributeMaxDynamicSharedMemorySize, LDS_BYTES) != hipSuccess) { fprintf(stderr, "kernel_launch: hipFuncSetAttribute failed\n"); grid = -1; return; }
        if (hipOccupancyMaxActiveBlocksPerMultiprocessor(&per_cu, (const void*)fwd_kernel, NWAVES * 64, LDS_BYTES) != hipSuccess || per_cu < 1) { fprintf(stderr, "kernel_launch: occupancy query says %d\n", per_cu); }
        (void)hipGetLastError();
        grid = cus;
    }
    if (grid < 0) return;
    if (hipMemsetAsync((char*)d_ws + WS_CTL, 0, CTL_ZERO_BYTES, stream) != hipSuccess) return;
    Args a{};
    for (int i = 0; i < 28; ++i) a.in[i] = (const float*)d_in[i];
    a.out = (float*)d_out; a.ws = (unsigned char*)d_ws; a.ph_lo = 0; a.ph_hi = N_PHASES + 64;
    hipLaunchKernelGGL(fwd_kernel, dim3(grid), dim3(NWAVES * 64), LDS_BYTES, stream, a);
}
```

```cpp
#include <hip/hip_runtime.h>
#include <cstdio>
#include <cstdint>
#include <cmath>
#ifndef NO_FLASH
#define FLASH_MLA 1
#define FLASH_MOBA 1
#define FLASH_NSA 1
#define FLASH_DSA 1
#endif
namespace pg8 {
#define PG8_LAS __attribute__((address_space(3)))
typedef unsigned short bf16_t;
typedef short bf16x8 __attribute__((ext_vector_type(8)));
typedef float f32x4 __attribute__((ext_vector_type(4)));
typedef unsigned u32x4 __attribute__((ext_vector_type(4)));
constexpr int BM = 256, BK = 64, HALF = 128, HTB = HALF * BK * 2  , STAGE_BYTES = 8 * HTB, NXCD = 8, WGM = 8;

__host__ __device__ __forceinline__ int lds_byte(int r, int c) { const int st = (r >> 4) * 2 + (c >> 5), rr = r & 15, cc = c & 31, ob = rr * 64 + cc * 2; return st * 1024 + (ob ^ (((ob >> 9) & 1) << 5)); }
__host__ __device__ __forceinline__ void stage_rc(int b, int& R, int& C) { const int st = b / 1024, sb = b % 1024, swz = sb ^ (((sb >> 9) & 1) << 5); R = (st >> 1) * 16 + swz / 64; C = (st & 1) * 32 + (swz % 64) / 2; }
__host__ __device__ __forceinline__ int perm32(int rho) { const int n = rho >> 4, i = rho & 15; return 8 * (i >> 2) + 4 * n + (i & 3); }

struct Unit { int pm, pn; };
struct Gemm { const bf16_t* A; const bf16_t* Bt; int M, N, K; int lda = 0; };

struct StaticOrder {
    int nM, nN, nwg, G, c;
    __host__ __device__ void init(int M, int N, int G_, int c_) { nM = M / BM; nN = N / BM; nwg = nM * nN; G = G_; c = c_; }
    __host__ __device__ bool next(int i, Unit& u) const {
        const long L = (long)i * G + c; if (L >= nwg) return false;
        int wgid = (int)L; { const int q = nwg / NXCD, r = nwg % NXCD, xcd = wgid % NXCD, off = wgid / NXCD; wgid = (xcd < r ? xcd * (q + 1) : r * (q + 1) + (xcd - r) * q) + off; }
        const int nig = WGM * nN, gid = wgid / nig, fm = gid * WGM, gsz = (nM - fm) < WGM ? (nM - fm) : WGM;
        u.pm = fm + ((wgid % nig) % gsz); u.pn = (wgid % nig) / gsz; return true;
    }
    __device__ __forceinline__ void a_ready(const Unit&) const {}
    __device__ __forceinline__ void done(const Unit&) const {}
};

__device__ __forceinline__ unsigned cvt_pk_bf16(float lo, float hi) { unsigned r; asm volatile("v_cvt_pk_bf16_f32 %0, %1, %2" : "=v"(r) : "v"(lo), "v"(hi)); return r; }
typedef float f32x2 __attribute__((ext_vector_type(2)));
typedef unsigned u32x2 __attribute__((ext_vector_type(2)));
__device__ __forceinline__ float silu_f(float x) { return x * __builtin_amdgcn_rcpf(1.0f + __builtin_amdgcn_exp2f(-1.4426950408889634f * x)); }

struct EpiSwiGLU {
    static constexpr bool PERM = false, AFTER_DRAIN = false;
    bf16_t* H; int ldh;
    __device__ __forceinline__ void operator()(const f32x4 (&acc)[2][2][4][2], const Unit& u, int wr, int wc, int fr, int fq) const {
        const int row0 = u.pm * BM + wr * 64 + fr;
        const int hc0 = u.pn * 128 + wc * 16 + 4 * fq;
#pragma unroll
        for (int ai = 0; ai < 2; ++ai)
#pragma unroll
            for (int m = 0; m < 4; ++m) {
                bf16_t* rowp = H + (size_t)(row0 + ai * HALF + m * 16) * ldh + hc0;
#pragma unroll
                for (int bj = 0; bj < 2; ++bj) {
                    const f32x4 g = acc[ai][bj][m][0], uu = acc[ai][bj][m][1];
                    u32x2 w; w.x = cvt_pk_bf16(silu_f(g[0]) * uu[0], silu_f(g[1]) * uu[1]); w.y = cvt_pk_bf16(silu_f(g[2]) * uu[2], silu_f(g[3]) * uu[3]);
                    *(u32x2*)(rowp + bj * 64) = w;
                }
            }
    }
};

struct EpiSwiGLU8 {
    static constexpr bool PERM = false, AFTER_DRAIN = false;
    bf16_t* H; int ldh; float deq;
    __device__ __forceinline__ void operator()(const f32x4 (&acc)[2][2][4][2], const Unit& u, int wr, int wc, int fr, int fq) const {
        typedef int i32x4_ __attribute__((ext_vector_type(4)));
        const int row0 = u.pm * BM + wr * 64 + fr;
        const int hc0 = u.pn * 128 + wc * 16 + 4 * fq;
#pragma unroll
        for (int ai = 0; ai < 2; ++ai)
#pragma unroll
            for (int m = 0; m < 4; ++m) {
                bf16_t* rowp = H + (size_t)(row0 + ai * HALF + m * 16) * ldh + hc0;
#pragma unroll
                for (int bj = 0; bj < 2; ++bj) {
                    const i32x4_ gi = __builtin_bit_cast(i32x4_, acc[ai][bj][m][0]), ui = __builtin_bit_cast(i32x4_, acc[ai][bj][m][1]);
                    float g[4], uu[4];
#pragma unroll
                    for (int i = 0; i < 4; ++i) { g[i] = (float)gi[i] * deq; uu[i] = (float)ui[i] * deq; }
                    u32x2 w; w.x = cvt_pk_bf16(silu_f(g[0]) * uu[0], silu_f(g[1]) * uu[1]); w.y = cvt_pk_bf16(silu_f(g[2]) * uu[2], silu_f(g[3]) * uu[3]);
                    *(u32x2*)(rowp + bj * 64) = w;
                }
            }
    }
};

template <bool XIN_BF16> struct EpiResid {
    static constexpr bool PERM = false, AFTER_DRAIN = false;
    const void* xin; bf16_t* xout; const float* gate; float coef;
    __device__ __forceinline__ void operator()(const f32x4 (&acc)[2][2][4][2], const Unit& u, int wr, int wc, int fr, int fq) const {
        const int b = (u.pm * BM) >> 12;
        const float* gv = gate + (size_t)b * 9216;
        const int row0 = u.pm * BM + wr * 64 + fr, col0 = u.pn * BM + wc * 32 + 4 * fq;
        f32x4 g[2][2];
#pragma unroll
        for (int bj = 0; bj < 2; ++bj)
#pragma unroll
            for (int n = 0; n < 2; ++n) g[bj][n] = *(const f32x4*)(gv + col0 + bj * HALF + n * 16) * coef;
#pragma unroll
        for (int ai = 0; ai < 2; ++ai)
#pragma unroll
            for (int m = 0; m < 4; ++m) {
                const size_t off = (size_t)(row0 + ai * HALF + m * 16) * 1024 + col0;
#pragma unroll
                for (int bj = 0; bj < 2; ++bj)
#pragma unroll
                    for (int n = 0; n < 2; ++n) {
                        f32x4 xi;
                        if (XIN_BF16) { const u32x2 w = *(const u32x2*)((const bf16_t*)xin + off + bj * HALF + n * 16);
                            xi[0] = __uint_as_float(w.x << 16); xi[1] = __uint_as_float(w.x & 0xffff0000u); xi[2] = __uint_as_float(w.y << 16); xi[3] = __uint_as_float(w.y & 0xffff0000u); }
                        else xi = *(const f32x4*)((const float*)xin + off + bj * HALF + n * 16);
                        const f32x4 xo = xi + g[bj][n] * acc[ai][bj][m][n];
                        u32x2 wo; wo.x = cvt_pk_bf16(xo[0], xo[1]); wo.y = cvt_pk_bf16(xo[2], xo[3]);
                        *(u32x2*)(xout + off + bj * HALF + n * 16) = wo; }
                if (m & 1) asm volatile("" ::: "memory");
            }
    }
};

struct ProjDesc { int kind, dfreq0, nstride, rep, repstride, bpitch, fpitch, pad; bf16_t* bp; float* fp; };
template <class DescFn> struct EpiProj {
    static constexpr bool PERM = false, AFTER_DRAIN = false;
    DescFn df; const float* cs64; const float* cs32; const float* rowscale;
    __device__ __forceinline__ void operator()(const f32x4 (&acc)[2][2][4][2], const Unit& u, int wr, int wc, int fr, int fq) const {
        const int row0 = u.pm * BM + wr * 64 + fr;
#pragma unroll
        for (int bj = 0; bj < 2; ++bj) {
            const int G = u.pn * 8 + bj * 4 + wc;
            const ProjDesc d = df(G);
            if (d.kind != 0) {
#pragma unroll
                for (int ai = 0; ai < 2; ++ai)
#pragma unroll
                    for (int m = 0; m < 4; ++m) {
                        const int row = row0 + ai * HALF + m * 16;
                        f32x4 v0 = acc[ai][bj][m][0], v1 = acc[ai][bj][m][1];
                        if (rowscale) { const float rs = rowscale[row]; v0 = v0 * rs; v1 = v1 * rs; }
                        if (d.kind >= 2) {
                            const int pos = row & 4095;
                            const float* cs = (d.kind == 2) ? cs64 + ((size_t)pos * 32 + d.dfreq0 + 4 * fq) * 2 : cs32 + ((size_t)pos * 16 + 4 * fq) * 2;
                            const f32x4 a = *(const f32x4*)cs, b2 = *(const f32x4*)(cs + 4);
                            const f32x4 c = {a[0], a[2], b2[0], b2[2]}, s = {a[1], a[3], b2[1], b2[3]};
                            const f32x4 o0 = v0 * c - v1 * s, o1 = v1 * c + v0 * s; v0 = o0; v1 = o1;
                        }
                        if (d.bp) {
                            u32x2 w0, w1; w0.x = cvt_pk_bf16(v0[0], v0[1]); w0.y = cvt_pk_bf16(v0[2], v0[3]); w1.x = cvt_pk_bf16(v1[0], v1[1]); w1.y = cvt_pk_bf16(v1[2], v1[3]);
                            bf16_t* p = d.bp + (size_t)row * d.bpitch + 4 * fq;
                            for (int rp = 0; rp < d.rep; ++rp) { *(u32x2*)(p + rp * d.repstride) = w0; *(u32x2*)(p + rp * d.repstride + d.nstride) = w1; }
                        }
                        if (d.fp) { float* p = d.fp + (size_t)row * d.fpitch + 4 * fq;
                            if (d.pad) {
                                typedef unsigned u32x4v __attribute__((ext_vector_type(4)));
                                u32x4v w0, w1;
#pragma unroll
                                for (int q = 0; q < 2; ++q) { const f32x4 v = q ? v1 : v0;
                                    const unsigned h01 = cvt_pk_bf16(v[0], v[1]), h23 = cvt_pk_bf16(v[2], v[3]);
                                    const unsigned l01 = cvt_pk_bf16(v[0] - __uint_as_float(h01 << 16), v[1] - __uint_as_float(h01 & 0xffff0000u)), l23 = cvt_pk_bf16(v[2] - __uint_as_float(h23 << 16), v[3] - __uint_as_float(h23 & 0xffff0000u));
                                    u32x4v w; w.x = (h01 & 0xffffu) | (l01 << 16); w.y = (h01 >> 16) | (l01 & 0xffff0000u); w.z = (h23 & 0xffffu) | (l23 << 16); w.w = (h23 >> 16) | (l23 & 0xffff0000u);
                                    if (q) w1 = w; else w0 = w; }
                                *(u32x4v*)p = w0; *(u32x4v*)(p + d.nstride) = w1;
                            } else { *(f32x4*)p = v0; *(f32x4*)(p + d.nstride) = v1; } }
                        asm volatile("" ::: "memory");
                    }
            }
        }
    }
};


struct EpiCmpH {
    static constexpr bool PERM = false, AFTER_DRAIN = false;
    float* out; const float* bias;
    __device__ __forceinline__ void operator()(const f32x4 (&acc)[2][2][4][2], const Unit& u, int wr, int wc, int fr, int fq) const {
        const int row0 = u.pm * BM + wr * 64 + fr, col0 = wc * 32 + 4 * fq;
        f32x4 bv[2][2];
#pragma unroll
        for (int bj = 0; bj < 2; ++bj)
#pragma unroll
            for (int n = 0; n < 2; ++n) bv[bj][n] = *(const f32x4*)(bias + col0 + bj * HALF + n * 16);
#pragma unroll
        for (int ai = 0; ai < 2; ++ai)
#pragma unroll
            for (int m = 0; m < 4; ++m) {
                float* rowp = out + (size_t)(row0 + ai * HALF + m * 16) * 256 + col0;
#pragma unroll
                for (int bj = 0; bj < 2; ++bj)
#pragma unroll
                    for (int n = 0; n < 2; ++n) { const f32x4 v = acc[ai][bj][m][n] + bv[bj][n];
                        f32x4 o; o[0] = silu_f(v[0]); o[1] = silu_f(v[1]); o[2] = silu_f(v[2]); o[3] = silu_f(v[3]); *(f32x4*)(rowp + bj * HALF + n * 16) = o; }
            }
    }
};
struct RangeOrder {
    int nM, c0;
    __device__ __forceinline__ bool next(int i, Unit& u) const { const int idx = (int)blockIdx.x - c0; if (i > 0 || idx < 0 || idx >= nM) return false; u.pm = idx; u.pn = 0; return true; }
    __device__ __forceinline__ void a_ready(const Unit&) const {}
    __device__ __forceinline__ void done(const Unit&) const {}
};
template <class Epi, class Sched, bool ALIGN_EPI = false, bool SP2 = false, bool I8 = false>
__device__ __forceinline__ void gemm_phase(PG8_LAS unsigned char* lds, const Gemm g, const Sched& S, const Epi& E) {
    int tid_ = threadIdx.x; asm volatile("" : "+v"(tid_));
    const int tid = tid_, wid = __builtin_amdgcn_readfirstlane(tid >> 6), lane = tid & 63, wr = wid >> 2, wc = wid & 3, fr = lane & 15, fq = lane >> 4;
    const int K = g.K, nt = K / BK, lda = g.lda ? g.lda : g.K;
    unsigned voffA[2], voffB[2];
#pragma unroll
    for (int i = 0; i < 2; ++i) { int R, C; stage_rc(tid * 16 + i * 8192, R, C); const int Rb = Epi::PERM ? ((R & ~31) + perm32(R & 31)) : R;
        voffA[i] = (unsigned)(R * lda + C) * 2u; voffB[i] = (unsigned)(Rb * K + C) * 2u; }
    const size_t kstep = (size_t)(BK * 2);
    const size_t hstepB = (size_t)HALF * K * 2, hstepA = (size_t)HALF * lda * 2;
    const size_t tstepB = 2 * hstepB, tstepA = 2 * hstepA;
    const unsigned ldsw = (unsigned)wid * 1024u;
    const int aoff = lds_byte(wr * 64 + fr, fq * 8), boff = lds_byte(wc * 32 + fr, fq * 8);
#define PG8_SA(b, h) (((b) * 2 + (h)) * HTB)
#define PG8_SB(b, h) ((4 + (b) * 2 + (h)) * HTB)
#define PG8_STAGE(bufoff, gbase, voff) do { _Pragma("unroll") for (int _i = 0; _i < 2; ++_i) \
        __builtin_amdgcn_global_load_lds((const unsigned*)((const char*)(gbase) + (voff)[_i]), (PG8_LAS unsigned*)(lds + (bufoff) + ldsw + _i * 8192), 16, 0, 0); } while (0)
#define PG8_LDA(dst, b, h) do { _Pragma("unroll") for (int m = 0; m < 4; ++m) _Pragma("unroll") for (int k = 0; k < 2; ++k) dst[m][k] = *(const PG8_LAS bf16x8*)(lds + PG8_SA(b, h) + aoff + m * 2048 + k * 1024); } while (0)
#define PG8_LDB(dst, b, h) do { _Pragma("unroll") for (int n = 0; n < 2; ++n) _Pragma("unroll") for (int k = 0; k < 2; ++k) dst[n][k] = *(const PG8_LAS bf16x8*)(lds + PG8_SB(b, h) + boff + n * 2048 + k * 1024); } while (0)
#define PG8_MMA(ai, bj, At, Bt) do { __builtin_amdgcn_s_setprio(1); _Pragma("unroll") for (int m = 0; m < 4; ++m) _Pragma("unroll") for (int n = 0; n < 2; ++n) _Pragma("unroll") for (int k = 0; k < 2; ++k) \
        { if constexpr (I8) { typedef int i32x4_ __attribute__((ext_vector_type(4))); acc[ai][bj][m][n] = __builtin_bit_cast(f32x4, __builtin_amdgcn_mfma_i32_16x16x64_i8(__builtin_bit_cast(i32x4_, Bt[n][k]), __builtin_bit_cast(i32x4_, At[m][k]), __builtin_bit_cast(i32x4_, acc[ai][bj][m][n]), 0, 0, 0)); } \
          else acc[ai][bj][m][n] = __builtin_amdgcn_mfma_f32_16x16x32_bf16(Bt[n][k], At[m][k], acc[ai][bj][m][n], 0, 0, 0); } __builtin_amdgcn_s_setprio(0); } while (0)
#define PG8_WAIT_V(n) asm volatile("s_waitcnt vmcnt(" #n ")" ::: "memory")
#define PG8_WAIT_L(n) asm volatile("s_waitcnt lgkmcnt(" #n ")" ::: "memory")
#define PG8_BAR __builtin_amdgcn_s_barrier()
#define PG8_SCHED __builtin_amdgcn_sched_barrier(0)
    Unit cur, nxt; int ui = 0;
    if (!S.next(0, cur)) return;
    f32x4 acc[2][2][4][2];
#pragma unroll
    for (int a = 0; a < 2; ++a)
#pragma unroll
        for (int b = 0; b < 2; ++b)
#pragma unroll
            for (int m = 0; m < 4; ++m)
#pragma unroll
                for (int n = 0; n < 2; ++n) acc[a][b][m][n] = (f32x4){0.f, 0.f, 0.f, 0.f};
    bf16x8 At[4][2], B0[2][2], B1[2][2];
    const char* cA = (const char*)g.A + (size_t)cur.pm * tstepA; const char* cB = (const char*)g.Bt + (size_t)cur.pn * tstepB;
    S.a_ready(cur);
    if constexpr (SP2) {
        PG8_STAGE(PG8_SB(0, 0), cB, voffB); PG8_STAGE(PG8_SB(0, 1), cB + hstepB, voffB); PG8_STAGE(PG8_SA(0, 0), cA, voffA); PG8_STAGE(PG8_SA(0, 1), cA + hstepA, voffA);
        if (wr == 1) PG8_BAR;
        PG8_WAIT_V(2); PG8_BAR;
        PG8_STAGE(PG8_SB(1, 0), cB + kstep, voffB); PG8_STAGE(PG8_SA(1, 0), cA + kstep, voffA); PG8_STAGE(PG8_SB(1, 1), cB + hstepB + kstep, voffB);
        PG8_WAIT_V(6); PG8_BAR;
    } else {
        PG8_STAGE(PG8_SB(0, 0), cB, voffB); PG8_STAGE(PG8_SA(0, 0), cA, voffA); PG8_STAGE(PG8_SB(0, 1), cB + hstepB, voffB); PG8_STAGE(PG8_SA(0, 1), cA + hstepA, voffA);
        if (wr == 1) PG8_BAR;
        PG8_WAIT_V(4); PG8_BAR;
        PG8_STAGE(PG8_SB(1, 0), cB + kstep, voffB); PG8_STAGE(PG8_SA(1, 0), cA + kstep, voffA); PG8_STAGE(PG8_SB(1, 1), cB + hstepB + kstep, voffB);
        PG8_WAIT_V(6); PG8_BAR;
    }
    for (;;) {
        const bool has_next = S.next(ui + 1, nxt);
        const char* nA = has_next ? (const char*)g.A + (size_t)nxt.pm * tstepA : cA; const char* nB = has_next ? (const char*)g.Bt + (size_t)nxt.pn * tstepB : cB;
        for (int t = 0; t < nt; t += 2) {
            const bool last = (t == nt - 2);
            const char* a1 = cA + (size_t)(t + 1) * kstep;
            const char* a2 = last ? nA : cA + (size_t)(t + 2) * kstep; const char* b2 = last ? nB : cB + (size_t)(t + 2) * kstep;
            const char* a3 = a2 + kstep; const char* b3 = b2 + kstep;
            if (last && has_next) S.a_ready(nxt);
            if constexpr (SP2) {
            PG8_LDB(B0, 0, 0); PG8_LDB(B1, 0, 1); PG8_SCHED; PG8_LDA(At, 0, 0); PG8_STAGE(PG8_SA(1, 1), a1 + hstepA, voffA);
            PG8_WAIT_V(8); PG8_WAIT_L(0); PG8_BAR; PG8_MMA(0, 0, At, B0); PG8_MMA(0, 1, At, B1); PG8_BAR; PG8_SCHED;
            PG8_LDA(At, 0, 1); PG8_STAGE(PG8_SB(0, 0), b2, voffB); PG8_STAGE(PG8_SB(0, 1), b2 + hstepB, voffB); PG8_STAGE(PG8_SA(0, 0), a2, voffA);
            PG8_WAIT_V(8); PG8_WAIT_L(0); PG8_BAR; PG8_MMA(1, 0, At, B0); PG8_MMA(1, 1, At, B1); PG8_BAR; PG8_SCHED;
            PG8_LDB(B0, 1, 0); PG8_LDB(B1, 1, 1); PG8_SCHED; PG8_LDA(At, 1, 0); PG8_STAGE(PG8_SA(0, 1), a2 + hstepA, voffA);
            PG8_WAIT_V(8); PG8_WAIT_L(0); PG8_BAR; PG8_MMA(0, 0, At, B0); PG8_MMA(0, 1, At, B1); PG8_BAR; PG8_SCHED;
            PG8_LDA(At, 1, 1); PG8_STAGE(PG8_SB(1, 0), b3, voffB); PG8_STAGE(PG8_SB(1, 1), b3 + hstepB, voffB); PG8_STAGE(PG8_SA(1, 0), a3, voffA);
            PG8_WAIT_V(8); PG8_WAIT_L(0); PG8_BAR; PG8_MMA(1, 0, At, B0); PG8_MMA(1, 1, At, B1); PG8_BAR; PG8_SCHED;
            } else {
            PG8_LDB(B0, 0, 0); PG8_SCHED; PG8_LDA(At, 0, 0); PG8_STAGE(PG8_SA(1, 1), a1 + hstepA, voffA);
            PG8_WAIT_L(8); PG8_BAR; PG8_WAIT_L(0); PG8_MMA(0, 0, At, B0); PG8_BAR; PG8_SCHED;
            PG8_LDB(B1, 0, 1); PG8_STAGE(PG8_SB(0, 0), b2, voffB);
            PG8_BAR; PG8_WAIT_L(0); PG8_MMA(0, 1, At, B1); PG8_BAR;
            PG8_LDA(At, 0, 1); PG8_STAGE(PG8_SA(0, 0), a2, voffA);
            PG8_BAR; PG8_WAIT_L(0); PG8_MMA(1, 0, At, B0); PG8_BAR; PG8_SCHED;
            PG8_STAGE(PG8_SB(0, 1), b2 + hstepB, voffB);
            PG8_WAIT_V(6); PG8_BAR; PG8_MMA(1, 1, At, B1); PG8_BAR;
            PG8_LDB(B0, 1, 0); PG8_SCHED; PG8_LDA(At, 1, 0); PG8_STAGE(PG8_SA(0, 1), a2 + hstepA, voffA);
            PG8_WAIT_L(8); PG8_BAR; PG8_WAIT_L(0); PG8_MMA(0, 0, At, B0); PG8_BAR; PG8_SCHED;
            PG8_LDB(B1, 1, 1); PG8_STAGE(PG8_SB(1, 0), b3, voffB);
            PG8_BAR; PG8_WAIT_L(0); PG8_MMA(0, 1, At, B1); PG8_BAR;
            PG8_LDA(At, 1, 1); PG8_STAGE(PG8_SA(1, 0), a3, voffA);
            PG8_BAR; PG8_WAIT_L(0); PG8_MMA(1, 0, At, B0); PG8_BAR; PG8_SCHED;
            PG8_STAGE(PG8_SB(1, 1), b3 + hstepB, voffB);
            PG8_WAIT_V(6); PG8_BAR; PG8_MMA(1, 1, At, B1); PG8_BAR;
            }
        }
        if constexpr (ALIGN_EPI) { if (wr == 0) PG8_BAR; }
        if constexpr (!Epi::AFTER_DRAIN) { E(acc, cur, wr, wc, fr, fq); S.done(cur); }
        if (!has_next) break;
#pragma unroll
        for (int a = 0; a < 2; ++a)
#pragma unroll
            for (int b = 0; b < 2; ++b)
#pragma unroll
                for (int m = 0; m < 4; ++m)
#pragma unroll
                    for (int n = 0; n < 2; ++n) acc[a][b][m][n] = (f32x4){0.f, 0.f, 0.f, 0.f};
        cur = nxt; cA = nA; cB = nB; ++ui;
        if constexpr (ALIGN_EPI) { if (wr == 1) PG8_BAR; }
    }
    PG8_WAIT_V(0);
    if constexpr (!ALIGN_EPI) { if (wr == 0) PG8_BAR; }
    PG8_BAR;
    if constexpr (Epi::AFTER_DRAIN) { E.fused(acc, cur, wr, wc, fr, fq, lds, wid, lane); S.done(cur); }
#undef PG8_SA
#undef PG8_SB
#undef PG8_STAGE
#undef PG8_LDA
#undef PG8_LDB
#undef PG8_MMA
#undef PG8_WAIT_V
#undef PG8_WAIT_L
#undef PG8_BAR
#undef PG8_SCHED
}
}
#define GAS __attribute__((address_space(1)))
#define LAS __attribute__((address_space(3)))
typedef unsigned short bf16;
typedef unsigned v4u __attribute__((ext_vector_type(4)));
typedef float f32x4 __attribute__((ext_vector_type(4)));
typedef short bf16x8 __attribute__((ext_vector_type(8)));
typedef GAS unsigned gu32;
typedef GAS unsigned long long gu64;
#define RLX_AGENT __ATOMIC_RELAXED, __HIP_MEMORY_SCOPE_AGENT
#define LDS_WAIT() asm volatile("s_waitcnt lgkmcnt(0)" ::: "memory")
#define VM_WAIT() asm volatile("s_waitcnt vmcnt(0)" ::: "memory")
__device__ __forceinline__ unsigned long long rt() { return __builtin_amdgcn_s_memrealtime(); }
__device__ __forceinline__ unsigned f2bf(float f) { unsigned u = __builtin_bit_cast(unsigned, f); return (u + 0x7fffu + ((u >> 16) & 1u)) >> 16; }
__device__ __forceinline__ unsigned pk2(float lo, float hi) { return f2bf(lo) | (f2bf(hi) << 16); }

#define XB_TMO      128
#define XB_XCNT(j)  (256  + 64 * (j))
#define XB_XSUB(j)  (1280 + 64 * (j))
#define XB_XGEN(j)  (2304 + 64 * (j))
#define XB_TOP      3328
#define XB_TOPGEN   3392
#define XCD_BAR_WORDS 3456
#define XB_SPIN_CAP (1u << 24)

__device__ __forceinline__ unsigned xb_ld(unsigned* p)              { return __hip_atomic_load(p, __ATOMIC_RELAXED, __HIP_MEMORY_SCOPE_AGENT); }
__device__ __forceinline__ unsigned xb_add(unsigned* p, unsigned v) { return __hip_atomic_fetch_add(p, v, __ATOMIC_RELAXED, __HIP_MEMORY_SCOPE_AGENT); }
__device__ __forceinline__ unsigned xb_xcc_id() { return (unsigned)__builtin_amdgcn_s_getreg((3 << 11) | 20) & 0xFu; }
#define XB_SPIN(cond, bar) do { unsigned _sp = 0; while (cond) { __builtin_amdgcn_s_sleep(1); \
    if ((++_sp & 255u) == 0u) { if (xb_ld(&(bar)[XB_TMO])) break; if (_sp > XB_SPIN_CAP) { atomicAdd(&(bar)[XB_TMO], 1u); break; } } } } while (0)

struct XcdBarrier {
    unsigned* bar; unsigned x;
    volatile LAS unsigned* st;
};

__device__ __forceinline__ XcdBarrier xcd_barrier_post(unsigned* bar, volatile LAS unsigned* st) {
    XcdBarrier b; b.bar = bar; b.x = xb_xcc_id(); b.st = st;
    if (threadIdx.x == 0) (void)xb_add(&bar[XB_XCNT(b.x)], 1u);
    return b;
}
__device__ __forceinline__ void xcd_barrier_complete(unsigned* bar, unsigned x, unsigned& nloc, unsigned& nx) {
    const unsigned G = gridDim.x * gridDim.y * gridDim.z;
    unsigned sum, cnt, mine, sp = 0u;
    for (;;) {
        sum = 0u; cnt = 0u; mine = 0u;
#pragma unroll
        for (unsigned j = 0; j < 16; ++j) { const unsigned c = xb_ld(&bar[XB_XCNT(j)]); sum += c; cnt += (c > 0u) ? 1u : 0u; mine = (j == x) ? c : mine; }
        if (sum == G) break;
        __builtin_amdgcn_s_sleep(1);
        if ((++sp & 255u) == 0u) { if (xb_ld(&bar[XB_TMO])) break; if (sp > XB_SPIN_CAP) { atomicAdd(&bar[XB_TMO], 1u); break; } }
    }
    nloc = mine > 0u ? mine : 1u; nx = cnt > 0u ? cnt : 1u;
}

__device__ __forceinline__ void xcd_barrier(const XcdBarrier& b) {
    asm volatile("s_waitcnt vmcnt(0)" ::: "memory");
    __syncthreads();
    if (threadIdx.x == 0) {
        unsigned* bar = b.bar; asm volatile("" : "+s"(bar));
        __builtin_amdgcn_s_waitcnt(0);
        unsigned nloc = b.st[0], nx = b.st[1];
        if (nloc == 0u) { xcd_barrier_complete(bar, b.x, nloc, nx); b.st[0] = nloc; b.st[1] = nx; }
        const unsigned old = xb_add(&bar[XB_XSUB(b.x)], 1u);
        const unsigned gen = old / nloc;
        if (old + 1u == (gen + 1u) * nloc) {
            __builtin_amdgcn_fence(__ATOMIC_RELEASE, "agent");
            asm volatile("s_waitcnt vmcnt(0)" ::: "memory");
            const unsigned og = xb_add(&bar[XB_TOP], 1u);
            const unsigned tg = og / nx;
            if (og + 1u == (tg + 1u) * nx) xb_add(&bar[XB_TOPGEN], 1u);
            else XB_SPIN(xb_ld(&bar[XB_TOPGEN]) == tg, bar);
            __builtin_amdgcn_fence(__ATOMIC_ACQUIRE, "agent");
            xb_add(&bar[XB_XGEN(b.x)], 1u);
            asm volatile("s_waitcnt vmcnt(0)" ::: "memory");
        } else {
            XB_SPIN(xb_ld(&bar[XB_XGEN(b.x)]) == gen, bar);
            __builtin_amdgcn_fence(__ATOMIC_ACQUIRE, "agent");
            asm volatile("s_waitcnt vmcnt(0)" ::: "memory");
        }
    }
    __syncthreads();
}
constexpr int NWAVES = 8;
constexpr int BATCH = 8, T = 4096, D = 1024, M = BATCH * T, FF = 2816, NGU = 2 * FF, NINP = 2560, NIN_SRC = 2516, NL = 2;
constexpr float RMS_EPS = 1e-6f;
constexpr size_t MiB = 1u << 20;
constexpr size_t WS_CTL = 0, CTL_ZERO_BYTES = 1 * MiB;
constexpr size_t WS_CS64 = 1 * MiB;
constexpr size_t WS_CS32 = 2 * MiB;
constexpr size_t WS_ADA = 2 * MiB + 512 * 1024;
constexpr size_t WS_CMPB = 3 * MiB + 128 * 1024;
constexpr size_t WS_KMEAN = 3 * MiB + 256 * 1024;
constexpr size_t WS_RSTDQ = 3 * MiB + 512 * 1024;
constexpr size_t WS_RSTDKV = 3 * MiB + 768 * 1024;
constexpr size_t WS_KCMP = 4 * MiB;
constexpr size_t WS_VCMP = 4 * MiB + 512 * 1024;
constexpr size_t WS_CMPH = 5 * MiB;
constexpr size_t WS_WTS = 10 * MiB, WTS_LAYER = 46 * MiB;
constexpr size_t WO_GU1 = 0, WO_D1 = 11 * MiB, WO_GU2 = 17 * MiB, WO_D2 = 28 * MiB, WO_IN = 34 * MiB, WO_OUT = 39 * MiB, WO_UQ = 41 * MiB, WO_UKV = 41 * MiB + 512 * 1024, WO_C1K = 42 * MiB, WO_C1V = 43 * MiB;
constexpr size_t WS_XB = 104 * MiB;
constexpr size_t WS_BIG = 168 * MiB;
constexpr size_t WS_HID = WS_BIG;
constexpr size_t WS_QM_BF = 168 * MiB, WS_KM_BF = 184 * MiB, WS_VM_BF = 200 * MiB, WS_QM_F = 216 * MiB, WS_KM_F = 248 * MiB;
constexpr size_t WS_CQ = 280 * MiB, WS_CKV = 296 * MiB;
constexpr size_t WS_QN = 304 * MiB, WS_KC = 320 * MiB, WS_VC = 324 * MiB, WS_KS = 328 * MiB, WS_VS = 332 * MiB, WS_KW = 336 * MiB, WS_VW = 340 * MiB;
constexpr size_t WS_QD = 344 * MiB, WS_KD = 360 * MiB, WS_VD = 364 * MiB, WS_IQ = 368 * MiB, WS_IK = 400 * MiB, WS_GW = 404 * MiB;
constexpr size_t WS_QMLA = 408 * MiB, WS_KMLA = 432 * MiB, WS_VMLA = 456 * MiB;
constexpr size_t WS_DSAMASK = 472 * MiB;
constexpr size_t WS_OC = 488 * MiB;
constexpr size_t WS_KCMPB = 9 * MiB + 256 * 1024, WS_VCMPB = 9 * MiB + 512 * 1024;
constexpr size_t WS_NSEL = 9 * MiB;
constexpr size_t WS_END = 512 * MiB;
constexpr int CW_BAR = 4096;
constexpr int CW_WMAX = 8192;
constexpr float ACT_CLIP = 12.0f;
constexpr int RING_OFF = 0, RING_BYTES = 131072;
constexpr int LDSCTL_OFF = RING_BYTES, MISC_OFF = LDSCTL_OFF + 320;
constexpr int XTRA_OFF = 132096, XTRA_WAVE = 2112;
constexpr int LDS_BYTES = 155648;
static_assert(XTRA_OFF + NWAVES * XTRA_WAVE <= LDS_BYTES && MISC_OFF + 128 <= XTRA_OFF, "LDS map");

struct Args { const float* in[28]; float* out; unsigned char* ws; int ph_lo, ph_hi; };
struct Frame {
    LAS unsigned char* lds;
    volatile LAS unsigned* MISC;
    gu32* ctl;
    unsigned char* ws;
    int G;
    const Args* A;
    float* out;
};
enum { I_X = 0, I_C, I_ADAW, I_ADAB, I_F1N, I_F1G, I_F1U, I_F1D, I_MIXN, I_WIN, I_QNORM, I_WUQ, I_KVNORM, I_WUK, I_WUV, I_PEK, I_PEV, I_CK1, I_CK2, I_CV1, I_CV2, I_GN, I_WOUT, I_F2N, I_F2G, I_F2U, I_F2D, I_FINN };

__device__ __forceinline__ int opaque_v(int v) { asm volatile("" : "+v"(v)); return v; }
__device__ __forceinline__ int cur_tid() { return opaque_v((int)threadIdx.x); }
__device__ __forceinline__ int cur_lane() { return opaque_v((int)threadIdx.x) & 63; }
__device__ __forceinline__ int cur_wave() { return __builtin_amdgcn_readfirstlane(opaque_v((int)threadIdx.x) >> 6); }
template <int CTRL> __device__ __forceinline__ float dpp_f(float v) { return __int_as_float(__builtin_amdgcn_update_dpp(0, __float_as_int(v), CTRL, 0xf, 0xf, false)); }
__device__ __forceinline__ float wave_sum(float v) {
    v += dpp_f<0xB1>(v); v += dpp_f<0x4E>(v); v += dpp_f<0x141>(v); v += dpp_f<0x140>(v);
    const float r0 = __int_as_float(__builtin_amdgcn_readlane(__float_as_int(v), 0)), r1 = __int_as_float(__builtin_amdgcn_readlane(__float_as_int(v), 16));
    const float r2 = __int_as_float(__builtin_amdgcn_readlane(__float_as_int(v), 32)), r3 = __int_as_float(__builtin_amdgcn_readlane(__float_as_int(v), 48));
    return (r0 + r1) + (r2 + r3);
}
__device__ __forceinline__ float wave_max(float v) {
    v = fmaxf(v, dpp_f<0xB1>(v)); v = fmaxf(v, dpp_f<0x4E>(v)); v = fmaxf(v, dpp_f<0x141>(v)); v = fmaxf(v, dpp_f<0x140>(v));
    const float r0 = __int_as_float(__builtin_amdgcn_readlane(__float_as_int(v), 0)), r1 = __int_as_float(__builtin_amdgcn_readlane(__float_as_int(v), 16));
    const float r2 = __int_as_float(__builtin_amdgcn_readlane(__float_as_int(v), 32)), r3 = __int_as_float(__builtin_amdgcn_readlane(__float_as_int(v), 48));
    return fmaxf(fmaxf(r0, r1), fmaxf(r2, r3));
}
__device__ __forceinline__ float bf2f(unsigned short b) { return __uint_as_float((unsigned)b << 16); }
__device__ __forceinline__ void unpack8(const v4u w, float* f) {
    f[0] = __uint_as_float(w.x << 16); f[1] = __uint_as_float(w.x & 0xffff0000u); f[2] = __uint_as_float(w.y << 16); f[3] = __uint_as_float(w.y & 0xffff0000u);
    f[4] = __uint_as_float(w.z << 16); f[5] = __uint_as_float(w.z & 0xffff0000u); f[6] = __uint_as_float(w.w << 16); f[7] = __uint_as_float(w.w & 0xffff0000u);
}
__device__ __forceinline__ float sigmoid_f(float x) { return 1.0f / (1.0f + __expf(-x)); }

__device__ __forceinline__ int perm64(int j) { return 32 * ((j & 31) >> 4) + 16 * (j >> 5) + (j & 15); }
__device__ __forceinline__ int win_src_col(int c) {
    if (c < 512) return (c & ~63) + perm64(c & 63);
    if (c < 1184) return c;
    if (c < 1504) { const int r = c - 1184; return 1184 + (r & ~63) + perm64(r & 63); }
    if (c < 1568) return c;
    if (c < 1632) return 1568 + perm64(c - 1568);
    if (c < 1696) return c;
    if (c < 1760) return 1696 + perm64(c - 1696);
    if (c < 1824) return c;
    if (c < 2144) { const int r = c - 1824; return 1836 + (r & ~63) + perm64(r & 63); }
    if (c < 2208) return 2156 + (c - 2144);
    if (c < 2464) return 2220 + (c - 2208);
    if (c < 2496) return 2476 + (c - 2464);
    if (c < 2508) return 1824 + (c - 2496);
    if (c < 2516) return 2508 + (c - 2508);
    return -1;
}
constexpr int WK_K[8] = {1024, 2816, 1024, 2816, 1024, 1024, 256, 128};
constexpr int WK_N[8] = {5632, 1024, 5632, 1024, 2560, 1024, 512, 512};
__device__ __forceinline__ size_t wk_off(int kind) { return kind == 0 ? WO_GU1 : kind == 1 ? WO_D1 : kind == 2 ? WO_GU2 : kind == 3 ? WO_D2 : kind == 4 ? WO_IN : kind == 5 ? WO_OUT : kind == 6 ? WO_UQ : kind == 7 ? WO_UKV : kind == 8 ? WO_C1K : WO_C1V; }
__device__ __forceinline__ const float* wsrc(const Frame& F, int kind, int l, int R, int& stride) {
    switch (kind) {
    case 0: case 2: { const int G = R >> 5, w = R & 31, j = 16 * G + (w & 15); stride = FF;
        const float* g = F.A->in[kind == 0 ? I_F1G : I_F2G] + (size_t)l * D * FF; const float* u = F.A->in[kind == 0 ? I_F1U : I_F2U] + (size_t)l * D * FF; return ((w >> 4) ? u : g) + j; }
    case 1: case 3: stride = D; return F.A->in[kind == 1 ? I_F1D : I_F2D] + (size_t)l * FF * D + R;
    case 4: { stride = NIN_SRC; const int s = win_src_col(R); return s < 0 ? nullptr : F.A->in[I_WIN] + (size_t)l * D * NIN_SRC + s; }
    case 5: stride = D; return F.A->in[I_WOUT] + (size_t)l * D * D + R;
    case 6: stride = 384; return R < 384 ? F.A->in[I_WUQ] + (size_t)l * 256 * 384 + R : nullptr;
    case 7: stride = 256; return R < 256 ? F.A->in[I_WUK] + (size_t)l * 128 * 256 + R : F.A->in[I_WUV] + (size_t)l * 128 * 256 + (R - 256);
    default: stride = 256; return F.A->in[kind == 8 ? I_CK1 : I_CV1] + (size_t)l * 2048 * 256 + R;
    }
}

struct WinDesc {
    unsigned char* ws;
    __device__ __forceinline__ pg8::ProjDesc operator()(int G) const {
        pg8::ProjDesc d; d.kind = 0; d.dfreq0 = 0; d.nstride = 16; d.rep = 1; d.repstride = 0; d.bpitch = 0; d.fpitch = 0; d.pad = 0; d.bp = nullptr; d.fp = nullptr;
        const int c = 32 * G;
#define ROPE64(rel, BOFF, BP, FOFF, FP) do { const int hh_ = (rel) >> 6, g_ = ((rel) >> 5) & 1; d.kind = 2; d.dfreq0 = 16 * g_; d.nstride = 32; \
            d.bp = (bf16*)(ws + (BOFF)) + hh_ * 64 + 16 * g_; d.bpitch = (BP); if (FP) { d.fp = (float*)(ws + (FOFF)) + hh_ * 64 + 16 * g_; d.fpitch = (FP); } } while (0)
#define PLAINB(rel, BOFF, BP) do { d.kind = 1; d.bp = (bf16*)(ws + (BOFF)) + (rel); d.bpitch = (BP); } while (0)
#define PLAINF(rel, FOFF, FP) do { d.kind = 1; d.fp = (float*)(ws + (FOFF)) + (rel); d.fpitch = (FP); } while (0)
        if (c < 256) ROPE64(c, WS_QM_BF, 256, WS_QM_F, 256);
        else if (c < 512) ROPE64(c - 256, WS_KM_BF, 256, WS_KM_F, 256);
        else if (c < 768) PLAINB(c - 512, WS_VM_BF, 256);
        else if (c < 1024) PLAINB(c - 768, WS_CQ, 256);
        else if (c < 1152) PLAINB(c - 1024, WS_CKV, 128);
        else if (c < 1184) { d.kind = 3; d.nstride = 16; d.bp = (bf16*)(ws + WS_KMLA) + 64; d.bpitch = 384; d.rep = 4; d.repstride = 96; }
        else if (c < 1440) ROPE64(c - 1184, WS_QN, 256, 0, 0);
        else if (c < 1504) ROPE64(c - 1440, WS_KC, 64, 0, 0);
        else if (c < 1568) PLAINB(c - 1504, WS_VC, 64);
        else if (c < 1632) ROPE64(c - 1568, WS_KS, 64, 0, 0);
        else if (c < 1696) PLAINB(c - 1632, WS_VS, 64);
        else if (c < 1760) ROPE64(c - 1696, WS_KW, 64, 0, 0);
        else if (c < 1824) PLAINB(c - 1760, WS_VW, 64);
        else if (c < 2080) ROPE64(c - 1824, WS_QD, 256, 0, 0);
        else if (c < 2144) ROPE64(c - 2080, WS_KD, 64, 0, 0);
        else if (c < 2208) PLAINB(c - 2144, WS_VD, 64);
        else if (c < 2464) PLAINF(c - 2208, WS_IQ, 256);
        else if (c < 2496) { PLAINF(c - 2464, WS_IK, 32); d.pad = 1; }
        else if (c < 2528) PLAINF(c - 2496, WS_GW, 32);
#undef ROPE64
#undef PLAINB
#undef PLAINF
        return d;
    }
};
struct MlaQDesc {
    unsigned char* ws;
    __device__ __forceinline__ pg8::ProjDesc operator()(int G) const {
        pg8::ProjDesc d; d.kind = 0; d.dfreq0 = 0; d.nstride = 16; d.rep = 1; d.repstride = 0; d.bpitch = 384; d.fpitch = 0; d.pad = 0; d.bp = nullptr; d.fp = nullptr;
        if (G < 12) { const int hh = G / 3, part = G - 3 * hh; d.kind = (part == 2) ? 3 : 1; d.bp = (bf16*)(ws + WS_QMLA) + hh * 96 + 32 * part; }
        return d;
    }
};
struct MlaKvDesc {
    unsigned char* ws;
    __device__ __forceinline__ pg8::ProjDesc operator()(int G) const {
        pg8::ProjDesc d; d.kind = 1; d.dfreq0 = 0; d.nstride = 16; d.rep = 1; d.repstride = 0; d.bpitch = 0; d.fpitch = 0; d.pad = 0; d.bp = nullptr; d.fp = nullptr;
        const int c = 32 * G;
        if (c < 256) { d.bp = (bf16*)(ws + WS_KMLA) + (c >> 6) * 96 + (c & 63); d.bpitch = 384; }
        else { d.bp = (bf16*)(ws + WS_VMLA) + (c - 256); d.bpitch = 256; }
        return d;
    }
};

__device__ __forceinline__ void p0_prologue(Frame& F) {
    const int tid = cur_tid();
    const int wave = cur_wave(), gw = blockIdx.x * NWAVES + wave, NGW = F.G * NWAVES, lane = cur_lane();
    {
        LAS float* scr = (LAS float*)(F.lds + RING_OFF + wave * 16384);
        constexpr int PER_LAYER = 2816 + 1408 + 2816 + 1408 + 1280 + 512 + 64 + 32 + 256 + 256;
        for (int it = gw; it < NL * PER_LAYER; it += NGW) {
            const int l = it / PER_LAYER; int r = it - l * PER_LAYER; int kind = 0;
            { const int cnt[10] = {2816, 1408, 2816, 1408, 1280, 512, 64, 32, 256, 256};
#pragma unroll
              for (int q = 0; q < 9; ++q) { if (kind == q && r >= cnt[q]) { r -= cnt[q]; kind = q + 1; } } }
            if (kind == 0 || kind == 2) continue;
            const int K = kind == 0 || kind == 2 || kind == 4 || kind == 5 ? 1024 : (kind == 1 || kind == 3) ? 2816 : kind == 6 ? 256 : kind == 7 ? 128 : 2048;
            const int N = kind == 0 || kind == 2 ? 5632 : kind == 4 ? 2560 : (kind == 6 || kind == 7) ? 512 : kind >= 8 ? 256 : 1024;
            const int nblk = N / 32, kb = r / nblk, nb = r - kb * nblk, k0 = 64 * kb, n0 = 32 * nb;
            int stride; const float* colp = wsrc(F, kind, l, n0 + (lane & 31), stride);
            const float* ksc = kind == 6 ? F.A->in[I_QNORM] + l * 256 : kind == 7 ? F.A->in[I_KVNORM] + l * 128 : nullptr;
            bf16* WT = (bf16*)(F.ws + WS_WTS + (size_t)l * WTS_LAYER + wk_off(kind));
            float vv[32];
#pragma unroll
            for (int i = 0; i < 32; ++i) { const int kk = 2 * i + (lane >> 5); vv[i] = colp ? colp[(size_t)(k0 + kk) * stride] : 0.f; }
#pragma unroll
            for (int i = 0; i < 32; ++i) { const int kk = 2 * i + (lane >> 5); float v = vv[i]; if (ksc) v *= ksc[k0 + kk]; scr[kk * 33 + (lane & 31)] = v; }
            LDS_WAIT(); asm volatile("" ::: "memory");
            const int c = lane & 7;
#pragma unroll
            for (int j = 0; j < 4; ++j) { const int n = (lane >> 3) + 8 * j; const LAS float* s = scr + (8 * c) * 33 + n;
                v4u o; o.x = pk2(s[0 * 33], s[1 * 33]); o.y = pk2(s[2 * 33], s[3 * 33]); o.z = pk2(s[4 * 33], s[5 * 33]); o.w = pk2(s[6 * 33], s[7 * 33]);
                *(GAS v4u*)(WT + (size_t)(n0 + n) * K + k0 + 8 * c) = o; }
            LDS_WAIT(); asm volatile("" ::: "memory");
        }
    }
    {
        const int gtid = blockIdx.x * 512 + tid, NT = F.G * 512; constexpr int n4 = D * FF / 4;
#pragma unroll 1
        for (int cm = 0; cm < 8; ++cm) { const int combo = cm >> 1, l = combo >> 1, ff2 = combo & 1, up = cm & 1;
            const f32x4* p = (const f32x4*)(F.A->in[ff2 ? (up ? I_F2U : I_F2G) : (up ? I_F1U : I_F1G)] + (size_t)l * D * FF);
            f32x4 v[6];
#pragma unroll
            for (int q = 0; q < 6; ++q) { const int i = gtid + q * NT; v[q] = i < n4 ? p[i] : (f32x4){0.f, 0.f, 0.f, 0.f}; }
            float mx = 0.f;
#pragma unroll
            for (int q = 0; q < 6; ++q) mx = fmaxf(mx, fmaxf(fmaxf(fabsf(v[q].x), fabsf(v[q].y)), fmaxf(fabsf(v[q].z), fabsf(v[q].w))));
            for (int i = gtid + 6 * NT; i < n4; i += NT) { const f32x4 w = p[i]; mx = fmaxf(mx, fmaxf(fmaxf(fabsf(w.x), fabsf(w.y)), fmaxf(fabsf(w.z), fabsf(w.w)))); }
            mx = wave_max(mx);
            if (lane == 0) __hip_atomic_fetch_max((unsigned*)(F.ctl + CW_WMAX) + combo, __float_as_uint(mx), __ATOMIC_RELAXED, __HIP_MEMORY_SCOPE_AGENT); }
    }
    for (int i = blockIdx.x * 512 + tid; i < 4096 * 48; i += F.G * 512) {
        const int pos = i / 48, j = i - pos * 48;
        float invf; float* dst;
        if (j < 32) { invf = 1.0f / (float)pow(10000.0, (double)j / 32.0); dst = (float*)(F.ws + WS_CS64) + ((size_t)pos * 32 + j) * 2; }
        else { invf = 1.0f / (float)pow(10000.0, (double)(j - 32) / 16.0); dst = (float*)(F.ws + WS_CS32) + ((size_t)pos * 16 + (j - 32)) * 2; }
        const float ang = (float)pos * invf;
        dst[0] = (float)cos((double)ang); dst[1] = (float)sin((double)ang);
    }
    {
        LAS float* red = (LAS float*)(F.lds + RING_OFF + 8 * 16384 - 2048);
        for (int task = blockIdx.x; task < NL * 2 * 4; task += F.G) {
            const int l = task >> 3, kvq = task & 7, kv = kvq >> 2, j = (kvq & 3) * 64 + lane;
            const float* pe = F.A->in[kv ? I_PEV : I_PEK] + (size_t)l * 2048 + wave * 256; const float* w1 = F.A->in[kv ? I_CV1 : I_CK1] + (size_t)l * 2048 * 256 + (size_t)wave * 256 * 256 + j;
            float acc = 0.f;
#pragma unroll 32
            for (int k = 0; k < 256; ++k) acc += pe[k] * w1[(size_t)k * 256];
            __syncthreads();
            red[wave * 64 + lane] = acc;
            __syncthreads();
            if (wave == 0) { float s = 0.f;
#pragma unroll
                for (int w = 0; w < 8; ++w) s += red[w * 64 + lane];
                ((float*)(F.ws + WS_CMPB))[(l * 2 + kv) * 256 + j] = s; }
        }
    }
    {
        __syncthreads();
        LAS float* cact = (LAS float*)(F.lds + RING_OFF);
        LAS float* red = (LAS float*)(F.lds + RING_OFF + 32768);
        for (int i = tid; i < 8 * 1024; i += 512) { const float cv = F.A->in[I_C][i]; cact[i] = cv / (1.0f + __expf(-cv)); }
        __syncthreads();
        for (int task = blockIdx.x; task < NL * 144; task += F.G) {
            const int l = task / 144, n0 = (task - l * 144) * 64;
            const float* W = F.A->in[I_ADAW] + (size_t)l * 1024 * 9216 + n0 + lane;
            float acc[8];
#pragma unroll
            for (int b = 0; b < 8; ++b) acc[b] = 0.f;
            const int kbeg = wave * 128;
#pragma unroll 16
            for (int k = kbeg; k < kbeg + 128; ++k) { const float wv = W[(size_t)k * 9216];
#pragma unroll
                for (int b = 0; b < 8; ++b) acc[b] += cact[b * 1024 + k] * wv; }
#pragma unroll
            for (int b = 0; b < 8; ++b) red[(wave * 8 + b) * 64 + lane] = acc[b];
            __syncthreads();
            { const int b = wave; float s = F.A->in[I_ADAB][(size_t)l * 9216 + n0 + lane];
#pragma unroll
              for (int w = 0; w < 8; ++w) s += red[(w * 8 + b) * 64 + lane];
              ((float*)(F.ws + WS_ADA))[((size_t)l * 8 + b) * 9216 + n0 + lane] = s; }
            __syncthreads();
        }
    }
}

__device__ __forceinline__ unsigned q8pack4(float a, float b, float c, float d, float qs) {
    int q0 = (int)__builtin_rintf(a * qs), q1 = (int)__builtin_rintf(b * qs), q2 = (int)__builtin_rintf(c * qs), q3 = (int)__builtin_rintf(d * qs);
    q0 = q0 > 127 ? 127 : (q0 < -127 ? -127 : q0); q1 = q1 > 127 ? 127 : (q1 < -127 ? -127 : q1); q2 = q2 > 127 ? 127 : (q2 < -127 ? -127 : q2); q3 = q3 > 127 ? 127 : (q3 < -127 ? -127 : q3);
    return (unsigned)(q0 & 255) | ((unsigned)(q1 & 255) << 8) | ((unsigned)(q2 & 255) << 16) | ((unsigned)(q3 & 255) << 24);
}
__device__ __forceinline__ void wgu8_convert(Frame& F) {
    const int wave = cur_wave(), gw = blockIdx.x * NWAVES + wave, NGW = F.G * NWAVES, lane = cur_lane();
    LAS float* scr = (LAS float*)(F.lds + RING_OFF + wave * 16384);
    for (int it = gw; it < 4 * 2816; it += NGW) {
        const int combo = it / 2816, r = it - combo * 2816, l = combo >> 1, ff2 = combo & 1, kind = ff2 ? 2 : 0;
        const int kb = r / 176, nb = r - kb * 176, k0 = 64 * kb, n0 = 32 * nb;
        int stride; const float* colp = wsrc(F, kind, l, n0 + (lane & 31), stride);
        const float wmax = __uint_as_float(__hip_atomic_load((unsigned*)(F.ctl + CW_WMAX) + combo, __ATOMIC_RELAXED, __HIP_MEMORY_SCOPE_AGENT)), qs = wmax > 0.f ? 127.0f / wmax : 0.f;
        signed char* WT = (signed char*)(F.ws + WS_WTS + (size_t)l * WTS_LAYER + wk_off(kind));
        float vv[32];
#pragma unroll
        for (int i = 0; i < 32; ++i) { const int kk = 2 * i + (lane >> 5); vv[i] = colp[(size_t)(k0 + kk) * stride]; }
#pragma unroll
        for (int i = 0; i < 32; ++i) { const int kk = 2 * i + (lane >> 5); scr[kk * 33 + (lane & 31)] = vv[i]; }
        LDS_WAIT(); asm volatile("" ::: "memory");
#pragma unroll
        for (int q = 0; q < 2; ++q) { const int p = lane + 64 * q, n = p >> 2, c = p & 3; const LAS float* s = scr + (16 * c) * 33 + n;
            v4u o; o.x = q8pack4(s[0 * 33], s[1 * 33], s[2 * 33], s[3 * 33], qs); o.y = q8pack4(s[4 * 33], s[5 * 33], s[6 * 33], s[7 * 33], qs);
            o.z = q8pack4(s[8 * 33], s[9 * 33], s[10 * 33], s[11 * 33], qs); o.w = q8pack4(s[12 * 33], s[13 * 33], s[14 * 33], s[15 * 33], qs);
            *(GAS v4u*)(WT + (size_t)(n0 + n) * 1024 + k0 + 16 * c) = o; }
        LDS_WAIT(); asm volatile("" ::: "memory");
    }
}
template <bool XBF> __device__ __forceinline__ void load_row16(const void* xsrc, int row, int lane, f32x4 (&v)[4]) {
    if (XBF) { const unsigned long long* xr = (const unsigned long long*)((const bf16*)xsrc + (size_t)row * D) + lane;
#pragma unroll
        for (int j = 0; j < 4; ++j) { const unsigned long long w = xr[64 * j];
            v[j] = (f32x4){__uint_as_float((unsigned)w << 16), __uint_as_float((unsigned)w & 0xffff0000u), __uint_as_float((unsigned)(w >> 32) << 16), __uint_as_float((unsigned)(w >> 32) & 0xffff0000u)}; } }
    else { const f32x4* xr = (const f32x4*)((const float*)xsrc + (size_t)row * D) + lane;
#pragma unroll
        for (int j = 0; j < 4; ++j) v[j] = xr[64 * j]; }
}
template <bool XBF, bool Q8>
__device__ __forceinline__ void norm_mod_phase(Frame& F, const void* xsrc, const float* gain, const float* sh, const float* sc, bf16* hout) {
    const int wave = cur_wave(), gw = blockIdx.x * NWAVES + wave, NGW = F.G * NWAVES, lane = cur_lane();
    f32x4 g[4];
#pragma unroll
    for (int j = 0; j < 4; ++j) g[j] = *(const f32x4*)(gain + 4 * lane + 256 * j);
    for (int row0 = gw; row0 < M; row0 += 2 * NGW) {
        const int row1 = row0 + NGW; const bool has1 = row1 < M; const int r1 = has1 ? row1 : row0;
        f32x4 va[4], vb[4]; float sa = 0.f, sb = 0.f;
        load_row16<XBF>(xsrc, row0, lane, va); load_row16<XBF>(xsrc, r1, lane, vb);
#pragma unroll
        for (int j = 0; j < 4; ++j) { sa += (va[j].x * va[j].x + va[j].y * va[j].y) + (va[j].z * va[j].z + va[j].w * va[j].w); sb += (vb[j].x * vb[j].x + vb[j].y * vb[j].y) + (vb[j].z * vb[j].z + vb[j].w * vb[j].w); }
        const float rsa = 1.0f / sqrtf(wave_sum(sa) * (1.f / D) + RMS_EPS), rsb = 1.0f / sqrtf(wave_sum(sb) * (1.f / D) + RMS_EPS);
#pragma unroll
        for (int q = 0; q < 2; ++q) {
            if (q == 1 && !has1) break;
            const int row = q ? row1 : row0; const int b = row >> 12; const float rstd = q ? rsb : rsa;
            const float* shb = sh + (size_t)b * 9216 + 4 * lane; const float* scb = sc + (size_t)b * 9216 + 4 * lane;
            unsigned long long* o8 = (unsigned long long*)(hout + (size_t)row * D) + lane;
            unsigned* o4 = (unsigned*)((signed char*)hout + (size_t)row * D) + lane;
#pragma unroll
            for (int j = 0; j < 4; ++j) { const f32x4 s4 = *(const f32x4*)(shb + 256 * j), c4 = *(const f32x4*)(scb + 256 * j);
                const f32x4 y = (q ? vb[j] : va[j]) * rstd * g[j] * (c4 + 1.0f) + s4;
                if (Q8) o4[64 * j] = q8pack4(y.x, y.y, y.z, y.w, 127.0f / ACT_CLIP);
                else o8[64 * j] = (unsigned long long)pk2(y.x, y.y) | ((unsigned long long)pk2(y.z, y.w) << 32); }
        }
    }
}
__device__ __forceinline__ void final_norm_phase(Frame& F, const bf16* xb, float* out, const float* gain) {
    const int wave = cur_wave(), gw = blockIdx.x * NWAVES + wave, NGW = F.G * NWAVES, lane = cur_lane();
    f32x4 g[4];
#pragma unroll
    for (int j = 0; j < 4; ++j) g[j] = *(const f32x4*)(gain + 4 * lane + 256 * j);
    for (int row0 = gw; row0 < M; row0 += 2 * NGW) {
        const int row1 = row0 + NGW; const bool has1 = row1 < M; const int r1 = has1 ? row1 : row0;
        f32x4 va[4], vb[4]; float sa = 0.f, sb = 0.f;
        load_row16<true>(xb, row0, lane, va); load_row16<true>(xb, r1, lane, vb);
#pragma unroll
        for (int j = 0; j < 4; ++j) { sa += (va[j].x * va[j].x + va[j].y * va[j].y) + (va[j].z * va[j].z + va[j].w * va[j].w); sb += (vb[j].x * vb[j].x + vb[j].y * vb[j].y) + (vb[j].z * vb[j].z + vb[j].w * vb[j].w); }
        const float rsa = 1.0f / sqrtf(wave_sum(sa) * (1.f / D) + RMS_EPS), rsb = 1.0f / sqrtf(wave_sum(sb) * (1.f / D) + RMS_EPS);
        f32x4* xa = (f32x4*)(out + (size_t)row0 * D) + lane;
#pragma unroll
        for (int j = 0; j < 4; ++j) xa[64 * j] = va[j] * rsa * g[j];
        if (has1) { f32x4* xo = (f32x4*)(out + (size_t)row1 * D) + lane;
#pragma unroll
            for (int j = 0; j < 4; ++j) xo[64 * j] = vb[j] * rsb * g[j]; }
    }
}
__device__ __forceinline__ void group_norm_phase(Frame& F, bf16* Y, const float* gn) {
    const int wave = cur_wave(), gw = blockIdx.x * NWAVES + wave, NGW = F.G * NWAVES, lane = cur_lane();
    f32x4 g[4];
#pragma unroll
    for (int j = 0; j < 4; ++j) g[j] = *(const f32x4*)(gn + 256 * j + 4 * lane);
    for (int row0 = gw; row0 < M; row0 += 4 * NGW) {
        unsigned long long w[4][4];
#pragma unroll
        for (int q = 0; q < 4; ++q) { const int row = row0 + q * NGW < M ? row0 + q * NGW : row0; const unsigned long long* yr = (const unsigned long long*)(Y + (size_t)row * D) + lane;
#pragma unroll
            for (int j = 0; j < 4; ++j) w[q][j] = yr[64 * j]; }
#pragma unroll
        for (int q = 0; q < 4; ++q) {
            const int row = row0 + q * NGW; if (row >= M) break;
            unsigned long long* yr = (unsigned long long*)(Y + (size_t)row * D) + lane;
#pragma unroll
            for (int j = 0; j < 4; ++j) {
                const unsigned long long ww = w[q][j];
                const float a0 = __uint_as_float((unsigned)ww << 16), a1 = __uint_as_float((unsigned)ww & 0xffff0000u), a2 = __uint_as_float((unsigned)(ww >> 32) << 16), a3 = __uint_as_float((unsigned)(ww >> 32) & 0xffff0000u);
                const float ss = wave_sum((a0 * a0 + a1 * a1) + (a2 * a2 + a3 * a3));
                const float rstd = 1.0f / sqrtf(ss * (1.f / 256.f) + RMS_EPS);
                yr[64 * j] = (unsigned long long)pk2(a0 * rstd * g[j].x, a1 * rstd * g[j].y) | ((unsigned long long)pk2(a2 * rstd * g[j].z, a3 * rstd * g[j].w) << 32);
            }
        }
    }
}
__device__ __forceinline__ unsigned long long causal_word(int d) { return d >= 63 ? ~0ull : (d < 0 ? 0ull : ((2ull << d) - 1ull)); }
__device__ __forceinline__ int mbcnt64(unsigned long long m) { return (int)__builtin_amdgcn_mbcnt_hi((unsigned)(m >> 32), __builtin_amdgcn_mbcnt_lo((unsigned)m, 0u)); }
__device__ __forceinline__ unsigned fkey(float x) { const unsigned u = __float_as_uint(x); return (u & 0x80000000u) ? ~u : (u | 0x80000000u); }
__device__ __forceinline__ float reduce64(const float (&o)[64], int lane) {
    float r5[32], r4[16], r3[8], r2[4], r1[2];
    { const bool hi = (lane & 32) != 0;
#pragma unroll
      for (int i = 0; i < 32; ++i) { const float a = o[i], b = o[i + 32]; r5[i] = (hi ? b : a) + __shfl_xor(hi ? a : b, 32); } }
    { const bool hi = (lane & 16) != 0;
#pragma unroll
      for (int i = 0; i < 16; ++i) { const float a = r5[i], b = r5[i + 16]; r4[i] = (hi ? b : a) + __shfl_xor(hi ? a : b, 16); } }
    { const bool hi = (lane & 8) != 0;
#pragma unroll
      for (int i = 0; i < 8; ++i) { const float a = r4[i], b = r4[i + 8]; r3[i] = (hi ? b : a) + __shfl_xor(hi ? a : b, 8); } }
    { const bool hi = (lane & 4) != 0;
#pragma unroll
      for (int i = 0; i < 4; ++i) { const float a = r3[i], b = r3[i + 4]; r2[i] = (hi ? b : a) + __shfl_xor(hi ? a : b, 4); } }
    { const bool hi = (lane & 2) != 0;
#pragma unroll
      for (int i = 0; i < 2; ++i) { const float a = r2[i], b = r2[i + 2]; r1[i] = (hi ? b : a) + __shfl_xor(hi ? a : b, 2); } }
    const bool hi = (lane & 1) != 0;
    return (hi ? r1[1] : r1[0]) + __shfl_xor(hi ? r1[0] : r1[1], 1);
}
struct KVbf {
    const bf16* K; const bf16* V; int kp, vp;
    template <int DQ> __device__ __forceinline__ float dot(int row, const LAS float* q) const {
        const v4u* p = (const v4u*)(K + (size_t)row * kp); float s = 0.f;
#pragma unroll
        for (int c = 0; c < DQ / 8; ++c) { float f[8]; unpack8(p[c], f); const f32x4 q0 = *(const LAS f32x4*)(q + 8 * c), q1 = *(const LAS f32x4*)(q + 8 * c + 4);
            s += (q0.x * f[0] + q0.y * f[1]) + (q0.z * f[2] + q0.w * f[3]) + (q1.x * f[4] + q1.y * f[5]) + (q1.z * f[6] + q1.w * f[7]); }
        return s;
    }
    __device__ __forceinline__ void axpy(int row, float pw, float (&o)[64]) const {
        const v4u* p = (const v4u*)(V + (size_t)row * vp);
#pragma unroll
        for (int c = 0; c < 8; ++c) { float f[8]; unpack8(p[c], f);
#pragma unroll
            for (int e = 0; e < 8; ++e) o[8 * c + e] += pw * f[e]; }
    }
};
struct KVf32 {
    const float* K; const float* V; int kp, vp;
    template <int DQ> __device__ __forceinline__ float dot(int row, const LAS float* q) const {
        const f32x4* p = (const f32x4*)(K + (size_t)row * kp); float s = 0.f;
#pragma unroll
        for (int c = 0; c < DQ / 4; ++c) { const f32x4 f = p[c]; const f32x4 qv = *(const LAS f32x4*)(q + 4 * c); s += (qv.x * f.x + qv.y * f.y) + (qv.z * f.z + qv.w * f.w); }
        return s;
    }
    __device__ __forceinline__ void axpy(int row, float pw, float (&o)[64]) const {
        const f32x4* p = (const f32x4*)(V + (size_t)row * vp);
#pragma unroll
        for (int c = 0; c < 16; ++c) { const f32x4 f = p[c]; o[4 * c] += pw * f.x; o[4 * c + 1] += pw * f.y; o[4 * c + 2] += pw * f.z; o[4 * c + 3] += pw * f.w; }
    }
};
template <int DQ, class KV, class KeyFn>
__device__ __forceinline__ float wave_attend(const LAS float* q, float scale, int nslots, const KeyFn& keyf, const KV& kv, int lane) {
    float m = -INFINITY;
    for (int s = 0; s < nslots; ++s) { const int key = keyf(s); if (key >= 0) m = fmaxf(m, kv.template dot<DQ>(key, q) * scale); }
    const float Mx = wave_max(m);
    float o[64];
#pragma unroll
    for (int d = 0; d < 64; ++d) o[d] = 0.f;
    float l = 0.f;
    if (Mx > -INFINITY) {
        for (int s = 0; s < nslots; ++s) { const int key = keyf(s);
            if (key >= 0) { const float p = __expf(kv.template dot<DQ>(key, q) * scale - Mx); l += p; kv.axpy(key, p, o); } }
    }
    l = wave_sum(l);
    const float r = reduce64(o, lane);
    return l > 0.f ? r / l : 0.f;
}
__device__ __forceinline__ void task_bt(int i, int& t, int& rest) { const int tt = i & 2047, j = i >> 11; t = (j & 1) ? 4095 - tt : tt; rest = j >> 1; }

__device__ __forceinline__ void m1_phase(Frame& F, int l) {
    const int wave = cur_wave(), gw = blockIdx.x * NWAVES + wave, NGW = F.G * NWAVES, lane = cur_lane();
    const bf16* CQ = (const bf16*)(F.ws + WS_CQ); const bf16* CKV = (const bf16*)(F.ws + WS_CKV);
    float* rq = (float*)(F.ws + WS_RSTDQ); float* rkv = (float*)(F.ws + WS_RSTDKV);
    for (int row0 = gw; row0 < M; row0 += 4 * NGW) {
        unsigned long long wq[4]; unsigned wk[4];
#pragma unroll
        for (int q = 0; q < 4; ++q) { const int row = row0 + q * NGW < M ? row0 + q * NGW : row0; wq[q] = ((const unsigned long long*)(CQ + (size_t)row * 256))[lane]; wk[q] = ((const unsigned*)(CKV + (size_t)row * 128))[lane]; }
#pragma unroll
        for (int q = 0; q < 4; ++q) {
            const int row = row0 + q * NGW; if (row >= M) break;
            const unsigned long long w = wq[q];
            const float a0 = __uint_as_float((unsigned)w << 16), a1 = __uint_as_float((unsigned)w & 0xffff0000u), a2 = __uint_as_float((unsigned)(w >> 32) << 16), a3 = __uint_as_float((unsigned)(w >> 32) & 0xffff0000u);
            const float s1 = wave_sum((a0 * a0 + a1 * a1) + (a2 * a2 + a3 * a3));
            const float b0 = __uint_as_float(wk[q] << 16), b1 = __uint_as_float(wk[q] & 0xffff0000u);
            const float s2 = wave_sum(b0 * b0 + b1 * b1);
            if (lane == 0) { rq[row] = 1.0f / sqrtf(s1 * (1.f / 256.f) + RMS_EPS); rkv[row] = 1.0f / sqrtf(s2 * (1.f / 128.f) + RMS_EPS); }
        }
    }
    const float* KMF = (const float*)(F.ws + WS_KM_F); float* kmean = (float*)(F.ws + WS_KMEAN);
    for (int task = gw; task < 512; task += NGW) {
        const int b = task >> 6, blk = (task >> 2) & 15, h = task & 3;
        const float* p = KMF + ((size_t)(b * T + blk * 256)) * 256 + h * 64 + lane; float s = 0.f;
#pragma unroll 32
        for (int i = 0; i < 256; ++i) s += p[(size_t)i * 256];
        kmean[((b * 4 + h) * 16 + blk) * 64 + lane] = s * (1.f / 256.f);
    }
}
__device__ __forceinline__ void cmp2_phase(Frame& F, int l) {
    const int wave = cur_wave(), gw = blockIdx.x * NWAVES + wave, NGW = F.G * NWAVES, lane = cur_lane();
    const float* cmph = (const float*)(F.ws + WS_CMPH);
    for (int task = gw; task < 2 * 8 * 255; task += NGW) {
        const int kv = task / 2040, r1 = task - kv * 2040, b = r1 / 255, n = r1 - b * 255;
        const float* hp = cmph + ((size_t)(kv * 8 + b) * 256 + n) * 256;
        const float* w2 = F.A->in[kv ? I_CV2 : I_CK2] + (size_t)l * 256 * 64 + lane;
        float acc = 0.f;
#pragma unroll 32
        for (int j = 0; j < 256; ++j) acc += hp[j] * w2[j * 64];
        ((float*)(F.ws + (kv ? WS_VCMP : WS_KCMP)))[((size_t)b * 256 + n) * 64 + lane] = acc;
        ((bf16*)(F.ws + (kv ? WS_VCMPB : WS_KCMPB)))[((size_t)b * 256 + n) * 64 + lane] = (bf16)f2bf(acc);
    }
    for (int task = gw; task < 16; task += NGW) ((bf16*)(F.ws + ((task & 1) ? WS_VCMPB : WS_KCMPB)))[((size_t)(task >> 1) * 256 + 255) * 64 + lane] = 0;
}
__device__ __forceinline__ void mla_rows_phase(Frame& F) {
    const int wave = cur_wave(), gw = blockIdx.x * NWAVES + wave, NGW = F.G * NWAVES, lane = cur_lane();
    const bf16* Q = (const bf16*)(F.ws + WS_QMLA); bf16* Y = (bf16*)F.out + (size_t)M * D;
    LAS float* q = (LAS float*)(F.lds + RING_OFF + wave * 16384 + 4096);
    for (int i = gw; i < M * 4; i += NGW) {
        int t, bh; task_bt(i, t, bh); const int b = bh >> 2, h = bh & 3, row = b * T + t;
        if (lane < 48) { const unsigned w = ((const unsigned*)(Q + (size_t)row * 384 + h * 96))[lane]; q[2 * lane] = __uint_as_float(w << 16); q[2 * lane + 1] = __uint_as_float(w & 0xffff0000u); }
        LDS_WAIT(); asm volatile("" ::: "memory");
        KVbf kv{(const bf16*)(F.ws + WS_KMLA) + h * 96, (const bf16*)(F.ws + WS_VMLA) + h * 64, 384, 256};
        const int base = b * T;
        auto keyf = [&](int s) { const int p = lane + 64 * s; return p <= t ? base + p : -1; };
        const float r = wave_attend<96>(q, 0.10206207261596577f, (t >> 6) + 1, keyf, kv, lane);
        Y[(size_t)row * 1024 + 256 + h * 64 + lane] = (bf16)f2bf(r);
        LDS_WAIT(); asm volatile("" ::: "memory");
    }
}
__device__ __forceinline__ void moba_rows_phase(Frame& F) {
    const int wave = cur_wave(), gw = blockIdx.x * NWAVES + wave, NGW = F.G * NWAVES, lane = cur_lane();
    const float* QF = (const float*)(F.ws + WS_QM_F); const float* kmean = (const float*)(F.ws + WS_KMEAN); bf16* Y = (bf16*)F.out + (size_t)M * D;
    LAS float* q = (LAS float*)(F.lds + RING_OFF + wave * 16384 + 4096);
    for (int i = gw; i < M * 4; i += NGW) {
        int t, bh; task_bt(i, t, bh); const int b = bh >> 2, h = bh & 3, row = b * T + t, own = t >> 8;
        q[lane] = QF[(size_t)row * 256 + h * 64 + lane];
        LDS_WAIT(); asm volatile("" ::: "memory");
        float g = -INFINITY;
        if (lane < own) { KVf32 km{kmean + (size_t)((b * 4 + h) * 16) * 64, nullptr, 64, 64}; g = km.dot<64>(lane, q); }
        unsigned selmask = 0u;
        for (int r = 0; r < 3; ++r) { const float mx = wave_max(g); if (!(mx > -INFINITY)) break;
            const unsigned long long ball = __ballot(g == mx); const int sl = __ffsll((long long)ball) - 1; selmask |= 1u << sl; if (lane == sl) g = -INFINITY; }
        KVbf kv{(const bf16*)(F.ws + WS_KM_BF) + h * 64, (const bf16*)(F.ws + WS_VM_BF) + h * 64, 256, 256};
        const int base = b * T;
        auto keyf = [&](int s) { const int blk = s >> 2, p = 64 * s + lane; return blk == own ? (p <= t ? base + p : -1) : (((selmask >> blk) & 1u) ? base + p : -1); };
        const float r = wave_attend<64>(q, 0.125f, 4 * own + 4, keyf, kv, lane);
        Y[(size_t)row * 1024 + h * 64 + lane] = (bf16)f2bf(r);
        LDS_WAIT(); asm volatile("" ::: "memory");
    }
}
__device__ __forceinline__ void nsa_tokens_phase(Frame& F) {
    const int wave = cur_wave(), gw = blockIdx.x * NWAVES + wave, NGW = F.G * NWAVES, lane = cur_lane();
    const bf16* QN = (const bf16*)(F.ws + WS_QN); bf16* Y = (bf16*)F.out + (size_t)M * D;
    const float* kcmp = (const float*)(F.ws + WS_KCMP); const float* vcmp = (const float*)(F.ws + WS_VCMP); const float* GWp = (const float*)(F.ws + WS_GW);
    LAS float* ps = (LAS float*)(F.lds + RING_OFF + wave * 16384);
    LAS float* ocs = ps + 256;
    LAS float* svl = ps + 512;
    LAS float* q = (LAS float*)(F.lds + RING_OFF + wave * 16384 + 4096);
    for (int i = gw; i < M; i += NGW) {
        int t, b; task_bt(i, t, b); const int row = b * T + t, own = t >> 6, base = b * T;
#pragma unroll
        for (int k = 0; k < 4; ++k) ps[lane + 64 * k] = 0.f;
#pragma unroll 1
        for (int h = 0; h < 4; ++h) {
            LDS_WAIT(); asm volatile("" ::: "memory");
            q[lane] = bf2f(QN[(size_t)row * 256 + h * 64 + lane]);
            LDS_WAIT(); asm volatile("" ::: "memory");
            KVf32 kc{kcmp + (size_t)b * 256 * 64, vcmp + (size_t)b * 256 * 64, 64, 64};
            float ml = -INFINITY;
#pragma unroll 1
            for (int k = 0; k < 4; ++k) { const int n = lane + 64 * k; const bool valid = (n < 255) && (16 * n + 31 <= t);
                float sv = -INFINITY; if (valid) sv = kc.dot<64>(n, q) * 0.125f; svl[n] = sv; ml = fmaxf(ml, sv); }
            const float Mx = wave_max(ml);
            float o[64];
#pragma unroll
            for (int d = 0; d < 64; ++d) o[d] = 0.f;
#ifndef NSA_NO_C
            if (Mx > -INFINITY) {
                float ls = 0.f;
#pragma unroll 1
                for (int k = 0; k < 4; ++k) { const float sv = svl[lane + 64 * k]; const float p = sv > -INFINITY ? __expf(sv - Mx) : 0.f; ls += p; svl[lane + 64 * k] = p; }
                const float inv = 1.0f / wave_sum(ls);
#pragma unroll 1
                for (int k = 0; k < 4; ++k) { const float p = svl[lane + 64 * k] * inv; ps[lane + 64 * k] += p; if (p > 0.f) kc.axpy(lane + 64 * k, p, o); }
            }
#endif
            ocs[h * 64 + lane] = reduce64(o, lane);
        }
        LDS_WAIT(); asm volatile("" ::: "memory");
        float imp = (ps[4 * lane] + ps[4 * lane + 1]) + (ps[4 * lane + 2] + ps[4 * lane + 3]); if (lane > 0) imp += ps[4 * lane - 1];
        LDS_WAIT(); asm volatile("" ::: "memory");
        const bool causal = lane <= own, forced = causal && (lane == 0 || lane >= own - 1);
        float val = forced ? 1e4f : (causal ? imp : -INFINITY);
        unsigned long long selmask = 0ull;
        for (int r = 0; r < 16; ++r) { const float mx = wave_max(val); if (!(mx > -INFINITY)) break;
            const unsigned long long ball = __ballot(val == mx); const int sl = __ffsll((long long)ball) - 1; selmask |= 1ull << sl; if (lane == sl) val = -INFINITY; }
#ifdef FLASH_NSA
        if (lane == 0) ((unsigned long long*)(F.ws + WS_NSEL))[row] = selmask;
#pragma unroll
        for (int h = 0; h < 4; ++h) ((bf16*)(F.ws + WS_OC))[(size_t)row * 256 + h * 64 + lane] = (bf16)f2bf(ocs[h * 64 + lane]);
        LDS_WAIT(); asm volatile("" ::: "memory");
        continue;
#endif
#pragma unroll 1
        for (int h = 0; h < 4; ++h) {
            LDS_WAIT(); asm volatile("" ::: "memory");
            q[lane] = bf2f(QN[(size_t)row * 256 + h * 64 + lane]);
            LDS_WAIT(); asm volatile("" ::: "memory");
            KVbf ks{(const bf16*)(F.ws + WS_KS), (const bf16*)(F.ws + WS_VS), 64, 64};
            auto keys = [&](int s) { const int p = 64 * s + lane; return (((selmask >> s) & 1ull) && p <= t) ? base + p : -1; };
#ifdef NSA_NO_S
            float os = q[3];
#else
            float os = wave_attend<64>(q, 0.125f, own + 1, keys, ks, lane);
            asm volatile("" : "+v"(os) :: "memory");
#endif
            KVbf kw{(const bf16*)(F.ws + WS_KW), (const bf16*)(F.ws + WS_VW), 64, 64};
            auto keyw = [&](int s) { const int p = t - 511 + lane + 64 * s; return p >= 0 ? base + p : -1; };
#ifdef NSA_NO_W
            float ow = q[5];
#else
            float ow = wave_attend<64>(q, 0.125f, 8, keyw, kw, lane);
            asm volatile("" : "+v"(ow) :: "memory");
#endif
            const float* gp = GWp + (size_t)row * 32 + h * 3;
            const float g0 = sigmoid_f(gp[0]), g1 = sigmoid_f(gp[1]), g2 = sigmoid_f(gp[2]);
            Y[(size_t)row * 1024 + 512 + h * 64 + lane] = (bf16)f2bf(g0 * ocs[h * 64 + lane] + g1 * os + g2 * ow);
        }
    }
}
__device__ __forceinline__ void dsa_tokens_phase(Frame& F) {
    const int wave = cur_wave(), gw = blockIdx.x * NWAVES + wave, NGW = F.G * NWAVES, lane = cur_lane();
    const float* IQ = (const float*)(F.ws + WS_IQ); const float* IK = (const float*)(F.ws + WS_IK); const float* GWp = (const float*)(F.ws + WS_GW);
    const bf16* QD = (const bf16*)(F.ws + WS_QD); bf16* Y = (bf16*)F.out + (size_t)M * D;
    LAS float* sc = (LAS float*)(F.lds + RING_OFF + wave * 16384);
    LAS unsigned* hist = (LAS unsigned*)(F.lds + XTRA_OFF + wave * XTRA_WAVE);
    LAS unsigned short* idx = (LAS unsigned short*)hist;
    LAS float* xq = (LAS float*)(F.lds + XTRA_OFF + wave * XTRA_WAVE + 1024);
    for (int i = gw; i < M; i += NGW) {
        int t, b; task_bt(i, t, b); const int row = b * T + t, base = b * T, n = t + 1;
#pragma unroll
        for (int k = 0; k < 4; ++k) xq[lane + 64 * k] = IQ[(size_t)row * 256 + lane + 64 * k];
        if (lane < 8) xq[256 + lane] = GWp[(size_t)row * 32 + 12 + lane];
        LDS_WAIT(); asm volatile("" ::: "memory");
        for (int k0 = 0; k0 < n; k0 += 64) {
            const int key = k0 + lane;
            if (key < n) {
                float ik[32];
                { const f32x4* kp = (const f32x4*)(IK + (size_t)(base + key) * 32);
#pragma unroll
                  for (int c = 0; c < 8; ++c) { const f32x4 f = kp[c]; ik[4 * c] = f.x; ik[4 * c + 1] = f.y; ik[4 * c + 2] = f.z; ik[4 * c + 3] = f.w; } }
                float score = 0.f;
#pragma unroll
                for (int h = 0; h < 8; ++h) { float ds = 0.f;
#pragma unroll
                    for (int c = 0; c < 8; ++c) { const f32x4 qv = *(const LAS f32x4*)(xq + h * 32 + 4 * c); ds += (qv.x * ik[4 * c] + qv.y * ik[4 * c + 1]) + (qv.z * ik[4 * c + 2] + qv.w * ik[4 * c + 3]); }
                    score += xq[256 + h] * fmaxf(ds, 0.f); }
                sc[key] = score * 0.0625f + 0.0f;
            }
        }
        LDS_WAIT(); asm volatile("" ::: "memory");
        int nsel = n;
        if (n > 256) {
            unsigned prefix = 0u, pmask = 0u; int kk = 256;
            for (int pass = 0; pass < 4; ++pass) {
                const int shift = 24 - 8 * pass;
#pragma unroll
                for (int k = 0; k < 4; ++k) hist[lane + 64 * k] = 0u;
                LDS_WAIT(); asm volatile("" ::: "memory");
                for (int k0 = 0; k0 < n; k0 += 64) { const int key = k0 + lane;
                    if (key < n) { const unsigned u = fkey(sc[key]); if ((u & pmask) == prefix) __hip_atomic_fetch_add(hist + ((u >> shift) & 255u), 1u, __ATOMIC_RELAXED, __HIP_MEMORY_SCOPE_WORKGROUP); } }
                LDS_WAIT(); asm volatile("" ::: "memory");
                const int h0 = (int)hist[4 * lane], h1 = (int)hist[4 * lane + 1], h2 = (int)hist[4 * lane + 2], h3 = (int)hist[4 * lane + 3];
                const int tot = (h0 + h1) + (h2 + h3); int incl = tot;
#pragma unroll
                for (int o = 1; o < 64; o <<= 1) { const int v = __shfl_down(incl, o); if (lane + o < 64) incl += v; }
                int run = incl - tot, found = -1, newk = 0;
                if (run < kk && run + h3 >= kk) { found = 4 * lane + 3; newk = kk - run; } run += h3;
                if (found < 0 && run < kk && run + h2 >= kk) { found = 4 * lane + 2; newk = kk - run; } run += h2;
                if (found < 0 && run < kk && run + h1 >= kk) { found = 4 * lane + 1; newk = kk - run; } run += h1;
                if (found < 0 && run < kk && run + h0 >= kk) { found = 4 * lane; newk = kk - run; }
                const unsigned long long ball = __ballot(found >= 0); const int src = __ffsll((long long)ball) - 1;
                const int bin = __shfl(found, src); kk = __shfl(newk, src);
                prefix |= (unsigned)bin << shift; pmask |= 255u << shift;
                LDS_WAIT(); asm volatile("" ::: "memory");
            }
            int eqseen = 0, cnt = 0;
            for (int k0 = 0; k0 < n; k0 += 64) { const int key = k0 + lane; const bool inb = key < n; const unsigned u = inb ? fkey(sc[key]) : 0u;
                const bool gt = inb && u > prefix, eq = inb && u == prefix;
                const unsigned long long be = __ballot(eq); const bool sel = gt || (eq && (eqseen + mbcnt64(be)) < kk);
                const unsigned long long bs = __ballot(sel); if (sel) idx[cnt + mbcnt64(bs)] = (unsigned short)key;
#ifdef FLASH_DSA
                if (lane == 0) ((unsigned long long*)(F.ws + WS_DSAMASK))[(size_t)row * 64 + (k0 >> 6)] = bs;
#endif
                eqseen += __popcll(be); cnt += __popcll(bs); }
            nsel = cnt;
            LDS_WAIT(); asm volatile("" ::: "memory");
        }
#ifdef FLASH_DSA
        if (n <= 256) { for (int k0 = 0; k0 < n; k0 += 64) if (lane == 0) ((unsigned long long*)(F.ws + WS_DSAMASK))[(size_t)row * 64 + (k0 >> 6)] = causal_word(t - k0); }
        continue;
#endif
        int kidx[4];
#pragma unroll
        for (int k = 0; k < 4; ++k) { const int p = lane + 64 * k; kidx[k] = p < nsel ? base + (n > 256 ? (int)idx[p] : p) : -1; }
        LDS_WAIT(); asm volatile("" ::: "memory");
#pragma unroll 1
        for (int h = 0; h < 4; ++h) {
            LDS_WAIT(); asm volatile("" ::: "memory");
            xq[lane] = bf2f(QD[(size_t)row * 256 + h * 64 + lane]);
            LDS_WAIT(); asm volatile("" ::: "memory");
            KVbf kd{(const bf16*)(F.ws + WS_KD), (const bf16*)(F.ws + WS_VD), 64, 64};
            auto keyf = [&](int s) { return s == 0 ? kidx[0] : s == 1 ? kidx[1] : s == 2 ? kidx[2] : kidx[3]; };
            const float r = wave_attend<64>(xq, 0.125f, 4, keyf, kd, lane);
            Y[(size_t)row * 1024 + 768 + h * 64 + lane] = (bf16)f2bf(r);
        }
        LDS_WAIT(); asm volatile("" ::: "memory");
    }
}
typedef float f32x16 __attribute__((ext_vector_type(16)));
__device__ __forceinline__ float xhalf_max(float v) { const auto rr = __builtin_amdgcn_permlane32_swap(__float_as_uint(v), __float_as_uint(v), false, false); return fmaxf(__uint_as_float(rr[0]), __uint_as_float(rr[1])); }
__device__ __forceinline__ float xhalf_sum(float v) { const auto rr = __builtin_amdgcn_permlane32_swap(__float_as_uint(v), __float_as_uint(v), false, false); return __uint_as_float(rr[0]) + __uint_as_float(rr[1]); }
__device__ __forceinline__ float xhalf_other(float v, int hh) { const auto rr = __builtin_amdgcn_permlane32_swap(__float_as_uint(v), __float_as_uint(v), false, false); return __uint_as_float(hh ? rr[0] : rr[1]); }
constexpr int FL_KP96 = 208, FL_KP64 = 144, FL_VP = 144;
constexpr int FL_KBUF = 0, FL_KBUF_SZ = 64 * FL_KP96, FL_VBUF = 2 * FL_KBUF_SZ, FL_VBUF_SZ = 64 * FL_VP;
constexpr int FL_TL = FL_VBUF + 2 * FL_VBUF_SZ, FL_TLN = FL_TL + 64, FL_ORM = FL_TLN + 8, FL_SEL = FL_TL + 128;
constexpr int FL_END = FL_SEL + 512;
static_assert(FL_END <= RING_BYTES, "flash LDS map");
struct FlashKV { const bf16* K; const bf16* V; int kp, vp; };


template <int MODE>
__device__ __forceinline__ void fl_softmax(f32x16& p0, f32x16& p1, const unsigned long long word, const int h, const float sc2, float& m, float& lsum, f32x16& o0, f32x16& o1) {
    if (MODE == 2) {
        const unsigned wlo = (unsigned)word >> (4 * h), whi = (unsigned)(word >> 32) >> (4 * h);
#pragma unroll
        for (int i = 0; i < 16; ++i) { const int bit = (i & 3) + 8 * (i >> 2);
            p0[i] = (wlo & (1u << bit)) ? p0[i] : -INFINITY; p1[i] = (whi & (1u << bit)) ? p1[i] : -INFINITY; }
    }
    float mx, mx2;
    asm("v_max3_f32 %0, %1, %2, %3" : "=v"(mx) : "v"(p0[0]), "v"(p0[1]), "v"(p0[2]));
    asm("v_max3_f32 %0, %1, %2, %3" : "=v"(mx2) : "v"(p1[0]), "v"(p1[1]), "v"(p1[2]));
#pragma unroll
    for (int i = 3; i < 15; i += 2) { asm("v_max3_f32 %0, %1, %2, %3" : "=v"(mx) : "v"(mx), "v"(p0[i]), "v"(p0[i + 1])); asm("v_max3_f32 %0, %1, %2, %3" : "=v"(mx2) : "v"(mx2), "v"(p1[i]), "v"(p1[i + 1])); }
    asm("v_max3_f32 %0, %1, %2, %3" : "=v"(mx) : "v"(mx), "v"(p0[15]), "v"(p1[15]));
    asm("v_max_f32_e32 %0, %1, %2" : "=v"(mx) : "v"(mx), "v"(mx2));
    const bool rowon = (MODE != 1) || (word != 0ull);
    if (MODE == 1) mx = rowon ? mx : -INFINITY;
    mx = xhalf_max(mx);
    const float mn = fmaxf(m, mx * sc2);
    if (__any(mn > m)) { const float alpha = __builtin_amdgcn_exp2f(m - mn); lsum *= alpha;
#pragma unroll
        for (int i = 0; i < 16; ++i) { o0[i] *= alpha; o1[i] *= alpha; } }
    m = mn;
    const float nm = rowon ? -mn : -INFINITY;
    float ps = 0.f;
#pragma unroll
    for (int i = 0; i < 16; ++i) { p0[i] = __builtin_amdgcn_exp2f(__builtin_fmaf(p0[i], sc2, nm)); p1[i] = __builtin_amdgcn_exp2f(__builtin_fmaf(p1[i], sc2, nm)); ps += p0[i] + p1[i]; }
    lsum += ps;
}
template <int DQK, class MaskFn>
__device__ __forceinline__ void flash_unit(LAS unsigned char* lds, const FlashKV kv, const bf16* qrow, const float sc2  , const int ntiles,
                                           const MaskFn& maskf, f32x16& o0, f32x16& o1, float& lsum) {
    constexpr int KP = (DQK == 96) ? FL_KP96 : FL_KP64, NKS = DQK / 16, CPR = DQK / 8;
    const int tid = cur_tid(), lane = tid & 63, r = lane & 31, h = lane >> 5;
    const LAS unsigned char* tl = lds + FL_TL;
    bf16x8 qf[NKS];
#pragma unroll
    for (int ks = 0; ks < NKS; ++ks) qf[ks] = *(const GAS bf16x8*)(qrow + 16 * ks + 8 * h);
    const int kr0 = tid / CPR, kc0 = tid - kr0 * CPR;
    const int kr1 = (tid + 512) / CPR, kc1 = (tid + 512) - kr1 * CPR;
    const bool has2 = (DQK == 96) && (tid < 256);
    const int vr = tid >> 3, vc = tid & 7;
    struct StageRegs { v4u k0, k1, v; };
    StageRegs S0, S1; S0.k1 = (v4u){0u, 0u, 0u, 0u}; S1.k1 = (v4u){0u, 0u, 0u, 0u};
    auto gload = [&](StageRegs& S, int tile) {
        const size_t rowb = (size_t)tile * 64;
        S.k0 = *(const GAS v4u*)(kv.K + (rowb + kr0) * kv.kp + 8 * kc0);
        if (DQK == 96) S.k1 = *(const GAS v4u*)(kv.K + (rowb + (has2 ? kr1 : kr0)) * kv.kp + 8 * (has2 ? kc1 : kc0));
        S.v = *(const GAS v4u*)(kv.V + (rowb + vr) * kv.vp + 8 * vc);
    };
    auto lstore = [&](const StageRegs& S, int buf) {
        LAS unsigned char* Kb = lds + FL_KBUF + buf * FL_KBUF_SZ; LAS unsigned char* Vb = lds + FL_VBUF + buf * FL_VBUF_SZ;
        *(LAS v4u*)(Kb + kr0 * KP + 16 * kc0) = S.k0;
        if (has2) *(LAS v4u*)(Kb + kr1 * KP + 16 * kc1) = S.k1;
        *(LAS v4u*)(Vb + vr * FL_VP + 16 * vc) = S.v;
    };
    float m = -1e30f; lsum = 0.f;
    __syncthreads();
#pragma unroll
    for (int i = 0; i < 16; ++i) { o0[i] = 0.f; o1[i] = 0.f; }
    unsigned long long wnext = 0ull;
    if (ntiles > 0) { wnext = maskf((int)tl[0]); gload(S0, (int)tl[0]); lstore(S0, 0); }
    if (ntiles > 0) gload(S1, (int)tl[ntiles > 1 ? 1 : 0]);
#pragma unroll
    for (int ks = 0; ks < NKS; ++ks) asm volatile("" :: "v"(qf[ks]));
    __syncthreads();
    auto step = [&](const int it, StageRegs& Sload, const StageRegs& Sstore) __attribute__((always_inline)) {
        const int cur = it & 1;
        const unsigned long long word = wnext;
        wnext = maskf((int)tl[it + 1 < ntiles ? it + 1 : ntiles - 1]);
        gload(Sload, (int)tl[it + 2 < ntiles ? it + 2 : ntiles - 1]);
        if (!__all(word == 0ull)) {
            const LAS unsigned char* Kb = lds + FL_KBUF + cur * FL_KBUF_SZ; const LAS unsigned char* Vb = lds + FL_VBUF + cur * FL_VBUF_SZ;
            f32x16 p0, p1;
#pragma unroll
            for (int i = 0; i < 16; ++i) { p0[i] = 0.f; p1[i] = 0.f; }
#pragma unroll
            for (int ks = 0; ks < NKS; ++ks) {
                const bf16x8 a0 = *(const LAS bf16x8*)(Kb + r * KP + (16 * ks + 8 * h) * 2), a1 = *(const LAS bf16x8*)(Kb + (32 + r) * KP + (16 * ks + 8 * h) * 2);
                p0 = __builtin_amdgcn_mfma_f32_32x32x16_bf16(a0, qf[ks], p0, 0, 0, 0);
                p1 = __builtin_amdgcn_mfma_f32_32x32x16_bf16(a1, qf[ks], p1, 0, 0, 0);
            }
            if (__all(word == ~0ull)) fl_softmax<0>(p0, p1, word, h, sc2, m, lsum, o0, o1);
            else if (__all(word == ~0ull || word == 0ull)) fl_softmax<1>(p0, p1, word, h, sc2, m, lsum, o0, o1);
            else fl_softmax<2>(p0, p1, word, h, sc2, m, lsum, o0, o1);
            bf16x8 pf[4];
#pragma unroll
            for (int s = 0; s < 4; ++s) { v4u w;
                if (s < 2) { w.x = pg8::cvt_pk_bf16(p0[8 * s], p0[8 * s + 1]); w.y = pg8::cvt_pk_bf16(p0[8 * s + 2], p0[8 * s + 3]); w.z = pg8::cvt_pk_bf16(p0[8 * s + 4], p0[8 * s + 5]); w.w = pg8::cvt_pk_bf16(p0[8 * s + 6], p0[8 * s + 7]); }
                else { const int s2 = s - 2; w.x = pg8::cvt_pk_bf16(p1[8 * s2], p1[8 * s2 + 1]); w.y = pg8::cvt_pk_bf16(p1[8 * s2 + 2], p1[8 * s2 + 3]); w.z = pg8::cvt_pk_bf16(p1[8 * s2 + 4], p1[8 * s2 + 5]); w.w = pg8::cvt_pk_bf16(p1[8 * s2 + 6], p1[8 * s2 + 7]); }
                pf[s] = __builtin_bit_cast(bf16x8, w); }
            {
                typedef short v4i16_t __attribute__((ext_vector_type(4)));
                const LAS unsigned char* vbase = Vb + (4 * h + ((lane & 15) >> 2)) * FL_VP + (16 * ((lane >> 4) & 1) + 4 * (lane & 3)) * 2;
#pragma unroll
                for (int s = 0; s < 4; ++s) {
#pragma unroll
                    for (int db = 0; db < 2; ++db) {
                        const LAS unsigned char* vp_ = vbase + (32 * (s >> 1) + 16 * (s & 1)) * FL_VP + 64 * db;
                        const v4i16_t lo = __builtin_amdgcn_ds_read_tr16_b64_v4i16((LAS v4i16_t*)vp_), hi = __builtin_amdgcn_ds_read_tr16_b64_v4i16((LAS v4i16_t*)(vp_ + 8 * FL_VP));
                        const bf16x8 a = {lo[0], lo[1], lo[2], lo[3], hi[0], hi[1], hi[2], hi[3]};
                        if (db == 0) o0 = __builtin_amdgcn_mfma_f32_32x32x16_bf16(a, pf[s], o0, 0, 0, 0);
                        else o1 = __builtin_amdgcn_mfma_f32_32x32x16_bf16(a, pf[s], o1, 0, 0, 0);
                    }
                }
            }
        }
        if (it + 1 < ntiles) lstore(Sstore, cur ^ 1);
        __syncthreads();
    };
    for (int it = 0; it < ntiles; it += 2) { step(it, S0, S1); if (it + 1 < ntiles) step(it + 1, S1, S0); }
}
__device__ __forceinline__ void flash_store(bf16* yrow  , const f32x16& o0, const f32x16& o1, float inv, int h) {
#pragma unroll
    for (int g = 0; g < 4; ++g) {
        typedef unsigned u32x2v __attribute__((ext_vector_type(2)));
        u32x2v w0, w1;
        w0.x = pg8::cvt_pk_bf16(o0[4 * g] * inv, o0[4 * g + 1] * inv); w0.y = pg8::cvt_pk_bf16(o0[4 * g + 2] * inv, o0[4 * g + 3] * inv);
        w1.x = pg8::cvt_pk_bf16(o1[4 * g] * inv, o1[4 * g + 1] * inv); w1.y = pg8::cvt_pk_bf16(o1[4 * g + 2] * inv, o1[4 * g + 3] * inv);
        *(u32x2v*)(yrow + 8 * g + 4 * h) = w0; *(u32x2v*)(yrow + 32 + 8 * g + 4 * h) = w1;
    }
}

__device__ __forceinline__ void mla_flash_phase(Frame& F) {
    const int tid = cur_tid(), wave = cur_wave(), lane = tid & 63, r = lane & 31, h2 = lane >> 5;
    bf16* Y = (bf16*)F.out + (size_t)M * D;
    for (int pass = 0; pass < 2; ++pass) {
        for (int u0 = blockIdx.x; u0 < 256; u0 += F.G) {
            const int u = pass ? 511 - u0 : u0, qb = u >> 5, bh = u & 31, b = bh >> 2, hd = bh & 3;
            const int t = 256 * qb + 32 * wave + r; const size_t row = (size_t)b * T + t;
            LAS unsigned char* tl = F.lds + FL_TL;
            if (tid < 64) tl[tid] = (unsigned char)tid;
            const int ntiles = 4 * qb + 4;
            FlashKV kv{(const bf16*)(F.ws + WS_KMLA) + (size_t)b * T * 384 + hd * 96, (const bf16*)(F.ws + WS_VMLA) + (size_t)b * T * 256 + hd * 64, 384, 256};
            auto maskf = [&](int tile) { return causal_word(t - 64 * tile); };
            f32x16 o0, o1; float ls;
            flash_unit<96>(F.lds, kv, (const bf16*)(F.ws + WS_QMLA) + row * 384 + hd * 96, 0.10206207261596577f * 1.4426950408889634f, ntiles, maskf, o0, o1, ls);
            ls = xhalf_sum(ls);
            flash_store(Y + row * 1024 + 256 + hd * 64, o0, o1, ls > 0.f ? 1.0f / ls : 0.f, h2);
        }
    }
}

__device__ __forceinline__ void moba_flash_phase(Frame& F) {
    const int tid = cur_tid(), wave = cur_wave(), lane = tid & 63, r = lane & 31, h2 = lane >> 5;
    bf16* Y = (bf16*)F.out + (size_t)M * D;
    const float* QF = (const float*)(F.ws + WS_QM_F); const float* kmean = (const float*)(F.ws + WS_KMEAN);
    LAS unsigned short* msel = (LAS unsigned short*)(F.lds + FL_SEL); LAS unsigned* orm = (LAS unsigned*)(F.lds + FL_ORM); LAS unsigned char* tl = F.lds + FL_TL; LAS int* tln = (LAS int*)(F.lds + FL_TLN);
    for (int pass = 0; pass < 2; ++pass) {
        for (int u0 = blockIdx.x; u0 < 256; u0 += F.G) {
            const int u = pass ? 511 - u0 : u0, own = u >> 5, bh = u & 31, b = bh >> 2, hd = bh & 3;
            if (tid == 0) orm[0] = 0u;
            __syncthreads();
            if (tid < 256) {
                const float* qp = QF + ((size_t)b * T + 256 * own + tid) * 256 + hd * 64;
                const float* km = kmean + (size_t)((b * 4 + hd) * 16) * 64;
                f32x4 qv[16];
#pragma unroll
                for (int c = 0; c < 16; ++c) qv[c] = *(const f32x4*)(qp + 4 * c);
                float g[15];
#pragma unroll
                for (int j = 0; j < 15; ++j) { g[j] = 0.f;
                    if (j < own) { float a = 0.f;
#pragma unroll
                        for (int c = 0; c < 16; ++c) { const f32x4 kv4 = *(const f32x4*)(km + j * 64 + 4 * c); a += (qv[c].x * kv4.x + qv[c].y * kv4.y) + (qv[c].z * kv4.z + qv[c].w * kv4.w); }
                        g[j] = a; } }
                unsigned sel = 0u;
#pragma unroll
                for (int rr = 0; rr < 3; ++rr) { float best = -INFINITY; int bi = -1;
#pragma unroll
                    for (int j = 0; j < 15; ++j) if (j < own && !((sel >> j) & 1u) && g[j] > best) { best = g[j]; bi = j; }
                    if (bi >= 0) sel |= 1u << bi; }
                msel[tid] = (unsigned short)sel;
                __hip_atomic_fetch_or(orm, sel, __ATOMIC_RELAXED, __HIP_MEMORY_SCOPE_WORKGROUP);
            }
            __syncthreads();
            if (tid == 0) { const unsigned om = orm[0]; int n = 0;
                for (int j = 0; j < own; ++j) if ((om >> j) & 1u) { for (int q4 = 0; q4 < 4; ++q4) tl[n++] = (unsigned char)(4 * j + q4); }
                for (int q4 = 0; q4 < 4; ++q4) tl[n++] = (unsigned char)(4 * own + q4);
                tln[0] = n; }
            __syncthreads();
            const int ntiles = tln[0];
            const int tq = 32 * wave + r, t = 256 * own + tq; const size_t row = (size_t)b * T + t;
            const unsigned mysel = msel[tq];
            FlashKV kv{(const bf16*)(F.ws + WS_KM_BF) + (size_t)b * T * 256 + hd * 64, (const bf16*)(F.ws + WS_VM_BF) + (size_t)b * T * 256 + hd * 64, 256, 256};
            auto maskf = [&](int tile) { const int blk = tile >> 2; return blk == own ? causal_word(t - 64 * tile) : (((mysel >> blk) & 1u) ? ~0ull : 0ull); };
            f32x16 o0, o1; float ls;
            flash_unit<64>(F.lds, kv, (const bf16*)(F.ws + WS_QM_BF) + row * 256 + hd * 64, 0.125f * 1.4426950408889634f, ntiles, maskf, o0, o1, ls);
            ls = xhalf_sum(ls);
            flash_store(Y + row * 1024 + hd * 64, o0, o1, ls > 0.f ? 1.0f / ls : 0.f, h2);
        }
    }
}
__device__ __forceinline__ void dsa_flash_phase(Frame& F) {
    const int tid = cur_tid(), wave = cur_wave(), lane = tid & 63, r = lane & 31, h2 = lane >> 5;
    bf16* Y = (bf16*)F.out + (size_t)M * D;
    const unsigned long long* BM = (const unsigned long long*)(F.ws + WS_DSAMASK);
    for (int pass = 0; pass < 2; ++pass) {
        for (int u0 = blockIdx.x; u0 < 256; u0 += F.G) {
            const int u = pass ? 511 - u0 : u0, tb = u >> 3, b = u & 7, hd = wave >> 1;
            const int t = 64 * tb + 32 * (wave & 1) + r; const size_t row = (size_t)b * T + t;
            LAS unsigned char* tl = F.lds + FL_TL;
            __syncthreads();
            if (tid < 64) tl[tid] = (unsigned char)tid;
            const int ntiles = tb + 1;
            FlashKV kv{(const bf16*)(F.ws + WS_KD) + (size_t)b * T * 64, (const bf16*)(F.ws + WS_VD) + (size_t)b * T * 64, 64, 64};
            const unsigned long long* bmrow = BM + row * 64;
            auto maskf = [&](int tile) { return bmrow[tile]; };
            f32x16 o0, o1; float ls;
            flash_unit<64>(F.lds, kv, (const bf16*)(F.ws + WS_QD) + row * 256 + hd * 64, 0.125f * 1.4426950408889634f, ntiles, maskf, o0, o1, ls);
            ls = xhalf_sum(ls);
            flash_store(Y + row * 1024 + 768 + hd * 64, o0, o1, ls > 0.f ? 1.0f / ls : 0.f, h2);
        }
    }
}
__device__ __forceinline__ void nsa_flash_phase(Frame& F) {
    const int tid = cur_tid(), wave = cur_wave(), lane = tid & 63, r = lane & 31, h2 = lane >> 5;
    bf16* Y = (bf16*)F.out + (size_t)M * D;
    const unsigned long long* NSEL = (const unsigned long long*)(F.ws + WS_NSEL); const bf16* OC = (const bf16*)(F.ws + WS_OC); const float* GWp = (const float*)(F.ws + WS_GW);
    LAS unsigned* orm = (LAS unsigned*)(F.lds + FL_ORM); LAS unsigned char* tl = F.lds + FL_TL; LAS int* tln = (LAS int*)(F.lds + FL_TLN);
    for (int pass = 0; pass < 2; ++pass) {
        for (int u0 = blockIdx.x; u0 < 256; u0 += F.G) {
            const int u = pass ? 511 - u0 : u0, tb = u >> 3, b = u & 7, hd = wave >> 1;
            const int t = 64 * tb + 32 * (wave & 1) + r; const size_t row = (size_t)b * T + t;
            const unsigned long long mysel = NSEL[row];
            __syncthreads();
            if (tid < 2) orm[tid] = 0u;
            __syncthreads();
            if (wave < 2) { __hip_atomic_fetch_or(orm, (unsigned)mysel, __ATOMIC_RELAXED, __HIP_MEMORY_SCOPE_WORKGROUP); __hip_atomic_fetch_or(orm + 1, (unsigned)(mysel >> 32), __ATOMIC_RELAXED, __HIP_MEMORY_SCOPE_WORKGROUP); }
            __syncthreads();
            if (tid == 0) { const unsigned long long om = (unsigned long long)orm[0] | ((unsigned long long)orm[1] << 32); int n = 0;
                for (int j = 0; j <= tb; ++j) if ((om >> j) & 1ull) tl[n++] = (unsigned char)j;
                tln[0] = n; }
            __syncthreads();
            const int nsel_tiles = tln[0];
            const bf16* qrow = (const bf16*)(F.ws + WS_QN) + row * 256 + hd * 64;
            const float* gp = GWp + row * 32 + hd * 3;
            const float g0 = sigmoid_f(gp[0]), g1 = sigmoid_f(gp[1]), g2 = sigmoid_f(gp[2]);
            LAS float* stash = (LAS float*)(F.lds + 49152) + wave * 2048 + lane;
            {
                FlashKV kv{(const bf16*)(F.ws + WS_KS) + (size_t)b * T * 64, (const bf16*)(F.ws + WS_VS) + (size_t)b * T * 64, 64, 64};
                auto maskf = [&](int tile) { return ((mysel >> tile) & 1ull) ? causal_word(t - 64 * tile) : 0ull; };
                f32x16 o0, o1; float ls;
                flash_unit<64>(F.lds, kv, qrow, 0.125f * 1.4426950408889634f, nsel_tiles, maskf, o0, o1, ls);
                ls = xhalf_sum(ls); const float sc = ls > 0.f ? g1 / ls : 0.f;
                const bf16* ocr = OC + row * 256 + hd * 64;
#pragma unroll
                for (int g = 0; g < 4; ++g) { const unsigned long long w0 = *(const unsigned long long*)(ocr + 8 * g + 4 * h2), w1 = *(const unsigned long long*)(ocr + 32 + 8 * g + 4 * h2);
                    stash[(4 * g) * 64] = sc * o0[4 * g] + g0 * __uint_as_float((unsigned)w0 << 16); stash[(4 * g + 1) * 64] = sc * o0[4 * g + 1] + g0 * __uint_as_float((unsigned)w0 & 0xffff0000u);
                    stash[(4 * g + 2) * 64] = sc * o0[4 * g + 2] + g0 * __uint_as_float((unsigned)(w0 >> 32) << 16); stash[(4 * g + 3) * 64] = sc * o0[4 * g + 3] + g0 * __uint_as_float((unsigned)(w0 >> 32) & 0xffff0000u);
                    stash[(16 + 4 * g) * 64] = sc * o1[4 * g] + g0 * __uint_as_float((unsigned)w1 << 16); stash[(16 + 4 * g + 1) * 64] = sc * o1[4 * g + 1] + g0 * __uint_as_float((unsigned)w1 & 0xffff0000u);
                    stash[(16 + 4 * g + 2) * 64] = sc * o1[4 * g + 2] + g0 * __uint_as_float((unsigned)(w1 >> 32) << 16); stash[(16 + 4 * g + 3) * 64] = sc * o1[4 * g + 3] + g0 * __uint_as_float((unsigned)(w1 >> 32) & 0xffff0000u); }
            }
            f32x16 a0, a1;
            {
                __syncthreads();
                const int t0 = tb >= 8 ? tb - 8 : 0;
                if (tid < 64) tl[tid] = (unsigned char)(t0 + tid);
                FlashKV kv{(const bf16*)(F.ws + WS_KW) + (size_t)b * T * 64, (const bf16*)(F.ws + WS_VW) + (size_t)b * T * 64, 64, 64};
                auto maskf = [&](int tile) { return causal_word(t - 64 * tile) & ~causal_word(t - 512 - 64 * tile); };
                f32x16 o0, o1; float ls;
                flash_unit<64>(F.lds, kv, qrow, 0.125f * 1.4426950408889634f, tb - t0 + 1, maskf, o0, o1, ls);
                ls = xhalf_sum(ls); const float sc = ls > 0.f ? g2 / ls : 0.f;
#pragma unroll
                for (int i = 0; i < 16; ++i) { a0[i] = sc * o0[i] + stash[i * 64]; a1[i] = sc * o1[i] + stash[(16 + i) * 64]; }
            }
            flash_store(Y + row * 1024 + 512 + hd * 64, a0, a1, 1.0f, h2);
        }
    }
}

__device__ __forceinline__ int hist_pick(LAS unsigned* hist, int& kk, const int lane) {
    const int h0 = (int)hist[4 * lane], h1 = (int)hist[4 * lane + 1], h2 = (int)hist[4 * lane + 2], h3 = (int)hist[4 * lane + 3];
    const int tot = (h0 + h1) + (h2 + h3); int incl = tot;
#pragma unroll
    for (int o = 1; o < 64; o <<= 1) { const int v = __shfl_down(incl, o); if (lane + o < 64) incl += v; }
    int run = incl - tot, found = -1, newk = 0;
    if (run < kk && run + h3 >= kk) { found = 4 * lane + 3; newk = kk - run; } run += h3;
    if (found < 0 && run < kk && run + h2 >= kk) { found = 4 * lane + 2; newk = kk - run; } run += h2;
    if (found < 0 && run < kk && run + h1 >= kk) { found = 4 * lane + 1; newk = kk - run; } run += h1;
    if (found < 0 && run < kk && run + h0 >= kk) { found = 4 * lane; newk = kk - run; }
    const unsigned long long ball = __ballot(found >= 0); const int src = __ffsll((long long)ball) - 1;
    const int bin = __shfl(found, src); kk = __shfl(newk, src);
    return bin;
}
__device__ __forceinline__ float unfkey(unsigned u) { return __uint_as_float((u & 0x80000000u) ? (u ^ 0x80000000u) : ~u); }
__device__ __forceinline__ void radix_select_write(LAS float* sc, LAS unsigned* hist, unsigned long long* bmrow, const int t, const int lane) {
    const int n = t + 1;
    if (n <= 256) { for (int k0 = 0; k0 < n; k0 += 64) if (lane == 0) bmrow[k0 >> 6] = causal_word(t - k0); return; }
#define RS_LOAD4(k0) float x_[4]; { _Pragma("unroll") for (int j_ = 0; j_ < 4; ++j_) { const float v_ = sc[(k0) + 64 * j_ + lane]; x_[j_] = (lane < n - (k0) - 64 * j_) ? v_ : -INFINITY; } }
    float mn = INFINITY, mx = -INFINITY;
    for (int k0 = 0; k0 < n; k0 += 256) { RS_LOAD4(k0);
#pragma unroll
        for (int j = 0; j < 4; ++j) { mx = fmaxf(mx, x_[j]); mn = fminf(mn, x_[j] > -INFINITY ? x_[j] : INFINITY); } }
    mn = -wave_max(-mn); mx = wave_max(mx);
    const float qs = mx > mn ? 255.99f / (mx - mn) : 1.0f, qo = -mn * qs;
#pragma unroll
    for (int k = 0; k < 4; ++k) hist[lane + 64 * k] = 0u;
    LDS_WAIT(); asm volatile("" ::: "memory");
#ifdef SEL_DUP_HIST
    for (int rep3_ = 0; rep3_ < 2; ++rep3_) {
#pragma unroll
    for (int k = 0; k < 4; ++k) hist[lane + 64 * k] = 0u;
    LDS_WAIT(); asm volatile("" ::: "memory");
#endif
    for (int k0 = 0; k0 < n; k0 += 256) { RS_LOAD4(k0);
#pragma unroll
        for (int j = 0; j < 4; ++j) { int q = (int)__builtin_fmaf(x_[j], qs, qo); q = q > 255 ? 255 : (q < 0 ? 0 : q); __hip_atomic_fetch_add(hist + q, 1u, __ATOMIC_RELAXED, __HIP_MEMORY_SCOPE_WORKGROUP); } }
    LDS_WAIT(); asm volatile("" ::: "memory");
#ifdef SEL_DUP_HIST
    }
#endif
    int kk = 256;
    const int B = hist_pick(hist, kk, lane);
    const int cntB = (int)hist[B];
    LDS_WAIT(); asm volatile("" ::: "memory");
#ifdef FORCE_FALLBACK
    if (cntB > 0) {
#else
    if (cntB > 128) {
#endif
        unsigned prefix = 0u, pmask = 0u;
#pragma unroll 1
        for (int pass = 0; pass < 4; ++pass) {
            const int shift = 24 - 8 * pass;
#pragma unroll
            for (int k = 0; k < 4; ++k) hist[lane + 64 * k] = 0u;
            LDS_WAIT(); asm volatile("" ::: "memory");
            for (int k0 = 0; k0 < n; k0 += 256) { RS_LOAD4(k0);
#pragma unroll
                for (int j = 0; j < 4; ++j) { int q = (int)__builtin_fmaf(x_[j], qs, qo); q = q > 255 ? 255 : (q < 0 ? 0 : q);
                    if (q == B) { const unsigned u = fkey(x_[j]); if ((u & pmask) == prefix) __hip_atomic_fetch_add(hist + ((u >> shift) & 255u), 1u, __ATOMIC_RELAXED, __HIP_MEMORY_SCOPE_WORKGROUP); } } }
            LDS_WAIT(); asm volatile("" ::: "memory");
            const int bin = hist_pick(hist, kk, lane);
            prefix |= (unsigned)bin << shift; pmask |= 255u << shift;
            LDS_WAIT(); asm volatile("" ::: "memory");
        }
        int eqseen = 0;
        for (int k0 = 0; k0 < n; k0 += 256) { RS_LOAD4(k0);
#pragma unroll
            for (int j = 0; j < 4; ++j) { int q = (int)__builtin_fmaf(x_[j], qs, qo); q = q > 255 ? 255 : (q < 0 ? 0 : q);
                const unsigned u = fkey(x_[j]); const bool valid = x_[j] > -INFINITY;
                const bool gt = valid && (q > B || (q == B && u > prefix)), eq = valid && q == B && u == prefix;
                const unsigned long long be = __ballot(eq); const bool sel = gt || (eq && (eqseen + mbcnt64(be)) < kk);
                const unsigned long long bs = __ballot(sel);
                if (lane == 0 && k0 + 64 * j < n) bmrow[(k0 >> 6) + j] = bs;
                eqseen += __popcll(be); } }
        return;
    }
    LAS unsigned* bmw = hist + 256;
    LAS unsigned* cand = (LAS unsigned*)sc;
    int ncand = 0;
    for (int k0 = 0; k0 < n; k0 += 256) { RS_LOAD4(k0);
        asm volatile("" ::: "memory");
#pragma unroll
        for (int j = 0; j < 4; ++j) { int q = (int)__builtin_fmaf(x_[j], qs, qo); q = q > 255 ? 255 : (q < 0 ? 0 : q);
            const bool valid = x_[j] > -INFINITY; const bool gt = valid && q > B, inb = valid && q == B;
            const unsigned long long bg = __ballot(gt), bi = __ballot(inb);
            if (lane == 0) { bmw[2 * ((k0 >> 6) + j)] = (unsigned)bg; bmw[2 * ((k0 >> 6) + j) + 1] = (unsigned)(bg >> 32); }
            if (inb) { const int c = ncand + mbcnt64(bi); cand[2 * c] = (unsigned)(k0 + 64 * j + lane); cand[2 * c + 1] = fkey(x_[j]); }
            ncand += __popcll(bi); }
        LDS_WAIT(); asm volatile("" ::: "memory"); }
#undef RS_LOAD4
    {
        const int c0 = lane, c1 = lane + 64;
        const unsigned k0_ = c0 < ncand ? cand[2 * c0 + 1] : 0u, k1_ = c1 < ncand ? cand[2 * c1 + 1] : 0u;
        const unsigned i0_ = c0 < ncand ? cand[2 * c0] : 0u, i1_ = c1 < ncand ? cand[2 * c1] : 0u;
        int r0 = 0, r1 = 0;
#ifdef SEL_DUP_RANK
        for (int rep3_ = 0; rep3_ < 2; ++rep3_) { r0 = 0; r1 = 0;
#endif
        for (int j = 0; j < ncand; ++j) { const unsigned kj = cand[2 * j + 1];
            r0 += (kj > k0_ || (kj == k0_ && j < c0)) ? 1 : 0; r1 += (kj > k1_ || (kj == k1_ && j < c1)) ? 1 : 0; }
#ifdef SEL_DUP_RANK
        asm volatile("" : "+v"(r0), "+v"(r1)); }
#endif
        if (c0 < ncand && r0 < kk) __hip_atomic_fetch_or(bmw + 2 * (i0_ >> 6) + ((i0_ >> 5) & 1u), 1u << (i0_ & 31u), __ATOMIC_RELAXED, __HIP_MEMORY_SCOPE_WORKGROUP);
        if (c1 < ncand && r1 < kk) __hip_atomic_fetch_or(bmw + 2 * (i1_ >> 6) + ((i1_ >> 5) & 1u), 1u << (i1_ & 31u), __ATOMIC_RELAXED, __HIP_MEMORY_SCOPE_WORKGROUP);
    }
    LDS_WAIT(); asm volatile("" ::: "memory");
    if (lane < ((n + 63) >> 6)) bmrow[lane] = (unsigned long long)bmw[2 * lane] | ((unsigned long long)bmw[2 * lane + 1] << 32);
    LDS_WAIT(); asm volatile("" ::: "memory");
}
__device__ __forceinline__ void split8(const f32x4 a, const f32x4 b, bf16x8& hi, bf16x8& lo) {
    v4u h, l;
    h.x = pg8::cvt_pk_bf16(a.x, a.y); h.y = pg8::cvt_pk_bf16(a.z, a.w); h.z = pg8::cvt_pk_bf16(b.x, b.y); h.w = pg8::cvt_pk_bf16(b.z, b.w);
    l.x = pg8::cvt_pk_bf16(a.x - __uint_as_float(h.x << 16), a.y - __uint_as_float(h.x & 0xffff0000u)); l.y = pg8::cvt_pk_bf16(a.z - __uint_as_float(h.y << 16), a.w - __uint_as_float(h.y & 0xffff0000u));
    l.z = pg8::cvt_pk_bf16(b.x - __uint_as_float(h.z << 16), b.y - __uint_as_float(h.z & 0xffff0000u)); l.w = pg8::cvt_pk_bf16(b.z - __uint_as_float(h.w << 16), b.w - __uint_as_float(h.w & 0xffff0000u));
    hi = __builtin_bit_cast(bf16x8, h); lo = __builtin_bit_cast(bf16x8, l);
}
__device__ __forceinline__ void dsa_select_phase(Frame& F) {
    const int tid = cur_tid(), wave = cur_wave(), lane = tid & 63, r = lane & 31, hh = lane >> 5;
    const float* IQ = (const float*)(F.ws + WS_IQ); const float* IK = (const float*)(F.ws + WS_IK); const float* GWp = (const float*)(F.ws + WS_GW);
    LAS float* sc = (LAS float*)(F.lds + RING_OFF);
    LAS unsigned* hist = (LAS unsigned*)(F.lds + XTRA_OFF + wave * XTRA_WAVE);
    f32x4 araw[2][2][2], wraw[2][4];
    auto load_a = [&](int pass_, int u0_) {
        const int b_ = u0_ >> 8, w8_ = u0_ & 255, tb8_ = pass_ ? 511 - w8_ : w8_; const size_t rowb = (size_t)b_ * T + 8 * tb8_;
#pragma unroll
        for (int gq = 0; gq < 2; ++gq) {
            const float* qp = IQ + (rowb + 4 * gq + (r >> 3)) * 256 + (r & 7) * 32 + 8 * hh;
#pragma unroll
            for (int ks = 0; ks < 2; ++ks) { araw[gq][ks][0] = *(const f32x4*)(qp + 16 * ks); araw[gq][ks][1] = *(const f32x4*)(qp + 16 * ks + 4); }
#pragma unroll
            for (int tk = 0; tk < 4; ++tk) wraw[gq][tk] = *(const f32x4*)(GWp + (rowb + 4 * gq + tk) * 32 + 12 + 4 * hh);
        }
    };
    if ((int)blockIdx.x < 2048) load_a(0, (int)blockIdx.x);
    for (int pass = 0; pass < 2; ++pass) {
        for (int u0 = blockIdx.x; u0 < 2048; u0 += F.G) {
            const int b = u0 >> 8, w8 = u0 & 255, tb8 = pass ? 511 - w8 : w8, t0 = 8 * tb8, nmax = t0 + 8;
            const size_t base = (size_t)b * T;
            bf16x8 ahi[2][2], alo[2][2]; float iw[2][4][4];
#pragma unroll
            for (int gq = 0; gq < 2; ++gq) {
#pragma unroll
                for (int ks = 0; ks < 2; ++ks) split8(araw[gq][ks][0], araw[gq][ks][1], ahi[gq][ks], alo[gq][ks]);
#pragma unroll
                for (int tk = 0; tk < 4; ++tk) { const f32x4 w4 = wraw[gq][tk]; iw[gq][tk][0] = w4.x; iw[gq][tk][1] = w4.y; iw[gq][tk][2] = w4.z; iw[gq][tk][3] = w4.w; }
            }
            const int nkb = (nmax + 31) >> 5;
            v4u nbA[4], nbB[4];
#define DS_LOADB(dst, kb_) do { const GAS unsigned* kp_ = (const GAS unsigned*)(IK + (base + 32 * (kb_) + r) * 32 + 8 * hh); dst[0] = *(const GAS v4u*)kp_; dst[1] = *(const GAS v4u*)(kp_ + 4); dst[2] = *(const GAS v4u*)(kp_ + 16); dst[3] = *(const GAS v4u*)(kp_ + 20); } while (0)
#define DS_UNPK(a, b, hi_, lo_) do { v4u h_, l_; h_.x = __builtin_amdgcn_perm(a.y, a.x, 0x05040100u); l_.x = __builtin_amdgcn_perm(a.y, a.x, 0x07060302u); h_.y = __builtin_amdgcn_perm(a.w, a.z, 0x05040100u); l_.y = __builtin_amdgcn_perm(a.w, a.z, 0x07060302u); \
            h_.z = __builtin_amdgcn_perm(b.y, b.x, 0x05040100u); l_.z = __builtin_amdgcn_perm(b.y, b.x, 0x07060302u); h_.w = __builtin_amdgcn_perm(b.w, b.z, 0x05040100u); l_.w = __builtin_amdgcn_perm(b.w, b.z, 0x07060302u); \
            hi_ = __builtin_bit_cast(bf16x8, h_); lo_ = __builtin_bit_cast(bf16x8, l_); } while (0)
#ifdef DSA_DUP_SCORE
            for (int rep2_ = 0; rep2_ < 2; ++rep2_) {
#endif
            if (wave < nkb) DS_LOADB(nbA, wave);
            if (wave + 8 < nkb) DS_LOADB(nbB, wave + 8);
            for (int kb = wave; kb < nkb; kb += 16) {
                const bool hasB = kb + 8 < nkb;
                bf16x8 bhiA[2], bloA[2], bhiB[2], bloB[2];
                DS_UNPK(nbA[0], nbA[1], bhiA[0], bloA[0]); DS_UNPK(nbA[2], nbA[3], bhiA[1], bloA[1]);
                if (hasB) { DS_UNPK(nbB[0], nbB[1], bhiB[0], bloB[0]); DS_UNPK(nbB[2], nbB[3], bhiB[1], bloB[1]); }
                else { bhiB[0] = bhiA[0]; bhiB[1] = bhiA[1]; bloB[0] = bloA[0]; bloB[1] = bloA[1]; }
                if (kb + 16 < nkb) DS_LOADB(nbA, kb + 16);
                if (kb + 24 < nkb) DS_LOADB(nbB, kb + 24);
                f32x16 cA0, cA1, cB0, cB1;
#pragma unroll
                for (int i = 0; i < 16; ++i) { cA0[i] = 0.f; cA1[i] = 0.f; cB0[i] = 0.f; cB1[i] = 0.f; }
#pragma unroll
                for (int ks = 0; ks < 2; ++ks) {
                    cA0 = __builtin_amdgcn_mfma_f32_32x32x16_bf16(ahi[0][ks], bhiA[ks], cA0, 0, 0, 0); cA1 = __builtin_amdgcn_mfma_f32_32x32x16_bf16(ahi[1][ks], bhiA[ks], cA1, 0, 0, 0);
                    cB0 = __builtin_amdgcn_mfma_f32_32x32x16_bf16(ahi[0][ks], bhiB[ks], cB0, 0, 0, 0); cB1 = __builtin_amdgcn_mfma_f32_32x32x16_bf16(ahi[1][ks], bhiB[ks], cB1, 0, 0, 0);
                    cA0 = __builtin_amdgcn_mfma_f32_32x32x16_bf16(ahi[0][ks], bloA[ks], cA0, 0, 0, 0); cA1 = __builtin_amdgcn_mfma_f32_32x32x16_bf16(ahi[1][ks], bloA[ks], cA1, 0, 0, 0);
                    cB0 = __builtin_amdgcn_mfma_f32_32x32x16_bf16(ahi[0][ks], bloB[ks], cB0, 0, 0, 0); cB1 = __builtin_amdgcn_mfma_f32_32x32x16_bf16(ahi[1][ks], bloB[ks], cB1, 0, 0, 0);
                    cA0 = __builtin_amdgcn_mfma_f32_32x32x16_bf16(alo[0][ks], bhiA[ks], cA0, 0, 0, 0); cA1 = __builtin_amdgcn_mfma_f32_32x32x16_bf16(alo[1][ks], bhiA[ks], cA1, 0, 0, 0);
                    cB0 = __builtin_amdgcn_mfma_f32_32x32x16_bf16(alo[0][ks], bhiB[ks], cB0, 0, 0, 0); cB1 = __builtin_amdgcn_mfma_f32_32x32x16_bf16(alo[1][ks], bhiB[ks], cB1, 0, 0, 0);
                }
#define DS_EPI(c, gq, kb_) do { float s4_[4]; _Pragma("unroll") for (int tk = 0; tk < 4; ++tk) { \
                        const float v_ = (iw[gq][tk][0] * fmaxf(c[4 * tk], 0.f) + iw[gq][tk][1] * fmaxf(c[4 * tk + 1], 0.f)) + (iw[gq][tk][2] * fmaxf(c[4 * tk + 2], 0.f) + iw[gq][tk][3] * fmaxf(c[4 * tk + 3], 0.f)); \
                        s4_[tk] = xhalf_sum(v_) * 0.0625f + 0.0f; } \
                    LAS float* dst_ = sc + (4 * (gq) + 2 * hh) * 4096 + 32 * (kb_) + r; dst_[0] = hh ? s4_[2] : s4_[0]; dst_[4096] = hh ? s4_[3] : s4_[1]; } while (0)
                DS_EPI(cA0, 0, kb); DS_EPI(cA1, 1, kb);
                if (hasB) { DS_EPI(cB0, 0, kb + 8); DS_EPI(cB1, 1, kb + 8); }
#undef DS_EPI
            }
#ifdef DSA_DUP_SCORE
            }
#endif
#undef DS_LOADB
#undef DS_UNPK
            { int pn_ = pass, un_ = u0 + F.G; if (un_ >= 2048) { pn_ = pass + 1; un_ = blockIdx.x; } if (pn_ < 2 && un_ < 2048) load_a(pn_, un_); }
            __syncthreads();
#ifdef DSA_DUP_SEL
            for (int rep2_ = 0; rep2_ < 2; ++rep2_)
#endif
            radix_select_write(sc + wave * 4096, hist, (unsigned long long*)(F.ws + WS_DSAMASK) + (base + t0 + wave) * 64, t0 + wave, lane);
            __syncthreads();
        }
    }
}

constexpr int NS_K = 0, NS_KP = 144, NS_V = 256 * NS_KP, NS_VP = 520, NS_IMP = NS_V + 64 * NS_VP, NS_IP = 68, NS_END = NS_IMP + 64 * NS_IP * 4;
static_assert(NS_END <= RING_BYTES, "nsa select LDS map");
__device__ __forceinline__ void nsa_select_phase(Frame& F) {
    const int tid = cur_tid(), wave = cur_wave(), lane = tid & 63, r = lane & 31, hh = lane >> 5;
    LAS unsigned char* lds = F.lds;
    LAS float* imp = (LAS float*)(lds + NS_IMP);
    for (int pass = 0; pass < 2; ++pass) {
        for (int u0 = blockIdx.x; u0 < 256; u0 += F.G) {
            const int u = pass ? 511 - u0 : u0, tb = u >> 3, b = u & 7;
            __syncthreads();
            {
                const bf16* Kc = (const bf16*)(F.ws + WS_KCMPB) + (size_t)b * 256 * 64; const bf16* Vc = (const bf16*)(F.ws + WS_VCMPB) + (size_t)b * 256 * 64;
#pragma unroll
                for (int j = 0; j < 4; ++j) { const int ch = tid + 512 * j, row = ch >> 3, c8 = ch & 7;
                    *(LAS v4u*)(lds + NS_K + row * NS_KP + 16 * c8) = *(const v4u*)(Kc + row * 64 + 8 * c8);
                    const v4u vv = *(const v4u*)(Vc + row * 64 + 8 * c8);
                    LAS unsigned short* vt = (LAS unsigned short*)(lds + NS_V + (8 * c8) * NS_VP) + row;
                    vt[0 * (NS_VP / 2)] = (unsigned short)(vv.x & 0xffffu); vt[1 * (NS_VP / 2)] = (unsigned short)(vv.x >> 16); vt[2 * (NS_VP / 2)] = (unsigned short)(vv.y & 0xffffu); vt[3 * (NS_VP / 2)] = (unsigned short)(vv.y >> 16);
                    vt[4 * (NS_VP / 2)] = (unsigned short)(vv.z & 0xffffu); vt[5 * (NS_VP / 2)] = (unsigned short)(vv.z >> 16); vt[6 * (NS_VP / 2)] = (unsigned short)(vv.w & 0xffffu); vt[7 * (NS_VP / 2)] = (unsigned short)(vv.w >> 16); }
                for (int i = tid; i < 64 * NS_IP; i += 512) imp[i] = 0.f;
            }
            __syncthreads();
            const int tl_ = 8 * wave + (r >> 2), hd = r & 3, t = 64 * tb + tl_; const size_t row = (size_t)b * T + t;
            const bf16* qrow = (const bf16*)(F.ws + WS_QN) + row * 256 + hd * 64;
            bf16x8 qf[4];
#pragma unroll
            for (int ks = 0; ks < 4; ++ks) qf[ks] = *(const bf16x8*)(qrow + 16 * ks + 8 * hh);
            const int nmax = (t - 31) >> 4;
            const int ntile = ((4 * tb + 2) >> 6) + 1;
            const float sc2 = 0.125f * 1.4426950408889634f;
            auto scores = [&](int tile, f32x16& p0, f32x16& p1) {
#pragma unroll
                for (int i = 0; i < 16; ++i) { p0[i] = 0.f; p1[i] = 0.f; }
                const LAS unsigned char* Kb = lds + NS_K + (64 * tile) * NS_KP;
#pragma unroll
                for (int ks = 0; ks < 4; ++ks) {
                    const bf16x8 a0 = *(const LAS bf16x8*)(Kb + r * NS_KP + (16 * ks + 8 * hh) * 2), a1 = *(const LAS bf16x8*)(Kb + (32 + r) * NS_KP + (16 * ks + 8 * hh) * 2);
                    p0 = __builtin_amdgcn_mfma_f32_32x32x16_bf16(a0, qf[ks], p0, 0, 0, 0);
                    p1 = __builtin_amdgcn_mfma_f32_32x32x16_bf16(a1, qf[ks], p1, 0, 0, 0);
                }
            };
            float m = -1e30f, l = 0.f;
            for (int tile = 0; tile < ntile; ++tile) {
                const unsigned long long word = causal_word(nmax - 64 * tile);
                f32x16 p0, p1; scores(tile, p0, p1);
                const unsigned wlo = (unsigned)word >> (4 * hh), whi = (unsigned)(word >> 32) >> (4 * hh);
                float mx = -1e30f;
#pragma unroll
                for (int i = 0; i < 16; ++i) { const int bit = (i & 3) + 8 * (i >> 2);
                    p0[i] = ((wlo >> bit) & 1u) ? p0[i] * sc2 : -1e30f; p1[i] = ((whi >> bit) & 1u) ? p1[i] * sc2 : -1e30f; mx = fmaxf(mx, fmaxf(p0[i], p1[i])); }
                mx = xhalf_max(mx);
                const float mn = fmaxf(m, mx), alpha = __builtin_amdgcn_exp2f(m - mn); m = mn;
                float ps = 0.f;
#pragma unroll
                for (int i = 0; i < 16; ++i) { const int bit = (i & 3) + 8 * (i >> 2);
                    ps += (((wlo >> bit) & 1u) ? __builtin_amdgcn_exp2f(p0[i] - mn) : 0.f) + (((whi >> bit) & 1u) ? __builtin_amdgcn_exp2f(p1[i] - mn) : 0.f); }
                l = l * alpha + ps;
            }
            l = xhalf_sum(l);
            const float inv = l > 0.f ? 1.0f / l : 0.f;
            f32x16 o0, o1;
#pragma unroll
            for (int i = 0; i < 16; ++i) { o0[i] = 0.f; o1[i] = 0.f; }
            float carry = 0.f;
            for (int tile = 0; tile < ntile; ++tile) {
                const unsigned long long word = causal_word(nmax - 64 * tile);
                f32x16 p0, p1; scores(tile, p0, p1);
                const unsigned wlo = (unsigned)word >> (4 * hh), whi = (unsigned)(word >> 32) >> (4 * hh);
#pragma unroll
                for (int i = 0; i < 16; ++i) { const int bit = (i & 3) + 8 * (i >> 2);
                    p0[i] = ((wlo >> bit) & 1u) ? __builtin_amdgcn_exp2f(p0[i] * sc2 - m) * inv : 0.f; p1[i] = ((whi >> bit) & 1u) ? __builtin_amdgcn_exp2f(p1[i] * sc2 - m) * inv : 0.f; }
#pragma unroll
                for (int blk = 0; blk < 2; ++blk) {
                    float tot[4];
#pragma unroll
                    for (int g = 0; g < 4; ++g) {
                        const float a = blk ? p1[4 * g] : p0[4 * g], b1 = blk ? p1[4 * g + 1] : p0[4 * g + 1], c1 = blk ? p1[4 * g + 2] : p0[4 * g + 2], d1 = blk ? p1[4 * g + 3] : p0[4 * g + 3];
                        const float mainv = (a + b1) + (c1 + d1);
                        const float recv = xhalf_other(d1, hh);
                        const float below = hh ? recv : carry;
                        tot[g] = mainv + below;
                        carry = recv;
                    }
#pragma unroll
                    for (int g = 0; g < 4; ++g) { float v = tot[g]; v += dpp_f<0xB1>(v); v += dpp_f<0x4E>(v);
                        if (hd == 0) imp[tl_ * NS_IP + 16 * tile + 8 * blk + 2 * g + hh] = v; }
                }
                bf16x8 pf[4];
#pragma unroll
                for (int s = 0; s < 4; ++s) { v4u w;
                    if (s < 2) { w.x = pg8::cvt_pk_bf16(p0[8 * s], p0[8 * s + 1]); w.y = pg8::cvt_pk_bf16(p0[8 * s + 2], p0[8 * s + 3]); w.z = pg8::cvt_pk_bf16(p0[8 * s + 4], p0[8 * s + 5]); w.w = pg8::cvt_pk_bf16(p0[8 * s + 6], p0[8 * s + 7]); }
                    else { const int s2 = s - 2; w.x = pg8::cvt_pk_bf16(p1[8 * s2], p1[8 * s2 + 1]); w.y = pg8::cvt_pk_bf16(p1[8 * s2 + 2], p1[8 * s2 + 3]); w.z = pg8::cvt_pk_bf16(p1[8 * s2 + 4], p1[8 * s2 + 5]); w.w = pg8::cvt_pk_bf16(p1[8 * s2 + 6], p1[8 * s2 + 7]); }
                    pf[s] = __builtin_bit_cast(bf16x8, w); }
#pragma unroll
                for (int s = 0; s < 4; ++s) {
                    const int kb = 64 * tile + 32 * (s >> 1) + 16 * (s & 1) + 4 * hh;
#pragma unroll
                    for (int db = 0; db < 2; ++db) {
                        const LAS unsigned char* vp_ = lds + NS_V + (32 * db + r) * NS_VP + kb * 2;
                        typedef unsigned u32x2v __attribute__((ext_vector_type(2)));
                        const u32x2v lo = *(const LAS u32x2v*)vp_, hi = *(const LAS u32x2v*)(vp_ + 16);
                        v4u aw; aw.x = lo.x; aw.y = lo.y; aw.z = hi.x; aw.w = hi.y;
                        const bf16x8 a = __builtin_bit_cast(bf16x8, aw);
                        if (db == 0) o0 = __builtin_amdgcn_mfma_f32_32x32x16_bf16(a, pf[s], o0, 0, 0, 0);
                        else o1 = __builtin_amdgcn_mfma_f32_32x32x16_bf16(a, pf[s], o1, 0, 0, 0);
                    }
                }
            }
            flash_store((bf16*)(F.ws + WS_OC) + row * 256 + hd * 64, o0, o1, 1.0f, hh);
            LDS_WAIT(); asm volatile("" ::: "memory");
            for (int k = 0; k < 8; ++k) {
                const int tk = 64 * tb + 8 * wave + k, own = tk >> 6;
                const float iv = imp[(8 * wave + k) * NS_IP + lane];
                const bool causal = lane <= own, forced = causal && (lane == 0 || lane >= own - 1);
                const float val = forced ? 1e4f : (causal ? iv : -INFINITY);
                const unsigned kv_ = fkey(val); const unsigned klo = (kv_ << 6) | (unsigned)(63 - lane), khi = kv_ >> 26;
                int rank = 0;
#pragma unroll
                for (int j = 0; j < 64; ++j) { const unsigned jlo = (unsigned)__builtin_amdgcn_readlane((int)klo, j), jhi = (unsigned)__builtin_amdgcn_readlane((int)khi, j);
                    rank += (jhi > khi || (jhi == khi && jlo > klo)) ? 1 : 0; }
                const unsigned long long selm = __ballot(causal && rank < 16);
                if (lane == 0) ((unsigned long long*)(F.ws + WS_NSEL))[(size_t)b * T + tk] = selm;
            }
        }
    }
}
#ifndef PHMASK
#define PHMASK 0xFFFFFFFFu
#endif
#define EN(b) ((PHMASK >> (b)) & 1u)
#ifndef DUPMASK
#define DUPMASK 0u
#endif
#define REP(b) for (int rep_ = 0; rep_ < (((DUPMASK >> (b)) & 1u) ? 2 : 1); ++rep_)
__global__ void __launch_bounds__(NWAVES * 64, 2) fwd_kernel(Args args) {
    extern __shared__ __attribute__((aligned(16))) unsigned char lds[];
    Frame F;
    F.lds = (LAS unsigned char*)lds;
    F.MISC = (volatile LAS unsigned*)(F.lds + MISC_OFF);
    F.G = gridDim.x;
    F.ws = args.ws; F.ctl = (gu32*)(args.ws + WS_CTL); F.out = args.out;
    F.A = &args;
    for (int u = threadIdx.x; u < (XTRA_OFF - LDSCTL_OFF) / 4; u += NWAVES * 64) ((LAS unsigned*)(F.lds + LDSCTL_OFF))[u] = 0u;
    __syncthreads();
    XcdBarrier bar = xcd_barrier_post((unsigned*)(F.ctl + CW_BAR), F.MISC + 8);
#ifdef PHASE_RANGES
    const int lo = args.ph_lo, hi = args.ph_hi;
#endif
#ifdef PHASE_RANGES
#define IN(k) (lo <= (k) && (k) < hi)
#else
#define IN(k) true
#endif
#ifdef DUP_BAR
#define SEAM(k) do { if (IN(k) && IN((k) + 1)) { xcd_barrier(bar); xcd_barrier(bar); } } while (0)
#else
#define SEAM(k) do { if (IN(k) && IN((k) + 1)) xcd_barrier(bar); } while (0)
#endif
    unsigned char* ws = F.ws;
    bf16 *H, *HID; const float *cs64, *cs32, *ada;

    if (EN(0) && IN(0)) REP(0) p0_prologue(F);
    SEAM(0);
    int ph = 1;
    auto half_layer = [&](const int s) __attribute__((always_inline)) {
        const int l = s >> 1, second = s & 1;
        { unsigned char* w_ = args.ws; asm volatile("" : "+s"(w_)); ws = w_; F.ws = w_; }
        H = (bf16*)F.out + (size_t)M * D; HID = (bf16*)(ws + WS_HID); cs64 = (const float*)(ws + WS_CS64); cs32 = (const float*)(ws + WS_CS32); ada = (const float*)(ws + WS_ADA);
        const unsigned char* wl = ws + WS_WTS + (size_t)l * WTS_LAYER;
        const float* adal = ada + (size_t)l * 8 * 9216;
        bf16* XB = (bf16*)(ws + WS_XB);
        if (EN(1) && IN(ph)) {
            if (s == 0) { wgu8_convert(F); norm_mod_phase<false, true>(F, args.in[I_X], args.in[I_F1N] + l * D, adal + 0 * 1024, adal + 1 * 1024, H); }
            else norm_mod_phase<true, true>(F, XB, args.in[second ? I_F2N : I_F1N] + l * D, adal + (second ? 6 : 0) * 1024, adal + (second ? 7 : 1) * 1024, H);
        }
        SEAM(ph); ++ph;
        if (EN(2) && IN(ph)) REP(2) {
            pg8::Gemm g{H, (const bf16*)(wl + (second ? WO_GU2 : WO_GU1)), M, NGU, D / 2}; pg8::StaticOrder S; S.init(M, NGU, F.G, (int)blockIdx.x);
            const float wmax = __uint_as_float(__hip_atomic_load((unsigned*)(F.ctl + CW_WMAX) + 2 * l + second, __ATOMIC_RELAXED, __HIP_MEMORY_SCOPE_AGENT));
            pg8::EpiSwiGLU8 E{HID, FF, (ACT_CLIP / 127.0f) * (wmax / 127.0f)};
            pg8::gemm_phase<pg8::EpiSwiGLU8, pg8::StaticOrder, true, true, true>(F.lds + RING_OFF, g, S, E);
        }
        SEAM(ph); ++ph;
        if (EN(3) && IN(ph)) {
            pg8::Gemm g{HID, (const bf16*)(wl + (second ? WO_D2 : WO_D1)), M, D, FF}; pg8::StaticOrder S; S.init(M, D, F.G, (int)blockIdx.x);
            if (s == 0) { pg8::EpiResid<false> E{args.in[I_X], XB, adal + 2 * 1024, 0.5f};
                pg8::gemm_phase<pg8::EpiResid<false>, pg8::StaticOrder, true, true>(F.lds + RING_OFF, g, S, E); }
            else { pg8::EpiResid<true> E{XB, XB, adal + (second ? 8 : 2) * 1024, 0.5f};
                pg8::gemm_phase<pg8::EpiResid<true>, pg8::StaticOrder, true, true>(F.lds + RING_OFF, g, S, E); }
        }
        SEAM(ph); ++ph;
        if (second) return;
        if (EN(4) && IN(ph)) norm_mod_phase<true, false>(F, XB, args.in[I_MIXN] + l * D, adal + 3 * 1024, adal + 4 * 1024, H);
        SEAM(ph); ++ph;
        if (EN(5) && IN(ph)) REP(5) {
            pg8::Gemm g{H, (const bf16*)(wl + WO_IN), M, NINP, D}; pg8::StaticOrder S; S.init(M, NINP, F.G, (int)blockIdx.x);
            pg8::EpiProj<WinDesc> E{WinDesc{ws}, cs64, cs32, nullptr};
            pg8::gemm_phase<pg8::EpiProj<WinDesc>, pg8::StaticOrder, true, true>(F.lds + RING_OFF, g, S, E);
        }
        SEAM(ph); ++ph;
        if (EN(6) && IN(ph)) REP(6) {
            m1_phase(F, l);
            { int kq = 2048; asm volatile("" : "+s"(kq)); pg8::Gemm g{(const bf16*)(ws + WS_KC), (const bf16*)(wl + WO_C1K), 2048, 256, kq, 1024}; pg8::RangeOrder S{8, 0};
              pg8::EpiCmpH E{(float*)(ws + WS_CMPH), (const float*)(ws + WS_CMPB) + (l * 2 + 0) * 256};
              pg8::gemm_phase<pg8::EpiCmpH, pg8::RangeOrder, false, true>(F.lds + RING_OFF, g, S, E); }
            { int kq = 2048; asm volatile("" : "+s"(kq)); pg8::Gemm g{(const bf16*)(ws + WS_VC), (const bf16*)(wl + WO_C1V), 2048, 256, kq, 1024}; pg8::RangeOrder S{8, 8};
              pg8::EpiCmpH E{(float*)(ws + WS_CMPH) + (size_t)8 * 256 * 256, (const float*)(ws + WS_CMPB) + (l * 2 + 1) * 256};
              pg8::gemm_phase<pg8::EpiCmpH, pg8::RangeOrder, false, true>(F.lds + RING_OFF, g, S, E); }
        }
        SEAM(ph); ++ph;
        if (IN(ph)) {
            if (EN(7)) REP(7) { int kq = 256; asm volatile("" : "+s"(kq)); pg8::Gemm g{(const bf16*)(ws + WS_CQ), (const bf16*)(wl + WO_UQ), M, 512, kq}; pg8::StaticOrder S; S.init(M, 512, F.G, (int)blockIdx.x);
              pg8::EpiProj<MlaQDesc> E{MlaQDesc{ws}, cs64, cs32, (const float*)(ws + WS_RSTDQ)};
              pg8::gemm_phase<pg8::EpiProj<MlaQDesc>, pg8::StaticOrder, true, true>(F.lds + RING_OFF, g, S, E); }
            if (EN(8)) REP(7) { int kq = 128; asm volatile("" : "+s"(kq)); pg8::Gemm g{(const bf16*)(ws + WS_CKV), (const bf16*)(wl + WO_UKV), M, 512, kq}; pg8::StaticOrder S; S.init(M, 512, F.G, (int)blockIdx.x);
              pg8::EpiProj<MlaKvDesc> E{MlaKvDesc{ws}, cs64, cs32, (const float*)(ws + WS_RSTDKV)};
              pg8::gemm_phase<pg8::EpiProj<MlaKvDesc>, pg8::StaticOrder, true, true>(F.lds + RING_OFF, g, S, E); }
            if (EN(9)) REP(9) cmp2_phase(F, l);
#ifdef FLASH_DSA
            if (EN(10)) REP(10) dsa_select_phase(F);
#else
            if (EN(10)) REP(10) dsa_tokens_phase(F);
#endif
        }
        SEAM(ph); ++ph;
#ifdef FLASH_NSA
        if (IN(ph)) { if (EN(13)) REP(13) nsa_select_phase(F); }
        SEAM(ph); ++ph;
#endif
        if (IN(ph)) {
#ifdef FLASH_MOBA
            if (EN(11)) REP(11) moba_flash_phase(F);
#else
            if (EN(11)) moba_rows_phase(F);
#endif
#ifdef FLASH_MLA
            if (EN(12)) REP(12) mla_flash_phase(F);
#else
            if (EN(12)) mla_rows_phase(F);
#endif
#ifdef FLASH_NSA
            if (EN(13)) REP(14) nsa_flash_phase(F);
#else
            if (EN(13)) nsa_tokens_phase(F);
#endif
#ifdef FLASH_DSA
            if (EN(10)) REP(15) dsa_flash_phase(F);
#endif
        }
        SEAM(ph); ++ph;
        if (EN(14) && IN(ph)) group_norm_phase(F, H, args.in[I_GN] + l * 1024);
        SEAM(ph); ++ph;
        if (EN(15) && IN(ph)) {
            pg8::Gemm g{H, (const bf16*)(wl + WO_OUT), M, D, D}; pg8::StaticOrder S; S.init(M, D, F.G, (int)blockIdx.x);
            pg8::EpiResid<true> E{XB, XB, adal + 5 * 1024, 1.0f};
            pg8::gemm_phase<pg8::EpiResid<true>, pg8::StaticOrder, true, true>(F.lds + RING_OFF, g, S, E);
        }
        SEAM(ph); ++ph;
    };
    half_layer(0); half_layer(1);
#ifdef DUP_LAYER0
    half_layer(0); half_layer(1);
#endif
    half_layer(2); half_layer(3);
    if (EN(16) && IN(ph)) final_norm_phase(F, (const bf16*)(args.ws + WS_XB), F.out, args.in[I_FINN]);
#undef IN
#undef SEAM
}
#ifdef FLASH_NSA
constexpr int N_PHASES = 1 + 4 * 3 + 2 * 8 + 1;
#else
constexpr int N_PHASES = 1 + 4 * 3 + 2 * 7 + 1;
#endif

extern "C" void kernel_launch(void* const* d_in, const int* in_sizes, int n_in, void* d_out, int out_size, void* d_ws, size_t ws_size, hipStream_t stream) {
    static int grid = 0;
    if (grid == 0) {
        if (n_in != 28 || in_sizes[0] != M * D || out_size != M * D || ws_size < WS_END) { fprintf(stderr, "kernel_launch: unexpected problem shape (n_in %d, in0 %d, out %d, ws %zu); nothing launched\n", n_in, n_in > 0 ? in_sizes[0] : -1, out_size, ws_size); grid = -1; return; }
        int dev = 0, cus = 0, per_cu = 0;
        if (hipGetDevice(&dev) != hipSuccess || hipDeviceGetAttribute(&cus, hipDeviceAttributeMultiprocessorCount, dev) != hipSuccess) { grid = -1; return; }
        if (hipFuncSetAttribute((const void*)fwd_kernel, hipFuncAttributeMaxDynamicSharedMemorySize, LDS_BYTES) != hipSuccess) { fprintf(stderr, "kernel_launch: hipFuncSetAttribute failed\n"); grid = -1; return; }
        if (hipOccupancyMaxActiveBlocksPerMultiprocessor(&per_cu, (const void*)fwd_kernel, NWAVES * 64, LDS_BYTES) != hipSuccess || per_cu < 1) { fprintf(stderr, "kernel_launch: occupancy query says %d\n", per_cu); }
        (void)hipGetLastError();
        grid = cus;
    }
    if (grid < 0) return;
    if (hipMemsetAsync((char*)d_ws + WS_CTL, 0, CTL_ZERO_BYTES, stream) != hipSuccess) return;
    Args a{};
    for (int i = 0; i < 28; ++i) a.in[i] = (const float*)d_in[i];
    a.out = (float*)d_out; a.ws = (unsigned char*)d_ws; a.ph_lo = 0; a.ph_hi = N_PHASES + 64;
    hipLaunchKernelGGL(fwd_kernel, dim3(grid), dim3(NWAVES * 64), LDS_BYTES, stream, a);
}
```

```cpp
#include <hip/hip_runtime.h>
#include <cstdio>
#include <cstdint>
#include <cmath>
#ifndef NO_FLASH
#define FLASH_MLA 1
#define FLASH_MOBA 1
#define FLASH_NSA 1
#define FLASH_DSA 1
#endif
namespace pg8 {
#define PG8_LAS __attribute__((address_space(3)))
typedef unsigned short bf16_t;
typedef short bf16x8 __attribute__((ext_vector_type(8)));
typedef float f32x4 __attribute__((ext_vector_type(4)));
typedef unsigned u32x4 __attribute__((ext_vector_type(4)));
constexpr int BM = 256, BK = 64, HALF = 128, HTB = HALF * BK * 2  , STAGE_BYTES = 8 * HTB, NXCD = 8, WGM = 8;

__host__ __device__ __forceinline__ int lds_byte(int r, int c) { const int st = (r >> 4) * 2 + (c >> 5), rr = r & 15, cc = c & 31, ob = rr * 64 + cc * 2; return st * 1024 + (ob ^ (((ob >> 9) & 1) << 5)); }
__host__ __device__ __forceinline__ void stage_rc(int b, int& R, int& C) { const int st = b / 1024, sb = b % 1024, swz = sb ^ (((sb >> 9) & 1) << 5); R = (st >> 1) * 16 + swz / 64; C = (st & 1) * 32 + (swz % 64) / 2; }
__host__ __device__ __forceinline__ int perm32(int rho) { const int n = rho >> 4, i = rho & 15; return 8 * (i >> 2) + 4 * n + (i & 3); }

struct Unit { int pm, pn; };
struct Gemm { const bf16_t* A; const bf16_t* Bt; int M, N, K; int lda = 0; };

struct StaticOrder {
    int nM, nN, nwg, G, c;
    __host__ __device__ void init(int M, int N, int G_, int c_) { nM = M / BM; nN = N / BM; nwg = nM * nN; G = G_; c = c_; }
    __host__ __device__ bool next(int i, Unit& u) const {
        const long L = (long)i * G + c; if (L >= nwg) return false;
        int wgid = (int)L; { const int q = nwg / NXCD, r = nwg % NXCD, xcd = wgid % NXCD, off = wgid / NXCD; wgid = (xcd < r ? xcd * (q + 1) : r * (q + 1) + (xcd - r) * q) + off; }
        const int nig = WGM * nN, gid = wgid / nig, fm = gid * WGM, gsz = (nM - fm) < WGM ? (nM - fm) : WGM;
        u.pm = fm + ((wgid % nig) % gsz); u.pn = (wgid % nig) / gsz; return true;
    }
    __device__ __forceinline__ void a_ready(const Unit&) const {}
    __device__ __forceinline__ void done(const Unit&) const {}
};

__device__ __forceinline__ unsigned cvt_pk_bf16(float lo, float hi) { unsigned r; asm volatile("v_cvt_pk_bf16_f32 %0, %1, %2" : "=v"(r) : "v"(lo), "v"(hi)); return r; }
typedef float f32x2 __attribute__((ext_vector_type(2)));
typedef unsigned u32x2 __attribute__((ext_vector_type(2)));
__device__ __forceinline__ float silu_f(float x) { return x * __builtin_amdgcn_rcpf(1.0f + __builtin_amdgcn_exp2f(-1.4426950408889634f * x)); }

struct EpiSwiGLU {
    static constexpr bool PERM = false, AFTER_DRAIN = false;
    bf16_t* H; int ldh;
    __device__ __forceinline__ void operator()(const f32x4 (&acc)[2][2][4][2], const Unit& u, int wr, int wc, int fr, int fq) const {
        const int row0 = u.pm * BM + wr * 64 + fr;
        const int hc0 = u.pn * 128 + wc * 16 + 4 * fq;
#pragma unroll
        for (int ai = 0; ai < 2; ++ai)
#pragma unroll
            for (int m = 0; m < 4; ++m) {
                bf16_t* rowp = H + (size_t)(row0 + ai * HALF + m * 16) * ldh + hc0;
#pragma unroll
                for (int bj = 0; bj < 2; ++bj) {
                    const f32x4 g = acc[ai][bj][m][0], uu = acc[ai][bj][m][1];
                    u32x2 w; w.x = cvt_pk_bf16(silu_f(g[0]) * uu[0], silu_f(g[1]) * uu[1]); w.y = cvt_pk_bf16(silu_f(g[2]) * uu[2], silu_f(g[3]) * uu[3]);
                    *(u32x2*)(rowp + bj * 64) = w;
                }
            }
    }
};

__device__ __forceinline__ unsigned q8pack4(float a, float b, float c, float d, float qs) {
    const float MG = 12582912.0f; const int MB = 0x4B400000;
    int ia = __float_as_int(__builtin_fmaf(a, qs, MG)), ib = __float_as_int(__builtin_fmaf(b, qs, MG)), ic = __float_as_int(__builtin_fmaf(c, qs, MG)), id = __float_as_int(__builtin_fmaf(d, qs, MG));
    ia = min(max(ia, MB - 127), MB + 127); ib = min(max(ib, MB - 127), MB + 127); ic = min(max(ic, MB - 127), MB + 127); id = min(max(id, MB - 127), MB + 127);
    return __builtin_amdgcn_perm((unsigned)ib, (unsigned)ia, 0x0c0c0400u) | __builtin_amdgcn_perm((unsigned)id, (unsigned)ic, 0x04000c0cu);
}
constexpr float HID_CLIP = 9.0f;
struct EpiSwiGLU8 {
    static constexpr bool PERM = false, AFTER_DRAIN = false;
    signed char* H; int ldh; float deq;
    __device__ __forceinline__ void operator()(const f32x4 (&acc)[2][2][4][2], const Unit& u, int wr, int wc, int fr, int fq) const {
        typedef int i32x4_ __attribute__((ext_vector_type(4)));
        const int row0 = u.pm * BM + wr * 64 + fr;
        const int hc0 = u.pn * 128 + wc * 16 + 4 * fq;
#pragma unroll
        for (int ai = 0; ai < 2; ++ai)
#pragma unroll
            for (int m = 0; m < 4; ++m) {
                signed char* rowp = H + (size_t)(row0 + ai * HALF + m * 16) * ldh + hc0;
#pragma unroll
                for (int bj = 0; bj < 2; ++bj) {
                    const i32x4_ gi = __builtin_bit_cast(i32x4_, acc[ai][bj][m][0]), ui = __builtin_bit_cast(i32x4_, acc[ai][bj][m][1]);
                    float g[4], uu[4];
#pragma unroll
                    for (int i = 0; i < 4; ++i) { g[i] = (float)gi[i] * deq; uu[i] = (float)ui[i] * deq; }
                    *(unsigned*)(rowp + bj * 64) = q8pack4(silu_f(g[0]) * uu[0], silu_f(g[1]) * uu[1], silu_f(g[2]) * uu[2], silu_f(g[3]) * uu[3], 127.0f / HID_CLIP);
                }
            }
    }
};

template <bool XIN_BF16, bool I8 = false> struct EpiResid {
    static constexpr bool PERM = false, AFTER_DRAIN = false;
    const void* xin; bf16_t* xout; const float* gate; float coef;
    __device__ __forceinline__ void operator()(const f32x4 (&acc)[2][2][4][2], const Unit& u, int wr, int wc, int fr, int fq) const {
        const int b = (u.pm * BM) >> 12;
        const float* gv = gate + (size_t)b * 9216;
        const int row0 = u.pm * BM + wr * 64 + fr, col0 = u.pn * BM + wc * 32 + 4 * fq;
        f32x4 g[2][2];
#pragma unroll
        for (int bj = 0; bj < 2; ++bj)
#pragma unroll
            for (int n = 0; n < 2; ++n) g[bj][n] = *(const f32x4*)(gv + col0 + bj * HALF + n * 16) * coef;
#pragma unroll
        for (int ai = 0; ai < 2; ++ai)
#pragma unroll
            for (int m = 0; m < 4; ++m) {
                const size_t off = (size_t)(row0 + ai * HALF + m * 16) * 1024 + col0;
#pragma unroll
                for (int bj = 0; bj < 2; ++bj)
#pragma unroll
                    for (int n = 0; n < 2; ++n) {
                        f32x4 xi;
                        if (XIN_BF16) { const u32x2 w = *(const u32x2*)((const bf16_t*)xin + off + bj * HALF + n * 16);
                            xi[0] = __uint_as_float(w.x << 16); xi[1] = __uint_as_float(w.x & 0xffff0000u); xi[2] = __uint_as_float(w.y << 16); xi[3] = __uint_as_float(w.y & 0xffff0000u); }
                        else xi = *(const f32x4*)((const float*)xin + off + bj * HALF + n * 16);
                        f32x4 av = acc[ai][bj][m][n];
                        if (I8) { typedef int i32x4_ __attribute__((ext_vector_type(4))); const i32x4_ q = __builtin_bit_cast(i32x4_, av); av = (f32x4){(float)q[0], (float)q[1], (float)q[2], (float)q[3]}; }
                        const f32x4 xo = xi + g[bj][n] * av;
                        u32x2 wo; wo.x = cvt_pk_bf16(xo[0], xo[1]); wo.y = cvt_pk_bf16(xo[2], xo[3]);
                        *(u32x2*)(xout + off + bj * HALF + n * 16) = wo; }
                if (m & 1) asm volatile("" ::: "memory");
            }
    }
};

struct ProjDesc { int kind, dfreq0, nstride, rep, repstride, bpitch, fpitch, pad; bf16_t* bp; float* fp; };
template <class DescFn> struct EpiProj {
    static constexpr bool PERM = false, AFTER_DRAIN = false;
    DescFn df; const float* cs64; const float* cs32; const float* rowscale;
    __device__ __forceinline__ void operator()(const f32x4 (&acc)[2][2][4][2], const Unit& u, int wr, int wc, int fr, int fq) const {
        const int row0 = u.pm * BM + wr * 64 + fr;
#pragma unroll
        for (int bj = 0; bj < 2; ++bj) {
            const int G = u.pn * 8 + bj * 4 + wc;
            const ProjDesc d = df(G);
            if (d.kind != 0) {
#pragma unroll
                for (int ai = 0; ai < 2; ++ai)
#pragma unroll
                    for (int m = 0; m < 4; ++m) {
                        const int row = row0 + ai * HALF + m * 16;
                        f32x4 v0 = acc[ai][bj][m][0], v1 = acc[ai][bj][m][1];
                        if (rowscale) { const float rs = rowscale[row]; v0 = v0 * rs; v1 = v1 * rs; }
                        if (d.kind >= 2) {
                            const int pos = row & 4095;
                            const float* cs = (d.kind == 2) ? cs64 + ((size_t)pos * 32 + d.dfreq0 + 4 * fq) * 2 : cs32 + ((size_t)pos * 16 + 4 * fq) * 2;
                            const f32x4 a = *(const f32x4*)cs, b2 = *(const f32x4*)(cs + 4);
                            const f32x4 c = {a[0], a[2], b2[0], b2[2]}, s = {a[1], a[3], b2[1], b2[3]};
                            const f32x4 o0 = v0 * c - v1 * s, o1 = v1 * c + v0 * s; v0 = o0; v1 = o1;
                        }
                        if (d.bp) {
                            u32x2 w0, w1; w0.x = cvt_pk_bf16(v0[0], v0[1]); w0.y = cvt_pk_bf16(v0[2], v0[3]); w1.x = cvt_pk_bf16(v1[0], v1[1]); w1.y = cvt_pk_bf16(v1[2], v1[3]);
                            bf16_t* p = d.bp + (size_t)row * d.bpitch + 4 * fq;
                            for (int rp = 0; rp < d.rep; ++rp) { *(u32x2*)(p + rp * d.repstride) = w0; *(u32x2*)(p + rp * d.repstride + d.nstride) = w1; }
                        }
                        if (d.fp) { float* p = d.fp + (size_t)row * d.fpitch + 4 * fq;
                            if (d.pad) {
                                typedef unsigned u32x4v __attribute__((ext_vector_type(4)));
                                u32x4v w0, w1;
#pragma unroll
                                for (int q = 0; q < 2; ++q) { const f32x4 v = q ? v1 : v0;
                                    const unsigned h01 = cvt_pk_bf16(v[0], v[1]), h23 = cvt_pk_bf16(v[2], v[3]);
                                    const unsigned l01 = cvt_pk_bf16(v[0] - __uint_as_float(h01 << 16), v[1] - __uint_as_float(h01 & 0xffff0000u)), l23 = cvt_pk_bf16(v[2] - __uint_as_float(h23 << 16), v[3] - __uint_as_float(h23 & 0xffff0000u));
                                    u32x4v w; w.x = (h01 & 0xffffu) | (l01 << 16); w.y = (h01 >> 16) | (l01 & 0xffff0000u); w.z = (h23 & 0xffffu) | (l23 << 16); w.w = (h23 >> 16) | (l23 & 0xffff0000u);
                                    if (q) w1 = w; else w0 = w; }
                                *(u32x4v*)p = w0; *(u32x4v*)(p + d.nstride) = w1;
                            } else { *(f32x4*)p = v0; *(f32x4*)(p + d.nstride) = v1; } }
                        asm volatile("" ::: "memory");
                    }
            }
        }
    }
};


struct EpiCmpH {
    static constexpr bool PERM = false, AFTER_DRAIN = false;
    float* out; const float* bias;
    __device__ __forceinline__ void operator()(const f32x4 (&acc)[2][2][4][2], const Unit& u, int wr, int wc, int fr, int fq) const {
        const int row0 = u.pm * BM + wr * 64 + fr, col0 = wc * 32 + 4 * fq;
        f32x4 bv[2][2];
#pragma unroll
        for (int bj = 0; bj < 2; ++bj)
#pragma unroll
            for (int n = 0; n < 2; ++n) bv[bj][n] = *(const f32x4*)(bias + col0 + bj * HALF + n * 16);
#pragma unroll
        for (int ai = 0; ai < 2; ++ai)
#pragma unroll
            for (int m = 0; m < 4; ++m) {
                float* rowp = out + (size_t)(row0 + ai * HALF + m * 16) * 256 + col0;
#pragma unroll
                for (int bj = 0; bj < 2; ++bj)
#pragma unroll
                    for (int n = 0; n < 2; ++n) { const f32x4 v = acc[ai][bj][m][n] + bv[bj][n];
                        f32x4 o; o[0] = silu_f(v[0]); o[1] = silu_f(v[1]); o[2] = silu_f(v[2]); o[3] = silu_f(v[3]); *(f32x4*)(rowp + bj * HALF + n * 16) = o; }
            }
    }
};
struct RangeOrder {
    int nM, c0;
    __device__ __forceinline__ bool next(int i, Unit& u) const { const int idx = (int)blockIdx.x - c0; if (i > 0 || idx < 0 || idx >= nM) return false; u.pm = idx; u.pn = 0; return true; }
    __device__ __forceinline__ void a_ready(const Unit&) const {}
    __device__ __forceinline__ void done(const Unit&) const {}
};
template <class Epi, class Sched, bool ALIGN_EPI = false, bool SP2 = false, bool I8 = false>
__device__ __forceinline__ void gemm_phase(PG8_LAS unsigned char* lds, const Gemm g, const Sched& S, const Epi& E) {
    int tid_ = threadIdx.x; asm volatile("" : "+v"(tid_));
    const int tid = tid_, wid = __builtin_amdgcn_readfirstlane(tid >> 6), lane = tid & 63, wr = wid >> 2, wc = wid & 3, fr = lane & 15, fq = lane >> 4;
    const int K = g.K, nt = K / BK, lda = g.lda ? g.lda : g.K;
    unsigned voffA[2], voffB[2];
#pragma unroll
    for (int i = 0; i < 2; ++i) { int R, C; stage_rc(tid * 16 + i * 8192, R, C); const int Rb = Epi::PERM ? ((R & ~31) + perm32(R & 31)) : R;
        voffA[i] = (unsigned)(R * lda + C) * 2u; voffB[i] = (unsigned)(Rb * K + C) * 2u; }
    const size_t kstep = (size_t)(BK * 2);
    const size_t hstepB = (size_t)HALF * K * 2, hstepA = (size_t)HALF * lda * 2;
    const size_t tstepB = 2 * hstepB, tstepA = 2 * hstepA;
    const unsigned ldsw = (unsigned)wid * 1024u;
    const int aoff = lds_byte(wr * 64 + fr, fq * 8), boff = lds_byte(wc * 32 + fr, fq * 8);
#define PG8_SA(b, h) (((b) * 2 + (h)) * HTB)
#define PG8_SB(b, h) ((4 + (b) * 2 + (h)) * HTB)
#define PG8_STAGE(bufoff, gbase, voff) do { _Pragma("unroll") for (int _i = 0; _i < 2; ++_i) \
        __builtin_amdgcn_global_load_lds((const unsigned*)((const char*)(gbase) + (voff)[_i]), (PG8_LAS unsigned*)(lds + (bufoff) + ldsw + _i * 8192), 16, 0, 0); } while (0)
#define PG8_LDA(dst, b, h) do { _Pragma("unroll") for (int m = 0; m < 4; ++m) _Pragma("unroll") for (int k = 0; k < 2; ++k) dst[m][k] = *(const PG8_LAS bf16x8*)(lds + PG8_SA(b, h) + aoff + m * 2048 + k * 1024); } while (0)
#define PG8_LDB(dst, b, h) do { _Pragma("unroll") for (int n = 0; n < 2; ++n) _Pragma("unroll") for (int k = 0; k < 2; ++k) dst[n][k] = *(const PG8_LAS bf16x8*)(lds + PG8_SB(b, h) + boff + n * 2048 + k * 1024); } while (0)
#define PG8_MMA(ai, bj, At, Bt) do { __builtin_amdgcn_s_setprio(1); _Pragma("unroll") for (int m = 0; m < 4; ++m) _Pragma("unroll") for (int n = 0; n < 2; ++n) _Pragma("unroll") for (int k = 0; k < 2; ++k) \
        { if constexpr (I8) { typedef int i32x4_ __attribute__((ext_vector_type(4))); acc[ai][bj][m][n] = __builtin_bit_cast(f32x4, __builtin_amdgcn_mfma_i32_16x16x64_i8(__builtin_bit_cast(i32x4_, Bt[n][k]), __builtin_bit_cast(i32x4_, At[m][k]), __builtin_bit_cast(i32x4_, acc[ai][bj][m][n]), 0, 0, 0)); } \
          else acc[ai][bj][m][n] = __builtin_amdgcn_mfma_f32_16x16x32_bf16(Bt[n][k], At[m][k], acc[ai][bj][m][n], 0, 0, 0); } __builtin_amdgcn_s_setprio(0); } while (0)
#define PG8_WAIT_V(n) asm volatile("s_waitcnt vmcnt(" #n ")" ::: "memory")
#define PG8_WAIT_L(n) asm volatile("s_waitcnt lgkmcnt(" #n ")" ::: "memory")
#define PG8_BAR __builtin_amdgcn_s_barrier()
#define PG8_SCHED __builtin_amdgcn_sched_barrier(0)
    Unit cur, nxt; int ui = 0;
    if (!S.next(0, cur)) return;
    f32x4 acc[2][2][4][2];
#pragma unroll
    for (int a = 0; a < 2; ++a)
#pragma unroll
        for (int b = 0; b < 2; ++b)
#pragma unroll
            for (int m = 0; m < 4; ++m)
#pragma unroll
                for (int n = 0; n < 2; ++n) acc[a][b][m][n] = (f32x4){0.f, 0.f, 0.f, 0.f};
    bf16x8 At[4][2], B0[2][2], B1[2][2];
    const char* cA = (const char*)g.A + (size_t)cur.pm * tstepA; const char* cB = (const char*)g.Bt + (size_t)cur.pn * tstepB;
    S.a_ready(cur);
    if constexpr (SP2) {
        PG8_STAGE(PG8_SB(0, 0), cB, voffB); PG8_STAGE(PG8_SB(0, 1), cB + hstepB, voffB); PG8_STAGE(PG8_SA(0, 0), cA, voffA); PG8_STAGE(PG8_SA(0, 1), cA + hstepA, voffA);
        if (wr == 1) PG8_BAR;
        PG8_WAIT_V(2); PG8_BAR;
        PG8_STAGE(PG8_SB(1, 0), cB + kstep, voffB); PG8_STAGE(PG8_SA(1, 0), cA + kstep, voffA); PG8_STAGE(PG8_SB(1, 1), cB + hstepB + kstep, voffB);
        PG8_WAIT_V(6); PG8_BAR;
    } else {
        PG8_STAGE(PG8_SB(0, 0), cB, voffB); PG8_STAGE(PG8_SA(0, 0), cA, voffA); PG8_STAGE(PG8_SB(0, 1), cB + hstepB, voffB); PG8_STAGE(PG8_SA(0, 1), cA + hstepA, voffA);
        if (wr == 1) PG8_BAR;
        PG8_WAIT_V(4); PG8_BAR;
        PG8_STAGE(PG8_SB(1, 0), cB + kstep, voffB); PG8_STAGE(PG8_SA(1, 0), cA + kstep, voffA); PG8_STAGE(PG8_SB(1, 1), cB + hstepB + kstep, voffB);
        PG8_WAIT_V(6); PG8_BAR;
    }
    for (;;) {
        const bool has_next = S.next(ui + 1, nxt);
        const char* nA = has_next ? (const char*)g.A + (size_t)nxt.pm * tstepA : cA; const char* nB = has_next ? (const char*)g.Bt + (size_t)nxt.pn * tstepB : cB;
        for (int t = 0; t < nt; t += 2) {
            const bool last = (t == nt - 2);
            const char* a1 = cA + (size_t)(t + 1) * kstep;
            const char* a2 = last ? nA : cA + (size_t)(t + 2) * kstep; const char* b2 = last ? nB : cB + (size_t)(t + 2) * kstep;
            const char* a3 = a2 + kstep; const char* b3 = b2 + kstep;
            if (last && has_next) S.a_ready(nxt);
            if constexpr (SP2) {
            PG8_LDB(B0, 0, 0); PG8_LDB(B1, 0, 1); PG8_SCHED; PG8_LDA(At, 0, 0); PG8_STAGE(PG8_SA(1, 1), a1 + hstepA, voffA);
            PG8_WAIT_V(8); PG8_WAIT_L(0); PG8_BAR; PG8_MMA(0, 0, At, B0); PG8_MMA(0, 1, At, B1); PG8_BAR; PG8_SCHED;
            PG8_LDA(At, 0, 1); PG8_STAGE(PG8_SB(0, 0), b2, voffB); PG8_STAGE(PG8_SB(0, 1), b2 + hstepB, voffB); PG8_STAGE(PG8_SA(0, 0), a2, voffA);
            PG8_WAIT_V(8); PG8_WAIT_L(0); PG8_BAR; PG8_MMA(1, 0, At, B0); PG8_MMA(1, 1, At, B1); PG8_BAR; PG8_SCHED;
            PG8_LDB(B0, 1, 0); PG8_LDB(B1, 1, 1); PG8_SCHED; PG8_LDA(At, 1, 0); PG8_STAGE(PG8_SA(0, 1), a2 + hstepA, voffA);
            PG8_WAIT_V(8); PG8_WAIT_L(0); PG8_BAR; PG8_MMA(0, 0, At, B0); PG8_MMA(0, 1, At, B1); PG8_BAR; PG8_SCHED;
            PG8_LDA(At, 1, 1); PG8_STAGE(PG8_SB(1, 0), b3, voffB); PG8_STAGE(PG8_SB(1, 1), b3 + hstepB, voffB); PG8_STAGE(PG8_SA(1, 0), a3, voffA);
            PG8_WAIT_V(8); PG8_WAIT_L(0); PG8_BAR; PG8_MMA(1, 0, At, B0); PG8_MMA(1, 1, At, B1); PG8_BAR; PG8_SCHED;
            } else {
            PG8_LDB(B0, 0, 0); PG8_SCHED; PG8_LDA(At, 0, 0); PG8_STAGE(PG8_SA(1, 1), a1 + hstepA, voffA);
            PG8_WAIT_L(8); PG8_BAR; PG8_WAIT_L(0); PG8_MMA(0, 0, At, B0); PG8_BAR; PG8_SCHED;
            PG8_LDB(B1, 0, 1); PG8_STAGE(PG8_SB(0, 0), b2, voffB);
            PG8_BAR; PG8_WAIT_L(0); PG8_MMA(0, 1, At, B1); PG8_BAR;
            PG8_LDA(At, 0, 1); PG8_STAGE(PG8_SA(0, 0), a2, voffA);
            PG8_BAR; PG8_WAIT_L(0); PG8_MMA(1, 0, At, B0); PG8_BAR; PG8_SCHED;
            PG8_STAGE(PG8_SB(0, 1), b2 + hstepB, voffB);
            PG8_WAIT_V(6); PG8_BAR; PG8_MMA(1, 1, At, B1); PG8_BAR;
            PG8_LDB(B0, 1, 0); PG8_SCHED; PG8_LDA(At, 1, 0); PG8_STAGE(PG8_SA(0, 1), a2 + hstepA, voffA);
            PG8_WAIT_L(8); PG8_BAR; PG8_WAIT_L(0); PG8_MMA(0, 0, At, B0); PG8_BAR; PG8_SCHED;
            PG8_LDB(B1, 1, 1); PG8_STAGE(PG8_SB(1, 0), b3, voffB);
            PG8_BAR; PG8_WAIT_L(0); PG8_MMA(0, 1, At, B1); PG8_BAR;
            PG8_LDA(At, 1, 1); PG8_STAGE(PG8_SA(1, 0), a3, voffA);
            PG8_BAR; PG8_WAIT_L(0); PG8_MMA(1, 0, At, B0); PG8_BAR; PG8_SCHED;
            PG8_STAGE(PG8_SB(1, 1), b3 + hstepB, voffB);
            PG8_WAIT_V(6); PG8_BAR; PG8_MMA(1, 1, At, B1); PG8_BAR;
            }
        }
        if constexpr (ALIGN_EPI) { if (wr == 0) PG8_BAR; }
        if constexpr (!Epi::AFTER_DRAIN) { E(acc, cur, wr, wc, fr, fq); S.done(cur); }
        if (!has_next) break;
#pragma unroll
        for (int a = 0; a < 2; ++a)
#pragma unroll
            for (int b = 0; b < 2; ++b)
#pragma unroll
                for (int m = 0; m < 4; ++m)
#pragma unroll
                    for (int n = 0; n < 2; ++n) acc[a][b][m][n] = (f32x4){0.f, 0.f, 0.f, 0.f};
        cur = nxt; cA = nA; cB = nB; ++ui;
        if constexpr (ALIGN_EPI) { if (wr == 1) PG8_BAR; }
    }
    PG8_WAIT_V(0);
    if constexpr (!ALIGN_EPI) { if (wr == 0) PG8_BAR; }
    PG8_BAR;
    if constexpr (Epi::AFTER_DRAIN) { E.fused(acc, cur, wr, wc, fr, fq, lds, wid, lane); S.done(cur); }
#undef PG8_SA
#undef PG8_SB
#undef PG8_STAGE
#undef PG8_LDA
#undef PG8_LDB
#undef PG8_MMA
#undef PG8_WAIT_V
#undef PG8_WAIT_L
#undef PG8_BAR
#undef PG8_SCHED
}
}
#define GAS __attribute__((address_space(1)))
#define LAS __attribute__((address_space(3)))
typedef unsigned short bf16;
typedef unsigned v4u __attribute__((ext_vector_type(4)));
typedef float f32x4 __attribute__((ext_vector_type(4)));
typedef short bf16x8 __attribute__((ext_vector_type(8)));
typedef GAS unsigned gu32;
typedef GAS unsigned long long gu64;
#define RLX_AGENT __ATOMIC_RELAXED, __HIP_MEMORY_SCOPE_AGENT
#define LDS_WAIT() asm volatile("s_waitcnt lgkmcnt(0)" ::: "memory")
#define VM_WAIT() asm volatile("s_waitcnt vmcnt(0)" ::: "memory")
__device__ __forceinline__ unsigned long long rt() { return __builtin_amdgcn_s_memrealtime(); }
__device__ __forceinline__ unsigned f2bf(float f) { unsigned u = __builtin_bit_cast(unsigned, f); return (u + 0x7fffu + ((u >> 16) & 1u)) >> 16; }
__device__ __forceinline__ unsigned pk2(float lo, float hi) { return f2bf(lo) | (f2bf(hi) << 16); }

#define XB_TMO      128
#define XB_XCNT(j)  (256  + 64 * (j))
#define XB_XSUB(j)  (1280 + 64 * (j))
#define XB_XGEN(j)  (2304 + 64 * (j))
#define XB_TOP      3328
#define XB_TOPGEN   3392
#define XCD_BAR_WORDS 3456
#define XB_SPIN_CAP (1u << 24)

__device__ __forceinline__ unsigned xb_ld(unsigned* p)              { return __hip_atomic_load(p, __ATOMIC_RELAXED, __HIP_MEMORY_SCOPE_AGENT); }
__device__ __forceinline__ unsigned xb_add(unsigned* p, unsigned v) { return __hip_atomic_fetch_add(p, v, __ATOMIC_RELAXED, __HIP_MEMORY_SCOPE_AGENT); }
__device__ __forceinline__ unsigned xb_xcc_id() { return (unsigned)__builtin_amdgcn_s_getreg((3 << 11) | 20) & 0xFu; }
#define XB_SPIN(cond, bar) do { unsigned _sp = 0; while (cond) { __builtin_amdgcn_s_sleep(1); \
    if ((++_sp & 255u) == 0u) { if (xb_ld(&(bar)[XB_TMO])) break; if (_sp > XB_SPIN_CAP) { atomicAdd(&(bar)[XB_TMO], 1u); break; } } } } while (0)

struct XcdBarrier {
    unsigned* bar; unsigned x;
    volatile LAS unsigned* st;
};

__device__ __forceinline__ XcdBarrier xcd_barrier_post(unsigned* bar, volatile LAS unsigned* st) {
    XcdBarrier b; b.bar = bar; b.x = xb_xcc_id(); b.st = st;
    if (threadIdx.x == 0) (void)xb_add(&bar[XB_XCNT(b.x)], 1u);
    return b;
}
__device__ __forceinline__ void xcd_barrier_complete(unsigned* bar, unsigned x, unsigned& nloc, unsigned& nx) {
    const unsigned G = gridDim.x * gridDim.y * gridDim.z;
    unsigned sum, cnt, mine, sp = 0u;
    for (;;) {
        sum = 0u; cnt = 0u; mine = 0u;
#pragma unroll
        for (unsigned j = 0; j < 16; ++j) { const unsigned c = xb_ld(&bar[XB_XCNT(j)]); sum += c; cnt += (c > 0u) ? 1u : 0u; mine = (j == x) ? c : mine; }
        if (sum == G) break;
        __builtin_amdgcn_s_sleep(1);
        if ((++sp & 255u) == 0u) { if (xb_ld(&bar[XB_TMO])) break; if (sp > XB_SPIN_CAP) { atomicAdd(&bar[XB_TMO], 1u); break; } }
    }
    nloc = mine > 0u ? mine : 1u; nx = cnt > 0u ? cnt : 1u;
}

__device__ __forceinline__ void xcd_barrier(const XcdBarrier& b) {
    asm volatile("s_waitcnt vmcnt(0)" ::: "memory");
    __syncthreads();
    if (threadIdx.x == 0) {
        unsigned* bar = b.bar; asm volatile("" : "+s"(bar));
        __builtin_amdgcn_s_waitcnt(0);
        unsigned nloc = b.st[0], nx = b.st[1];
        if (nloc == 0u) { xcd_barrier_complete(bar, b.x, nloc, nx); b.st[0] = nloc; b.st[1] = nx; }
        const unsigned old = xb_add(&bar[XB_XSUB(b.x)], 1u);
        const unsigned gen = old / nloc;
        if (old + 1u == (gen + 1u) * nloc) {
            __builtin_amdgcn_fence(__ATOMIC_RELEASE, "agent");
            asm volatile("s_waitcnt vmcnt(0)" ::: "memory");
            const unsigned og = xb_add(&bar[XB_TOP], 1u);
            const unsigned tg = og / nx;
            if (og + 1u == (tg + 1u) * nx) xb_add(&bar[XB_TOPGEN], 1u);
            else XB_SPIN(xb_ld(&bar[XB_TOPGEN]) == tg, bar);
            __builtin_amdgcn_fence(__ATOMIC_ACQUIRE, "agent");
            xb_add(&bar[XB_XGEN(b.x)], 1u);
            asm volatile("s_waitcnt vmcnt(0)" ::: "memory");
        } else {
            XB_SPIN(xb_ld(&bar[XB_XGEN(b.x)]) == gen, bar);
            __builtin_amdgcn_fence(__ATOMIC_ACQUIRE, "agent");
            asm volatile("s_waitcnt vmcnt(0)" ::: "memory");
        }
    }
    __syncthreads();
}
constexpr int NWAVES = 8;
constexpr int BATCH = 8, T = 4096, D = 1024, M = BATCH * T, FF = 2816, NGU = 2 * FF, NINP = 2560, NIN_SRC = 2516, NL = 2;
constexpr float RMS_EPS = 1e-6f;
constexpr size_t MiB = 1u << 20;
constexpr size_t WS_CTL = 0, CTL_ZERO_BYTES = 1 * MiB;
constexpr size_t WS_CS64 = 1 * MiB;
constexpr size_t WS_CS32 = 2 * MiB;
constexpr size_t WS_ADA = 2 * MiB + 512 * 1024;
constexpr size_t WS_CMPB = 3 * MiB + 128 * 1024;
constexpr size_t WS_KMEAN = 3 * MiB + 256 * 1024;
constexpr size_t WS_RSTDQ = 3 * MiB + 512 * 1024;
constexpr size_t WS_RSTDKV = 3 * MiB + 768 * 1024;
constexpr size_t WS_KCMP = 4 * MiB;
constexpr size_t WS_VCMP = 4 * MiB + 512 * 1024;
constexpr size_t WS_CMPH = 5 * MiB;
constexpr size_t WS_WTS = 10 * MiB, WTS_LAYER = 46 * MiB;
constexpr size_t WO_GU1 = 0, WO_D1 = 11 * MiB, WO_GU2 = 17 * MiB, WO_D2 = 28 * MiB, WO_IN = 34 * MiB, WO_OUT = 39 * MiB, WO_UQ = 41 * MiB, WO_UKV = 41 * MiB + 512 * 1024, WO_C1K = 42 * MiB, WO_C1V = 43 * MiB;
constexpr size_t WS_XB = 104 * MiB;
constexpr size_t WS_BIG = 168 * MiB;
constexpr size_t WS_HID = WS_BIG;
constexpr size_t WS_QM_BF = 168 * MiB, WS_KM_BF = 184 * MiB, WS_VM_BF = 200 * MiB, WS_QM_F = 216 * MiB, WS_KM_F = 248 * MiB;
constexpr size_t WS_CQ = 280 * MiB, WS_CKV = 296 * MiB;
constexpr size_t WS_QN = 304 * MiB, WS_KC = 320 * MiB, WS_VC = 324 * MiB, WS_KS = 328 * MiB, WS_VS = 332 * MiB, WS_KW = 336 * MiB, WS_VW = 340 * MiB;
constexpr size_t WS_QD = 344 * MiB, WS_KD = 360 * MiB, WS_VD = 364 * MiB, WS_IQ = 368 * MiB, WS_IK = 400 * MiB, WS_GW = 404 * MiB;
constexpr size_t WS_QMLA = 408 * MiB, WS_KMLA = 432 * MiB, WS_VMLA = 456 * MiB;
constexpr size_t WS_DSAMASK = 472 * MiB;
constexpr size_t WS_OC = 488 * MiB;
constexpr size_t WS_KCMPB = 9 * MiB + 256 * 1024, WS_VCMPB = 9 * MiB + 512 * 1024;
constexpr size_t WS_NSEL = 9 * MiB;
constexpr size_t WS_END = 512 * MiB;
constexpr int CW_BAR = 4096;
constexpr int CW_WMAX = 8192;
constexpr float ACT_CLIP = 12.0f;
constexpr int RING_OFF = 0, RING_BYTES = 131072;
constexpr int LDSCTL_OFF = RING_BYTES, MISC_OFF = LDSCTL_OFF + 320;
constexpr int XTRA_OFF = 132096, XTRA_WAVE = 2112;
constexpr int LDS_BYTES = 155648;
static_assert(XTRA_OFF + NWAVES * XTRA_WAVE <= LDS_BYTES && MISC_OFF + 128 <= XTRA_OFF, "LDS map");

struct Args { const float* in[28]; float* out; unsigned char* ws; int ph_lo, ph_hi; };
struct Frame {
    LAS unsigned char* lds;
    volatile LAS unsigned* MISC;
    gu32* ctl;
    unsigned char* ws;
    int G;
    const Args* A;
    float* out;
};
enum { I_X = 0, I_C, I_ADAW, I_ADAB, I_F1N, I_F1G, I_F1U, I_F1D, I_MIXN, I_WIN, I_QNORM, I_WUQ, I_KVNORM, I_WUK, I_WUV, I_PEK, I_PEV, I_CK1, I_CK2, I_CV1, I_CV2, I_GN, I_WOUT, I_F2N, I_F2G, I_F2U, I_F2D, I_FINN };

__device__ __forceinline__ int opaque_v(int v) { asm volatile("" : "+v"(v)); return v; }
__device__ __forceinline__ int cur_tid() { return opaque_v((int)threadIdx.x); }
__device__ __forceinline__ int cur_lane() { return opaque_v((int)threadIdx.x) & 63; }
__device__ __forceinline__ int cur_wave() { return __builtin_amdgcn_readfirstlane(opaque_v((int)threadIdx.x) >> 6); }
template <int CTRL> __device__ __forceinline__ float dpp_f(float v) { return __int_as_float(__builtin_amdgcn_update_dpp(0, __float_as_int(v), CTRL, 0xf, 0xf, false)); }
__device__ __forceinline__ float wave_sum(float v) {
    v += dpp_f<0xB1>(v); v += dpp_f<0x4E>(v); v += dpp_f<0x141>(v); v += dpp_f<0x140>(v);
    const float r0 = __int_as_float(__builtin_amdgcn_readlane(__float_as_int(v), 0)), r1 = __int_as_float(__builtin_amdgcn_readlane(__float_as_int(v), 16));
    const float r2 = __int_as_float(__builtin_amdgcn_readlane(__float_as_int(v), 32)), r3 = __int_as_float(__builtin_amdgcn_readlane(__float_as_int(v), 48));
    return (r0 + r1) + (r2 + r3);
}
__device__ __forceinline__ float wave_max(float v) {
    v = fmaxf(v, dpp_f<0xB1>(v)); v = fmaxf(v, dpp_f<0x4E>(v)); v = fmaxf(v, dpp_f<0x141>(v)); v = fmaxf(v, dpp_f<0x140>(v));
    const float r0 = __int_as_float(__builtin_amdgcn_readlane(__float_as_int(v), 0)), r1 = __int_as_float(__builtin_amdgcn_readlane(__float_as_int(v), 16));
    const float r2 = __int_as_float(__builtin_amdgcn_readlane(__float_as_int(v), 32)), r3 = __int_as_float(__builtin_amdgcn_readlane(__float_as_int(v), 48));
    return fmaxf(fmaxf(r0, r1), fmaxf(r2, r3));
}
__device__ __forceinline__ float bf2f(unsigned short b) { return __uint_as_float((unsigned)b << 16); }
__device__ __forceinline__ void unpack8(const v4u w, float* f) {
    f[0] = __uint_as_float(w.x << 16); f[1] = __uint_as_float(w.x & 0xffff0000u); f[2] = __uint_as_float(w.y << 16); f[3] = __uint_as_float(w.y & 0xffff0000u);
    f[4] = __uint_as_float(w.z << 16); f[5] = __uint_as_float(w.z & 0xffff0000u); f[6] = __uint_as_float(w.w << 16); f[7] = __uint_as_float(w.w & 0xffff0000u);
}
__device__ __forceinline__ float sigmoid_f(float x) { return 1.0f / (1.0f + __expf(-x)); }

__device__ __forceinline__ int perm64(int j) { return 32 * ((j & 31) >> 4) + 16 * (j >> 5) + (j & 15); }
__device__ __forceinline__ int win_src_col(int c) {
    if (c < 512) return (c & ~63) + perm64(c & 63);
    if (c < 1184) return c;
    if (c < 1504) { const int r = c - 1184; return 1184 + (r & ~63) + perm64(r & 63); }
    if (c < 1568) return c;
    if (c < 1632) return 1568 + perm64(c - 1568);
    if (c < 1696) return c;
    if (c < 1760) return 1696 + perm64(c - 1696);
    if (c < 1824) return c;
    if (c < 2144) { const int r = c - 1824; return 1836 + (r & ~63) + perm64(r & 63); }
    if (c < 2208) return 2156 + (c - 2144);
    if (c < 2464) return 2220 + (c - 2208);
    if (c < 2496) return 2476 + (c - 2464);
    if (c < 2508) return 1824 + (c - 2496);
    if (c < 2516) return 2508 + (c - 2508);
    return -1;
}
constexpr int WK_K[8] = {1024, 2816, 1024, 2816, 1024, 1024, 256, 128};
constexpr int WK_N[8] = {5632, 1024, 5632, 1024, 2560, 1024, 512, 512};
__device__ __forceinline__ size_t wk_off(int kind) { return kind == 0 ? WO_GU1 : kind == 1 ? WO_D1 : kind == 2 ? WO_GU2 : kind == 3 ? WO_D2 : kind == 4 ? WO_IN : kind == 5 ? WO_OUT : kind == 6 ? WO_UQ : kind == 7 ? WO_UKV : kind == 8 ? WO_C1K : WO_C1V; }
__device__ __forceinline__ const float* wsrc(const Frame& F, int kind, int l, int R, int& stride) {
    switch (kind) {
    case 0: case 2: { const int G = R >> 5, w = R & 31, j = 16 * G + (w & 15); stride = FF;
        const float* g = F.A->in[kind == 0 ? I_F1G : I_F2G] + (size_t)l * D * FF; const float* u = F.A->in[kind == 0 ? I_F1U : I_F2U] + (size_t)l * D * FF; return ((w >> 4) ? u : g) + j; }
    case 1: case 3: stride = D; return F.A->in[kind == 1 ? I_F1D : I_F2D] + (size_t)l * FF * D + R;
    case 4: { stride = NIN_SRC; const int s = win_src_col(R); return s < 0 ? nullptr : F.A->in[I_WIN] + (size_t)l * D * NIN_SRC + s; }
    case 5: stride = D; return F.A->in[I_WOUT] + (size_t)l * D * D + R;
    case 6: stride = 384; return R < 384 ? F.A->in[I_WUQ] + (size_t)l * 256 * 384 + R : nullptr;
    case 7: stride = 256; return R < 256 ? F.A->in[I_WUK] + (size_t)l * 128 * 256 + R : F.A->in[I_WUV] + (size_t)l * 128 * 256 + (R - 256);
    default: stride = 256; return F.A->in[kind == 8 ? I_CK1 : I_CV1] + (size_t)l * 2048 * 256 + R;
    }
}

struct WinDesc {
    unsigned char* ws;
    __device__ __forceinline__ pg8::ProjDesc operator()(int G) const {
        pg8::ProjDesc d; d.kind = 0; d.dfreq0 = 0; d.nstride = 16; d.rep = 1; d.repstride = 0; d.bpitch = 0; d.fpitch = 0; d.pad = 0; d.bp = nullptr; d.fp = nullptr;
        const int c = 32 * G;
#define ROPE64(rel, BOFF, BP, FOFF, FP) do { const int hh_ = (rel) >> 6, g_ = ((rel) >> 5) & 1; d.kind = 2; d.dfreq0 = 16 * g_; d.nstride = 32; \
            d.bp = (bf16*)(ws + (BOFF)) + hh_ * 64 + 16 * g_; d.bpitch = (BP); if (FP) { d.fp = (float*)(ws + (FOFF)) + hh_ * 64 + 16 * g_; d.fpitch = (FP); } } while (0)
#define PLAINB(rel, BOFF, BP) do { d.kind = 1; d.bp = (bf16*)(ws + (BOFF)) + (rel); d.bpitch = (BP); } while (0)
#define PLAINF(rel, FOFF, FP) do { d.kind = 1; d.fp = (float*)(ws + (FOFF)) + (rel); d.fpitch = (FP); } while (0)
        if (c < 256) ROPE64(c, WS_QM_BF, 256, WS_QM_F, 256);
        else if (c < 512) ROPE64(c - 256, WS_KM_BF, 256, WS_KM_F, 256);
        else if (c < 768) PLAINB(c - 512, WS_VM_BF, 256);
        else if (c < 1024) PLAINB(c - 768, WS_CQ, 256);
        else if (c < 1152) PLAINB(c - 1024, WS_CKV, 128);
        else if (c < 1184) { d.kind = 3; d.nstride = 16; d.bp = (bf16*)(ws + WS_KMLA) + 64; d.bpitch = 384; d.rep = 4; d.repstride = 96; }
        else if (c < 1440) ROPE64(c - 1184, WS_QN, 256, 0, 0);
        else if (c < 1504) ROPE64(c - 1440, WS_KC, 64, 0, 0);
        else if (c < 1568) PLAINB(c - 1504, WS_VC, 64);
        else if (c < 1632) ROPE64(c - 1568, WS_KS, 64, 0, 0);
        else if (c < 1696) PLAINB(c - 1632, WS_VS, 64);
        else if (c < 1760) ROPE64(c - 1696, WS_KW, 64, 0, 0);
        else if (c < 1824) PLAINB(c - 1760, WS_VW, 64);
        else if (c < 2080) ROPE64(c - 1824, WS_QD, 256, 0, 0);
        else if (c < 2144) ROPE64(c - 2080, WS_KD, 64, 0, 0);
        else if (c < 2208) PLAINB(c - 2144, WS_VD, 64);
        else if (c < 2464) PLAINF(c - 2208, WS_IQ, 256);
        else if (c < 2496) { PLAINF(c - 2464, WS_IK, 32); d.pad = 1; }
        else if (c < 2528) PLAINF(c - 2496, WS_GW, 32);
#undef ROPE64
#undef PLAINB
#undef PLAINF
        return d;
    }
};
struct MlaQDesc {
    unsigned char* ws;
    __device__ __forceinline__ pg8::ProjDesc operator()(int G) const {
        pg8::ProjDesc d; d.kind = 0; d.dfreq0 = 0; d.nstride = 16; d.rep = 1; d.repstride = 0; d.bpitch = 384; d.fpitch = 0; d.pad = 0; d.bp = nullptr; d.fp = nullptr;
        if (G < 12) { const int hh = G / 3, part = G - 3 * hh; d.kind = (part == 2) ? 3 : 1; d.bp = (bf16*)(ws + WS_QMLA) + hh * 96 + 32 * part; }
        return d;
    }
};
struct MlaKvDesc {
    unsigned char* ws;
    __device__ __forceinline__ pg8::ProjDesc operator()(int G) const {
        pg8::ProjDesc d; d.kind = 1; d.dfreq0 = 0; d.nstride = 16; d.rep = 1; d.repstride = 0; d.bpitch = 0; d.fpitch = 0; d.pad = 0; d.bp = nullptr; d.fp = nullptr;
        const int c = 32 * G;
        if (c < 256) { d.bp = (bf16*)(ws + WS_KMLA) + (c >> 6) * 96 + (c & 63); d.bpitch = 384; }
        else { d.bp = (bf16*)(ws + WS_VMLA) + (c - 256); d.bpitch = 256; }
        return d;
    }
};

__device__ __forceinline__ void p0_prologue(Frame& F) {
    const int tid = cur_tid();
    const int wave = cur_wave(), gw = blockIdx.x * NWAVES + wave, NGW = F.G * NWAVES, lane = cur_lane();
    {
        LAS float* scr = (LAS float*)(F.lds + RING_OFF + wave * 16384);
        constexpr int PER_LAYER = 1280 + 512 + 64 + 32 + 256 + 256;
        for (int it = gw; it < NL * PER_LAYER; it += NGW) {
            const int l = it / PER_LAYER; int r = it - l * PER_LAYER; int kind = 4;
            { const int cnt[6] = {1280, 512, 64, 32, 256, 256};
#pragma unroll
              for (int q = 0; q < 5; ++q) { if (kind == q + 4 && r >= cnt[q]) { r -= cnt[q]; kind = q + 5; } } }
            const int K = kind == 0 || kind == 2 || kind == 4 || kind == 5 ? 1024 : (kind == 1 || kind == 3) ? 2816 : kind == 6 ? 256 : kind == 7 ? 128 : 2048;
            const int N = kind == 0 || kind == 2 ? 5632 : kind == 4 ? 2560 : (kind == 6 || kind == 7) ? 512 : kind >= 8 ? 256 : 1024;
            const int nblk = N / 32, kb = r / nblk, nb = r - kb * nblk, k0 = 64 * kb, n0 = 32 * nb;
            int stride; const float* colp = wsrc(F, kind, l, n0 + (lane & 31), stride);
            const float* ksc = kind == 6 ? F.A->in[I_QNORM] + l * 256 : kind == 7 ? F.A->in[I_KVNORM] + l * 128 : nullptr;
            bf16* WT = (bf16*)(F.ws + WS_WTS + (size_t)l * WTS_LAYER + wk_off(kind));
            float vv[32];
#pragma unroll
            for (int i = 0; i < 32; ++i) { const int kk = 2 * i + (lane >> 5); vv[i] = colp ? colp[(size_t)(k0 + kk) * stride] : 0.f; }
#pragma unroll
            for (int i = 0; i < 32; ++i) { const int kk = 2 * i + (lane >> 5); float v = vv[i]; if (ksc) v *= ksc[k0 + kk]; scr[kk * 33 + (lane & 31)] = v; }
            LDS_WAIT(); asm volatile("" ::: "memory");
            const int c = lane & 7;
#pragma unroll
            for (int j = 0; j < 4; ++j) { const int n = (lane >> 3) + 8 * j; const LAS float* s = scr + (8 * c) * 33 + n;
                v4u o; o.x = pk2(s[0 * 33], s[1 * 33]); o.y = pk2(s[2 * 33], s[3 * 33]); o.z = pk2(s[4 * 33], s[5 * 33]); o.w = pk2(s[6 * 33], s[7 * 33]);
                *(GAS v4u*)(WT + (size_t)(n0 + n) * K + k0 + 8 * c) = o; }
            LDS_WAIT(); asm volatile("" ::: "memory");
        }
    }
    {
        const int gtid = blockIdx.x * 512 + tid, NT = F.G * 512; constexpr int n4 = D * FF / 4;
#pragma unroll 1
        for (int cm = 0; cm < 12; ++cm) { const bool isd = cm >= 8; const int combo = isd ? cm - 8 : cm >> 1, l = combo >> 1, ff2 = combo & 1, up = cm & 1;
            const f32x4* p = (const f32x4*)(F.A->in[isd ? (ff2 ? I_F2D : I_F1D) : ff2 ? (up ? I_F2U : I_F2G) : (up ? I_F1U : I_F1G)] + (size_t)l * D * FF);
            f32x4 v[6];
#pragma unroll
            for (int q = 0; q < 6; ++q) { const int i = gtid + q * NT; v[q] = i < n4 ? p[i] : (f32x4){0.f, 0.f, 0.f, 0.f}; }
            float mx = 0.f;
#pragma unroll
            for (int q = 0; q < 6; ++q) mx = fmaxf(mx, fmaxf(fmaxf(fabsf(v[q].x), fabsf(v[q].y)), fmaxf(fabsf(v[q].z), fabsf(v[q].w))));
            for (int i = gtid + 6 * NT; i < n4; i += NT) { const f32x4 w = p[i]; mx = fmaxf(mx, fmaxf(fmaxf(fabsf(w.x), fabsf(w.y)), fmaxf(fabsf(w.z), fabsf(w.w)))); }
            mx = wave_max(mx);
            if (lane == 0) __hip_atomic_fetch_max((unsigned*)(F.ctl + CW_WMAX) + combo + (isd ? 4 : 0), __float_as_uint(mx), __ATOMIC_RELAXED, __HIP_MEMORY_SCOPE_AGENT); }
    }
    for (int i = blockIdx.x * 512 + tid; i < 4096 * 48; i += F.G * 512) {
        const int pos = i / 48, j = i - pos * 48;
        float invf; float* dst;
        if (j < 32) { invf = 1.0f / (float)pow(10000.0, (double)j / 32.0); dst = (float*)(F.ws + WS_CS64) + ((size_t)pos * 32 + j) * 2; }
        else { invf = 1.0f / (float)pow(10000.0, (double)(j - 32) / 16.0); dst = (float*)(F.ws + WS_CS32) + ((size_t)pos * 16 + (j - 32)) * 2; }
        const float ang = (float)pos * invf;
        dst[0] = (float)cos((double)ang); dst[1] = (float)sin((double)ang);
    }
    {
        LAS float* red = (LAS float*)(F.lds + RING_OFF + 8 * 16384 - 2048);
        for (int task = blockIdx.x; task < NL * 2 * 4; task += F.G) {
            const int l = task >> 3, kvq = task & 7, kv = kvq >> 2, j = (kvq & 3) * 64 + lane;
            const float* pe = F.A->in[kv ? I_PEV : I_PEK] + (size_t)l * 2048 + wave * 256; const float* w1 = F.A->in[kv ? I_CV1 : I_CK1] + (size_t)l * 2048 * 256 + (size_t)wave * 256 * 256 + j;
            float acc = 0.f;
#pragma unroll 32
            for (int k = 0; k < 256; ++k) acc += pe[k] * w1[(size_t)k * 256];
            __syncthreads();
            red[wave * 64 + lane] = acc;
            __syncthreads();
            if (wave == 0) { float s = 0.f;
#pragma unroll
                for (int w = 0; w < 8; ++w) s += red[w * 64 + lane];
                ((float*)(F.ws + WS_CMPB))[(l * 2 + kv) * 256 + j] = s; }
        }
    }
    {
        __syncthreads();
        LAS float* cact = (LAS float*)(F.lds + RING_OFF);
        LAS float* red = (LAS float*)(F.lds + RING_OFF + 32768);
        for (int i = tid; i < 8 * 1024; i += 512) { const float cv = F.A->in[I_C][i]; cact[i] = cv / (1.0f + __expf(-cv)); }
        __syncthreads();
        for (int task = blockIdx.x; task < NL * 144; task += F.G) {
            const int l = task / 144, n0 = (task - l * 144) * 64;
            const float* W = F.A->in[I_ADAW] + (size_t)l * 1024 * 9216 + n0 + lane;
            float acc[8];
#pragma unroll
            for (int b = 0; b < 8; ++b) acc[b] = 0.f;
            const int kbeg = wave * 128;
#pragma unroll 16
            for (int k = kbeg; k < kbeg + 128; ++k) { const float wv = W[(size_t)k * 9216];
#pragma unroll
                for (int b = 0; b < 8; ++b) acc[b] += cact[b * 1024 + k] * wv; }
#pragma unroll
            for (int b = 0; b < 8; ++b) red[(wave * 8 + b) * 64 + lane] = acc[b];
            __syncthreads();
            { const int b = wave; float s = F.A->in[I_ADAB][(size_t)l * 9216 + n0 + lane];
#pragma unroll
              for (int w = 0; w < 8; ++w) s += red[(w * 8 + b) * 64 + lane];
              ((float*)(F.ws + WS_ADA))[((size_t)l * 8 + b) * 9216 + n0 + lane] = s; }
            __syncthreads();
        }
    }
}

using pg8::q8pack4; using pg8::HID_CLIP;
__device__ __forceinline__ void wgu8_convert(Frame& F) {
    const int wave = cur_wave(), gw = blockIdx.x * NWAVES + wave, NGW = F.G * NWAVES, lane = cur_lane();
    LAS float* scr = (LAS float*)(F.lds + RING_OFF + wave * 16384);
    for (int it = gw; it < 4 * 2816 + 4 * 1408; it += NGW) {
        const bool isd = it >= 4 * 2816; const int r0 = isd ? it - 4 * 2816 : it, per = isd ? 1408 : 2816, nblk = isd ? 32 : 176, KB = isd ? 2816 : 1024;
        const int cmb = r0 / per, r = r0 - cmb * per, l = cmb >> 1, ff2 = cmb & 1, kind = (isd ? 1 : 0) + 2 * ff2, combo = cmb + (isd ? 4 : 0);
        const int kb = r / nblk, nb = r - kb * nblk, k0 = 64 * kb, n0 = 32 * nb;
        int stride; const float* colp = wsrc(F, kind, l, n0 + (lane & 31), stride);
        const float wmax = __uint_as_float(__hip_atomic_load((unsigned*)(F.ctl + CW_WMAX) + combo, __ATOMIC_RELAXED, __HIP_MEMORY_SCOPE_AGENT)), qs = wmax > 0.f ? 127.0f / wmax : 0.f;
        signed char* WT = (signed char*)(F.ws + WS_WTS + (size_t)l * WTS_LAYER + wk_off(kind));
        float vv[32];
#pragma unroll
        for (int i = 0; i < 32; ++i) { const int kk = 2 * i + (lane >> 5); vv[i] = colp[(size_t)(k0 + kk) * stride]; }
#pragma unroll
        for (int i = 0; i < 32; ++i) { const int kk = 2 * i + (lane >> 5); scr[kk * 33 + (lane & 31)] = vv[i]; }
        LDS_WAIT(); asm volatile("" ::: "memory");
#pragma unroll
        for (int q = 0; q < 2; ++q) { const int p = lane + 64 * q, n = p >> 2, c = p & 3; const LAS float* s = scr + (16 * c) * 33 + n;
            v4u o; o.x = q8pack4(s[0 * 33], s[1 * 33], s[2 * 33], s[3 * 33], qs); o.y = q8pack4(s[4 * 33], s[5 * 33], s[6 * 33], s[7 * 33], qs);
            o.z = q8pack4(s[8 * 33], s[9 * 33], s[10 * 33], s[11 * 33], qs); o.w = q8pack4(s[12 * 33], s[13 * 33], s[14 * 33], s[15 * 33], qs);
            *(GAS v4u*)(WT + (size_t)(n0 + n) * KB + k0 + 16 * c) = o; }
        LDS_WAIT(); asm volatile("" ::: "memory");
    }
}
template <bool XBF> __device__ __forceinline__ void load_row16(const void* xsrc, int row, int lane, f32x4 (&v)[4]) {
    if (XBF) { const unsigned long long* xr = (const unsigned long long*)((const bf16*)xsrc + (size_t)row * D) + lane;
#pragma unroll
        for (int j = 0; j < 4; ++j) { const unsigned long long w = xr[64 * j];
            v[j] = (f32x4){__uint_as_float((unsigned)w << 16), __uint_as_float((unsigned)w & 0xffff0000u), __uint_as_float((unsigned)(w >> 32) << 16), __uint_as_float((unsigned)(w >> 32) & 0xffff0000u)}; } }
    else { const f32x4* xr = (const f32x4*)((const float*)xsrc + (size_t)row * D) + lane;
#pragma unroll
        for (int j = 0; j < 4; ++j) v[j] = xr[64 * j]; }
}
template <bool XBF, bool Q8>
__device__ __forceinline__ void norm_mod_phase(Frame& F, const void* xsrc, const float* gain, const float* sh, const float* sc, bf16* hout) {
    const int wave = cur_wave(), gw = blockIdx.x * NWAVES + wave, NGW = F.G * NWAVES, lane = cur_lane();
    f32x4 g[4];
#pragma unroll
    for (int j = 0; j < 4; ++j) g[j] = *(const f32x4*)(gain + 4 * lane + 256 * j);
    for (int row0 = gw; row0 < M; row0 += 2 * NGW) {
        const int row1 = row0 + NGW; const bool has1 = row1 < M; const int r1 = has1 ? row1 : row0;
        f32x4 va[4], vb[4]; float sa = 0.f, sb = 0.f;
        load_row16<XBF>(xsrc, row0, lane, va); load_row16<XBF>(xsrc, r1, lane, vb);
#pragma unroll
        for (int j = 0; j < 4; ++j) { sa += (va[j].x * va[j].x + va[j].y * va[j].y) + (va[j].z * va[j].z + va[j].w * va[j].w); sb += (vb[j].x * vb[j].x + vb[j].y * vb[j].y) + (vb[j].z * vb[j].z + vb[j].w * vb[j].w); }
        const float rsa = 1.0f / sqrtf(wave_sum(sa) * (1.f / D) + RMS_EPS), rsb = 1.0f / sqrtf(wave_sum(sb) * (1.f / D) + RMS_EPS);
#pragma unroll
        for (int q = 0; q < 2; ++q) {
            if (q == 1 && !has1) break;
            const int row = q ? row1 : row0; const int b = row >> 12; const float rstd = q ? rsb : rsa;
            const float* shb = sh + (size_t)b * 9216 + 4 * lane; const float* scb = sc + (size_t)b * 9216 + 4 * lane;
            unsigned long long* o8 = (unsigned long long*)(hout + (size_t)row * D) + lane;
            unsigned* o4 = (unsigned*)((signed char*)hout + (size_t)row * D) + lane;
#pragma unroll
            for (int j = 0; j < 4; ++j) { const f32x4 s4 = *(const f32x4*)(shb + 256 * j), c4 = *(const f32x4*)(scb + 256 * j);
                const f32x4 y = (q ? vb[j] : va[j]) * rstd * g[j] * (c4 + 1.0f) + s4;
                if (Q8) o4[64 * j] = q8pack4(y.x, y.y, y.z, y.w, 127.0f / ACT_CLIP);
                else o8[64 * j] = (unsigned long long)pk2(y.x, y.y) | ((unsigned long long)pk2(y.z, y.w) << 32); }
        }
    }
}
__device__ __forceinline__ void final_norm_phase(Frame& F, const bf16* xb, float* out, const float* gain) {
    const int wave = cur_wave(), gw = blockIdx.x * NWAVES + wave, NGW = F.G * NWAVES, lane = cur_lane();
    f32x4 g[4];
#pragma unroll
    for (int j = 0; j < 4; ++j) g[j] = *(const f32x4*)(gain + 4 * lane + 256 * j);
    for (int row0 = gw; row0 < M; row0 += 2 * NGW) {
        const int row1 = row0 + NGW; const bool has1 = row1 < M; const int r1 = has1 ? row1 : row0;
        f32x4 va[4], vb[4]; float sa = 0.f, sb = 0.f;
        load_row16<true>(xb, row0, lane, va); load_row16<true>(xb, r1, lane, vb);
#pragma unroll
        for (int j = 0; j < 4; ++j) { sa += (va[j].x * va[j].x + va[j].y * va[j].y) + (va[j].z * va[j].z + va[j].w * va[j].w); sb += (vb[j].x * vb[j].x + vb[j].y * vb[j].y) + (vb[j].z * vb[j].z + vb[j].w * vb[j].w); }
        const float rsa = 1.0f / sqrtf(wave_sum(sa) * (1.f / D) + RMS_EPS), rsb = 1.0f / sqrtf(wave_sum(sb) * (1.f / D) + RMS_EPS);
        f32x4* xa = (f32x4*)(out + (size_t)row0 * D) + lane;
#pragma unroll
        for (int j = 0; j < 4; ++j) xa[64 * j] = va[j] * rsa * g[j];
        if (has1) { f32x4* xo = (f32x4*)(out + (size_t)row1 * D) + lane;
#pragma unroll
            for (int j = 0; j < 4; ++j) xo[64 * j] = vb[j] * rsb * g[j]; }
    }
}
__device__ __forceinline__ void group_norm_phase(Frame& F, bf16* Y, const float* gn) {
    const int wave = cur_wave(), gw = blockIdx.x * NWAVES + wave, NGW = F.G * NWAVES, lane = cur_lane();
    f32x4 g[4];
#pragma unroll
    for (int j = 0; j < 4; ++j) g[j] = *(const f32x4*)(gn + 256 * j + 4 * lane);
    for (int row0 = gw; row0 < M; row0 += 4 * NGW) {
        unsigned long long w[4][4];
#pragma unroll
        for (int q = 0; q < 4; ++q) { const int row = row0 + q * NGW < M ? row0 + q * NGW : row0; const unsigned long long* yr = (const unsigned long long*)(Y + (size_t)row * D) + lane;
#pragma unroll
            for (int j = 0; j < 4; ++j) w[q][j] = yr[64 * j]; }
#pragma unroll
        for (int q = 0; q < 4; ++q) {
            const int row = row0 + q * NGW; if (row >= M) break;
            unsigned long long* yr = (unsigned long long*)(Y + (size_t)row * D) + lane;
#pragma unroll
            for (int j = 0; j < 4; ++j) {
                const unsigned long long ww = w[q][j];
                const float a0 = __uint_as_float((unsigned)ww << 16), a1 = __uint_as_float((unsigned)ww & 0xffff0000u), a2 = __uint_as_float((unsigned)(ww >> 32) << 16), a3 = __uint_as_float((unsigned)(ww >> 32) & 0xffff0000u);
                const float ss = wave_sum((a0 * a0 + a1 * a1) + (a2 * a2 + a3 * a3));
                const float rstd = 1.0f / sqrtf(ss * (1.f / 256.f) + RMS_EPS);
                yr[64 * j] = (unsigned long long)pk2(a0 * rstd * g[j].x, a1 * rstd * g[j].y) | ((unsigned long long)pk2(a2 * rstd * g[j].z, a3 * rstd * g[j].w) << 32);
            }
        }
    }
}
__device__ __forceinline__ unsigned long long causal_word(int d) { return d >= 63 ? ~0ull : (d < 0 ? 0ull : ((2ull << d) - 1ull)); }
__device__ __forceinline__ int mbcnt64(unsigned long long m) { return (int)__builtin_amdgcn_mbcnt_hi((unsigned)(m >> 32), __builtin_amdgcn_mbcnt_lo((unsigned)m, 0u)); }
__device__ __forceinline__ unsigned fkey(float x) { const unsigned u = __float_as_uint(x); return (u & 0x80000000u) ? ~u : (u | 0x80000000u); }
__device__ __forceinline__ float reduce64(const float (&o)[64], int lane) {
    float r5[32], r4[16], r3[8], r2[4], r1[2];
    { const bool hi = (lane & 32) != 0;
#pragma unroll
      for (int i = 0; i < 32; ++i) { const float a = o[i], b = o[i + 32]; r5[i] = (hi ? b : a) + __shfl_xor(hi ? a : b, 32); } }
    { const bool hi = (lane & 16) != 0;
#pragma unroll
      for (int i = 0; i < 16; ++i) { const float a = r5[i], b = r5[i + 16]; r4[i] = (hi ? b : a) + __shfl_xor(hi ? a : b, 16); } }
    { const bool hi = (lane & 8) != 0;
#pragma unroll
      for (int i = 0; i < 8; ++i) { const float a = r4[i], b = r4[i + 8]; r3[i] = (hi ? b : a) + __shfl_xor(hi ? a : b, 8); } }
    { const bool hi = (lane & 4) != 0;
#pragma unroll
      for (int i = 0; i < 4; ++i) { const float a = r3[i], b = r3[i + 4]; r2[i] = (hi ? b : a) + __shfl_xor(hi ? a : b, 4); } }
    { const bool hi = (lane & 2) != 0;
#pragma unroll
      for (int i = 0; i < 2; ++i) { const float a = r2[i], b = r2[i + 2]; r1[i] = (hi ? b : a) + __shfl_xor(hi ? a : b, 2); } }
    const bool hi = (lane & 1) != 0;
    return (hi ? r1[1] : r1[0]) + __shfl_xor(hi ? r1[0] : r1[1], 1);
}
struct KVbf {
    const bf16* K; const bf16* V; int kp, vp;
    template <int DQ> __device__ __forceinline__ float dot(int row, const LAS float* q) const {
        const v4u* p = (const v4u*)(K + (size_t)row * kp); float s = 0.f;
#pragma unroll
        for (int c = 0; c < DQ / 8; ++c) { float f[8]; unpack8(p[c], f); const f32x4 q0 = *(const LAS f32x4*)(q + 8 * c), q1 = *(const LAS f32x4*)(q + 8 * c + 4);
            s += (q0.x * f[0] + q0.y * f[1]) + (q0.z * f[2] + q0.w * f[3]) + (q1.x * f[4] + q1.y * f[5]) + (q1.z * f[6] + q1.w * f[7]); }
        return s;
    }
    __device__ __forceinline__ void axpy(int row, float pw, float (&o)[64]) const {
        const v4u* p = (const v4u*)(V + (size_t)row * vp);
#pragma unroll
        for (int c = 0; c < 8; ++c) { float f[8]; unpack8(p[c], f);
#pragma unroll
            for (int e = 0; e < 8; ++e) o[8 * c + e] += pw * f[e]; }
    }
};
struct KVf32 {
    const float* K; const float* V; int kp, vp;
    template <int DQ> __device__ __forceinline__ float dot(int row, const LAS float* q) const {
        const f32x4* p = (const f32x4*)(K + (size_t)row * kp); float s = 0.f;
#pragma unroll
        for (int c = 0; c < DQ / 4; ++c) { const f32x4 f = p[c]; const f32x4 qv = *(const LAS f32x4*)(q + 4 * c); s += (qv.x * f.x + qv.y * f.y) + (qv.z * f.z + qv.w * f.w); }
        return s;
    }
    __device__ __forceinline__ void axpy(int row, float pw, float (&o)[64]) const {
        const f32x4* p = (const f32x4*)(V + (size_t)row * vp);
#pragma unroll
        for (int c = 0; c < 16; ++c) { const f32x4 f = p[c]; o[4 * c] += pw * f.x; o[4 * c + 1] += pw * f.y; o[4 * c + 2] += pw * f.z; o[4 * c + 3] += pw * f.w; }
    }
};
template <int DQ, class KV, class KeyFn>
__device__ __forceinline__ float wave_attend(const LAS float* q, float scale, int nslots, const KeyFn& keyf, const KV& kv, int lane) {
    float m = -INFINITY;
    for (int s = 0; s < nslots; ++s) { const int key = keyf(s); if (key >= 0) m = fmaxf(m, kv.template dot<DQ>(key, q) * scale); }
    const float Mx = wave_max(m);
    float o[64];
#pragma unroll
    for (int d = 0; d < 64; ++d) o[d] = 0.f;
    float l = 0.f;
    if (Mx > -INFINITY) {
        for (int s = 0; s < nslots; ++s) { const int key = keyf(s);
            if (key >= 0) { const float p = __expf(kv.template dot<DQ>(key, q) * scale - Mx); l += p; kv.axpy(key, p, o); } }
    }
    l = wave_sum(l);
    const float r = reduce64(o, lane);
    return l > 0.f ? r / l : 0.f;
}
__device__ __forceinline__ void task_bt(int i, int& t, int& rest) { const int tt = i & 2047, j = i >> 11; t = (j & 1) ? 4095 - tt : tt; rest = j >> 1; }

__device__ __forceinline__ void m1_phase(Frame& F, int l) {
    const int wave = cur_wave(), gw = blockIdx.x * NWAVES + wave, NGW = F.G * NWAVES, lane = cur_lane();
    const bf16* CQ = (const bf16*)(F.ws + WS_CQ); const bf16* CKV = (const bf16*)(F.ws + WS_CKV);
    float* rq = (float*)(F.ws + WS_RSTDQ); float* rkv = (float*)(F.ws + WS_RSTDKV);
    for (int row0 = gw; row0 < M; row0 += 4 * NGW) {
        unsigned long long wq[4]; unsigned wk[4];
#pragma unroll
        for (int q = 0; q < 4; ++q) { const int row = row0 + q * NGW < M ? row0 + q * NGW : row0; wq[q] = ((const unsigned long long*)(CQ + (size_t)row * 256))[lane]; wk[q] = ((const unsigned*)(CKV + (size_t)row * 128))[lane]; }
#pragma unroll
        for (int q = 0; q < 4; ++q) {
            const int row = row0 + q * NGW; if (row >= M) break;
            const unsigned long long w = wq[q];
            const float a0 = __uint_as_float((unsigned)w << 16), a1 = __uint_as_float((unsigned)w & 0xffff0000u), a2 = __uint_as_float((unsigned)(w >> 32) << 16), a3 = __uint_as_float((unsigned)(w >> 32) & 0xffff0000u);
            const float s1 = wave_sum((a0 * a0 + a1 * a1) + (a2 * a2 + a3 * a3));
            const float b0 = __uint_as_float(wk[q] << 16), b1 = __uint_as_float(wk[q] & 0xffff0000u);
            const float s2 = wave_sum(b0 * b0 + b1 * b1);
            if (lane == 0) { rq[row] = 1.0f / sqrtf(s1 * (1.f / 256.f) + RMS_EPS); rkv[row] = 1.0f / sqrtf(s2 * (1.f / 128.f) + RMS_EPS); }
        }
    }
    const float* KMF = (const float*)(F.ws + WS_KM_F); float* kmean = (float*)(F.ws + WS_KMEAN);
    for (int task = gw; task < 512; task += NGW) {
        const int b = task >> 6, blk = (task >> 2) & 15, h = task & 3;
        const float* p = KMF + ((size_t)(b * T + blk * 256)) * 256 + h * 64 + lane; float s = 0.f;
#pragma unroll 32
        for (int i = 0; i < 256; ++i) s += p[(size_t)i * 256];
        kmean[((b * 4 + h) * 16 + blk) * 64 + lane] = s * (1.f / 256.f);
    }
}
__device__ __forceinline__ void cmp2_phase(Frame& F, int l) {
    const int wave = cur_wave(), gw = blockIdx.x * NWAVES + wave, NGW = F.G * NWAVES, lane = cur_lane();
    const float* cmph = (const float*)(F.ws + WS_CMPH);
    for (int task = gw; task < 2 * 8 * 255; task += NGW) {
        const int kv = task / 2040, r1 = task - kv * 2040, b = r1 / 255, n = r1 - b * 255;
        const float* hp = cmph + ((size_t)(kv * 8 + b) * 256 + n) * 256;
        const float* w2 = F.A->in[kv ? I_CV2 : I_CK2] + (size_t)l * 256 * 64 + lane;
        float acc = 0.f;
#pragma unroll 32
        for (int j = 0; j < 256; ++j) acc += hp[j] * w2[j * 64];
        ((float*)(F.ws + (kv ? WS_VCMP : WS_KCMP)))[((size_t)b * 256 + n) * 64 + lane] = acc;
        ((bf16*)(F.ws + (kv ? WS_VCMPB : WS_KCMPB)))[((size_t)b * 256 + n) * 64 + lane] = (bf16)f2bf(acc);
    }
    for (int task = gw; task < 16; task += NGW) ((bf16*)(F.ws + ((task & 1) ? WS_VCMPB : WS_KCMPB)))[((size_t)(task >> 1) * 256 + 255) * 64 + lane] = 0;
}
__device__ __forceinline__ void mla_rows_phase(Frame& F) {
    const int wave = cur_wave(), gw = blockIdx.x * NWAVES + wave, NGW = F.G * NWAVES, lane = cur_lane();
    const bf16* Q = (const bf16*)(F.ws + WS_QMLA); bf16* Y = (bf16*)F.out + (size_t)M * D;
    LAS float* q = (LAS float*)(F.lds + RING_OFF + wave * 16384 + 4096);
    for (int i = gw; i < M * 4; i += NGW) {
        int t, bh; task_bt(i, t, bh); const int b = bh >> 2, h = bh & 3, row = b * T + t;
        if (lane < 48) { const unsigned w = ((const unsigned*)(Q + (size_t)row * 384 + h * 96))[lane]; q[2 * lane] = __uint_as_float(w << 16); q[2 * lane + 1] = __uint_as_float(w & 0xffff0000u); }
        LDS_WAIT(); asm volatile("" ::: "memory");
        KVbf kv{(const bf16*)(F.ws + WS_KMLA) + h * 96, (const bf16*)(F.ws + WS_VMLA) + h * 64, 384, 256};
        const int base = b * T;
        auto keyf = [&](int s) { const int p = lane + 64 * s; return p <= t ? base + p : -1; };
        const float r = wave_attend<96>(q, 0.10206207261596577f, (t >> 6) + 1, keyf, kv, lane);
        Y[(size_t)row * 1024 + 256 + h * 64 + lane] = (bf16)f2bf(r);
        LDS_WAIT(); asm volatile("" ::: "memory");
    }
}
__device__ __forceinline__ void moba_rows_phase(Frame& F) {
    const int wave = cur_wave(), gw = blockIdx.x * NWAVES + wave, NGW = F.G * NWAVES, lane = cur_lane();
    const float* QF = (const float*)(F.ws + WS_QM_F); const float* kmean = (const float*)(F.ws + WS_KMEAN); bf16* Y = (bf16*)F.out + (size_t)M * D;
    LAS float* q = (LAS float*)(F.lds + RING_OFF + wave * 16384 + 4096);
    for (int i = gw; i < M * 4; i += NGW) {
        int t, bh; task_bt(i, t, bh); const int b = bh >> 2, h = bh & 3, row = b * T + t, own = t >> 8;
        q[lane] = QF[(size_t)row * 256 + h * 64 + lane];
        LDS_WAIT(); asm volatile("" ::: "memory");
        float g = -INFINITY;
        if (lane < own) { KVf32 km{kmean + (size_t)((b * 4 + h) * 16) * 64, nullptr, 64, 64}; g = km.dot<64>(lane, q); }
        unsigned selmask = 0u;
        for (int r = 0; r < 3; ++r) { const float mx = wave_max(g); if (!(mx > -INFINITY)) break;
            const unsigned long long ball = __ballot(g == mx); const int sl = __ffsll((long long)ball) - 1; selmask |= 1u << sl; if (lane == sl) g = -INFINITY; }
        KVbf kv{(const bf16*)(F.ws + WS_KM_BF) + h * 64, (const bf16*)(F.ws + WS_VM_BF) + h * 64, 256, 256};
        const int base = b * T;
        auto keyf = [&](int s) { const int blk = s >> 2, p = 64 * s + lane; return blk == own ? (p <= t ? base + p : -1) : (((selmask >> blk) & 1u) ? base + p : -1); };
        const float r = wave_attend<64>(q, 0.125f, 4 * own + 4, keyf, kv, lane);
        Y[(size_t)row * 1024 + h * 64 + lane] = (bf16)f2bf(r);
        LDS_WAIT(); asm volatile("" ::: "memory");
    }
}
__device__ __forceinline__ void nsa_tokens_phase(Frame& F) {
    const int wave = cur_wave(), gw = blockIdx.x * NWAVES + wave, NGW = F.G * NWAVES, lane = cur_lane();
    const bf16* QN = (const bf16*)(F.ws + WS_QN); bf16* Y = (bf16*)F.out + (size_t)M * D;
    const float* kcmp = (const float*)(F.ws + WS_KCMP); const float* vcmp = (const float*)(F.ws + WS_VCMP); const float* GWp = (const float*)(F.ws + WS_GW);
    LAS float* ps = (LAS float*)(F.lds + RING_OFF + wave * 16384);
    LAS float* ocs = ps + 256;
    LAS float* svl = ps + 512;
    LAS float* q = (LAS float*)(F.lds + RING_OFF + wave * 16384 + 4096);
    for (int i = gw; i < M; i += NGW) {
        int t, b; task_bt(i, t, b); const int row = b * T + t, own = t >> 6, base = b * T;
#pragma unroll
        for (int k = 0; k < 4; ++k) ps[lane + 64 * k] = 0.f;
#pragma unroll 1
        for (int h = 0; h < 4; ++h) {
            LDS_WAIT(); asm volatile("" ::: "memory");
            q[lane] = bf2f(QN[(size_t)row * 256 + h * 64 + lane]);
            LDS_WAIT(); asm volatile("" ::: "memory");
            KVf32 kc{kcmp + (size_t)b * 256 * 64, vcmp + (size_t)b * 256 * 64, 64, 64};
            float ml = -INFINITY;
#pragma unroll 1
            for (int k = 0; k < 4; ++k) { const int n = lane + 64 * k; const bool valid = (n < 255) && (16 * n + 31 <= t);
                float sv = -INFINITY; if (valid) sv = kc.dot<64>(n, q) * 0.125f; svl[n] = sv; ml = fmaxf(ml, sv); }
            const float Mx = wave_max(ml);
            float o[64];
#pragma unroll
            for (int d = 0; d < 64; ++d) o[d] = 0.f;
#ifndef NSA_NO_C
            if (Mx > -INFINITY) {
                float ls = 0.f;
#pragma unroll 1
                for (int k = 0; k < 4; ++k) { const float sv = svl[lane + 64 * k]; const float p = sv > -INFINITY ? __expf(sv - Mx) : 0.f; ls += p; svl[lane + 64 * k] = p; }
                const float inv = 1.0f / wave_sum(ls);
#pragma unroll 1
                for (int k = 0; k < 4; ++k) { const float p = svl[lane + 64 * k] * inv; ps[lane + 64 * k] += p; if (p > 0.f) kc.axpy(lane + 64 * k, p, o); }
            }
#endif
            ocs[h * 64 + lane] = reduce64(o, lane);
        }
        LDS_WAIT(); asm volatile("" ::: "memory");
        float imp = (ps[4 * lane] + ps[4 * lane + 1]) + (ps[4 * lane + 2] + ps[4 * lane + 3]); if (lane > 0) imp += ps[4 * lane - 1];
        LDS_WAIT(); asm volatile("" ::: "memory");
        const bool causal = lane <= own, forced = causal && (lane == 0 || lane >= own - 1);
        float val = forced ? 1e4f : (causal ? imp : -INFINITY);
        unsigned long long selmask = 0ull;
        for (int r = 0; r < 16; ++r) { const float mx = wave_max(val); if (!(mx > -INFINITY)) break;
            const unsigned long long ball = __ballot(val == mx); const int sl = __ffsll((long long)ball) - 1; selmask |= 1ull << sl; if (lane == sl) val = -INFINITY; }
#ifdef FLASH_NSA
        if (lane == 0) ((unsigned long long*)(F.ws + WS_NSEL))[row] = selmask;
#pragma unroll
        for (int h = 0; h < 4; ++h) ((bf16*)(F.ws + WS_OC))[(size_t)row * 256 + h * 64 + lane] = (bf16)f2bf(ocs[h * 64 + lane]);
        LDS_WAIT(); asm volatile("" ::: "memory");
        continue;
#endif
#pragma unroll 1
        for (int h = 0; h < 4; ++h) {
            LDS_WAIT(); asm volatile("" ::: "memory");
            q[lane] = bf2f(QN[(size_t)row * 256 + h * 64 + lane]);
            LDS_WAIT(); asm volatile("" ::: "memory");
            KVbf ks{(const bf16*)(F.ws + WS_KS), (const bf16*)(F.ws + WS_VS), 64, 64};
            auto keys = [&](int s) { const int p = 64 * s + lane; return (((selmask >> s) & 1ull) && p <= t) ? base + p : -1; };
#ifdef NSA_NO_S
            float os = q[3];
#else
            float os = wave_attend<64>(q, 0.125f, own + 1, keys, ks, lane);
            asm volatile("" : "+v"(os) :: "memory");
#endif
            KVbf kw{(const bf16*)(F.ws + WS_KW), (const bf16*)(F.ws + WS_VW), 64, 64};
            auto keyw = [&](int s) { const int p = t - 511 + lane + 64 * s; return p >= 0 ? base + p : -1; };
#ifdef NSA_NO_W
            float ow = q[5];
#else
            float ow = wave_attend<64>(q, 0.125f, 8, keyw, kw, lane);
            asm volatile("" : "+v"(ow) :: "memory");
#endif
            const float* gp = GWp + (size_t)row * 32 + h * 3;
            const float g0 = sigmoid_f(gp[0]), g1 = sigmoid_f(gp[1]), g2 = sigmoid_f(gp[2]);
            Y[(size_t)row * 1024 + 512 + h * 64 + lane] = (bf16)f2bf(g0 * ocs[h * 64 + lane] + g1 * os + g2 * ow);
        }
    }
}
__device__ __forceinline__ void dsa_tokens_phase(Frame& F) {
    const int wave = cur_wave(), gw = blockIdx.x * NWAVES + wave, NGW = F.G * NWAVES, lane = cur_lane();
    const float* IQ = (const float*)(F.ws + WS_IQ); const float* IK = (const float*)(F.ws + WS_IK); const float* GWp = (const float*)(F.ws + WS_GW);
    const bf16* QD = (const bf16*)(F.ws + WS_QD); bf16* Y = (bf16*)F.out + (size_t)M * D;
    LAS float* sc = (LAS float*)(F.lds + RING_OFF + wave * 16384);
    LAS unsigned* hist = (LAS unsigned*)(F.lds + XTRA_OFF + wave * XTRA_WAVE);
    LAS unsigned short* idx = (LAS unsigned short*)hist;
    LAS float* xq = (LAS float*)(F.lds + XTRA_OFF + wave * XTRA_WAVE + 1024);
    for (int i = gw; i < M; i += NGW) {
        int t, b; task_bt(i, t, b); const int row = b * T + t, base = b * T, n = t + 1;
#pragma unroll
        for (int k = 0; k < 4; ++k) xq[lane + 64 * k] = IQ[(size_t)row * 256 + lane + 64 * k];
        if (lane < 8) xq[256 + lane] = GWp[(size_t)row * 32 + 12 + lane];
        LDS_WAIT(); asm volatile("" ::: "memory");
        for (int k0 = 0; k0 < n; k0 += 64) {
            const int key = k0 + lane;
            if (key < n) {
                float ik[32];
                { const f32x4* kp = (const f32x4*)(IK + (size_t)(base + key) * 32);
#pragma unroll
                  for (int c = 0; c < 8; ++c) { const f32x4 f = kp[c]; ik[4 * c] = f.x; ik[4 * c + 1] = f.y; ik[4 * c + 2] = f.z; ik[4 * c + 3] = f.w; } }
                float score = 0.f;
#pragma unroll
                for (int h = 0; h < 8; ++h) { float ds = 0.f;
#pragma unroll
                    for (int c = 0; c < 8; ++c) { const f32x4 qv = *(const LAS f32x4*)(xq + h * 32 + 4 * c); ds += (qv.x * ik[4 * c] + qv.y * ik[4 * c + 1]) + (qv.z * ik[4 * c + 2] + qv.w * ik[4 * c + 3]); }
                    score += xq[256 + h] * fmaxf(ds, 0.f); }
                sc[key] = score * 0.0625f + 0.0f;
            }
        }
        LDS_WAIT(); asm volatile("" ::: "memory");
        int nsel = n;
        if (n > 256) {
            unsigned prefix = 0u, pmask = 0u; int kk = 256;
            for (int pass = 0; pass < 4; ++pass) {
                const int shift = 24 - 8 * pass;
#pragma unroll
                for (int k = 0; k < 4; ++k) hist[lane + 64 * k] = 0u;
                LDS_WAIT(); asm volatile("" ::: "memory");
                for (int k0 = 0; k0 < n; k0 += 64) { const int key = k0 + lane;
                    if (key < n) { const unsigned u = fkey(sc[key]); if ((u & pmask) == prefix) __hip_atomic_fetch_add(hist + ((u >> shift) & 255u), 1u, __ATOMIC_RELAXED, __HIP_MEMORY_SCOPE_WORKGROUP); } }
                LDS_WAIT(); asm volatile("" ::: "memory");
                const int h0 = (int)hist[4 * lane], h1 = (int)hist[4 * lane + 1], h2 = (int)hist[4 * lane + 2], h3 = (int)hist[4 * lane + 3];
                const int tot = (h0 + h1) + (h2 + h3); int incl = tot;
#pragma unroll
                for (int o = 1; o < 64; o <<= 1) { const int v = __shfl_down(incl, o); if (lane + o < 64) incl += v; }
                int run = incl - tot, found = -1, newk = 0;
                if (run < kk && run + h3 >= kk) { found = 4 * lane + 3; newk = kk - run; } run += h3;
                if (found < 0 && run < kk && run + h2 >= kk) { found = 4 * lane + 2; newk = kk - run; } run += h2;
                if (found < 0 && run < kk && run + h1 >= kk) { found = 4 * lane + 1; newk = kk - run; } run += h1;
                if (found < 0 && run < kk && run + h0 >= kk) { found = 4 * lane; newk = kk - run; }
                const unsigned long long ball = __ballot(found >= 0); const int src = __ffsll((long long)ball) - 1;
                const int bin = __shfl(found, src); kk = __shfl(newk, src);
                prefix |= (unsigned)bin << shift; pmask |= 255u << shift;
                LDS_WAIT(); asm volatile("" ::: "memory");
            }
            int eqseen = 0, cnt = 0;
            for (int k0 = 0; k0 < n; k0 += 64) { const int key = k0 + lane; const bool inb = key < n; const unsigned u = inb ? fkey(sc[key]) : 0u;
                const bool gt = inb && u > prefix, eq = inb && u == prefix;
                const unsigned long long be = __ballot(eq); const bool sel = gt || (eq && (eqseen + mbcnt64(be)) < kk);
                const unsigned long long bs = __ballot(sel); if (sel) idx[cnt + mbcnt64(bs)] = (unsigned short)key;
#ifdef FLASH_DSA
                if (lane == 0) ((unsigned long long*)(F.ws + WS_DSAMASK))[(size_t)row * 64 + (k0 >> 6)] = bs;
#endif
                eqseen += __popcll(be); cnt += __popcll(bs); }
            nsel = cnt;
            LDS_WAIT(); asm volatile("" ::: "memory");
        }
#ifdef FLASH_DSA
        if (n <= 256) { for (int k0 = 0; k0 < n; k0 += 64) if (lane == 0) ((unsigned long long*)(F.ws + WS_DSAMASK))[(size_t)row * 64 + (k0 >> 6)] = causal_word(t - k0); }
        continue;
#endif
        int kidx[4];
#pragma unroll
        for (int k = 0; k < 4; ++k) { const int p = lane + 64 * k; kidx[k] = p < nsel ? base + (n > 256 ? (int)idx[p] : p) : -1; }
        LDS_WAIT(); asm volatile("" ::: "memory");
#pragma unroll 1
        for (int h = 0; h < 4; ++h) {
            LDS_WAIT(); asm volatile("" ::: "memory");
            xq[lane] = bf2f(QD[(size_t)row * 256 + h * 64 + lane]);
            LDS_WAIT(); asm volatile("" ::: "memory");
            KVbf kd{(const bf16*)(F.ws + WS_KD), (const bf16*)(F.ws + WS_VD), 64, 64};
            auto keyf = [&](int s) { return s == 0 ? kidx[0] : s == 1 ? kidx[1] : s == 2 ? kidx[2] : kidx[3]; };
            const float r = wave_attend<64>(xq, 0.125f, 4, keyf, kd, lane);
            Y[(size_t)row * 1024 + 768 + h * 64 + lane] = (bf16)f2bf(r);
        }
        LDS_WAIT(); asm volatile("" ::: "memory");
    }
}
typedef float f32x16 __attribute__((ext_vector_type(16)));
__device__ __forceinline__ float xhalf_max(float v) { const auto rr = __builtin_amdgcn_permlane32_swap(__float_as_uint(v), __float_as_uint(v), false, false); return fmaxf(__uint_as_float(rr[0]), __uint_as_float(rr[1])); }
__device__ __forceinline__ float xhalf_sum(float v) { const auto rr = __builtin_amdgcn_permlane32_swap(__float_as_uint(v), __float_as_uint(v), false, false); return __uint_as_float(rr[0]) + __uint_as_float(rr[1]); }
__device__ __forceinline__ float xhalf_other(float v, int hh) { const auto rr = __builtin_amdgcn_permlane32_swap(__float_as_uint(v), __float_as_uint(v), false, false); return __uint_as_float(hh ? rr[0] : rr[1]); }
constexpr int FL_KP96 = 208, FL_KP64 = 144, FL_VP = 144;
constexpr int FL_KBUF = 0, FL_KBUF_SZ = 64 * FL_KP96, FL_VBUF = 2 * FL_KBUF_SZ, FL_VBUF_SZ = 64 * FL_VP;
constexpr int FL_TL = FL_VBUF + 2 * FL_VBUF_SZ, FL_TLN = FL_TL + 64, FL_ORM = FL_TLN + 8, FL_SEL = FL_TL + 128;
constexpr int FL_END = FL_SEL + 512;
static_assert(FL_END <= RING_BYTES, "flash LDS map");
struct FlashKV { const bf16* K; const bf16* V; int kp, vp; };


template <int MODE>
__device__ __forceinline__ void fl_softmax(f32x16& p0, f32x16& p1, const unsigned long long word, const int h, const float sc2, float& m, float& lsum, f32x16& o0, f32x16& o1) {
    if (MODE == 2) {
        const unsigned wlo = (unsigned)word >> (4 * h), whi = (unsigned)(word >> 32) >> (4 * h);
#pragma unroll
        for (int i = 0; i < 16; ++i) { const int bit = (i & 3) + 8 * (i >> 2);
            p0[i] = (wlo & (1u << bit)) ? p0[i] : -INFINITY; p1[i] = (whi & (1u << bit)) ? p1[i] : -INFINITY; }
    }
    float mx, mx2;
    asm("v_max3_f32 %0, %1, %2, %3" : "=v"(mx) : "v"(p0[0]), "v"(p0[1]), "v"(p0[2]));
    asm("v_max3_f32 %0, %1, %2, %3" : "=v"(mx2) : "v"(p1[0]), "v"(p1[1]), "v"(p1[2]));
#pragma unroll
    for (int i = 3; i < 15; i += 2) { asm("v_max3_f32 %0, %1, %2, %3" : "=v"(mx) : "v"(mx), "v"(p0[i]), "v"(p0[i + 1])); asm("v_max3_f32 %0, %1, %2, %3" : "=v"(mx2) : "v"(mx2), "v"(p1[i]), "v"(p1[i + 1])); }
    asm("v_max3_f32 %0, %1, %2, %3" : "=v"(mx) : "v"(mx), "v"(p0[15]), "v"(p1[15]));
    asm("v_max_f32_e32 %0, %1, %2" : "=v"(mx) : "v"(mx), "v"(mx2));
    const bool rowon = (MODE != 1) || (word != 0ull);
    if (MODE == 1) mx = rowon ? mx : -INFINITY;
    mx = xhalf_max(mx);
    const float mn = fmaxf(m, mx * sc2);
    if (__any(mn > m)) { const float alpha = __builtin_amdgcn_exp2f(m - mn); lsum *= alpha;
#pragma unroll
        for (int i = 0; i < 16; ++i) { o0[i] *= alpha; o1[i] *= alpha; } }
    m = mn;
    const float nm = rowon ? -mn : -INFINITY;
    float ps = 0.f;
#pragma unroll
    for (int i = 0; i < 16; ++i) { p0[i] = __builtin_amdgcn_exp2f(__builtin_fmaf(p0[i], sc2, nm)); p1[i] = __builtin_amdgcn_exp2f(__builtin_fmaf(p1[i], sc2, nm)); ps += p0[i] + p1[i]; }
    lsum += ps;
}
template <int DQK, class MaskFn>
__device__ __forceinline__ void flash_unit(LAS unsigned char* lds, const FlashKV kv, const bf16* qrow, const float sc2  , const int ntiles,
                                           const MaskFn& maskf, f32x16& o0, f32x16& o1, float& lsum) {
    constexpr int KP = (DQK == 96) ? FL_KP96 : FL_KP64, NKS = DQK / 16, CPR = DQK / 8;
    const int tid = cur_tid(), lane = tid & 63, r = lane & 31, h = lane >> 5;
    const LAS unsigned char* tl = lds + FL_TL;
    bf16x8 qf[NKS];
#pragma unroll
    for (int ks = 0; ks < NKS; ++ks) qf[ks] = *(const GAS bf16x8*)(qrow + 16 * ks + 8 * h);
    const int kr0 = tid / CPR, kc0 = tid - kr0 * CPR;
    const int kr1 = (tid + 512) / CPR, kc1 = (tid + 512) - kr1 * CPR;
    const bool has2 = (DQK == 96) && (tid < 256);
    const int vr = tid >> 3, vc = tid & 7;
    struct StageRegs { v4u k0, k1, v; };
    StageRegs S0, S1; S0.k1 = (v4u){0u, 0u, 0u, 0u}; S1.k1 = (v4u){0u, 0u, 0u, 0u};
    auto gload = [&](StageRegs& S, int tile) {
        const size_t rowb = (size_t)tile * 64;
        S.k0 = *(const GAS v4u*)(kv.K + (rowb + kr0) * kv.kp + 8 * kc0);
        if (DQK == 96) S.k1 = *(const GAS v4u*)(kv.K + (rowb + (has2 ? kr1 : kr0)) * kv.kp + 8 * (has2 ? kc1 : kc0));
        S.v = *(const GAS v4u*)(kv.V + (rowb + vr) * kv.vp + 8 * vc);
    };
    auto lstore = [&](const StageRegs& S, int buf) {
        LAS unsigned char* Kb = lds + FL_KBUF + buf * FL_KBUF_SZ; LAS unsigned char* Vb = lds + FL_VBUF + buf * FL_VBUF_SZ;
        *(LAS v4u*)(Kb + kr0 * KP + 16 * kc0) = S.k0;
        if (has2) *(LAS v4u*)(Kb + kr1 * KP + 16 * kc1) = S.k1;
        *(LAS v4u*)(Vb + vr * FL_VP + 16 * vc) = S.v;
    };
    float m = -1e30f; lsum = 0.f;
    __syncthreads();
#pragma unroll
    for (int i = 0; i < 16; ++i) { o0[i] = 0.f; o1[i] = 0.f; }
    unsigned long long wnext = 0ull;
    if (ntiles > 0) { wnext = maskf((int)tl[0]); gload(S0, (int)tl[0]); lstore(S0, 0); }
    if (ntiles > 0) gload(S1, (int)tl[ntiles > 1 ? 1 : 0]);
#pragma unroll
    for (int ks = 0; ks < NKS; ++ks) asm volatile("" :: "v"(qf[ks]));
    __syncthreads();
    auto step = [&](const int it, StageRegs& Sload, const StageRegs& Sstore) __attribute__((always_inline)) {
        const int cur = it & 1;
        const unsigned long long word = wnext;
        wnext = maskf((int)tl[it + 1 < ntiles ? it + 1 : ntiles - 1]);
        gload(Sload, (int)tl[it + 2 < ntiles ? it + 2 : ntiles - 1]);
        if (!__all(word == 0ull)) {
            const LAS unsigned char* Kb = lds + FL_KBUF + cur * FL_KBUF_SZ; const LAS unsigned char* Vb = lds + FL_VBUF + cur * FL_VBUF_SZ;
            f32x16 p0, p1;
#pragma unroll
            for (int i = 0; i < 16; ++i) { p0[i] = 0.f; p1[i] = 0.f; }
#pragma unroll
            for (int ks = 0; ks < NKS; ++ks) {
                const bf16x8 a0 = *(const LAS bf16x8*)(Kb + r * KP + (16 * ks + 8 * h) * 2), a1 = *(const LAS bf16x8*)(Kb + (32 + r) * KP + (16 * ks + 8 * h) * 2);
                p0 = __builtin_amdgcn_mfma_f32_32x32x16_bf16(a0, qf[ks], p0, 0, 0, 0);
                p1 = __builtin_amdgcn_mfma_f32_32x32x16_bf16(a1, qf[ks], p1, 0, 0, 0);
            }
            if (__all(word == ~0ull)) fl_softmax<0>(p0, p1, word, h, sc2, m, lsum, o0, o1);
            else if (__all(word == ~0ull || word == 0ull)) fl_softmax<1>(p0, p1, word, h, sc2, m, lsum, o0, o1);
            else fl_softmax<2>(p0, p1, word, h, sc2, m, lsum, o0, o1);
            bf16x8 pf[4];
#pragma unroll
            for (int s = 0; s < 4; ++s) { v4u w;
                if (s < 2) { w.x = pg8::cvt_pk_bf16(p0[8 * s], p0[8 * s + 1]); w.y = pg8::cvt_pk_bf16(p0[8 * s + 2], p0[8 * s + 3]); w.z = pg8::cvt_pk_bf16(p0[8 * s + 4], p0[8 * s + 5]); w.w = pg8::cvt_pk_bf16(p0[8 * s + 6], p0[8 * s + 7]); }
                else { const int s2 = s - 2; w.x = pg8::cvt_pk_bf16(p1[8 * s2], p1[8 * s2 + 1]); w.y = pg8::cvt_pk_bf16(p1[8 * s2 + 2], p1[8 * s2 + 3]); w.z = pg8::cvt_pk_bf16(p1[8 * s2 + 4], p1[8 * s2 + 5]); w.w = pg8::cvt_pk_bf16(p1[8 * s2 + 6], p1[8 * s2 + 7]); }
                pf[s] = __builtin_bit_cast(bf16x8, w); }
            {
                typedef short v4i16_t __attribute__((ext_vector_type(4)));
                const LAS unsigned char* vbase = Vb + (4 * h + ((lane & 15) >> 2)) * FL_VP + (16 * ((lane >> 4) & 1) + 4 * (lane & 3)) * 2;
#pragma unroll
                for (int s = 0; s < 4; ++s) {
#pragma unroll
                    for (int db = 0; db < 2; ++db) {
                        const LAS unsigned char* vp_ = vbase + (32 * (s >> 1) + 16 * (s & 1)) * FL_VP + 64 * db;
                        const v4i16_t lo = __builtin_amdgcn_ds_read_tr16_b64_v4i16((LAS v4i16_t*)vp_), hi = __builtin_amdgcn_ds_read_tr16_b64_v4i16((LAS v4i16_t*)(vp_ + 8 * FL_VP));
                        const bf16x8 a = {lo[0], lo[1], lo[2], lo[3], hi[0], hi[1], hi[2], hi[3]};
                        if (db == 0) o0 = __builtin_amdgcn_mfma_f32_32x32x16_bf16(a, pf[s], o0, 0, 0, 0);
                        else o1 = __builtin_amdgcn_mfma_f32_32x32x16_bf16(a, pf[s], o1, 0, 0, 0);
                    }
                }
            }
        }
        if (it + 1 < ntiles) lstore(Sstore, cur ^ 1);
        __syncthreads();
    };
    for (int it = 0; it < ntiles; it += 2) { step(it, S0, S1); if (it + 1 < ntiles) step(it + 1, S1, S0); }
}
__device__ __forceinline__ void flash_store(bf16* yrow  , const f32x16& o0, const f32x16& o1, float inv, int h) {
#pragma unroll
    for (int g = 0; g < 4; ++g) {
        typedef unsigned u32x2v __attribute__((ext_vector_type(2)));
        u32x2v w0, w1;
        w0.x = pg8::cvt_pk_bf16(o0[4 * g] * inv, o0[4 * g + 1] * inv); w0.y = pg8::cvt_pk_bf16(o0[4 * g + 2] * inv, o0[4 * g + 3] * inv);
        w1.x = pg8::cvt_pk_bf16(o1[4 * g] * inv, o1[4 * g + 1] * inv); w1.y = pg8::cvt_pk_bf16(o1[4 * g + 2] * inv, o1[4 * g + 3] * inv);
        *(u32x2v*)(yrow + 8 * g + 4 * h) = w0; *(u32x2v*)(yrow + 32 + 8 * g + 4 * h) = w1;
    }
}

__device__ __forceinline__ void mla_flash_phase(Frame& F) {
    const int tid = cur_tid(), wave = cur_wave(), lane = tid & 63, r = lane & 31, h2 = lane >> 5;
    bf16* Y = (bf16*)F.out + (size_t)M * D;
    for (int pass = 0; pass < 2; ++pass) {
        for (int u0 = blockIdx.x; u0 < 256; u0 += F.G) {
            const int u = pass ? 511 - u0 : u0, qb = u >> 5, bh = u & 31, b = bh >> 2, hd = bh & 3;
            const int t = 256 * qb + 32 * wave + r; const size_t row = (size_t)b * T + t;
            LAS unsigned char* tl = F.lds + FL_TL;
            if (tid < 64) tl[tid] = (unsigned char)tid;
            const int ntiles = 4 * qb + 4;
            FlashKV kv{(const bf16*)(F.ws + WS_KMLA) + (size_t)b * T * 384 + hd * 96, (const bf16*)(F.ws + WS_VMLA) + (size_t)b * T * 256 + hd * 64, 384, 256};
            auto maskf = [&](int tile) { return causal_word(t - 64 * tile); };
            f32x16 o0, o1; float ls;
            flash_unit<96>(F.lds, kv, (const bf16*)(F.ws + WS_QMLA) + row * 384 + hd * 96, 0.10206207261596577f * 1.4426950408889634f, ntiles, maskf, o0, o1, ls);
            ls = xhalf_sum(ls);
            flash_store(Y + row * 1024 + 256 + hd * 64, o0, o1, ls > 0.f ? 1.0f / ls : 0.f, h2);
        }
    }
}

__device__ __forceinline__ void moba_flash_phase(Frame& F) {
    const int tid = cur_tid(), wave = cur_wave(), lane = tid & 63, r = lane & 31, h2 = lane >> 5;
    bf16* Y = (bf16*)F.out + (size_t)M * D;
    const float* QF = (const float*)(F.ws + WS_QM_F); const float* kmean = (const float*)(F.ws + WS_KMEAN);
    LAS unsigned short* msel = (LAS unsigned short*)(F.lds + FL_SEL); LAS unsigned* orm = (LAS unsigned*)(F.lds + FL_ORM); LAS unsigned char* tl = F.lds + FL_TL; LAS int* tln = (LAS int*)(F.lds + FL_TLN);
    for (int pass = 0; pass < 2; ++pass) {
        for (int u0 = blockIdx.x; u0 < 256; u0 += F.G) {
            const int u = pass ? 511 - u0 : u0, own = u >> 5, bh = u & 31, b = bh >> 2, hd = bh & 3;
            if (tid == 0) orm[0] = 0u;
            __syncthreads();
            if (tid < 256) {
                const float* qp = QF + ((size_t)b * T + 256 * own + tid) * 256 + hd * 64;
                const float* km = kmean + (size_t)((b * 4 + hd) * 16) * 64;
                f32x4 qv[16];
#pragma unroll
                for (int c = 0; c < 16; ++c) qv[c] = *(const f32x4*)(qp + 4 * c);
                float g[15];
#pragma unroll
                for (int j = 0; j < 15; ++j) { g[j] = 0.f;
                    if (j < own) { float a = 0.f;
#pragma unroll
                        for (int c = 0; c < 16; ++c) { const f32x4 kv4 = *(const f32x4*)(km + j * 64 + 4 * c); a += (qv[c].x * kv4.x + qv[c].y * kv4.y) + (qv[c].z * kv4.z + qv[c].w * kv4.w); }
                        g[j] = a; } }
                unsigned sel = 0u;
#pragma unroll
                for (int rr = 0; rr < 3; ++rr) { float best = -INFINITY; int bi = -1;
#pragma unroll
                    for (int j = 0; j < 15; ++j) if (j < own && !((sel >> j) & 1u) && g[j] > best) { best = g[j]; bi = j; }
                    if (bi >= 0) sel |= 1u << bi; }
                msel[tid] = (unsigned short)sel;
                __hip_atomic_fetch_or(orm, sel, __ATOMIC_RELAXED, __HIP_MEMORY_SCOPE_WORKGROUP);
            }
            __syncthreads();
            if (tid == 0) { const unsigned om = orm[0]; int n = 0;
                for (int j = 0; j < own; ++j) if ((om >> j) & 1u) { for (int q4 = 0; q4 < 4; ++q4) tl[n++] = (unsigned char)(4 * j + q4); }
                for (int q4 = 0; q4 < 4; ++q4) tl[n++] = (unsigned char)(4 * own + q4);
                tln[0] = n; }
            __syncthreads();
            const int ntiles = tln[0];
            const int tq = 32 * wave + r, t = 256 * own + tq; const size_t row = (size_t)b * T + t;
            const unsigned mysel = msel[tq];
            FlashKV kv{(const bf16*)(F.ws + WS_KM_BF) + (size_t)b * T * 256 + hd * 64, (const bf16*)(F.ws + WS_VM_BF) + (size_t)b * T * 256 + hd * 64, 256, 256};
            auto maskf = [&](int tile) { const int blk = tile >> 2; return blk == own ? causal_word(t - 64 * tile) : (((mysel >> blk) & 1u) ? ~0ull : 0ull); };
            f32x16 o0, o1; float ls;
            flash_unit<64>(F.lds, kv, (const bf16*)(F.ws + WS_QM_BF) + row * 256 + hd * 64, 0.125f * 1.4426950408889634f, ntiles, maskf, o0, o1, ls);
            ls = xhalf_sum(ls);
            flash_store(Y + row * 1024 + hd * 64, o0, o1, ls > 0.f ? 1.0f / ls : 0.f, h2);
        }
    }
}
__device__ __forceinline__ void dsa_flash_phase(Frame& F) {
    const int tid = cur_tid(), wave = cur_wave(), lane = tid & 63, r = lane & 31, h2 = lane >> 5;
    bf16* Y = (bf16*)F.out + (size_t)M * D;
    const unsigned long long* BM = (const unsigned long long*)(F.ws + WS_DSAMASK);
    for (int pass = 0; pass < 2; ++pass) {
        for (int u0 = blockIdx.x; u0 < 256; u0 += F.G) {
            const int u = pass ? 511 - u0 : u0, tb = u >> 3, b = u & 7, hd = wave >> 1;
            const int t = 64 * tb + 32 * (wave & 1) + r; const size_t row = (size_t)b * T + t;
            LAS unsigned char* tl = F.lds + FL_TL;
            __syncthreads();
            if (tid < 64) tl[tid] = (unsigned char)tid;
            const int ntiles = tb + 1;
            FlashKV kv{(const bf16*)(F.ws + WS_KD) + (size_t)b * T * 64, (const bf16*)(F.ws + WS_VD) + (size_t)b * T * 64, 64, 64};
            const unsigned long long* bmrow = BM + row * 64;
            auto maskf = [&](int tile) { return bmrow[tile]; };
            f32x16 o0, o1; float ls;
            flash_unit<64>(F.lds, kv, (const bf16*)(F.ws + WS_QD) + row * 256 + hd * 64, 0.125f * 1.4426950408889634f, ntiles, maskf, o0, o1, ls);
            ls = xhalf_sum(ls);
            flash_store(Y + row * 1024 + 768 + hd * 64, o0, o1, ls > 0.f ? 1.0f / ls : 0.f, h2);
        }
    }
}
__device__ __forceinline__ void nsa_flash_phase(Frame& F) {
    const int tid = cur_tid(), wave = cur_wave(), lane = tid & 63, r = lane & 31, h2 = lane >> 5;
    bf16* Y = (bf16*)F.out + (size_t)M * D;
    const unsigned long long* NSEL = (const unsigned long long*)(F.ws + WS_NSEL); const bf16* OC = (const bf16*)(F.ws + WS_OC); const float* GWp = (const float*)(F.ws + WS_GW);
    LAS unsigned* orm = (LAS unsigned*)(F.lds + FL_ORM); LAS unsigned char* tl = F.lds + FL_TL; LAS int* tln = (LAS int*)(F.lds + FL_TLN);
    for (int pass = 0; pass < 2; ++pass) {
        for (int u0 = blockIdx.x; u0 < 256; u0 += F.G) {
            const int u = pass ? 511 - u0 : u0, tb = u >> 3, b = u & 7, hd = wave >> 1;
            const int t = 64 * tb + 32 * (wave & 1) + r; const size_t row = (size_t)b * T + t;
            const unsigned long long mysel = NSEL[row];
            __syncthreads();
            if (tid < 2) orm[tid] = 0u;
            __syncthreads();
            if (wave < 2) { __hip_atomic_fetch_or(orm, (unsigned)mysel, __ATOMIC_RELAXED, __HIP_MEMORY_SCOPE_WORKGROUP); __hip_atomic_fetch_or(orm + 1, (unsigned)(mysel >> 32), __ATOMIC_RELAXED, __HIP_MEMORY_SCOPE_WORKGROUP); }
            __syncthreads();
            if (tid == 0) { const unsigned long long om = (unsigned long long)orm[0] | ((unsigned long long)orm[1] << 32); int n = 0;
                for (int j = 0; j <= tb; ++j) if ((om >> j) & 1ull) tl[n++] = (unsigned char)j;
                tln[0] = n; }
            __syncthreads();
            const int nsel_tiles = tln[0];
            const bf16* qrow = (const bf16*)(F.ws + WS_QN) + row * 256 + hd * 64;
            const float* gp = GWp + row * 32 + hd * 3;
            const float g0 = sigmoid_f(gp[0]), g1 = sigmoid_f(gp[1]), g2 = sigmoid_f(gp[2]);
            LAS float* stash = (LAS float*)(F.lds + 49152) + wave * 2048 + lane;
            {
                FlashKV kv{(const bf16*)(F.ws + WS_KS) + (size_t)b * T * 64, (const bf16*)(F.ws + WS_VS) + (size_t)b * T * 64, 64, 64};
                auto maskf = [&](int tile) { return ((mysel >> tile) & 1ull) ? causal_word(t - 64 * tile) : 0ull; };
                f32x16 o0, o1; float ls;
                flash_unit<64>(F.lds, kv, qrow, 0.125f * 1.4426950408889634f, nsel_tiles, maskf, o0, o1, ls);
                ls = xhalf_sum(ls); const float sc = ls > 0.f ? g1 / ls : 0.f;
                const bf16* ocr = OC + row * 256 + hd * 64;
#pragma unroll
                for (int g = 0; g < 4; ++g) { const unsigned long long w0 = *(const unsigned long long*)(ocr + 8 * g + 4 * h2), w1 = *(const unsigned long long*)(ocr + 32 + 8 * g + 4 * h2);
                    stash[(4 * g) * 64] = sc * o0[4 * g] + g0 * __uint_as_float((unsigned)w0 << 16); stash[(4 * g + 1) * 64] = sc * o0[4 * g + 1] + g0 * __uint_as_float((unsigned)w0 & 0xffff0000u);
                    stash[(4 * g + 2) * 64] = sc * o0[4 * g + 2] + g0 * __uint_as_float((unsigned)(w0 >> 32) << 16); stash[(4 * g + 3) * 64] = sc * o0[4 * g + 3] + g0 * __uint_as_float((unsigned)(w0 >> 32) & 0xffff0000u);
                    stash[(16 + 4 * g) * 64] = sc * o1[4 * g] + g0 * __uint_as_float((unsigned)w1 << 16); stash[(16 + 4 * g + 1) * 64] = sc * o1[4 * g + 1] + g0 * __uint_as_float((unsigned)w1 & 0xffff0000u);
                    stash[(16 + 4 * g + 2) * 64] = sc * o1[4 * g + 2] + g0 * __uint_as_float((unsigned)(w1 >> 32) << 16); stash[(16 + 4 * g + 3) * 64] = sc * o1[4 * g + 3] + g0 * __uint_as_float((unsigned)(w1 >> 32) & 0xffff0000u); }
            }
            f32x16 a0, a1;
            {
                __syncthreads();
                const int t0 = tb >= 8 ? tb - 8 : 0;
                if (tid < 64) tl[tid] = (unsigned char)(t0 + tid);
                FlashKV kv{(const bf16*)(F.ws + WS_KW) + (size_t)b * T * 64, (const bf16*)(F.ws + WS_VW) + (size_t)b * T * 64, 64, 64};
                auto maskf = [&](int tile) { return causal_word(t - 64 * tile) & ~causal_word(t - 512 - 64 * tile); };
                f32x16 o0, o1; float ls;
                flash_unit<64>(F.lds, kv, qrow, 0.125f * 1.4426950408889634f, tb - t0 + 1, maskf, o0, o1, ls);
                ls = xhalf_sum(ls); const float sc = ls > 0.f ? g2 / ls : 0.f;
#pragma unroll
                for (int i = 0; i < 16; ++i) { a0[i] = sc * o0[i] + stash[i * 64]; a1[i] = sc * o1[i] + stash[(16 + i) * 64]; }
            }
            flash_store(Y + row * 1024 + 512 + hd * 64, a0, a1, 1.0f, h2);
        }
    }
}

__device__ __forceinline__ int hist_pick(LAS unsigned* hist, int& kk, const int lane) {
    const int h0 = (int)hist[4 * lane], h1 = (int)hist[4 * lane + 1], h2 = (int)hist[4 * lane + 2], h3 = (int)hist[4 * lane + 3];
    const int tot = (h0 + h1) + (h2 + h3); int incl = tot;
#pragma unroll
    for (int o = 1; o < 64; o <<= 1) { const int v = __shfl_down(incl, o); if (lane + o < 64) incl += v; }
    int run = incl - tot, found = -1, newk = 0;
    if (run < kk && run + h3 >= kk) { found = 4 * lane + 3; newk = kk - run; } run += h3;
    if (found < 0 && run < kk && run + h2 >= kk) { found = 4 * lane + 2; newk = kk - run; } run += h2;
    if (found < 0 && run < kk && run + h1 >= kk) { found = 4 * lane + 1; newk = kk - run; } run += h1;
    if (found < 0 && run < kk && run + h0 >= kk) { found = 4 * lane; newk = kk - run; }
    const unsigned long long ball = __ballot(found >= 0); const int src = __ffsll((long long)ball) - 1;
    const int bin = __shfl(found, src); kk = __shfl(newk, src);
    return bin;
}
__device__ __forceinline__ float unfkey(unsigned u) { return __uint_as_float((u & 0x80000000u) ? (u ^ 0x80000000u) : ~u); }
__device__ __forceinline__ void radix_select_write(LAS float* sc, LAS unsigned* hist, unsigned long long* bmrow, const int t, const int lane) {
    const int n = t + 1;
    if (n <= 256) { for (int k0 = 0; k0 < n; k0 += 64) if (lane == 0) bmrow[k0 >> 6] = causal_word(t - k0); return; }
#define RS_LOAD4(k0) float x_[4]; { _Pragma("unroll") for (int j_ = 0; j_ < 4; ++j_) { const float v_ = sc[(k0) + 64 * j_ + lane]; x_[j_] = (lane < n - (k0) - 64 * j_) ? v_ : -INFINITY; } }
    float mn = INFINITY, mx = -INFINITY;
    for (int k0 = 0; k0 < n; k0 += 256) { RS_LOAD4(k0);
#pragma unroll
        for (int j = 0; j < 4; ++j) { mx = fmaxf(mx, x_[j]); mn = fminf(mn, x_[j] > -INFINITY ? x_[j] : INFINITY); } }
    mn = -wave_max(-mn); mx = wave_max(mx);
    const float qs = mx > mn ? 255.99f / (mx - mn) : 1.0f, qo = -mn * qs;
#pragma unroll
    for (int k = 0; k < 4; ++k) hist[lane + 64 * k] = 0u;
    LDS_WAIT(); asm volatile("" ::: "memory");
#ifdef SEL_DUP_HIST
    for (int rep3_ = 0; rep3_ < 2; ++rep3_) {
#pragma unroll
    for (int k = 0; k < 4; ++k) hist[lane + 64 * k] = 0u;
    LDS_WAIT(); asm volatile("" ::: "memory");
#endif
    for (int k0 = 0; k0 < n; k0 += 256) { RS_LOAD4(k0);
#pragma unroll
        for (int j = 0; j < 4; ++j) { int q = (int)__builtin_fmaf(x_[j], qs, qo); q = q > 255 ? 255 : (q < 0 ? 0 : q); __hip_atomic_fetch_add(hist + q, 1u, __ATOMIC_RELAXED, __HIP_MEMORY_SCOPE_WORKGROUP); } }
    LDS_WAIT(); asm volatile("" ::: "memory");
#ifdef SEL_DUP_HIST
    }
#endif
    int kk = 256;
    const int B = hist_pick(hist, kk, lane);
    const int cntB = (int)hist[B];
    LDS_WAIT(); asm volatile("" ::: "memory");
#ifdef FORCE_FALLBACK
    if (cntB > 0) {
#else
    if (cntB > 128) {
#endif
        unsigned prefix = 0u, pmask = 0u;
#pragma unroll 1
        for (int pass = 0; pass < 4; ++pass) {
            const int shift = 24 - 8 * pass;
#pragma unroll
            for (int k = 0; k < 4; ++k) hist[lane + 64 * k] = 0u;
            LDS_WAIT(); asm volatile("" ::: "memory");
            for (int k0 = 0; k0 < n; k0 += 256) { RS_LOAD4(k0);
#pragma unroll
                for (int j = 0; j < 4; ++j) { int q = (int)__builtin_fmaf(x_[j], qs, qo); q = q > 255 ? 255 : (q < 0 ? 0 : q);
                    if (q == B) { const unsigned u = fkey(x_[j]); if ((u & pmask) == prefix) __hip_atomic_fetch_add(hist + ((u >> shift) & 255u), 1u, __ATOMIC_RELAXED, __HIP_MEMORY_SCOPE_WORKGROUP); } } }
            LDS_WAIT(); asm volatile("" ::: "memory");
            const int bin = hist_pick(hist, kk, lane);
            prefix |= (unsigned)bin << shift; pmask |= 255u << shift;
            LDS_WAIT(); asm volatile("" ::: "memory");
        }
        int eqseen = 0;
        for (int k0 = 0; k0 < n; k0 += 256) { RS_LOAD4(k0);
#pragma unroll
            for (int j = 0; j < 4; ++j) { int q = (int)__builtin_fmaf(x_[j], qs, qo); q = q > 255 ? 255 : (q < 0 ? 0 : q);
                const unsigned u = fkey(x_[j]); const bool valid = x_[j] > -INFINITY;
                const bool gt = valid && (q > B || (q == B && u > prefix)), eq = valid && q == B && u == prefix;
                const unsigned long long be = __ballot(eq); const bool sel = gt || (eq && (eqseen + mbcnt64(be)) < kk);
                const unsigned long long bs = __ballot(sel);
                if (lane == 0 && k0 + 64 * j < n) bmrow[(k0 >> 6) + j] = bs;
                eqseen += __popcll(be); } }
        return;
    }
    LAS unsigned* bmw = hist + 256;
    LAS unsigned* cand = (LAS unsigned*)sc;
    int ncand = 0;
    for (int k0 = 0; k0 < n; k0 += 256) { RS_LOAD4(k0);
        asm volatile("" ::: "memory");
#pragma unroll
        for (int j = 0; j < 4; ++j) { int q = (int)__builtin_fmaf(x_[j], qs, qo); q = q > 255 ? 255 : (q < 0 ? 0 : q);
            const bool valid = x_[j] > -INFINITY; const bool gt = valid && q > B, inb = valid && q == B;
            const unsigned long long bg = __ballot(gt), bi = __ballot(inb);
            if (lane == 0) { bmw[2 * ((k0 >> 6) + j)] = (unsigned)bg; bmw[2 * ((k0 >> 6) + j) + 1] = (unsigned)(bg >> 32); }
            if (inb) { const int c = ncand + mbcnt64(bi); cand[2 * c] = (unsigned)(k0 + 64 * j + lane); cand[2 * c + 1] = fkey(x_[j]); }
            ncand += __popcll(bi); }
        LDS_WAIT(); asm volatile("" ::: "memory"); }
#undef RS_LOAD4
    {
        const int c0 = lane, c1 = lane + 64;
        const unsigned k0_ = c0 < ncand ? cand[2 * c0 + 1] : 0u, k1_ = c1 < ncand ? cand[2 * c1 + 1] : 0u;
        const unsigned i0_ = c0 < ncand ? cand[2 * c0] : 0u, i1_ = c1 < ncand ? cand[2 * c1] : 0u;
        int r0 = 0, r1 = 0;
#ifdef SEL_DUP_RANK
        for (int rep3_ = 0; rep3_ < 2; ++rep3_) { r0 = 0; r1 = 0;
#endif
        for (int j = 0; j < ncand; ++j) { const unsigned kj = cand[2 * j + 1];
            r0 += (kj > k0_ || (kj == k0_ && j < c0)) ? 1 : 0; r1 += (kj > k1_ || (kj == k1_ && j < c1)) ? 1 : 0; }
#ifdef SEL_DUP_RANK
        asm volatile("" : "+v"(r0), "+v"(r1)); }
#endif
        if (c0 < ncand && r0 < kk) __hip_atomic_fetch_or(bmw + 2 * (i0_ >> 6) + ((i0_ >> 5) & 1u), 1u << (i0_ & 31u), __ATOMIC_RELAXED, __HIP_MEMORY_SCOPE_WORKGROUP);
        if (c1 < ncand && r1 < kk) __hip_atomic_fetch_or(bmw + 2 * (i1_ >> 6) + ((i1_ >> 5) & 1u), 1u << (i1_ & 31u), __ATOMIC_RELAXED, __HIP_MEMORY_SCOPE_WORKGROUP);
    }
    LDS_WAIT(); asm volatile("" ::: "memory");
    if (lane < ((n + 63) >> 6)) bmrow[lane] = (unsigned long long)bmw[2 * lane] | ((unsigned long long)bmw[2 * lane + 1] << 32);
    LDS_WAIT(); asm volatile("" ::: "memory");
}
__device__ __forceinline__ void split8(const f32x4 a, const f32x4 b, bf16x8& hi, bf16x8& lo) {
    v4u h, l;
    h.x = pg8::cvt_pk_bf16(a.x, a.y); h.y = pg8::cvt_pk_bf16(a.z, a.w); h.z = pg8::cvt_pk_bf16(b.x, b.y); h.w = pg8::cvt_pk_bf16(b.z, b.w);
    l.x = pg8::cvt_pk_bf16(a.x - __uint_as_float(h.x << 16), a.y - __uint_as_float(h.x & 0xffff0000u)); l.y = pg8::cvt_pk_bf16(a.z - __uint_as_float(h.y << 16), a.w - __uint_as_float(h.y & 0xffff0000u));
    l.z = pg8::cvt_pk_bf16(b.x - __uint_as_float(h.z << 16), b.y - __uint_as_float(h.z & 0xffff0000u)); l.w = pg8::cvt_pk_bf16(b.z - __uint_as_float(h.w << 16), b.w - __uint_as_float(h.w & 0xffff0000u));
    hi = __builtin_bit_cast(bf16x8, h); lo = __builtin_bit_cast(bf16x8, l);
}
__device__ __forceinline__ void dsa_select_phase(Frame& F) {
    const int tid = cur_tid(), wave = cur_wave(), lane = tid & 63, r = lane & 31, hh = lane >> 5;
    const float* IQ = (const float*)(F.ws + WS_IQ); const float* IK = (const float*)(F.ws + WS_IK); const float* GWp = (const float*)(F.ws + WS_GW);
    LAS float* sc = (LAS float*)(F.lds + RING_OFF);
    LAS unsigned* hist = (LAS unsigned*)(F.lds + XTRA_OFF + wave * XTRA_WAVE);
    f32x4 araw[2][2][2], wraw[2][4];
    auto load_a = [&](int pass_, int u0_) {
        const int b_ = u0_ >> 8, w8_ = u0_ & 255, tb8_ = pass_ ? 511 - w8_ : w8_; const size_t rowb = (size_t)b_ * T + 8 * tb8_;
#pragma unroll
        for (int gq = 0; gq < 2; ++gq) {
            const float* qp = IQ + (rowb + 4 * gq + (r >> 3)) * 256 + (r & 7) * 32 + 8 * hh;
#pragma unroll
            for (int ks = 0; ks < 2; ++ks) { araw[gq][ks][0] = *(const f32x4*)(qp + 16 * ks); araw[gq][ks][1] = *(const f32x4*)(qp + 16 * ks + 4); }
#pragma unroll
            for (int tk = 0; tk < 4; ++tk) wraw[gq][tk] = *(const f32x4*)(GWp + (rowb + 4 * gq + tk) * 32 + 12 + 4 * hh);
        }
    };
    if ((int)blockIdx.x < 2048) load_a(0, (int)blockIdx.x);
    for (int pass = 0; pass < 2; ++pass) {
        for (int u0 = blockIdx.x; u0 < 2048; u0 += F.G) {
            const int b = u0 >> 8, w8 = u0 & 255, tb8 = pass ? 511 - w8 : w8, t0 = 8 * tb8, nmax = t0 + 8;
            const size_t base = (size_t)b * T;
            bf16x8 ahi[2][2], alo[2][2]; float iw[2][4][4];
#pragma unroll
            for (int gq = 0; gq < 2; ++gq) {
#pragma unroll
                for (int ks = 0; ks < 2; ++ks) split8(araw[gq][ks][0], araw[gq][ks][1], ahi[gq][ks], alo[gq][ks]);
#pragma unroll
                for (int tk = 0; tk < 4; ++tk) { const f32x4 w4 = wraw[gq][tk]; iw[gq][tk][0] = w4.x; iw[gq][tk][1] = w4.y; iw[gq][tk][2] = w4.z; iw[gq][tk][3] = w4.w; }
            }
            const int nkb = (nmax + 31) >> 5;
            v4u nbA[4], nbB[4];
#define DS_LOADB(dst, kb_) do { const GAS unsigned* kp_ = (const GAS unsigned*)(IK + (base + 32 * (kb_) + r) * 32 + 8 * hh); dst[0] = *(const GAS v4u*)kp_; dst[1] = *(const GAS v4u*)(kp_ + 4); dst[2] = *(const GAS v4u*)(kp_ + 16); dst[3] = *(const GAS v4u*)(kp_ + 20); } while (0)
#define DS_UNPK(a, b, hi_, lo_) do { v4u h_, l_; h_.x = __builtin_amdgcn_perm(a.y, a.x, 0x05040100u); l_.x = __builtin_amdgcn_perm(a.y, a.x, 0x07060302u); h_.y = __builtin_amdgcn_perm(a.w, a.z, 0x05040100u); l_.y = __builtin_amdgcn_perm(a.w, a.z, 0x07060302u); \
            h_.z = __builtin_amdgcn_perm(b.y, b.x, 0x05040100u); l_.z = __builtin_amdgcn_perm(b.y, b.x, 0x07060302u); h_.w = __builtin_amdgcn_perm(b.w, b.z, 0x05040100u); l_.w = __builtin_amdgcn_perm(b.w, b.z, 0x07060302u); \
            hi_ = __builtin_bit_cast(bf16x8, h_); lo_ = __builtin_bit_cast(bf16x8, l_); } while (0)
#ifdef DSA_DUP_SCORE
            for (int rep2_ = 0; rep2_ < 2; ++rep2_) {
#endif
            if (wave < nkb) DS_LOADB(nbA, wave);
            if (wave + 8 < nkb) DS_LOADB(nbB, wave + 8);
            for (int kb = wave; kb < nkb; kb += 16) {
                const bool hasB = kb + 8 < nkb;
                bf16x8 bhiA[2], bloA[2], bhiB[2], bloB[2];
                DS_UNPK(nbA[0], nbA[1], bhiA[0], bloA[0]); DS_UNPK(nbA[2], nbA[3], bhiA[1], bloA[1]);
                if (hasB) { DS_UNPK(nbB[0], nbB[1], bhiB[0], bloB[0]); DS_UNPK(nbB[2], nbB[3], bhiB[1], bloB[1]); }
                else { bhiB[0] = bhiA[0]; bhiB[1] = bhiA[1]; bloB[0] = bloA[0]; bloB[1] = bloA[1]; }
                if (kb + 16 < nkb) DS_LOADB(nbA, kb + 16);
                if (kb + 24 < nkb) DS_LOADB(nbB, kb + 24);
                f32x16 cA0, cA1, cB0, cB1;
#pragma unroll
                for (int i = 0; i < 16; ++i) { cA0[i] = 0.f; cA1[i] = 0.f; cB0[i] = 0.f; cB1[i] = 0.f; }
#pragma unroll
                for (int ks = 0; ks < 2; ++ks) {
                    cA0 = __builtin_amdgcn_mfma_f32_32x32x16_bf16(ahi[0][ks], bhiA[ks], cA0, 0, 0, 0); cA1 = __builtin_amdgcn_mfma_f32_32x32x16_bf16(ahi[1][ks], bhiA[ks], cA1, 0, 0, 0);
                    cB0 = __builtin_amdgcn_mfma_f32_32x32x16_bf16(ahi[0][ks], bhiB[ks], cB0, 0, 0, 0); cB1 = __builtin_amdgcn_mfma_f32_32x32x16_bf16(ahi[1][ks], bhiB[ks], cB1, 0, 0, 0);
                    cA0 = __builtin_amdgcn_mfma_f32_32x32x16_bf16(ahi[0][ks], bloA[ks], cA0, 0, 0, 0); cA1 = __builtin_amdgcn_mfma_f32_32x32x16_bf16(ahi[1][ks], bloA[ks], cA1, 0, 0, 0);
                    cB0 = __builtin_amdgcn_mfma_f32_32x32x16_bf16(ahi[0][ks], bloB[ks], cB0, 0, 0, 0); cB1 = __builtin_amdgcn_mfma_f32_32x32x16_bf16(ahi[1][ks], bloB[ks], cB1, 0, 0, 0);
                    cA0 = __builtin_amdgcn_mfma_f32_32x32x16_bf16(alo[0][ks], bhiA[ks], cA0, 0, 0, 0); cA1 = __builtin_amdgcn_mfma_f32_32x32x16_bf16(alo[1][ks], bhiA[ks], cA1, 0, 0, 0);
                    cB0 = __builtin_amdgcn_mfma_f32_32x32x16_bf16(alo[0][ks], bhiB[ks], cB0, 0, 0, 0); cB1 = __builtin_amdgcn_mfma_f32_32x32x16_bf16(alo[1][ks], bhiB[ks], cB1, 0, 0, 0);
                }
#define DS_EPI(c, gq, kb_) do { float s4_[4]; _Pragma("unroll") for (int tk = 0; tk < 4; ++tk) { \
                        const float v_ = (iw[gq][tk][0] * fmaxf(c[4 * tk], 0.f) + iw[gq][tk][1] * fmaxf(c[4 * tk + 1], 0.f)) + (iw[gq][tk][2] * fmaxf(c[4 * tk + 2], 0.f) + iw[gq][tk][3] * fmaxf(c[4 * tk + 3], 0.f)); \
                        s4_[tk] = xhalf_sum(v_) * 0.0625f + 0.0f; } \
                    LAS float* dst_ = sc + (4 * (gq) + 2 * hh) * 4096 + 32 * (kb_) + r; dst_[0] = hh ? s4_[2] : s4_[0]; dst_[4096] = hh ? s4_[3] : s4_[1]; } while (0)
                DS_EPI(cA0, 0, kb); DS_EPI(cA1, 1, kb);
                if (hasB) { DS_EPI(cB0, 0, kb + 8); DS_EPI(cB1, 1, kb + 8); }
#undef DS_EPI
            }
#ifdef DSA_DUP_SCORE
            }
#endif
#undef DS_LOADB
#undef DS_UNPK
            { int pn_ = pass, un_ = u0 + F.G; if (un_ >= 2048) { pn_ = pass + 1; un_ = blockIdx.x; } if (pn_ < 2 && un_ < 2048) load_a(pn_, un_); }
            __syncthreads();
#ifdef DSA_DUP_SEL
            for (int rep2_ = 0; rep2_ < 2; ++rep2_)
#endif
            radix_select_write(sc + wave * 4096, hist, (unsigned long long*)(F.ws + WS_DSAMASK) + (base + t0 + wave) * 64, t0 + wave, lane);
            __syncthreads();
        }
    }
}

constexpr int NS_K = 0, NS_KP = 144, NS_V = 256 * NS_KP, NS_VP = 520, NS_IMP = NS_V + 64 * NS_VP, NS_IP = 68, NS_END = NS_IMP + 64 * NS_IP * 4;
static_assert(NS_END <= RING_BYTES, "nsa select LDS map");
__device__ __forceinline__ void nsa_select_phase(Frame& F) {
    const int tid = cur_tid(), wave = cur_wave(), lane = tid & 63, r = lane & 31, hh = lane >> 5;
    LAS unsigned char* lds = F.lds;
    LAS float* imp = (LAS float*)(lds + NS_IMP);
    for (int pass = 0; pass < 2; ++pass) {
        for (int u0 = blockIdx.x; u0 < 256; u0 += F.G) {
            const int u = pass ? 511 - u0 : u0, tb = u >> 3, b = u & 7;
            __syncthreads();
            {
                const bf16* Kc = (const bf16*)(F.ws + WS_KCMPB) + (size_t)b * 256 * 64; const bf16* Vc = (const bf16*)(F.ws + WS_VCMPB) + (size_t)b * 256 * 64;
#pragma unroll
                for (int j = 0; j < 4; ++j) { const int ch = tid + 512 * j, row = ch >> 3, c8 = ch & 7;
                    *(LAS v4u*)(lds + NS_K + row * NS_KP + 16 * c8) = *(const v4u*)(Kc + row * 64 + 8 * c8);
                    const v4u vv = *(const v4u*)(Vc + row * 64 + 8 * c8);
                    LAS unsigned short* vt = (LAS unsigned short*)(lds + NS_V + (8 * c8) * NS_VP) + row;
                    vt[0 * (NS_VP / 2)] = (unsigned short)(vv.x & 0xffffu); vt[1 * (NS_VP / 2)] = (unsigned short)(vv.x >> 16); vt[2 * (NS_VP / 2)] = (unsigned short)(vv.y & 0xffffu); vt[3 * (NS_VP / 2)] = (unsigned short)(vv.y >> 16);
                    vt[4 * (NS_VP / 2)] = (unsigned short)(vv.z & 0xffffu); vt[5 * (NS_VP / 2)] = (unsigned short)(vv.z >> 16); vt[6 * (NS_VP / 2)] = (unsigned short)(vv.w & 0xffffu); vt[7 * (NS_VP / 2)] = (unsigned short)(vv.w >> 16); }
                for (int i = tid; i < 64 * NS_IP; i += 512) imp[i] = 0.f;
            }
            __syncthreads();
            const int tl_ = 8 * wave + (r >> 2), hd = r & 3, t = 64 * tb + tl_; const size_t row = (size_t)b * T + t;
            const bf16* qrow = (const bf16*)(F.ws + WS_QN) + row * 256 + hd * 64;
            bf16x8 qf[4];
#pragma unroll
            for (int ks = 0; ks < 4; ++ks) qf[ks] = *(const bf16x8*)(qrow + 16 * ks + 8 * hh);
            const int nmax = (t - 31) >> 4;
            const int ntile = ((4 * tb + 2) >> 6) + 1;
            const float sc2 = 0.125f * 1.4426950408889634f;
            auto scores = [&](int tile, f32x16& p0, f32x16& p1) {
#pragma unroll
                for (int i = 0; i < 16; ++i) { p0[i] = 0.f; p1[i] = 0.f; }
                const LAS unsigned char* Kb = lds + NS_K + (64 * tile) * NS_KP;
#pragma unroll
                for (int ks = 0; ks < 4; ++ks) {
                    const bf16x8 a0 = *(const LAS bf16x8*)(Kb + r * NS_KP + (16 * ks + 8 * hh) * 2), a1 = *(const LAS bf16x8*)(Kb + (32 + r) * NS_KP + (16 * ks + 8 * hh) * 2);
                    p0 = __builtin_amdgcn_mfma_f32_32x32x16_bf16(a0, qf[ks], p0, 0, 0, 0);
                    p1 = __builtin_amdgcn_mfma_f32_32x32x16_bf16(a1, qf[ks], p1, 0, 0, 0);
                }
            };
            float m = -1e30f, l = 0.f;
            for (int tile = 0; tile < ntile; ++tile) {
                const unsigned long long word = causal_word(nmax - 64 * tile);
                f32x16 p0, p1; scores(tile, p0, p1);
                const unsigned wlo = (unsigned)word >> (4 * hh), whi = (unsigned)(word >> 32) >> (4 * hh);
                float mx = -1e30f;
#pragma unroll
                for (int i = 0; i < 16; ++i) { const int bit = (i & 3) + 8 * (i >> 2);
                    p0[i] = ((wlo >> bit) & 1u) ? p0[i] * sc2 : -1e30f; p1[i] = ((whi >> bit) & 1u) ? p1[i] * sc2 : -1e30f; mx = fmaxf(mx, fmaxf(p0[i], p1[i])); }
                mx = xhalf_max(mx);
                const float mn = fmaxf(m, mx), alpha = __builtin_amdgcn_exp2f(m - mn); m = mn;
                float ps = 0.f;
#pragma unroll
                for (int i = 0; i < 16; ++i) { const int bit = (i & 3) + 8 * (i >> 2);
                    ps += (((wlo >> bit) & 1u) ? __builtin_amdgcn_exp2f(p0[i] - mn) : 0.f) + (((whi >> bit) & 1u) ? __builtin_amdgcn_exp2f(p1[i] - mn) : 0.f); }
                l = l * alpha + ps;
            }
            l = xhalf_sum(l);
            const float inv = l > 0.f ? 1.0f / l : 0.f;
            f32x16 o0, o1;
#pragma unroll
            for (int i = 0; i < 16; ++i) { o0[i] = 0.f; o1[i] = 0.f; }
            float carry = 0.f;
            for (int tile = 0; tile < ntile; ++tile) {
                const unsigned long long word = causal_word(nmax - 64 * tile);
                f32x16 p0, p1; scores(tile, p0, p1);
                const unsigned wlo = (unsigned)word >> (4 * hh), whi = (unsigned)(word >> 32) >> (4 * hh);
#pragma unroll
                for (int i = 0; i < 16; ++i) { const int bit = (i & 3) + 8 * (i >> 2);
                    p0[i] = ((wlo >> bit) & 1u) ? __builtin_amdgcn_exp2f(p0[i] * sc2 - m) * inv : 0.f; p1[i] = ((whi >> bit) & 1u) ? __builtin_amdgcn_exp2f(p1[i] * sc2 - m) * inv : 0.f; }
#pragma unroll
                for (int blk = 0; blk < 2; ++blk) {
                    float tot[4];
#pragma unroll
                    for (int g = 0; g < 4; ++g) {
                        const float a = blk ? p1[4 * g] : p0[4 * g], b1 = blk ? p1[4 * g + 1] : p0[4 * g + 1], c1 = blk ? p1[4 * g + 2] : p0[4 * g + 2], d1 = blk ? p1[4 * g + 3] : p0[4 * g + 3];
                        const float mainv = (a + b1) + (c1 + d1);
                        const float recv = xhalf_other(d1, hh);
                        const float below = hh ? recv : carry;
                        tot[g] = mainv + below;
                        carry = recv;
                    }
#pragma unroll
                    for (int g = 0; g < 4; ++g) { float v = tot[g]; v += dpp_f<0xB1>(v); v += dpp_f<0x4E>(v);
                        if (hd == 0) imp[tl_ * NS_IP + 16 * tile + 8 * blk + 2 * g + hh] = v; }
                }
                bf16x8 pf[4];
#pragma unroll
                for (int s = 0; s < 4; ++s) { v4u w;
                    if (s < 2) { w.x = pg8::cvt_pk_bf16(p0[8 * s], p0[8 * s + 1]); w.y = pg8::cvt_pk_bf16(p0[8 * s + 2], p0[8 * s + 3]); w.z = pg8::cvt_pk_bf16(p0[8 * s + 4], p0[8 * s + 5]); w.w = pg8::cvt_pk_bf16(p0[8 * s + 6], p0[8 * s + 7]); }
                    else { const int s2 = s - 2; w.x = pg8::cvt_pk_bf16(p1[8 * s2], p1[8 * s2 + 1]); w.y = pg8::cvt_pk_bf16(p1[8 * s2 + 2], p1[8 * s2 + 3]); w.z = pg8::cvt_pk_bf16(p1[8 * s2 + 4], p1[8 * s2 + 5]); w.w = pg8::cvt_pk_bf16(p1[8 * s2 + 6], p1[8 * s2 + 7]); }
                    pf[s] = __builtin_bit_cast(bf16x8, w); }
#pragma unroll
                for (int s = 0; s < 4; ++s) {
                    const int kb = 64 * tile + 32 * (s >> 1) + 16 * (s & 1) + 4 * hh;
#pragma unroll
                    for (int db = 0; db < 2; ++db) {
                        const LAS unsigned char* vp_ = lds + NS_V + (32 * db + r) * NS_VP + kb * 2;
                        typedef unsigned u32x2v __attribute__((ext_vector_type(2)));
                        const u32x2v lo = *(const LAS u32x2v*)vp_, hi = *(const LAS u32x2v*)(vp_ + 16);
                        v4u aw; aw.x = lo.x; aw.y = lo.y; aw.z = hi.x; aw.w = hi.y;
                        const bf16x8 a = __builtin_bit_cast(bf16x8, aw);
                        if (db == 0) o0 = __builtin_amdgcn_mfma_f32_32x32x16_bf16(a, pf[s], o0, 0, 0, 0);
                        else o1 = __builtin_amdgcn_mfma_f32_32x32x16_bf16(a, pf[s], o1, 0, 0, 0);
                    }
                }
            }
            flash_store((bf16*)(F.ws + WS_OC) + row * 256 + hd * 64, o0, o1, 1.0f, hh);
            LDS_WAIT(); asm volatile("" ::: "memory");
            for (int k = 0; k < 8; ++k) {
                const int tk = 64 * tb + 8 * wave + k, own = tk >> 6;
                const float iv = imp[(8 * wave + k) * NS_IP + lane];
                const bool causal = lane <= own, forced = causal && (lane == 0 || lane >= own - 1);
                const float val = forced ? 1e4f : (causal ? iv : -INFINITY);
                const unsigned kv_ = fkey(val); const unsigned klo = (kv_ << 6) | (unsigned)(63 - lane), khi = kv_ >> 26;
                int rank = 0;
#pragma unroll
                for (int j = 0; j < 64; ++j) { const unsigned jlo = (unsigned)__builtin_amdgcn_readlane((int)klo, j), jhi = (unsigned)__builtin_amdgcn_readlane((int)khi, j);
                    rank += (jhi > khi || (jhi == khi && jlo > klo)) ? 1 : 0; }
                const unsigned long long selm = __ballot(causal && rank < 16);
                if (lane == 0) ((unsigned long long*)(F.ws + WS_NSEL))[(size_t)b * T + tk] = selm;
            }
        }
    }
}
#ifndef PHMASK
#define PHMASK 0xFFFFFFFFu
#endif
#define EN(b) ((PHMASK >> (b)) & 1u)
#ifndef DUPMASK
#define DUPMASK 0u
#endif
#define REP(b) for (int rep_ = 0; rep_ < (((DUPMASK >> (b)) & 1u) ? 2 : 1); ++rep_)
__global__ void __launch_bounds__(NWAVES * 64, 2) fwd_kernel(Args args) {
    extern __shared__ __attribute__((aligned(16))) unsigned char lds[];
    Frame F;
    F.lds = (LAS unsigned char*)lds;
    F.MISC = (volatile LAS unsigned*)(F.lds + MISC_OFF);
    F.G = gridDim.x;
    F.ws = args.ws; F.ctl = (gu32*)(args.ws + WS_CTL); F.out = args.out;
    F.A = &args;
    for (int u = threadIdx.x; u < (XTRA_OFF - LDSCTL_OFF) / 4; u += NWAVES * 64) ((LAS unsigned*)(F.lds + LDSCTL_OFF))[u] = 0u;
    __syncthreads();
    XcdBarrier bar = xcd_barrier_post((unsigned*)(F.ctl + CW_BAR), F.MISC + 8);
#ifdef PHASE_RANGES
    const int lo = args.ph_lo, hi = args.ph_hi;
#endif
#ifdef PHASE_RANGES
#define IN(k) (lo <= (k) && (k) < hi)
#else
#define IN(k) true
#endif
#ifdef DUP_BAR
#define SEAM(k) do { if (IN(k) && IN((k) + 1)) { xcd_barrier(bar); xcd_barrier(bar); } } while (0)
#else
#define SEAM(k) do { if (IN(k) && IN((k) + 1)) xcd_barrier(bar); } while (0)
#endif
    unsigned char* ws = F.ws;
    bf16 *H; signed char* HID; const float *cs64, *cs32, *ada;

    if (EN(0) && IN(0)) REP(0) p0_prologue(F);
    SEAM(0);
    int ph = 1;
    auto half_layer = [&](const int s) __attribute__((always_inline)) {
        const int l = s >> 1, second = s & 1;
        { unsigned char* w_ = args.ws; asm volatile("" : "+s"(w_)); ws = w_; F.ws = w_; }
        H = (bf16*)F.out + (size_t)M * D; HID = (signed char*)(ws + WS_HID); cs64 = (const float*)(ws + WS_CS64); cs32 = (const float*)(ws + WS_CS32); ada = (const float*)(ws + WS_ADA);
        const unsigned char* wl = ws + WS_WTS + (size_t)l * WTS_LAYER;
        const float* adal = ada + (size_t)l * 8 * 9216;
        bf16* XB = (bf16*)(ws + WS_XB);
        if (EN(1) && IN(ph)) {
            if (s == 0) { wgu8_convert(F); norm_mod_phase<false, true>(F, args.in[I_X], args.in[I_F1N] + l * D, adal + 0 * 1024, adal + 1 * 1024, H); }
            else norm_mod_phase<true, true>(F, XB, args.in[second ? I_F2N : I_F1N] + l * D, adal + (second ? 6 : 0) * 1024, adal + (second ? 7 : 1) * 1024, H);
        }
        SEAM(ph); ++ph;
        if (EN(2) && IN(ph)) REP(2) {
            pg8::Gemm g{H, (const bf16*)(wl + (second ? WO_GU2 : WO_GU1)), M, NGU, D / 2}; pg8::StaticOrder S; S.init(M, NGU, F.G, (int)blockIdx.x);
            const float wmax = __uint_as_float(__hip_atomic_load((unsigned*)(F.ctl + CW_WMAX) + 2 * l + second, __ATOMIC_RELAXED, __HIP_MEMORY_SCOPE_AGENT));
            pg8::EpiSwiGLU8 E{HID, FF, (ACT_CLIP / 127.0f) * (wmax / 127.0f)};
            pg8::gemm_phase<pg8::EpiSwiGLU8, pg8::StaticOrder, true, true, true>(F.lds + RING_OFF, g, S, E);
        }
        SEAM(ph); ++ph;
        if (EN(3) && IN(ph)) {
            pg8::Gemm g{(const bf16*)HID, (const bf16*)(wl + (second ? WO_D2 : WO_D1)), M, D, FF / 2}; pg8::StaticOrder S; S.init(M, D, F.G, (int)blockIdx.x);
            const float wmaxd = __uint_as_float(__hip_atomic_load((unsigned*)(F.ctl + CW_WMAX) + 4 + 2 * l + second, __ATOMIC_RELAXED, __HIP_MEMORY_SCOPE_AGENT));
            const float cf = 0.5f * (pg8::HID_CLIP / 127.0f) * (wmaxd / 127.0f);
            if (s == 0) { pg8::EpiResid<false, true> E{args.in[I_X], XB, adal + 2 * 1024, cf};
                pg8::gemm_phase<pg8::EpiResid<false, true>, pg8::StaticOrder, true, true, true>(F.lds + RING_OFF, g, S, E); }
            else { pg8::EpiResid<true, true> E{XB, XB, adal + (second ? 8 : 2) * 1024, cf};
                pg8::gemm_phase<pg8::EpiResid<true, true>, pg8::StaticOrder, true, true, true>(F.lds + RING_OFF, g, S, E); }
        }
        SEAM(ph); ++ph;
        if (second) return;
        if (EN(4) && IN(ph)) norm_mod_phase<true, false>(F, XB, args.in[I_MIXN] + l * D, adal + 3 * 1024, adal + 4 * 1024, H);
        SEAM(ph); ++ph;
        if (EN(5) && IN(ph)) REP(5) {
            pg8::Gemm g{H, (const bf16*)(wl + WO_IN), M, NINP, D}; pg8::StaticOrder S; S.init(M, NINP, F.G, (int)blockIdx.x);
            pg8::EpiProj<WinDesc> E{WinDesc{ws}, cs64, cs32, nullptr};
            pg8::gemm_phase<pg8::EpiProj<WinDesc>, pg8::StaticOrder, true, true>(F.lds + RING_OFF, g, S, E);
        }
        SEAM(ph); ++ph;
        if (EN(6) && IN(ph)) REP(6) {
            m1_phase(F, l);
            { int kq = 2048; asm volatile("" : "+s"(kq)); pg8::Gemm g{(const bf16*)(ws + WS_KC), (const bf16*)(wl + WO_C1K), 2048, 256, kq, 1024}; pg8::RangeOrder S{8, 0};
              pg8::EpiCmpH E{(float*)(ws + WS_CMPH), (const float*)(ws + WS_CMPB) + (l * 2 + 0) * 256};
              pg8::gemm_phase<pg8::EpiCmpH, pg8::RangeOrder, false, true>(F.lds + RING_OFF, g, S, E); }
            { int kq = 2048; asm volatile("" : "+s"(kq)); pg8::Gemm g{(const bf16*)(ws + WS_VC), (const bf16*)(wl + WO_C1V), 2048, 256, kq, 1024}; pg8::RangeOrder S{8, 8};
              pg8::EpiCmpH E{(float*)(ws + WS_CMPH) + (size_t)8 * 256 * 256, (const float*)(ws + WS_CMPB) + (l * 2 + 1) * 256};
              pg8::gemm_phase<pg8::EpiCmpH, pg8::RangeOrder, false, true>(F.lds + RING_OFF, g, S, E); }
        }
        SEAM(ph); ++ph;
        if (IN(ph)) {
            if (EN(7)) REP(7) { int kq = 256; asm volatile("" : "+s"(kq)); pg8::Gemm g{(const bf16*)(ws + WS_CQ), (const bf16*)(wl + WO_UQ), M, 512, kq}; pg8::StaticOrder S; S.init(M, 512, F.G, (int)blockIdx.x);
              pg8::EpiProj<MlaQDesc> E{MlaQDesc{ws}, cs64, cs32, (const float*)(ws + WS_RSTDQ)};
              pg8::gemm_phase<pg8::EpiProj<MlaQDesc>, pg8::StaticOrder, true, true>(F.lds + RING_OFF, g, S, E); }
            if (EN(8)) REP(7) { int kq = 128; asm volatile("" : "+s"(kq)); pg8::Gemm g{(const bf16*)(ws + WS_CKV), (const bf16*)(wl + WO_UKV), M, 512, kq}; pg8::StaticOrder S; S.init(M, 512, F.G, (int)blockIdx.x);
              pg8::EpiProj<MlaKvDesc> E{MlaKvDesc{ws}, cs64, cs32, (const float*)(ws + WS_RSTDKV)};
              pg8::gemm_phase<pg8::EpiProj<MlaKvDesc>, pg8::StaticOrder, true, true>(F.lds + RING_OFF, g, S, E); }
            if (EN(9)) REP(9) cmp2_phase(F, l);
#ifdef FLASH_DSA
            if (EN(10)) REP(10) dsa_select_phase(F);
#else
            if (EN(10)) REP(10) dsa_tokens_phase(F);
#endif
        }
        SEAM(ph); ++ph;
#ifdef FLASH_NSA
        if (IN(ph)) { if (EN(13)) REP(13) nsa_select_phase(F); }
        SEAM(ph); ++ph;
#endif
        if (IN(ph)) {
#ifdef FLASH_MOBA
            if (EN(11)) REP(11) moba_flash_phase(F);
#else
            if (EN(11)) moba_rows_phase(F);
#endif
#ifdef FLASH_MLA
            if (EN(12)) REP(12) mla_flash_phase(F);
#else
            if (EN(12)) mla_rows_phase(F);
#endif
#ifdef FLASH_NSA
            if (EN(13)) REP(14) nsa_flash_phase(F);
#else
            if (EN(13)) nsa_tokens_phase(F);
#endif
#ifdef FLASH_DSA
            if (EN(10)) REP(15) dsa_flash_phase(F);
#endif
        }
        SEAM(ph); ++ph;
        if (EN(14) && IN(ph)) group_norm_phase(F, H, args.in[I_GN] + l * 1024);
        SEAM(ph); ++ph;
        if (EN(15) && IN(ph)) {
            pg8::Gemm g{H, (const bf16*)(wl + WO_OUT), M, D, D}; pg8::StaticOrder S; S.init(M, D, F.G, (int)blockIdx.x);
            pg8::EpiResid<true> E{XB, XB, adal + 5 * 1024, 1.0f};
            pg8::gemm_phase<pg8::EpiResid<true>, pg8::StaticOrder, true, true>(F.lds + RING_OFF, g, S, E);
        }
        SEAM(ph); ++ph;
    };
    half_layer(0); half_layer(1);
#ifdef DUP_LAYER0
    half_layer(0); half_layer(1);
#endif
    half_layer(2); half_layer(3);
    if (EN(16) && IN(ph)) final_norm_phase(F, (const bf16*)(args.ws + WS_XB), F.out, args.in[I_FINN]);
#undef IN
#undef SEAM
}
#ifdef FLASH_NSA
constexpr int N_PHASES = 1 + 4 * 3 + 2 * 8 + 1;
#else
constexpr int N_PHASES = 1 + 4 * 3 + 2 * 7 + 1;
#endif

extern "C" void kernel_launch(void* const* d_in, const int* in_sizes, int n_in, void* d_out, int out_size, void* d_ws, size_t ws_size, hipStream_t stream) {
    static int grid = 0;
    if (grid == 0) {
        if (n_in != 28 || in_sizes[0] != M * D || out_size != M * D || ws_size < WS_END) { fprintf(stderr, "kernel_launch: unexpected problem shape (n_in %d, in0 %d, out %d, ws %zu); nothing launched\n", n_in, n_in > 0 ? in_sizes[0] : -1, out_size, ws_size); grid = -1; return; }
        int dev = 0, cus = 0, per_cu = 0;
        if (hipGetDevice(&dev) != hipSuccess || hipDeviceGetAttribute(&cus, hipDeviceAttributeMultiprocessorCount, dev) != hipSuccess) { grid = -1; return; }
        if (hipFuncSetAttribute((const void*)fwd_kernel, hipFuncAttributeMaxDynamicSharedMemorySize, LDS_BYTES) != hipSuccess) { fprintf(stderr, "kernel_launch: hipFuncSetAttribute failed\n"); grid = -1; return; }
        if (hipOccupancyMaxActiveBlocksPerMultiprocessor(&per_cu, (const void*)fwd_kernel, NWAVES * 64, LDS_BYTES) != hipSuccess || per_cu < 1) { fprintf(stderr, "kernel_launch: occupancy query says %d\n", per_cu); }
        (void)hipGetLastError();
        grid = cus;
    }
    if (grid < 0) return;
    if (hipMemsetAsync((char*)d_ws + WS_CTL, 0, CTL_ZERO_BYTES, stream) != hipSuccess) return;
    Args a{};
    for (int i = 0; i < 28; ++i) a.in[i] = (const float*)d_in[i];
    a.out = (float*)d_out; a.ws = (unsigned char*)d_ws; a.ph_lo = 0; a.ph_hi = N_PHASES + 64;
    hipLaunchKernelGGL(fwd_kernel, dim3(grid), dim3(NWAVES * 64), LDS_BYTES, stream, a);
}
```

```cpp
#include <hip/hip_runtime.h>
#include <cstdio>
#include <cstdint>
#include <cmath>
#ifndef NO_FLASH
#define FLASH_MLA 1
#define FLASH_MOBA 1
#define FLASH_NSA 1
#define FLASH_DSA 1
#endif
namespace pg8 {
#define PG8_LAS __attribute__((address_space(3)))
typedef unsigned short bf16_t;
typedef short bf16x8 __attribute__((ext_vector_type(8)));
typedef float f32x4 __attribute__((ext_vector_type(4)));
typedef unsigned u32x4 __attribute__((ext_vector_type(4)));
constexpr int BM = 256, BK = 64, HALF = 128, HTB = HALF * BK * 2  , STAGE_BYTES = 8 * HTB, NXCD = 8, WGM = 8;

__host__ __device__ __forceinline__ int lds_byte(int r, int c) { const int st = (r >> 4) * 2 + (c >> 5), rr = r & 15, cc = c & 31, ob = rr * 64 + cc * 2; return st * 1024 + (ob ^ (((ob >> 9) & 1) << 5)); }
__host__ __device__ __forceinline__ void stage_rc(int b, int& R, int& C) { const int st = b / 1024, sb = b % 1024, swz = sb ^ (((sb >> 9) & 1) << 5); R = (st >> 1) * 16 + swz / 64; C = (st & 1) * 32 + (swz % 64) / 2; }
__host__ __device__ __forceinline__ int perm32(int rho) { const int n = rho >> 4, i = rho & 15; return 8 * (i >> 2) + 4 * n + (i & 3); }

struct Unit { int pm, pn; };
struct Gemm { const bf16_t* A; const bf16_t* Bt; int M, N, K; int lda = 0; };

struct StaticOrder {
    int nM, nN, nwg, G, c;
    __host__ __device__ void init(int M, int N, int G_, int c_) { nM = M / BM; nN = N / BM; nwg = nM * nN; G = G_; c = c_; }
    __host__ __device__ bool next(int i, Unit& u) const {
        const long L = (long)i * G + c; if (L >= nwg) return false;
        int wgid = (int)L; { const int q = nwg / NXCD, r = nwg % NXCD, xcd = wgid % NXCD, off = wgid / NXCD; wgid = (xcd < r ? xcd * (q + 1) : r * (q + 1) + (xcd - r) * q) + off; }
        const int nig = WGM * nN, gid = wgid / nig, fm = gid * WGM, gsz = (nM - fm) < WGM ? (nM - fm) : WGM;
        u.pm = fm + ((wgid % nig) % gsz); u.pn = (wgid % nig) / gsz; return true;
    }
    __device__ __forceinline__ void a_ready(const Unit&) const {}
    __device__ __forceinline__ void done(const Unit&) const {}
};

__device__ __forceinline__ unsigned cvt_pk_bf16(float lo, float hi) { unsigned r; asm volatile("v_cvt_pk_bf16_f32 %0, %1, %2" : "=v"(r) : "v"(lo), "v"(hi)); return r; }
typedef float f32x2 __attribute__((ext_vector_type(2)));
typedef unsigned u32x2 __attribute__((ext_vector_type(2)));
__device__ __forceinline__ float silu_f(float x) { return x * __builtin_amdgcn_rcpf(1.0f + __builtin_amdgcn_exp2f(-1.4426950408889634f * x)); }

struct EpiSwiGLU {
    static constexpr bool PERM = false, AFTER_DRAIN = false;
    bf16_t* H; int ldh;
    __device__ __forceinline__ void operator()(const f32x4 (&acc)[2][2][4][2], const Unit& u, int wr, int wc, int fr, int fq) const {
        const int row0 = u.pm * BM + wr * 64 + fr;
        const int hc0 = u.pn * 128 + wc * 16 + 4 * fq;
#pragma unroll
        for (int ai = 0; ai < 2; ++ai)
#pragma unroll
            for (int m = 0; m < 4; ++m) {
                bf16_t* rowp = H + (size_t)(row0 + ai * HALF + m * 16) * ldh + hc0;
#pragma unroll
                for (int bj = 0; bj < 2; ++bj) {
                    const f32x4 g = acc[ai][bj][m][0], uu = acc[ai][bj][m][1];
                    u32x2 w; w.x = cvt_pk_bf16(silu_f(g[0]) * uu[0], silu_f(g[1]) * uu[1]); w.y = cvt_pk_bf16(silu_f(g[2]) * uu[2], silu_f(g[3]) * uu[3]);
                    *(u32x2*)(rowp + bj * 64) = w;
                }
            }
    }
};

__device__ __forceinline__ unsigned q8pack4(float a, float b, float c, float d, float qs) {
    const float MG = 12582912.0f; const int MB = 0x4B400000;
    int ia = __float_as_int(__builtin_fmaf(a, qs, MG)), ib = __float_as_int(__builtin_fmaf(b, qs, MG)), ic = __float_as_int(__builtin_fmaf(c, qs, MG)), id = __float_as_int(__builtin_fmaf(d, qs, MG));
    ia = min(max(ia, MB - 127), MB + 127); ib = min(max(ib, MB - 127), MB + 127); ic = min(max(ic, MB - 127), MB + 127); id = min(max(id, MB - 127), MB + 127);
    return __builtin_amdgcn_perm((unsigned)ib, (unsigned)ia, 0x0c0c0400u) | __builtin_amdgcn_perm((unsigned)id, (unsigned)ic, 0x04000c0cu);
}
constexpr float HID_CLIP = 9.0f;
struct EpiSwiGLU8 {
    static constexpr bool PERM = false, AFTER_DRAIN = false;
    signed char* H; int ldh; float deq;
    __device__ __forceinline__ void operator()(const f32x4 (&acc)[2][2][4][2], const Unit& u, int wr, int wc, int fr, int fq) const {
        typedef int i32x4_ __attribute__((ext_vector_type(4)));
        const int row0 = u.pm * BM + wr * 64 + fr;
        const int hc0 = u.pn * 128 + wc * 16 + 4 * fq;
#pragma unroll
        for (int ai = 0; ai < 2; ++ai)
#pragma unroll
            for (int m = 0; m < 4; ++m) {
                signed char* rowp = H + (size_t)(row0 + ai * HALF + m * 16) * ldh + hc0;
#pragma unroll
                for (int bj = 0; bj < 2; ++bj) {
                    const i32x4_ gi = __builtin_bit_cast(i32x4_, acc[ai][bj][m][0]), ui = __builtin_bit_cast(i32x4_, acc[ai][bj][m][1]);
                    float g[4], uu[4];
#pragma unroll
                    for (int i = 0; i < 4; ++i) { g[i] = (float)gi[i] * deq; uu[i] = (float)ui[i] * deq; }
                    *(unsigned*)(rowp + bj * 64) = q8pack4(silu_f(g[0]) * uu[0], silu_f(g[1]) * uu[1], silu_f(g[2]) * uu[2], silu_f(g[3]) * uu[3], 127.0f / HID_CLIP);
                }
            }
    }
};

template <bool XIN_BF16, bool I8 = false> struct EpiResid {
    static constexpr bool PERM = false, AFTER_DRAIN = false;
    const void* xin; bf16_t* xout; const float* gate; float coef;
    __device__ __forceinline__ void operator()(const f32x4 (&acc)[2][2][4][2], const Unit& u, int wr, int wc, int fr, int fq) const {
        const int b = (u.pm * BM) >> 12;
        const float* gv = gate + (size_t)b * 9216;
        const int row0 = u.pm * BM + wr * 64 + fr, col0 = u.pn * BM + wc * 32 + 4 * fq;
        f32x4 g[2][2];
#pragma unroll
        for (int bj = 0; bj < 2; ++bj)
#pragma unroll
            for (int n = 0; n < 2; ++n) g[bj][n] = *(const f32x4*)(gv + col0 + bj * HALF + n * 16) * coef;
#pragma unroll
        for (int ai = 0; ai < 2; ++ai)
#pragma unroll
            for (int m = 0; m < 4; ++m) {
                const size_t off = (size_t)(row0 + ai * HALF + m * 16) * 1024 + col0;
#pragma unroll
                for (int bj = 0; bj < 2; ++bj)
#pragma unroll
                    for (int n = 0; n < 2; ++n) {
                        f32x4 xi;
                        if (XIN_BF16) { const u32x2 w = *(const u32x2*)((const bf16_t*)xin + off + bj * HALF + n * 16);
                            xi[0] = __uint_as_float(w.x << 16); xi[1] = __uint_as_float(w.x & 0xffff0000u); xi[2] = __uint_as_float(w.y << 16); xi[3] = __uint_as_float(w.y & 0xffff0000u); }
                        else xi = *(const f32x4*)((const float*)xin + off + bj * HALF + n * 16);
                        f32x4 av = acc[ai][bj][m][n];
                        if (I8) { typedef int i32x4_ __attribute__((ext_vector_type(4))); const i32x4_ q = __builtin_bit_cast(i32x4_, av); av = (f32x4){(float)q[0], (float)q[1], (float)q[2], (float)q[3]}; }
                        const f32x4 xo = xi + g[bj][n] * av;
                        u32x2 wo; wo.x = cvt_pk_bf16(xo[0], xo[1]); wo.y = cvt_pk_bf16(xo[2], xo[3]);
                        *(u32x2*)(xout + off + bj * HALF + n * 16) = wo; }
                if (m & 1) asm volatile("" ::: "memory");
            }
    }
};

struct ProjDesc { int kind, dfreq0, nstride, rep, repstride, bpitch, fpitch, pad; bf16_t* bp; float* fp; };
template <class DescFn> struct EpiProj {
    static constexpr bool PERM = false, AFTER_DRAIN = false;
    DescFn df; const float* cs64; const float* cs32; const float* rowscale;
    __device__ __forceinline__ void operator()(const f32x4 (&acc)[2][2][4][2], const Unit& u, int wr, int wc, int fr, int fq) const {
        const int row0 = u.pm * BM + wr * 64 + fr;
#pragma unroll
        for (int bj = 0; bj < 2; ++bj) {
            const int G = u.pn * 8 + bj * 4 + wc;
            const ProjDesc d = df(G);
            if (d.kind != 0) {
#pragma unroll
                for (int ai = 0; ai < 2; ++ai)
#pragma unroll
                    for (int m = 0; m < 4; ++m) {
                        const int row = row0 + ai * HALF + m * 16;
                        f32x4 v0 = acc[ai][bj][m][0], v1 = acc[ai][bj][m][1];
                        if (rowscale) { const float rs = rowscale[row]; v0 = v0 * rs; v1 = v1 * rs; }
                        if (d.kind >= 2) {
                            const int pos = row & 4095;
                            const float* cs = (d.kind == 2) ? cs64 + ((size_t)pos * 32 + d.dfreq0 + 4 * fq) * 2 : cs32 + ((size_t)pos * 16 + 4 * fq) * 2;
                            const f32x4 a = *(const f32x4*)cs, b2 = *(const f32x4*)(cs + 4);
                            const f32x4 c = {a[0], a[2], b2[0], b2[2]}, s = {a[1], a[3], b2[1], b2[3]};
                            const f32x4 o0 = v0 * c - v1 * s, o1 = v1 * c + v0 * s; v0 = o0; v1 = o1;
                        }
                        if (d.bp) {
                            u32x2 w0, w1; w0.x = cvt_pk_bf16(v0[0], v0[1]); w0.y = cvt_pk_bf16(v0[2], v0[3]); w1.x = cvt_pk_bf16(v1[0], v1[1]); w1.y = cvt_pk_bf16(v1[2], v1[3]);
                            bf16_t* p = d.bp + (size_t)row * d.bpitch + 4 * fq;
                            for (int rp = 0; rp < d.rep; ++rp) { *(u32x2*)(p + rp * d.repstride) = w0; *(u32x2*)(p + rp * d.repstride + d.nstride) = w1; }
                        }
                        if (d.fp) { float* p = d.fp + (size_t)row * d.fpitch + 4 * fq;
                            if (d.pad) {
                                typedef unsigned u32x4v __attribute__((ext_vector_type(4)));
                                u32x4v w0, w1;
#pragma unroll
                                for (int q = 0; q < 2; ++q) { const f32x4 v = q ? v1 : v0;
                                    const unsigned h01 = cvt_pk_bf16(v[0], v[1]), h23 = cvt_pk_bf16(v[2], v[3]);
                                    const unsigned l01 = cvt_pk_bf16(v[0] - __uint_as_float(h01 << 16), v[1] - __uint_as_float(h01 & 0xffff0000u)), l23 = cvt_pk_bf16(v[2] - __uint_as_float(h23 << 16), v[3] - __uint_as_float(h23 & 0xffff0000u));
                                    u32x4v w; w.x = (h01 & 0xffffu) | (l01 << 16); w.y = (h01 >> 16) | (l01 & 0xffff0000u); w.z = (h23 & 0xffffu) | (l23 << 16); w.w = (h23 >> 16) | (l23 & 0xffff0000u);
                                    if (q) w1 = w; else w0 = w; }
                                *(u32x4v*)p = w0; *(u32x4v*)(p + d.nstride) = w1;
                            } else { *(f32x4*)p = v0; *(f32x4*)(p + d.nstride) = v1; } }
                        asm volatile("" ::: "memory");
                    }
            }
        }
    }
};


struct EpiCmpH {
    static constexpr bool PERM = false, AFTER_DRAIN = false;
    float* out; const float* bias;
    __device__ __forceinline__ void operator()(const f32x4 (&acc)[2][2][4][2], const Unit& u, int wr, int wc, int fr, int fq) const {
        const int row0 = u.pm * BM + wr * 64 + fr, col0 = wc * 32 + 4 * fq;
        f32x4 bv[2][2];
#pragma unroll
        for (int bj = 0; bj < 2; ++bj)
#pragma unroll
            for (int n = 0; n < 2; ++n) bv[bj][n] = *(const f32x4*)(bias + col0 + bj * HALF + n * 16);
#pragma unroll
        for (int ai = 0; ai < 2; ++ai)
#pragma unroll
            for (int m = 0; m < 4; ++m) {
                float* rowp = out + (size_t)(row0 + ai * HALF + m * 16) * 256 + col0;
#pragma unroll
                for (int bj = 0; bj < 2; ++bj)
#pragma unroll
                    for (int n = 0; n < 2; ++n) { const f32x4 v = acc[ai][bj][m][n] + bv[bj][n];
                        f32x4 o; o[0] = silu_f(v[0]); o[1] = silu_f(v[1]); o[2] = silu_f(v[2]); o[3] = silu_f(v[3]); *(f32x4*)(rowp + bj * HALF + n * 16) = o; }
            }
    }
};
struct RangeOrder {
    int nM, c0;
    __device__ __forceinline__ bool next(int i, Unit& u) const { const int idx = (int)blockIdx.x - c0; if (i > 0 || idx < 0 || idx >= nM) return false; u.pm = idx; u.pn = 0; return true; }
    __device__ __forceinline__ void a_ready(const Unit&) const {}
    __device__ __forceinline__ void done(const Unit&) const {}
};
template <class Epi, class Sched, bool ALIGN_EPI = false, bool SP2 = false, bool I8 = false>
__device__ __forceinline__ void gemm_phase(PG8_LAS unsigned char* lds, const Gemm g, const Sched& S, const Epi& E) {
    int tid_ = threadIdx.x; asm volatile("" : "+v"(tid_));
    const int tid = tid_, wid = __builtin_amdgcn_readfirstlane(tid >> 6), lane = tid & 63, wr = wid >> 2, wc = wid & 3, fr = lane & 15, fq = lane >> 4;
    const int K = g.K, nt = K / BK, lda = g.lda ? g.lda : g.K;
    unsigned voffA[2], voffB[2];
#pragma unroll
    for (int i = 0; i < 2; ++i) { int R, C; stage_rc(tid * 16 + i * 8192, R, C); const int Rb = Epi::PERM ? ((R & ~31) + perm32(R & 31)) : R;
        voffA[i] = (unsigned)(R * lda + C) * 2u; voffB[i] = (unsigned)(Rb * K + C) * 2u; }
    const size_t kstep = (size_t)(BK * 2);
    const size_t hstepB = (size_t)HALF * K * 2, hstepA = (size_t)HALF * lda * 2;
    const size_t tstepB = 2 * hstepB, tstepA = 2 * hstepA;
    const unsigned ldsw = (unsigned)wid * 1024u;
    const int aoff = lds_byte(wr * 64 + fr, fq * 8), boff = lds_byte(wc * 32 + fr, fq * 8);
#define PG8_SA(b, h) (((b) * 2 + (h)) * HTB)
#define PG8_SB(b, h) ((4 + (b) * 2 + (h)) * HTB)
#define PG8_STAGE(bufoff, gbase, voff) do { _Pragma("unroll") for (int _i = 0; _i < 2; ++_i) \
        __builtin_amdgcn_global_load_lds((const unsigned*)((const char*)(gbase) + (voff)[_i]), (PG8_LAS unsigned*)(lds + (bufoff) + ldsw + _i * 8192), 16, 0, 0); } while (0)
#define PG8_LDA(dst, b, h) do { _Pragma("unroll") for (int m = 0; m < 4; ++m) _Pragma("unroll") for (int k = 0; k < 2; ++k) dst[m][k] = *(const PG8_LAS bf16x8*)(lds + PG8_SA(b, h) + aoff + m * 2048 + k * 1024); } while (0)
#define PG8_LDB(dst, b, h) do { _Pragma("unroll") for (int n = 0; n < 2; ++n) _Pragma("unroll") for (int k = 0; k < 2; ++k) dst[n][k] = *(const PG8_LAS bf16x8*)(lds + PG8_SB(b, h) + boff + n * 2048 + k * 1024); } while (0)
#define PG8_MMA(ai, bj, At, Bt) do { __builtin_amdgcn_s_setprio(1); _Pragma("unroll") for (int m = 0; m < 4; ++m) _Pragma("unroll") for (int n = 0; n < 2; ++n) _Pragma("unroll") for (int k = 0; k < 2; ++k) \
        { if constexpr (I8) { typedef int i32x4_ __attribute__((ext_vector_type(4))); acc[ai][bj][m][n] = __builtin_bit_cast(f32x4, __builtin_amdgcn_mfma_i32_16x16x64_i8(__builtin_bit_cast(i32x4_, Bt[n][k]), __builtin_bit_cast(i32x4_, At[m][k]), __builtin_bit_cast(i32x4_, acc[ai][bj][m][n]), 0, 0, 0)); } \
          else acc[ai][bj][m][n] = __builtin_amdgcn_mfma_f32_16x16x32_bf16(Bt[n][k], At[m][k], acc[ai][bj][m][n], 0, 0, 0); } __builtin_amdgcn_s_setprio(0); } while (0)
#define PG8_WAIT_V(n) asm volatile("s_waitcnt vmcnt(" #n ")" ::: "memory")
#define PG8_WAIT_L(n) asm volatile("s_waitcnt lgkmcnt(" #n ")" ::: "memory")
#define PG8_BAR __builtin_amdgcn_s_barrier()
#define PG8_SCHED __builtin_amdgcn_sched_barrier(0)
    Unit cur, nxt; int ui = 0;
    if (!S.next(0, cur)) return;
    f32x4 acc[2][2][4][2];
#pragma unroll
    for (int a = 0; a < 2; ++a)
#pragma unroll
        for (int b = 0; b < 2; ++b)
#pragma unroll
            for (int m = 0; m < 4; ++m)
#pragma unroll
                for (int n = 0; n < 2; ++n) acc[a][b][m][n] = (f32x4){0.f, 0.f, 0.f, 0.f};
    bf16x8 At[4][2], B0[2][2], B1[2][2];
    const char* cA = (const char*)g.A + (size_t)cur.pm * tstepA; const char* cB = (const char*)g.Bt + (size_t)cur.pn * tstepB;
    S.a_ready(cur);
    if constexpr (SP2) {
        PG8_STAGE(PG8_SB(0, 0), cB, voffB); PG8_STAGE(PG8_SB(0, 1), cB + hstepB, voffB); PG8_STAGE(PG8_SA(0, 0), cA, voffA); PG8_STAGE(PG8_SA(0, 1), cA + hstepA, voffA);
        if (wr == 1) PG8_BAR;
        PG8_WAIT_V(2); PG8_BAR;
        PG8_STAGE(PG8_SB(1, 0), cB + kstep, voffB); PG8_STAGE(PG8_SA(1, 0), cA + kstep, voffA); PG8_STAGE(PG8_SB(1, 1), cB + hstepB + kstep, voffB);
        PG8_WAIT_V(6); PG8_BAR;
    } else {
        PG8_STAGE(PG8_SB(0, 0), cB, voffB); PG8_STAGE(PG8_SA(0, 0), cA, voffA); PG8_STAGE(PG8_SB(0, 1), cB + hstepB, voffB); PG8_STAGE(PG8_SA(0, 1), cA + hstepA, voffA);
        if (wr == 1) PG8_BAR;
        PG8_WAIT_V(4); PG8_BAR;
        PG8_STAGE(PG8_SB(1, 0), cB + kstep, voffB); PG8_STAGE(PG8_SA(1, 0), cA + kstep, voffA); PG8_STAGE(PG8_SB(1, 1), cB + hstepB + kstep, voffB);
        PG8_WAIT_V(6); PG8_BAR;
    }
    for (;;) {
        const bool has_next = S.next(ui + 1, nxt);
        const char* nA = has_next ? (const char*)g.A + (size_t)nxt.pm * tstepA : cA; const char* nB = has_next ? (const char*)g.Bt + (size_t)nxt.pn * tstepB : cB;
        for (int t = 0; t < nt; t += 2) {
            const bool last = (t == nt - 2);
            const char* a1 = cA + (size_t)(t + 1) * kstep;
            const char* a2 = last ? nA : cA + (size_t)(t + 2) * kstep; const char* b2 = last ? nB : cB + (size_t)(t + 2) * kstep;
            const char* a3 = a2 + kstep; const char* b3 = b2 + kstep;
            if (last && has_next) S.a_ready(nxt);
            if constexpr (SP2) {
            PG8_LDB(B0, 0, 0); PG8_LDB(B1, 0, 1); PG8_SCHED; PG8_LDA(At, 0, 0); PG8_STAGE(PG8_SA(1, 1), a1 + hstepA, voffA);
            PG8_WAIT_V(8); PG8_WAIT_L(0); PG8_BAR; PG8_MMA(0, 0, At, B0); PG8_MMA(0, 1, At, B1); PG8_BAR; PG8_SCHED;
            PG8_LDA(At, 0, 1); PG8_STAGE(PG8_SB(0, 0), b2, voffB); PG8_STAGE(PG8_SB(0, 1), b2 + hstepB, voffB); PG8_STAGE(PG8_SA(0, 0), a2, voffA);
            PG8_WAIT_V(8); PG8_WAIT_L(0); PG8_BAR; PG8_MMA(1, 0, At, B0); PG8_MMA(1, 1, At, B1); PG8_BAR; PG8_SCHED;
            PG8_LDB(B0, 1, 0); PG8_LDB(B1, 1, 1); PG8_SCHED; PG8_LDA(At, 1, 0); PG8_STAGE(PG8_SA(0, 1), a2 + hstepA, voffA);
            PG8_WAIT_V(8); PG8_WAIT_L(0); PG8_BAR; PG8_MMA(0, 0, At, B0); PG8_MMA(0, 1, At, B1); PG8_BAR; PG8_SCHED;
            PG8_LDA(At, 1, 1); PG8_STAGE(PG8_SB(1, 0), b3, voffB); PG8_STAGE(PG8_SB(1, 1), b3 + hstepB, voffB); PG8_STAGE(PG8_SA(1, 0), a3, voffA);
            PG8_WAIT_V(8); PG8_WAIT_L(0); PG8_BAR; PG8_MMA(1, 0, At, B0); PG8_MMA(1, 1, At, B1); PG8_BAR; PG8_SCHED;
            } else {
            PG8_LDB(B0, 0, 0); PG8_SCHED; PG8_LDA(At, 0, 0); PG8_STAGE(PG8_SA(1, 1), a1 + hstepA, voffA);
            PG8_WAIT_L(8); PG8_BAR; PG8_WAIT_L(0); PG8_MMA(0, 0, At, B0); PG8_BAR; PG8_SCHED;
            PG8_LDB(B1, 0, 1); PG8_STAGE(PG8_SB(0, 0), b2, voffB);
            PG8_BAR; PG8_WAIT_L(0); PG8_MMA(0, 1, At, B1); PG8_BAR;
            PG8_LDA(At, 0, 1); PG8_STAGE(PG8_SA(0, 0), a2, voffA);
            PG8_BAR; PG8_WAIT_L(0); PG8_MMA(1, 0, At, B0); PG8_BAR; PG8_SCHED;
            PG8_STAGE(PG8_SB(0, 1), b2 + hstepB, voffB);
            PG8_WAIT_V(6); PG8_BAR; PG8_MMA(1, 1, At, B1); PG8_BAR;
            PG8_LDB(B0, 1, 0); PG8_SCHED; PG8_LDA(At, 1, 0); PG8_STAGE(PG8_SA(0, 1), a2 + hstepA, voffA);
            PG8_WAIT_L(8); PG8_BAR; PG8_WAIT_L(0); PG8_MMA(0, 0, At, B0); PG8_BAR; PG8_SCHED;
            PG8_LDB(B1, 1, 1); PG8_STAGE(PG8_SB(1, 0), b3, voffB);
            PG8_BAR; PG8_WAIT_L(0); PG8_MMA(0, 1, At, B1); PG8_BAR;
            PG8_LDA(At, 1, 1); PG8_STAGE(PG8_SA(1, 0), a3, voffA);
            PG8_BAR; PG8_WAIT_L(0); PG8_MMA(1, 0, At, B0); PG8_BAR; PG8_SCHED;
            PG8_STAGE(PG8_SB(1, 1), b3 + hstepB, voffB);
            PG8_WAIT_V(6); PG8_BAR; PG8_MMA(1, 1, At, B1); PG8_BAR;
            }
        }
        if constexpr (ALIGN_EPI) { if (wr == 0) PG8_BAR; }
        if constexpr (!Epi::AFTER_DRAIN) { E(acc, cur, wr, wc, fr, fq); S.done(cur); }
        if (!has_next) break;
#pragma unroll
        for (int a = 0; a < 2; ++a)
#pragma unroll
            for (int b = 0; b < 2; ++b)
#pragma unroll
                for (int m = 0; m < 4; ++m)
#pragma unroll
                    for (int n = 0; n < 2; ++n) acc[a][b][m][n] = (f32x4){0.f, 0.f, 0.f, 0.f};
        cur = nxt; cA = nA; cB = nB; ++ui;
        if constexpr (ALIGN_EPI) { if (wr == 1) PG8_BAR; }
    }
    PG8_WAIT_V(0);
    if constexpr (!ALIGN_EPI) { if (wr == 0) PG8_BAR; }
    PG8_BAR;
    if constexpr (Epi::AFTER_DRAIN) { E.fused(acc, cur, wr, wc, fr, fq, lds, wid, lane); S.done(cur); }
#undef PG8_SA
#undef PG8_SB
#undef PG8_STAGE
#undef PG8_LDA
#undef PG8_LDB
#undef PG8_MMA
#undef PG8_WAIT_V
#undef PG8_WAIT_L
#undef PG8_BAR
#undef PG8_SCHED
}
}
#define GAS __attribute__((address_space(1)))
#define LAS __attribute__((address_space(3)))
typedef unsigned short bf16;
typedef unsigned v4u __attribute__((ext_vector_type(4)));
typedef float f32x4 __attribute__((ext_vector_type(4)));
typedef short bf16x8 __attribute__((ext_vector_type(8)));
typedef GAS unsigned gu32;
typedef GAS unsigned long long gu64;
#define RLX_AGENT __ATOMIC_RELAXED, __HIP_MEMORY_SCOPE_AGENT
#define LDS_WAIT() asm volatile("s_waitcnt lgkmcnt(0)" ::: "memory")
#define VM_WAIT() asm volatile("s_waitcnt vmcnt(0)" ::: "memory")
__device__ __forceinline__ unsigned long long rt() { return __builtin_amdgcn_s_memrealtime(); }
__device__ __forceinline__ unsigned f2bf(float f) { unsigned u = __builtin_bit_cast(unsigned, f); return (u + 0x7fffu + ((u >> 16) & 1u)) >> 16; }
__device__ __forceinline__ unsigned pk2(float lo, float hi) { return f2bf(lo) | (f2bf(hi) << 16); }

#define XB_TMO      128
#define XB_XCNT(j)  (256  + 64 * (j))
#define XB_XSUB(j)  (1280 + 64 * (j))
#define XB_XGEN(j)  (2304 + 64 * (j))
#define XB_TOP      3328
#define XB_TOPGEN   3392
#define XCD_BAR_WORDS 3456
#define XB_SPIN_CAP (1u << 24)

__device__ __forceinline__ unsigned xb_ld(unsigned* p)              { return __hip_atomic_load(p, __ATOMIC_RELAXED, __HIP_MEMORY_SCOPE_AGENT); }
__device__ __forceinline__ unsigned xb_add(unsigned* p, unsigned v) { return __hip_atomic_fetch_add(p, v, __ATOMIC_RELAXED, __HIP_MEMORY_SCOPE_AGENT); }
__device__ __forceinline__ unsigned xb_xcc_id() { return (unsigned)__builtin_amdgcn_s_getreg((3 << 11) | 20) & 0xFu; }
#define XB_SPIN(cond, bar) do { unsigned _sp = 0; while (cond) { __builtin_amdgcn_s_sleep(1); \
    if ((++_sp & 255u) == 0u) { if (xb_ld(&(bar)[XB_TMO])) break; if (_sp > XB_SPIN_CAP) { atomicAdd(&(bar)[XB_TMO], 1u); break; } } } } while (0)

struct XcdBarrier {
    unsigned* bar; unsigned x;
    volatile LAS unsigned* st;
};

__device__ __forceinline__ XcdBarrier xcd_barrier_post(unsigned* bar, volatile LAS unsigned* st) {
    XcdBarrier b; b.bar = bar; b.x = xb_xcc_id(); b.st = st;
    if (threadIdx.x == 0) (void)xb_add(&bar[XB_XCNT(b.x)], 1u);
    return b;
}
__device__ __forceinline__ void xcd_barrier_complete(unsigned* bar, unsigned x, unsigned& nloc, unsigned& nx) {
    const unsigned G = gridDim.x * gridDim.y * gridDim.z;
    unsigned sum, cnt, mine, sp = 0u;
    for (;;) {
        sum = 0u; cnt = 0u; mine = 0u;
#pragma unroll
        for (unsigned j = 0; j < 16; ++j) { const unsigned c = xb_ld(&bar[XB_XCNT(j)]); sum += c; cnt += (c > 0u) ? 1u : 0u; mine = (j == x) ? c : mine; }
        if (sum == G) break;
        __builtin_amdgcn_s_sleep(1);
        if ((++sp & 255u) == 0u) { if (xb_ld(&bar[XB_TMO])) break; if (sp > XB_SPIN_CAP) { atomicAdd(&bar[XB_TMO], 1u); break; } }
    }
    nloc = mine > 0u ? mine : 1u; nx = cnt > 0u ? cnt : 1u;
}

__device__ __forceinline__ void xcd_barrier(const XcdBarrier& b) {
    asm volatile("s_waitcnt vmcnt(0)" ::: "memory");
    __syncthreads();
    if (threadIdx.x == 0) {
        unsigned* bar = b.bar; asm volatile("" : "+s"(bar));
        __builtin_amdgcn_s_waitcnt(0);
        unsigned nloc = b.st[0], nx = b.st[1];
        if (nloc == 0u) { xcd_barrier_complete(bar, b.x, nloc, nx); b.st[0] = nloc; b.st[1] = nx; }
        const unsigned old = xb_add(&bar[XB_XSUB(b.x)], 1u);
        const unsigned gen = old / nloc;
        if (old + 1u == (gen + 1u) * nloc) {
            __builtin_amdgcn_fence(__ATOMIC_RELEASE, "agent");
            asm volatile("s_waitcnt vmcnt(0)" ::: "memory");
            const unsigned og = xb_add(&bar[XB_TOP], 1u);
            const unsigned tg = og / nx;
            if (og + 1u == (tg + 1u) * nx) xb_add(&bar[XB_TOPGEN], 1u);
            else XB_SPIN(xb_ld(&bar[XB_TOPGEN]) == tg, bar);
            __builtin_amdgcn_fence(__ATOMIC_ACQUIRE, "agent");
            xb_add(&bar[XB_XGEN(b.x)], 1u);
            asm volatile("s_waitcnt vmcnt(0)" ::: "memory");
        } else {
            XB_SPIN(xb_ld(&bar[XB_XGEN(b.x)]) == gen, bar);
            __builtin_amdgcn_fence(__ATOMIC_ACQUIRE, "agent");
            asm volatile("s_waitcnt vmcnt(0)" ::: "memory");
        }
    }
    __syncthreads();
}
constexpr int NWAVES = 8;
constexpr int BATCH = 8, T = 4096, D = 1024, M = BATCH * T, FF = 2816, NGU = 2 * FF, NINP = 2560, NIN_SRC = 2516, NL = 2;
constexpr float RMS_EPS = 1e-6f;
constexpr size_t MiB = 1u << 20;
constexpr size_t WS_CTL = 0, CTL_ZERO_BYTES = 1 * MiB;
constexpr size_t WS_CS64 = 1 * MiB;
constexpr size_t WS_CS32 = 2 * MiB;
constexpr size_t WS_ADA = 2 * MiB + 512 * 1024;
constexpr size_t WS_CMPB = 3 * MiB + 128 * 1024;
constexpr size_t WS_KMEAN = 3 * MiB + 256 * 1024;
constexpr size_t WS_RSTDQ = 3 * MiB + 512 * 1024;
constexpr size_t WS_RSTDKV = 3 * MiB + 768 * 1024;
constexpr size_t WS_KCMP = 4 * MiB;
constexpr size_t WS_VCMP = 4 * MiB + 512 * 1024;
constexpr size_t WS_CMPH = 5 * MiB;
constexpr size_t WS_WTS = 10 * MiB, WTS_LAYER = 46 * MiB;
constexpr size_t WO_GU1 = 0, WO_D1 = 11 * MiB, WO_GU2 = 17 * MiB, WO_D2 = 28 * MiB, WO_IN = 34 * MiB, WO_OUT = 39 * MiB, WO_UQ = 41 * MiB, WO_UKV = 41 * MiB + 512 * 1024, WO_C1K = 42 * MiB, WO_C1V = 43 * MiB;
constexpr size_t WS_XB = 104 * MiB;
constexpr size_t WS_BIG = 168 * MiB;
constexpr size_t WS_HID = WS_BIG;
constexpr size_t WS_QM_BF = 168 * MiB, WS_KM_BF = 184 * MiB, WS_VM_BF = 200 * MiB, WS_QM_F = 216 * MiB, WS_KM_F = 248 * MiB;
constexpr size_t WS_CQ = 280 * MiB, WS_CKV = 296 * MiB;
constexpr size_t WS_QN = 304 * MiB, WS_KC = 320 * MiB, WS_VC = 324 * MiB, WS_KS = 328 * MiB, WS_VS = 332 * MiB, WS_KW = 336 * MiB, WS_VW = 340 * MiB;
constexpr size_t WS_QD = 344 * MiB, WS_KD = 360 * MiB, WS_VD = 364 * MiB, WS_IQ = 368 * MiB, WS_IK = 400 * MiB, WS_GW = 404 * MiB;
constexpr size_t WS_QMLA = 408 * MiB, WS_KMLA = 432 * MiB, WS_VMLA = 456 * MiB;
constexpr size_t WS_DSAMASK = 472 * MiB;
constexpr size_t WS_OC = 488 * MiB;
constexpr size_t WS_KCMPB = 9 * MiB + 256 * 1024, WS_VCMPB = 9 * MiB + 512 * 1024;
constexpr size_t WS_NSEL = 9 * MiB;
constexpr size_t WS_END = 512 * MiB;
constexpr int CW_BAR = 4096;
constexpr int CW_WMAX = 8192;
constexpr float ACT_CLIP = 12.0f;
constexpr int RING_OFF = 0, RING_BYTES = 131072;
constexpr int LDSCTL_OFF = RING_BYTES, MISC_OFF = LDSCTL_OFF + 320;
constexpr int XTRA_OFF = 132096, XTRA_WAVE = 2112;
constexpr int LDS_BYTES = 155648;
static_assert(XTRA_OFF + NWAVES * XTRA_WAVE <= LDS_BYTES && MISC_OFF + 128 <= XTRA_OFF, "LDS map");

struct Args { const float* in[28]; float* out; unsigned char* ws; int ph_lo, ph_hi; };
struct Frame {
    LAS unsigned char* lds;
    volatile LAS unsigned* MISC;
    gu32* ctl;
    unsigned char* ws;
    int G;
    const Args* A;
    float* out;
};
enum { I_X = 0, I_C, I_ADAW, I_ADAB, I_F1N, I_F1G, I_F1U, I_F1D, I_MIXN, I_WIN, I_QNORM, I_WUQ, I_KVNORM, I_WUK, I_WUV, I_PEK, I_PEV, I_CK1, I_CK2, I_CV1, I_CV2, I_GN, I_WOUT, I_F2N, I_F2G, I_F2U, I_F2D, I_FINN };

__device__ __forceinline__ int opaque_v(int v) { asm volatile("" : "+v"(v)); return v; }
__device__ __forceinline__ int cur_tid() { return opaque_v((int)threadIdx.x); }
__device__ __forceinline__ int cur_lane() { return opaque_v((int)threadIdx.x) & 63; }
__device__ __forceinline__ int cur_wave() { return __builtin_amdgcn_readfirstlane(opaque_v((int)threadIdx.x) >> 6); }
template <int CTRL> __device__ __forceinline__ float dpp_f(float v) { return __int_as_float(__builtin_amdgcn_update_dpp(0, __float_as_int(v), CTRL, 0xf, 0xf, false)); }
__device__ __forceinline__ float wave_sum(float v) {
    v += dpp_f<0xB1>(v); v += dpp_f<0x4E>(v); v += dpp_f<0x141>(v); v += dpp_f<0x140>(v);
    const float r0 = __int_as_float(__builtin_amdgcn_readlane(__float_as_int(v), 0)), r1 = __int_as_float(__builtin_amdgcn_readlane(__float_as_int(v), 16));
    const float r2 = __int_as_float(__builtin_amdgcn_readlane(__float_as_int(v), 32)), r3 = __int_as_float(__builtin_amdgcn_readlane(__float_as_int(v), 48));
    return (r0 + r1) + (r2 + r3);
}
__device__ __forceinline__ float wave_max(float v) {
    v = fmaxf(v, dpp_f<0xB1>(v)); v = fmaxf(v, dpp_f<0x4E>(v)); v = fmaxf(v, dpp_f<0x141>(v)); v = fmaxf(v, dpp_f<0x140>(v));
    const float r0 = __int_as_float(__builtin_amdgcn_readlane(__float_as_int(v), 0)), r1 = __int_as_float(__builtin_amdgcn_readlane(__float_as_int(v), 16));
    const float r2 = __int_as_float(__builtin_amdgcn_readlane(__float_as_int(v), 32)), r3 = __int_as_float(__builtin_amdgcn_readlane(__float_as_int(v), 48));
    return fmaxf(fmaxf(r0, r1), fmaxf(r2, r3));
}
__device__ __forceinline__ float bf2f(unsigned short b) { return __uint_as_float((unsigned)b << 16); }
__device__ __forceinline__ void unpack8(const v4u w, float* f) {
    f[0] = __uint_as_float(w.x << 16); f[1] = __uint_as_float(w.x & 0xffff0000u); f[2] = __uint_as_float(w.y << 16); f[3] = __uint_as_float(w.y & 0xffff0000u);
    f[4] = __uint_as_float(w.z << 16); f[5] = __uint_as_float(w.z & 0xffff0000u); f[6] = __uint_as_float(w.w << 16); f[7] = __uint_as_float(w.w & 0xffff0000u);
}
__device__ __forceinline__ float sigmoid_f(float x) { return 1.0f / (1.0f + __expf(-x)); }

__device__ __forceinline__ int perm64(int j) { return 32 * ((j & 31) >> 4) + 16 * (j >> 5) + (j & 15); }
__device__ __forceinline__ int win_src_col(int c) {
    if (c < 512) return (c & ~63) + perm64(c & 63);
    if (c < 1184) return c;
    if (c < 1504) { const int r = c - 1184; return 1184 + (r & ~63) + perm64(r & 63); }
    if (c < 1568) return c;
    if (c < 1632) return 1568 + perm64(c - 1568);
    if (c < 1696) return c;
    if (c < 1760) return 1696 + perm64(c - 1696);
    if (c < 1824) return c;
    if (c < 2144) { const int r = c - 1824; return 1836 + (r & ~63) + perm64(r & 63); }
    if (c < 2208) return 2156 + (c - 2144);
    if (c < 2464) return 2220 + (c - 2208);
    if (c < 2496) return 2476 + (c - 2464);
    if (c < 2508) return 1824 + (c - 2496);
    if (c < 2516) return 2508 + (c - 2508);
    return -1;
}
constexpr int WK_K[8] = {1024, 2816, 1024, 2816, 1024, 1024, 256, 128};
constexpr int WK_N[8] = {5632, 1024, 5632, 1024, 2560, 1024, 512, 512};
__device__ __forceinline__ size_t wk_off(int kind) { return kind == 0 ? WO_GU1 : kind == 1 ? WO_D1 : kind == 2 ? WO_GU2 : kind == 3 ? WO_D2 : kind == 4 ? WO_IN : kind == 5 ? WO_OUT : kind == 6 ? WO_UQ : kind == 7 ? WO_UKV : kind == 8 ? WO_C1K : WO_C1V; }
__device__ __forceinline__ const float* wsrc(const Frame& F, int kind, int l, int R, int& stride) {
    switch (kind) {
    case 0: case 2: { const int G = R >> 5, w = R & 31, j = 16 * G + (w & 15); stride = FF;
        const float* g = F.A->in[kind == 0 ? I_F1G : I_F2G] + (size_t)l * D * FF; const float* u = F.A->in[kind == 0 ? I_F1U : I_F2U] + (size_t)l * D * FF; return ((w >> 4) ? u : g) + j; }
    case 1: case 3: stride = D; return F.A->in[kind == 1 ? I_F1D : I_F2D] + (size_t)l * FF * D + R;
    case 4: { stride = NIN_SRC; const int s = win_src_col(R); return s < 0 ? nullptr : F.A->in[I_WIN] + (size_t)l * D * NIN_SRC + s; }
    case 5: stride = D; return F.A->in[I_WOUT] + (size_t)l * D * D + R;
    case 6: stride = 384; return R < 384 ? F.A->in[I_WUQ] + (size_t)l * 256 * 384 + R : nullptr;
    case 7: stride = 256; return R < 256 ? F.A->in[I_WUK] + (size_t)l * 128 * 256 + R : F.A->in[I_WUV] + (size_t)l * 128 * 256 + (R - 256);
    default: stride = 256; return F.A->in[kind == 8 ? I_CK1 : I_CV1] + (size_t)l * 2048 * 256 + R;
    }
}

struct WinDesc {
    unsigned char* ws;
    __device__ __forceinline__ pg8::ProjDesc operator()(int G) const {
        pg8::ProjDesc d; d.kind = 0; d.dfreq0 = 0; d.nstride = 16; d.rep = 1; d.repstride = 0; d.bpitch = 0; d.fpitch = 0; d.pad = 0; d.bp = nullptr; d.fp = nullptr;
        const int c = 32 * G;
#define ROPE64(rel, BOFF, BP, FOFF, FP) do { const int hh_ = (rel) >> 6, g_ = ((rel) >> 5) & 1; d.kind = 2; d.dfreq0 = 16 * g_; d.nstride = 32; \
            d.bp = (bf16*)(ws + (BOFF)) + hh_ * 64 + 16 * g_; d.bpitch = (BP); if (FP) { d.fp = (float*)(ws + (FOFF)) + hh_ * 64 + 16 * g_; d.fpitch = (FP); } } while (0)
#define PLAINB(rel, BOFF, BP) do { d.kind = 1; d.bp = (bf16*)(ws + (BOFF)) + (rel); d.bpitch = (BP); } while (0)
#define PLAINF(rel, FOFF, FP) do { d.kind = 1; d.fp = (float*)(ws + (FOFF)) + (rel); d.fpitch = (FP); } while (0)
        if (c < 256) ROPE64(c, WS_QM_BF, 256, WS_QM_F, 256);
        else if (c < 512) ROPE64(c - 256, WS_KM_BF, 256, WS_KM_F, 256);
        else if (c < 768) PLAINB(c - 512, WS_VM_BF, 256);
        else if (c < 1024) PLAINB(c - 768, WS_CQ, 256);
        else if (c < 1152) PLAINB(c - 1024, WS_CKV, 128);
        else if (c < 1184) { d.kind = 3; d.nstride = 16; d.bp = (bf16*)(ws + WS_KMLA) + 64; d.bpitch = 384; d.rep = 4; d.repstride = 96; }
        else if (c < 1440) ROPE64(c - 1184, WS_QN, 256, 0, 0);
        else if (c < 1504) ROPE64(c - 1440, WS_KC, 64, 0, 0);
        else if (c < 1568) PLAINB(c - 1504, WS_VC, 64);
        else if (c < 1632) ROPE64(c - 1568, WS_KS, 64, 0, 0);
        else if (c < 1696) PLAINB(c - 1632, WS_VS, 64);
        else if (c < 1760) ROPE64(c - 1696, WS_KW, 64, 0, 0);
        else if (c < 1824) PLAINB(c - 1760, WS_VW, 64);
        else if (c < 2080) ROPE64(c - 1824, WS_QD, 256, 0, 0);
        else if (c < 2144) ROPE64(c - 2080, WS_KD, 64, 0, 0);
        else if (c < 2208) PLAINB(c - 2144, WS_VD, 64);
        else if (c < 2464) PLAINB(c - 2208, WS_IQ, 256);
        else if (c < 2496) PLAINB(c - 2464, WS_IK, 32);
        else if (c < 2528) PLAINF(c - 2496, WS_GW, 32);
#undef ROPE64
#undef PLAINB
#undef PLAINF
        return d;
    }
};
struct MlaQDesc {
    unsigned char* ws;
    __device__ __forceinline__ pg8::ProjDesc operator()(int G) const {
        pg8::ProjDesc d; d.kind = 0; d.dfreq0 = 0; d.nstride = 16; d.rep = 1; d.repstride = 0; d.bpitch = 384; d.fpitch = 0; d.pad = 0; d.bp = nullptr; d.fp = nullptr;
        if (G < 12) { const int hh = G / 3, part = G - 3 * hh; d.kind = (part == 2) ? 3 : 1; d.bp = (bf16*)(ws + WS_QMLA) + hh * 96 + 32 * part; }
        return d;
    }
};
struct MlaKvDesc {
    unsigned char* ws;
    __device__ __forceinline__ pg8::ProjDesc operator()(int G) const {
        pg8::ProjDesc d; d.kind = 1; d.dfreq0 = 0; d.nstride = 16; d.rep = 1; d.repstride = 0; d.bpitch = 0; d.fpitch = 0; d.pad = 0; d.bp = nullptr; d.fp = nullptr;
        const int c = 32 * G;
        if (c < 256) { d.bp = (bf16*)(ws + WS_KMLA) + (c >> 6) * 96 + (c & 63); d.bpitch = 384; }
        else { d.bp = (bf16*)(ws + WS_VMLA) + (c - 256); d.bpitch = 256; }
        return d;
    }
};

__device__ __forceinline__ void p0_prologue(Frame& F) {
    const int tid = cur_tid();
    const int wave = cur_wave(), gw = blockIdx.x * NWAVES + wave, NGW = F.G * NWAVES, lane = cur_lane();
    {
        LAS float* scr = (LAS float*)(F.lds + RING_OFF + wave * 16384);
        constexpr int PER_LAYER = 1280 + 512 + 64 + 32 + 256 + 256;
        for (int it = gw; it < NL * PER_LAYER; it += NGW) {
            const int l = it / PER_LAYER; int r = it - l * PER_LAYER; int kind = 4;
            { const int cnt[6] = {1280, 512, 64, 32, 256, 256};
#pragma unroll
              for (int q = 0; q < 5; ++q) { if (kind == q + 4 && r >= cnt[q]) { r -= cnt[q]; kind = q + 5; } } }
            const int K = kind == 0 || kind == 2 || kind == 4 || kind == 5 ? 1024 : (kind == 1 || kind == 3) ? 2816 : kind == 6 ? 256 : kind == 7 ? 128 : 2048;
            const int N = kind == 0 || kind == 2 ? 5632 : kind == 4 ? 2560 : (kind == 6 || kind == 7) ? 512 : kind >= 8 ? 256 : 1024;
            const int nblk = N / 32, kb = r / nblk, nb = r - kb * nblk, k0 = 64 * kb, n0 = 32 * nb;
            int stride; const float* colp = wsrc(F, kind, l, n0 + (lane & 31), stride);
            const float* ksc = kind == 6 ? F.A->in[I_QNORM] + l * 256 : kind == 7 ? F.A->in[I_KVNORM] + l * 128 : nullptr;
            bf16* WT = (bf16*)(F.ws + WS_WTS + (size_t)l * WTS_LAYER + wk_off(kind));
            float vv[32];
#pragma unroll
            for (int i = 0; i < 32; ++i) { const int kk = 2 * i + (lane >> 5); vv[i] = colp ? colp[(size_t)(k0 + kk) * stride] : 0.f; }
#pragma unroll
            for (int i = 0; i < 32; ++i) { const int kk = 2 * i + (lane >> 5); float v = vv[i]; if (ksc) v *= ksc[k0 + kk]; scr[kk * 33 + (lane & 31)] = v; }
            LDS_WAIT(); asm volatile("" ::: "memory");
            const int c = lane & 7;
#pragma unroll
            for (int j = 0; j < 4; ++j) { const int n = (lane >> 3) + 8 * j; const LAS float* s = scr + (8 * c) * 33 + n;
                v4u o; o.x = pk2(s[0 * 33], s[1 * 33]); o.y = pk2(s[2 * 33], s[3 * 33]); o.z = pk2(s[4 * 33], s[5 * 33]); o.w = pk2(s[6 * 33], s[7 * 33]);
                *(GAS v4u*)(WT + (size_t)(n0 + n) * K + k0 + 8 * c) = o; }
            LDS_WAIT(); asm volatile("" ::: "memory");
        }
    }
    {
        const int gtid = blockIdx.x * 512 + tid, NT = F.G * 512; constexpr int n4 = D * FF / 4;
#pragma unroll 1
        for (int cm = 0; cm < 12; ++cm) { const bool isd = cm >= 8; const int combo = isd ? cm - 8 : cm >> 1, l = combo >> 1, ff2 = combo & 1, up = cm & 1;
            const f32x4* p = (const f32x4*)(F.A->in[isd ? (ff2 ? I_F2D : I_F1D) : ff2 ? (up ? I_F2U : I_F2G) : (up ? I_F1U : I_F1G)] + (size_t)l * D * FF);
            f32x4 v[6];
#pragma unroll
            for (int q = 0; q < 6; ++q) { const int i = gtid + q * NT; v[q] = i < n4 ? p[i] : (f32x4){0.f, 0.f, 0.f, 0.f}; }
            float mx = 0.f;
#pragma unroll
            for (int q = 0; q < 6; ++q) mx = fmaxf(mx, fmaxf(fmaxf(fabsf(v[q].x), fabsf(v[q].y)), fmaxf(fabsf(v[q].z), fabsf(v[q].w))));
            for (int i = gtid + 6 * NT; i < n4; i += NT) { const f32x4 w = p[i]; mx = fmaxf(mx, fmaxf(fmaxf(fabsf(w.x), fabsf(w.y)), fmaxf(fabsf(w.z), fabsf(w.w)))); }
            mx = wave_max(mx);
            if (lane == 0) __hip_atomic_fetch_max((unsigned*)(F.ctl + CW_WMAX) + combo + (isd ? 4 : 0), __float_as_uint(mx), __ATOMIC_RELAXED, __HIP_MEMORY_SCOPE_AGENT); }
    }
    for (int i = blockIdx.x * 512 + tid; i < 4096 * 48; i += F.G * 512) {
        const int pos = i / 48, j = i - pos * 48;
        float invf; float* dst;
        if (j < 32) { invf = 1.0f / (float)pow(10000.0, (double)j / 32.0); dst = (float*)(F.ws + WS_CS64) + ((size_t)pos * 32 + j) * 2; }
        else { invf = 1.0f / (float)pow(10000.0, (double)(j - 32) / 16.0); dst = (float*)(F.ws + WS_CS32) + ((size_t)pos * 16 + (j - 32)) * 2; }
        const float ang = (float)pos * invf;
        dst[0] = (float)cos((double)ang); dst[1] = (float)sin((double)ang);
    }
    {
        LAS float* red = (LAS float*)(F.lds + RING_OFF + 8 * 16384 - 2048);
        for (int task = blockIdx.x; task < NL * 2 * 4; task += F.G) {
            const int l = task >> 3, kvq = task & 7, kv = kvq >> 2, j = (kvq & 3) * 64 + lane;
            const float* pe = F.A->in[kv ? I_PEV : I_PEK] + (size_t)l * 2048 + wave * 256; const float* w1 = F.A->in[kv ? I_CV1 : I_CK1] + (size_t)l * 2048 * 256 + (size_t)wave * 256 * 256 + j;
            float acc = 0.f;
#pragma unroll 32
            for (int k = 0; k < 256; ++k) acc += pe[k] * w1[(size_t)k * 256];
            __syncthreads();
            red[wave * 64 + lane] = acc;
            __syncthreads();
            if (wave == 0) { float s = 0.f;
#pragma unroll
                for (int w = 0; w < 8; ++w) s += red[w * 64 + lane];
                ((float*)(F.ws + WS_CMPB))[(l * 2 + kv) * 256 + j] = s; }
        }
    }
    {
        __syncthreads();
        LAS float* cact = (LAS float*)(F.lds + RING_OFF);
        LAS float* red = (LAS float*)(F.lds + RING_OFF + 32768);
        for (int i = tid; i < 8 * 1024; i += 512) { const float cv = F.A->in[I_C][i]; cact[i] = cv / (1.0f + __expf(-cv)); }
        __syncthreads();
        for (int task = blockIdx.x; task < NL * 144; task += F.G) {
            const int l = task / 144, n0 = (task - l * 144) * 64;
            const float* W = F.A->in[I_ADAW] + (size_t)l * 1024 * 9216 + n0 + lane;
            float acc[8];
#pragma unroll
            for (int b = 0; b < 8; ++b) acc[b] = 0.f;
            const int kbeg = wave * 128;
#pragma unroll 16
            for (int k = kbeg; k < kbeg + 128; ++k) { const float wv = W[(size_t)k * 9216];
#pragma unroll
                for (int b = 0; b < 8; ++b) acc[b] += cact[b * 1024 + k] * wv; }
#pragma unroll
            for (int b = 0; b < 8; ++b) red[(wave * 8 + b) * 64 + lane] = acc[b];
            __syncthreads();
            { const int b = wave; float s = F.A->in[I_ADAB][(size_t)l * 9216 + n0 + lane];
#pragma unroll
              for (int w = 0; w < 8; ++w) s += red[(w * 8 + b) * 64 + lane];
              ((float*)(F.ws + WS_ADA))[((size_t)l * 8 + b) * 9216 + n0 + lane] = s; }
            __syncthreads();
        }
    }
}

using pg8::q8pack4; using pg8::HID_CLIP;
__device__ __forceinline__ void wgu8_convert(Frame& F) {
    const int wave = cur_wave(), gw = blockIdx.x * NWAVES + wave, NGW = F.G * NWAVES, lane = cur_lane();
    LAS float* scr = (LAS float*)(F.lds + RING_OFF + wave * 16384);
    for (int it = gw; it < 4 * 2816 + 4 * 1408; it += NGW) {
        const bool isd = it >= 4 * 2816; const int r0 = isd ? it - 4 * 2816 : it, per = isd ? 1408 : 2816, nblk = isd ? 32 : 176, KB = isd ? 2816 : 1024;
        const int cmb = r0 / per, r = r0 - cmb * per, l = cmb >> 1, ff2 = cmb & 1, kind = (isd ? 1 : 0) + 2 * ff2, combo = cmb + (isd ? 4 : 0);
        const int kb = r / nblk, nb = r - kb * nblk, k0 = 64 * kb, n0 = 32 * nb;
        int stride; const float* colp = wsrc(F, kind, l, n0 + (lane & 31), stride);
        const float wmax = __uint_as_float(__hip_atomic_load((unsigned*)(F.ctl + CW_WMAX) + combo, __ATOMIC_RELAXED, __HIP_MEMORY_SCOPE_AGENT)), qs = wmax > 0.f ? 127.0f / wmax : 0.f;
        signed char* WT = (signed char*)(F.ws + WS_WTS + (size_t)l * WTS_LAYER + wk_off(kind));
        float vv[32];
#pragma unroll
        for (int i = 0; i < 32; ++i) { const int kk = 2 * i + (lane >> 5); vv[i] = colp[(size_t)(k0 + kk) * stride]; }
#pragma unroll
        for (int i = 0; i < 32; ++i) { const int kk = 2 * i + (lane >> 5); scr[kk * 33 + (lane & 31)] = vv[i]; }
        LDS_WAIT(); asm volatile("" ::: "memory");
#pragma unroll
        for (int q = 0; q < 2; ++q) { const int p = lane + 64 * q, n = p >> 2, c = p & 3; const LAS float* s = scr + (16 * c) * 33 + n;
            v4u o; o.x = q8pack4(s[0 * 33], s[1 * 33], s[2 * 33], s[3 * 33], qs); o.y = q8pack4(s[4 * 33], s[5 * 33], s[6 * 33], s[7 * 33], qs);
            o.z = q8pack4(s[8 * 33], s[9 * 33], s[10 * 33], s[11 * 33], qs); o.w = q8pack4(s[12 * 33], s[13 * 33], s[14 * 33], s[15 * 33], qs);
            *(GAS v4u*)(WT + (size_t)(n0 + n) * KB + k0 + 16 * c) = o; }
        LDS_WAIT(); asm volatile("" ::: "memory");
    }
}
template <bool XBF> __device__ __forceinline__ void load_row16(const void* xsrc, int row, int lane, f32x4 (&v)[4]) {
    if (XBF) { const unsigned long long* xr = (const unsigned long long*)((const bf16*)xsrc + (size_t)row * D) + lane;
#pragma unroll
        for (int j = 0; j < 4; ++j) { const unsigned long long w = xr[64 * j];
            v[j] = (f32x4){__uint_as_float((unsigned)w << 16), __uint_as_float((unsigned)w & 0xffff0000u), __uint_as_float((unsigned)(w >> 32) << 16), __uint_as_float((unsigned)(w >> 32) & 0xffff0000u)}; } }
    else { const f32x4* xr = (const f32x4*)((const float*)xsrc + (size_t)row * D) + lane;
#pragma unroll
        for (int j = 0; j < 4; ++j) v[j] = xr[64 * j]; }
}
template <bool XBF, bool Q8>
__device__ __forceinline__ void norm_mod_phase(Frame& F, const void* xsrc, const float* gain, const float* sh, const float* sc, bf16* hout) {
    const int wave = cur_wave(), gw = blockIdx.x * NWAVES + wave, NGW = F.G * NWAVES, lane = cur_lane();
    f32x4 g[4];
#pragma unroll
    for (int j = 0; j < 4; ++j) g[j] = *(const f32x4*)(gain + 4 * lane + 256 * j);
    for (int row0 = gw; row0 < M; row0 += 2 * NGW) {
        const int row1 = row0 + NGW; const bool has1 = row1 < M; const int r1 = has1 ? row1 : row0;
        f32x4 va[4], vb[4]; float sa = 0.f, sb = 0.f;
        load_row16<XBF>(xsrc, row0, lane, va); load_row16<XBF>(xsrc, r1, lane, vb);
#pragma unroll
        for (int j = 0; j < 4; ++j) { sa += (va[j].x * va[j].x + va[j].y * va[j].y) + (va[j].z * va[j].z + va[j].w * va[j].w); sb += (vb[j].x * vb[j].x + vb[j].y * vb[j].y) + (vb[j].z * vb[j].z + vb[j].w * vb[j].w); }
        const float rsa = 1.0f / sqrtf(wave_sum(sa) * (1.f / D) + RMS_EPS), rsb = 1.0f / sqrtf(wave_sum(sb) * (1.f / D) + RMS_EPS);
#pragma unroll
        for (int q = 0; q < 2; ++q) {
            if (q == 1 && !has1) break;
            const int row = q ? row1 : row0; const int b = row >> 12; const float rstd = q ? rsb : rsa;
            const float* shb = sh + (size_t)b * 9216 + 4 * lane; const float* scb = sc + (size_t)b * 9216 + 4 * lane;
            unsigned long long* o8 = (unsigned long long*)(hout + (size_t)row * D) + lane;
            unsigned* o4 = (unsigned*)((signed char*)hout + (size_t)row * D) + lane;
#pragma unroll
            for (int j = 0; j < 4; ++j) { const f32x4 s4 = *(const f32x4*)(shb + 256 * j), c4 = *(const f32x4*)(scb + 256 * j);
                const f32x4 y = (q ? vb[j] : va[j]) * rstd * g[j] * (c4 + 1.0f) + s4;
                if (Q8) o4[64 * j] = q8pack4(y.x, y.y, y.z, y.w, 127.0f / ACT_CLIP);
                else o8[64 * j] = (unsigned long long)pk2(y.x, y.y) | ((unsigned long long)pk2(y.z, y.w) << 32); }
        }
    }
}
__device__ __forceinline__ void final_norm_phase(Frame& F, const bf16* xb, float* out, const float* gain) {
    const int wave = cur_wave(), gw = blockIdx.x * NWAVES + wave, NGW = F.G * NWAVES, lane = cur_lane();
    f32x4 g[4];
#pragma unroll
    for (int j = 0; j < 4; ++j) g[j] = *(const f32x4*)(gain + 4 * lane + 256 * j);
    for (int row0 = gw; row0 < M; row0 += 2 * NGW) {
        const int row1 = row0 + NGW; const bool has1 = row1 < M; const int r1 = has1 ? row1 : row0;
        f32x4 va[4], vb[4]; float sa = 0.f, sb = 0.f;
        load_row16<true>(xb, row0, lane, va); load_row16<true>(xb, r1, lane, vb);
#pragma unroll
        for (int j = 0; j < 4; ++j) { sa += (va[j].x * va[j].x + va[j].y * va[j].y) + (va[j].z * va[j].z + va[j].w * va[j].w); sb += (vb[j].x * vb[j].x + vb[j].y * vb[j].y) + (vb[j].z * vb[j].z + vb[j].w * vb[j].w); }
        const float rsa = 1.0f / sqrtf(wave_sum(sa) * (1.f / D) + RMS_EPS), rsb = 1.0f / sqrtf(wave_sum(sb) * (1.f / D) + RMS_EPS);
        f32x4* xa = (f32x4*)(out + (size_t)row0 * D) + lane;
#pragma unroll
        for (int j = 0; j < 4; ++j) xa[64 * j] = va[j] * rsa * g[j];
        if (has1) { f32x4* xo = (f32x4*)(out + (size_t)row1 * D) + lane;
#pragma unroll
            for (int j = 0; j < 4; ++j) xo[64 * j] = vb[j] * rsb * g[j]; }
    }
}
__device__ __forceinline__ void group_norm_phase(Frame& F, bf16* Y, const float* gn) {
    const int wave = cur_wave(), gw = blockIdx.x * NWAVES + wave, NGW = F.G * NWAVES, lane = cur_lane();
    f32x4 g[4];
#pragma unroll
    for (int j = 0; j < 4; ++j) g[j] = *(const f32x4*)(gn + 256 * j + 4 * lane);
    for (int row0 = gw; row0 < M; row0 += 4 * NGW) {
        unsigned long long w[4][4];
#pragma unroll
        for (int q = 0; q < 4; ++q) { const int row = row0 + q * NGW < M ? row0 + q * NGW : row0; const unsigned long long* yr = (const unsigned long long*)(Y + (size_t)row * D) + lane;
#pragma unroll
            for (int j = 0; j < 4; ++j) w[q][j] = yr[64 * j]; }
#pragma unroll
        for (int q = 0; q < 4; ++q) {
            const int row = row0 + q * NGW; if (row >= M) break;
            unsigned long long* yr = (unsigned long long*)(Y + (size_t)row * D) + lane;
#pragma unroll
            for (int j = 0; j < 4; ++j) {
                const unsigned long long ww = w[q][j];
                const float a0 = __uint_as_float((unsigned)ww << 16), a1 = __uint_as_float((unsigned)ww & 0xffff0000u), a2 = __uint_as_float((unsigned)(ww >> 32) << 16), a3 = __uint_as_float((unsigned)(ww >> 32) & 0xffff0000u);
                const float ss = wave_sum((a0 * a0 + a1 * a1) + (a2 * a2 + a3 * a3));
                const float rstd = 1.0f / sqrtf(ss * (1.f / 256.f) + RMS_EPS);
                yr[64 * j] = (unsigned long long)pk2(a0 * rstd * g[j].x, a1 * rstd * g[j].y) | ((unsigned long long)pk2(a2 * rstd * g[j].z, a3 * rstd * g[j].w) << 32);
            }
        }
    }
}
__device__ __forceinline__ unsigned long long causal_word(int d) { return d >= 63 ? ~0ull : (d < 0 ? 0ull : ((2ull << d) - 1ull)); }
__device__ __forceinline__ int mbcnt64(unsigned long long m) { return (int)__builtin_amdgcn_mbcnt_hi((unsigned)(m >> 32), __builtin_amdgcn_mbcnt_lo((unsigned)m, 0u)); }
__device__ __forceinline__ unsigned fkey(float x) { const unsigned u = __float_as_uint(x); return (u & 0x80000000u) ? ~u : (u | 0x80000000u); }
__device__ __forceinline__ float reduce64(const float (&o)[64], int lane) {
    float r5[32], r4[16], r3[8], r2[4], r1[2];
    { const bool hi = (lane & 32) != 0;
#pragma unroll
      for (int i = 0; i < 32; ++i) { const float a = o[i], b = o[i + 32]; r5[i] = (hi ? b : a) + __shfl_xor(hi ? a : b, 32); } }
    { const bool hi = (lane & 16) != 0;
#pragma unroll
      for (int i = 0; i < 16; ++i) { const float a = r5[i], b = r5[i + 16]; r4[i] = (hi ? b : a) + __shfl_xor(hi ? a : b, 16); } }
    { const bool hi = (lane & 8) != 0;
#pragma unroll
      for (int i = 0; i < 8; ++i) { const float a = r4[i], b = r4[i + 8]; r3[i] = (hi ? b : a) + __shfl_xor(hi ? a : b, 8); } }
    { const bool hi = (lane & 4) != 0;
#pragma unroll
      for (int i = 0; i < 4; ++i) { const float a = r3[i], b = r3[i + 4]; r2[i] = (hi ? b : a) + __shfl_xor(hi ? a : b, 4); } }
    { const bool hi = (lane & 2) != 0;
#pragma unroll
      for (int i = 0; i < 2; ++i) { const float a = r2[i], b = r2[i + 2]; r1[i] = (hi ? b : a) + __shfl_xor(hi ? a : b, 2); } }
    const bool hi = (lane & 1) != 0;
    return (hi ? r1[1] : r1[0]) + __shfl_xor(hi ? r1[0] : r1[1], 1);
}
struct KVbf {
    const bf16* K; const bf16* V; int kp, vp;
    template <int DQ> __device__ __forceinline__ float dot(int row, const LAS float* q) const {
        const v4u* p = (const v4u*)(K + (size_t)row * kp); float s = 0.f;
#pragma unroll
        for (int c = 0; c < DQ / 8; ++c) { float f[8]; unpack8(p[c], f); const f32x4 q0 = *(const LAS f32x4*)(q + 8 * c), q1 = *(const LAS f32x4*)(q + 8 * c + 4);
            s += (q0.x * f[0] + q0.y * f[1]) + (q0.z * f[2] + q0.w * f[3]) + (q1.x * f[4] + q1.y * f[5]) + (q1.z * f[6] + q1.w * f[7]); }
        return s;
    }
    __device__ __forceinline__ void axpy(int row, float pw, float (&o)[64]) const {
        const v4u* p = (const v4u*)(V + (size_t)row * vp);
#pragma unroll
        for (int c = 0; c < 8; ++c) { float f[8]; unpack8(p[c], f);
#pragma unroll
            for (int e = 0; e < 8; ++e) o[8 * c + e] += pw * f[e]; }
    }
};
struct KVf32 {
    const float* K; const float* V; int kp, vp;
    template <int DQ> __device__ __forceinline__ float dot(int row, const LAS float* q) const {
        const f32x4* p = (const f32x4*)(K + (size_t)row * kp); float s = 0.f;
#pragma unroll
        for (int c = 0; c < DQ / 4; ++c) { const f32x4 f = p[c]; const f32x4 qv = *(const LAS f32x4*)(q + 4 * c); s += (qv.x * f.x + qv.y * f.y) + (qv.z * f.z + qv.w * f.w); }
        return s;
    }
    __device__ __forceinline__ void axpy(int row, float pw, float (&o)[64]) const {
        const f32x4* p = (const f32x4*)(V + (size_t)row * vp);
#pragma unroll
        for (int c = 0; c < 16; ++c) { const f32x4 f = p[c]; o[4 * c] += pw * f.x; o[4 * c + 1] += pw * f.y; o[4 * c + 2] += pw * f.z; o[4 * c + 3] += pw * f.w; }
    }
};
template <int DQ, class KV, class KeyFn>
__device__ __forceinline__ float wave_attend(const LAS float* q, float scale, int nslots, const KeyFn& keyf, const KV& kv, int lane) {
    float m = -INFINITY;
    for (int s = 0; s < nslots; ++s) { const int key = keyf(s); if (key >= 0) m = fmaxf(m, kv.template dot<DQ>(key, q) * scale); }
    const float Mx = wave_max(m);
    float o[64];
#pragma unroll
    for (int d = 0; d < 64; ++d) o[d] = 0.f;
    float l = 0.f;
    if (Mx > -INFINITY) {
        for (int s = 0; s < nslots; ++s) { const int key = keyf(s);
            if (key >= 0) { const float p = __expf(kv.template dot<DQ>(key, q) * scale - Mx); l += p; kv.axpy(key, p, o); } }
    }
    l = wave_sum(l);
    const float r = reduce64(o, lane);
    return l > 0.f ? r / l : 0.f;
}
__device__ __forceinline__ void task_bt(int i, int& t, int& rest) { const int tt = i & 2047, j = i >> 11; t = (j & 1) ? 4095 - tt : tt; rest = j >> 1; }

__device__ __forceinline__ void m1_phase(Frame& F, int l) {
    const int wave = cur_wave(), gw = blockIdx.x * NWAVES + wave, NGW = F.G * NWAVES, lane = cur_lane();
    const bf16* CQ = (const bf16*)(F.ws + WS_CQ); const bf16* CKV = (const bf16*)(F.ws + WS_CKV);
    float* rq = (float*)(F.ws + WS_RSTDQ); float* rkv = (float*)(F.ws + WS_RSTDKV);
    for (int row0 = gw; row0 < M; row0 += 4 * NGW) {
        unsigned long long wq[4]; unsigned wk[4];
#pragma unroll
        for (int q = 0; q < 4; ++q) { const int row = row0 + q * NGW < M ? row0 + q * NGW : row0; wq[q] = ((const unsigned long long*)(CQ + (size_t)row * 256))[lane]; wk[q] = ((const unsigned*)(CKV + (size_t)row * 128))[lane]; }
#pragma unroll
        for (int q = 0; q < 4; ++q) {
            const int row = row0 + q * NGW; if (row >= M) break;
            const unsigned long long w = wq[q];
            const float a0 = __uint_as_float((unsigned)w << 16), a1 = __uint_as_float((unsigned)w & 0xffff0000u), a2 = __uint_as_float((unsigned)(w >> 32) << 16), a3 = __uint_as_float((unsigned)(w >> 32) & 0xffff0000u);
            const float s1 = wave_sum((a0 * a0 + a1 * a1) + (a2 * a2 + a3 * a3));
            const float b0 = __uint_as_float(wk[q] << 16), b1 = __uint_as_float(wk[q] & 0xffff0000u);
            const float s2 = wave_sum(b0 * b0 + b1 * b1);
            if (lane == 0) { rq[row] = 1.0f / sqrtf(s1 * (1.f / 256.f) + RMS_EPS); rkv[row] = 1.0f / sqrtf(s2 * (1.f / 128.f) + RMS_EPS); }
        }
    }
    const float* KMF = (const float*)(F.ws + WS_KM_F); float* kmean = (float*)(F.ws + WS_KMEAN);
    for (int task = gw; task < 512; task += NGW) {
        const int b = task >> 6, blk = (task >> 2) & 15, h = task & 3;
        const float* p = KMF + ((size_t)(b * T + blk * 256)) * 256 + h * 64 + lane; float s = 0.f;
#pragma unroll 32
        for (int i = 0; i < 256; ++i) s += p[(size_t)i * 256];
        kmean[((b * 4 + h) * 16 + blk) * 64 + lane] = s * (1.f / 256.f);
    }
}
__device__ __forceinline__ void cmp2_phase(Frame& F, int l) {
    const int wave = cur_wave(), gw = blockIdx.x * NWAVES + wave, NGW = F.G * NWAVES, lane = cur_lane();
    const float* cmph = (const float*)(F.ws + WS_CMPH);
    for (int task = gw; task < 2 * 8 * 255; task += NGW) {
        const int kv = task / 2040, r1 = task - kv * 2040, b = r1 / 255, n = r1 - b * 255;
        const float* hp = cmph + ((size_t)(kv * 8 + b) * 256 + n) * 256;
        const float* w2 = F.A->in[kv ? I_CV2 : I_CK2] + (size_t)l * 256 * 64 + lane;
        float acc = 0.f;
#pragma unroll 32
        for (int j = 0; j < 256; ++j) acc += hp[j] * w2[j * 64];
        ((float*)(F.ws + (kv ? WS_VCMP : WS_KCMP)))[((size_t)b * 256 + n) * 64 + lane] = acc;
        ((bf16*)(F.ws + (kv ? WS_VCMPB : WS_KCMPB)))[((size_t)b * 256 + n) * 64 + lane] = (bf16)f2bf(acc);
    }
    for (int task = gw; task < 16; task += NGW) ((bf16*)(F.ws + ((task & 1) ? WS_VCMPB : WS_KCMPB)))[((size_t)(task >> 1) * 256 + 255) * 64 + lane] = 0;
}
__device__ __forceinline__ void mla_rows_phase(Frame& F) {
    const int wave = cur_wave(), gw = blockIdx.x * NWAVES + wave, NGW = F.G * NWAVES, lane = cur_lane();
    const bf16* Q = (const bf16*)(F.ws + WS_QMLA); bf16* Y = (bf16*)F.out + (size_t)M * D;
    LAS float* q = (LAS float*)(F.lds + RING_OFF + wave * 16384 + 4096);
    for (int i = gw; i < M * 4; i += NGW) {
        int t, bh; task_bt(i, t, bh); const int b = bh >> 2, h = bh & 3, row = b * T + t;
        if (lane < 48) { const unsigned w = ((const unsigned*)(Q + (size_t)row * 384 + h * 96))[lane]; q[2 * lane] = __uint_as_float(w << 16); q[2 * lane + 1] = __uint_as_float(w & 0xffff0000u); }
        LDS_WAIT(); asm volatile("" ::: "memory");
        KVbf kv{(const bf16*)(F.ws + WS_KMLA) + h * 96, (const bf16*)(F.ws + WS_VMLA) + h * 64, 384, 256};
        const int base = b * T;
        auto keyf = [&](int s) { const int p = lane + 64 * s; return p <= t ? base + p : -1; };
        const float r = wave_attend<96>(q, 0.10206207261596577f, (t >> 6) + 1, keyf, kv, lane);
        Y[(size_t)row * 1024 + 256 + h * 64 + lane] = (bf16)f2bf(r);
        LDS_WAIT(); asm volatile("" ::: "memory");
    }
}
__device__ __forceinline__ void moba_rows_phase(Frame& F) {
    const int wave = cur_wave(), gw = blockIdx.x * NWAVES + wave, NGW = F.G * NWAVES, lane = cur_lane();
    const float* QF = (const float*)(F.ws + WS_QM_F); const float* kmean = (const float*)(F.ws + WS_KMEAN); bf16* Y = (bf16*)F.out + (size_t)M * D;
    LAS float* q = (LAS float*)(F.lds + RING_OFF + wave * 16384 + 4096);
    for (int i = gw; i < M * 4; i += NGW) {
        int t, bh; task_bt(i, t, bh); const int b = bh >> 2, h = bh & 3, row = b * T + t, own = t >> 8;
        q[lane] = QF[(size_t)row * 256 + h * 64 + lane];
        LDS_WAIT(); asm volatile("" ::: "memory");
        float g = -INFINITY;
        if (lane < own) { KVf32 km{kmean + (size_t)((b * 4 + h) * 16) * 64, nullptr, 64, 64}; g = km.dot<64>(lane, q); }
        unsigned selmask = 0u;
        for (int r = 0; r < 3; ++r) { const float mx = wave_max(g); if (!(mx > -INFINITY)) break;
            const unsigned long long ball = __ballot(g == mx); const int sl = __ffsll((long long)ball) - 1; selmask |= 1u << sl; if (lane == sl) g = -INFINITY; }
        KVbf kv{(const bf16*)(F.ws + WS_KM_BF) + h * 64, (const bf16*)(F.ws + WS_VM_BF) + h * 64, 256, 256};
        const int base = b * T;
        auto keyf = [&](int s) { const int blk = s >> 2, p = 64 * s + lane; return blk == own ? (p <= t ? base + p : -1) : (((selmask >> blk) & 1u) ? base + p : -1); };
        const float r = wave_attend<64>(q, 0.125f, 4 * own + 4, keyf, kv, lane);
        Y[(size_t)row * 1024 + h * 64 + lane] = (bf16)f2bf(r);
        LDS_WAIT(); asm volatile("" ::: "memory");
    }
}
__device__ __forceinline__ void nsa_tokens_phase(Frame& F) {
    const int wave = cur_wave(), gw = blockIdx.x * NWAVES + wave, NGW = F.G * NWAVES, lane = cur_lane();
    const bf16* QN = (const bf16*)(F.ws + WS_QN); bf16* Y = (bf16*)F.out + (size_t)M * D;
    const float* kcmp = (const float*)(F.ws + WS_KCMP); const float* vcmp = (const float*)(F.ws + WS_VCMP); const float* GWp = (const float*)(F.ws + WS_GW);
    LAS float* ps = (LAS float*)(F.lds + RING_OFF + wave * 16384);
    LAS float* ocs = ps + 256;
    LAS float* svl = ps + 512;
    LAS float* q = (LAS float*)(F.lds + RING_OFF + wave * 16384 + 4096);
    for (int i = gw; i < M; i += NGW) {
        int t, b; task_bt(i, t, b); const int row = b * T + t, own = t >> 6, base = b * T;
#pragma unroll
        for (int k = 0; k < 4; ++k) ps[lane + 64 * k] = 0.f;
#pragma unroll 1
        for (int h = 0; h < 4; ++h) {
            LDS_WAIT(); asm volatile("" ::: "memory");
            q[lane] = bf2f(QN[(size_t)row * 256 + h * 64 + lane]);
            LDS_WAIT(); asm volatile("" ::: "memory");
            KVf32 kc{kcmp + (size_t)b * 256 * 64, vcmp + (size_t)b * 256 * 64, 64, 64};
            float ml = -INFINITY;
#pragma unroll 1
            for (int k = 0; k < 4; ++k) { const int n = lane + 64 * k; const bool valid = (n < 255) && (16 * n + 31 <= t);
                float sv = -INFINITY; if (valid) sv = kc.dot<64>(n, q) * 0.125f; svl[n] = sv; ml = fmaxf(ml, sv); }
            const float Mx = wave_max(ml);
            float o[64];
#pragma unroll
            for (int d = 0; d < 64; ++d) o[d] = 0.f;
#ifndef NSA_NO_C
            if (Mx > -INFINITY) {
                float ls = 0.f;
#pragma unroll 1
                for (int k = 0; k < 4; ++k) { const float sv = svl[lane + 64 * k]; const float p = sv > -INFINITY ? __expf(sv - Mx) : 0.f; ls += p; svl[lane + 64 * k] = p; }
                const float inv = 1.0f / wave_sum(ls);
#pragma unroll 1
                for (int k = 0; k < 4; ++k) { const float p = svl[lane + 64 * k] * inv; ps[lane + 64 * k] += p; if (p > 0.f) kc.axpy(lane + 64 * k, p, o); }
            }
#endif
            ocs[h * 64 + lane] = reduce64(o, lane);
        }
        LDS_WAIT(); asm volatile("" ::: "memory");
        float imp = (ps[4 * lane] + ps[4 * lane + 1]) + (ps[4 * lane + 2] + ps[4 * lane + 3]); if (lane > 0) imp += ps[4 * lane - 1];
        LDS_WAIT(); asm volatile("" ::: "memory");
        const bool causal = lane <= own, forced = causal && (lane == 0 || lane >= own - 1);
        float val = forced ? 1e4f : (causal ? imp : -INFINITY);
        unsigned long long selmask = 0ull;
        for (int r = 0; r < 16; ++r) { const float mx = wave_max(val); if (!(mx > -INFINITY)) break;
            const unsigned long long ball = __ballot(val == mx); const int sl = __ffsll((long long)ball) - 1; selmask |= 1ull << sl; if (lane == sl) val = -INFINITY; }
#ifdef FLASH_NSA
        if (lane == 0) ((unsigned long long*)(F.ws + WS_NSEL))[row] = selmask;
#pragma unroll
        for (int h = 0; h < 4; ++h) ((bf16*)(F.ws + WS_OC))[(size_t)row * 256 + h * 64 + lane] = (bf16)f2bf(ocs[h * 64 + lane]);
        LDS_WAIT(); asm volatile("" ::: "memory");
        continue;
#endif
#pragma unroll 1
        for (int h = 0; h < 4; ++h) {
            LDS_WAIT(); asm volatile("" ::: "memory");
            q[lane] = bf2f(QN[(size_t)row * 256 + h * 64 + lane]);
            LDS_WAIT(); asm volatile("" ::: "memory");
            KVbf ks{(const bf16*)(F.ws + WS_KS), (const bf16*)(F.ws + WS_VS), 64, 64};
            auto keys = [&](int s) { const int p = 64 * s + lane; return (((selmask >> s) & 1ull) && p <= t) ? base + p : -1; };
#ifdef NSA_NO_S
            float os = q[3];
#else
            float os = wave_attend<64>(q, 0.125f, own + 1, keys, ks, lane);
            asm volatile("" : "+v"(os) :: "memory");
#endif
            KVbf kw{(const bf16*)(F.ws + WS_KW), (const bf16*)(F.ws + WS_VW), 64, 64};
            auto keyw = [&](int s) { const int p = t - 511 + lane + 64 * s; return p >= 0 ? base + p : -1; };
#ifdef NSA_NO_W
            float ow = q[5];
#else
            float ow = wave_attend<64>(q, 0.125f, 8, keyw, kw, lane);
            asm volatile("" : "+v"(ow) :: "memory");
#endif
            const float* gp = GWp + (size_t)row * 32 + h * 3;
            const float g0 = sigmoid_f(gp[0]), g1 = sigmoid_f(gp[1]), g2 = sigmoid_f(gp[2]);
            Y[(size_t)row * 1024 + 512 + h * 64 + lane] = (bf16)f2bf(g0 * ocs[h * 64 + lane] + g1 * os + g2 * ow);
        }
    }
}
__device__ __forceinline__ void dsa_tokens_phase(Frame& F) {
    const int wave = cur_wave(), gw = blockIdx.x * NWAVES + wave, NGW = F.G * NWAVES, lane = cur_lane();
    const float* IQ = (const float*)(F.ws + WS_IQ); const float* IK = (const float*)(F.ws + WS_IK); const float* GWp = (const float*)(F.ws + WS_GW);
    const bf16* QD = (const bf16*)(F.ws + WS_QD); bf16* Y = (bf16*)F.out + (size_t)M * D;
    LAS float* sc = (LAS float*)(F.lds + RING_OFF + wave * 16384);
    LAS unsigned* hist = (LAS unsigned*)(F.lds + XTRA_OFF + wave * XTRA_WAVE);
    LAS unsigned short* idx = (LAS unsigned short*)hist;
    LAS float* xq = (LAS float*)(F.lds + XTRA_OFF + wave * XTRA_WAVE + 1024);
    for (int i = gw; i < M; i += NGW) {
        int t, b; task_bt(i, t, b); const int row = b * T + t, base = b * T, n = t + 1;
#pragma unroll
        for (int k = 0; k < 4; ++k) xq[lane + 64 * k] = IQ[(size_t)row * 256 + lane + 64 * k];
        if (lane < 8) xq[256 + lane] = GWp[(size_t)row * 32 + 12 + lane];
        LDS_WAIT(); asm volatile("" ::: "memory");
        for (int k0 = 0; k0 < n; k0 += 64) {
            const int key = k0 + lane;
            if (key < n) {
                float ik[32];
                { const f32x4* kp = (const f32x4*)(IK + (size_t)(base + key) * 32);
#pragma unroll
                  for (int c = 0; c < 8; ++c) { const f32x4 f = kp[c]; ik[4 * c] = f.x; ik[4 * c + 1] = f.y; ik[4 * c + 2] = f.z; ik[4 * c + 3] = f.w; } }
                float score = 0.f;
#pragma unroll
                for (int h = 0; h < 8; ++h) { float ds = 0.f;
#pragma unroll
                    for (int c = 0; c < 8; ++c) { const f32x4 qv = *(const LAS f32x4*)(xq + h * 32 + 4 * c); ds += (qv.x * ik[4 * c] + qv.y * ik[4 * c + 1]) + (qv.z * ik[4 * c + 2] + qv.w * ik[4 * c + 3]); }
                    score += xq[256 + h] * fmaxf(ds, 0.f); }
                sc[key] = score * 0.0625f + 0.0f;
            }
        }
        LDS_WAIT(); asm volatile("" ::: "memory");
        int nsel = n;
        if (n > 256) {
            unsigned prefix = 0u, pmask = 0u; int kk = 256;
            for (int pass = 0; pass < 4; ++pass) {
                const int shift = 24 - 8 * pass;
#pragma unroll
                for (int k = 0; k < 4; ++k) hist[lane + 64 * k] = 0u;
                LDS_WAIT(); asm volatile("" ::: "memory");
                for (int k0 = 0; k0 < n; k0 += 64) { const int key = k0 + lane;
                    if (key < n) { const unsigned u = fkey(sc[key]); if ((u & pmask) == prefix) __hip_atomic_fetch_add(hist + ((u >> shift) & 255u), 1u, __ATOMIC_RELAXED, __HIP_MEMORY_SCOPE_WORKGROUP); } }
                LDS_WAIT(); asm volatile("" ::: "memory");
                const int h0 = (int)hist[4 * lane], h1 = (int)hist[4 * lane + 1], h2 = (int)hist[4 * lane + 2], h3 = (int)hist[4 * lane + 3];
                const int tot = (h0 + h1) + (h2 + h3); int incl = tot;
#pragma unroll
                for (int o = 1; o < 64; o <<= 1) { const int v = __shfl_down(incl, o); if (lane + o < 64) incl += v; }
                int run = incl - tot, found = -1, newk = 0;
                if (run < kk && run + h3 >= kk) { found = 4 * lane + 3; newk = kk - run; } run += h3;
                if (found < 0 && run < kk && run + h2 >= kk) { found = 4 * lane + 2; newk = kk - run; } run += h2;
                if (found < 0 && run < kk && run + h1 >= kk) { found = 4 * lane + 1; newk = kk - run; } run += h1;
                if (found < 0 && run < kk && run + h0 >= kk) { found = 4 * lane; newk = kk - run; }
                const unsigned long long ball = __ballot(found >= 0); const int src = __ffsll((long long)ball) - 1;
                const int bin = __shfl(found, src); kk = __shfl(newk, src);
                prefix |= (unsigned)bin << shift; pmask |= 255u << shift;
                LDS_WAIT(); asm volatile("" ::: "memory");
            }
            int eqseen = 0, cnt = 0;
            for (int k0 = 0; k0 < n; k0 += 64) { const int key = k0 + lane; const bool inb = key < n; const unsigned u = inb ? fkey(sc[key]) : 0u;
                const bool gt = inb && u > prefix, eq = inb && u == prefix;
                const unsigned long long be = __ballot(eq); const bool sel = gt || (eq && (eqseen + mbcnt64(be)) < kk);
                const unsigned long long bs = __ballot(sel); if (sel) idx[cnt + mbcnt64(bs)] = (unsigned short)key;
#ifdef FLASH_DSA
                if (lane == 0) ((unsigned long long*)(F.ws + WS_DSAMASK))[(size_t)row * 64 + (k0 >> 6)] = bs;
#endif
                eqseen += __popcll(be); cnt += __popcll(bs); }
            nsel = cnt;
            LDS_WAIT(); asm volatile("" ::: "memory");
        }
#ifdef FLASH_DSA
        if (n <= 256) { for (int k0 = 0; k0 < n; k0 += 64) if (lane == 0) ((unsigned long long*)(F.ws + WS_DSAMASK))[(size_t)row * 64 + (k0 >> 6)] = causal_word(t - k0); }
        continue;
#endif
        int kidx[4];
#pragma unroll
        for (int k = 0; k < 4; ++k) { const int p = lane + 64 * k; kidx[k] = p < nsel ? base + (n > 256 ? (int)idx[p] : p) : -1; }
        LDS_WAIT(); asm volatile("" ::: "memory");
#pragma unroll 1
        for (int h = 0; h < 4; ++h) {
            LDS_WAIT(); asm volatile("" ::: "memory");
            xq[lane] = bf2f(QD[(size_t)row * 256 + h * 64 + lane]);
            LDS_WAIT(); asm volatile("" ::: "memory");
            KVbf kd{(const bf16*)(F.ws + WS_KD), (const bf16*)(F.ws + WS_VD), 64, 64};
            auto keyf = [&](int s) { return s == 0 ? kidx[0] : s == 1 ? kidx[1] : s == 2 ? kidx[2] : kidx[3]; };
            const float r = wave_attend<64>(xq, 0.125f, 4, keyf, kd, lane);
            Y[(size_t)row * 1024 + 768 + h * 64 + lane] = (bf16)f2bf(r);
        }
        LDS_WAIT(); asm volatile("" ::: "memory");
    }
}
typedef float f32x16 __attribute__((ext_vector_type(16)));
__device__ __forceinline__ float xhalf_max(float v) { const auto rr = __builtin_amdgcn_permlane32_swap(__float_as_uint(v), __float_as_uint(v), false, false); return fmaxf(__uint_as_float(rr[0]), __uint_as_float(rr[1])); }
__device__ __forceinline__ float xhalf_sum(float v) { const auto rr = __builtin_amdgcn_permlane32_swap(__float_as_uint(v), __float_as_uint(v), false, false); return __uint_as_float(rr[0]) + __uint_as_float(rr[1]); }
__device__ __forceinline__ float xhalf_other(float v, int hh) { const auto rr = __builtin_amdgcn_permlane32_swap(__float_as_uint(v), __float_as_uint(v), false, false); return __uint_as_float(hh ? rr[0] : rr[1]); }
constexpr int FL_KP96 = 208, FL_KP64 = 144, FL_VP = 144;
constexpr int FL_KBUF = 0, FL_KBUF_SZ = 64 * FL_KP96, FL_VBUF = 2 * FL_KBUF_SZ, FL_VBUF_SZ = 64 * FL_VP;
constexpr int FL_TL = FL_VBUF + 2 * FL_VBUF_SZ, FL_TLN = FL_TL + 64, FL_ORM = FL_TLN + 8, FL_SEL = FL_TL + 128;
constexpr int FL_END = FL_SEL + 512;
static_assert(FL_END <= RING_BYTES, "flash LDS map");
struct FlashKV { const bf16* K; const bf16* V; int kp, vp; };


template <int MODE>
__device__ __forceinline__ void fl_softmax(f32x16& p0, f32x16& p1, const unsigned long long word, const int h, const float sc2, float& m, float& lsum, f32x16& o0, f32x16& o1) {
    if (MODE == 2) {
        const unsigned wlo = (unsigned)word >> (4 * h), whi = (unsigned)(word >> 32) >> (4 * h);
#pragma unroll
        for (int i = 0; i < 16; ++i) { const int bit = (i & 3) + 8 * (i >> 2);
            p0[i] = (wlo & (1u << bit)) ? p0[i] : -INFINITY; p1[i] = (whi & (1u << bit)) ? p1[i] : -INFINITY; }
    }
    float mx, mx2;
    asm("v_max3_f32 %0, %1, %2, %3" : "=v"(mx) : "v"(p0[0]), "v"(p0[1]), "v"(p0[2]));
    asm("v_max3_f32 %0, %1, %2, %3" : "=v"(mx2) : "v"(p1[0]), "v"(p1[1]), "v"(p1[2]));
#pragma unroll
    for (int i = 3; i < 15; i += 2) { asm("v_max3_f32 %0, %1, %2, %3" : "=v"(mx) : "v"(mx), "v"(p0[i]), "v"(p0[i + 1])); asm("v_max3_f32 %0, %1, %2, %3" : "=v"(mx2) : "v"(mx2), "v"(p1[i]), "v"(p1[i + 1])); }
    asm("v_max3_f32 %0, %1, %2, %3" : "=v"(mx) : "v"(mx), "v"(p0[15]), "v"(p1[15]));
    asm("v_max_f32_e32 %0, %1, %2" : "=v"(mx) : "v"(mx), "v"(mx2));
    const bool rowon = (MODE != 1) || (word != 0ull);
    if (MODE == 1) mx = rowon ? mx : -INFINITY;
    mx = xhalf_max(mx);
    const float mn = fmaxf(m, mx * sc2);
    if (__any(mn > m)) { const float alpha = __builtin_amdgcn_exp2f(m - mn); lsum *= alpha;
#pragma unroll
        for (int i = 0; i < 16; ++i) { o0[i] *= alpha; o1[i] *= alpha; } }
    m = mn;
    const float nm = rowon ? -mn : -INFINITY;
    float ps = 0.f;
#pragma unroll
    for (int i = 0; i < 16; ++i) { p0[i] = __builtin_amdgcn_exp2f(__builtin_fmaf(p0[i], sc2, nm)); p1[i] = __builtin_amdgcn_exp2f(__builtin_fmaf(p1[i], sc2, nm)); ps += p0[i] + p1[i]; }
    lsum += ps;
}
template <int DQK, class MaskFn>
__device__ __forceinline__ void flash_unit(LAS unsigned char* lds, const FlashKV kv, const bf16* qrow, const float sc2  , const int ntiles,
                                           const MaskFn& maskf, f32x16& o0, f32x16& o1, float& lsum) {
    constexpr int KP = (DQK == 96) ? FL_KP96 : FL_KP64, NKS = DQK / 16, CPR = DQK / 8;
    const int tid = cur_tid(), lane = tid & 63, r = lane & 31, h = lane >> 5;
    const LAS unsigned char* tl = lds + FL_TL;
    bf16x8 qf[NKS];
#pragma unroll
    for (int ks = 0; ks < NKS; ++ks) qf[ks] = *(const GAS bf16x8*)(qrow + 16 * ks + 8 * h);
    const int kr0 = tid / CPR, kc0 = tid - kr0 * CPR;
    const int kr1 = (tid + 512) / CPR, kc1 = (tid + 512) - kr1 * CPR;
    const bool has2 = (DQK == 96) && (tid < 256);
    const int vr = tid >> 3, vc = tid & 7;
    struct StageRegs { v4u k0, k1, v; };
    StageRegs S0, S1; S0.k1 = (v4u){0u, 0u, 0u, 0u}; S1.k1 = (v4u){0u, 0u, 0u, 0u};
    auto gload = [&](StageRegs& S, int tile) {
        const size_t rowb = (size_t)tile * 64;
        S.k0 = *(const GAS v4u*)(kv.K + (rowb + kr0) * kv.kp + 8 * kc0);
        if (DQK == 96) S.k1 = *(const GAS v4u*)(kv.K + (rowb + (has2 ? kr1 : kr0)) * kv.kp + 8 * (has2 ? kc1 : kc0));
        S.v = *(const GAS v4u*)(kv.V + (rowb + vr) * kv.vp + 8 * vc);
    };
    auto lstore = [&](const StageRegs& S, int buf) {
        LAS unsigned char* Kb = lds + FL_KBUF + buf * FL_KBUF_SZ; LAS unsigned char* Vb = lds + FL_VBUF + buf * FL_VBUF_SZ;
        *(LAS v4u*)(Kb + kr0 * KP + 16 * kc0) = S.k0;
        if (has2) *(LAS v4u*)(Kb + kr1 * KP + 16 * kc1) = S.k1;
        *(LAS v4u*)(Vb + vr * FL_VP + 16 * vc) = S.v;
    };
    float m = -1e30f; lsum = 0.f;
    __syncthreads();
#pragma unroll
    for (int i = 0; i < 16; ++i) { o0[i] = 0.f; o1[i] = 0.f; }
    unsigned long long wnext = 0ull;
    if (ntiles > 0) { wnext = maskf((int)tl[0]); gload(S0, (int)tl[0]); lstore(S0, 0); }
    if (ntiles > 0) gload(S1, (int)tl[ntiles > 1 ? 1 : 0]);
#pragma unroll
    for (int ks = 0; ks < NKS; ++ks) asm volatile("" :: "v"(qf[ks]));
    __syncthreads();
    auto step = [&](const int it, StageRegs& Sload, const StageRegs& Sstore) __attribute__((always_inline)) {
        const int cur = it & 1;
        const unsigned long long word = wnext;
        wnext = maskf((int)tl[it + 1 < ntiles ? it + 1 : ntiles - 1]);
        gload(Sload, (int)tl[it + 2 < ntiles ? it + 2 : ntiles - 1]);
        if (!__all(word == 0ull)) {
            const LAS unsigned char* Kb = lds + FL_KBUF + cur * FL_KBUF_SZ; const LAS unsigned char* Vb = lds + FL_VBUF + cur * FL_VBUF_SZ;
            f32x16 p0, p1;
#pragma unroll
            for (int i = 0; i < 16; ++i) { p0[i] = 0.f; p1[i] = 0.f; }
#pragma unroll
            for (int ks = 0; ks < NKS; ++ks) {
                const bf16x8 a0 = *(const LAS bf16x8*)(Kb + r * KP + (16 * ks + 8 * h) * 2), a1 = *(const LAS bf16x8*)(Kb + (32 + r) * KP + (16 * ks + 8 * h) * 2);
                p0 = __builtin_amdgcn_mfma_f32_32x32x16_bf16(a0, qf[ks], p0, 0, 0, 0);
                p1 = __builtin_amdgcn_mfma_f32_32x32x16_bf16(a1, qf[ks], p1, 0, 0, 0);
            }
            if (__all(word == ~0ull)) fl_softmax<0>(p0, p1, word, h, sc2, m, lsum, o0, o1);
            else if (__all(word == ~0ull || word == 0ull)) fl_softmax<1>(p0, p1, word, h, sc2, m, lsum, o0, o1);
            else fl_softmax<2>(p0, p1, word, h, sc2, m, lsum, o0, o1);
            bf16x8 pf[4];
#pragma unroll
            for (int s = 0; s < 4; ++s) { v4u w;
                if (s < 2) { w.x = pg8::cvt_pk_bf16(p0[8 * s], p0[8 * s + 1]); w.y = pg8::cvt_pk_bf16(p0[8 * s + 2], p0[8 * s + 3]); w.z = pg8::cvt_pk_bf16(p0[8 * s + 4], p0[8 * s + 5]); w.w = pg8::cvt_pk_bf16(p0[8 * s + 6], p0[8 * s + 7]); }
                else { const int s2 = s - 2; w.x = pg8::cvt_pk_bf16(p1[8 * s2], p1[8 * s2 + 1]); w.y = pg8::cvt_pk_bf16(p1[8 * s2 + 2], p1[8 * s2 + 3]); w.z = pg8::cvt_pk_bf16(p1[8 * s2 + 4], p1[8 * s2 + 5]); w.w = pg8::cvt_pk_bf16(p1[8 * s2 + 6], p1[8 * s2 + 7]); }
                pf[s] = __builtin_bit_cast(bf16x8, w); }
            {
                typedef short v4i16_t __attribute__((ext_vector_type(4)));
                const LAS unsigned char* vbase = Vb + (4 * h + ((lane & 15) >> 2)) * FL_VP + (16 * ((lane >> 4) & 1) + 4 * (lane & 3)) * 2;
#pragma unroll
                for (int s = 0; s < 4; ++s) {
#pragma unroll
                    for (int db = 0; db < 2; ++db) {
                        const LAS unsigned char* vp_ = vbase + (32 * (s >> 1) + 16 * (s & 1)) * FL_VP + 64 * db;
                        const v4i16_t lo = __builtin_amdgcn_ds_read_tr16_b64_v4i16((LAS v4i16_t*)vp_), hi = __builtin_amdgcn_ds_read_tr16_b64_v4i16((LAS v4i16_t*)(vp_ + 8 * FL_VP));
                        const bf16x8 a = {lo[0], lo[1], lo[2], lo[3], hi[0], hi[1], hi[2], hi[3]};
                        if (db == 0) o0 = __builtin_amdgcn_mfma_f32_32x32x16_bf16(a, pf[s], o0, 0, 0, 0);
                        else o1 = __builtin_amdgcn_mfma_f32_32x32x16_bf16(a, pf[s], o1, 0, 0, 0);
                    }
                }
            }
        }
        if (it + 1 < ntiles) lstore(Sstore, cur ^ 1);
        __syncthreads();
    };
    for (int it = 0; it < ntiles; it += 2) { step(it, S0, S1); if (it + 1 < ntiles) step(it + 1, S1, S0); }
}
__device__ __forceinline__ void flash_store(bf16* yrow  , const f32x16& o0, const f32x16& o1, float inv, int h) {
#pragma unroll
    for (int g = 0; g < 4; ++g) {
        typedef unsigned u32x2v __attribute__((ext_vector_type(2)));
        u32x2v w0, w1;
        w0.x = pg8::cvt_pk_bf16(o0[4 * g] * inv, o0[4 * g + 1] * inv); w0.y = pg8::cvt_pk_bf16(o0[4 * g + 2] * inv, o0[4 * g + 3] * inv);
        w1.x = pg8::cvt_pk_bf16(o1[4 * g] * inv, o1[4 * g + 1] * inv); w1.y = pg8::cvt_pk_bf16(o1[4 * g + 2] * inv, o1[4 * g + 3] * inv);
        *(u32x2v*)(yrow + 8 * g + 4 * h) = w0; *(u32x2v*)(yrow + 32 + 8 * g + 4 * h) = w1;
    }
}

__device__ __forceinline__ void mla_flash_phase(Frame& F) {
    const int tid = cur_tid(), wave = cur_wave(), lane = tid & 63, r = lane & 31, h2 = lane >> 5;
    bf16* Y = (bf16*)F.out + (size_t)M * D;
    for (int pass = 0; pass < 2; ++pass) {
        for (int u0 = blockIdx.x; u0 < 256; u0 += F.G) {
            const int u = pass ? 511 - u0 : u0, qb = u >> 5, bh = u & 31, b = bh >> 2, hd = bh & 3;
            const int t = 256 * qb + 32 * wave + r; const size_t row = (size_t)b * T + t;
            LAS unsigned char* tl = F.lds + FL_TL;
            if (tid < 64) tl[tid] = (unsigned char)tid;
            const int ntiles = 4 * qb + 4;
            FlashKV kv{(const bf16*)(F.ws + WS_KMLA) + (size_t)b * T * 384 + hd * 96, (const bf16*)(F.ws + WS_VMLA) + (size_t)b * T * 256 + hd * 64, 384, 256};
            auto maskf = [&](int tile) { return causal_word(t - 64 * tile); };
            f32x16 o0, o1; float ls;
            flash_unit<96>(F.lds, kv, (const bf16*)(F.ws + WS_QMLA) + row * 384 + hd * 96, 0.10206207261596577f * 1.4426950408889634f, ntiles, maskf, o0, o1, ls);
            ls = xhalf_sum(ls);
            flash_store(Y + row * 1024 + 256 + hd * 64, o0, o1, ls > 0.f ? 1.0f / ls : 0.f, h2);
        }
    }
}

__device__ __forceinline__ void moba_flash_phase(Frame& F) {
    const int tid = cur_tid(), wave = cur_wave(), lane = tid & 63, r = lane & 31, h2 = lane >> 5;
    bf16* Y = (bf16*)F.out + (size_t)M * D;
    const float* QF = (const float*)(F.ws + WS_QM_F); const float* kmean = (const float*)(F.ws + WS_KMEAN);
    LAS unsigned short* msel = (LAS unsigned short*)(F.lds + FL_SEL); LAS unsigned* orm = (LAS unsigned*)(F.lds + FL_ORM); LAS unsigned char* tl = F.lds + FL_TL; LAS int* tln = (LAS int*)(F.lds + FL_TLN);
    for (int pass = 0; pass < 2; ++pass) {
        for (int u0 = blockIdx.x; u0 < 256; u0 += F.G) {
            const int u = pass ? 511 - u0 : u0, own = u >> 5, bh = u & 31, b = bh >> 2, hd = bh & 3;
            if (tid == 0) orm[0] = 0u;
            __syncthreads();
            if (tid < 256) {
                const float* qp = QF + ((size_t)b * T + 256 * own + tid) * 256 + hd * 64;
                const float* km = kmean + (size_t)((b * 4 + hd) * 16) * 64;
                f32x4 qv[16];
#pragma unroll
                for (int c = 0; c < 16; ++c) qv[c] = *(const f32x4*)(qp + 4 * c);
                float g[15];
#pragma unroll
                for (int j = 0; j < 15; ++j) { g[j] = 0.f;
                    if (j < own) { float a = 0.f;
#pragma unroll
                        for (int c = 0; c < 16; ++c) { const f32x4 kv4 = *(const f32x4*)(km + j * 64 + 4 * c); a += (qv[c].x * kv4.x + qv[c].y * kv4.y) + (qv[c].z * kv4.z + qv[c].w * kv4.w); }
                        g[j] = a; } }
                unsigned sel = 0u;
#pragma unroll
                for (int rr = 0; rr < 3; ++rr) { float best = -INFINITY; int bi = -1;
#pragma unroll
                    for (int j = 0; j < 15; ++j) if (j < own && !((sel >> j) & 1u) && g[j] > best) { best = g[j]; bi = j; }
                    if (bi >= 0) sel |= 1u << bi; }
                msel[tid] = (unsigned short)sel;
                __hip_atomic_fetch_or(orm, sel, __ATOMIC_RELAXED, __HIP_MEMORY_SCOPE_WORKGROUP);
            }
            __syncthreads();
            if (tid == 0) { const unsigned om = orm[0]; int n = 0;
                for (int j = 0; j < own; ++j) if ((om >> j) & 1u) { for (int q4 = 0; q4 < 4; ++q4) tl[n++] = (unsigned char)(4 * j + q4); }
                for (int q4 = 0; q4 < 4; ++q4) tl[n++] = (unsigned char)(4 * own + q4);
                tln[0] = n; }
            __syncthreads();
            const int ntiles = tln[0];
            const int tq = 32 * wave + r, t = 256 * own + tq; const size_t row = (size_t)b * T + t;
            const unsigned mysel = msel[tq];
            FlashKV kv{(const bf16*)(F.ws + WS_KM_BF) + (size_t)b * T * 256 + hd * 64, (const bf16*)(F.ws + WS_VM_BF) + (size_t)b * T * 256 + hd * 64, 256, 256};
            auto maskf = [&](int tile) { const int blk = tile >> 2; return blk == own ? causal_word(t - 64 * tile) : (((mysel >> blk) & 1u) ? ~0ull : 0ull); };
            f32x16 o0, o1; float ls;
            flash_unit<64>(F.lds, kv, (const bf16*)(F.ws + WS_QM_BF) + row * 256 + hd * 64, 0.125f * 1.4426950408889634f, ntiles, maskf, o0, o1, ls);
            ls = xhalf_sum(ls);
            flash_store(Y + row * 1024 + hd * 64, o0, o1, ls > 0.f ? 1.0f / ls : 0.f, h2);
        }
    }
}
__device__ __forceinline__ void dsa_flash_phase(Frame& F) {
    const int tid = cur_tid(), wave = cur_wave(), lane = tid & 63, r = lane & 31, h2 = lane >> 5;
    bf16* Y = (bf16*)F.out + (size_t)M * D;
    const unsigned long long* BM = (const unsigned long long*)(F.ws + WS_DSAMASK);
    for (int pass = 0; pass < 2; ++pass) {
        for (int u0 = blockIdx.x; u0 < 256; u0 += F.G) {
            const int u = pass ? 511 - u0 : u0, tb = u >> 3, b = u & 7, hd = wave >> 1;
            const int t = 64 * tb + 32 * (wave & 1) + r; const size_t row = (size_t)b * T + t;
            LAS unsigned char* tl = F.lds + FL_TL;
            __syncthreads();
            if (tid < 64) tl[tid] = (unsigned char)tid;
            const int ntiles = tb + 1;
            FlashKV kv{(const bf16*)(F.ws + WS_KD) + (size_t)b * T * 64, (const bf16*)(F.ws + WS_VD) + (size_t)b * T * 64, 64, 64};
            const unsigned long long* bmrow = BM + row * 64;
            auto maskf = [&](int tile) { return bmrow[tile]; };
            f32x16 o0, o1; float ls;
            flash_unit<64>(F.lds, kv, (const bf16*)(F.ws + WS_QD) + row * 256 + hd * 64, 0.125f * 1.4426950408889634f, ntiles, maskf, o0, o1, ls);
            ls = xhalf_sum(ls);
            flash_store(Y + row * 1024 + 768 + hd * 64, o0, o1, ls > 0.f ? 1.0f / ls : 0.f, h2);
        }
    }
}
__device__ __forceinline__ void nsa_flash_phase(Frame& F) {
    const int tid = cur_tid(), wave = cur_wave(), lane = tid & 63, r = lane & 31, h2 = lane >> 5;
    bf16* Y = (bf16*)F.out + (size_t)M * D;
    const unsigned long long* NSEL = (const unsigned long long*)(F.ws + WS_NSEL); const bf16* OC = (const bf16*)(F.ws + WS_OC); const float* GWp = (const float*)(F.ws + WS_GW);
    LAS unsigned* orm = (LAS unsigned*)(F.lds + FL_ORM); LAS unsigned char* tl = F.lds + FL_TL; LAS int* tln = (LAS int*)(F.lds + FL_TLN);
    for (int pass = 0; pass < 2; ++pass) {
        for (int u0 = blockIdx.x; u0 < 256; u0 += F.G) {
            const int u = pass ? 511 - u0 : u0, tb = u >> 3, b = u & 7, hd = wave >> 1;
            const int t = 64 * tb + 32 * (wave & 1) + r; const size_t row = (size_t)b * T + t;
            const unsigned long long mysel = NSEL[row];
            __syncthreads();
            if (tid < 2) orm[tid] = 0u;
            __syncthreads();
            if (wave < 2) { __hip_atomic_fetch_or(orm, (unsigned)mysel, __ATOMIC_RELAXED, __HIP_MEMORY_SCOPE_WORKGROUP); __hip_atomic_fetch_or(orm + 1, (unsigned)(mysel >> 32), __ATOMIC_RELAXED, __HIP_MEMORY_SCOPE_WORKGROUP); }
            __syncthreads();
            if (tid == 0) { const unsigned long long om = (unsigned long long)orm[0] | ((unsigned long long)orm[1] << 32); int n = 0;
                for (int j = 0; j <= tb; ++j) if ((om >> j) & 1ull) tl[n++] = (unsigned char)j;
                tln[0] = n; }
            __syncthreads();
            const int nsel_tiles = tln[0];
            const bf16* qrow = (const bf16*)(F.ws + WS_QN) + row * 256 + hd * 64;
            const float* gp = GWp + row * 32 + hd * 3;
            const float g0 = sigmoid_f(gp[0]), g1 = sigmoid_f(gp[1]), g2 = sigmoid_f(gp[2]);
            LAS float* stash = (LAS float*)(F.lds + 49152) + wave * 2048 + lane;
            {
                FlashKV kv{(const bf16*)(F.ws + WS_KS) + (size_t)b * T * 64, (const bf16*)(F.ws + WS_VS) + (size_t)b * T * 64, 64, 64};
                auto maskf = [&](int tile) { return ((mysel >> tile) & 1ull) ? causal_word(t - 64 * tile) : 0ull; };
                f32x16 o0, o1; float ls;
                flash_unit<64>(F.lds, kv, qrow, 0.125f * 1.4426950408889634f, nsel_tiles, maskf, o0, o1, ls);
                ls = xhalf_sum(ls); const float sc = ls > 0.f ? g1 / ls : 0.f;
                const bf16* ocr = OC + row * 256 + hd * 64;
#pragma unroll
                for (int g = 0; g < 4; ++g) { const unsigned long long w0 = *(const unsigned long long*)(ocr + 8 * g + 4 * h2), w1 = *(const unsigned long long*)(ocr + 32 + 8 * g + 4 * h2);
                    stash[(4 * g) * 64] = sc * o0[4 * g] + g0 * __uint_as_float((unsigned)w0 << 16); stash[(4 * g + 1) * 64] = sc * o0[4 * g + 1] + g0 * __uint_as_float((unsigned)w0 & 0xffff0000u);
                    stash[(4 * g + 2) * 64] = sc * o0[4 * g + 2] + g0 * __uint_as_float((unsigned)(w0 >> 32) << 16); stash[(4 * g + 3) * 64] = sc * o0[4 * g + 3] + g0 * __uint_as_float((unsigned)(w0 >> 32) & 0xffff0000u);
                    stash[(16 + 4 * g) * 64] = sc * o1[4 * g] + g0 * __uint_as_float((unsigned)w1 << 16); stash[(16 + 4 * g + 1) * 64] = sc * o1[4 * g + 1] + g0 * __uint_as_float((unsigned)w1 & 0xffff0000u);
                    stash[(16 + 4 * g + 2) * 64] = sc * o1[4 * g + 2] + g0 * __uint_as_float((unsigned)(w1 >> 32) << 16); stash[(16 + 4 * g + 3) * 64] = sc * o1[4 * g + 3] + g0 * __uint_as_float((unsigned)(w1 >> 32) & 0xffff0000u); }
            }
            f32x16 a0, a1;
            {
                __syncthreads();
                const int t0 = tb >= 8 ? tb - 8 : 0;
                if (tid < 64) tl[tid] = (unsigned char)(t0 + tid);
                FlashKV kv{(const bf16*)(F.ws + WS_KW) + (size_t)b * T * 64, (const bf16*)(F.ws + WS_VW) + (size_t)b * T * 64, 64, 64};
                auto maskf = [&](int tile) { return causal_word(t - 64 * tile) & ~causal_word(t - 512 - 64 * tile); };
                f32x16 o0, o1; float ls;
                flash_unit<64>(F.lds, kv, qrow, 0.125f * 1.4426950408889634f, tb - t0 + 1, maskf, o0, o1, ls);
                ls = xhalf_sum(ls); const float sc = ls > 0.f ? g2 / ls : 0.f;
#pragma unroll
                for (int i = 0; i < 16; ++i) { a0[i] = sc * o0[i] + stash[i * 64]; a1[i] = sc * o1[i] + stash[(16 + i) * 64]; }
            }
            flash_store(Y + row * 1024 + 512 + hd * 64, a0, a1, 1.0f, h2);
        }
    }
}

__device__ __forceinline__ int hist_pick(LAS unsigned* hist, int& kk, const int lane) {
    const int h0 = (int)hist[4 * lane], h1 = (int)hist[4 * lane + 1], h2 = (int)hist[4 * lane + 2], h3 = (int)hist[4 * lane + 3];
    const int tot = (h0 + h1) + (h2 + h3); int incl = tot;
#pragma unroll
    for (int o = 1; o < 64; o <<= 1) { const int v = __shfl_down(incl, o); if (lane + o < 64) incl += v; }
    int run = incl - tot, found = -1, newk = 0;
    if (run < kk && run + h3 >= kk) { found = 4 * lane + 3; newk = kk - run; } run += h3;
    if (found < 0 && run < kk && run + h2 >= kk) { found = 4 * lane + 2; newk = kk - run; } run += h2;
    if (found < 0 && run < kk && run + h1 >= kk) { found = 4 * lane + 1; newk = kk - run; } run += h1;
    if (found < 0 && run < kk && run + h0 >= kk) { found = 4 * lane; newk = kk - run; }
    const unsigned long long ball = __ballot(found >= 0); const int src = __ffsll((long long)ball) - 1;
    const int bin = __shfl(found, src); kk = __shfl(newk, src);
    return bin;
}
__device__ __forceinline__ float unfkey(unsigned u) { return __uint_as_float((u & 0x80000000u) ? (u ^ 0x80000000u) : ~u); }
__device__ __forceinline__ void radix_select_write(LAS float* sc, LAS unsigned* hist, unsigned long long* bmrow, const int t, const int lane) {
    const int n = t + 1;
    if (n <= 256) { for (int k0 = 0; k0 < n; k0 += 64) if (lane == 0) bmrow[k0 >> 6] = causal_word(t - k0); return; }
#define RS_LOAD4(k0) float x_[4]; { _Pragma("unroll") for (int j_ = 0; j_ < 4; ++j_) { const float v_ = sc[(k0) + 64 * j_ + lane]; x_[j_] = (lane < n - (k0) - 64 * j_) ? v_ : -INFINITY; } }
    float mn = INFINITY, mx = -INFINITY;
    for (int k0 = 0; k0 < n; k0 += 256) { RS_LOAD4(k0);
#pragma unroll
        for (int j = 0; j < 4; ++j) { mx = fmaxf(mx, x_[j]); mn = fminf(mn, x_[j] > -INFINITY ? x_[j] : INFINITY); } }
    mn = -wave_max(-mn); mx = wave_max(mx);
    const float qs = mx > mn ? 255.99f / (mx - mn) : 1.0f, qo = -mn * qs;
#pragma unroll
    for (int k = 0; k < 4; ++k) hist[lane + 64 * k] = 0u;
    LDS_WAIT(); asm volatile("" ::: "memory");
#ifdef SEL_DUP_HIST
    for (int rep3_ = 0; rep3_ < 2; ++rep3_) {
#pragma unroll
    for (int k = 0; k < 4; ++k) hist[lane + 64 * k] = 0u;
    LDS_WAIT(); asm volatile("" ::: "memory");
#endif
    for (int k0 = 0; k0 < n; k0 += 256) { RS_LOAD4(k0);
#pragma unroll
        for (int j = 0; j < 4; ++j) { int q = (int)__builtin_fmaf(x_[j], qs, qo); q = q > 255 ? 255 : (q < 0 ? 0 : q); __hip_atomic_fetch_add(hist + q, 1u, __ATOMIC_RELAXED, __HIP_MEMORY_SCOPE_WORKGROUP); } }
    LDS_WAIT(); asm volatile("" ::: "memory");
#ifdef SEL_DUP_HIST
    }
#endif
    int kk = 256;
    const int B = hist_pick(hist, kk, lane);
    const int cntB = (int)hist[B];
    LDS_WAIT(); asm volatile("" ::: "memory");
#ifdef FORCE_FALLBACK
    if (cntB > 0) {
#else
    if (cntB > 128) {
#endif
        unsigned prefix = 0u, pmask = 0u;
#pragma unroll 1
        for (int pass = 0; pass < 4; ++pass) {
            const int shift = 24 - 8 * pass;
#pragma unroll
            for (int k = 0; k < 4; ++k) hist[lane + 64 * k] = 0u;
            LDS_WAIT(); asm volatile("" ::: "memory");
            for (int k0 = 0; k0 < n; k0 += 256) { RS_LOAD4(k0);
#pragma unroll
                for (int j = 0; j < 4; ++j) { int q = (int)__builtin_fmaf(x_[j], qs, qo); q = q > 255 ? 255 : (q < 0 ? 0 : q);
                    if (q == B) { const unsigned u = fkey(x_[j]); if ((u & pmask) == prefix) __hip_atomic_fetch_add(hist + ((u >> shift) & 255u), 1u, __ATOMIC_RELAXED, __HIP_MEMORY_SCOPE_WORKGROUP); } } }
            LDS_WAIT(); asm volatile("" ::: "memory");
            const int bin = hist_pick(hist, kk, lane);
            prefix |= (unsigned)bin << shift; pmask |= 255u << shift;
            LDS_WAIT(); asm volatile("" ::: "memory");
        }
        int eqseen = 0;
        for (int k0 = 0; k0 < n; k0 += 256) { RS_LOAD4(k0);
#pragma unroll
            for (int j = 0; j < 4; ++j) { int q = (int)__builtin_fmaf(x_[j], qs, qo); q = q > 255 ? 255 : (q < 0 ? 0 : q);
                const unsigned u = fkey(x_[j]); const bool valid = x_[j] > -INFINITY;
                const bool gt = valid && (q > B || (q == B && u > prefix)), eq = valid && q == B && u == prefix;
                const unsigned long long be = __ballot(eq); const bool sel = gt || (eq && (eqseen + mbcnt64(be)) < kk);
                const unsigned long long bs = __ballot(sel);
                if (lane == 0 && k0 + 64 * j < n) bmrow[(k0 >> 6) + j] = bs;
                eqseen += __popcll(be); } }
        return;
    }
    LAS unsigned* bmw = hist + 256;
    LAS unsigned* cand = (LAS unsigned*)sc;
    int ncand = 0;
    for (int k0 = 0; k0 < n; k0 += 256) { RS_LOAD4(k0);
        asm volatile("" ::: "memory");
#pragma unroll
        for (int j = 0; j < 4; ++j) { int q = (int)__builtin_fmaf(x_[j], qs, qo); q = q > 255 ? 255 : (q < 0 ? 0 : q);
            const bool valid = x_[j] > -INFINITY; const bool gt = valid && q > B, inb = valid && q == B;
            const unsigned long long bg = __ballot(gt), bi = __ballot(inb);
            if (lane == 0) { bmw[2 * ((k0 >> 6) + j)] = (unsigned)bg; bmw[2 * ((k0 >> 6) + j) + 1] = (unsigned)(bg >> 32); }
            if (inb) { const int c = ncand + mbcnt64(bi); cand[2 * c] = (unsigned)(k0 + 64 * j + lane); cand[2 * c + 1] = fkey(x_[j]); }
            ncand += __popcll(bi); }
        LDS_WAIT(); asm volatile("" ::: "memory"); }
#undef RS_LOAD4
    {
        const int c0 = lane, c1 = lane + 64;
        const unsigned k0_ = c0 < ncand ? cand[2 * c0 + 1] : 0u, k1_ = c1 < ncand ? cand[2 * c1 + 1] : 0u;
        const unsigned i0_ = c0 < ncand ? cand[2 * c0] : 0u, i1_ = c1 < ncand ? cand[2 * c1] : 0u;
        int r0 = 0, r1 = 0;
#ifdef SEL_DUP_RANK
        for (int rep3_ = 0; rep3_ < 2; ++rep3_) { r0 = 0; r1 = 0;
#endif
        for (int j = 0; j < ncand; ++j) { const unsigned kj = cand[2 * j + 1];
            r0 += (kj > k0_ || (kj == k0_ && j < c0)) ? 1 : 0; r1 += (kj > k1_ || (kj == k1_ && j < c1)) ? 1 : 0; }
#ifdef SEL_DUP_RANK
        asm volatile("" : "+v"(r0), "+v"(r1)); }
#endif
        if (c0 < ncand && r0 < kk) __hip_atomic_fetch_or(bmw + 2 * (i0_ >> 6) + ((i0_ >> 5) & 1u), 1u << (i0_ & 31u), __ATOMIC_RELAXED, __HIP_MEMORY_SCOPE_WORKGROUP);
        if (c1 < ncand && r1 < kk) __hip_atomic_fetch_or(bmw + 2 * (i1_ >> 6) + ((i1_ >> 5) & 1u), 1u << (i1_ & 31u), __ATOMIC_RELAXED, __HIP_MEMORY_SCOPE_WORKGROUP);
    }
    LDS_WAIT(); asm volatile("" ::: "memory");
    if (lane < ((n + 63) >> 6)) bmrow[lane] = (unsigned long long)bmw[2 * lane] | ((unsigned long long)bmw[2 * lane + 1] << 32);
    LDS_WAIT(); asm volatile("" ::: "memory");
}
__device__ __forceinline__ void split8(const f32x4 a, const f32x4 b, bf16x8& hi, bf16x8& lo) {
    v4u h, l;
    h.x = pg8::cvt_pk_bf16(a.x, a.y); h.y = pg8::cvt_pk_bf16(a.z, a.w); h.z = pg8::cvt_pk_bf16(b.x, b.y); h.w = pg8::cvt_pk_bf16(b.z, b.w);
    l.x = pg8::cvt_pk_bf16(a.x - __uint_as_float(h.x << 16), a.y - __uint_as_float(h.x & 0xffff0000u)); l.y = pg8::cvt_pk_bf16(a.z - __uint_as_float(h.y << 16), a.w - __uint_as_float(h.y & 0xffff0000u));
    l.z = pg8::cvt_pk_bf16(b.x - __uint_as_float(h.z << 16), b.y - __uint_as_float(h.z & 0xffff0000u)); l.w = pg8::cvt_pk_bf16(b.z - __uint_as_float(h.w << 16), b.w - __uint_as_float(h.w & 0xffff0000u));
    hi = __builtin_bit_cast(bf16x8, h); lo = __builtin_bit_cast(bf16x8, l);
}
__device__ __forceinline__ void dsa_select_phase(Frame& F) {
    const int tid = cur_tid(), wave = cur_wave(), lane = tid & 63, r = lane & 31, hh = lane >> 5;
    const bf16* IQ = (const bf16*)(F.ws + WS_IQ); const bf16* IK = (const bf16*)(F.ws + WS_IK); const float* GWp = (const float*)(F.ws + WS_GW);
    LAS float* sc = (LAS float*)(F.lds + RING_OFF);
    LAS unsigned* hist = (LAS unsigned*)(F.lds + XTRA_OFF + wave * XTRA_WAVE);
    bf16x8 araw[2][2]; f32x4 wraw[2][4];
    auto load_a = [&](int pass_, int u0_) {
        const int b_ = u0_ >> 8, w8_ = u0_ & 255, tb8_ = pass_ ? 511 - w8_ : w8_; const size_t rowb = (size_t)b_ * T + 8 * tb8_;
#pragma unroll
        for (int gq = 0; gq < 2; ++gq) {
            const bf16* qp = IQ + (rowb + 4 * gq + (r >> 3)) * 256 + (r & 7) * 32 + 8 * hh;
#pragma unroll
            for (int ks = 0; ks < 2; ++ks) araw[gq][ks] = *(const bf16x8*)(qp + 16 * ks);
#pragma unroll
            for (int tk = 0; tk < 4; ++tk) wraw[gq][tk] = *(const f32x4*)(GWp + (rowb + 4 * gq + tk) * 32 + 12 + 4 * hh);
        }
    };
    if ((int)blockIdx.x < 2048) load_a(0, (int)blockIdx.x);
    for (int pass = 0; pass < 2; ++pass) {
        for (int u0 = blockIdx.x; u0 < 2048; u0 += F.G) {
            const int b = u0 >> 8, w8 = u0 & 255, tb8 = pass ? 511 - w8 : w8, t0 = 8 * tb8, nmax = t0 + 8;
            const size_t base = (size_t)b * T;
            bf16x8 ahi[2][2]; float iw[2][4][4];
#pragma unroll
            for (int gq = 0; gq < 2; ++gq) {
#pragma unroll
                for (int ks = 0; ks < 2; ++ks) ahi[gq][ks] = araw[gq][ks];
#pragma unroll
                for (int tk = 0; tk < 4; ++tk) { const f32x4 w4 = wraw[gq][tk]; iw[gq][tk][0] = w4.x; iw[gq][tk][1] = w4.y; iw[gq][tk][2] = w4.z; iw[gq][tk][3] = w4.w; }
            }
            const int nkb = (nmax + 31) >> 5;
            bf16x8 nbA[2], nbB[2];
#define DS_LOADB(dst, kb_) do { const GAS bf16* kp_ = (const GAS bf16*)(IK + (base + 32 * (kb_) + r) * 32 + 8 * hh); dst[0] = *(const GAS bf16x8*)kp_; dst[1] = *(const GAS bf16x8*)(kp_ + 16); } while (0)
#ifdef DSA_DUP_SCORE
            for (int rep2_ = 0; rep2_ < 2; ++rep2_) {
#endif
            if (wave < nkb) DS_LOADB(nbA, wave);
            if (wave + 8 < nkb) DS_LOADB(nbB, wave + 8);
            for (int kb = wave; kb < nkb; kb += 16) {
                const bool hasB = kb + 8 < nkb;
                bf16x8 bhiA[2], bhiB[2];
                bhiA[0] = nbA[0]; bhiA[1] = nbA[1];
                if (hasB) { bhiB[0] = nbB[0]; bhiB[1] = nbB[1]; } else { bhiB[0] = bhiA[0]; bhiB[1] = bhiA[1]; }
                if (kb + 16 < nkb) DS_LOADB(nbA, kb + 16);
                if (kb + 24 < nkb) DS_LOADB(nbB, kb + 24);
                f32x16 cA0, cA1, cB0, cB1;
#pragma unroll
                for (int i = 0; i < 16; ++i) { cA0[i] = 0.f; cA1[i] = 0.f; cB0[i] = 0.f; cB1[i] = 0.f; }
#pragma unroll
                for (int ks = 0; ks < 2; ++ks) {
                    cA0 = __builtin_amdgcn_mfma_f32_32x32x16_bf16(ahi[0][ks], bhiA[ks], cA0, 0, 0, 0); cA1 = __builtin_amdgcn_mfma_f32_32x32x16_bf16(ahi[1][ks], bhiA[ks], cA1, 0, 0, 0);
                    cB0 = __builtin_amdgcn_mfma_f32_32x32x16_bf16(ahi[0][ks], bhiB[ks], cB0, 0, 0, 0); cB1 = __builtin_amdgcn_mfma_f32_32x32x16_bf16(ahi[1][ks], bhiB[ks], cB1, 0, 0, 0);
                }
#define DS_EPI(c, gq, kb_) do { float s4_[4]; _Pragma("unroll") for (int tk = 0; tk < 4; ++tk) { \
                        const float v_ = (iw[gq][tk][0] * fmaxf(c[4 * tk], 0.f) + iw[gq][tk][1] * fmaxf(c[4 * tk + 1], 0.f)) + (iw[gq][tk][2] * fmaxf(c[4 * tk + 2], 0.f) + iw[gq][tk][3] * fmaxf(c[4 * tk + 3], 0.f)); \
                        s4_[tk] = xhalf_sum(v_) * 0.0625f + 0.0f; } \
                    LAS float* dst_ = sc + (4 * (gq) + 2 * hh) * 4096 + 32 * (kb_) + r; dst_[0] = hh ? s4_[2] : s4_[0]; dst_[4096] = hh ? s4_[3] : s4_[1]; } while (0)
                DS_EPI(cA0, 0, kb); DS_EPI(cA1, 1, kb);
                if (hasB) { DS_EPI(cB0, 0, kb + 8); DS_EPI(cB1, 1, kb + 8); }
#undef DS_EPI
            }
#ifdef DSA_DUP_SCORE
            }
#endif
#undef DS_LOADB
            { int pn_ = pass, un_ = u0 + F.G; if (un_ >= 2048) { pn_ = pass + 1; un_ = blockIdx.x; } if (pn_ < 2 && un_ < 2048) load_a(pn_, un_); }
            __syncthreads();
#ifdef DSA_DUP_SEL
            for (int rep2_ = 0; rep2_ < 2; ++rep2_)
#endif
            radix_select_write(sc + wave * 4096, hist, (unsigned long long*)(F.ws + WS_DSAMASK) + (base + t0 + wave) * 64, t0 + wave, lane);
            __syncthreads();
        }
    }
}

constexpr int NS_K = 0, NS_KP = 144, NS_V = 256 * NS_KP, NS_VP = 520, NS_IMP = NS_V + 64 * NS_VP, NS_IP = 68, NS_END = NS_IMP + 64 * NS_IP * 4;
static_assert(NS_END <= RING_BYTES, "nsa select LDS map");
__device__ __forceinline__ void nsa_select_phase(Frame& F) {
    const int tid = cur_tid(), wave = cur_wave(), lane = tid & 63, r = lane & 31, hh = lane >> 5;
    LAS unsigned char* lds = F.lds;
    LAS float* imp = (LAS float*)(lds + NS_IMP);
    for (int pass = 0; pass < 2; ++pass) {
        for (int u0 = blockIdx.x; u0 < 256; u0 += F.G) {
            const int u = pass ? 511 - u0 : u0, tb = u >> 3, b = u & 7;
            __syncthreads();
            {
                const bf16* Kc = (const bf16*)(F.ws + WS_KCMPB) + (size_t)b * 256 * 64; const bf16* Vc = (const bf16*)(F.ws + WS_VCMPB) + (size_t)b * 256 * 64;
#pragma unroll
                for (int j = 0; j < 4; ++j) { const int ch = tid + 512 * j, row = ch >> 3, c8 = ch & 7;
                    *(LAS v4u*)(lds + NS_K + row * NS_KP + 16 * c8) = *(const v4u*)(Kc + row * 64 + 8 * c8);
                    const v4u vv = *(const v4u*)(Vc + row * 64 + 8 * c8);
                    LAS unsigned short* vt = (LAS unsigned short*)(lds + NS_V + (8 * c8) * NS_VP) + row;
                    vt[0 * (NS_VP / 2)] = (unsigned short)(vv.x & 0xffffu); vt[1 * (NS_VP / 2)] = (unsigned short)(vv.x >> 16); vt[2 * (NS_VP / 2)] = (unsigned short)(vv.y & 0xffffu); vt[3 * (NS_VP / 2)] = (unsigned short)(vv.y >> 16);
                    vt[4 * (NS_VP / 2)] = (unsigned short)(vv.z & 0xffffu); vt[5 * (NS_VP / 2)] = (unsigned short)(vv.z >> 16); vt[6 * (NS_VP / 2)] = (unsigned short)(vv.w & 0xffffu); vt[7 * (NS_VP / 2)] = (unsigned short)(vv.w >> 16); }
                for (int i = tid; i < 64 * NS_IP; i += 512) imp[i] = 0.f;
            }
            __syncthreads();
            const int tl_ = 8 * wave + (r >> 2), hd = r & 3, t = 64 * tb + tl_; const size_t row = (size_t)b * T + t;
            const bf16* qrow = (const bf16*)(F.ws + WS_QN) + row * 256 + hd * 64;
            bf16x8 qf[4];
#pragma unroll
            for (int ks = 0; ks < 4; ++ks) qf[ks] = *(const bf16x8*)(qrow + 16 * ks + 8 * hh);
            const int nmax = (t - 31) >> 4;
            const int ntile = ((4 * tb + 2) >> 6) + 1;
            const float sc2 = 0.125f * 1.4426950408889634f;
            auto scores = [&](int tile, f32x16& p0, f32x16& p1) {
#pragma unroll
                for (int i = 0; i < 16; ++i) { p0[i] = 0.f; p1[i] = 0.f; }
                const LAS unsigned char* Kb = lds + NS_K + (64 * tile) * NS_KP;
#pragma unroll
                for (int ks = 0; ks < 4; ++ks) {
                    const bf16x8 a0 = *(const LAS bf16x8*)(Kb + r * NS_KP + (16 * ks + 8 * hh) * 2), a1 = *(const LAS bf16x8*)(Kb + (32 + r) * NS_KP + (16 * ks + 8 * hh) * 2);
                    p0 = __builtin_amdgcn_mfma_f32_32x32x16_bf16(a0, qf[ks], p0, 0, 0, 0);
                    p1 = __builtin_amdgcn_mfma_f32_32x32x16_bf16(a1, qf[ks], p1, 0, 0, 0);
                }
            };
            float m = -1e30f, l = 0.f;
            for (int tile = 0; tile < ntile; ++tile) {
                const unsigned long long word = causal_word(nmax - 64 * tile);
                f32x16 p0, p1; scores(tile, p0, p1);
                const unsigned wlo = (unsigned)word >> (4 * hh), whi = (unsigned)(word >> 32) >> (4 * hh);
                float mx = -1e30f;
#pragma unroll
                for (int i = 0; i < 16; ++i) { const int bit = (i & 3) + 8 * (i >> 2);
                    p0[i] = ((wlo >> bit) & 1u) ? p0[i] * sc2 : -1e30f; p1[i] = ((whi >> bit) & 1u) ? p1[i] * sc2 : -1e30f; mx = fmaxf(mx, fmaxf(p0[i], p1[i])); }
                mx = xhalf_max(mx);
                const float mn = fmaxf(m, mx), alpha = __builtin_amdgcn_exp2f(m - mn); m = mn;
                float ps = 0.f;
#pragma unroll
                for (int i = 0; i < 16; ++i) { const int bit = (i & 3) + 8 * (i >> 2);
                    ps += (((wlo >> bit) & 1u) ? __builtin_amdgcn_exp2f(p0[i] - mn) : 0.f) + (((whi >> bit) & 1u) ? __builtin_amdgcn_exp2f(p1[i] - mn) : 0.f); }
                l = l * alpha + ps;
            }
            l = xhalf_sum(l);
            const float inv = l > 0.f ? 1.0f / l : 0.f;
            f32x16 o0, o1;
#pragma unroll
            for (int i = 0; i < 16; ++i) { o0[i] = 0.f; o1[i] = 0.f; }
            float carry = 0.f;
            for (int tile = 0; tile < ntile; ++tile) {
                const unsigned long long word = causal_word(nmax - 64 * tile);
                f32x16 p0, p1; scores(tile, p0, p1);
                const unsigned wlo = (unsigned)word >> (4 * hh), whi = (unsigned)(word >> 32) >> (4 * hh);
#pragma unroll
                for (int i = 0; i < 16; ++i) { const int bit = (i & 3) + 8 * (i >> 2);
                    p0[i] = ((wlo >> bit) & 1u) ? __builtin_amdgcn_exp2f(p0[i] * sc2 - m) * inv : 0.f; p1[i] = ((whi >> bit) & 1u) ? __builtin_amdgcn_exp2f(p1[i] * sc2 - m) * inv : 0.f; }
#pragma unroll
                for (int blk = 0; blk < 2; ++blk) {
                    float tot[4];
#pragma unroll
                    for (int g = 0; g < 4; ++g) {
                        const float a = blk ? p1[4 * g] : p0[4 * g], b1 = blk ? p1[4 * g + 1] : p0[4 * g + 1], c1 = blk ? p1[4 * g + 2] : p0[4 * g + 2], d1 = blk ? p1[4 * g + 3] : p0[4 * g + 3];
                        const float mainv = (a + b1) + (c1 + d1);
                        const float recv = xhalf_other(d1, hh);
                        const float below = hh ? recv : carry;
                        tot[g] = mainv + below;
                        carry = recv;
                    }
#pragma unroll
                    for (int g = 0; g < 4; ++g) { float v = tot[g]; v += dpp_f<0xB1>(v); v += dpp_f<0x4E>(v);
                        if (hd == 0) imp[tl_ * NS_IP + 16 * tile + 8 * blk + 2 * g + hh] = v; }
                }
                bf16x8 pf[4];
#pragma unroll
                for (int s = 0; s < 4; ++s) { v4u w;
                    if (s < 2) { w.x = pg8::cvt_pk_bf16(p0[8 * s], p0[8 * s + 1]); w.y = pg8::cvt_pk_bf16(p0[8 * s + 2], p0[8 * s + 3]); w.z = pg8::cvt_pk_bf16(p0[8 * s + 4], p0[8 * s + 5]); w.w = pg8::cvt_pk_bf16(p0[8 * s + 6], p0[8 * s + 7]); }
                    else { const int s2 = s - 2; w.x = pg8::cvt_pk_bf16(p1[8 * s2], p1[8 * s2 + 1]); w.y = pg8::cvt_pk_bf16(p1[8 * s2 + 2], p1[8 * s2 + 3]); w.z = pg8::cvt_pk_bf16(p1[8 * s2 + 4], p1[8 * s2 + 5]); w.w = pg8::cvt_pk_bf16(p1[8 * s2 + 6], p1[8 * s2 + 7]); }
                    pf[s] = __builtin_bit_cast(bf16x8, w); }
#pragma unroll
                for (int s = 0; s < 4; ++s) {
                    const int kb = 64 * tile + 32 * (s >> 1) + 16 * (s & 1) + 4 * hh;
#pragma unroll
                    for (int db = 0; db < 2; ++db) {
                        const LAS unsigned char* vp_ = lds + NS_V + (32 * db + r) * NS_VP + kb * 2;
                        typedef unsigned u32x2v __attribute__((ext_vector_type(2)));
                        const u32x2v lo = *(const LAS u32x2v*)vp_, hi = *(const LAS u32x2v*)(vp_ + 16);
                        v4u aw; aw.x = lo.x; aw.y = lo.y; aw.z = hi.x; aw.w = hi.y;
                        const bf16x8 a = __builtin_bit_cast(bf16x8, aw);
                        if (db == 0) o0 = __builtin_amdgcn_mfma_f32_32x32x16_bf16(a, pf[s], o0, 0, 0, 0);
                        else o1 = __builtin_amdgcn_mfma_f32_32x32x16_bf16(a, pf[s], o1, 0, 0, 0);
                    }
                }
            }
            flash_store((bf16*)(F.ws + WS_OC) + row * 256 + hd * 64, o0, o1, 1.0f, hh);
            LDS_WAIT(); asm volatile("" ::: "memory");
            for (int k = 0; k < 8; ++k) {
                const int tk = 64 * tb + 8 * wave + k, own = tk >> 6;
                const float iv = imp[(8 * wave + k) * NS_IP + lane];
                const bool causal = lane <= own, forced = causal && (lane == 0 || lane >= own - 1);
                const float val = forced ? 1e4f : (causal ? iv : -INFINITY);
                const unsigned kv_ = fkey(val); const unsigned klo = (kv_ << 6) | (unsigned)(63 - lane), khi = kv_ >> 26;
                int rank = 0;
#pragma unroll
                for (int j = 0; j < 64; ++j) { const unsigned jlo = (unsigned)__builtin_amdgcn_readlane((int)klo, j), jhi = (unsigned)__builtin_amdgcn_readlane((int)khi, j);
                    rank += (jhi > khi || (jhi == khi && jlo > klo)) ? 1 : 0; }
                const unsigned long long selm = __ballot(causal && rank < 16);
                if (lane == 0) ((unsigned long long*)(F.ws + WS_NSEL))[(size_t)b * T + tk] = selm;
            }
        }
    }
}
#ifndef PHMASK
#define PHMASK 0xFFFFFFFFu
#endif
#define EN(b) ((PHMASK >> (b)) & 1u)
#ifndef DUPMASK
#define DUPMASK 0u
#endif
#define REP(b) for (int rep_ = 0; rep_ < (((DUPMASK >> (b)) & 1u) ? 2 : 1); ++rep_)
__global__ void __launch_bounds__(NWAVES * 64, 2) fwd_kernel(Args args) {
    extern __shared__ __attribute__((aligned(16))) unsigned char lds[];
    Frame F;
    F.lds = (LAS unsigned char*)lds;
    F.MISC = (volatile LAS unsigned*)(F.lds + MISC_OFF);
    F.G = gridDim.x;
    F.ws = args.ws; F.ctl = (gu32*)(args.ws + WS_CTL); F.out = args.out;
    F.A = &args;
    for (int u = threadIdx.x; u < (XTRA_OFF - LDSCTL_OFF) / 4; u += NWAVES * 64) ((LAS unsigned*)(F.lds + LDSCTL_OFF))[u] = 0u;
    __syncthreads();
    XcdBarrier bar = xcd_barrier_post((unsigned*)(F.ctl + CW_BAR), F.MISC + 8);
#ifdef PHASE_RANGES
    const int lo = args.ph_lo, hi = args.ph_hi;
#endif
#ifdef PHASE_RANGES
#define IN(k) (lo <= (k) && (k) < hi)
#else
#define IN(k) true
#endif
#ifdef DUP_BAR
#define SEAM(k) do { if (IN(k) && IN((k) + 1)) { xcd_barrier(bar); xcd_barrier(bar); } } while (0)
#else
#define SEAM(k) do { if (IN(k) && IN((k) + 1)) xcd_barrier(bar); } while (0)
#endif
    unsigned char* ws = F.ws;
    bf16 *H; signed char* HID; const float *cs64, *cs32, *ada;

    if (EN(0) && IN(0)) REP(0) p0_prologue(F);
    SEAM(0);
    int ph = 1;
    auto half_layer = [&](const int s) __attribute__((always_inline)) {
        const int l = s >> 1, second = s & 1;
        { unsigned char* w_ = args.ws; asm volatile("" : "+s"(w_)); ws = w_; F.ws = w_; }
        H = (bf16*)F.out + (size_t)M * D; HID = (signed char*)(ws + WS_HID); cs64 = (const float*)(ws + WS_CS64); cs32 = (const float*)(ws + WS_CS32); ada = (const float*)(ws + WS_ADA);
        const unsigned char* wl = ws + WS_WTS + (size_t)l * WTS_LAYER;
        const float* adal = ada + (size_t)l * 8 * 9216;
        bf16* XB = (bf16*)(ws + WS_XB);
        if (EN(1) && IN(ph)) {
            if (s == 0) { wgu8_convert(F); norm_mod_phase<false, true>(F, args.in[I_X], args.in[I_F1N] + l * D, adal + 0 * 1024, adal + 1 * 1024, H); }
            else norm_mod_phase<true, true>(F, XB, args.in[second ? I_F2N : I_F1N] + l * D, adal + (second ? 6 : 0) * 1024, adal + (second ? 7 : 1) * 1024, H);
        }
        SEAM(ph); ++ph;
        if (EN(2) && IN(ph)) REP(2) {
            pg8::Gemm g{H, (const bf16*)(wl + (second ? WO_GU2 : WO_GU1)), M, NGU, D / 2}; pg8::StaticOrder S; S.init(M, NGU, F.G, (int)blockIdx.x);
            const float wmax = __uint_as_float(__hip_atomic_load((unsigned*)(F.ctl + CW_WMAX) + 2 * l + second, __ATOMIC_RELAXED, __HIP_MEMORY_SCOPE_AGENT));
            pg8::EpiSwiGLU8 E{HID, FF, (ACT_CLIP / 127.0f) * (wmax / 127.0f)};
            pg8::gemm_phase<pg8::EpiSwiGLU8, pg8::StaticOrder, true, true, true>(F.lds + RING_OFF, g, S, E);
        }
        SEAM(ph); ++ph;
        if (EN(3) && IN(ph)) {
            pg8::Gemm g{(const bf16*)HID, (const bf16*)(wl + (second ? WO_D2 : WO_D1)), M, D, FF / 2}; pg8::StaticOrder S; S.init(M, D, F.G, (int)blockIdx.x);
            const float wmaxd = __uint_as_float(__hip_atomic_load((unsigned*)(F.ctl + CW_WMAX) + 4 + 2 * l + second, __ATOMIC_RELAXED, __HIP_MEMORY_SCOPE_AGENT));
            const float cf = 0.5f * (pg8::HID_CLIP / 127.0f) * (wmaxd / 127.0f);
            if (s == 0) { pg8::EpiResid<false, true> E{args.in[I_X], XB, adal + 2 * 1024, cf};
                pg8::gemm_phase<pg8::EpiResid<false, true>, pg8::StaticOrder, true, true, true>(F.lds + RING_OFF, g, S, E); }
            else { pg8::EpiResid<true, true> E{XB, XB, adal + (second ? 8 : 2) * 1024, cf};
                pg8::gemm_phase<pg8::EpiResid<true, true>, pg8::StaticOrder, true, true, true>(F.lds + RING_OFF, g, S, E); }
        }
        SEAM(ph); ++ph;
        if (second) return;
        if (EN(4) && IN(ph)) norm_mod_phase<true, false>(F, XB, args.in[I_MIXN] + l * D, adal + 3 * 1024, adal + 4 * 1024, H);
        SEAM(ph); ++ph;
        if (EN(5) && IN(ph)) REP(5) {
            pg8::Gemm g{H, (const bf16*)(wl + WO_IN), M, NINP, D}; pg8::StaticOrder S; S.init(M, NINP, F.G, (int)blockIdx.x);
            pg8::EpiProj<WinDesc> E{WinDesc{ws}, cs64, cs32, nullptr};
            pg8::gemm_phase<pg8::EpiProj<WinDesc>, pg8::StaticOrder, true, true>(F.lds + RING_OFF, g, S, E);
        }
        SEAM(ph); ++ph;
        if (EN(6) && IN(ph)) REP(6) {
            m1_phase(F, l);
            { int kq = 2048; asm volatile("" : "+s"(kq)); pg8::Gemm g{(const bf16*)(ws + WS_KC), (const bf16*)(wl + WO_C1K), 2048, 256, kq, 1024}; pg8::RangeOrder S{8, 0};
              pg8::EpiCmpH E{(float*)(ws + WS_CMPH), (const float*)(ws + WS_CMPB) + (l * 2 + 0) * 256};
              pg8::gemm_phase<pg8::EpiCmpH, pg8::RangeOrder, false, true>(F.lds + RING_OFF, g, S, E); }
            { int kq = 2048; asm volatile("" : "+s"(kq)); pg8::Gemm g{(const bf16*)(ws + WS_VC), (const bf16*)(wl + WO_C1V), 2048, 256, kq, 1024}; pg8::RangeOrder S{8, 8};
              pg8::EpiCmpH E{(float*)(ws + WS_CMPH) + (size_t)8 * 256 * 256, (const float*)(ws + WS_CMPB) + (l * 2 + 1) * 256};
              pg8::gemm_phase<pg8::EpiCmpH, pg8::RangeOrder, false, true>(F.lds + RING_OFF, g, S, E); }
        }
        SEAM(ph); ++ph;
        if (IN(ph)) {
            if (EN(7)) REP(7) { int kq = 256; asm volatile("" : "+s"(kq)); pg8::Gemm g{(const bf16*)(ws + WS_CQ), (const bf16*)(wl + WO_UQ), M, 512, kq}; pg8::StaticOrder S; S.init(M, 512, F.G, (int)blockIdx.x);
              pg8::EpiProj<MlaQDesc> E{MlaQDesc{ws}, cs64, cs32, (const float*)(ws + WS_RSTDQ)};
              pg8::gemm_phase<pg8::EpiProj<MlaQDesc>, pg8::StaticOrder, true, true>(F.lds + RING_OFF, g, S, E); }
            if (EN(8)) REP(7) { int kq = 128; asm volatile("" : "+s"(kq)); pg8::Gemm g{(const bf16*)(ws + WS_CKV), (const bf16*)(wl + WO_UKV), M, 512, kq}; pg8::StaticOrder S; S.init(M, 512, F.G, (int)blockIdx.x);
              pg8::EpiProj<MlaKvDesc> E{MlaKvDesc{ws}, cs64, cs32, (const float*)(ws + WS_RSTDKV)};
              pg8::gemm_phase<pg8::EpiProj<MlaKvDesc>, pg8::StaticOrder, true, true>(F.lds + RING_OFF, g, S, E); }
            if (EN(9)) REP(9) cmp2_phase(F, l);
#ifdef FLASH_DSA
            if (EN(10)) REP(10) dsa_select_phase(F);
#else
            if (EN(10)) REP(10) dsa_tokens_phase(F);
#endif
        }
        SEAM(ph); ++ph;
#ifdef FLASH_NSA
        if (IN(ph)) { if (EN(13)) REP(13) nsa_select_phase(F); }
        SEAM(ph); ++ph;
#endif
        if (IN(ph)) {
#ifdef FLASH_MOBA
            if (EN(11)) REP(11) moba_flash_phase(F);
#else
            if (EN(11)) moba_rows_phase(F);
#endif
#ifdef FLASH_MLA
            if (EN(12)) REP(12) mla_flash_phase(F);
#else
            if (EN(12)) mla_rows_phase(F);
#endif
#ifdef FLASH_NSA
            if (EN(13)) REP(14) nsa_flash_phase(F);
#else
            if (EN(13)) nsa_tokens_phase(F);
#endif
#ifdef FLASH_DSA
            if (EN(10)) REP(15) dsa_flash_phase(F);
#endif
        }
        SEAM(ph); ++ph;
        if (EN(14) && IN(ph)) group_norm_phase(F, H, args.in[I_GN] + l * 1024);
        SEAM(ph); ++ph;
        if (EN(15) && IN(ph)) {
            pg8::Gemm g{H, (const bf16*)(wl + WO_OUT), M, D, D}; pg8::StaticOrder S; S.init(M, D, F.G, (int)blockIdx.x);
            pg8::EpiResid<true> E{XB, XB, adal + 5 * 1024, 1.0f};
            pg8::gemm_phase<pg8::EpiResid<true>, pg8::StaticOrder, true, true>(F.lds + RING_OFF, g, S, E);
        }
        SEAM(ph); ++ph;
    };
    half_layer(0); half_layer(1);
#ifdef DUP_LAYER0
    half_layer(0); half_layer(1);
#endif
    half_layer(2); half_layer(3);
    if (EN(16) && IN(ph)) final_norm_phase(F, (const bf16*)(args.ws + WS_XB), F.out, args.in[I_FINN]);
#undef IN
#undef SEAM
}
#ifdef FLASH_NSA
constexpr int N_PHASES = 1 + 4 * 3 + 2 * 8 + 1;
#else
constexpr int N_PHASES = 1 + 4 * 3 + 2 * 7 + 1;
#endif

extern "C" void kernel_launch(void* const* d_in, const int* in_sizes, int n_in, void* d_out, int out_size, void* d_ws, size_t ws_size, hipStream_t stream) {
    static int grid = 0;
    if (grid == 0) {
        if (n_in != 28 || in_sizes[0] != M * D || out_size != M * D || ws_size < WS_END) { fprintf(stderr, "kernel_launch: unexpected problem shape (n_in %d, in0 %d, out %d, ws %zu); nothing launched\n", n_in, n_in > 0 ? in_sizes[0] : -1, out_size, ws_size); grid = -1; return; }
        int dev = 0, cus = 0, per_cu = 0;
        if (hipGetDevice(&dev) != hipSuccess || hipDeviceGetAttribute(&cus, hipDeviceAttributeMultiprocessorCount, dev) != hipSuccess) { grid = -1; return; }
        if (hipFuncSetAttribute((const void*)fwd_kernel, hipFuncAttributeMaxDynamicSharedMemorySize, LDS_BYTES) != hipSuccess) { fprintf(stderr, "kernel_launch: hipFuncSetAttribute failed\n"); grid = -1; return; }
        if (hipOccupancyMaxActiveBlocksPerMultiprocessor(&per_cu, (const void*)fwd_kernel, NWAVES * 64, LDS_BYTES) != hipSuccess || per_cu < 1) { fprintf(stderr, "kernel_launch: occupancy query says %d\n", per_cu); }
        (void)hipGetLastError();
        grid = cus;
    }
    if (grid < 0) return;
    if (hipMemsetAsync((char*)d_ws + WS_CTL, 0, CTL_ZERO_BYTES, stream) != hipSuccess) return;
    Args a{};
    for (int i = 0; i < 28; ++i) a.in[i] = (const float*)d_in[i];
    a.out = (float*)d_out; a.ws = (unsigned char*)d_ws; a.ph_lo = 0; a.ph_hi = N_PHASES + 64;
    hipLaunchKernelGGL(fwd_kernel, dim3(grid), dim3(NWAVES * 64), LDS_BYTES, stream, a);
}
```

```cpp
#include <hip/hip_runtime.h>
#include <cstdio>
#include <cstdint>
#include <cmath>
#ifndef NO_FLASH
#define FLASH_MLA 1
#define FLASH_MOBA 1
#define FLASH_NSA 1
#define FLASH_DSA 1
#endif
namespace pg8 {
#define PG8_LAS __attribute__((address_space(3)))
typedef unsigned short bf16_t;
typedef short bf16x8 __attribute__((ext_vector_type(8)));
typedef float f32x4 __attribute__((ext_vector_type(4)));
typedef unsigned u32x4 __attribute__((ext_vector_type(4)));
constexpr int BM = 256, BK = 64, HALF = 128, HTB = HALF * BK * 2  , STAGE_BYTES = 8 * HTB, NXCD = 8, WGM = 8;

__host__ __device__ __forceinline__ int lds_byte(int r, int c) { const int st = (r >> 4) * 2 + (c >> 5), rr = r & 15, cc = c & 31, ob = rr * 64 + cc * 2; return st * 1024 + (ob ^ (((ob >> 9) & 1) << 5)); }
__host__ __device__ __forceinline__ void stage_rc(int b, int& R, int& C) { const int st = b / 1024, sb = b % 1024, swz = sb ^ (((sb >> 9) & 1) << 5); R = (st >> 1) * 16 + swz / 64; C = (st & 1) * 32 + (swz % 64) / 2; }
__host__ __device__ __forceinline__ int perm32(int rho) { const int n = rho >> 4, i = rho & 15; return 8 * (i >> 2) + 4 * n + (i & 3); }

struct Unit { int pm, pn; };
struct Gemm { const bf16_t* A; const bf16_t* Bt; int M, N, K; int lda = 0; };

struct StaticOrder {
    int nM, nN, nwg, G, c;
    __host__ __device__ void init(int M, int N, int G_, int c_) { nM = M / BM; nN = N / BM; nwg = nM * nN; G = G_; c = c_; }
    __host__ __device__ bool next(int i, Unit& u) const {
        const long L = (long)i * G + c; if (L >= nwg) return false;
        int wgid = (int)L; { const int q = nwg / NXCD, r = nwg % NXCD, xcd = wgid % NXCD, off = wgid / NXCD; wgid = (xcd < r ? xcd * (q + 1) : r * (q + 1) + (xcd - r) * q) + off; }
        const int nig = WGM * nN, gid = wgid / nig, fm = gid * WGM, gsz = (nM - fm) < WGM ? (nM - fm) : WGM;
        u.pm = fm + ((wgid % nig) % gsz); u.pn = (wgid % nig) / gsz; return true;
    }
    __device__ __forceinline__ void a_ready(const Unit&) const {}
    __device__ __forceinline__ void done(const Unit&) const {}
};

__device__ __forceinline__ unsigned cvt_pk_bf16(float lo, float hi) { unsigned r; asm volatile("v_cvt_pk_bf16_f32 %0, %1, %2" : "=v"(r) : "v"(lo), "v"(hi)); return r; }
typedef float f32x2 __attribute__((ext_vector_type(2)));
typedef unsigned u32x2 __attribute__((ext_vector_type(2)));
__device__ __forceinline__ float silu_f(float x) { return x * __builtin_amdgcn_rcpf(1.0f + __builtin_amdgcn_exp2f(-1.4426950408889634f * x)); }

struct EpiSwiGLU {
    static constexpr bool PERM = false, AFTER_DRAIN = false;
    bf16_t* H; int ldh;
    __device__ __forceinline__ void operator()(const f32x4 (&acc)[2][2][4][2], const Unit& u, int wr, int wc, int fr, int fq) const {
        const int row0 = u.pm * BM + wr * 64 + fr;
        const int hc0 = u.pn * 128 + wc * 16 + 4 * fq;
#pragma unroll
        for (int ai = 0; ai < 2; ++ai)
#pragma unroll
            for (int m = 0; m < 4; ++m) {
                bf16_t* rowp = H + (size_t)(row0 + ai * HALF + m * 16) * ldh + hc0;
#pragma unroll
                for (int bj = 0; bj < 2; ++bj) {
                    const f32x4 g = acc[ai][bj][m][0], uu = acc[ai][bj][m][1];
                    u32x2 w; w.x = cvt_pk_bf16(silu_f(g[0]) * uu[0], silu_f(g[1]) * uu[1]); w.y = cvt_pk_bf16(silu_f(g[2]) * uu[2], silu_f(g[3]) * uu[3]);
                    *(u32x2*)(rowp + bj * 64) = w;
                }
            }
    }
};

__device__ __forceinline__ unsigned q8pack4(float a, float b, float c, float d, float qs) {
    const float MG = 12582912.0f; const int MB = 0x4B400000;
    int ia = __float_as_int(__builtin_fmaf(a, qs, MG)), ib = __float_as_int(__builtin_fmaf(b, qs, MG)), ic = __float_as_int(__builtin_fmaf(c, qs, MG)), id = __float_as_int(__builtin_fmaf(d, qs, MG));
    ia = min(max(ia, MB - 127), MB + 127); ib = min(max(ib, MB - 127), MB + 127); ic = min(max(ic, MB - 127), MB + 127); id = min(max(id, MB - 127), MB + 127);
    return __builtin_amdgcn_perm((unsigned)ib, (unsigned)ia, 0x0c0c0400u) | __builtin_amdgcn_perm((unsigned)id, (unsigned)ic, 0x04000c0cu);
}
constexpr float HID_CLIP = 9.0f;
struct EpiSwiGLU8 {
    static constexpr bool PERM = false, AFTER_DRAIN = false;
    signed char* H; int ldh; float deq;
    __device__ __forceinline__ void operator()(const f32x4 (&acc)[2][2][4][2], const Unit& u, int wr, int wc, int fr, int fq) const {
        typedef int i32x4_ __attribute__((ext_vector_type(4)));
        const int row0 = u.pm * BM + wr * 64 + fr;
        const int hc0 = u.pn * 128 + wc * 16 + 4 * fq;
#pragma unroll
        for (int ai = 0; ai < 2; ++ai)
#pragma unroll
            for (int m = 0; m < 4; ++m) {
                signed char* rowp = H + (size_t)(row0 + ai * HALF + m * 16) * ldh + hc0;
#pragma unroll
                for (int bj = 0; bj < 2; ++bj) {
                    const i32x4_ gi = __builtin_bit_cast(i32x4_, acc[ai][bj][m][0]), ui = __builtin_bit_cast(i32x4_, acc[ai][bj][m][1]);
                    float g[4], uu[4];
#pragma unroll
                    for (int i = 0; i < 4; ++i) { g[i] = (float)gi[i] * deq; uu[i] = (float)ui[i] * deq; }
                    *(unsigned*)(rowp + bj * 64) = q8pack4(silu_f(g[0]) * uu[0], silu_f(g[1]) * uu[1], silu_f(g[2]) * uu[2], silu_f(g[3]) * uu[3], 127.0f / HID_CLIP);
                }
            }
    }
};

template <bool XIN_BF16, bool I8 = false> struct EpiResid {
    static constexpr bool PERM = false, AFTER_DRAIN = false;
    const void* xin; bf16_t* xout; const float* gate; float coef;
    __device__ __forceinline__ void operator()(const f32x4 (&acc)[2][2][4][2], const Unit& u, int wr, int wc, int fr, int fq) const {
        const int b = (u.pm * BM) >> 12;
        const float* gv = gate + (size_t)b * 9216;
        const int row0 = u.pm * BM + wr * 64 + fr, col0 = u.pn * BM + wc * 32 + 4 * fq;
        f32x4 g[2][2];
#pragma unroll
        for (int bj = 0; bj < 2; ++bj)
#pragma unroll
            for (int n = 0; n < 2; ++n) g[bj][n] = *(const f32x4*)(gv + col0 + bj * HALF + n * 16) * coef;
#pragma unroll
        for (int ai = 0; ai < 2; ++ai)
#pragma unroll
            for (int m = 0; m < 4; ++m) {
                const size_t off = (size_t)(row0 + ai * HALF + m * 16) * 1024 + col0;
#pragma unroll
                for (int bj = 0; bj < 2; ++bj)
#pragma unroll
                    for (int n = 0; n < 2; ++n) {
                        f32x4 xi;
                        if (XIN_BF16) { const u32x2 w = *(const u32x2*)((const bf16_t*)xin + off + bj * HALF + n * 16);
                            xi[0] = __uint_as_float(w.x << 16); xi[1] = __uint_as_float(w.x & 0xffff0000u); xi[2] = __uint_as_float(w.y << 16); xi[3] = __uint_as_float(w.y & 0xffff0000u); }
                        else xi = *(const f32x4*)((const float*)xin + off + bj * HALF + n * 16);
                        f32x4 av = acc[ai][bj][m][n];
                        if (I8) { typedef int i32x4_ __attribute__((ext_vector_type(4))); const i32x4_ q = __builtin_bit_cast(i32x4_, av); av = (f32x4){(float)q[0], (float)q[1], (float)q[2], (float)q[3]}; }
                        const f32x4 xo = xi + g[bj][n] * av;
                        u32x2 wo; wo.x = cvt_pk_bf16(xo[0], xo[1]); wo.y = cvt_pk_bf16(xo[2], xo[3]);
                        *(u32x2*)(xout + off + bj * HALF + n * 16) = wo; }
                if (m & 1) asm volatile("" ::: "memory");
            }
    }
};

struct ProjDesc { int kind, dfreq0, nstride, rep, repstride, bpitch, fpitch, pad; bf16_t* bp; float* fp; };
template <class DescFn> struct EpiProj {
    static constexpr bool PERM = false, AFTER_DRAIN = false;
    DescFn df; const float* cs64; const float* cs32; const float* rowscale;
    __device__ __forceinline__ void operator()(const f32x4 (&acc)[2][2][4][2], const Unit& u, int wr, int wc, int fr, int fq) const {
        const int row0 = u.pm * BM + wr * 64 + fr;
#pragma unroll
        for (int bj = 0; bj < 2; ++bj) {
            const int G = u.pn * 8 + bj * 4 + wc;
            const ProjDesc d = df(G);
            if (d.kind != 0) {
#pragma unroll
                for (int ai = 0; ai < 2; ++ai)
#pragma unroll
                    for (int m = 0; m < 4; ++m) {
                        const int row = row0 + ai * HALF + m * 16;
                        f32x4 v0 = acc[ai][bj][m][0], v1 = acc[ai][bj][m][1];
                        if (rowscale) { const float rs = rowscale[row]; v0 = v0 * rs; v1 = v1 * rs; }
                        if (d.kind >= 2) {
                            const int pos = row & 4095;
                            const float* cs = (d.kind == 2) ? cs64 + ((size_t)pos * 32 + d.dfreq0 + 4 * fq) * 2 : cs32 + ((size_t)pos * 16 + 4 * fq) * 2;
                            const f32x4 a = *(const f32x4*)cs, b2 = *(const f32x4*)(cs + 4);
                            const f32x4 c = {a[0], a[2], b2[0], b2[2]}, s = {a[1], a[3], b2[1], b2[3]};
                            const f32x4 o0 = v0 * c - v1 * s, o1 = v1 * c + v0 * s; v0 = o0; v1 = o1;
                        }
                        if (d.bp) {
                            u32x2 w0, w1; w0.x = cvt_pk_bf16(v0[0], v0[1]); w0.y = cvt_pk_bf16(v0[2], v0[3]); w1.x = cvt_pk_bf16(v1[0], v1[1]); w1.y = cvt_pk_bf16(v1[2], v1[3]);
                            bf16_t* p = d.bp + (size_t)row * d.bpitch + 4 * fq;
                            for (int rp = 0; rp < d.rep; ++rp) { *(u32x2*)(p + rp * d.repstride) = w0; *(u32x2*)(p + rp * d.repstride + d.nstride) = w1; }
                        }
                        if (d.fp) { float* p = d.fp + (size_t)row * d.fpitch + 4 * fq;
                            if (d.pad) {
                                typedef unsigned u32x4v __attribute__((ext_vector_type(4)));
                                u32x4v w0, w1;
#pragma unroll
                                for (int q = 0; q < 2; ++q) { const f32x4 v = q ? v1 : v0;
                                    const unsigned h01 = cvt_pk_bf16(v[0], v[1]), h23 = cvt_pk_bf16(v[2], v[3]);
                                    const unsigned l01 = cvt_pk_bf16(v[0] - __uint_as_float(h01 << 16), v[1] - __uint_as_float(h01 & 0xffff0000u)), l23 = cvt_pk_bf16(v[2] - __uint_as_float(h23 << 16), v[3] - __uint_as_float(h23 & 0xffff0000u));
                                    u32x4v w; w.x = (h01 & 0xffffu) | (l01 << 16); w.y = (h01 >> 16) | (l01 & 0xffff0000u); w.z = (h23 & 0xffffu) | (l23 << 16); w.w = (h23 >> 16) | (l23 & 0xffff0000u);
                                    if (q) w1 = w; else w0 = w; }
                                *(u32x4v*)p = w0; *(u32x4v*)(p + d.nstride) = w1;
                            } else { *(f32x4*)p = v0; *(f32x4*)(p + d.nstride) = v1; } }
                        asm volatile("" ::: "memory");
                    }
            }
        }
    }
};


struct EpiCmpH {
    static constexpr bool PERM = false, AFTER_DRAIN = false;
    float* out; const float* bias;
    __device__ __forceinline__ void operator()(const f32x4 (&acc)[2][2][4][2], const Unit& u, int wr, int wc, int fr, int fq) const {
        const int row0 = u.pm * BM + wr * 64 + fr, col0 = wc * 32 + 4 * fq;
        f32x4 bv[2][2];
#pragma unroll
        for (int bj = 0; bj < 2; ++bj)
#pragma unroll
            for (int n = 0; n < 2; ++n) bv[bj][n] = *(const f32x4*)(bias + col0 + bj * HALF + n * 16);
#pragma unroll
        for (int ai = 0; ai < 2; ++ai)
#pragma unroll
            for (int m = 0; m < 4; ++m) {
                float* rowp = out + (size_t)(row0 + ai * HALF + m * 16) * 256 + col0;
#pragma unroll
                for (int bj = 0; bj < 2; ++bj)
#pragma unroll
                    for (int n = 0; n < 2; ++n) { const f32x4 v = acc[ai][bj][m][n] + bv[bj][n];
                        f32x4 o; o[0] = silu_f(v[0]); o[1] = silu_f(v[1]); o[2] = silu_f(v[2]); o[3] = silu_f(v[3]); *(f32x4*)(rowp + bj * HALF + n * 16) = o; }
            }
    }
};
struct RangeOrder {
    int nM, c0;
    __device__ __forceinline__ bool next(int i, Unit& u) const { const int idx = (int)blockIdx.x - c0; if (i > 0 || idx < 0 || idx >= nM) return false; u.pm = idx; u.pn = 0; return true; }
    __device__ __forceinline__ void a_ready(const Unit&) const {}
    __device__ __forceinline__ void done(const Unit&) const {}
};
template <class Epi, class Sched, bool ALIGN_EPI = false, bool SP2 = false, bool I8 = false>
__device__ __forceinline__ void gemm_phase(PG8_LAS unsigned char* lds, const Gemm g, const Sched& S, const Epi& E) {
    int tid_ = threadIdx.x; asm volatile("" : "+v"(tid_));
    const int tid = tid_, wid = __builtin_amdgcn_readfirstlane(tid >> 6), lane = tid & 63, wr = wid >> 2, wc = wid & 3, fr = lane & 15, fq = lane >> 4;
    const int K = g.K, nt = K / BK, lda = g.lda ? g.lda : g.K;
    unsigned voffA[2], voffB[2];
#pragma unroll
    for (int i = 0; i < 2; ++i) { int R, C; stage_rc(tid * 16 + i * 8192, R, C); const int Rb = Epi::PERM ? ((R & ~31) + perm32(R & 31)) : R;
        voffA[i] = (unsigned)(R * lda + C) * 2u; voffB[i] = (unsigned)(Rb * K + C) * 2u; }
    const size_t kstep = (size_t)(BK * 2);
    const size_t hstepB = (size_t)HALF * K * 2, hstepA = (size_t)HALF * lda * 2;
    const size_t tstepB = 2 * hstepB, tstepA = 2 * hstepA;
    const unsigned ldsw = (unsigned)wid * 1024u;
    const int aoff = lds_byte(wr * 64 + fr, fq * 8), boff = lds_byte(wc * 32 + fr, fq * 8);
#define PG8_SA(b, h) (((b) * 2 + (h)) * HTB)
#define PG8_SB(b, h) ((4 + (b) * 2 + (h)) * HTB)
#define PG8_STAGE(bufoff, gbase, voff) do { _Pragma("unroll") for (int _i = 0; _i < 2; ++_i) \
        __builtin_amdgcn_global_load_lds((const unsigned*)((const char*)(gbase) + (voff)[_i]), (PG8_LAS unsigned*)(lds + (bufoff) + ldsw + _i * 8192), 16, 0, 0); } while (0)
#define PG8_LDA(dst, b, h) do { _Pragma("unroll") for (int m = 0; m < 4; ++m) _Pragma("unroll") for (int k = 0; k < 2; ++k) dst[m][k] = *(const PG8_LAS bf16x8*)(lds + PG8_SA(b, h) + aoff + m * 2048 + k * 1024); } while (0)
#define PG8_LDB(dst, b, h) do { _Pragma("unroll") for (int n = 0; n < 2; ++n) _Pragma("unroll") for (int k = 0; k < 2; ++k) dst[n][k] = *(const PG8_LAS bf16x8*)(lds + PG8_SB(b, h) + boff + n * 2048 + k * 1024); } while (0)
#define PG8_MMA(ai, bj, At, Bt) do { __builtin_amdgcn_s_setprio(1); _Pragma("unroll") for (int m = 0; m < 4; ++m) _Pragma("unroll") for (int n = 0; n < 2; ++n) _Pragma("unroll") for (int k = 0; k < 2; ++k) \
        { if constexpr (I8) { typedef int i32x4_ __attribute__((ext_vector_type(4))); acc[ai][bj][m][n] = __builtin_bit_cast(f32x4, __builtin_amdgcn_mfma_i32_16x16x64_i8(__builtin_bit_cast(i32x4_, Bt[n][k]), __builtin_bit_cast(i32x4_, At[m][k]), __builtin_bit_cast(i32x4_, acc[ai][bj][m][n]), 0, 0, 0)); } \
          else acc[ai][bj][m][n] = __builtin_amdgcn_mfma_f32_16x16x32_bf16(Bt[n][k], At[m][k], acc[ai][bj][m][n], 0, 0, 0); } __builtin_amdgcn_s_setprio(0); } while (0)
#define PG8_WAIT_V(n) asm volatile("s_waitcnt vmcnt(" #n ")" ::: "memory")
#define PG8_WAIT_L(n) asm volatile("s_waitcnt lgkmcnt(" #n ")" ::: "memory")
#define PG8_BAR __builtin_amdgcn_s_barrier()
#define PG8_SCHED __builtin_amdgcn_sched_barrier(0)
    Unit cur, nxt; int ui = 0;
    if (!S.next(0, cur)) return;
    f32x4 acc[2][2][4][2];
#pragma unroll
    for (int a = 0; a < 2; ++a)
#pragma unroll
        for (int b = 0; b < 2; ++b)
#pragma unroll
            for (int m = 0; m < 4; ++m)
#pragma unroll
                for (int n = 0; n < 2; ++n) acc[a][b][m][n] = (f32x4){0.f, 0.f, 0.f, 0.f};
    bf16x8 At[4][2], B0[2][2], B1[2][2];
    const char* cA = (const char*)g.A + (size_t)cur.pm * tstepA; const char* cB = (const char*)g.Bt + (size_t)cur.pn * tstepB;
    S.a_ready(cur);
    if constexpr (SP2) {
        PG8_STAGE(PG8_SB(0, 0), cB, voffB); PG8_STAGE(PG8_SB(0, 1), cB + hstepB, voffB); PG8_STAGE(PG8_SA(0, 0), cA, voffA); PG8_STAGE(PG8_SA(0, 1), cA + hstepA, voffA);
        if (wr == 1) PG8_BAR;
        PG8_WAIT_V(2); PG8_BAR;
        PG8_STAGE(PG8_SB(1, 0), cB + kstep, voffB); PG8_STAGE(PG8_SA(1, 0), cA + kstep, voffA); PG8_STAGE(PG8_SB(1, 1), cB + hstepB + kstep, voffB);
        PG8_WAIT_V(6); PG8_BAR;
    } else {
        PG8_STAGE(PG8_SB(0, 0), cB, voffB); PG8_STAGE(PG8_SA(0, 0), cA, voffA); PG8_STAGE(PG8_SB(0, 1), cB + hstepB, voffB); PG8_STAGE(PG8_SA(0, 1), cA + hstepA, voffA);
        if (wr == 1) PG8_BAR;
        PG8_WAIT_V(4); PG8_BAR;
        PG8_STAGE(PG8_SB(1, 0), cB + kstep, voffB); PG8_STAGE(PG8_SA(1, 0), cA + kstep, voffA); PG8_STAGE(PG8_SB(1, 1), cB + hstepB + kstep, voffB);
        PG8_WAIT_V(6); PG8_BAR;
    }
    for (;;) {
        const bool has_next = S.next(ui + 1, nxt);
        const char* nA = has_next ? (const char*)g.A + (size_t)nxt.pm * tstepA : cA; const char* nB = has_next ? (const char*)g.Bt + (size_t)nxt.pn * tstepB : cB;
        for (int t = 0; t < nt; t += 2) {
            const bool last = (t == nt - 2);
            const char* a1 = cA + (size_t)(t + 1) * kstep;
            const char* a2 = last ? nA : cA + (size_t)(t + 2) * kstep; const char* b2 = last ? nB : cB + (size_t)(t + 2) * kstep;
            const char* a3 = a2 + kstep; const char* b3 = b2 + kstep;
            if (last && has_next) S.a_ready(nxt);
            if constexpr (SP2) {
            PG8_LDB(B0, 0, 0); PG8_LDB(B1, 0, 1); PG8_SCHED; PG8_LDA(At, 0, 0); PG8_STAGE(PG8_SA(1, 1), a1 + hstepA, voffA);
            PG8_WAIT_V(8); PG8_WAIT_L(0); PG8_BAR; PG8_MMA(0, 0, At, B0); PG8_MMA(0, 1, At, B1); PG8_BAR; PG8_SCHED;
            PG8_LDA(At, 0, 1); PG8_STAGE(PG8_SB(0, 0), b2, voffB); PG8_STAGE(PG8_SB(0, 1), b2 + hstepB, voffB); PG8_STAGE(PG8_SA(0, 0), a2, voffA);
            PG8_WAIT_V(8); PG8_WAIT_L(0); PG8_BAR; PG8_MMA(1, 0, At, B0); PG8_MMA(1, 1, At, B1); PG8_BAR; PG8_SCHED;
            PG8_LDB(B0, 1, 0); PG8_LDB(B1, 1, 1); PG8_SCHED; PG8_LDA(At, 1, 0); PG8_STAGE(PG8_SA(0, 1), a2 + hstepA, voffA);
            PG8_WAIT_V(8); PG8_WAIT_L(0); PG8_BAR; PG8_MMA(0, 0, At, B0); PG8_MMA(0, 1, At, B1); PG8_BAR; PG8_SCHED;
            PG8_LDA(At, 1, 1); PG8_STAGE(PG8_SB(1, 0), b3, voffB); PG8_STAGE(PG8_SB(1, 1), b3 + hstepB, voffB); PG8_STAGE(PG8_SA(1, 0), a3, voffA);
            PG8_WAIT_V(8); PG8_WAIT_L(0); PG8_BAR; PG8_MMA(1, 0, At, B0); PG8_MMA(1, 1, At, B1); PG8_BAR; PG8_SCHED;
            } else {
            PG8_LDB(B0, 0, 0); PG8_SCHED; PG8_LDA(At, 0, 0); PG8_STAGE(PG8_SA(1, 1), a1 + hstepA, voffA);
            PG8_WAIT_L(8); PG8_BAR; PG8_WAIT_L(0); PG8_MMA(0, 0, At, B0); PG8_BAR; PG8_SCHED;
            PG8_LDB(B1, 0, 1); PG8_STAGE(PG8_SB(0, 0), b2, voffB);
            PG8_BAR; PG8_WAIT_L(0); PG8_MMA(0, 1, At, B1); PG8_BAR;
            PG8_LDA(At, 0, 1); PG8_STAGE(PG8_SA(0, 0), a2, voffA);
            PG8_BAR; PG8_WAIT_L(0); PG8_MMA(1, 0, At, B0); PG8_BAR; PG8_SCHED;
            PG8_STAGE(PG8_SB(0, 1), b2 + hstepB, voffB);
            PG8_WAIT_V(6); PG8_BAR; PG8_MMA(1, 1, At, B1); PG8_BAR;
            PG8_LDB(B0, 1, 0); PG8_SCHED; PG8_LDA(At, 1, 0); PG8_STAGE(PG8_SA(0, 1), a2 + hstepA, voffA);
            PG8_WAIT_L(8); PG8_BAR; PG8_WAIT_L(0); PG8_MMA(0, 0, At, B0); PG8_BAR; PG8_SCHED;
            PG8_LDB(B1, 1, 1); PG8_STAGE(PG8_SB(1, 0), b3, voffB);
            PG8_BAR; PG8_WAIT_L(0); PG8_MMA(0, 1, At, B1); PG8_BAR;
            PG8_LDA(At, 1, 1); PG8_STAGE(PG8_SA(1, 0), a3, voffA);
            PG8_BAR; PG8_WAIT_L(0); PG8_MMA(1, 0, At, B0); PG8_BAR; PG8_SCHED;
            PG8_STAGE(PG8_SB(1, 1), b3 + hstepB, voffB);
            PG8_WAIT_V(6); PG8_BAR; PG8_MMA(1, 1, At, B1); PG8_BAR;
            }
        }
        if constexpr (ALIGN_EPI) { if (wr == 0) PG8_BAR; }
        if constexpr (!Epi::AFTER_DRAIN) { E(acc, cur, wr, wc, fr, fq); S.done(cur); }
        if (!has_next) break;
#pragma unroll
        for (int a = 0; a < 2; ++a)
#pragma unroll
            for (int b = 0; b < 2; ++b)
#pragma unroll
                for (int m = 0; m < 4; ++m)
#pragma unroll
                    for (int n = 0; n < 2; ++n) acc[a][b][m][n] = (f32x4){0.f, 0.f, 0.f, 0.f};
        cur = nxt; cA = nA; cB = nB; ++ui;
        if constexpr (ALIGN_EPI) { if (wr == 1) PG8_BAR; }
    }
    PG8_WAIT_V(0);
    if constexpr (!ALIGN_EPI) { if (wr == 0) PG8_BAR; }
    PG8_BAR;
    if constexpr (Epi::AFTER_DRAIN) { E.fused(acc, cur, wr, wc, fr, fq, lds, wid, lane); S.done(cur); }
#undef PG8_SA
#undef PG8_SB
#undef PG8_STAGE
#undef PG8_LDA
#undef PG8_LDB
#undef PG8_MMA
#undef PG8_WAIT_V
#undef PG8_WAIT_L
#undef PG8_BAR
#undef PG8_SCHED
}
}
#define GAS __attribute__((address_space(1)))
#define LAS __attribute__((address_space(3)))
typedef unsigned short bf16;
typedef unsigned v4u __attribute__((ext_vector_type(4)));
typedef float f32x4 __attribute__((ext_vector_type(4)));
typedef short bf16x8 __attribute__((ext_vector_type(8)));
typedef GAS unsigned gu32;
typedef GAS unsigned long long gu64;
#define RLX_AGENT __ATOMIC_RELAXED, __HIP_MEMORY_SCOPE_AGENT
#define LDS_WAIT() asm volatile("s_waitcnt lgkmcnt(0)" ::: "memory")
#define VM_WAIT() asm volatile("s_waitcnt vmcnt(0)" ::: "memory")
__device__ __forceinline__ unsigned long long rt() { return __builtin_amdgcn_s_memrealtime(); }
__device__ __forceinline__ unsigned f2bf(float f) { unsigned u = __builtin_bit_cast(unsigned, f); return (u + 0x7fffu + ((u >> 16) & 1u)) >> 16; }
__device__ __forceinline__ unsigned pk2(float lo, float hi) { return f2bf(lo) | (f2bf(hi) << 16); }

#define XB_TMO      128
#define XB_XCNT(j)  (256  + 64 * (j))
#define XB_XSUB(j)  (1280 + 64 * (j))
#define XB_XGEN(j)  (2304 + 64 * (j))
#define XB_TOP      3328
#define XB_TOPGEN   3392
#define XCD_BAR_WORDS 3456
#define XB_SPIN_CAP (1u << 24)

__device__ __forceinline__ unsigned xb_ld(unsigned* p)              { return __hip_atomic_load(p, __ATOMIC_RELAXED, __HIP_MEMORY_SCOPE_AGENT); }
__device__ __forceinline__ unsigned xb_add(unsigned* p, unsigned v) { return __hip_atomic_fetch_add(p, v, __ATOMIC_RELAXED, __HIP_MEMORY_SCOPE_AGENT); }
__device__ __forceinline__ unsigned xb_xcc_id() { return (unsigned)__builtin_amdgcn_s_getreg((3 << 11) | 20) & 0xFu; }
#define XB_SPIN(cond, bar) do { unsigned _sp = 0; while (cond) { __builtin_amdgcn_s_sleep(1); \
    if ((++_sp & 255u) == 0u) { if (xb_ld(&(bar)[XB_TMO])) break; if (_sp > XB_SPIN_CAP) { atomicAdd(&(bar)[XB_TMO], 1u); break; } } } } while (0)

struct XcdBarrier {
    unsigned* bar; unsigned x;
    volatile LAS unsigned* st;
};

__device__ __forceinline__ XcdBarrier xcd_barrier_post(unsigned* bar, volatile LAS unsigned* st) {
    XcdBarrier b; b.bar = bar; b.x = xb_xcc_id(); b.st = st;
    if (threadIdx.x == 0) (void)xb_add(&bar[XB_XCNT(b.x)], 1u);
    return b;
}
__device__ __forceinline__ void xcd_barrier_complete(unsigned* bar, unsigned x, unsigned& nloc, unsigned& nx) {
    const unsigned G = gridDim.x * gridDim.y * gridDim.z;
    unsigned sum, cnt, mine, sp = 0u;
    for (;;) {
        sum = 0u; cnt = 0u; mine = 0u;
#pragma unroll
        for (unsigned j = 0; j < 16; ++j) { const unsigned c = xb_ld(&bar[XB_XCNT(j)]); sum += c; cnt += (c > 0u) ? 1u : 0u; mine = (j == x) ? c : mine; }
        if (sum == G) break;
        __builtin_amdgcn_s_sleep(1);
        if ((++sp & 255u) == 0u) { if (xb_ld(&bar[XB_TMO])) break; if (sp > XB_SPIN_CAP) { atomicAdd(&bar[XB_TMO], 1u); break; } }
    }
    nloc = mine > 0u ? mine : 1u; nx = cnt > 0u ? cnt : 1u;
}

__device__ __forceinline__ void xcd_barrier(const XcdBarrier& b) {
    asm volatile("s_waitcnt vmcnt(0)" ::: "memory");
    __syncthreads();
    if (threadIdx.x == 0) {
        unsigned* bar = b.bar; asm volatile("" : "+s"(bar));
        __builtin_amdgcn_s_waitcnt(0);
        unsigned nloc = b.st[0], nx = b.st[1];
        if (nloc == 0u) { xcd_barrier_complete(bar, b.x, nloc, nx); b.st[0] = nloc; b.st[1] = nx; }
        const unsigned old = xb_add(&bar[XB_XSUB(b.x)], 1u);
        const unsigned gen = old / nloc;
        if (old + 1u == (gen + 1u) * nloc) {
            __builtin_amdgcn_fence(__ATOMIC_RELEASE, "agent");
            asm volatile("s_waitcnt vmcnt(0)" ::: "memory");
            const unsigned og = xb_add(&bar[XB_TOP], 1u);
            const unsigned tg = og / nx;
            if (og + 1u == (tg + 1u) * nx) xb_add(&bar[XB_TOPGEN], 1u);
            else XB_SPIN(xb_ld(&bar[XB_TOPGEN]) == tg, bar);
            __builtin_amdgcn_fence(__ATOMIC_ACQUIRE, "agent");
            xb_add(&bar[XB_XGEN(b.x)], 1u);
            asm volatile("s_waitcnt vmcnt(0)" ::: "memory");
        } else {
            XB_SPIN(xb_ld(&bar[XB_XGEN(b.x)]) == gen, bar);
            __builtin_amdgcn_fence(__ATOMIC_ACQUIRE, "agent");
            asm volatile("s_waitcnt vmcnt(0)" ::: "memory");
        }
    }
    __syncthreads();
}
constexpr int NWAVES = 8;
constexpr int BATCH = 8, T = 4096, D = 1024, M = BATCH * T, FF = 2816, NGU = 2 * FF, NINP = 2560, NIN_SRC = 2516, NL = 2;
constexpr float RMS_EPS = 1e-6f;
constexpr size_t MiB = 1u << 20;
constexpr size_t WS_CTL = 0, CTL_ZERO_BYTES = 1 * MiB;
constexpr size_t WS_CS64 = 1 * MiB;
constexpr size_t WS_CS32 = 2 * MiB;
constexpr size_t WS_ADA = 2 * MiB + 512 * 1024;
constexpr size_t WS_CMPB = 3 * MiB + 128 * 1024;
constexpr size_t WS_KMEAN = 3 * MiB + 256 * 1024;
constexpr size_t WS_RSTDQ = 3 * MiB + 512 * 1024;
constexpr size_t WS_RSTDKV = 3 * MiB + 768 * 1024;
constexpr size_t WS_KCMP = 4 * MiB;
constexpr size_t WS_VCMP = 4 * MiB + 512 * 1024;
constexpr size_t WS_CMPH = 5 * MiB;
constexpr size_t WS_WTS = 10 * MiB, WTS_LAYER = 46 * MiB;
constexpr size_t WO_GU1 = 0, WO_D1 = 11 * MiB, WO_GU2 = 17 * MiB, WO_D2 = 28 * MiB, WO_IN = 34 * MiB, WO_OUT = 39 * MiB, WO_UQ = 41 * MiB, WO_UKV = 41 * MiB + 512 * 1024, WO_C1K = 42 * MiB, WO_C1V = 43 * MiB;
constexpr size_t WS_XB = 104 * MiB;
constexpr size_t WS_BIG = 168 * MiB;
constexpr size_t WS_HID = WS_BIG;
constexpr size_t WS_QM_BF = 168 * MiB, WS_KM_BF = 184 * MiB, WS_VM_BF = 200 * MiB, WS_QM_F = 216 * MiB, WS_KM_F = 248 * MiB;
constexpr size_t WS_CQ = 280 * MiB, WS_CKV = 296 * MiB;
constexpr size_t WS_QN = 304 * MiB, WS_KC = 320 * MiB, WS_VC = 324 * MiB, WS_KS = 328 * MiB, WS_VS = 332 * MiB, WS_KW = 336 * MiB, WS_VW = 340 * MiB;
constexpr size_t WS_QD = 344 * MiB, WS_KD = 360 * MiB, WS_VD = 364 * MiB, WS_IQ = 368 * MiB, WS_IK = 400 * MiB, WS_GW = 404 * MiB;
constexpr size_t WS_QMLA = 408 * MiB, WS_KMLA = 432 * MiB, WS_VMLA = 456 * MiB;
constexpr size_t WS_DSAMASK = 472 * MiB;
constexpr size_t WS_OC = 488 * MiB;
constexpr size_t WS_KCMPB = 9 * MiB + 256 * 1024, WS_VCMPB = 9 * MiB + 512 * 1024;
constexpr size_t WS_NSEL = 9 * MiB;
constexpr size_t WS_END = 512 * MiB;
constexpr int CW_BAR = 4096;
constexpr int CW_WPART = 8448;
constexpr int CW_WMAX = 8192;
constexpr float ACT_CLIP = 12.0f;
constexpr int RING_OFF = 0, RING_BYTES = 131072;
constexpr int LDSCTL_OFF = RING_BYTES, MISC_OFF = LDSCTL_OFF + 320;
constexpr int XTRA_OFF = 132096, XTRA_WAVE = 2112;
constexpr int LDS_BYTES = 155648;
static_assert(XTRA_OFF + NWAVES * XTRA_WAVE <= LDS_BYTES && MISC_OFF + 128 <= XTRA_OFF, "LDS map");

struct Args { const float* in[28]; float* out; unsigned char* ws; int ph_lo, ph_hi; };
struct Frame {
    LAS unsigned char* lds;
    volatile LAS unsigned* MISC;
    gu32* ctl;
    unsigned char* ws;
    int G;
    const Args* A;
    float* out;
};
enum { I_X = 0, I_C, I_ADAW, I_ADAB, I_F1N, I_F1G, I_F1U, I_F1D, I_MIXN, I_WIN, I_QNORM, I_WUQ, I_KVNORM, I_WUK, I_WUV, I_PEK, I_PEV, I_CK1, I_CK2, I_CV1, I_CV2, I_GN, I_WOUT, I_F2N, I_F2G, I_F2U, I_F2D, I_FINN };

__device__ __forceinline__ int opaque_v(int v) { asm volatile("" : "+v"(v)); return v; }
__device__ __forceinline__ int cur_tid() { return opaque_v((int)threadIdx.x); }
__device__ __forceinline__ int cur_lane() { return opaque_v((int)threadIdx.x) & 63; }
__device__ __forceinline__ int cur_wave() { return __builtin_amdgcn_readfirstlane(opaque_v((int)threadIdx.x) >> 6); }
template <int CTRL> __device__ __forceinline__ float dpp_f(float v) { return __int_as_float(__builtin_amdgcn_update_dpp(0, __float_as_int(v), CTRL, 0xf, 0xf, false)); }
__device__ __forceinline__ float wave_sum(float v) {
    v += dpp_f<0xB1>(v); v += dpp_f<0x4E>(v); v += dpp_f<0x141>(v); v += dpp_f<0x140>(v);
    const float r0 = __int_as_float(__builtin_amdgcn_readlane(__float_as_int(v), 0)), r1 = __int_as_float(__builtin_amdgcn_readlane(__float_as_int(v), 16));
    const float r2 = __int_as_float(__builtin_amdgcn_readlane(__float_as_int(v), 32)), r3 = __int_as_float(__builtin_amdgcn_readlane(__float_as_int(v), 48));
    return (r0 + r1) + (r2 + r3);
}
__device__ __forceinline__ float wave_max(float v) {
    v = fmaxf(v, dpp_f<0xB1>(v)); v = fmaxf(v, dpp_f<0x4E>(v)); v = fmaxf(v, dpp_f<0x141>(v)); v = fmaxf(v, dpp_f<0x140>(v));
    const float r0 = __int_as_float(__builtin_amdgcn_readlane(__float_as_int(v), 0)), r1 = __int_as_float(__builtin_amdgcn_readlane(__float_as_int(v), 16));
    const float r2 = __int_as_float(__builtin_amdgcn_readlane(__float_as_int(v), 32)), r3 = __int_as_float(__builtin_amdgcn_readlane(__float_as_int(v), 48));
    return fmaxf(fmaxf(r0, r1), fmaxf(r2, r3));
}
__device__ __forceinline__ float bf2f(unsigned short b) { return __uint_as_float((unsigned)b << 16); }
__device__ __forceinline__ void unpack8(const v4u w, float* f) {
    f[0] = __uint_as_float(w.x << 16); f[1] = __uint_as_float(w.x & 0xffff0000u); f[2] = __uint_as_float(w.y << 16); f[3] = __uint_as_float(w.y & 0xffff0000u);
    f[4] = __uint_as_float(w.z << 16); f[5] = __uint_as_float(w.z & 0xffff0000u); f[6] = __uint_as_float(w.w << 16); f[7] = __uint_as_float(w.w & 0xffff0000u);
}
__device__ __forceinline__ float sigmoid_f(float x) { return 1.0f / (1.0f + __expf(-x)); }

__device__ __forceinline__ int perm64(int j) { return 32 * ((j & 31) >> 4) + 16 * (j >> 5) + (j & 15); }
__device__ __forceinline__ int win_src_col(int c) {
    if (c < 512) return (c & ~63) + perm64(c & 63);
    if (c < 1184) return c;
    if (c < 1504) { const int r = c - 1184; return 1184 + (r & ~63) + perm64(r & 63); }
    if (c < 1568) return c;
    if (c < 1632) return 1568 + perm64(c - 1568);
    if (c < 1696) return c;
    if (c < 1760) return 1696 + perm64(c - 1696);
    if (c < 1824) return c;
    if (c < 2144) { const int r = c - 1824; return 1836 + (r & ~63) + perm64(r & 63); }
    if (c < 2208) return 2156 + (c - 2144);
    if (c < 2464) return 2220 + (c - 2208);
    if (c < 2496) return 2476 + (c - 2464);
    if (c < 2508) return 1824 + (c - 2496);
    if (c < 2516) return 2508 + (c - 2508);
    return -1;
}
constexpr int WK_K[8] = {1024, 2816, 1024, 2816, 1024, 1024, 256, 128};
constexpr int WK_N[8] = {5632, 1024, 5632, 1024, 2560, 1024, 512, 512};
__device__ __forceinline__ size_t wk_off(int kind) { return kind == 0 ? WO_GU1 : kind == 1 ? WO_D1 : kind == 2 ? WO_GU2 : kind == 3 ? WO_D2 : kind == 4 ? WO_IN : kind == 5 ? WO_OUT : kind == 6 ? WO_UQ : kind == 7 ? WO_UKV : kind == 8 ? WO_C1K : WO_C1V; }
__device__ __forceinline__ const float* wsrc(const Frame& F, int kind, int l, int R, int& stride) {
    switch (kind) {
    case 0: case 2: { const int G = R >> 5, w = R & 31, j = 16 * G + (w & 15); stride = FF;
        const float* g = F.A->in[kind == 0 ? I_F1G : I_F2G] + (size_t)l * D * FF; const float* u = F.A->in[kind == 0 ? I_F1U : I_F2U] + (size_t)l * D * FF; return ((w >> 4) ? u : g) + j; }
    case 1: case 3: stride = D; return F.A->in[kind == 1 ? I_F1D : I_F2D] + (size_t)l * FF * D + R;
    case 4: { stride = NIN_SRC; const int s = win_src_col(R); return s < 0 ? nullptr : F.A->in[I_WIN] + (size_t)l * D * NIN_SRC + s; }
    case 5: stride = D; return F.A->in[I_WOUT] + (size_t)l * D * D + R;
    case 6: stride = 384; return R < 384 ? F.A->in[I_WUQ] + (size_t)l * 256 * 384 + R : nullptr;
    case 7: stride = 256; return R < 256 ? F.A->in[I_WUK] + (size_t)l * 128 * 256 + R : F.A->in[I_WUV] + (size_t)l * 128 * 256 + (R - 256);
    default: stride = 256; return F.A->in[kind == 8 ? I_CK1 : I_CV1] + (size_t)l * 2048 * 256 + R;
    }
}

struct WinDesc {
    unsigned char* ws;
    __device__ __forceinline__ pg8::ProjDesc operator()(int G) const {
        pg8::ProjDesc d; d.kind = 0; d.dfreq0 = 0; d.nstride = 16; d.rep = 1; d.repstride = 0; d.bpitch = 0; d.fpitch = 0; d.pad = 0; d.bp = nullptr; d.fp = nullptr;
        const int c = 32 * G;
#define ROPE64(rel, BOFF, BP, FOFF, FP) do { const int hh_ = (rel) >> 6, g_ = ((rel) >> 5) & 1; d.kind = 2; d.dfreq0 = 16 * g_; d.nstride = 32; \
            d.bp = (bf16*)(ws + (BOFF)) + hh_ * 64 + 16 * g_; d.bpitch = (BP); if (FP) { d.fp = (float*)(ws + (FOFF)) + hh_ * 64 + 16 * g_; d.fpitch = (FP); } } while (0)
#define PLAINB(rel, BOFF, BP) do { d.kind = 1; d.bp = (bf16*)(ws + (BOFF)) + (rel); d.bpitch = (BP); } while (0)
#define PLAINF(rel, FOFF, FP) do { d.kind = 1; d.fp = (float*)(ws + (FOFF)) + (rel); d.fpitch = (FP); } while (0)
        if (c < 256) ROPE64(c, WS_QM_BF, 256, WS_QM_F, 256);
        else if (c < 512) ROPE64(c - 256, WS_KM_BF, 256, WS_KM_F, 256);
        else if (c < 768) PLAINB(c - 512, WS_VM_BF, 256);
        else if (c < 1024) PLAINB(c - 768, WS_CQ, 256);
        else if (c < 1152) PLAINB(c - 1024, WS_CKV, 128);
        else if (c < 1184) { d.kind = 3; d.nstride = 16; d.bp = (bf16*)(ws + WS_KMLA) + 64; d.bpitch = 384; d.rep = 4; d.repstride = 96; }
        else if (c < 1440) ROPE64(c - 1184, WS_QN, 256, 0, 0);
        else if (c < 1504) ROPE64(c - 1440, WS_KC, 64, 0, 0);
        else if (c < 1568) PLAINB(c - 1504, WS_VC, 64);
        else if (c < 1632) ROPE64(c - 1568, WS_KS, 64, 0, 0);
        else if (c < 1696) PLAINB(c - 1632, WS_VS, 64);
        else if (c < 1760) ROPE64(c - 1696, WS_KW, 64, 0, 0);
        else if (c < 1824) PLAINB(c - 1760, WS_VW, 64);
        else if (c < 2080) ROPE64(c - 1824, WS_QD, 256, 0, 0);
        else if (c < 2144) ROPE64(c - 2080, WS_KD, 64, 0, 0);
        else if (c < 2208) PLAINB(c - 2144, WS_VD, 64);
        else if (c < 2464) PLAINB(c - 2208, WS_IQ, 256);
        else if (c < 2496) PLAINB(c - 2464, WS_IK, 32);
        else if (c < 2528) PLAINF(c - 2496, WS_GW, 32);
#undef ROPE64
#undef PLAINB
#undef PLAINF
        return d;
    }
};
struct MlaQDesc {
    unsigned char* ws;
    __device__ __forceinline__ pg8::ProjDesc operator()(int G) const {
        pg8::ProjDesc d; d.kind = 0; d.dfreq0 = 0; d.nstride = 16; d.rep = 1; d.repstride = 0; d.bpitch = 384; d.fpitch = 0; d.pad = 0; d.bp = nullptr; d.fp = nullptr;
        if (G < 12) { const int hh = G / 3, part = G - 3 * hh; d.kind = (part == 2) ? 3 : 1; d.bp = (bf16*)(ws + WS_QMLA) + hh * 96 + 32 * part; }
        return d;
    }
};
struct MlaKvDesc {
    unsigned char* ws;
    __device__ __forceinline__ pg8::ProjDesc operator()(int G) const {
        pg8::ProjDesc d; d.kind = 1; d.dfreq0 = 0; d.nstride = 16; d.rep = 1; d.repstride = 0; d.bpitch = 0; d.fpitch = 0; d.pad = 0; d.bp = nullptr; d.fp = nullptr;
        const int c = 32 * G;
        if (c < 256) { d.bp = (bf16*)(ws + WS_KMLA) + (c >> 6) * 96 + (c & 63); d.bpitch = 384; }
        else { d.bp = (bf16*)(ws + WS_VMLA) + (c - 256); d.bpitch = 256; }
        return d;
    }
};

__device__ __forceinline__ void p0_prologue(Frame& F) {
    const int tid = cur_tid();
    const int wave = cur_wave(), gw = blockIdx.x * NWAVES + wave, NGW = F.G * NWAVES, lane = cur_lane();
    {
        LAS float* scr = (LAS float*)(F.lds + RING_OFF + wave * 16384);
        constexpr int PER_LAYER = 1280 + 512 + 64 + 32 + 256 + 256;
        for (int it = gw; it < NL * PER_LAYER; it += NGW) {
            const int l = it / PER_LAYER; int r = it - l * PER_LAYER; int kind = 4;
            { const int cnt[6] = {1280, 512, 64, 32, 256, 256};
#pragma unroll
              for (int q = 0; q < 5; ++q) { if (kind == q + 4 && r >= cnt[q]) { r -= cnt[q]; kind = q + 5; } } }
            const int K = kind == 0 || kind == 2 || kind == 4 || kind == 5 ? 1024 : (kind == 1 || kind == 3) ? 2816 : kind == 6 ? 256 : kind == 7 ? 128 : 2048;
            const int N = kind == 0 || kind == 2 ? 5632 : kind == 4 ? 2560 : (kind == 6 || kind == 7) ? 512 : kind >= 8 ? 256 : 1024;
            const int nblk = N / 32, kb = r / nblk, nb = r - kb * nblk, k0 = 64 * kb, n0 = 32 * nb;
            int stride; const float* colp = wsrc(F, kind, l, n0 + (lane & 31), stride);
            const float* ksc = kind == 6 ? F.A->in[I_QNORM] + l * 256 : kind == 7 ? F.A->in[I_KVNORM] + l * 128 : nullptr;
            bf16* WT = (bf16*)(F.ws + WS_WTS + (size_t)l * WTS_LAYER + wk_off(kind));
            float vv[32];
#pragma unroll
            for (int i = 0; i < 32; ++i) { const int kk = 2 * i + (lane >> 5); vv[i] = colp ? colp[(size_t)(k0 + kk) * stride] : 0.f; }
#pragma unroll
            for (int i = 0; i < 32; ++i) { const int kk = 2 * i + (lane >> 5); float v = vv[i]; if (ksc) v *= ksc[k0 + kk]; scr[kk * 33 + (lane & 31)] = v; }
            LDS_WAIT(); asm volatile("" ::: "memory");
            const int c = lane & 7;
#pragma unroll
            for (int j = 0; j < 4; ++j) { const int n = (lane >> 3) + 8 * j; const LAS float* s = scr + (8 * c) * 33 + n;
                v4u o; o.x = pk2(s[0 * 33], s[1 * 33]); o.y = pk2(s[2 * 33], s[3 * 33]); o.z = pk2(s[4 * 33], s[5 * 33]); o.w = pk2(s[6 * 33], s[7 * 33]);
                *(GAS v4u*)(WT + (size_t)(n0 + n) * K + k0 + 8 * c) = o; }
            LDS_WAIT(); asm volatile("" ::: "memory");
        }
    }
    {
        const int gtid = blockIdx.x * 512 + tid, NT = F.G * 512; constexpr int n4 = D * FF / 4;
        LAS float* red = (LAS float*)(F.lds + RING_OFF);
        __syncthreads();
#pragma unroll 1
        for (int cm = 0; cm < 12; ++cm) { const bool isd = cm >= 8; const int combo = isd ? cm - 8 : cm >> 1, l = combo >> 1, ff2 = combo & 1, up = cm & 1;
            const f32x4* p = (const f32x4*)(F.A->in[isd ? (ff2 ? I_F2D : I_F1D) : ff2 ? (up ? I_F2U : I_F2G) : (up ? I_F1U : I_F1G)] + (size_t)l * D * FF);
            f32x4 v[6];
#pragma unroll
            for (int q = 0; q < 6; ++q) { const int i = gtid + q * NT; v[q] = i < n4 ? p[i] : (f32x4){0.f, 0.f, 0.f, 0.f}; }
            float mx = 0.f;
#pragma unroll
            for (int q = 0; q < 6; ++q) mx = fmaxf(mx, fmaxf(fmaxf(fabsf(v[q].x), fabsf(v[q].y)), fmaxf(fabsf(v[q].z), fabsf(v[q].w))));
            for (int i = gtid + 6 * NT; i < n4; i += NT) { const f32x4 w = p[i]; mx = fmaxf(mx, fmaxf(fmaxf(fabsf(w.x), fabsf(w.y)), fmaxf(fabsf(w.z), fabsf(w.w)))); }
            mx = wave_max(mx);
            if (lane == 0) red[cm * 8 + wave] = mx; }
        __syncthreads();
        if (tid < 8) { const int c0 = tid < 4 ? 2 * tid : 4 + tid, nc = tid < 4 ? 16 : 8; float mx = 0.f;
            for (int q = 0; q < nc; ++q) mx = fmaxf(mx, red[c0 * 8 + q]);
            __hip_atomic_fetch_max((unsigned*)(F.ctl + CW_WPART) + tid * 256 + (blockIdx.x & 255), __float_as_uint(mx), __ATOMIC_RELAXED, __HIP_MEMORY_SCOPE_AGENT); }
        __syncthreads();
    }
    for (int i = blockIdx.x * 512 + tid; i < 4096 * 48; i += F.G * 512) {
        const int pos = i / 48, j = i - pos * 48;
        float invf; float* dst;
        if (j < 32) { invf = 1.0f / (float)pow(10000.0, (double)j / 32.0); dst = (float*)(F.ws + WS_CS64) + ((size_t)pos * 32 + j) * 2; }
        else { invf = 1.0f / (float)pow(10000.0, (double)(j - 32) / 16.0); dst = (float*)(F.ws + WS_CS32) + ((size_t)pos * 16 + (j - 32)) * 2; }
        const float ang = (float)pos * invf;
        dst[0] = (float)cos((double)ang); dst[1] = (float)sin((double)ang);
    }
    {
        LAS float* red = (LAS float*)(F.lds + RING_OFF + 8 * 16384 - 2048);
        for (int task = blockIdx.x; task < NL * 2 * 4; task += F.G) {
            const int l = task >> 3, kvq = task & 7, kv = kvq >> 2, j = (kvq & 3) * 64 + lane;
            const float* pe = F.A->in[kv ? I_PEV : I_PEK] + (size_t)l * 2048 + wave * 256; const float* w1 = F.A->in[kv ? I_CV1 : I_CK1] + (size_t)l * 2048 * 256 + (size_t)wave * 256 * 256 + j;
            float acc = 0.f;
#pragma unroll 32
            for (int k = 0; k < 256; ++k) acc += pe[k] * w1[(size_t)k * 256];
            __syncthreads();
            red[wave * 64 + lane] = acc;
            __syncthreads();
            if (wave == 0) { float s = 0.f;
#pragma unroll
                for (int w = 0; w < 8; ++w) s += red[w * 64 + lane];
                ((float*)(F.ws + WS_CMPB))[(l * 2 + kv) * 256 + j] = s; }
        }
    }
    {
        __syncthreads();
        LAS float* cact = (LAS float*)(F.lds + RING_OFF);
        LAS float* red = (LAS float*)(F.lds + RING_OFF + 32768);
        for (int i = tid; i < 8 * 1024; i += 512) { const float cv = F.A->in[I_C][i]; cact[i] = cv / (1.0f + __expf(-cv)); }
        __syncthreads();
        for (int task = blockIdx.x; task < NL * 144; task += F.G) {
            const int l = task / 144, n0 = (task - l * 144) * 64;
            const float* W = F.A->in[I_ADAW] + (size_t)l * 1024 * 9216 + n0 + lane;
            float acc[8];
#pragma unroll
            for (int b = 0; b < 8; ++b) acc[b] = 0.f;
            const int kbeg = wave * 128;
#pragma unroll 16
            for (int k = kbeg; k < kbeg + 128; ++k) { const float wv = W[(size_t)k * 9216];
#pragma unroll
                for (int b = 0; b < 8; ++b) acc[b] += cact[b * 1024 + k] * wv; }
#pragma unroll
            for (int b = 0; b < 8; ++b) red[(wave * 8 + b) * 64 + lane] = acc[b];
            __syncthreads();
            { const int b = wave; float s = F.A->in[I_ADAB][(size_t)l * 9216 + n0 + lane];
#pragma unroll
              for (int w = 0; w < 8; ++w) s += red[(w * 8 + b) * 64 + lane];
              ((float*)(F.ws + WS_ADA))[((size_t)l * 8 + b) * 9216 + n0 + lane] = s; }
            __syncthreads();
        }
    }
}

using pg8::q8pack4; using pg8::HID_CLIP;
__device__ __forceinline__ void wgu8_convert(Frame& F) {
    const int wave = cur_wave(), gw = blockIdx.x * NWAVES + wave, NGW = F.G * NWAVES, lane = cur_lane();
    LAS float* scr = (LAS float*)(F.lds + RING_OFF + wave * 16384);
    float wm[8];
    { unsigned pv[8][4];
#pragma unroll
      for (int sl = 0; sl < 8; ++sl)
#pragma unroll
          for (int j = 0; j < 4; ++j) pv[sl][j] = __hip_atomic_load((unsigned*)(F.ctl + CW_WPART) + sl * 256 + lane + 64 * j, __ATOMIC_RELAXED, __HIP_MEMORY_SCOPE_AGENT);
#pragma unroll
      for (int sl = 0; sl < 8; ++sl) wm[sl] = wave_max(fmaxf(fmaxf(__uint_as_float(pv[sl][0]), __uint_as_float(pv[sl][1])), fmaxf(__uint_as_float(pv[sl][2]), __uint_as_float(pv[sl][3]))));
      if (gw == 0 && lane == 0) {
#pragma unroll
          for (int sl = 0; sl < 8; ++sl) __hip_atomic_store((unsigned*)(F.ctl + CW_WMAX) + sl, __float_as_uint(wm[sl]), __ATOMIC_RELAXED, __HIP_MEMORY_SCOPE_AGENT); } }
    for (int it = gw; it < 4 * 2816 + 4 * 1408; it += NGW) {
        const bool isd = it >= 4 * 2816; const int r0 = isd ? it - 4 * 2816 : it, per = isd ? 1408 : 2816, nblk = isd ? 32 : 176, KB = isd ? 2816 : 1024;
        const int cmb = r0 / per, r = r0 - cmb * per, l = cmb >> 1, ff2 = cmb & 1, kind = (isd ? 1 : 0) + 2 * ff2, combo = cmb + (isd ? 4 : 0);
        const int kb = r / nblk, nb = r - kb * nblk, k0 = 64 * kb, n0 = 32 * nb;
        int stride; const float* colp = wsrc(F, kind, l, n0 + (lane & 31), stride);
        float wmax = wm[0];
#pragma unroll
        for (int sl = 1; sl < 8; ++sl) wmax = combo == sl ? wm[sl] : wmax;
        const float qs = wmax > 0.f ? 127.0f / wmax : 0.f;
        signed char* WT = (signed char*)(F.ws + WS_WTS + (size_t)l * WTS_LAYER + wk_off(kind));
        float vv[32];
#pragma unroll
        for (int i = 0; i < 32; ++i) { const int kk = 2 * i + (lane >> 5); vv[i] = colp[(size_t)(k0 + kk) * stride]; }
#pragma unroll
        for (int i = 0; i < 32; ++i) { const int kk = 2 * i + (lane >> 5); scr[kk * 33 + (lane & 31)] = vv[i]; }
        LDS_WAIT(); asm volatile("" ::: "memory");
#pragma unroll
        for (int q = 0; q < 2; ++q) { const int p = lane + 64 * q, n = p >> 2, c = p & 3; const LAS float* s = scr + (16 * c) * 33 + n;
            v4u o; o.x = q8pack4(s[0 * 33], s[1 * 33], s[2 * 33], s[3 * 33], qs); o.y = q8pack4(s[4 * 33], s[5 * 33], s[6 * 33], s[7 * 33], qs);
            o.z = q8pack4(s[8 * 33], s[9 * 33], s[10 * 33], s[11 * 33], qs); o.w = q8pack4(s[12 * 33], s[13 * 33], s[14 * 33], s[15 * 33], qs);
            *(GAS v4u*)(WT + (size_t)(n0 + n) * KB + k0 + 16 * c) = o; }
        LDS_WAIT(); asm volatile("" ::: "memory");
    }
}
template <bool XBF> __device__ __forceinline__ void load_row16(const void* xsrc, int row, int lane, f32x4 (&v)[4]) {
    if (XBF) { const unsigned long long* xr = (const unsigned long long*)((const bf16*)xsrc + (size_t)row * D) + lane;
#pragma unroll
        for (int j = 0; j < 4; ++j) { const unsigned long long w = xr[64 * j];
            v[j] = (f32x4){__uint_as_float((unsigned)w << 16), __uint_as_float((unsigned)w & 0xffff0000u), __uint_as_float((unsigned)(w >> 32) << 16), __uint_as_float((unsigned)(w >> 32) & 0xffff0000u)}; } }
    else { const f32x4* xr = (const f32x4*)((const float*)xsrc + (size_t)row * D) + lane;
#pragma unroll
        for (int j = 0; j < 4; ++j) v[j] = xr[64 * j]; }
}
template <bool XBF, bool Q8>
__device__ __forceinline__ void norm_mod_phase(Frame& F, const void* xsrc, const float* gain, const float* sh, const float* sc, bf16* hout) {
    const int wave = cur_wave(), gw = blockIdx.x * NWAVES + wave, NGW = F.G * NWAVES, lane = cur_lane();
    f32x4 g[4];
#pragma unroll
    for (int j = 0; j < 4; ++j) g[j] = *(const f32x4*)(gain + 4 * lane + 256 * j);
    for (int row0 = gw; row0 < M; row0 += 2 * NGW) {
        const int row1 = row0 + NGW; const bool has1 = row1 < M; const int r1 = has1 ? row1 : row0;
        f32x4 va[4], vb[4]; float sa = 0.f, sb = 0.f;
        load_row16<XBF>(xsrc, row0, lane, va); load_row16<XBF>(xsrc, r1, lane, vb);
#pragma unroll
        for (int j = 0; j < 4; ++j) { sa += (va[j].x * va[j].x + va[j].y * va[j].y) + (va[j].z * va[j].z + va[j].w * va[j].w); sb += (vb[j].x * vb[j].x + vb[j].y * vb[j].y) + (vb[j].z * vb[j].z + vb[j].w * vb[j].w); }
        const float rsa = 1.0f / sqrtf(wave_sum(sa) * (1.f / D) + RMS_EPS), rsb = 1.0f / sqrtf(wave_sum(sb) * (1.f / D) + RMS_EPS);
#pragma unroll
        for (int q = 0; q < 2; ++q) {
            if (q == 1 && !has1) break;
            const int row = q ? row1 : row0; const int b = row >> 12; const float rstd = q ? rsb : rsa;
            const float* shb = sh + (size_t)b * 9216 + 4 * lane; const float* scb = sc + (size_t)b * 9216 + 4 * lane;
            unsigned long long* o8 = (unsigned long long*)(hout + (size_t)row * D) + lane;
            unsigned* o4 = (unsigned*)((signed char*)hout + (size_t)row * D) + lane;
#pragma unroll
            for (int j = 0; j < 4; ++j) { const f32x4 s4 = *(const f32x4*)(shb + 256 * j), c4 = *(const f32x4*)(scb + 256 * j);
                const f32x4 y = (q ? vb[j] : va[j]) * rstd * g[j] * (c4 + 1.0f) + s4;
                if (Q8) o4[64 * j] = q8pack4(y.x, y.y, y.z, y.w, 127.0f / ACT_CLIP);
                else o8[64 * j] = (unsigned long long)pk2(y.x, y.y) | ((unsigned long long)pk2(y.z, y.w) << 32); }
        }
    }
}
__device__ __forceinline__ void final_norm_phase(Frame& F, const bf16* xb, float* out, const float* gain) {
    const int wave = cur_wave(), gw = blockIdx.x * NWAVES + wave, NGW = F.G * NWAVES, lane = cur_lane();
    f32x4 g[4];
#pragma unroll
    for (int j = 0; j < 4; ++j) g[j] = *(const f32x4*)(gain + 4 * lane + 256 * j);
    for (int row0 = gw; row0 < M; row0 += 2 * NGW) {
        const int row1 = row0 + NGW; const bool has1 = row1 < M; const int r1 = has1 ? row1 : row0;
        f32x4 va[4], vb[4]; float sa = 0.f, sb = 0.f;
        load_row16<true>(xb, row0, lane, va); load_row16<true>(xb, r1, lane, vb);
#pragma unroll
        for (int j = 0; j < 4; ++j) { sa += (va[j].x * va[j].x + va[j].y * va[j].y) + (va[j].z * va[j].z + va[j].w * va[j].w); sb += (vb[j].x * vb[j].x + vb[j].y * vb[j].y) + (vb[j].z * vb[j].z + vb[j].w * vb[j].w); }
        const float rsa = 1.0f / sqrtf(wave_sum(sa) * (1.f / D) + RMS_EPS), rsb = 1.0f / sqrtf(wave_sum(sb) * (1.f / D) + RMS_EPS);
        f32x4* xa = (f32x4*)(out + (size_t)row0 * D) + lane;
#pragma unroll
        for (int j = 0; j < 4; ++j) xa[64 * j] = va[j] * rsa * g[j];
        if (has1) { f32x4* xo = (f32x4*)(out + (size_t)row1 * D) + lane;
#pragma unroll
            for (int j = 0; j < 4; ++j) xo[64 * j] = vb[j] * rsb * g[j]; }
    }
}
__device__ __forceinline__ void group_norm_phase(Frame& F, bf16* Y, const float* gn) {
    const int wave = cur_wave(), gw = blockIdx.x * NWAVES + wave, NGW = F.G * NWAVES, lane = cur_lane();
    f32x4 g[4];
#pragma unroll
    for (int j = 0; j < 4; ++j) g[j] = *(const f32x4*)(gn + 256 * j + 4 * lane);
    for (int row0 = gw; row0 < M; row0 += 4 * NGW) {
        unsigned long long w[4][4];
#pragma unroll
        for (int q = 0; q < 4; ++q) { const int row = row0 + q * NGW < M ? row0 + q * NGW : row0; const unsigned long long* yr = (const unsigned long long*)(Y + (size_t)row * D) + lane;
#pragma unroll
            for (int j = 0; j < 4; ++j) w[q][j] = yr[64 * j]; }
#pragma unroll
        for (int q = 0; q < 4; ++q) {
            const int row = row0 + q * NGW; if (row >= M) break;
            unsigned long long* yr = (unsigned long long*)(Y + (size_t)row * D) + lane;
#pragma unroll
            for (int j = 0; j < 4; ++j) {
                const unsigned long long ww = w[q][j];
                const float a0 = __uint_as_float((unsigned)ww << 16), a1 = __uint_as_float((unsigned)ww & 0xffff0000u), a2 = __uint_as_float((unsigned)(ww >> 32) << 16), a3 = __uint_as_float((unsigned)(ww >> 32) & 0xffff0000u);
                const float ss = wave_sum((a0 * a0 + a1 * a1) + (a2 * a2 + a3 * a3));
                const float rstd = 1.0f / sqrtf(ss * (1.f / 256.f) + RMS_EPS);
                yr[64 * j] = (unsigned long long)pk2(a0 * rstd * g[j].x, a1 * rstd * g[j].y) | ((unsigned long long)pk2(a2 * rstd * g[j].z, a3 * rstd * g[j].w) << 32);
            }
        }
    }
}
__device__ __forceinline__ unsigned long long causal_word(int d) { return d >= 63 ? ~0ull : (d < 0 ? 0ull : ((2ull << d) - 1ull)); }
__device__ __forceinline__ int mbcnt64(unsigned long long m) { return (int)__builtin_amdgcn_mbcnt_hi((unsigned)(m >> 32), __builtin_amdgcn_mbcnt_lo((unsigned)m, 0u)); }
__device__ __forceinline__ unsigned fkey(float x) { const unsigned u = __float_as_uint(x); return (u & 0x80000000u) ? ~u : (u | 0x80000000u); }
__device__ __forceinline__ float reduce64(const float (&o)[64], int lane) {
    float r5[32], r4[16], r3[8], r2[4], r1[2];
    { const bool hi = (lane & 32) != 0;
#pragma unroll
      for (int i = 0; i < 32; ++i) { const float a = o[i], b = o[i + 32]; r5[i] = (hi ? b : a) + __shfl_xor(hi ? a : b, 32); } }
    { const bool hi = (lane & 16) != 0;
#pragma unroll
      for (int i = 0; i < 16; ++i) { const float a = r5[i], b = r5[i + 16]; r4[i] = (hi ? b : a) + __shfl_xor(hi ? a : b, 16); } }
    { const bool hi = (lane & 8) != 0;
#pragma unroll
      for (int i = 0; i < 8; ++i) { const float a = r4[i], b = r4[i + 8]; r3[i] = (hi ? b : a) + __shfl_xor(hi ? a : b, 8); } }
    { const bool hi = (lane & 4) != 0;
#pragma unroll
      for (int i = 0; i < 4; ++i) { const float a = r3[i], b = r3[i + 4]; r2[i] = (hi ? b : a) + __shfl_xor(hi ? a : b, 4); } }
    { const bool hi = (lane & 2) != 0;
#pragma unroll
      for (int i = 0; i < 2; ++i) { const float a = r2[i], b = r2[i + 2]; r1[i] = (hi ? b : a) + __shfl_xor(hi ? a : b, 2); } }
    const bool hi = (lane & 1) != 0;
    return (hi ? r1[1] : r1[0]) + __shfl_xor(hi ? r1[0] : r1[1], 1);
}
struct KVbf {
    const bf16* K; const bf16* V; int kp, vp;
    template <int DQ> __device__ __forceinline__ float dot(int row, const LAS float* q) const {
        const v4u* p = (const v4u*)(K + (size_t)row * kp); float s = 0.f;
#pragma unroll
        for (int c = 0; c < DQ / 8; ++c) { float f[8]; unpack8(p[c], f); const f32x4 q0 = *(const LAS f32x4*)(q + 8 * c), q1 = *(const LAS f32x4*)(q + 8 * c + 4);
            s += (q0.x * f[0] + q0.y * f[1]) + (q0.z * f[2] + q0.w * f[3]) + (q1.x * f[4] + q1.y * f[5]) + (q1.z * f[6] + q1.w * f[7]); }
        return s;
    }
    __device__ __forceinline__ void axpy(int row, float pw, float (&o)[64]) const {
        const v4u* p = (const v4u*)(V + (size_t)row * vp);
#pragma unroll
        for (int c = 0; c < 8; ++c) { float f[8]; unpack8(p[c], f);
#pragma unroll
            for (int e = 0; e < 8; ++e) o[8 * c + e] += pw * f[e]; }
    }
};
struct KVf32 {
    const float* K; const float* V; int kp, vp;
    template <int DQ> __device__ __forceinline__ float dot(int row, const LAS float* q) const {
        const f32x4* p = (const f32x4*)(K + (size_t)row * kp); float s = 0.f;
#pragma unroll
        for (int c = 0; c < DQ / 4; ++c) { const f32x4 f = p[c]; const f32x4 qv = *(const LAS f32x4*)(q + 4 * c); s += (qv.x * f.x + qv.y * f.y) + (qv.z * f.z + qv.w * f.w); }
        return s;
    }
    __device__ __forceinline__ void axpy(int row, float pw, float (&o)[64]) const {
        const f32x4* p = (const f32x4*)(V + (size_t)row * vp);
#pragma unroll
        for (int c = 0; c < 16; ++c) { const f32x4 f = p[c]; o[4 * c] += pw * f.x; o[4 * c + 1] += pw * f.y; o[4 * c + 2] += pw * f.z; o[4 * c + 3] += pw * f.w; }
    }
};
template <int DQ, class KV, class KeyFn>
__device__ __forceinline__ float wave_attend(const LAS float* q, float scale, int nslots, const KeyFn& keyf, const KV& kv, int lane) {
    float m = -INFINITY;
    for (int s = 0; s < nslots; ++s) { const int key = keyf(s); if (key >= 0) m = fmaxf(m, kv.template dot<DQ>(key, q) * scale); }
    const float Mx = wave_max(m);
    float o[64];
#pragma unroll
    for (int d = 0; d < 64; ++d) o[d] = 0.f;
    float l = 0.f;
    if (Mx > -INFINITY) {
        for (int s = 0; s < nslots; ++s) { const int key = keyf(s);
            if (key >= 0) { const float p = __expf(kv.template dot<DQ>(key, q) * scale - Mx); l += p; kv.axpy(key, p, o); } }
    }
    l = wave_sum(l);
    const float r = reduce64(o, lane);
    return l > 0.f ? r / l : 0.f;
}
__device__ __forceinline__ void task_bt(int i, int& t, int& rest) { const int tt = i & 2047, j = i >> 11; t = (j & 1) ? 4095 - tt : tt; rest = j >> 1; }

__device__ __forceinline__ void m1_phase(Frame& F, int l) {
    const int wave = cur_wave(), gw = blockIdx.x * NWAVES + wave, NGW = F.G * NWAVES, lane = cur_lane();
    const bf16* CQ = (const bf16*)(F.ws + WS_CQ); const bf16* CKV = (const bf16*)(F.ws + WS_CKV);
    float* rq = (float*)(F.ws + WS_RSTDQ); float* rkv = (float*)(F.ws + WS_RSTDKV);
    for (int row0 = gw; row0 < M; row0 += 4 * NGW) {
        unsigned long long wq[4]; unsigned wk[4];
#pragma unroll
        for (int q = 0; q < 4; ++q) { const int row = row0 + q * NGW < M ? row0 + q * NGW : row0; wq[q] = ((const unsigned long long*)(CQ + (size_t)row * 256))[lane]; wk[q] = ((const unsigned*)(CKV + (size_t)row * 128))[lane]; }
#pragma unroll
        for (int q = 0; q < 4; ++q) {
            const int row = row0 + q * NGW; if (row >= M) break;
            const unsigned long long w = wq[q];
            const float a0 = __uint_as_float((unsigned)w << 16), a1 = __uint_as_float((unsigned)w & 0xffff0000u), a2 = __uint_as_float((unsigned)(w >> 32) << 16), a3 = __uint_as_float((unsigned)(w >> 32) & 0xffff0000u);
            const float s1 = wave_sum((a0 * a0 + a1 * a1) + (a2 * a2 + a3 * a3));
            const float b0 = __uint_as_float(wk[q] << 16), b1 = __uint_as_float(wk[q] & 0xffff0000u);
            const float s2 = wave_sum(b0 * b0 + b1 * b1);
            if (lane == 0) { rq[row] = 1.0f / sqrtf(s1 * (1.f / 256.f) + RMS_EPS); rkv[row] = 1.0f / sqrtf(s2 * (1.f / 128.f) + RMS_EPS); }
        }
    }
    const float* KMF = (const float*)(F.ws + WS_KM_F); float* kmean = (float*)(F.ws + WS_KMEAN);
    for (int task = gw; task < 512; task += NGW) {
        const int b = task >> 6, blk = (task >> 2) & 15, h = task & 3;
        const float* p = KMF + ((size_t)(b * T + blk * 256)) * 256 + h * 64 + lane; float s = 0.f;
#pragma unroll 32
        for (int i = 0; i < 256; ++i) s += p[(size_t)i * 256];
        kmean[((b * 4 + h) * 16 + blk) * 64 + lane] = s * (1.f / 256.f);
    }
}
__device__ __forceinline__ void cmp2_phase(Frame& F, int l) {
    const int wave = cur_wave(), gw = blockIdx.x * NWAVES + wave, NGW = F.G * NWAVES, lane = cur_lane();
    const float* cmph = (const float*)(F.ws + WS_CMPH);
    for (int task = gw; task < 2 * 8 * 255; task += NGW) {
        const int kv = task / 2040, r1 = task - kv * 2040, b = r1 / 255, n = r1 - b * 255;
        const float* hp = cmph + ((size_t)(kv * 8 + b) * 256 + n) * 256;
        const float* w2 = F.A->in[kv ? I_CV2 : I_CK2] + (size_t)l * 256 * 64 + lane;
        float acc = 0.f;
#pragma unroll 32
        for (int j = 0; j < 256; ++j) acc += hp[j] * w2[j * 64];
        ((float*)(F.ws + (kv ? WS_VCMP : WS_KCMP)))[((size_t)b * 256 + n) * 64 + lane] = acc;
        ((bf16*)(F.ws + (kv ? WS_VCMPB : WS_KCMPB)))[((size_t)b * 256 + n) * 64 + lane] = (bf16)f2bf(acc);
    }
    for (int task = gw; task < 16; task += NGW) ((bf16*)(F.ws + ((task & 1) ? WS_VCMPB : WS_KCMPB)))[((size_t)(task >> 1) * 256 + 255) * 64 + lane] = 0;
}
__device__ __forceinline__ void mla_rows_phase(Frame& F) {
    const int wave = cur_wave(), gw = blockIdx.x * NWAVES + wave, NGW = F.G * NWAVES, lane = cur_lane();
    const bf16* Q = (const bf16*)(F.ws + WS_QMLA); bf16* Y = (bf16*)F.out + (size_t)M * D;
    LAS float* q = (LAS float*)(F.lds + RING_OFF + wave * 16384 + 4096);
    for (int i = gw; i < M * 4; i += NGW) {
        int t, bh; task_bt(i, t, bh); const int b = bh >> 2, h = bh & 3, row = b * T + t;
        if (lane < 48) { const unsigned w = ((const unsigned*)(Q + (size_t)row * 384 + h * 96))[lane]; q[2 * lane] = __uint_as_float(w << 16); q[2 * lane + 1] = __uint_as_float(w & 0xffff0000u); }
        LDS_WAIT(); asm volatile("" ::: "memory");
        KVbf kv{(const bf16*)(F.ws + WS_KMLA) + h * 96, (const bf16*)(F.ws + WS_VMLA) + h * 64, 384, 256};
        const int base = b * T;
        auto keyf = [&](int s) { const int p = lane + 64 * s; return p <= t ? base + p : -1; };
        const float r = wave_attend<96>(q, 0.10206207261596577f, (t >> 6) + 1, keyf, kv, lane);
        Y[(size_t)row * 1024 + 256 + h * 64 + lane] = (bf16)f2bf(r);
        LDS_WAIT(); asm volatile("" ::: "memory");
    }
}
__device__ __forceinline__ void moba_rows_phase(Frame& F) {
    const int wave = cur_wave(), gw = blockIdx.x * NWAVES + wave, NGW = F.G * NWAVES, lane = cur_lane();
    const float* QF = (const float*)(F.ws + WS_QM_F); const float* kmean = (const float*)(F.ws + WS_KMEAN); bf16* Y = (bf16*)F.out + (size_t)M * D;
    LAS float* q = (LAS float*)(F.lds + RING_OFF + wave * 16384 + 4096);
    for (int i = gw; i < M * 4; i += NGW) {
        int t, bh; task_bt(i, t, bh); const int b = bh >> 2, h = bh & 3, row = b * T + t, own = t >> 8;
        q[lane] = QF[(size_t)row * 256 + h * 64 + lane];
        LDS_WAIT(); asm volatile("" ::: "memory");
        float g = -INFINITY;
        if (lane < own) { KVf32 km{kmean + (size_t)((b * 4 + h) * 16) * 64, nullptr, 64, 64}; g = km.dot<64>(lane, q); }
        unsigned selmask = 0u;
        for (int r = 0; r < 3; ++r) { const float mx = wave_max(g); if (!(mx > -INFINITY)) break;
            const unsigned long long ball = __ballot(g == mx); const int sl = __ffsll((long long)ball) - 1; selmask |= 1u << sl; if (lane == sl) g = -INFINITY; }
        KVbf kv{(const bf16*)(F.ws + WS_KM_BF) + h * 64, (const bf16*)(F.ws + WS_VM_BF) + h * 64, 256, 256};
        const int base = b * T;
        auto keyf = [&](int s) { const int blk = s >> 2, p = 64 * s + lane; return blk == own ? (p <= t ? base + p : -1) : (((selmask >> blk) & 1u) ? base + p : -1); };
        const float r = wave_attend<64>(q, 0.125f, 4 * own + 4, keyf, kv, lane);
        Y[(size_t)row * 1024 + h * 64 + lane] = (bf16)f2bf(r);
        LDS_WAIT(); asm volatile("" ::: "memory");
    }
}
__device__ __forceinline__ void nsa_tokens_phase(Frame& F) {
    const int wave = cur_wave(), gw = blockIdx.x * NWAVES + wave, NGW = F.G * NWAVES, lane = cur_lane();
    const bf16* QN = (const bf16*)(F.ws + WS_QN); bf16* Y = (bf16*)F.out + (size_t)M * D;
    const float* kcmp = (const float*)(F.ws + WS_KCMP); const float* vcmp = (const float*)(F.ws + WS_VCMP); const float* GWp = (const float*)(F.ws + WS_GW);
    LAS float* ps = (LAS float*)(F.lds + RING_OFF + wave * 16384);
    LAS float* ocs = ps + 256;
    LAS float* svl = ps + 512;
    LAS float* q = (LAS float*)(F.lds + RING_OFF + wave * 16384 + 4096);
    for (int i = gw; i < M; i += NGW) {
        int t, b; task_bt(i, t, b); const int row = b * T + t, own = t >> 6, base = b * T;
#pragma unroll
        for (int k = 0; k < 4; ++k) ps[lane + 64 * k] = 0.f;
#pragma unroll 1
        for (int h = 0; h < 4; ++h) {
            LDS_WAIT(); asm volatile("" ::: "memory");
            q[lane] = bf2f(QN[(size_t)row * 256 + h * 64 + lane]);
            LDS_WAIT(); asm volatile("" ::: "memory");
            KVf32 kc{kcmp + (size_t)b * 256 * 64, vcmp + (size_t)b * 256 * 64, 64, 64};
            float ml = -INFINITY;
#pragma unroll 1
            for (int k = 0; k < 4; ++k) { const int n = lane + 64 * k; const bool valid = (n < 255) && (16 * n + 31 <= t);
                float sv = -INFINITY; if (valid) sv = kc.dot<64>(n, q) * 0.125f; svl[n] = sv; ml = fmaxf(ml, sv); }
            const float Mx = wave_max(ml);
            float o[64];
#pragma unroll
            for (int d = 0; d < 64; ++d) o[d] = 0.f;
#ifndef NSA_NO_C
            if (Mx > -INFINITY) {
                float ls = 0.f;
#pragma unroll 1
                for (int k = 0; k < 4; ++k) { const float sv = svl[lane + 64 * k]; const float p = sv > -INFINITY ? __expf(sv - Mx) : 0.f; ls += p; svl[lane + 64 * k] = p; }
                const float inv = 1.0f / wave_sum(ls);
#pragma unroll 1
                for (int k = 0; k < 4; ++k) { const float p = svl[lane + 64 * k] * inv; ps[lane + 64 * k] += p; if (p > 0.f) kc.axpy(lane + 64 * k, p, o); }
            }
#endif
            ocs[h * 64 + lane] = reduce64(o, lane);
        }
        LDS_WAIT(); asm volatile("" ::: "memory");
        float imp = (ps[4 * lane] + ps[4 * lane + 1]) + (ps[4 * lane + 2] + ps[4 * lane + 3]); if (lane > 0) imp += ps[4 * lane - 1];
        LDS_WAIT(); asm volatile("" ::: "memory");
        const bool causal = lane <= own, forced = causal && (lane == 0 || lane >= own - 1);
        float val = forced ? 1e4f : (causal ? imp : -INFINITY);
        unsigned long long selmask = 0ull;
        for (int r = 0; r < 16; ++r) { const float mx = wave_max(val); if (!(mx > -INFINITY)) break;
            const unsigned long long ball = __ballot(val == mx); const int sl = __ffsll((long long)ball) - 1; selmask |= 1ull << sl; if (lane == sl) val = -INFINITY; }
#ifdef FLASH_NSA
        if (lane == 0) ((unsigned long long*)(F.ws + WS_NSEL))[row] = selmask;
#pragma unroll
        for (int h = 0; h < 4; ++h) ((bf16*)(F.ws + WS_OC))[(size_t)row * 256 + h * 64 + lane] = (bf16)f2bf(ocs[h * 64 + lane]);
        LDS_WAIT(); asm volatile("" ::: "memory");
        continue;
#endif
#pragma unroll 1
        for (int h = 0; h < 4; ++h) {
            LDS_WAIT(); asm volatile("" ::: "memory");
            q[lane] = bf2f(QN[(size_t)row * 256 + h * 64 + lane]);
            LDS_WAIT(); asm volatile("" ::: "memory");
            KVbf ks{(const bf16*)(F.ws + WS_KS), (const bf16*)(F.ws + WS_VS), 64, 64};
            auto keys = [&](int s) { const int p = 64 * s + lane; return (((selmask >> s) & 1ull) && p <= t) ? base + p : -1; };
#ifdef NSA_NO_S
            float os = q[3];
#else
            float os = wave_attend<64>(q, 0.125f, own + 1, keys, ks, lane);
            asm volatile("" : "+v"(os) :: "memory");
#endif
            KVbf kw{(const bf16*)(F.ws + WS_KW), (const bf16*)(F.ws + WS_VW), 64, 64};
            auto keyw = [&](int s) { const int p = t - 511 + lane + 64 * s; return p >= 0 ? base + p : -1; };
#ifdef NSA_NO_W
            float ow = q[5];
#else
            float ow = wave_attend<64>(q, 0.125f, 8, keyw, kw, lane);
            asm volatile("" : "+v"(ow) :: "memory");
#endif
            const float* gp = GWp + (size_t)row * 32 + h * 3;
            const float g0 = sigmoid_f(gp[0]), g1 = sigmoid_f(gp[1]), g2 = sigmoid_f(gp[2]);
            Y[(size_t)row * 1024 + 512 + h * 64 + lane] = (bf16)f2bf(g0 * ocs[h * 64 + lane] + g1 * os + g2 * ow);
        }
    }
}
__device__ __forceinline__ void dsa_tokens_phase(Frame& F) {
    const int wave = cur_wave(), gw = blockIdx.x * NWAVES + wave, NGW = F.G * NWAVES, lane = cur_lane();
    const float* IQ = (const float*)(F.ws + WS_IQ); const float* IK = (const float*)(F.ws + WS_IK); const float* GWp = (const float*)(F.ws + WS_GW);
    const bf16* QD = (const bf16*)(F.ws + WS_QD); bf16* Y = (bf16*)F.out + (size_t)M * D;
    LAS float* sc = (LAS float*)(F.lds + RING_OFF + wave * 16384);
    LAS unsigned* hist = (LAS unsigned*)(F.lds + XTRA_OFF + wave * XTRA_WAVE);
    LAS unsigned short* idx = (LAS unsigned short*)hist;
    LAS float* xq = (LAS float*)(F.lds + XTRA_OFF + wave * XTRA_WAVE + 1024);
    for (int i = gw; i < M; i += NGW) {
        int t, b; task_bt(i, t, b); const int row = b * T + t, base = b * T, n = t + 1;
#pragma unroll
        for (int k = 0; k < 4; ++k) xq[lane + 64 * k] = IQ[(size_t)row * 256 + lane + 64 * k];
        if (lane < 8) xq[256 + lane] = GWp[(size_t)row * 32 + 12 + lane];
        LDS_WAIT(); asm volatile("" ::: "memory");
        for (int k0 = 0; k0 < n; k0 += 64) {
            const int key = k0 + lane;
            if (key < n) {
                float ik[32];
                { const f32x4* kp = (const f32x4*)(IK + (size_t)(base + key) * 32);
#pragma unroll
                  for (int c = 0; c < 8; ++c) { const f32x4 f = kp[c]; ik[4 * c] = f.x; ik[4 * c + 1] = f.y; ik[4 * c + 2] = f.z; ik[4 * c + 3] = f.w; } }
                float score = 0.f;
#pragma unroll
                for (int h = 0; h < 8; ++h) { float ds = 0.f;
#pragma unroll
                    for (int c = 0; c < 8; ++c) { const f32x4 qv = *(const LAS f32x4*)(xq + h * 32 + 4 * c); ds += (qv.x * ik[4 * c] + qv.y * ik[4 * c + 1]) + (qv.z * ik[4 * c + 2] + qv.w * ik[4 * c + 3]); }
                    score += xq[256 + h] * fmaxf(ds, 0.f); }
                sc[key] = score * 0.0625f + 0.0f;
            }
        }
        LDS_WAIT(); asm volatile("" ::: "memory");
        int nsel = n;
        if (n > 256) {
            unsigned prefix = 0u, pmask = 0u; int kk = 256;
            for (int pass = 0; pass < 4; ++pass) {
                const int shift = 24 - 8 * pass;
#pragma unroll
                for (int k = 0; k < 4; ++k) hist[lane + 64 * k] = 0u;
                LDS_WAIT(); asm volatile("" ::: "memory");
                for (int k0 = 0; k0 < n; k0 += 64) { const int key = k0 + lane;
                    if (key < n) { const unsigned u = fkey(sc[key]); if ((u & pmask) == prefix) __hip_atomic_fetch_add(hist + ((u >> shift) & 255u), 1u, __ATOMIC_RELAXED, __HIP_MEMORY_SCOPE_WORKGROUP); } }
                LDS_WAIT(); asm volatile("" ::: "memory");
                const int h0 = (int)hist[4 * lane], h1 = (int)hist[4 * lane + 1], h2 = (int)hist[4 * lane + 2], h3 = (int)hist[4 * lane + 3];
                const int tot = (h0 + h1) + (h2 + h3); int incl = tot;
#pragma unroll
                for (int o = 1; o < 64; o <<= 1) { const int v = __shfl_down(incl, o); if (lane + o < 64) incl += v; }
                int run = incl - tot, found = -1, newk = 0;
                if (run < kk && run + h3 >= kk) { found = 4 * lane + 3; newk = kk - run; } run += h3;
                if (found < 0 && run < kk && run + h2 >= kk) { found = 4 * lane + 2; newk = kk - run; } run += h2;
                if (found < 0 && run < kk && run + h1 >= kk) { found = 4 * lane + 1; newk = kk - run; } run += h1;
                if (found < 0 && run < kk && run + h0 >= kk) { found = 4 * lane; newk = kk - run; }
                const unsigned long long ball = __ballot(found >= 0); const int src = __ffsll((long long)ball) - 1;
                const int bin = __shfl(found, src); kk = __shfl(newk, src);
                prefix |= (unsigned)bin << shift; pmask |= 255u << shift;
                LDS_WAIT(); asm volatile("" ::: "memory");
            }
            int eqseen = 0, cnt = 0;
            for (int k0 = 0; k0 < n; k0 += 64) { const int key = k0 + lane; const bool inb = key < n; const unsigned u = inb ? fkey(sc[key]) : 0u;
                const bool gt = inb && u > prefix, eq = inb && u == prefix;
                const unsigned long long be = __ballot(eq); const bool sel = gt || (eq && (eqseen + mbcnt64(be)) < kk);
                const unsigned long long bs = __ballot(sel); if (sel) idx[cnt + mbcnt64(bs)] = (unsigned short)key;
#ifdef FLASH_DSA
                if (lane == 0) ((unsigned long long*)(F.ws + WS_DSAMASK))[(size_t)row * 64 + (k0 >> 6)] = bs;
#endif
                eqseen += __popcll(be); cnt += __popcll(bs); }
            nsel = cnt;
            LDS_WAIT(); asm volatile("" ::: "memory");
        }
#ifdef FLASH_DSA
        if (n <= 256) { for (int k0 = 0; k0 < n; k0 += 64) if (lane == 0) ((unsigned long long*)(F.ws + WS_DSAMASK))[(size_t)row * 64 + (k0 >> 6)] = causal_word(t - k0); }
        continue;
#endif
        int kidx[4];
#pragma unroll
        for (int k = 0; k < 4; ++k) { const int p = lane + 64 * k; kidx[k] = p < nsel ? base + (n > 256 ? (int)idx[p] : p) : -1; }
        LDS_WAIT(); asm volatile("" ::: "memory");
#pragma unroll 1
        for (int h = 0; h < 4; ++h) {
            LDS_WAIT(); asm volatile("" ::: "memory");
            xq[lane] = bf2f(QD[(size_t)row * 256 + h * 64 + lane]);
            LDS_WAIT(); asm volatile("" ::: "memory");
            KVbf kd{(const bf16*)(F.ws + WS_KD), (const bf16*)(F.ws + WS_VD), 64, 64};
            auto keyf = [&](int s) { return s == 0 ? kidx[0] : s == 1 ? kidx[1] : s == 2 ? kidx[2] : kidx[3]; };
            const float r = wave_attend<64>(xq, 0.125f, 4, keyf, kd, lane);
            Y[(size_t)row * 1024 + 768 + h * 64 + lane] = (bf16)f2bf(r);
        }
        LDS_WAIT(); asm volatile("" ::: "memory");
    }
}
typedef float f32x16 __attribute__((ext_vector_type(16)));
__device__ __forceinline__ float xhalf_max(float v) { const auto rr = __builtin_amdgcn_permlane32_swap(__float_as_uint(v), __float_as_uint(v), false, false); return fmaxf(__uint_as_float(rr[0]), __uint_as_float(rr[1])); }
__device__ __forceinline__ float xhalf_sum(float v) { const auto rr = __builtin_amdgcn_permlane32_swap(__float_as_uint(v), __float_as_uint(v), false, false); return __uint_as_float(rr[0]) + __uint_as_float(rr[1]); }
__device__ __forceinline__ float xhalf_other(float v, int hh) { const auto rr = __builtin_amdgcn_permlane32_swap(__float_as_uint(v), __float_as_uint(v), false, false); return __uint_as_float(hh ? rr[0] : rr[1]); }
constexpr int FL_KP96 = 208, FL_KP64 = 144, FL_VP = 144;
constexpr int FL_KBUF = 0, FL_KBUF_SZ = 64 * FL_KP96, FL_VBUF = 2 * FL_KBUF_SZ, FL_VBUF_SZ = 64 * FL_VP;
constexpr int FL_TL = FL_VBUF + 2 * FL_VBUF_SZ, FL_TLN = FL_TL + 64, FL_ORM = FL_TLN + 8, FL_SEL = FL_TL + 128;
constexpr int FL_END = FL_SEL + 512;
static_assert(FL_END <= RING_BYTES, "flash LDS map");
struct FlashKV { const bf16* K; const bf16* V; int kp, vp; };


template <int MODE>
__device__ __forceinline__ void fl_softmax(f32x16& p0, f32x16& p1, const unsigned long long word, const int h, const float sc2, float& m, float& lsum, f32x16& o0, f32x16& o1) {
    if (MODE == 2) {
        const unsigned wlo = (unsigned)word >> (4 * h), whi = (unsigned)(word >> 32) >> (4 * h);
#pragma unroll
        for (int i = 0; i < 16; ++i) { const int bit = (i & 3) + 8 * (i >> 2);
            p0[i] = (wlo & (1u << bit)) ? p0[i] : -INFINITY; p1[i] = (whi & (1u << bit)) ? p1[i] : -INFINITY; }
    }
    float mx, mx2;
    asm("v_max3_f32 %0, %1, %2, %3" : "=v"(mx) : "v"(p0[0]), "v"(p0[1]), "v"(p0[2]));
    asm("v_max3_f32 %0, %1, %2, %3" : "=v"(mx2) : "v"(p1[0]), "v"(p1[1]), "v"(p1[2]));
#pragma unroll
    for (int i = 3; i < 15; i += 2) { asm("v_max3_f32 %0, %1, %2, %3" : "=v"(mx) : "v"(mx), "v"(p0[i]), "v"(p0[i + 1])); asm("v_max3_f32 %0, %1, %2, %3" : "=v"(mx2) : "v"(mx2), "v"(p1[i]), "v"(p1[i + 1])); }
    asm("v_max3_f32 %0, %1, %2, %3" : "=v"(mx) : "v"(mx), "v"(p0[15]), "v"(p1[15]));
    asm("v_max_f32_e32 %0, %1, %2" : "=v"(mx) : "v"(mx), "v"(mx2));
    const bool rowon = (MODE != 1) || (word != 0ull);
    if (MODE == 1) mx = rowon ? mx : -INFINITY;
    mx = xhalf_max(mx);
    const float mn = fmaxf(m, mx * sc2);
    if (__any(mn > m)) { const float alpha = __builtin_amdgcn_exp2f(m - mn); lsum *= alpha;
#pragma unroll
        for (int i = 0; i < 16; ++i) { o0[i] *= alpha; o1[i] *= alpha; } }
    m = mn;
    const float nm = rowon ? -mn : -INFINITY;
    float ps = 0.f;
#pragma unroll
    for (int i = 0; i < 16; ++i) { p0[i] = __builtin_amdgcn_exp2f(__builtin_fmaf(p0[i], sc2, nm)); p1[i] = __builtin_amdgcn_exp2f(__builtin_fmaf(p1[i], sc2, nm)); ps += p0[i] + p1[i]; }
    lsum += ps;
}
template <int DQK, class MaskFn>
__device__ __forceinline__ void flash_unit(LAS unsigned char* lds, const FlashKV kv, const bf16* qrow, const float sc2  , const int ntiles,
                                           const MaskFn& maskf, f32x16& o0, f32x16& o1, float& lsum) {
    constexpr int KP = (DQK == 96) ? FL_KP96 : FL_KP64, NKS = DQK / 16, CPR = DQK / 8;
    const int tid = cur_tid(), lane = tid & 63, r = lane & 31, h = lane >> 5;
    const LAS unsigned char* tl = lds + FL_TL;
    bf16x8 qf[NKS];
#pragma unroll
    for (int ks = 0; ks < NKS; ++ks) qf[ks] = *(const GAS bf16x8*)(qrow + 16 * ks + 8 * h);
    const int kr0 = tid / CPR, kc0 = tid - kr0 * CPR;
    const int kr1 = (tid + 512) / CPR, kc1 = (tid + 512) - kr1 * CPR;
    const bool has2 = (DQK == 96) && (tid < 256);
    const int vr = tid >> 3, vc = tid & 7;
    struct StageRegs { v4u k0, k1, v; };
    StageRegs S0, S1; S0.k1 = (v4u){0u, 0u, 0u, 0u}; S1.k1 = (v4u){0u, 0u, 0u, 0u};
    auto gload = [&](StageRegs& S, int tile) {
        const size_t rowb = (size_t)tile * 64;
        S.k0 = *(const GAS v4u*)(kv.K + (rowb + kr0) * kv.kp + 8 * kc0);
        if (DQK == 96) S.k1 = *(const GAS v4u*)(kv.K + (rowb + (has2 ? kr1 : kr0)) * kv.kp + 8 * (has2 ? kc1 : kc0));
        S.v = *(const GAS v4u*)(kv.V + (rowb + vr) * kv.vp + 8 * vc);
    };
    auto lstore = [&](const StageRegs& S, int buf) {
        LAS unsigned char* Kb = lds + FL_KBUF + buf * FL_KBUF_SZ; LAS unsigned char* Vb = lds + FL_VBUF + buf * FL_VBUF_SZ;
        *(LAS v4u*)(Kb + kr0 * KP + 16 * kc0) = S.k0;
        if (has2) *(LAS v4u*)(Kb + kr1 * KP + 16 * kc1) = S.k1;
        *(LAS v4u*)(Vb + vr * FL_VP + 16 * vc) = S.v;
    };
    float m = -1e30f; lsum = 0.f;
    __syncthreads();
#pragma unroll
    for (int i = 0; i < 16; ++i) { o0[i] = 0.f; o1[i] = 0.f; }
    unsigned long long wnext = 0ull;
    if (ntiles > 0) { wnext = maskf((int)tl[0]); gload(S0, (int)tl[0]); lstore(S0, 0); }
    if (ntiles > 0) gload(S1, (int)tl[ntiles > 1 ? 1 : 0]);
#pragma unroll
    for (int ks = 0; ks < NKS; ++ks) asm volatile("" :: "v"(qf[ks]));
    __syncthreads();
    auto step = [&](const int it, StageRegs& Sload, const StageRegs& Sstore) __attribute__((always_inline)) {
        const int cur = it & 1;
        const unsigned long long word = wnext;
        wnext = maskf((int)tl[it + 1 < ntiles ? it + 1 : ntiles - 1]);
        gload(Sload, (int)tl[it + 2 < ntiles ? it + 2 : ntiles - 1]);
        if (!__all(word == 0ull)) {
            const LAS unsigned char* Kb = lds + FL_KBUF + cur * FL_KBUF_SZ; const LAS unsigned char* Vb = lds + FL_VBUF + cur * FL_VBUF_SZ;
            f32x16 p0, p1;
#pragma unroll
            for (int i = 0; i < 16; ++i) { p0[i] = 0.f; p1[i] = 0.f; }
#pragma unroll
            for (int ks = 0; ks < NKS; ++ks) {
                const bf16x8 a0 = *(const LAS bf16x8*)(Kb + r * KP + (16 * ks + 8 * h) * 2), a1 = *(const LAS bf16x8*)(Kb + (32 + r) * KP + (16 * ks + 8 * h) * 2);
                p0 = __builtin_amdgcn_mfma_f32_32x32x16_bf16(a0, qf[ks], p0, 0, 0, 0);
                p1 = __builtin_amdgcn_mfma_f32_32x32x16_bf16(a1, qf[ks], p1, 0, 0, 0);
            }
            if (__all(word == ~0ull)) fl_softmax<0>(p0, p1, word, h, sc2, m, lsum, o0, o1);
            else if (__all(word == ~0ull || word == 0ull)) fl_softmax<1>(p0, p1, word, h, sc2, m, lsum, o0, o1);
            else fl_softmax<2>(p0, p1, word, h, sc2, m, lsum, o0, o1);
            bf16x8 pf[4];
#pragma unroll
            for (int s = 0; s < 4; ++s) { v4u w;
                if (s < 2) { w.x = pg8::cvt_pk_bf16(p0[8 * s], p0[8 * s + 1]); w.y = pg8::cvt_pk_bf16(p0[8 * s + 2], p0[8 * s + 3]); w.z = pg8::cvt_pk_bf16(p0[8 * s + 4], p0[8 * s + 5]); w.w = pg8::cvt_pk_bf16(p0[8 * s + 6], p0[8 * s + 7]); }
                else { const int s2 = s - 2; w.x = pg8::cvt_pk_bf16(p1[8 * s2], p1[8 * s2 + 1]); w.y = pg8::cvt_pk_bf16(p1[8 * s2 + 2], p1[8 * s2 + 3]); w.z = pg8::cvt_pk_bf16(p1[8 * s2 + 4], p1[8 * s2 + 5]); w.w = pg8::cvt_pk_bf16(p1[8 * s2 + 6], p1[8 * s2 + 7]); }
                pf[s] = __builtin_bit_cast(bf16x8, w); }
            {
                typedef short v4i16_t __attribute__((ext_vector_type(4)));
                const LAS unsigned char* vbase = Vb + (4 * h + ((lane & 15) >> 2)) * FL_VP + (16 * ((lane >> 4) & 1) + 4 * (lane & 3)) * 2;
#pragma unroll
                for (int s = 0; s < 4; ++s) {
#pragma unroll
                    for (int db = 0; db < 2; ++db) {
                        const LAS unsigned char* vp_ = vbase + (32 * (s >> 1) + 16 * (s & 1)) * FL_VP + 64 * db;
                        const v4i16_t lo = __builtin_amdgcn_ds_read_tr16_b64_v4i16((LAS v4i16_t*)vp_), hi = __builtin_amdgcn_ds_read_tr16_b64_v4i16((LAS v4i16_t*)(vp_ + 8 * FL_VP));
                        const bf16x8 a = {lo[0], lo[1], lo[2], lo[3], hi[0], hi[1], hi[2], hi[3]};
                        if (db == 0) o0 = __builtin_amdgcn_mfma_f32_32x32x16_bf16(a, pf[s], o0, 0, 0, 0);
                        else o1 = __builtin_amdgcn_mfma_f32_32x32x16_bf16(a, pf[s], o1, 0, 0, 0);
                    }
                }
            }
        }
        if (it + 1 < ntiles) lstore(Sstore, cur ^ 1);
        __syncthreads();
    };
    for (int it = 0; it < ntiles; it += 2) { step(it, S0, S1); if (it + 1 < ntiles) step(it + 1, S1, S0); }
}
__device__ __forceinline__ void flash_store(bf16* yrow  , const f32x16& o0, const f32x16& o1, float inv, int h) {
#pragma unroll
    for (int g = 0; g < 4; ++g) {
        typedef unsigned u32x2v __attribute__((ext_vector_type(2)));
        u32x2v w0, w1;
        w0.x = pg8::cvt_pk_bf16(o0[4 * g] * inv, o0[4 * g + 1] * inv); w0.y = pg8::cvt_pk_bf16(o0[4 * g + 2] * inv, o0[4 * g + 3] * inv);
        w1.x = pg8::cvt_pk_bf16(o1[4 * g] * inv, o1[4 * g + 1] * inv); w1.y = pg8::cvt_pk_bf16(o1[4 * g + 2] * inv, o1[4 * g + 3] * inv);
        *(u32x2v*)(yrow + 8 * g + 4 * h) = w0; *(u32x2v*)(yrow + 32 + 8 * g + 4 * h) = w1;
    }
}

__device__ __forceinline__ void mla_flash_phase(Frame& F) {
    const int tid = cur_tid(), wave = cur_wave(), lane = tid & 63, r = lane & 31, h2 = lane >> 5;
    bf16* Y = (bf16*)F.out + (size_t)M * D;
    for (int pass = 0; pass < 2; ++pass) {
        for (int u0 = blockIdx.x; u0 < 256; u0 += F.G) {
            const int u = pass ? 511 - u0 : u0, qb = u >> 5, bh = u & 31, b = bh >> 2, hd = bh & 3;
            const int t = 256 * qb + 32 * wave + r; const size_t row = (size_t)b * T + t;
            LAS unsigned char* tl = F.lds + FL_TL;
            if (tid < 64) tl[tid] = (unsigned char)tid;
            const int ntiles = 4 * qb + 4;
            FlashKV kv{(const bf16*)(F.ws + WS_KMLA) + (size_t)b * T * 384 + hd * 96, (const bf16*)(F.ws + WS_VMLA) + (size_t)b * T * 256 + hd * 64, 384, 256};
            auto maskf = [&](int tile) { return causal_word(t - 64 * tile); };
            f32x16 o0, o1; float ls;
            flash_unit<96>(F.lds, kv, (const bf16*)(F.ws + WS_QMLA) + row * 384 + hd * 96, 0.10206207261596577f * 1.4426950408889634f, ntiles, maskf, o0, o1, ls);
            ls = xhalf_sum(ls);
            flash_store(Y + row * 1024 + 256 + hd * 64, o0, o1, ls > 0.f ? 1.0f / ls : 0.f, h2);
        }
    }
}

__device__ __forceinline__ void moba_flash_phase(Frame& F) {
    const int tid = cur_tid(), wave = cur_wave(), lane = tid & 63, r = lane & 31, h2 = lane >> 5;
    bf16* Y = (bf16*)F.out + (size_t)M * D;
    const float* QF = (const float*)(F.ws + WS_QM_F); const float* kmean = (const float*)(F.ws + WS_KMEAN);
    LAS unsigned short* msel = (LAS unsigned short*)(F.lds + FL_SEL); LAS unsigned* orm = (LAS unsigned*)(F.lds + FL_ORM); LAS unsigned char* tl = F.lds + FL_TL; LAS int* tln = (LAS int*)(F.lds + FL_TLN);
    for (int pass = 0; pass < 2; ++pass) {
        for (int u0 = blockIdx.x; u0 < 256; u0 += F.G) {
            const int u = pass ? 511 - u0 : u0, own = u >> 5, bh = u & 31, b = bh >> 2, hd = bh & 3;
            if (tid == 0) orm[0] = 0u;
            __syncthreads();
            if (tid < 256) {
                const float* qp = QF + ((size_t)b * T + 256 * own + tid) * 256 + hd * 64;
                const float* km = kmean + (size_t)((b * 4 + hd) * 16) * 64;
                f32x4 qv[16];
#pragma unroll
                for (int c = 0; c < 16; ++c) qv[c] = *(const f32x4*)(qp + 4 * c);
                float g[15];
#pragma unroll
                for (int j = 0; j < 15; ++j) { g[j] = 0.f;
                    if (j < own) { float a = 0.f;
#pragma unroll
                        for (int c = 0; c < 16; ++c) { const f32x4 kv4 = *(const f32x4*)(km + j * 64 + 4 * c); a += (qv[c].x * kv4.x + qv[c].y * kv4.y) + (qv[c].z * kv4.z + qv[c].w * kv4.w); }
                        g[j] = a; } }
                unsigned sel = 0u;
#pragma unroll
                for (int rr = 0; rr < 3; ++rr) { float best = -INFINITY; int bi = -1;
#pragma unroll
                    for (int j = 0; j < 15; ++j) if (j < own && !((sel >> j) & 1u) && g[j] > best) { best = g[j]; bi = j; }
                    if (bi >= 0) sel |= 1u << bi; }
                msel[tid] = (unsigned short)sel;
                __hip_atomic_fetch_or(orm, sel, __ATOMIC_RELAXED, __HIP_MEMORY_SCOPE_WORKGROUP);
            }
            __syncthreads();
            if (tid == 0) { const unsigned om = orm[0]; int n = 0;
                for (int j = 0; j < own; ++j) if ((om >> j) & 1u) { for (int q4 = 0; q4 < 4; ++q4) tl[n++] = (unsigned char)(4 * j + q4); }
                for (int q4 = 0; q4 < 4; ++q4) tl[n++] = (unsigned char)(4 * own + q4);
                tln[0] = n; }
            __syncthreads();
            const int ntiles = tln[0];
            const int tq = 32 * wave + r, t = 256 * own + tq; const size_t row = (size_t)b * T + t;
            const unsigned mysel = msel[tq];
            FlashKV kv{(const bf16*)(F.ws + WS_KM_BF) + (size_t)b * T * 256 + hd * 64, (const bf16*)(F.ws + WS_VM_BF) + (size_t)b * T * 256 + hd * 64, 256, 256};
            auto maskf = [&](int tile) { const int blk = tile >> 2; return blk == own ? causal_word(t - 64 * tile) : (((mysel >> blk) & 1u) ? ~0ull : 0ull); };
            f32x16 o0, o1; float ls;
            flash_unit<64>(F.lds, kv, (const bf16*)(F.ws + WS_QM_BF) + row * 256 + hd * 64, 0.125f * 1.4426950408889634f, ntiles, maskf, o0, o1, ls);
            ls = xhalf_sum(ls);
            flash_store(Y + row * 1024 + hd * 64, o0, o1, ls > 0.f ? 1.0f / ls : 0.f, h2);
        }
    }
}
__device__ __forceinline__ void dsa_flash_phase(Frame& F) {
    const int tid = cur_tid(), wave = cur_wave(), lane = tid & 63, r = lane & 31, h2 = lane >> 5;
    bf16* Y = (bf16*)F.out + (size_t)M * D;
    const unsigned long long* BM = (const unsigned long long*)(F.ws + WS_DSAMASK);
    for (int pass = 0; pass < 2; ++pass) {
        for (int u0 = blockIdx.x; u0 < 256; u0 += F.G) {
            const int u = pass ? 511 - u0 : u0, tb = u >> 3, b = u & 7, hd = wave >> 1;
            const int t = 64 * tb + 32 * (wave & 1) + r; const size_t row = (size_t)b * T + t;
            LAS unsigned char* tl = F.lds + FL_TL;
            __syncthreads();
            if (tid < 64) tl[tid] = (unsigned char)tid;
            const int ntiles = tb + 1;
            FlashKV kv{(const bf16*)(F.ws + WS_KD) + (size_t)b * T * 64, (const bf16*)(F.ws + WS_VD) + (size_t)b * T * 64, 64, 64};
            const unsigned long long* bmrow = BM + row * 64;
            auto maskf = [&](int tile) { return bmrow[tile]; };
            f32x16 o0, o1; float ls;
            flash_unit<64>(F.lds, kv, (const bf16*)(F.ws + WS_QD) + row * 256 + hd * 64, 0.125f * 1.4426950408889634f, ntiles, maskf, o0, o1, ls);
            ls = xhalf_sum(ls);
            flash_store(Y + row * 1024 + 768 + hd * 64, o0, o1, ls > 0.f ? 1.0f / ls : 0.f, h2);
        }
    }
}
__device__ __forceinline__ void nsa_flash_phase(Frame& F) {
    const int tid = cur_tid(), wave = cur_wave(), lane = tid & 63, r = lane & 31, h2 = lane >> 5;
    bf16* Y = (bf16*)F.out + (size_t)M * D;
    const unsigned long long* NSEL = (const unsigned long long*)(F.ws + WS_NSEL); const bf16* OC = (const bf16*)(F.ws + WS_OC); const float* GWp = (const float*)(F.ws + WS_GW);
    LAS unsigned* orm = (LAS unsigned*)(F.lds + FL_ORM); LAS unsigned char* tl = F.lds + FL_TL; LAS int* tln = (LAS int*)(F.lds + FL_TLN);
    for (int pass = 0; pass < 2; ++pass) {
        for (int u0 = blockIdx.x; u0 < 256; u0 += F.G) {
            const int u = pass ? 511 - u0 : u0, tb = u >> 3, b = u & 7, hd = wave >> 1;
            const int t = 64 * tb + 32 * (wave & 1) + r; const size_t row = (size_t)b * T + t;
            const unsigned long long mysel = NSEL[row];
            __syncthreads();
            if (tid < 2) orm[tid] = 0u;
            __syncthreads();
            if (wave < 2) { __hip_atomic_fetch_or(orm, (unsigned)mysel, __ATOMIC_RELAXED, __HIP_MEMORY_SCOPE_WORKGROUP); __hip_atomic_fetch_or(orm + 1, (unsigned)(mysel >> 32), __ATOMIC_RELAXED, __HIP_MEMORY_SCOPE_WORKGROUP); }
            __syncthreads();
            if (tid == 0) { const unsigned long long om = (unsigned long long)orm[0] | ((unsigned long long)orm[1] << 32); int n = 0;
                for (int j = 0; j <= tb; ++j) if ((om >> j) & 1ull) tl[n++] = (unsigned char)j;
                tln[0] = n; }
            __syncthreads();
            const int nsel_tiles = tln[0];
            const bf16* qrow = (const bf16*)(F.ws + WS_QN) + row * 256 + hd * 64;
            const float* gp = GWp + row * 32 + hd * 3;
            const float g0 = sigmoid_f(gp[0]), g1 = sigmoid_f(gp[1]), g2 = sigmoid_f(gp[2]);
            LAS float* stash = (LAS float*)(F.lds + 49152) + wave * 2048 + lane;
            {
                FlashKV kv{(const bf16*)(F.ws + WS_KS) + (size_t)b * T * 64, (const bf16*)(F.ws + WS_VS) + (size_t)b * T * 64, 64, 64};
                auto maskf = [&](int tile) { return ((mysel >> tile) & 1ull) ? causal_word(t - 64 * tile) : 0ull; };
                f32x16 o0, o1; float ls;
                flash_unit<64>(F.lds, kv, qrow, 0.125f * 1.4426950408889634f, nsel_tiles, maskf, o0, o1, ls);
                ls = xhalf_sum(ls); const float sc = ls > 0.f ? g1 / ls : 0.f;
                const bf16* ocr = OC + row * 256 + hd * 64;
#pragma unroll
                for (int g = 0; g < 4; ++g) { const unsigned long long w0 = *(const unsigned long long*)(ocr + 8 * g + 4 * h2), w1 = *(const unsigned long long*)(ocr + 32 + 8 * g + 4 * h2);
                    stash[(4 * g) * 64] = sc * o0[4 * g] + g0 * __uint_as_float((unsigned)w0 << 16); stash[(4 * g + 1) * 64] = sc * o0[4 * g + 1] + g0 * __uint_as_float((unsigned)w0 & 0xffff0000u);
                    stash[(4 * g + 2) * 64] = sc * o0[4 * g + 2] + g0 * __uint_as_float((unsigned)(w0 >> 32) << 16); stash[(4 * g + 3) * 64] = sc * o0[4 * g + 3] + g0 * __uint_as_float((unsigned)(w0 >> 32) & 0xffff0000u);
                    stash[(16 + 4 * g) * 64] = sc * o1[4 * g] + g0 * __uint_as_float((unsigned)w1 << 16); stash[(16 + 4 * g + 1) * 64] = sc * o1[4 * g + 1] + g0 * __uint_as_float((unsigned)w1 & 0xffff0000u);
                    stash[(16 + 4 * g + 2) * 64] = sc * o1[4 * g + 2] + g0 * __uint_as_float((unsigned)(w1 >> 32) << 16); stash[(16 + 4 * g + 3) * 64] = sc * o1[4 * g + 3] + g0 * __uint_as_float((unsigned)(w1 >> 32) & 0xffff0000u); }
            }
            f32x16 a0, a1;
            {
                __syncthreads();
                const int t0 = tb >= 8 ? tb - 8 : 0;
                if (tid < 64) tl[tid] = (unsigned char)(t0 + tid);
                FlashKV kv{(const bf16*)(F.ws + WS_KW) + (size_t)b * T * 64, (const bf16*)(F.ws + WS_VW) + (size_t)b * T * 64, 64, 64};
                auto maskf = [&](int tile) { return causal_word(t - 64 * tile) & ~causal_word(t - 512 - 64 * tile); };
                f32x16 o0, o1; float ls;
                flash_unit<64>(F.lds, kv, qrow, 0.125f * 1.4426950408889634f, tb - t0 + 1, maskf, o0, o1, ls);
                ls = xhalf_sum(ls); const float sc = ls > 0.f ? g2 / ls : 0.f;
#pragma unroll
                for (int i = 0; i < 16; ++i) { a0[i] = sc * o0[i] + stash[i * 64]; a1[i] = sc * o1[i] + stash[(16 + i) * 64]; }
            }
            flash_store(Y + row * 1024 + 512 + hd * 64, a0, a1, 1.0f, h2);
        }
    }
}

__device__ __forceinline__ int hist_pick(LAS unsigned* hist, int& kk, const int lane) {
    const int h0 = (int)hist[4 * lane], h1 = (int)hist[4 * lane + 1], h2 = (int)hist[4 * lane + 2], h3 = (int)hist[4 * lane + 3];
    const int tot = (h0 + h1) + (h2 + h3); int incl = tot;
#pragma unroll
    for (int o = 1; o < 64; o <<= 1) { const int v = __shfl_down(incl, o); if (lane + o < 64) incl += v; }
    int run = incl - tot, found = -1, newk = 0;
    if (run < kk && run + h3 >= kk) { found = 4 * lane + 3; newk = kk - run; } run += h3;
    if (found < 0 && run < kk && run + h2 >= kk) { found = 4 * lane + 2; newk = kk - run; } run += h2;
    if (found < 0 && run < kk && run + h1 >= kk) { found = 4 * lane + 1; newk = kk - run; } run += h1;
    if (found < 0 && run < kk && run + h0 >= kk) { found = 4 * lane; newk = kk - run; }
    const unsigned long long ball = __ballot(found >= 0); const int src = __ffsll((long long)ball) - 1;
    const int bin = __shfl(found, src); kk = __shfl(newk, src);
    return bin;
}
__device__ __forceinline__ float unfkey(unsigned u) { return __uint_as_float((u & 0x80000000u) ? (u ^ 0x80000000u) : ~u); }
__device__ __forceinline__ void radix_select_write(LAS float* sc, LAS unsigned* hist, unsigned long long* bmrow, const int t, const int lane) {
    const int n = t + 1;
    if (n <= 256) { for (int k0 = 0; k0 < n; k0 += 64) if (lane == 0) bmrow[k0 >> 6] = causal_word(t - k0); return; }
#define RS_LOAD4(k0) float x_[4]; { _Pragma("unroll") for (int j_ = 0; j_ < 4; ++j_) { const float v_ = sc[(k0) + 64 * j_ + lane]; x_[j_] = (lane < n - (k0) - 64 * j_) ? v_ : -INFINITY; } }
    float mn = INFINITY, mx = -INFINITY;
    for (int k0 = 0; k0 < n; k0 += 256) { RS_LOAD4(k0);
#pragma unroll
        for (int j = 0; j < 4; ++j) { mx = fmaxf(mx, x_[j]); mn = fminf(mn, x_[j] > -INFINITY ? x_[j] : INFINITY); } }
    mn = -wave_max(-mn); mx = wave_max(mx);
    const float qs = mx > mn ? 255.99f / (mx - mn) : 1.0f, qo = -mn * qs;
#pragma unroll
    for (int k = 0; k < 4; ++k) hist[lane + 64 * k] = 0u;
    LDS_WAIT(); asm volatile("" ::: "memory");
#ifdef SEL_DUP_HIST
    for (int rep3_ = 0; rep3_ < 2; ++rep3_) {
#pragma unroll
    for (int k = 0; k < 4; ++k) hist[lane + 64 * k] = 0u;
    LDS_WAIT(); asm volatile("" ::: "memory");
#endif
    for (int k0 = 0; k0 < n; k0 += 256) { RS_LOAD4(k0);
#pragma unroll
        for (int j = 0; j < 4; ++j) { int q = (int)__builtin_fmaf(x_[j], qs, qo); q = q > 255 ? 255 : (q < 0 ? 0 : q); __hip_atomic_fetch_add(hist + q, 1u, __ATOMIC_RELAXED, __HIP_MEMORY_SCOPE_WORKGROUP); } }
    LDS_WAIT(); asm volatile("" ::: "memory");
#ifdef SEL_DUP_HIST
    }
#endif
    int kk = 256;
    const int B = hist_pick(hist, kk, lane);
    const int cntB = (int)hist[B];
    LDS_WAIT(); asm volatile("" ::: "memory");
#ifdef FORCE_FALLBACK
    if (cntB > 0) {
#else
    if (cntB > 128) {
#endif
        unsigned prefix = 0u, pmask = 0u;
#pragma unroll 1
        for (int pass = 0; pass < 4; ++pass) {
            const int shift = 24 - 8 * pass;
#pragma unroll
            for (int k = 0; k < 4; ++k) hist[lane + 64 * k] = 0u;
            LDS_WAIT(); asm volatile("" ::: "memory");
            for (int k0 = 0; k0 < n; k0 += 256) { RS_LOAD4(k0);
#pragma unroll
                for (int j = 0; j < 4; ++j) { int q = (int)__builtin_fmaf(x_[j], qs, qo); q = q > 255 ? 255 : (q < 0 ? 0 : q);
                    if (q == B) { const unsigned u = fkey(x_[j]); if ((u & pmask) == prefix) __hip_atomic_fetch_add(hist + ((u >> shift) & 255u), 1u, __ATOMIC_RELAXED, __HIP_MEMORY_SCOPE_WORKGROUP); } } }
            LDS_WAIT(); asm volatile("" ::: "memory");
            const int bin = hist_pick(hist, kk, lane);
            prefix |= (unsigned)bin << shift; pmask |= 255u << shift;
            LDS_WAIT(); asm volatile("" ::: "memory");
        }
        int eqseen = 0;
        for (int k0 = 0; k0 < n; k0 += 256) { RS_LOAD4(k0);
#pragma unroll
            for (int j = 0; j < 4; ++j) { int q = (int)__builtin_fmaf(x_[j], qs, qo); q = q > 255 ? 255 : (q < 0 ? 0 : q);
                const unsigned u = fkey(x_[j]); const bool valid = x_[j] > -INFINITY;
                const bool gt = valid && (q > B || (q == B && u > prefix)), eq = valid && q == B && u == prefix;
                const unsigned long long be = __ballot(eq); const bool sel = gt || (eq && (eqseen + mbcnt64(be)) < kk);
                const unsigned long long bs = __ballot(sel);
                if (lane == 0 && k0 + 64 * j < n) bmrow[(k0 >> 6) + j] = bs;
                eqseen += __popcll(be); } }
        return;
    }
    LAS unsigned* bmw = hist + 256;
    LAS unsigned* cand = (LAS unsigned*)sc;
    int ncand = 0;
    for (int k0 = 0; k0 < n; k0 += 256) { RS_LOAD4(k0);
        asm volatile("" ::: "memory");
#pragma unroll
        for (int j = 0; j < 4; ++j) { int q = (int)__builtin_fmaf(x_[j], qs, qo); q = q > 255 ? 255 : (q < 0 ? 0 : q);
            const bool valid = x_[j] > -INFINITY; const bool gt = valid && q > B, inb = valid && q == B;
            const unsigned long long bg = __ballot(gt), bi = __ballot(inb);
            if (lane == 0) { bmw[2 * ((k0 >> 6) + j)] = (unsigned)bg; bmw[2 * ((k0 >> 6) + j) + 1] = (unsigned)(bg >> 32); }
            if (inb) { const int c = ncand + mbcnt64(bi); cand[2 * c] = (unsigned)(k0 + 64 * j + lane); cand[2 * c + 1] = fkey(x_[j]); }
            ncand += __popcll(bi); }
        LDS_WAIT(); asm volatile("" ::: "memory"); }
#undef RS_LOAD4
    {
        const int c0 = lane, c1 = lane + 64;
        const unsigned k0_ = c0 < ncand ? cand[2 * c0 + 1] : 0u, k1_ = c1 < ncand ? cand[2 * c1 + 1] : 0u;
        const unsigned i0_ = c0 < ncand ? cand[2 * c0] : 0u, i1_ = c1 < ncand ? cand[2 * c1] : 0u;
        int r0 = 0, r1 = 0;
#ifdef SEL_DUP_RANK
        for (int rep3_ = 0; rep3_ < 2; ++rep3_) { r0 = 0; r1 = 0;
#endif
        for (int j = 0; j < ncand; ++j) { const unsigned kj = cand[2 * j + 1];
            r0 += (kj > k0_ || (kj == k0_ && j < c0)) ? 1 : 0; r1 += (kj > k1_ || (kj == k1_ && j < c1)) ? 1 : 0; }
#ifdef SEL_DUP_RANK
        asm volatile("" : "+v"(r0), "+v"(r1)); }
#endif
        if (c0 < ncand && r0 < kk) __hip_atomic_fetch_or(bmw + 2 * (i0_ >> 6) + ((i0_ >> 5) & 1u), 1u << (i0_ & 31u), __ATOMIC_RELAXED, __HIP_MEMORY_SCOPE_WORKGROUP);
        if (c1 < ncand && r1 < kk) __hip_atomic_fetch_or(bmw + 2 * (i1_ >> 6) + ((i1_ >> 5) & 1u), 1u << (i1_ & 31u), __ATOMIC_RELAXED, __HIP_MEMORY_SCOPE_WORKGROUP);
    }
    LDS_WAIT(); asm volatile("" ::: "memory");
    if (lane < ((n + 63) >> 6)) bmrow[lane] = (unsigned long long)bmw[2 * lane] | ((unsigned long long)bmw[2 * lane + 1] << 32);
    LDS_WAIT(); asm volatile("" ::: "memory");
}
__device__ __forceinline__ void split8(const f32x4 a, const f32x4 b, bf16x8& hi, bf16x8& lo) {
    v4u h, l;
    h.x = pg8::cvt_pk_bf16(a.x, a.y); h.y = pg8::cvt_pk_bf16(a.z, a.w); h.z = pg8::cvt_pk_bf16(b.x, b.y); h.w = pg8::cvt_pk_bf16(b.z, b.w);
    l.x = pg8::cvt_pk_bf16(a.x - __uint_as_float(h.x << 16), a.y - __uint_as_float(h.x & 0xffff0000u)); l.y = pg8::cvt_pk_bf16(a.z - __uint_as_float(h.y << 16), a.w - __uint_as_float(h.y & 0xffff0000u));
    l.z = pg8::cvt_pk_bf16(b.x - __uint_as_float(h.z << 16), b.y - __uint_as_float(h.z & 0xffff0000u)); l.w = pg8::cvt_pk_bf16(b.z - __uint_as_float(h.w << 16), b.w - __uint_as_float(h.w & 0xffff0000u));
    hi = __builtin_bit_cast(bf16x8, h); lo = __builtin_bit_cast(bf16x8, l);
}
__device__ __forceinline__ void dsa_select_phase(Frame& F) {
    const int tid = cur_tid(), wave = cur_wave(), lane = tid & 63, r = lane & 31, hh = lane >> 5;
    const bf16* IQ = (const bf16*)(F.ws + WS_IQ); const bf16* IK = (const bf16*)(F.ws + WS_IK); const float* GWp = (const float*)(F.ws + WS_GW);
    LAS float* sc = (LAS float*)(F.lds + RING_OFF);
    LAS unsigned* hist = (LAS unsigned*)(F.lds + XTRA_OFF + wave * XTRA_WAVE);
    bf16x8 araw[2][2]; f32x4 wraw[2][4];
    auto load_a = [&](int pass_, int u0_) {
        const int b_ = u0_ >> 8, w8_ = u0_ & 255, tb8_ = pass_ ? 511 - w8_ : w8_; const size_t rowb = (size_t)b_ * T + 8 * tb8_;
#pragma unroll
        for (int gq = 0; gq < 2; ++gq) {
            const bf16* qp = IQ + (rowb + 4 * gq + (r >> 3)) * 256 + (r & 7) * 32 + 8 * hh;
#pragma unroll
            for (int ks = 0; ks < 2; ++ks) araw[gq][ks] = *(const bf16x8*)(qp + 16 * ks);
#pragma unroll
            for (int tk = 0; tk < 4; ++tk) wraw[gq][tk] = *(const f32x4*)(GWp + (rowb + 4 * gq + tk) * 32 + 12 + 4 * hh);
        }
    };
    if ((int)blockIdx.x < 2048) load_a(0, (int)blockIdx.x);
    for (int pass = 0; pass < 2; ++pass) {
        for (int u0 = blockIdx.x; u0 < 2048; u0 += F.G) {
            const int b = u0 >> 8, w8 = u0 & 255, tb8 = pass ? 511 - w8 : w8, t0 = 8 * tb8, nmax = t0 + 8;
            const size_t base = (size_t)b * T;
            bf16x8 ahi[2][2]; float iw[2][4][4];
#pragma unroll
            for (int gq = 0; gq < 2; ++gq) {
#pragma unroll
                for (int ks = 0; ks < 2; ++ks) ahi[gq][ks] = araw[gq][ks];
#pragma unroll
                for (int tk = 0; tk < 4; ++tk) { const f32x4 w4 = wraw[gq][tk]; iw[gq][tk][0] = w4.x; iw[gq][tk][1] = w4.y; iw[gq][tk][2] = w4.z; iw[gq][tk][3] = w4.w; }
            }
            const int nkb = (nmax + 31) >> 5;
            bf16x8 nbA[2], nbB[2];
#define DS_LOADB(dst, kb_) do { const GAS bf16* kp_ = (const GAS bf16*)(IK + (base + 32 * (kb_) + r) * 32 + 8 * hh); dst[0] = *(const GAS bf16x8*)kp_; dst[1] = *(const GAS bf16x8*)(kp_ + 16); } while (0)
#ifdef DSA_DUP_SCORE
            for (int rep2_ = 0; rep2_ < 2; ++rep2_) {
#endif
            if (wave < nkb) DS_LOADB(nbA, wave);
            if (wave + 8 < nkb) DS_LOADB(nbB, wave + 8);
            for (int kb = wave; kb < nkb; kb += 16) {
                const bool hasB = kb + 8 < nkb;
                bf16x8 bhiA[2], bhiB[2];
                bhiA[0] = nbA[0]; bhiA[1] = nbA[1];
                if (hasB) { bhiB[0] = nbB[0]; bhiB[1] = nbB[1]; } else { bhiB[0] = bhiA[0]; bhiB[1] = bhiA[1]; }
                if (kb + 16 < nkb) DS_LOADB(nbA, kb + 16);
                if (kb + 24 < nkb) DS_LOADB(nbB, kb + 24);
                f32x16 cA0, cA1, cB0, cB1;
#pragma unroll
                for (int i = 0; i < 16; ++i) { cA0[i] = 0.f; cA1[i] = 0.f; cB0[i] = 0.f; cB1[i] = 0.f; }
#pragma unroll
                for (int ks = 0; ks < 2; ++ks) {
                    cA0 = __builtin_amdgcn_mfma_f32_32x32x16_bf16(ahi[0][ks], bhiA[ks], cA0, 0, 0, 0); cA1 = __builtin_amdgcn_mfma_f32_32x32x16_bf16(ahi[1][ks], bhiA[ks], cA1, 0, 0, 0);
                    cB0 = __builtin_amdgcn_mfma_f32_32x32x16_bf16(ahi[0][ks], bhiB[ks], cB0, 0, 0, 0); cB1 = __builtin_amdgcn_mfma_f32_32x32x16_bf16(ahi[1][ks], bhiB[ks], cB1, 0, 0, 0);
                }
#define DS_EPI(c, gq, kb_) do { float s4_[4]; _Pragma("unroll") for (int tk = 0; tk < 4; ++tk) { \
                        const float v_ = (iw[gq][tk][0] * fmaxf(c[4 * tk], 0.f) + iw[gq][tk][1] * fmaxf(c[4 * tk + 1], 0.f)) + (iw[gq][tk][2] * fmaxf(c[4 * tk + 2], 0.f) + iw[gq][tk][3] * fmaxf(c[4 * tk + 3], 0.f)); \
                        s4_[tk] = xhalf_sum(v_) * 0.0625f + 0.0f; } \
                    LAS float* dst_ = sc + (4 * (gq) + 2 * hh) * 4096 + 32 * (kb_) + r; dst_[0] = hh ? s4_[2] : s4_[0]; dst_[4096] = hh ? s4_[3] : s4_[1]; } while (0)
                DS_EPI(cA0, 0, kb); DS_EPI(cA1, 1, kb);
                if (hasB) { DS_EPI(cB0, 0, kb + 8); DS_EPI(cB1, 1, kb + 8); }
#undef DS_EPI
            }
#ifdef DSA_DUP_SCORE
            }
#endif
#undef DS_LOADB
            { int pn_ = pass, un_ = u0 + F.G; if (un_ >= 2048) { pn_ = pass + 1; un_ = blockIdx.x; } if (pn_ < 2 && un_ < 2048) load_a(pn_, un_); }
            __syncthreads();
#ifdef DSA_DUP_SEL
            for (int rep2_ = 0; rep2_ < 2; ++rep2_)
#endif
            radix_select_write(sc + wave * 4096, hist, (unsigned long long*)(F.ws + WS_DSAMASK) + (base + t0 + wave) * 64, t0 + wave, lane);
            __syncthreads();
        }
    }
}

constexpr int NS_K = 0, NS_KP = 144, NS_V = 256 * NS_KP, NS_VP = 520, NS_IMP = NS_V + 64 * NS_VP, NS_IP = 68, NS_END = NS_IMP + 64 * NS_IP * 4;
static_assert(NS_END <= RING_BYTES, "nsa select LDS map");
__device__ __forceinline__ void nsa_select_phase(Frame& F) {
    const int tid = cur_tid(), wave = cur_wave(), lane = tid & 63, r = lane & 31, hh = lane >> 5;
    LAS unsigned char* lds = F.lds;
    LAS float* imp = (LAS float*)(lds + NS_IMP);
    for (int pass = 0; pass < 2; ++pass) {
        for (int u0 = blockIdx.x; u0 < 256; u0 += F.G) {
            const int u = pass ? 511 - u0 : u0, tb = u >> 3, b = u & 7;
            __syncthreads();
            {
                const bf16* Kc = (const bf16*)(F.ws + WS_KCMPB) + (size_t)b * 256 * 64; const bf16* Vc = (const bf16*)(F.ws + WS_VCMPB) + (size_t)b * 256 * 64;
#pragma unroll
                for (int j = 0; j < 4; ++j) { const int ch = tid + 512 * j, row = ch >> 3, c8 = ch & 7;
                    *(LAS v4u*)(lds + NS_K + row * NS_KP + 16 * c8) = *(const v4u*)(Kc + row * 64 + 8 * c8);
                    const v4u vv = *(const v4u*)(Vc + row * 64 + 8 * c8);
                    LAS unsigned short* vt = (LAS unsigned short*)(lds + NS_V + (8 * c8) * NS_VP) + row;
                    vt[0 * (NS_VP / 2)] = (unsigned short)(vv.x & 0xffffu); vt[1 * (NS_VP / 2)] = (unsigned short)(vv.x >> 16); vt[2 * (NS_VP / 2)] = (unsigned short)(vv.y & 0xffffu); vt[3 * (NS_VP / 2)] = (unsigned short)(vv.y >> 16);
                    vt[4 * (NS_VP / 2)] = (unsigned short)(vv.z & 0xffffu); vt[5 * (NS_VP / 2)] = (unsigned short)(vv.z >> 16); vt[6 * (NS_VP / 2)] = (unsigned short)(vv.w & 0xffffu); vt[7 * (NS_VP / 2)] = (unsigned short)(vv.w >> 16); }
                for (int i = tid; i < 64 * NS_IP; i += 512) imp[i] = 0.f;
            }
            __syncthreads();
            const int tl_ = 8 * wave + (r >> 2), hd = r & 3, t = 64 * tb + tl_; const size_t row = (size_t)b * T + t;
            const bf16* qrow = (const bf16*)(F.ws + WS_QN) + row * 256 + hd * 64;
            bf16x8 qf[4];
#pragma unroll
            for (int ks = 0; ks < 4; ++ks) qf[ks] = *(const bf16x8*)(qrow + 16 * ks + 8 * hh);
            const int nmax = (t - 31) >> 4;
            const int ntile = ((4 * tb + 2) >> 6) + 1;
            const float sc2 = 0.125f * 1.4426950408889634f;
            auto scores = [&](int tile, f32x16& p0, f32x16& p1) {
#pragma unroll
                for (int i = 0; i < 16; ++i) { p0[i] = 0.f; p1[i] = 0.f; }
                const LAS unsigned char* Kb = lds + NS_K + (64 * tile) * NS_KP;
#pragma unroll
                for (int ks = 0; ks < 4; ++ks) {
                    const bf16x8 a0 = *(const LAS bf16x8*)(Kb + r * NS_KP + (16 * ks + 8 * hh) * 2), a1 = *(const LAS bf16x8*)(Kb + (32 + r) * NS_KP + (16 * ks + 8 * hh) * 2);
                    p0 = __builtin_amdgcn_mfma_f32_32x32x16_bf16(a0, qf[ks], p0, 0, 0, 0);
                    p1 = __builtin_amdgcn_mfma_f32_32x32x16_bf16(a1, qf[ks], p1, 0, 0, 0);
                }
            };
            float m = -1e30f, l = 0.f;
            for (int tile = 0; tile < ntile; ++tile) {
                const unsigned long long word = causal_word(nmax - 64 * tile);
                f32x16 p0, p1; scores(tile, p0, p1);
                const unsigned wlo = (unsigned)word >> (4 * hh), whi = (unsigned)(word >> 32) >> (4 * hh);
                float mx = -1e30f;
#pragma unroll
                for (int i = 0; i < 16; ++i) { const int bit = (i & 3) + 8 * (i >> 2);
                    p0[i] = ((wlo >> bit) & 1u) ? p0[i] * sc2 : -1e30f; p1[i] = ((whi >> bit) & 1u) ? p1[i] * sc2 : -1e30f; mx = fmaxf(mx, fmaxf(p0[i], p1[i])); }
                mx = xhalf_max(mx);
                const float mn = fmaxf(m, mx), alpha = __builtin_amdgcn_exp2f(m - mn); m = mn;
                float ps = 0.f;
#pragma unroll
                for (int i = 0; i < 16; ++i) { const int bit = (i & 3) + 8 * (i >> 2);
                    ps += (((wlo >> bit) & 1u) ? __builtin_amdgcn_exp2f(p0[i] - mn) : 0.f) + (((whi >> bit) & 1u) ? __builtin_amdgcn_exp2f(p1[i] - mn) : 0.f); }
                l = l * alpha + ps;
            }
            l = xhalf_sum(l);
            const float inv = l > 0.f ? 1.0f / l : 0.f;
            f32x16 o0, o1;
#pragma unroll
            for (int i = 0; i < 16; ++i) { o0[i] = 0.f; o1[i] = 0.f; }
            float carry = 0.f;
            for (int tile = 0; tile < ntile; ++tile) {
                const unsigned long long word = causal_word(nmax - 64 * tile);
                f32x16 p0, p1; scores(tile, p0, p1);
                const unsigned wlo = (unsigned)word >> (4 * hh), whi = (unsigned)(word >> 32) >> (4 * hh);
#pragma unroll
                for (int i = 0; i < 16; ++i) { const int bit = (i & 3) + 8 * (i >> 2);
                    p0[i] = ((wlo >> bit) & 1u) ? __builtin_amdgcn_exp2f(p0[i] * sc2 - m) * inv : 0.f; p1[i] = ((whi >> bit) & 1u) ? __builtin_amdgcn_exp2f(p1[i] * sc2 - m) * inv : 0.f; }
#pragma unroll
                for (int blk = 0; blk < 2; ++blk) {
                    float tot[4];
#pragma unroll
                    for (int g = 0; g < 4; ++g) {
                        const float a = blk ? p1[4 * g] : p0[4 * g], b1 = blk ? p1[4 * g + 1] : p0[4 * g + 1], c1 = blk ? p1[4 * g + 2] : p0[4 * g + 2], d1 = blk ? p1[4 * g + 3] : p0[4 * g + 3];
                        const float mainv = (a + b1) + (c1 + d1);
                        const float recv = xhalf_other(d1, hh);
                        const float below = hh ? recv : carry;
                        tot[g] = mainv + below;
                        carry = recv;
                    }
#pragma unroll
                    for (int g = 0; g < 4; ++g) { float v = tot[g]; v += dpp_f<0xB1>(v); v += dpp_f<0x4E>(v);
                        if (hd == 0) imp[tl_ * NS_IP + 16 * tile + 8 * blk + 2 * g + hh] = v; }
                }
                bf16x8 pf[4];
#pragma unroll
                for (int s = 0; s < 4; ++s) { v4u w;
                    if (s < 2) { w.x = pg8::cvt_pk_bf16(p0[8 * s], p0[8 * s + 1]); w.y = pg8::cvt_pk_bf16(p0[8 * s + 2], p0[8 * s + 3]); w.z = pg8::cvt_pk_bf16(p0[8 * s + 4], p0[8 * s + 5]); w.w = pg8::cvt_pk_bf16(p0[8 * s + 6], p0[8 * s + 7]); }
                    else { const int s2 = s - 2; w.x = pg8::cvt_pk_bf16(p1[8 * s2], p1[8 * s2 + 1]); w.y = pg8::cvt_pk_bf16(p1[8 * s2 + 2], p1[8 * s2 + 3]); w.z = pg8::cvt_pk_bf16(p1[8 * s2 + 4], p1[8 * s2 + 5]); w.w = pg8::cvt_pk_bf16(p1[8 * s2 + 6], p1[8 * s2 + 7]); }
                    pf[s] = __builtin_bit_cast(bf16x8, w); }
#pragma unroll
                for (int s = 0; s < 4; ++s) {
                    const int kb = 64 * tile + 32 * (s >> 1) + 16 * (s & 1) + 4 * hh;
#pragma unroll
                    for (int db = 0; db < 2; ++db) {
                        const LAS unsigned char* vp_ = lds + NS_V + (32 * db + r) * NS_VP + kb * 2;
                        typedef unsigned u32x2v __attribute__((ext_vector_type(2)));
                        const u32x2v lo = *(const LAS u32x2v*)vp_, hi = *(const LAS u32x2v*)(vp_ + 16);
                        v4u aw; aw.x = lo.x; aw.y = lo.y; aw.z = hi.x; aw.w = hi.y;
                        const bf16x8 a = __builtin_bit_cast(bf16x8, aw);
                        if (db == 0) o0 = __builtin_amdgcn_mfma_f32_32x32x16_bf16(a, pf[s], o0, 0, 0, 0);
                        else o1 = __builtin_amdgcn_mfma_f32_32x32x16_bf16(a, pf[s], o1, 0, 0, 0);
                    }
                }
            }
            flash_store((bf16*)(F.ws + WS_OC) + row * 256 + hd * 64, o0, o1, 1.0f, hh);
            LDS_WAIT(); asm volatile("" ::: "memory");
            for (int k = 0; k < 8; ++k) {
                const int tk = 64 * tb + 8 * wave + k, own = tk >> 6;
                const float iv = imp[(8 * wave + k) * NS_IP + lane];
                const bool causal = lane <= own, forced = causal && (lane == 0 || lane >= own - 1);
                const float val = forced ? 1e4f : (causal ? iv : -INFINITY);
                const unsigned kv_ = fkey(val); const unsigned klo = (kv_ << 6) | (unsigned)(63 - lane), khi = kv_ >> 26;
                int rank = 0;
#pragma unroll
                for (int j = 0; j < 64; ++j) { const unsigned jlo = (unsigned)__builtin_amdgcn_readlane((int)klo, j), jhi = (unsigned)__builtin_amdgcn_readlane((int)khi, j);
                    rank += (jhi > khi || (jhi == khi && jlo > klo)) ? 1 : 0; }
                const unsigned long long selm = __ballot(causal && rank < 16);
                if (lane == 0) ((unsigned long long*)(F.ws + WS_NSEL))[(size_t)b * T + tk] = selm;
            }
        }
    }
}
#ifndef PHMASK
#define PHMASK 0xFFFFFFFFu
#endif
#define EN(b) ((PHMASK >> (b)) & 1u)
#ifndef DUPMASK
#define DUPMASK 0u
#endif
#define REP(b) for (int rep_ = 0; rep_ < (((DUPMASK >> (b)) & 1u) ? 2 : 1); ++rep_)
__global__ void __launch_bounds__(NWAVES * 64, 2) fwd_kernel(Args args) {
    extern __shared__ __attribute__((aligned(16))) unsigned char lds[];
    Frame F;
    F.lds = (LAS unsigned char*)lds;
    F.MISC = (volatile LAS unsigned*)(F.lds + MISC_OFF);
    F.G = gridDim.x;
    F.ws = args.ws; F.ctl = (gu32*)(args.ws + WS_CTL); F.out = args.out;
    F.A = &args;
    for (int u = threadIdx.x; u < (XTRA_OFF - LDSCTL_OFF) / 4; u += NWAVES * 64) ((LAS unsigned*)(F.lds + LDSCTL_OFF))[u] = 0u;
    __syncthreads();
    XcdBarrier bar = xcd_barrier_post((unsigned*)(F.ctl + CW_BAR), F.MISC + 8);
#ifdef PHASE_RANGES
    const int lo = args.ph_lo, hi = args.ph_hi;
#endif
#ifdef PHASE_RANGES
#define IN(k) (lo <= (k) && (k) < hi)
#else
#define IN(k) true
#endif
#ifdef STAMP_DUR
    long long tprev_ = wall_clock64();
#define SEAM(k) do { xcd_barrier(bar); if (blockIdx.x == 0) { const long long tn_ = wall_clock64(); if ((k) == STAMP_DUR) { const long long dt_ = 8 * (tn_ - tprev_); while (wall_clock64() - tn_ < dt_) __builtin_amdgcn_s_sleep(8); } tprev_ = wall_clock64(); } } while (0)
#elif defined(DUP_BAR)
#define SEAM(k) do { if (IN(k) && IN((k) + 1)) { xcd_barrier(bar); xcd_barrier(bar); } } while (0)
#else
#define SEAM(k) do { if (IN(k) && IN((k) + 1)) xcd_barrier(bar); } while (0)
#endif
    unsigned char* ws = F.ws;
    bf16 *H; signed char* HID; const float *cs64, *cs32, *ada;

    if (EN(0) && IN(0)) REP(0) p0_prologue(F);
    SEAM(0);
    int ph = 1;
    auto half_layer = [&](const int s) __attribute__((always_inline)) {
        const int l = s >> 1, second = s & 1;
        { unsigned char* w_ = args.ws; asm volatile("" : "+s"(w_)); ws = w_; F.ws = w_; }
        H = (bf16*)F.out + (size_t)M * D; HID = (signed char*)(ws + WS_HID); cs64 = (const float*)(ws + WS_CS64); cs32 = (const float*)(ws + WS_CS32); ada = (const float*)(ws + WS_ADA);
        const unsigned char* wl = ws + WS_WTS + (size_t)l * WTS_LAYER;
        const float* adal = ada + (size_t)l * 8 * 9216;
        bf16* XB = (bf16*)(ws + WS_XB);
        if (EN(1) && IN(ph)) {
            if (s == 0) { wgu8_convert(F); norm_mod_phase<false, true>(F, args.in[I_X], args.in[I_F1N] + l * D, adal + 0 * 1024, adal + 1 * 1024, H); }
            else norm_mod_phase<true, true>(F, XB, args.in[second ? I_F2N : I_F1N] + l * D, adal + (second ? 6 : 0) * 1024, adal + (second ? 7 : 1) * 1024, H);
        }
        SEAM(ph); ++ph;
        if (EN(2) && IN(ph)) REP(2) {
            pg8::Gemm g{H, (const bf16*)(wl + (second ? WO_GU2 : WO_GU1)), M, NGU, D / 2}; pg8::StaticOrder S; S.init(M, NGU, F.G, (int)blockIdx.x);
            const float wmax = __uint_as_float(__hip_atomic_load((unsigned*)(F.ctl + CW_WMAX) + 2 * l + second, __ATOMIC_RELAXED, __HIP_MEMORY_SCOPE_AGENT));
            pg8::EpiSwiGLU8 E{HID, FF, (ACT_CLIP / 127.0f) * (wmax / 127.0f)};
            pg8::gemm_phase<pg8::EpiSwiGLU8, pg8::StaticOrder, true, true, true>(F.lds + RING_OFF, g, S, E);
        }
        SEAM(ph); ++ph;
        if (EN(3) && IN(ph)) {
            pg8::Gemm g{(const bf16*)HID, (const bf16*)(wl + (second ? WO_D2 : WO_D1)), M, D, FF / 2}; pg8::StaticOrder S; S.init(M, D, F.G, (int)blockIdx.x);
            const float wmaxd = __uint_as_float(__hip_atomic_load((unsigned*)(F.ctl + CW_WMAX) + 4 + 2 * l + second, __ATOMIC_RELAXED, __HIP_MEMORY_SCOPE_AGENT));
            const float cf = 0.5f * (pg8::HID_CLIP / 127.0f) * (wmaxd / 127.0f);
            if (s == 0) { pg8::EpiResid<false, true> E{args.in[I_X], XB, adal + 2 * 1024, cf};
                pg8::gemm_phase<pg8::EpiResid<false, true>, pg8::StaticOrder, true, true, true>(F.lds + RING_OFF, g, S, E); }
            else { pg8::EpiResid<true, true> E{XB, XB, adal + (second ? 8 : 2) * 1024, cf};
                pg8::gemm_phase<pg8::EpiResid<true, true>, pg8::StaticOrder, true, true, true>(F.lds + RING_OFF, g, S, E); }
        }
        SEAM(ph); ++ph;
        if (second) return;
        if (EN(4) && IN(ph)) norm_mod_phase<true, false>(F, XB, args.in[I_MIXN] + l * D, adal + 3 * 1024, adal + 4 * 1024, H);
        SEAM(ph); ++ph;
        if (EN(5) && IN(ph)) REP(5) {
            pg8::Gemm g{H, (const bf16*)(wl + WO_IN), M, NINP, D}; pg8::StaticOrder S; S.init(M, NINP, F.G, (int)blockIdx.x);
            pg8::EpiProj<WinDesc> E{WinDesc{ws}, cs64, cs32, nullptr};
            pg8::gemm_phase<pg8::EpiProj<WinDesc>, pg8::StaticOrder, true, true>(F.lds + RING_OFF, g, S, E);
        }
        SEAM(ph); ++ph;
        if (EN(6) && IN(ph)) REP(6) {
            m1_phase(F, l);
            { int kq = 2048; asm volatile("" : "+s"(kq)); pg8::Gemm g{(const bf16*)(ws + WS_KC), (const bf16*)(wl + WO_C1K), 2048, 256, kq, 1024}; pg8::RangeOrder S{8, 0};
              pg8::EpiCmpH E{(float*)(ws + WS_CMPH), (const float*)(ws + WS_CMPB) + (l * 2 + 0) * 256};
              pg8::gemm_phase<pg8::EpiCmpH, pg8::RangeOrder, false, true>(F.lds + RING_OFF, g, S, E); }
            { int kq = 2048; asm volatile("" : "+s"(kq)); pg8::Gemm g{(const bf16*)(ws + WS_VC), (const bf16*)(wl + WO_C1V), 2048, 256, kq, 1024}; pg8::RangeOrder S{8, 8};
              pg8::EpiCmpH E{(float*)(ws + WS_CMPH) + (size_t)8 * 256 * 256, (const float*)(ws + WS_CMPB) + (l * 2 + 1) * 256};
              pg8::gemm_phase<pg8::EpiCmpH, pg8::RangeOrder, false, true>(F.lds + RING_OFF, g, S, E); }
        }
        SEAM(ph); ++ph;
        if (IN(ph)) {
            if (EN(7)) REP(7) { int kq = 256; asm volatile("" : "+s"(kq)); pg8::Gemm g{(const bf16*)(ws + WS_CQ), (const bf16*)(wl + WO_UQ), M, 512, kq}; pg8::StaticOrder S; S.init(M, 512, F.G, (int)blockIdx.x);
              pg8::EpiProj<MlaQDesc> E{MlaQDesc{ws}, cs64, cs32, (const float*)(ws + WS_RSTDQ)};
              pg8::gemm_phase<pg8::EpiProj<MlaQDesc>, pg8::StaticOrder, true, true>(F.lds + RING_OFF, g, S, E); }
            if (EN(8)) REP(7) { int kq = 128; asm volatile("" : "+s"(kq)); pg8::Gemm g{(const bf16*)(ws + WS_CKV), (const bf16*)(wl + WO_UKV), M, 512, kq}; pg8::StaticOrder S; S.init(M, 512, F.G, (int)blockIdx.x);
              pg8::EpiProj<MlaKvDesc> E{MlaKvDesc{ws}, cs64, cs32, (const float*)(ws + WS_RSTDKV)};
              pg8::gemm_phase<pg8::EpiProj<MlaKvDesc>, pg8::StaticOrder, true, true>(F.lds + RING_OFF, g, S, E); }
            if (EN(9)) REP(9) cmp2_phase(F, l);
#ifdef FLASH_DSA
            if (EN(10)) REP(10) dsa_select_phase(F);
#else
            if (EN(10)) REP(10) dsa_tokens_phase(F);
#endif
        }
        SEAM(ph); ++ph;
#ifdef FLASH_NSA
        if (IN(ph)) { if (EN(13)) REP(13) nsa_select_phase(F); }
        SEAM(ph); ++ph;
#endif
        if (IN(ph)) {
#ifdef FLASH_MOBA
            if (EN(11)) REP(11) moba_flash_phase(F);
#else
            if (EN(11)) moba_rows_phase(F);
#endif
#ifdef FLASH_MLA
            if (EN(12)) REP(12) mla_flash_phase(F);
#else
            if (EN(12)) mla_rows_phase(F);
#endif
#ifdef FLASH_NSA
            if (EN(13)) REP(14) nsa_flash_phase(F);
#else
            if (EN(13)) nsa_tokens_phase(F);
#endif
#ifdef FLASH_DSA
            if (EN(10)) REP(15) dsa_flash_phase(F);
#endif
        }
        SEAM(ph); ++ph;
        if (EN(14) && IN(ph)) group_norm_phase(F, H, args.in[I_GN] + l * 1024);
        SEAM(ph); ++ph;
        if (EN(15) && IN(ph)) {
            pg8::Gemm g{H, (const bf16*)(wl + WO_OUT), M, D, D}; pg8::StaticOrder S; S.init(M, D, F.G, (int)blockIdx.x);
            pg8::EpiResid<true> E{XB, XB, adal + 5 * 1024, 1.0f};
            pg8::gemm_phase<pg8::EpiResid<true>, pg8::StaticOrder, true, true>(F.lds + RING_OFF, g, S, E);
        }
        SEAM(ph); ++ph;
    };
    half_layer(0); half_layer(1);
#ifdef DUP_LAYER0
    half_layer(0); half_layer(1);
#endif
    half_layer(2); half_layer(3);
    if (EN(16) && IN(ph)) final_norm_phase(F, (const bf16*)(args.ws + WS_XB), F.out, args.in[I_FINN]);
#undef IN
#undef SEAM
}
#ifdef FLASH_NSA
constexpr int N_PHASES = 1 + 4 * 3 + 2 * 8 + 1;
#else
constexpr int N_PHASES = 1 + 4 * 3 + 2 * 7 + 1;
#endif

extern "C" void kernel_launch(void* const* d_in, const int* in_sizes, int n_in, void* d_out, int out_size, void* d_ws, size_t ws_size, hipStream_t stream) {
    static int grid = 0;
    if (grid == 0) {
        if (n_in != 28 || in_sizes[0] != M * D || out_size != M * D || ws_size < WS_END) { fprintf(stderr, "kernel_launch: unexpected problem shape (n_in %d, in0 %d, out %d, ws %zu); nothing launched\n", n_in, n_in > 0 ? in_sizes[0] : -1, out_size, ws_size); grid = -1; return; }
        int dev = 0, cus = 0, per_cu = 0;
        if (hipGetDevice(&dev) != hipSuccess || hipDeviceGetAttribute(&cus, hipDeviceAttributeMultiprocessorCount, dev) != hipSuccess) { grid = -1; return; }
        if (hipFuncSetAttribute((const void*)fwd_kernel, hipFuncAttributeMaxDynamicSharedMemorySize, LDS_BYTES) != hipSuccess) { fprintf(stderr, "kernel_launch: hipFuncSetAttribute failed\n"); grid = -1; return; }
        if (hipOccupancyMaxActiveBlocksPerMultiprocessor(&per_cu, (const void*)fwd_kernel, NWAVES * 64, LDS_BYTES) != hipSuccess || per_cu < 1) { fprintf(stderr, "kernel_launch: occupancy query says %d\n", per_cu); }
        (void)hipGetLastError();
        grid = cus;
    }
    if (grid < 0) return;
    if (hipMemsetAsync((char*)d_ws + WS_CTL, 0, CTL_ZERO_BYTES, stream) != hipSuccess) return;
    Args a{};
    for (int i = 0; i < 28; ++i) a.in[i] = (const float*)d_in[i];
    a.out = (float*)d_out; a.ws = (unsigned char*)d_ws; a.ph_lo = 0; a.ph_hi = N_PHASES + 64;
    hipLaunchKernelGGL(fwd_kernel, dim3(grid), dim3(NWAVES * 64), LDS_BYTES, stream, a);
}
```

```cpp
#include <hip/hip_runtime.h>
#include <cstdio>
#include <cstdint>
#include <cmath>
#ifndef NO_FLASH
#define FLASH_MLA 1
#define FLASH_MOBA 1
#define FLASH_NSA 1
#define FLASH_DSA 1
#endif
namespace pg8 {
#define PG8_LAS __attribute__((address_space(3)))
typedef unsigned short bf16_t;
typedef short bf16x8 __attribute__((ext_vector_type(8)));
typedef float f32x4 __attribute__((ext_vector_type(4)));
typedef unsigned u32x4 __attribute__((ext_vector_type(4)));
constexpr int BM = 256, BK = 64, HALF = 128, HTB = HALF * BK * 2  , STAGE_BYTES = 8 * HTB, NXCD = 8, WGM = 8;

__host__ __device__ __forceinline__ int lds_byte(int r, int c) { const int st = (r >> 4) * 2 + (c >> 5), rr = r & 15, cc = c & 31, ob = rr * 64 + cc * 2; return st * 1024 + (ob ^ (((ob >> 9) & 1) << 5)); }
__host__ __device__ __forceinline__ void stage_rc(int b, int& R, int& C) { const int st = b / 1024, sb = b % 1024, swz = sb ^ (((sb >> 9) & 1) << 5); R = (st >> 1) * 16 + swz / 64; C = (st & 1) * 32 + (swz % 64) / 2; }
__host__ __device__ __forceinline__ int perm32(int rho) { const int n = rho >> 4, i = rho & 15; return 8 * (i >> 2) + 4 * n + (i & 3); }

struct Unit { int pm, pn; };
struct Gemm { const bf16_t* A; const bf16_t* Bt; int M, N, K; int lda = 0; size_t kstepA = 0; };

struct StaticOrder {
    int nM, nN, nwg, G, c;
    __host__ __device__ void init(int M, int N, int G_, int c_) { nM = M / BM; nN = N / BM; nwg = nM * nN; G = G_; c = c_; }
    __host__ __device__ bool next(int i, Unit& u) const {
        const long L = (long)i * G + c; if (L >= nwg) return false;
        int wgid = (int)L; { const int q = nwg / NXCD, r = nwg % NXCD, xcd = wgid % NXCD, off = wgid / NXCD; wgid = (xcd < r ? xcd * (q + 1) : r * (q + 1) + (xcd - r) * q) + off; }
        const int nig = WGM * nN, gid = wgid / nig, fm = gid * WGM, gsz = (nM - fm) < WGM ? (nM - fm) : WGM;
        u.pm = fm + ((wgid % nig) % gsz); u.pn = (wgid % nig) / gsz; return true;
    }
    __device__ __forceinline__ void a_ready(const Unit&) const {}
    __device__ __forceinline__ void done(const Unit&) const {}
};

__device__ __forceinline__ unsigned cvt_pk_bf16(float lo, float hi) { unsigned r; asm volatile("v_cvt_pk_bf16_f32 %0, %1, %2" : "=v"(r) : "v"(lo), "v"(hi)); return r; }
typedef float f32x2 __attribute__((ext_vector_type(2)));
typedef unsigned u32x2 __attribute__((ext_vector_type(2)));
__device__ __forceinline__ float silu_f(float x) { return x * __builtin_amdgcn_rcpf(1.0f + __builtin_amdgcn_exp2f(-1.4426950408889634f * x)); }

struct EpiSwiGLU {
    static constexpr bool PERM = false, AFTER_DRAIN = false;
    bf16_t* H; int ldh;
    __device__ __forceinline__ void operator()(const f32x4 (&acc)[2][2][4][2], const Unit& u, int wr, int wc, int fr, int fq) const {
        const int row0 = u.pm * BM + wr * 64 + fr;
        const int hc0 = u.pn * 128 + wc * 16 + 4 * fq;
#pragma unroll
        for (int ai = 0; ai < 2; ++ai)
#pragma unroll
            for (int m = 0; m < 4; ++m) {
                bf16_t* rowp = H + (size_t)(row0 + ai * HALF + m * 16) * ldh + hc0;
#pragma unroll
                for (int bj = 0; bj < 2; ++bj) {
                    const f32x4 g = acc[ai][bj][m][0], uu = acc[ai][bj][m][1];
                    u32x2 w; w.x = cvt_pk_bf16(silu_f(g[0]) * uu[0], silu_f(g[1]) * uu[1]); w.y = cvt_pk_bf16(silu_f(g[2]) * uu[2], silu_f(g[3]) * uu[3]);
                    *(u32x2*)(rowp + bj * 64) = w;
                }
            }
    }
};

__device__ __forceinline__ unsigned q8pack4(float a, float b, float c, float d, float qs) {
    const float MG = 12582912.0f; const int MB = 0x4B400000;
    int ia = __float_as_int(__builtin_fmaf(a, qs, MG)), ib = __float_as_int(__builtin_fmaf(b, qs, MG)), ic = __float_as_int(__builtin_fmaf(c, qs, MG)), id = __float_as_int(__builtin_fmaf(d, qs, MG));
    ia = min(max(ia, MB - 127), MB + 127); ib = min(max(ib, MB - 127), MB + 127); ic = min(max(ic, MB - 127), MB + 127); id = min(max(id, MB - 127), MB + 127);
    return __builtin_amdgcn_perm((unsigned)ib, (unsigned)ia, 0x0c0c0400u) | __builtin_amdgcn_perm((unsigned)id, (unsigned)ic, 0x04000c0cu);
}
constexpr float HID_CLIP = 9.0f;
struct EpiSwiGLU8 {
    static constexpr bool PERM = false, AFTER_DRAIN = false;
    signed char* H; int ldh; float deq; size_t ktile;
    __device__ __forceinline__ unsigned one(const f32x4& ga, const f32x4& ua, float nle, float qsc) const {
        typedef int i32x4_ __attribute__((ext_vector_type(4)));
        const i32x4_ gi = __builtin_bit_cast(i32x4_, ga), ui = __builtin_bit_cast(i32x4_, ua);
        float hv[4];
#pragma unroll
        for (int i = 0; i < 4; i += 2) {
            const f32x2 gf = {(float)gi[i], (float)gi[i + 1]}, uf = {(float)ui[i], (float)ui[i + 1]};
            const f32x2 ea = gf * nle, gu = gf * uf;
            const f32x2 dn = (f32x2){__builtin_amdgcn_exp2f(ea.x), __builtin_amdgcn_exp2f(ea.y)} + 1.0f;
            const f32x2 hh = gu * (f32x2){__builtin_amdgcn_rcpf(dn.x), __builtin_amdgcn_rcpf(dn.y)};
            hv[i] = hh.x; hv[i + 1] = hh.y; }
        return q8pack4(hv[0], hv[1], hv[2], hv[3], qsc);
    }
    __device__ __forceinline__ void operator()(const f32x4 (&acc)[2][2][4][2], const Unit& u, int wr, int wc, int fr, int fq) const {
        typedef unsigned u32x4s __attribute__((ext_vector_type(4)));
        const int row0 = u.pm * BM + wr * 64 + fr;
        const float nle = -1.4426950408889634f * deq, qsc = deq * deq * (127.0f / HID_CLIP);
        signed char* base = H + (size_t)u.pn * ktile + (size_t)row0 * ldh + wc * 16 + (fq & 1) * 64;
#pragma unroll
        for (int ai = 0; ai < 2; ++ai)
#pragma unroll
            for (int m = 0; m < 4; m += 2) {
                const unsigned a0 = one(acc[ai][0][m][0], acc[ai][0][m][1], nle, qsc), b0 = one(acc[ai][1][m][0], acc[ai][1][m][1], nle, qsc);
                const unsigned a1 = one(acc[ai][0][m + 1][0], acc[ai][0][m + 1][1], nle, qsc), b1 = one(acc[ai][1][m + 1][0], acc[ai][1][m + 1][1], nle, qsc);
                const auto s0 = __builtin_amdgcn_permlane16_swap(a0, b0, false, false), s1 = __builtin_amdgcn_permlane16_swap(a1, b1, false, false);
                const auto tl = __builtin_amdgcn_permlane32_swap(s0[0], s1[0], false, false), th = __builtin_amdgcn_permlane32_swap(s0[1], s1[1], false, false);
                const u32x4s w = {tl[0], th[0], tl[1], th[1]};
                *(u32x4s*)(base + (size_t)(ai * HALF + (m + (fq >> 1)) * 16) * ldh) = w;
            }
    }
};

template <bool XIN_BF16, bool I8 = false> struct EpiResid {
    static constexpr bool PERM = true, AFTER_DRAIN = false;
    const void* xin; bf16_t* xout; const float* gate; float coef;
    __device__ __forceinline__ void operator()(const f32x4 (&acc)[2][2][4][2], const Unit& u, int wr, int wc, int fr, int fq) const {
        typedef unsigned u32x4v __attribute__((ext_vector_type(4)));
        const int b = (u.pm * BM) >> 12;
        const float* gv = gate + (size_t)b * 9216;
        const int row0 = u.pm * BM + wr * 64 + fr, col0 = u.pn * BM + wc * 32 + 8 * fq;
        f32x4 g[2][2];
#pragma unroll
        for (int bj = 0; bj < 2; ++bj)
#pragma unroll
            for (int n = 0; n < 2; ++n) g[bj][n] = *(const f32x4*)(gv + col0 + bj * HALF + 4 * n) * coef;
#pragma unroll
        for (int ai = 0; ai < 2; ++ai)
#pragma unroll
            for (int m = 0; m < 4; ++m) {
                const size_t off = (size_t)(row0 + ai * HALF + m * 16) * 1024 + col0;
#pragma unroll
                for (int bj = 0; bj < 2; ++bj) {
                    f32x4 xi[2];
                    if (XIN_BF16) { const u32x4v w = *(const u32x4v*)((const bf16_t*)xin + off + bj * HALF);
                        xi[0] = (f32x4){__uint_as_float(w.x << 16), __uint_as_float(w.x & 0xffff0000u), __uint_as_float(w.y << 16), __uint_as_float(w.y & 0xffff0000u)};
                        xi[1] = (f32x4){__uint_as_float(w.z << 16), __uint_as_float(w.z & 0xffff0000u), __uint_as_float(w.w << 16), __uint_as_float(w.w & 0xffff0000u)}; }
                    else { xi[0] = *(const f32x4*)((const float*)xin + off + bj * HALF); xi[1] = *(const f32x4*)((const float*)xin + off + bj * HALF + 4); }
                    u32x4v wo;
#pragma unroll
                    for (int n = 0; n < 2; ++n) {
                        f32x4 av = acc[ai][bj][m][n];
                        if (I8) { typedef int i32x4_ __attribute__((ext_vector_type(4))); const i32x4_ q = __builtin_bit_cast(i32x4_, av); av = (f32x4){(float)q[0], (float)q[1], (float)q[2], (float)q[3]}; }
                        const f32x4 xo = xi[n] + g[bj][n] * av;
                        if (n == 0) { wo.x = cvt_pk_bf16(xo[0], xo[1]); wo.y = cvt_pk_bf16(xo[2], xo[3]); } else { wo.z = cvt_pk_bf16(xo[0], xo[1]); wo.w = cvt_pk_bf16(xo[2], xo[3]); } }
                    *(u32x4v*)(xout + off + bj * HALF) = wo; }
                if (m & 1) asm volatile("" ::: "memory");
            }
    }
};

struct ProjDesc { int kind, dfreq0, nstride, rep, repstride, bpitch, fpitch, pad; bf16_t* bp; float* fp; };
template <class DescFn> struct EpiProj {
    static constexpr bool PERM = false, AFTER_DRAIN = false;
    DescFn df; const float* cs64; const float* cs32; const float* rowscale;
    __device__ __forceinline__ void operator()(const f32x4 (&acc)[2][2][4][2], const Unit& u, int wr, int wc, int fr, int fq) const {
        const int row0 = u.pm * BM + wr * 64 + fr;
#pragma unroll
        for (int bj = 0; bj < 2; ++bj) {
            const int G = u.pn * 8 + bj * 4 + wc;
            const ProjDesc d = df(G);
            if (d.kind != 0) {
#pragma unroll
                for (int ai = 0; ai < 2; ++ai)
#pragma unroll
                    for (int m = 0; m < 4; ++m) {
                        const int row = row0 + ai * HALF + m * 16;
                        f32x4 v0 = acc[ai][bj][m][0], v1 = acc[ai][bj][m][1];
                        if (rowscale) { const float rs = rowscale[row]; v0 = v0 * rs; v1 = v1 * rs; }
                        if (d.kind >= 2) {
                            const int pos = row & 4095;
                            const float* cs = (d.kind == 2) ? cs64 + ((size_t)pos * 32 + d.dfreq0 + 4 * fq) * 2 : cs32 + ((size_t)pos * 16 + 4 * fq) * 2;
                            const f32x4 a = *(const f32x4*)cs, b2 = *(const f32x4*)(cs + 4);
                            const f32x4 c = {a[0], a[2], b2[0], b2[2]}, s = {a[1], a[3], b2[1], b2[3]};
                            const f32x4 o0 = v0 * c - v1 * s, o1 = v1 * c + v0 * s; v0 = o0; v1 = o1;
                        }
                        if (d.bp) {
                            u32x2 w0, w1; w0.x = cvt_pk_bf16(v0[0], v0[1]); w0.y = cvt_pk_bf16(v0[2], v0[3]); w1.x = cvt_pk_bf16(v1[0], v1[1]); w1.y = cvt_pk_bf16(v1[2], v1[3]);
                            asm volatile("s_nop 1");
                            const auto sx = __builtin_amdgcn_permlane16_swap(w0.x, w1.x, false, false); const auto sy = __builtin_amdgcn_permlane16_swap(w0.y, w1.y, false, false);
                            typedef unsigned u32x4s __attribute__((ext_vector_type(4)));
                            const u32x4s ww = {sx[0], sy[0], sx[1], sy[1]};
                            bf16_t* p = d.bp + (size_t)row * d.bpitch + ((fq & 1) ? d.nstride + 4 * (fq - 1) : 4 * fq);
                            for (int rp = 0; rp < d.rep; ++rp) *(u32x4s*)(p + rp * d.repstride) = ww;
                        }
                        if (d.fp) { float* p = d.fp + (size_t)row * d.fpitch + 4 * fq;
                            if (d.pad) {
                                typedef unsigned u32x4v __attribute__((ext_vector_type(4)));
                                u32x4v w0, w1;
#pragma unroll
                                for (int q = 0; q < 2; ++q) { const f32x4 v = q ? v1 : v0;
                                    const unsigned h01 = cvt_pk_bf16(v[0], v[1]), h23 = cvt_pk_bf16(v[2], v[3]);
                                    const unsigned l01 = cvt_pk_bf16(v[0] - __uint_as_float(h01 << 16), v[1] - __uint_as_float(h01 & 0xffff0000u)), l23 = cvt_pk_bf16(v[2] - __uint_as_float(h23 << 16), v[3] - __uint_as_float(h23 & 0xffff0000u));
                                    u32x4v w; w.x = (h01 & 0xffffu) | (l01 << 16); w.y = (h01 >> 16) | (l01 & 0xffff0000u); w.z = (h23 & 0xffffu) | (l23 << 16); w.w = (h23 >> 16) | (l23 & 0xffff0000u);
                                    if (q) w1 = w; else w0 = w; }
                                *(u32x4v*)p = w0; *(u32x4v*)(p + d.nstride) = w1;
                            } else { *(f32x4*)p = v0; *(f32x4*)(p + d.nstride) = v1; } }
                        asm volatile("" ::: "memory");
                    }
            }
        }
    }
};


struct EpiCmpH {
    static constexpr bool PERM = false, AFTER_DRAIN = false;
    float* out; const float* bias;
    __device__ __forceinline__ void operator()(const f32x4 (&acc)[2][2][4][2], const Unit& u, int wr, int wc, int fr, int fq) const {
        const int row0 = u.pm * BM + wr * 64 + fr, col0 = wc * 32 + 4 * fq;
        f32x4 bv[2][2];
#pragma unroll
        for (int bj = 0; bj < 2; ++bj)
#pragma unroll
            for (int n = 0; n < 2; ++n) bv[bj][n] = *(const f32x4*)(bias + col0 + bj * HALF + n * 16);
#pragma unroll
        for (int ai = 0; ai < 2; ++ai)
#pragma unroll
            for (int m = 0; m < 4; ++m) {
                float* rowp = out + (size_t)(row0 + ai * HALF + m * 16) * 256 + col0;
#pragma unroll
                for (int bj = 0; bj < 2; ++bj)
#pragma unroll
                    for (int n = 0; n < 2; ++n) { const f32x4 v = acc[ai][bj][m][n] + bv[bj][n];
                        f32x4 o; o[0] = silu_f(v[0]); o[1] = silu_f(v[1]); o[2] = silu_f(v[2]); o[3] = silu_f(v[3]); *(f32x4*)(rowp + bj * HALF + n * 16) = o; }
            }
    }
};
struct RangeOrder {
    int nM, c0;
    __device__ __forceinline__ bool next(int i, Unit& u) const { const int idx = (int)blockIdx.x - c0; if (i > 0 || idx < 0 || idx >= nM) return false; u.pm = idx; u.pn = 0; return true; }
    __device__ __forceinline__ void a_ready(const Unit&) const {}
    __device__ __forceinline__ void done(const Unit&) const {}
};
template <class Epi, class Sched, bool ALIGN_EPI = false, bool SP2 = false, bool I8 = false>
__device__ __forceinline__ void gemm_phase(PG8_LAS unsigned char* lds, const Gemm g, const Sched& S, const Epi& E) {
    int tid_ = threadIdx.x; asm volatile("" : "+v"(tid_));
    const int tid = tid_, wid = __builtin_amdgcn_readfirstlane(tid >> 6), lane = tid & 63, wr = wid >> 2, wc = wid & 3, fr = lane & 15, fq = lane >> 4;
    const int K = g.K, nt = K / BK, lda = g.lda ? g.lda : g.K;
    unsigned voffA[2], voffB[2];
#pragma unroll
    for (int i = 0; i < 2; ++i) { int R, C; stage_rc(tid * 16 + i * 8192, R, C); const int Rb = Epi::PERM ? ((R & ~31) + perm32(R & 31)) : R;
        voffA[i] = (unsigned)(R * lda + C) * 2u; voffB[i] = (unsigned)(Rb * K + C) * 2u; }
    const size_t kstep = (size_t)(BK * 2), kstepA = g.kstepA ? g.kstepA : kstep;
    const size_t hstepB = (size_t)HALF * K * 2, hstepA = (size_t)HALF * lda * 2;
    const size_t tstepB = 2 * hstepB, tstepA = 2 * hstepA;
    const unsigned ldsw = (unsigned)wid * 1024u;
    const int aoff = lds_byte(wr * 64 + fr, fq * 8), boff = lds_byte(wc * 32 + fr, fq * 8);
#define PG8_SA(b, h) (((b) * 2 + (h)) * HTB)
#define PG8_SB(b, h) ((4 + (b) * 2 + (h)) * HTB)
#define PG8_STAGE(bufoff, gbase, voff) do { _Pragma("unroll") for (int _i = 0; _i < 2; ++_i) \
        __builtin_amdgcn_global_load_lds((const unsigned*)((const char*)(gbase) + (voff)[_i]), (PG8_LAS unsigned*)(lds + (bufoff) + ldsw + _i * 8192), 16, 0, 0); } while (0)
#define PG8_LDA(dst, b, h) do { _Pragma("unroll") for (int m = 0; m < 4; ++m) _Pragma("unroll") for (int k = 0; k < 2; ++k) dst[m][k] = *(const PG8_LAS bf16x8*)(lds + PG8_SA(b, h) + aoff + m * 2048 + k * 1024); } while (0)
#define PG8_LDB(dst, b, h) do { _Pragma("unroll") for (int n = 0; n < 2; ++n) _Pragma("unroll") for (int k = 0; k < 2; ++k) dst[n][k] = *(const PG8_LAS bf16x8*)(lds + PG8_SB(b, h) + boff + n * 2048 + k * 1024); } while (0)
#define PG8_MMA(ai, bj, At, Bt) do { __builtin_amdgcn_s_setprio(1); _Pragma("unroll") for (int m = 0; m < 4; ++m) _Pragma("unroll") for (int n = 0; n < 2; ++n) _Pragma("unroll") for (int k = 0; k < 2; ++k) \
        { if constexpr (I8) { typedef int i32x4_ __attribute__((ext_vector_type(4))); acc[ai][bj][m][n] = __builtin_bit_cast(f32x4, __builtin_amdgcn_mfma_i32_16x16x64_i8(__builtin_bit_cast(i32x4_, Bt[n][k]), __builtin_bit_cast(i32x4_, At[m][k]), __builtin_bit_cast(i32x4_, acc[ai][bj][m][n]), 0, 0, 0)); } \
          else acc[ai][bj][m][n] = __builtin_amdgcn_mfma_f32_16x16x32_bf16(Bt[n][k], At[m][k], acc[ai][bj][m][n], 0, 0, 0); } __builtin_amdgcn_s_setprio(0); } while (0)
#define PG8_WAIT_V(n) asm volatile("s_waitcnt vmcnt(" #n ")" ::: "memory")
#define PG8_WAIT_L(n) asm volatile("s_waitcnt lgkmcnt(" #n ")" ::: "memory")
#define PG8_BAR __builtin_amdgcn_s_barrier()
#define PG8_SCHED __builtin_amdgcn_sched_barrier(0)
    Unit cur, nxt; int ui = 0;
    if (!S.next(0, cur)) return;
    f32x4 acc[2][2][4][2];
#pragma unroll
    for (int a = 0; a < 2; ++a)
#pragma unroll
        for (int b = 0; b < 2; ++b)
#pragma unroll
            for (int m = 0; m < 4; ++m)
#pragma unroll
                for (int n = 0; n < 2; ++n) acc[a][b][m][n] = (f32x4){0.f, 0.f, 0.f, 0.f};
    bf16x8 At[4][2], B0[2][2], B1[2][2];
    const char* cA = (const char*)g.A + (size_t)cur.pm * tstepA; const char* cB = (const char*)g.Bt + (size_t)cur.pn * tstepB;
    S.a_ready(cur);
    if constexpr (SP2) {
        PG8_STAGE(PG8_SB(0, 0), cB, voffB); PG8_STAGE(PG8_SB(0, 1), cB + hstepB, voffB); PG8_STAGE(PG8_SA(0, 0), cA, voffA); PG8_STAGE(PG8_SA(0, 1), cA + hstepA, voffA);
        if (wr == 1) PG8_BAR;
        PG8_WAIT_V(2); PG8_BAR;
        PG8_STAGE(PG8_SB(1, 0), cB + kstep, voffB); PG8_STAGE(PG8_SA(1, 0), cA + kstepA, voffA); PG8_STAGE(PG8_SB(1, 1), cB + hstepB + kstep, voffB);
        PG8_WAIT_V(6); PG8_BAR;
    } else {
        PG8_STAGE(PG8_SB(0, 0), cB, voffB); PG8_STAGE(PG8_SA(0, 0), cA, voffA); PG8_STAGE(PG8_SB(0, 1), cB + hstepB, voffB); PG8_STAGE(PG8_SA(0, 1), cA + hstepA, voffA);
        if (wr == 1) PG8_BAR;
        PG8_WAIT_V(4); PG8_BAR;
        PG8_STAGE(PG8_SB(1, 0), cB + kstep, voffB); PG8_STAGE(PG8_SA(1, 0), cA + kstepA, voffA); PG8_STAGE(PG8_SB(1, 1), cB + hstepB + kstep, voffB);
        PG8_WAIT_V(6); PG8_BAR;
    }
    for (;;) {
        const bool has_next = S.next(ui + 1, nxt);
        const char* nA = has_next ? (const char*)g.A + (size_t)nxt.pm * tstepA : cA; const char* nB = has_next ? (const char*)g.Bt + (size_t)nxt.pn * tstepB : cB;
        for (int t = 0; t < nt; t += 2) {
            const bool last = (t == nt - 2);
            const char* a1 = cA + (size_t)(t + 1) * kstepA;
            const char* a2 = last ? nA : cA + (size_t)(t + 2) * kstepA; const char* b2 = last ? nB : cB + (size_t)(t + 2) * kstep;
            const char* a3 = a2 + kstepA; const char* b3 = b2 + kstep;
            if (last && has_next) S.a_ready(nxt);
            if constexpr (SP2) {
            PG8_LDB(B0, 0, 0); PG8_LDB(B1, 0, 1); PG8_SCHED; PG8_LDA(At, 0, 0); PG8_STAGE(PG8_SA(1, 1), a1 + hstepA, voffA);
            PG8_WAIT_V(8); PG8_WAIT_L(0); PG8_BAR; PG8_MMA(0, 0, At, B0); PG8_MMA(0, 1, At, B1); PG8_BAR; PG8_SCHED;
            PG8_LDA(At, 0, 1); PG8_STAGE(PG8_SB(0, 0), b2, voffB); PG8_STAGE(PG8_SB(0, 1), b2 + hstepB, voffB); PG8_STAGE(PG8_SA(0, 0), a2, voffA);
            PG8_WAIT_V(8); PG8_WAIT_L(0); PG8_BAR; PG8_MMA(1, 0, At, B0); PG8_MMA(1, 1, At, B1); PG8_BAR; PG8_SCHED;
            PG8_LDB(B0, 1, 0); PG8_LDB(B1, 1, 1); PG8_SCHED; PG8_LDA(At, 1, 0); PG8_STAGE(PG8_SA(0, 1), a2 + hstepA, voffA);
            PG8_WAIT_V(8); PG8_WAIT_L(0); PG8_BAR; PG8_MMA(0, 0, At, B0); PG8_MMA(0, 1, At, B1); PG8_BAR; PG8_SCHED;
            PG8_LDA(At, 1, 1); PG8_STAGE(PG8_SB(1, 0), b3, voffB); PG8_STAGE(PG8_SB(1, 1), b3 + hstepB, voffB); PG8_STAGE(PG8_SA(1, 0), a3, voffA);
            PG8_WAIT_V(8); PG8_WAIT_L(0); PG8_BAR; PG8_MMA(1, 0, At, B0); PG8_MMA(1, 1, At, B1); PG8_BAR; PG8_SCHED;
            } else {
            PG8_LDB(B0, 0, 0); PG8_SCHED; PG8_LDA(At, 0, 0); PG8_STAGE(PG8_SA(1, 1), a1 + hstepA, voffA);
            PG8_WAIT_L(8); PG8_BAR; PG8_WAIT_L(0); PG8_MMA(0, 0, At, B0); PG8_BAR; PG8_SCHED;
            PG8_LDB(B1, 0, 1); PG8_STAGE(PG8_SB(0, 0), b2, voffB);
            PG8_BAR; PG8_WAIT_L(0); PG8_MMA(0, 1, At, B1); PG8_BAR;
            PG8_LDA(At, 0, 1); PG8_STAGE(PG8_SA(0, 0), a2, voffA);
            PG8_BAR; PG8_WAIT_L(0); PG8_MMA(1, 0, At, B0); PG8_BAR; PG8_SCHED;
            PG8_STAGE(PG8_SB(0, 1), b2 + hstepB, voffB);
            PG8_WAIT_V(6); PG8_BAR; PG8_MMA(1, 1, At, B1); PG8_BAR;
            PG8_LDB(B0, 1, 0); PG8_SCHED; PG8_LDA(At, 1, 0); PG8_STAGE(PG8_SA(0, 1), a2 + hstepA, voffA);
            PG8_WAIT_L(8); PG8_BAR; PG8_WAIT_L(0); PG8_MMA(0, 0, At, B0); PG8_BAR; PG8_SCHED;
            PG8_LDB(B1, 1, 1); PG8_STAGE(PG8_SB(1, 0), b3, voffB);
            PG8_BAR; PG8_WAIT_L(0); PG8_MMA(0, 1, At, B1); PG8_BAR;
            PG8_LDA(At, 1, 1); PG8_STAGE(PG8_SA(1, 0), a3, voffA);
            PG8_BAR; PG8_WAIT_L(0); PG8_MMA(1, 0, At, B0); PG8_BAR; PG8_SCHED;
            PG8_STAGE(PG8_SB(1, 1), b3 + hstepB, voffB);
            PG8_WAIT_V(6); PG8_BAR; PG8_MMA(1, 1, At, B1); PG8_BAR;
            }
        }
        if constexpr (ALIGN_EPI) { if (wr == 0) PG8_BAR; }
        if constexpr (!Epi::AFTER_DRAIN) { E(acc, cur, wr, wc, fr, fq); S.done(cur); }
        if (!has_next) break;
#pragma unroll
        for (int a = 0; a < 2; ++a)
#pragma unroll
            for (int b = 0; b < 2; ++b)
#pragma unroll
                for (int m = 0; m < 4; ++m)
#pragma unroll
                    for (int n = 0; n < 2; ++n) acc[a][b][m][n] = (f32x4){0.f, 0.f, 0.f, 0.f};
        cur = nxt; cA = nA; cB = nB; ++ui;
        if constexpr (ALIGN_EPI) { if (wr == 1) PG8_BAR; }
    }
    PG8_WAIT_V(0);
    if constexpr (!ALIGN_EPI) { if (wr == 0) PG8_BAR; }
    PG8_BAR;
    if constexpr (Epi::AFTER_DRAIN) { E.fused(acc, cur, wr, wc, fr, fq, lds, wid, lane); S.done(cur); }
#undef PG8_SA
#undef PG8_SB
#undef PG8_STAGE
#undef PG8_LDA
#undef PG8_LDB
#undef PG8_MMA
#undef PG8_WAIT_V
#undef PG8_WAIT_L
#undef PG8_BAR
#undef PG8_SCHED
}
}
#define GAS __attribute__((address_space(1)))
#define LAS __attribute__((address_space(3)))
typedef unsigned short bf16;
typedef unsigned v4u __attribute__((ext_vector_type(4)));
typedef float f32x4 __attribute__((ext_vector_type(4)));
typedef short bf16x8 __attribute__((ext_vector_type(8)));
typedef GAS unsigned gu32;
typedef GAS unsigned long long gu64;
#define RLX_AGENT __ATOMIC_RELAXED, __HIP_MEMORY_SCOPE_AGENT
#define LDS_WAIT() asm volatile("s_waitcnt lgkmcnt(0)" ::: "memory")
#define VM_WAIT() asm volatile("s_waitcnt vmcnt(0)" ::: "memory")
__device__ __forceinline__ unsigned long long rt() { return __builtin_amdgcn_s_memrealtime(); }
__device__ __forceinline__ unsigned f2bf(float f) { unsigned u = __builtin_bit_cast(unsigned, f); return (u + 0x7fffu + ((u >> 16) & 1u)) >> 16; }
__device__ __forceinline__ unsigned pk2(float lo, float hi) { return f2bf(lo) | (f2bf(hi) << 16); }

#define XB_TMO      128
#define XB_XCNT(j)  (256  + 64 * (j))
#define XB_XSUB(j)  (1280 + 64 * (j))
#define XB_XGEN(j)  (2304 + 64 * (j))
#define XB_TOP      3328
#define XB_TOPGEN   3392
#define XCD_BAR_WORDS 3456
#define XB_SPIN_CAP (1u << 24)

__device__ __forceinline__ unsigned xb_ld(unsigned* p)              { return __hip_atomic_load(p, __ATOMIC_RELAXED, __HIP_MEMORY_SCOPE_AGENT); }
__device__ __forceinline__ unsigned xb_add(unsigned* p, unsigned v) { return __hip_atomic_fetch_add(p, v, __ATOMIC_RELAXED, __HIP_MEMORY_SCOPE_AGENT); }
__device__ __forceinline__ unsigned xb_xcc_id() { return (unsigned)__builtin_amdgcn_s_getreg((3 << 11) | 20) & 0xFu; }
#define XB_SPIN(cond, bar) do { unsigned _sp = 0; while (cond) { __builtin_amdgcn_s_sleep(1); \
    if ((++_sp & 255u) == 0u) { if (xb_ld(&(bar)[XB_TMO])) break; if (_sp > XB_SPIN_CAP) { atomicAdd(&(bar)[XB_TMO], 1u); break; } } } } while (0)

struct XcdBarrier {
    unsigned* bar; unsigned x;
    volatile LAS unsigned* st;
};

__device__ __forceinline__ XcdBarrier xcd_barrier_post(unsigned* bar, volatile LAS unsigned* st) {
    XcdBarrier b; b.bar = bar; b.x = xb_xcc_id(); b.st = st;
    if (threadIdx.x == 0) (void)xb_add(&bar[XB_XCNT(b.x)], 1u);
    return b;
}
__device__ __forceinline__ void xcd_barrier_complete(unsigned* bar, unsigned x, unsigned& nloc, unsigned& nx) {
    const unsigned G = gridDim.x * gridDim.y * gridDim.z;
    unsigned sum, cnt, mine, sp = 0u;
    for (;;) {
        sum = 0u; cnt = 0u; mine = 0u;
#pragma unroll
        for (unsigned j = 0; j < 16; ++j) { const unsigned c = xb_ld(&bar[XB_XCNT(j)]); sum += c; cnt += (c > 0u) ? 1u : 0u; mine = (j == x) ? c : mine; }
        if (sum == G) break;
        __builtin_amdgcn_s_sleep(1);
        if ((++sp & 255u) == 0u) { if (xb_ld(&bar[XB_TMO])) break; if (sp > XB_SPIN_CAP) { atomicAdd(&bar[XB_TMO], 1u); break; } }
    }
    nloc = mine > 0u ? mine : 1u; nx = cnt > 0u ? cnt : 1u;
}

__device__ __forceinline__ void xcd_barrier(const XcdBarrier& b) {
    asm volatile("s_waitcnt vmcnt(0)" ::: "memory");
    __syncthreads();
    if (threadIdx.x == 0) {
        unsigned* bar = b.bar; asm volatile("" : "+s"(bar));
        __builtin_amdgcn_s_waitcnt(0);
        unsigned nloc = b.st[0], nx = b.st[1];
        if (nloc == 0u) { xcd_barrier_complete(bar, b.x, nloc, nx); b.st[0] = nloc; b.st[1] = nx; }
        const unsigned old = xb_add(&bar[XB_XSUB(b.x)], 1u);
        const unsigned gen = old / nloc;
        if (old + 1u == (gen + 1u) * nloc) {
            __builtin_amdgcn_fence(__ATOMIC_RELEASE, "agent");
            asm volatile("s_waitcnt vmcnt(0)" ::: "memory");
            const unsigned og = xb_add(&bar[XB_TOP], 1u);
            const unsigned tg = og / nx;
            if (og + 1u == (tg + 1u) * nx) xb_add(&bar[XB_TOPGEN], 1u);
            else XB_SPIN(xb_ld(&bar[XB_TOPGEN]) == tg, bar);
            __builtin_amdgcn_fence(__ATOMIC_ACQUIRE, "agent");
            xb_add(&bar[XB_XGEN(b.x)], 1u);
            asm volatile("s_waitcnt vmcnt(0)" ::: "memory");
        } else {
            XB_SPIN(xb_ld(&bar[XB_XGEN(b.x)]) == gen, bar);
            __builtin_amdgcn_fence(__ATOMIC_ACQUIRE, "agent");
            asm volatile("s_waitcnt vmcnt(0)" ::: "memory");
        }
    }
    __syncthreads();
}
constexpr int NWAVES = 8;
constexpr int BATCH = 8, T = 4096, D = 1024, M = BATCH * T, FF = 2816, NGU = 2 * FF, NINP = 2560, NIN_SRC = 2516, NL = 2;
constexpr float RMS_EPS = 1e-6f;
constexpr size_t MiB = 1u << 20;
constexpr size_t WS_CTL = 0, CTL_ZERO_BYTES = 1 * MiB;
constexpr size_t WS_CS64 = 1 * MiB;
constexpr size_t WS_CS32 = 2 * MiB;
constexpr size_t WS_ADA = 2 * MiB + 512 * 1024;
constexpr size_t WS_CMPB = 3 * MiB + 128 * 1024;
constexpr size_t WS_KMEAN = 3 * MiB + 256 * 1024;
constexpr size_t WS_RSTDQ = 3 * MiB + 512 * 1024;
constexpr size_t WS_RSTDKV = 3 * MiB + 768 * 1024;
constexpr size_t WS_KCMP = 4 * MiB;
constexpr size_t WS_VCMP = 4 * MiB + 512 * 1024;
constexpr size_t WS_CMPH = 5 * MiB;
constexpr size_t WS_WTS = 10 * MiB, WTS_LAYER = 46 * MiB;
constexpr size_t WO_GU1 = 0, WO_D1 = 11 * MiB, WO_GU2 = 17 * MiB, WO_D2 = 28 * MiB, WO_IN = 34 * MiB, WO_OUT = 39 * MiB, WO_UQ = 41 * MiB, WO_UKV = 41 * MiB + 512 * 1024, WO_C1K = 42 * MiB, WO_C1V = 43 * MiB;
constexpr size_t WS_XB = 104 * MiB;
constexpr size_t WS_BIG = 168 * MiB;
constexpr size_t WS_HID = WS_BIG;
constexpr size_t WS_QM_BF = 168 * MiB, WS_KM_BF = 184 * MiB, WS_VM_BF = 200 * MiB, WS_QM_F = 216 * MiB, WS_KM_F = 248 * MiB;
constexpr size_t WS_CQ = 280 * MiB, WS_CKV = 296 * MiB;
constexpr size_t WS_QN = 304 * MiB, WS_KC = 320 * MiB, WS_VC = 324 * MiB, WS_KS = 328 * MiB, WS_VS = 332 * MiB, WS_KW = 336 * MiB, WS_VW = 340 * MiB;
constexpr size_t WS_QD = 344 * MiB, WS_KD = 360 * MiB, WS_VD = 364 * MiB, WS_IQ = 368 * MiB, WS_IK = 400 * MiB, WS_GW = 404 * MiB;
constexpr size_t WS_QMLA = 408 * MiB, WS_KMLA = 432 * MiB, WS_VMLA = 456 * MiB;
constexpr size_t WS_DSAMASK = 472 * MiB;
constexpr size_t WS_OC = 488 * MiB;
constexpr size_t WS_KCMPB = 9 * MiB + 256 * 1024, WS_VCMPB = 9 * MiB + 512 * 1024;
constexpr size_t WS_NSEL = 9 * MiB;
constexpr size_t WS_END = 512 * MiB;
constexpr int CW_BAR = 4096;
constexpr int CW_WPART = 8448;
constexpr int CW_DSAQ = 8320;
constexpr int CW_WMAX = 8192;
constexpr float ACT_CLIP = 12.0f;
constexpr int RING_OFF = 0, RING_BYTES = 131072;
constexpr int LDSCTL_OFF = RING_BYTES, MISC_OFF = LDSCTL_OFF + 320;
constexpr int XTRA_OFF = 132096, XTRA_WAVE = 2112;
constexpr int LDS_BYTES = 155648;
static_assert(XTRA_OFF + NWAVES * XTRA_WAVE <= LDS_BYTES && MISC_OFF + 128 <= XTRA_OFF, "LDS map");

struct Args { const float* in[28]; float* out; unsigned char* ws; int ph_lo, ph_hi; };
struct Frame {
    LAS unsigned char* lds;
    volatile LAS unsigned* MISC;
    gu32* ctl;
    unsigned char* ws;
    int G;
    const Args* A;
    float* out;
};
enum { I_X = 0, I_C, I_ADAW, I_ADAB, I_F1N, I_F1G, I_F1U, I_F1D, I_MIXN, I_WIN, I_QNORM, I_WUQ, I_KVNORM, I_WUK, I_WUV, I_PEK, I_PEV, I_CK1, I_CK2, I_CV1, I_CV2, I_GN, I_WOUT, I_F2N, I_F2G, I_F2U, I_F2D, I_FINN };

__device__ __forceinline__ int opaque_v(int v) { asm volatile("" : "+v"(v)); return v; }
__device__ __forceinline__ int cur_tid() { return opaque_v((int)threadIdx.x); }
__device__ __forceinline__ int cur_lane() { return opaque_v((int)threadIdx.x) & 63; }
__device__ __forceinline__ int cur_wave() { return __builtin_amdgcn_readfirstlane(opaque_v((int)threadIdx.x) >> 6); }
template <int CTRL> __device__ __forceinline__ float dpp_f(float v) { return __int_as_float(__builtin_amdgcn_update_dpp(0, __float_as_int(v), CTRL, 0xf, 0xf, false)); }
__device__ __forceinline__ float wave_sum(float v) {
    v += dpp_f<0xB1>(v); v += dpp_f<0x4E>(v); v += dpp_f<0x141>(v); v += dpp_f<0x140>(v);
    const float r0 = __int_as_float(__builtin_amdgcn_readlane(__float_as_int(v), 0)), r1 = __int_as_float(__builtin_amdgcn_readlane(__float_as_int(v), 16));
    const float r2 = __int_as_float(__builtin_amdgcn_readlane(__float_as_int(v), 32)), r3 = __int_as_float(__builtin_amdgcn_readlane(__float_as_int(v), 48));
    return (r0 + r1) + (r2 + r3);
}
__device__ __forceinline__ float wave_max(float v) {
    v = fmaxf(v, dpp_f<0xB1>(v)); v = fmaxf(v, dpp_f<0x4E>(v)); v = fmaxf(v, dpp_f<0x141>(v)); v = fmaxf(v, dpp_f<0x140>(v));
    const float r0 = __int_as_float(__builtin_amdgcn_readlane(__float_as_int(v), 0)), r1 = __int_as_float(__builtin_amdgcn_readlane(__float_as_int(v), 16));
    const float r2 = __int_as_float(__builtin_amdgcn_readlane(__float_as_int(v), 32)), r3 = __int_as_float(__builtin_amdgcn_readlane(__float_as_int(v), 48));
    return fmaxf(fmaxf(r0, r1), fmaxf(r2, r3));
}
__device__ __forceinline__ float bf2f(unsigned short b) { return __uint_as_float((unsigned)b << 16); }
__device__ __forceinline__ void unpack8(const v4u w, float* f) {
    f[0] = __uint_as_float(w.x << 16); f[1] = __uint_as_float(w.x & 0xffff0000u); f[2] = __uint_as_float(w.y << 16); f[3] = __uint_as_float(w.y & 0xffff0000u);
    f[4] = __uint_as_float(w.z << 16); f[5] = __uint_as_float(w.z & 0xffff0000u); f[6] = __uint_as_float(w.w << 16); f[7] = __uint_as_float(w.w & 0xffff0000u);
}
__device__ __forceinline__ float sigmoid_f(float x) { return 1.0f / (1.0f + __expf(-x)); }

__device__ __forceinline__ int perm64(int j) { return 32 * ((j & 31) >> 4) + 16 * (j >> 5) + (j & 15); }
__device__ __forceinline__ int win_src_col(int c) {
    if (c < 512) return (c & ~63) + perm64(c & 63);
    if (c < 1184) return c;
    if (c < 1504) { const int r = c - 1184; return 1184 + (r & ~63) + perm64(r & 63); }
    if (c < 1568) return c;
    if (c < 1632) return 1568 + perm64(c - 1568);
    if (c < 1696) return c;
    if (c < 1760) return 1696 + perm64(c - 1696);
    if (c < 1824) return c;
    if (c < 2144) { const int r = c - 1824; return 1836 + (r & ~63) + perm64(r & 63); }
    if (c < 2208) return 2156 + (c - 2144);
    if (c < 2464) return 2220 + (c - 2208);
    if (c < 2496) return 2476 + (c - 2464);
    if (c < 2508) return 1824 + (c - 2496);
    if (c < 2516) return 2508 + (c - 2508);
    return -1;
}
constexpr int WK_K[8] = {1024, 2816, 1024, 2816, 1024, 1024, 256, 128};
constexpr int WK_N[8] = {5632, 1024, 5632, 1024, 2560, 1024, 512, 512};
__device__ __forceinline__ size_t wk_off(int kind) { return kind == 0 ? WO_GU1 : kind == 1 ? WO_D1 : kind == 2 ? WO_GU2 : kind == 3 ? WO_D2 : kind == 4 ? WO_IN : kind == 5 ? WO_OUT : kind == 6 ? WO_UQ : kind == 7 ? WO_UKV : kind == 8 ? WO_C1K : WO_C1V; }
__device__ __forceinline__ const float* wsrc(const Frame& F, int kind, int l, int R, int& stride) {
    switch (kind) {
    case 0: case 2: { const int G = R >> 5, w = R & 31, j = 16 * G + (w & 15); stride = FF;
        const float* g = F.A->in[kind == 0 ? I_F1G : I_F2G] + (size_t)l * D * FF; const float* u = F.A->in[kind == 0 ? I_F1U : I_F2U] + (size_t)l * D * FF; return ((w >> 4) ? u : g) + j; }
    case 1: case 3: stride = D; return F.A->in[kind == 1 ? I_F1D : I_F2D] + (size_t)l * FF * D + R;
    case 4: { stride = NIN_SRC; const int s = win_src_col(R); return s < 0 ? nullptr : F.A->in[I_WIN] + (size_t)l * D * NIN_SRC + s; }
    case 5: stride = D; return F.A->in[I_WOUT] + (size_t)l * D * D + R;
    case 6: stride = 384; return R < 384 ? F.A->in[I_WUQ] + (size_t)l * 256 * 384 + R : nullptr;
    case 7: stride = 256; return R < 256 ? F.A->in[I_WUK] + (size_t)l * 128 * 256 + R : F.A->in[I_WUV] + (size_t)l * 128 * 256 + (R - 256);
    default: stride = 256; return F.A->in[kind == 8 ? I_CK1 : I_CV1] + (size_t)l * 2048 * 256 + R;
    }
}

struct WinDesc {
    unsigned char* ws;
    __device__ __forceinline__ pg8::ProjDesc operator()(int G) const {
        pg8::ProjDesc d; d.kind = 0; d.dfreq0 = 0; d.nstride = 16; d.rep = 1; d.repstride = 0; d.bpitch = 0; d.fpitch = 0; d.pad = 0; d.bp = nullptr; d.fp = nullptr;
        const int c = 32 * G;
#define ROPE64(rel, BOFF, BP, FOFF, FP) do { const int hh_ = (rel) >> 6, g_ = ((rel) >> 5) & 1; d.kind = 2; d.dfreq0 = 16 * g_; d.nstride = 32; \
            d.bp = (bf16*)(ws + (BOFF)) + hh_ * 64 + 16 * g_; d.bpitch = (BP); if (FP) { d.fp = (float*)(ws + (FOFF)) + hh_ * 64 + 16 * g_; d.fpitch = (FP); } } while (0)
#define PLAINB(rel, BOFF, BP) do { d.kind = 1; d.bp = (bf16*)(ws + (BOFF)) + (rel); d.bpitch = (BP); } while (0)
#define PLAINF(rel, FOFF, FP) do { d.kind = 1; d.fp = (float*)(ws + (FOFF)) + (rel); d.fpitch = (FP); } while (0)
        if (c < 256) ROPE64(c, WS_QM_BF, 256, 0, 0);
        else if (c < 512) ROPE64(c - 256, WS_KM_BF, 256, 0, 0);
        else if (c < 768) PLAINB(c - 512, WS_VM_BF, 256);
        else if (c < 1024) PLAINB(c - 768, WS_CQ, 256);
        else if (c < 1152) PLAINB(c - 1024, WS_CKV, 128);
        else if (c < 1184) { d.kind = 3; d.nstride = 16; d.bp = (bf16*)(ws + WS_KMLA) + 64; d.bpitch = 384; d.rep = 4; d.repstride = 96; }
        else if (c < 1440) ROPE64(c - 1184, WS_QN, 256, 0, 0);
        else if (c < 1504) ROPE64(c - 1440, WS_KC, 64, 0, 0);
        else if (c < 1568) PLAINB(c - 1504, WS_VC, 64);
        else if (c < 1632) ROPE64(c - 1568, WS_KS, 64, 0, 0);
        else if (c < 1696) PLAINB(c - 1632, WS_VS, 64);
        else if (c < 1760) ROPE64(c - 1696, WS_KW, 64, 0, 0);
        else if (c < 1824) PLAINB(c - 1760, WS_VW, 64);
        else if (c < 2080) ROPE64(c - 1824, WS_QD, 256, 0, 0);
        else if (c < 2144) ROPE64(c - 2080, WS_KD, 64, 0, 0);
        else if (c < 2208) PLAINB(c - 2144, WS_VD, 64);
        else if (c < 2464) PLAINB(c - 2208, WS_IQ, 256);
        else if (c < 2496) PLAINB(c - 2464, WS_IK, 32);
        else if (c < 2528) PLAINF(c - 2496, WS_GW, 32);
#undef ROPE64
#undef PLAINB
#undef PLAINF
        return d;
    }
};
struct MlaQDesc {
    unsigned char* ws;
    __device__ __forceinline__ pg8::ProjDesc operator()(int G) const {
        pg8::ProjDesc d; d.kind = 0; d.dfreq0 = 0; d.nstride = 16; d.rep = 1; d.repstride = 0; d.bpitch = 384; d.fpitch = 0; d.pad = 0; d.bp = nullptr; d.fp = nullptr;
        if (G < 12) { const int hh = G / 3, part = G - 3 * hh; d.kind = (part == 2) ? 3 : 1; d.bp = (bf16*)(ws + WS_QMLA) + hh * 96 + 32 * part; }
        return d;
    }
};
struct MlaKvDesc {
    unsigned char* ws;
    __device__ __forceinline__ pg8::ProjDesc operator()(int G) const {
        pg8::ProjDesc d; d.kind = 1; d.dfreq0 = 0; d.nstride = 16; d.rep = 1; d.repstride = 0; d.bpitch = 0; d.fpitch = 0; d.pad = 0; d.bp = nullptr; d.fp = nullptr;
        const int c = 32 * G;
        if (c < 256) { d.bp = (bf16*)(ws + WS_KMLA) + (c >> 6) * 96 + (c & 63); d.bpitch = 384; }
        else { d.bp = (bf16*)(ws + WS_VMLA) + (c - 256); d.bpitch = 256; }
        return d;
    }
};

__device__ __forceinline__ void p0_prologue(Frame& F) {
    const int tid = cur_tid();
    const int wave = cur_wave(), gw = blockIdx.x * NWAVES + wave, NGW = F.G * NWAVES, lane = cur_lane();
    {
        LAS float* scr = (LAS float*)(F.lds + RING_OFF + wave * 16384);
        constexpr int PER_LAYER = 1280 + 512 + 64 + 32 + 256 + 256;
        for (int it = gw; it < NL * PER_LAYER; it += NGW) {
            const int l = it / PER_LAYER; int r = it - l * PER_LAYER; int kind = 4;
            { const int cnt[6] = {1280, 512, 64, 32, 256, 256};
#pragma unroll
              for (int q = 0; q < 5; ++q) { if (kind == q + 4 && r >= cnt[q]) { r -= cnt[q]; kind = q + 5; } } }
            const int K = kind == 0 || kind == 2 || kind == 4 || kind == 5 ? 1024 : (kind == 1 || kind == 3) ? 2816 : kind == 6 ? 256 : kind == 7 ? 128 : 2048;
            const int N = kind == 0 || kind == 2 ? 5632 : kind == 4 ? 2560 : (kind == 6 || kind == 7) ? 512 : kind >= 8 ? 256 : 1024;
            const int nblk = N / 32, kb = r / nblk, nb = r - kb * nblk, k0 = 64 * kb, n0 = 32 * nb;
            int stride; const float* colp = wsrc(F, kind, l, n0 + (lane & 31), stride);
            const float* ksc = kind == 6 ? F.A->in[I_QNORM] + l * 256 : kind == 7 ? F.A->in[I_KVNORM] + l * 128 : nullptr;
            bf16* WT = (bf16*)(F.ws + WS_WTS + (size_t)l * WTS_LAYER + wk_off(kind));
            float vv[32];
#pragma unroll
            for (int i = 0; i < 32; ++i) { const int kk = 2 * i + (lane >> 5); vv[i] = colp ? colp[(size_t)(k0 + kk) * stride] : 0.f; }
#pragma unroll
            for (int i = 0; i < 32; ++i) { const int kk = 2 * i + (lane >> 5); float v = vv[i]; if (ksc) v *= ksc[k0 + kk]; scr[kk * 33 + (lane & 31)] = v; }
            LDS_WAIT(); asm volatile("" ::: "memory");
            const int c = lane & 7;
#pragma unroll
            for (int j = 0; j < 4; ++j) { const int n = (lane >> 3) + 8 * j; const LAS float* s = scr + (8 * c) * 33 + n;
                v4u o; o.x = pk2(s[0 * 33], s[1 * 33]); o.y = pk2(s[2 * 33], s[3 * 33]); o.z = pk2(s[4 * 33], s[5 * 33]); o.w = pk2(s[6 * 33], s[7 * 33]);
                *(GAS v4u*)(WT + (size_t)(n0 + n) * K + k0 + 8 * c) = o; }
            LDS_WAIT(); asm volatile("" ::: "memory");
        }
    }
    {
        const int gtid = blockIdx.x * 512 + tid, NT = F.G * 512; constexpr int n4 = D * FF / 4;
        LAS float* red = (LAS float*)(F.lds + RING_OFF);
        __syncthreads();
#pragma unroll 1
        for (int cp = 0; cp < 6; ++cp) {
            const f32x4* p[2];
#pragma unroll
            for (int q2 = 0; q2 < 2; ++q2) { const int cm = 2 * cp + q2; const bool isd = cm >= 8; const int combo = isd ? cm - 8 : cm >> 1, l = combo >> 1, ff2 = combo & 1, up = cm & 1;
                p[q2] = (const f32x4*)(F.A->in[isd ? (ff2 ? I_F2D : I_F1D) : ff2 ? (up ? I_F2U : I_F2G) : (up ? I_F1U : I_F1G)] + (size_t)l * D * FF); }
            f32x4 v[2][6];
#pragma unroll
            for (int q2 = 0; q2 < 2; ++q2)
#pragma unroll
                for (int q = 0; q < 6; ++q) { const int i = gtid + q * NT; v[q2][q] = i < n4 ? p[q2][i] : (f32x4){0.f, 0.f, 0.f, 0.f}; }
#pragma unroll
            for (int q2 = 0; q2 < 2; ++q2) { float mx = 0.f;
#pragma unroll
                for (int q = 0; q < 6; ++q) mx = fmaxf(mx, fmaxf(fmaxf(fabsf(v[q2][q].x), fabsf(v[q2][q].y)), fmaxf(fabsf(v[q2][q].z), fabsf(v[q2][q].w))));
                for (int i = gtid + 6 * NT; i < n4; i += NT) { const f32x4 w = p[q2][i]; mx = fmaxf(mx, fmaxf(fmaxf(fabsf(w.x), fabsf(w.y)), fmaxf(fabsf(w.z), fabsf(w.w)))); }
                mx = wave_max(mx);
                if (lane == 0) red[(2 * cp + q2) * 8 + wave] = mx; }
        }
        __syncthreads();
        if (tid < 8) { const int c0 = tid < 4 ? 2 * tid : 4 + tid, nc = tid < 4 ? 16 : 8; float mx = 0.f;
            for (int q = 0; q < nc; ++q) mx = fmaxf(mx, red[c0 * 8 + q]);
            __hip_atomic_fetch_max((unsigned*)(F.ctl + CW_WPART) + tid * 256 + (blockIdx.x & 255), __float_as_uint(mx), __ATOMIC_RELAXED, __HIP_MEMORY_SCOPE_AGENT); }
        __syncthreads();
    }
    for (int i = blockIdx.x * 512 + tid; i < 4096 * 48; i += F.G * 512) {
        const int pos = i / 48, j = i - pos * 48;
        float invf; float* dst;
        if (j < 32) { invf = 1.0f / (float)pow(10000.0, (double)j / 32.0); dst = (float*)(F.ws + WS_CS64) + ((size_t)pos * 32 + j) * 2; }
        else { invf = 1.0f / (float)pow(10000.0, (double)(j - 32) / 16.0); dst = (float*)(F.ws + WS_CS32) + ((size_t)pos * 16 + (j - 32)) * 2; }
        const float ang = (float)pos * invf;
        dst[0] = (float)cos((double)ang); dst[1] = (float)sin((double)ang);
    }
    {
        LAS float* red = (LAS float*)(F.lds + RING_OFF + 8 * 16384 - 2048);
        for (int task = blockIdx.x; task < NL * 2 * 4; task += F.G) {
            const int l = task >> 3, kvq = task & 7, kv = kvq >> 2, j = (kvq & 3) * 64 + lane;
            const float* pe = F.A->in[kv ? I_PEV : I_PEK] + (size_t)l * 2048 + wave * 256; const float* w1 = F.A->in[kv ? I_CV1 : I_CK1] + (size_t)l * 2048 * 256 + (size_t)wave * 256 * 256 + j;
            float acc = 0.f;
#pragma unroll 32
            for (int k = 0; k < 256; ++k) acc += pe[k] * w1[(size_t)k * 256];
            __syncthreads();
            red[wave * 64 + lane] = acc;
            __syncthreads();
            if (wave == 0) { float s = 0.f;
#pragma unroll
                for (int w = 0; w < 8; ++w) s += red[w * 64 + lane];
                ((float*)(F.ws + WS_CMPB))[(l * 2 + kv) * 256 + j] = s; }
        }
    }
    {
        __syncthreads();
        LAS float* cact = (LAS float*)(F.lds + RING_OFF);
        LAS float* red = (LAS float*)(F.lds + RING_OFF + 32768);
        for (int i = tid; i < 8 * 1024; i += 512) { const float cv = F.A->in[I_C][i]; cact[i] = cv / (1.0f + __expf(-cv)); }
        __syncthreads();
        for (int task = blockIdx.x; task < NL * 144; task += F.G) {
            const int l = task / 144, n0 = (task - l * 144) * 64;
            const float* W = F.A->in[I_ADAW] + (size_t)l * 1024 * 9216 + n0 + lane;
            float acc[8];
#pragma unroll
            for (int b = 0; b < 8; ++b) acc[b] = 0.f;
            const int kbeg = wave * 128;
#pragma unroll 16
            for (int k = kbeg; k < kbeg + 128; ++k) { const float wv = W[(size_t)k * 9216];
#pragma unroll
                for (int b = 0; b < 8; ++b) acc[b] += cact[b * 1024 + k] * wv; }
#pragma unroll
            for (int b = 0; b < 8; ++b) red[(wave * 8 + b) * 64 + lane] = acc[b];
            __syncthreads();
            { const int b = wave; float s = F.A->in[I_ADAB][(size_t)l * 9216 + n0 + lane];
#pragma unroll
              for (int w = 0; w < 8; ++w) s += red[(w * 8 + b) * 64 + lane];
              ((float*)(F.ws + WS_ADA))[((size_t)l * 8 + b) * 9216 + n0 + lane] = s; }
            __syncthreads();
        }
    }
}

using pg8::q8pack4; using pg8::HID_CLIP;
__device__ __forceinline__ void wgu8_convert(Frame& F) {
    const int wave = cur_wave(), gw = blockIdx.x * NWAVES + wave, NGW = F.G * NWAVES, lane = cur_lane();
    LAS float* scr = (LAS float*)(F.lds + RING_OFF + wave * 16384);
    float wm[8];
    { unsigned pv[8][4];
#pragma unroll
      for (int sl = 0; sl < 8; ++sl)
#pragma unroll
          for (int j = 0; j < 4; ++j) pv[sl][j] = __hip_atomic_load((unsigned*)(F.ctl + CW_WPART) + sl * 256 + lane + 64 * j, __ATOMIC_RELAXED, __HIP_MEMORY_SCOPE_AGENT);
#pragma unroll
      for (int sl = 0; sl < 8; ++sl) wm[sl] = wave_max(fmaxf(fmaxf(__uint_as_float(pv[sl][0]), __uint_as_float(pv[sl][1])), fmaxf(__uint_as_float(pv[sl][2]), __uint_as_float(pv[sl][3]))));
      if (gw == 0 && lane == 0) {
#pragma unroll
          for (int sl = 0; sl < 8; ++sl) __hip_atomic_store((unsigned*)(F.ctl + CW_WMAX) + sl, __float_as_uint(wm[sl]), __ATOMIC_RELAXED, __HIP_MEMORY_SCOPE_AGENT); } }
    for (int it = gw; it < 4 * 2816 + 4 * 1408; it += NGW) {
        const bool isd = it >= 4 * 2816; const int r0 = isd ? it - 4 * 2816 : it, per = isd ? 1408 : 2816, nblk = isd ? 32 : 176, KB = isd ? 2816 : 1024;
        const int cmb = r0 / per, r = r0 - cmb * per, l = cmb >> 1, ff2 = cmb & 1, kind = (isd ? 1 : 0) + 2 * ff2, combo = cmb + (isd ? 4 : 0);
        const int kb = r / nblk, nb = r - kb * nblk, k0 = 64 * kb, n0 = 32 * nb;
        int stride; const float* colp = wsrc(F, kind, l, n0 + (lane & 31), stride);
        float wmax = wm[0];
#pragma unroll
        for (int sl = 1; sl < 8; ++sl) wmax = combo == sl ? wm[sl] : wmax;
        const float qs = wmax > 0.f ? 127.0f / wmax : 0.f;
        signed char* WT = (signed char*)(F.ws + WS_WTS + (size_t)l * WTS_LAYER + wk_off(kind));
        float vv[32];
#pragma unroll
        for (int i = 0; i < 32; ++i) { const int kk = 2 * i + (lane >> 5); vv[i] = colp[(size_t)(k0 + kk) * stride]; }
#pragma unroll
        for (int i = 0; i < 32; ++i) { const int kk = 2 * i + (lane >> 5); scr[kk * 33 + (lane & 31)] = vv[i]; }
        LDS_WAIT(); asm volatile("" ::: "memory");
#pragma unroll
        for (int q = 0; q < 2; ++q) { const int p = lane + 64 * q, n = p >> 2, c = p & 3; const LAS float* s = scr + (16 * c) * 33 + n;
            v4u o; o.x = q8pack4(s[0 * 33], s[1 * 33], s[2 * 33], s[3 * 33], qs); o.y = q8pack4(s[4 * 33], s[5 * 33], s[6 * 33], s[7 * 33], qs);
            o.z = q8pack4(s[8 * 33], s[9 * 33], s[10 * 33], s[11 * 33], qs); o.w = q8pack4(s[12 * 33], s[13 * 33], s[14 * 33], s[15 * 33], qs);
            *(GAS v4u*)(WT + (size_t)(n0 + n) * KB + k0 + 16 * c) = o; }
        LDS_WAIT(); asm volatile("" ::: "memory");
    }
}
typedef unsigned u32x2_t __attribute__((ext_vector_type(2)));
template <bool XBF> __device__ __forceinline__ void load_row16(const void* xsrc, int row, int lane, f32x4 (&v)[4]) {
    if (XBF) { const unsigned long long* xr = (const unsigned long long*)((const bf16*)xsrc + (size_t)row * D) + lane;
#pragma unroll
        for (int j = 0; j < 4; ++j) { const unsigned long long w = xr[64 * j];
            v[j] = (f32x4){__uint_as_float((unsigned)w << 16), __uint_as_float((unsigned)w & 0xffff0000u), __uint_as_float((unsigned)(w >> 32) << 16), __uint_as_float((unsigned)(w >> 32) & 0xffff0000u)}; } }
    else { const f32x4* xr = (const f32x4*)((const float*)xsrc + (size_t)row * D) + lane;
#pragma unroll
        for (int j = 0; j < 4; ++j) v[j] = xr[64 * j]; }
}
template <bool XBF, bool Q8>
__device__ __forceinline__ void norm_mod_phase(Frame& F, const void* xsrc, const float* gain, const float* sh, const float* sc, bf16* hout) {
    const int wave = cur_wave(), gw = blockIdx.x * NWAVES + wave, NGW = F.G * NWAVES, lane = cur_lane();
    constexpr int RPI = XBF ? 8 : 4;
    for (int chunk = gw; chunk < M / 16; chunk += NGW) {
        const int rowb = chunk * 16, b = rowb >> 12;
        f32x4 gm[2][2], sv[2][2];
#pragma unroll
        for (int j = 0; j < 2; ++j)
#pragma unroll
            for (int h = 0; h < 2; ++h) { const int col = 8 * lane + 512 * j + 4 * h;
                gm[j][h] = *(const f32x4*)(gain + col) * (*(const f32x4*)(sc + (size_t)b * 9216 + col) + 1.0f); sv[j][h] = *(const f32x4*)(sh + (size_t)b * 9216 + col); }
#pragma unroll 1
        for (int r0 = 0; r0 < 16; r0 += RPI) {
            v4u raw[XBF ? RPI : 1][2]; f32x4 xf[XBF ? 1 : RPI][2][2];
            if constexpr (XBF) {
#pragma unroll
                for (int i = 0; i < RPI; ++i)
#pragma unroll
                    for (int j = 0; j < 2; ++j) raw[i][j] = *(const GAS v4u*)((const bf16*)xsrc + (size_t)(rowb + r0 + i) * D + 8 * lane + 512 * j);
            } else {
#pragma unroll
                for (int i = 0; i < RPI; ++i)
#pragma unroll
                    for (int j = 0; j < 2; ++j)
#pragma unroll
                        for (int h = 0; h < 2; ++h) xf[i][j][h] = *(const GAS f32x4*)((const float*)xsrc + (size_t)(rowb + r0 + i) * D + 8 * lane + 512 * j + 4 * h);
            }
#pragma unroll
            for (int i = 0; i < RPI; ++i) {
                f32x4 x[2][2];
#pragma unroll
                for (int j = 0; j < 2; ++j) {
                    if constexpr (XBF) { const v4u w = raw[i][j];
                        x[j][0] = (f32x4){__uint_as_float(w.x << 16), __uint_as_float(w.x & 0xffff0000u), __uint_as_float(w.y << 16), __uint_as_float(w.y & 0xffff0000u)};
                        x[j][1] = (f32x4){__uint_as_float(w.z << 16), __uint_as_float(w.z & 0xffff0000u), __uint_as_float(w.w << 16), __uint_as_float(w.w & 0xffff0000u)}; }
                    else { x[j][0] = xf[i][j][0]; x[j][1] = xf[i][j][1]; } }
                float ss = 0.f;
#pragma unroll
                for (int j = 0; j < 2; ++j)
#pragma unroll
                    for (int h = 0; h < 2; ++h) { const f32x4 v = x[j][h]; ss += (v.x * v.x + v.y * v.y) + (v.z * v.z + v.w * v.w); }
                const float rstd = 1.0f / sqrtf(wave_sum(ss) * (1.f / D) + RMS_EPS);
                const size_t ro = (size_t)(rowb + r0 + i) * D + 8 * lane;
                unsigned q8w[2][2];
#pragma unroll
                for (int j = 0; j < 2; ++j) { const f32x4 y0 = x[j][0] * rstd * gm[j][0] + sv[j][0], y1 = x[j][1] * rstd * gm[j][1] + sv[j][1];
                    if (Q8) { q8w[j][0] = q8pack4(y0.x, y0.y, y0.z, y0.w, 127.0f / ACT_CLIP); q8w[j][1] = q8pack4(y1.x, y1.y, y1.z, y1.w, 127.0f / ACT_CLIP); }
                    else { v4u o; o.x = pk2(y0.x, y0.y); o.y = pk2(y0.z, y0.w); o.z = pk2(y1.x, y1.y); o.w = pk2(y1.z, y1.w); *(v4u*)(hout + ro + 512 * j) = o; } }
                if (Q8) {
                    const bool odd = lane & 1;
                    const unsigned s0 = odd ? q8w[0][0] : q8w[1][0], s1 = odd ? q8w[0][1] : q8w[1][1];
                    const unsigned r0_ = (unsigned)__builtin_amdgcn_update_dpp(0, (int)s0, 0xB1, 0xf, 0xf, false), r1_ = (unsigned)__builtin_amdgcn_update_dpp(0, (int)s1, 0xB1, 0xf, 0xf, false);
                    v4u o; o.x = odd ? r0_ : q8w[0][0]; o.y = odd ? r1_ : q8w[0][1]; o.z = odd ? q8w[1][0] : r0_; o.w = odd ? q8w[1][1] : r1_;
                    const int c16 = odd ? 504 + 8 * lane : 8 * lane;
                    *(v4u*)((signed char*)hout + (size_t)(c16 >> 7) * ((size_t)M * 128) + (size_t)(rowb + r0 + i) * 128 + (c16 & 127)) = o; }
                if (i & 1) __builtin_amdgcn_sched_barrier(0);
            }
        }
    }
}
__device__ __forceinline__ void final_norm_phase(Frame& F, const bf16* xb, float* out, const float* gain) {
    const int wave = cur_wave(), gw = blockIdx.x * NWAVES + wave, NGW = F.G * NWAVES, lane = cur_lane();
    f32x4 g[2][2];
#pragma unroll
    for (int j = 0; j < 2; ++j)
#pragma unroll
        for (int h = 0; h < 2; ++h) g[j][h] = *(const f32x4*)(gain + 8 * lane + 512 * j + 4 * h);
    for (int chunk = gw; chunk < M / 16; chunk += NGW) {
        const int rowb = chunk * 16;
#pragma unroll 1
        for (int r0 = 0; r0 < 16; r0 += 8) {
            v4u raw[8][2];
#pragma unroll
            for (int i = 0; i < 8; ++i)
#pragma unroll
                for (int j = 0; j < 2; ++j) raw[i][j] = *(const GAS v4u*)(xb + (size_t)(rowb + r0 + i) * D + 8 * lane + 512 * j);
#pragma unroll
            for (int i = 0; i < 8; ++i) {
                f32x4 x[2][2];
#pragma unroll
                for (int j = 0; j < 2; ++j) { const v4u w = raw[i][j];
                    x[j][0] = (f32x4){__uint_as_float(w.x << 16), __uint_as_float(w.x & 0xffff0000u), __uint_as_float(w.y << 16), __uint_as_float(w.y & 0xffff0000u)};
                    x[j][1] = (f32x4){__uint_as_float(w.z << 16), __uint_as_float(w.z & 0xffff0000u), __uint_as_float(w.w << 16), __uint_as_float(w.w & 0xffff0000u)}; }
                float ss = 0.f;
#pragma unroll
                for (int j = 0; j < 2; ++j)
#pragma unroll
                    for (int h = 0; h < 2; ++h) { const f32x4 v = x[j][h]; ss += (v.x * v.x + v.y * v.y) + (v.z * v.z + v.w * v.w); }
                const float rstd = 1.0f / sqrtf(wave_sum(ss) * (1.f / D) + RMS_EPS);
                float* o = out + (size_t)(rowb + r0 + i) * D + 8 * lane;
#pragma unroll
                for (int j = 0; j < 2; ++j)
#pragma unroll
                    for (int h = 0; h < 2; ++h) *(f32x4*)(o + 512 * j + 4 * h) = x[j][h] * rstd * g[j][h];
                if (i & 1) __builtin_amdgcn_sched_barrier(0);
            }
        }
    }
}
__device__ __forceinline__ void group_norm_phase(Frame& F, bf16* Y, const float* gn) {
    const int wave = cur_wave(), gw = blockIdx.x * NWAVES + wave, NGW = F.G * NWAVES, lane = cur_lane();
    f32x4 g[2][2];
#pragma unroll
    for (int j = 0; j < 2; ++j)
#pragma unroll
        for (int h = 0; h < 2; ++h) g[j][h] = *(const f32x4*)(gn + 8 * lane + 512 * j + 4 * h);
    for (int chunk = gw; chunk < M / 16; chunk += NGW) {
        const int rowb = chunk * 16;
#pragma unroll 1
        for (int r0 = 0; r0 < 16; r0 += 8) {
            v4u raw[8][2];
#pragma unroll
            for (int i = 0; i < 8; ++i)
#pragma unroll
                for (int j = 0; j < 2; ++j) raw[i][j] = *(const GAS v4u*)(Y + (size_t)(rowb + r0 + i) * D + 8 * lane + 512 * j);
#pragma unroll
            for (int i = 0; i < 8; ++i) {
#pragma unroll
                for (int j = 0; j < 2; ++j) { const v4u w = raw[i][j];
                    const f32x4 x0 = {__uint_as_float(w.x << 16), __uint_as_float(w.x & 0xffff0000u), __uint_as_float(w.y << 16), __uint_as_float(w.y & 0xffff0000u)};
                    const f32x4 x1 = {__uint_as_float(w.z << 16), __uint_as_float(w.z & 0xffff0000u), __uint_as_float(w.w << 16), __uint_as_float(w.w & 0xffff0000u)};
                    float ss = ((x0.x * x0.x + x0.y * x0.y) + (x0.z * x0.z + x0.w * x0.w)) + ((x1.x * x1.x + x1.y * x1.y) + (x1.z * x1.z + x1.w * x1.w));
                    ss += dpp_f<0xB1>(ss); ss += dpp_f<0x4E>(ss); ss += dpp_f<0x141>(ss); ss += dpp_f<0x140>(ss);
                    const auto hs = __builtin_amdgcn_permlane16_swap(__float_as_uint(ss), __float_as_uint(ss), false, false);
                    const float rstd = 1.0f / sqrtf((__uint_as_float(hs[0]) + __uint_as_float(hs[1])) * (1.f / 256.f) + RMS_EPS);
                    const f32x4 y0 = x0 * rstd * g[j][0], y1 = x1 * rstd * g[j][1];
                    v4u o; o.x = pk2(y0.x, y0.y); o.y = pk2(y0.z, y0.w); o.z = pk2(y1.x, y1.y); o.w = pk2(y1.z, y1.w);
                    *(v4u*)(Y + (size_t)(rowb + r0 + i) * D + 8 * lane + 512 * j) = o; }
                if (i & 1) __builtin_amdgcn_sched_barrier(0);
            }
        }
    }
}
__device__ __forceinline__ unsigned long long causal_word(int d) { return d >= 63 ? ~0ull : (d < 0 ? 0ull : ((2ull << d) - 1ull)); }
__device__ __forceinline__ int mbcnt64(unsigned long long m) { return (int)__builtin_amdgcn_mbcnt_hi((unsigned)(m >> 32), __builtin_amdgcn_mbcnt_lo((unsigned)m, 0u)); }
__device__ __forceinline__ unsigned fkey(float x) { const unsigned u = __float_as_uint(x); return (u & 0x80000000u) ? ~u : (u | 0x80000000u); }
__device__ __forceinline__ float reduce64(const float (&o)[64], int lane) {
    float r5[32], r4[16], r3[8], r2[4], r1[2];
    { const bool hi = (lane & 32) != 0;
#pragma unroll
      for (int i = 0; i < 32; ++i) { const float a = o[i], b = o[i + 32]; r5[i] = (hi ? b : a) + __shfl_xor(hi ? a : b, 32); } }
    { const bool hi = (lane & 16) != 0;
#pragma unroll
      for (int i = 0; i < 16; ++i) { const float a = r5[i], b = r5[i + 16]; r4[i] = (hi ? b : a) + __shfl_xor(hi ? a : b, 16); } }
    { const bool hi = (lane & 8) != 0;
#pragma unroll
      for (int i = 0; i < 8; ++i) { const float a = r4[i], b = r4[i + 8]; r3[i] = (hi ? b : a) + __shfl_xor(hi ? a : b, 8); } }
    { const bool hi = (lane & 4) != 0;
#pragma unroll
      for (int i = 0; i < 4; ++i) { const float a = r3[i], b = r3[i + 4]; r2[i] = (hi ? b : a) + __shfl_xor(hi ? a : b, 4); } }
    { const bool hi = (lane & 2) != 0;
#pragma unroll
      for (int i = 0; i < 2; ++i) { const float a = r2[i], b = r2[i + 2]; r1[i] = (hi ? b : a) + __shfl_xor(hi ? a : b, 2); } }
    const bool hi = (lane & 1) != 0;
    return (hi ? r1[1] : r1[0]) + __shfl_xor(hi ? r1[0] : r1[1], 1);
}
struct KVbf {
    const bf16* K; const bf16* V; int kp, vp;
    template <int DQ> __device__ __forceinline__ float dot(int row, const LAS float* q) const {
        const v4u* p = (const v4u*)(K + (size_t)row * kp); float s = 0.f;
#pragma unroll
        for (int c = 0; c < DQ / 8; ++c) { float f[8]; unpack8(p[c], f); const f32x4 q0 = *(const LAS f32x4*)(q + 8 * c), q1 = *(const LAS f32x4*)(q + 8 * c + 4);
            s += (q0.x * f[0] + q0.y * f[1]) + (q0.z * f[2] + q0.w * f[3]) + (q1.x * f[4] + q1.y * f[5]) + (q1.z * f[6] + q1.w * f[7]); }
        return s;
    }
    __device__ __forceinline__ void axpy(int row, float pw, float (&o)[64]) const {
        const v4u* p = (const v4u*)(V + (size_t)row * vp);
#pragma unroll
        for (int c = 0; c < 8; ++c) { float f[8]; unpack8(p[c], f);
#pragma unroll
            for (int e = 0; e < 8; ++e) o[8 * c + e] += pw * f[e]; }
    }
};
struct KVf32 {
    const float* K; const float* V; int kp, vp;
    template <int DQ> __device__ __forceinline__ float dot(int row, const LAS float* q) const {
        const f32x4* p = (const f32x4*)(K + (size_t)row * kp); float s = 0.f;
#pragma unroll
        for (int c = 0; c < DQ / 4; ++c) { const f32x4 f = p[c]; const f32x4 qv = *(const LAS f32x4*)(q + 4 * c); s += (qv.x * f.x + qv.y * f.y) + (qv.z * f.z + qv.w * f.w); }
        return s;
    }
    __device__ __forceinline__ void axpy(int row, float pw, float (&o)[64]) const {
        const f32x4* p = (const f32x4*)(V + (size_t)row * vp);
#pragma unroll
        for (int c = 0; c < 16; ++c) { const f32x4 f = p[c]; o[4 * c] += pw * f.x; o[4 * c + 1] += pw * f.y; o[4 * c + 2] += pw * f.z; o[4 * c + 3] += pw * f.w; }
    }
};
template <int DQ, class KV, class KeyFn>
__device__ __forceinline__ float wave_attend(const LAS float* q, float scale, int nslots, const KeyFn& keyf, const KV& kv, int lane) {
    float m = -INFINITY;
    for (int s = 0; s < nslots; ++s) { const int key = keyf(s); if (key >= 0) m = fmaxf(m, kv.template dot<DQ>(key, q) * scale); }
    const float Mx = wave_max(m);
    float o[64];
#pragma unroll
    for (int d = 0; d < 64; ++d) o[d] = 0.f;
    float l = 0.f;
    if (Mx > -INFINITY) {
        for (int s = 0; s < nslots; ++s) { const int key = keyf(s);
            if (key >= 0) { const float p = __expf(kv.template dot<DQ>(key, q) * scale - Mx); l += p; kv.axpy(key, p, o); } }
    }
    l = wave_sum(l);
    const float r = reduce64(o, lane);
    return l > 0.f ? r / l : 0.f;
}
__device__ __forceinline__ void task_bt(int i, int& t, int& rest) { const int tt = i & 2047, j = i >> 11; t = (j & 1) ? 4095 - tt : tt; rest = j >> 1; }

__device__ __forceinline__ void m1_phase(Frame& F, int l) {
    const int skipw = F.G > 32 ? 16 : 0;
    if ((int)blockIdx.x < skipw) return;
    const int wave = cur_wave(), gw = ((int)blockIdx.x - skipw) * NWAVES + wave, NGW = (F.G - skipw) * NWAVES, lane = cur_lane();
    const bf16* CQ = (const bf16*)(F.ws + WS_CQ); const bf16* CKV = (const bf16*)(F.ws + WS_CKV);
    float* rq = (float*)(F.ws + WS_RSTDQ); float* rkv = (float*)(F.ws + WS_RSTDKV);
    for (int row0 = gw; row0 < M; row0 += 4 * NGW) {
        unsigned long long wq[4]; unsigned wk[4];
#pragma unroll
        for (int q = 0; q < 4; ++q) { const int row = row0 + q * NGW < M ? row0 + q * NGW : row0; wq[q] = ((const unsigned long long*)(CQ + (size_t)row * 256))[lane]; wk[q] = ((const unsigned*)(CKV + (size_t)row * 128))[lane]; }
#pragma unroll
        for (int q = 0; q < 4; ++q) {
            const int row = row0 + q * NGW; if (row >= M) break;
            const unsigned long long w = wq[q];
            const float a0 = __uint_as_float((unsigned)w << 16), a1 = __uint_as_float((unsigned)w & 0xffff0000u), a2 = __uint_as_float((unsigned)(w >> 32) << 16), a3 = __uint_as_float((unsigned)(w >> 32) & 0xffff0000u);
            const float s1 = wave_sum((a0 * a0 + a1 * a1) + (a2 * a2 + a3 * a3));
            const float b0 = __uint_as_float(wk[q] << 16), b1 = __uint_as_float(wk[q] & 0xffff0000u);
            const float s2 = wave_sum(b0 * b0 + b1 * b1);
            if (lane == 0) { rq[row] = 1.0f / sqrtf(s1 * (1.f / 256.f) + RMS_EPS); rkv[row] = 1.0f / sqrtf(s2 * (1.f / 128.f) + RMS_EPS); }
        }
    }
    const unsigned short* KMF = (const unsigned short*)(F.ws + WS_KM_BF); float* kmean = (float*)(F.ws + WS_KMEAN);
    for (int task = NGW - 1 - gw; task < 512; task += NGW) {
        const int b = task >> 6, blk = (task >> 2) & 15, h = task & 3;
        const unsigned short* p = KMF + ((size_t)(b * T + blk * 256)) * 256 + h * 64 + lane; float s = 0.f;
#pragma unroll 32
        for (int i = 0; i < 256; ++i) s += bf2f(p[(size_t)i * 256]);
        kmean[((b * 4 + h) * 16 + blk) * 64 + lane] = s * (1.f / 256.f);
    }
}
__device__ __forceinline__ void cmp2_phase(Frame& F, int l) {
    const int wave = cur_wave(), gw = blockIdx.x * NWAVES + wave, NGW = F.G * NWAVES, lane = cur_lane();
    const float* cmph = (const float*)(F.ws + WS_CMPH);
    for (int task = gw; task < 2 * 8 * 255; task += NGW) {
        const int kv = task / 2040, r1 = task - kv * 2040, b = r1 / 255, n = r1 - b * 255;
        const float* hp = cmph + ((size_t)(kv * 8 + b) * 256 + n) * 256;
        const float* w2 = F.A->in[kv ? I_CV2 : I_CK2] + (size_t)l * 256 * 64 + lane;
        float acc = 0.f;
#pragma unroll 32
        for (int j = 0; j < 256; ++j) acc += hp[j] * w2[j * 64];
        ((float*)(F.ws + (kv ? WS_VCMP : WS_KCMP)))[((size_t)b * 256 + n) * 64 + lane] = acc;
        ((bf16*)(F.ws + (kv ? WS_VCMPB : WS_KCMPB)))[((size_t)b * 256 + n) * 64 + lane] = (bf16)f2bf(acc);
    }
    for (int task = gw; task < 16; task += NGW) ((bf16*)(F.ws + ((task & 1) ? WS_VCMPB : WS_KCMPB)))[((size_t)(task >> 1) * 256 + 255) * 64 + lane] = 0;
}
__device__ __forceinline__ void mla_rows_phase(Frame& F) {
    const int wave = cur_wave(), gw = blockIdx.x * NWAVES + wave, NGW = F.G * NWAVES, lane = cur_lane();
    const bf16* Q = (const bf16*)(F.ws + WS_QMLA); bf16* Y = (bf16*)F.out + (size_t)M * D;
    LAS float* q = (LAS float*)(F.lds + RING_OFF + wave * 16384 + 4096);
    for (int i = gw; i < M * 4; i += NGW) {
        int t, bh; task_bt(i, t, bh); const int b = bh >> 2, h = bh & 3, row = b * T + t;
        if (lane < 48) { const unsigned w = ((const unsigned*)(Q + (size_t)row * 384 + h * 96))[lane]; q[2 * lane] = __uint_as_float(w << 16); q[2 * lane + 1] = __uint_as_float(w & 0xffff0000u); }
        LDS_WAIT(); asm volatile("" ::: "memory");
        KVbf kv{(const bf16*)(F.ws + WS_KMLA) + h * 96, (const bf16*)(F.ws + WS_VMLA) + h * 64, 384, 256};
        const int base = b * T;
        auto keyf = [&](int s) { const int p = lane + 64 * s; return p <= t ? base + p : -1; };
        const float r = wave_attend<96>(q, 0.10206207261596577f, (t >> 6) + 1, keyf, kv, lane);
        Y[(size_t)row * 1024 + 256 + h * 64 + lane] = (bf16)f2bf(r);
        LDS_WAIT(); asm volatile("" ::: "memory");
    }
}
__device__ __forceinline__ void moba_rows_phase(Frame& F) {
    const int wave = cur_wave(), gw = blockIdx.x * NWAVES + wave, NGW = F.G * NWAVES, lane = cur_lane();
    const float* QF = (const float*)(F.ws + WS_QM_F); const float* kmean = (const float*)(F.ws + WS_KMEAN); bf16* Y = (bf16*)F.out + (size_t)M * D;
    LAS float* q = (LAS float*)(F.lds + RING_OFF + wave * 16384 + 4096);
    for (int i = gw; i < M * 4; i += NGW) {
        int t, bh; task_bt(i, t, bh); const int b = bh >> 2, h = bh & 3, row = b * T + t, own = t >> 8;
        q[lane] = QF[(size_t)row * 256 + h * 64 + lane];
        LDS_WAIT(); asm volatile("" ::: "memory");
        float g = -INFINITY;
        if (lane < own) { KVf32 km{kmean + (size_t)((b * 4 + h) * 16) * 64, nullptr, 64, 64}; g = km.dot<64>(lane, q); }
        unsigned selmask = 0u;
        for (int r = 0; r < 3; ++r) { const float mx = wave_max(g); if (!(mx > -INFINITY)) break;
            const unsigned long long ball = __ballot(g == mx); const int sl = __ffsll((long long)ball) - 1; selmask |= 1u << sl; if (lane == sl) g = -INFINITY; }
        KVbf kv{(const bf16*)(F.ws + WS_KM_BF) + h * 64, (const bf16*)(F.ws + WS_VM_BF) + h * 64, 256, 256};
        const int base = b * T;
        auto keyf = [&](int s) { const int blk = s >> 2, p = 64 * s + lane; return blk == own ? (p <= t ? base + p : -1) : (((selmask >> blk) & 1u) ? base + p : -1); };
        const float r = wave_attend<64>(q, 0.125f, 4 * own + 4, keyf, kv, lane);
        Y[(size_t)row * 1024 + h * 64 + lane] = (bf16)f2bf(r);
        LDS_WAIT(); asm volatile("" ::: "memory");
    }
}
__device__ __forceinline__ void nsa_tokens_phase(Frame& F) {
    const int wave = cur_wave(), gw = blockIdx.x * NWAVES + wave, NGW = F.G * NWAVES, lane = cur_lane();
    const bf16* QN = (const bf16*)(F.ws + WS_QN); bf16* Y = (bf16*)F.out + (size_t)M * D;
    const float* kcmp = (const float*)(F.ws + WS_KCMP); const float* vcmp = (const float*)(F.ws + WS_VCMP); const float* GWp = (const float*)(F.ws + WS_GW);
    LAS float* ps = (LAS float*)(F.lds + RING_OFF + wave * 16384);
    LAS float* ocs = ps + 256;
    LAS float* svl = ps + 512;
    LAS float* q = (LAS float*)(F.lds + RING_OFF + wave * 16384 + 4096);
    for (int i = gw; i < M; i += NGW) {
        int t, b; task_bt(i, t, b); const int row = b * T + t, own = t >> 6, base = b * T;
#pragma unroll
        for (int k = 0; k < 4; ++k) ps[lane + 64 * k] = 0.f;
#pragma unroll 1
        for (int h = 0; h < 4; ++h) {
            LDS_WAIT(); asm volatile("" ::: "memory");
            q[lane] = bf2f(QN[(size_t)row * 256 + h * 64 + lane]);
            LDS_WAIT(); asm volatile("" ::: "memory");
            KVf32 kc{kcmp + (size_t)b * 256 * 64, vcmp + (size_t)b * 256 * 64, 64, 64};
            float ml = -INFINITY;
#pragma unroll 1
            for (int k = 0; k < 4; ++k) { const int n = lane + 64 * k; const bool valid = (n < 255) && (16 * n + 31 <= t);
                float sv = -INFINITY; if (valid) sv = kc.dot<64>(n, q) * 0.125f; svl[n] = sv; ml = fmaxf(ml, sv); }
            const float Mx = wave_max(ml);
            float o[64];
#pragma unroll
            for (int d = 0; d < 64; ++d) o[d] = 0.f;
#ifndef NSA_NO_C
            if (Mx > -INFINITY) {
                float ls = 0.f;
#pragma unroll 1
                for (int k = 0; k < 4; ++k) { const float sv = svl[lane + 64 * k]; const float p = sv > -INFINITY ? __expf(sv - Mx) : 0.f; ls += p; svl[lane + 64 * k] = p; }
                const float inv = 1.0f / wave_sum(ls);
#pragma unroll 1
                for (int k = 0; k < 4; ++k) { const float p = svl[lane + 64 * k] * inv; ps[lane + 64 * k] += p; if (p > 0.f) kc.axpy(lane + 64 * k, p, o); }
            }
#endif
            ocs[h * 64 + lane] = reduce64(o, lane);
        }
        LDS_WAIT(); asm volatile("" ::: "memory");
        float imp = (ps[4 * lane] + ps[4 * lane + 1]) + (ps[4 * lane + 2] + ps[4 * lane + 3]); if (lane > 0) imp += ps[4 * lane - 1];
        LDS_WAIT(); asm volatile("" ::: "memory");
        const bool causal = lane <= own, forced = causal && (lane == 0 || lane >= own - 1);
        float val = forced ? 1e4f : (causal ? imp : -INFINITY);
        unsigned long long selmask = 0ull;
        for (int r = 0; r < 16; ++r) { const float mx = wave_max(val); if (!(mx > -INFINITY)) break;
            const unsigned long long ball = __ballot(val == mx); const int sl = __ffsll((long long)ball) - 1; selmask |= 1ull << sl; if (lane == sl) val = -INFINITY; }
#ifdef FLASH_NSA
        if (lane == 0) ((unsigned long long*)(F.ws + WS_NSEL))[row] = selmask;
#pragma unroll
        for (int h = 0; h < 4; ++h) ((bf16*)(F.ws + WS_OC))[(size_t)row * 256 + h * 64 + lane] = (bf16)f2bf(ocs[h * 64 + lane]);
        LDS_WAIT(); asm volatile("" ::: "memory");
        continue;
#endif
#pragma unroll 1
        for (int h = 0; h < 4; ++h) {
            LDS_WAIT(); asm volatile("" ::: "memory");
            q[lane] = bf2f(QN[(size_t)row * 256 + h * 64 + lane]);
            LDS_WAIT(); asm volatile("" ::: "memory");
            KVbf ks{(const bf16*)(F.ws + WS_KS), (const bf16*)(F.ws + WS_VS), 64, 64};
            auto keys = [&](int s) { const int p = 64 * s + lane; return (((selmask >> s) & 1ull) && p <= t) ? base + p : -1; };
#ifdef NSA_NO_S
            float os = q[3];
#else
            float os = wave_attend<64>(q, 0.125f, own + 1, keys, ks, lane);
            asm volatile("" : "+v"(os) :: "memory");
#endif
            KVbf kw{(const bf16*)(F.ws + WS_KW), (const bf16*)(F.ws + WS_VW), 64, 64};
            auto keyw = [&](int s) { const int p = t - 511 + lane + 64 * s; return p >= 0 ? base + p : -1; };
#ifdef NSA_NO_W
            float ow = q[5];
#else
            float ow = wave_attend<64>(q, 0.125f, 8, keyw, kw, lane);
            asm volatile("" : "+v"(ow) :: "memory");
#endif
            const float* gp = GWp + (size_t)row * 32 + h * 3;
            const float g0 = sigmoid_f(gp[0]), g1 = sigmoid_f(gp[1]), g2 = sigmoid_f(gp[2]);
            Y[(size_t)row * 1024 + 512 + h * 64 + lane] = (bf16)f2bf(g0 * ocs[h * 64 + lane] + g1 * os + g2 * ow);
        }
    }
}
__device__ __forceinline__ void dsa_tokens_phase(Frame& F) {
    const int wave = cur_wave(), gw = blockIdx.x * NWAVES + wave, NGW = F.G * NWAVES, lane = cur_lane();
    const float* IQ = (const float*)(F.ws + WS_IQ); const float* IK = (const float*)(F.ws + WS_IK); const float* GWp = (const float*)(F.ws + WS_GW);
    const bf16* QD = (const bf16*)(F.ws + WS_QD); bf16* Y = (bf16*)F.out + (size_t)M * D;
    LAS float* sc = (LAS float*)(F.lds + RING_OFF + wave * 16384);
    LAS unsigned* hist = (LAS unsigned*)(F.lds + XTRA_OFF + wave * XTRA_WAVE);
    LAS unsigned short* idx = (LAS unsigned short*)hist;
    LAS float* xq = (LAS float*)(F.lds + XTRA_OFF + wave * XTRA_WAVE + 1024);
    for (int i = gw; i < M; i += NGW) {
        int t, b; task_bt(i, t, b); const int row = b * T + t, base = b * T, n = t + 1;
#pragma unroll
        for (int k = 0; k < 4; ++k) xq[lane + 64 * k] = IQ[(size_t)row * 256 + lane + 64 * k];
        if (lane < 8) xq[256 + lane] = GWp[(size_t)row * 32 + 12 + lane];
        LDS_WAIT(); asm volatile("" ::: "memory");
        for (int k0 = 0; k0 < n; k0 += 64) {
            const int key = k0 + lane;
            if (key < n) {
                float ik[32];
                { const f32x4* kp = (const f32x4*)(IK + (size_t)(base + key) * 32);
#pragma unroll
                  for (int c = 0; c < 8; ++c) { const f32x4 f = kp[c]; ik[4 * c] = f.x; ik[4 * c + 1] = f.y; ik[4 * c + 2] = f.z; ik[4 * c + 3] = f.w; } }
                float score = 0.f;
#pragma unroll
                for (int h = 0; h < 8; ++h) { float ds = 0.f;
#pragma unroll
                    for (int c = 0; c < 8; ++c) { const f32x4 qv = *(const LAS f32x4*)(xq + h * 32 + 4 * c); ds += (qv.x * ik[4 * c] + qv.y * ik[4 * c + 1]) + (qv.z * ik[4 * c + 2] + qv.w * ik[4 * c + 3]); }
                    score += xq[256 + h] * fmaxf(ds, 0.f); }
                sc[key] = score * 0.0625f + 0.0f;
            }
        }
        LDS_WAIT(); asm volatile("" ::: "memory");
        int nsel = n;
        if (n > 256) {
            unsigned prefix = 0u, pmask = 0u; int kk = 256;
            for (int pass = 0; pass < 4; ++pass) {
                const int shift = 24 - 8 * pass;
#pragma unroll
                for (int k = 0; k < 4; ++k) hist[lane + 64 * k] = 0u;
                LDS_WAIT(); asm volatile("" ::: "memory");
                for (int k0 = 0; k0 < n; k0 += 64) { const int key = k0 + lane;
                    if (key < n) { const unsigned u = fkey(sc[key]); if ((u & pmask) == prefix) __hip_atomic_fetch_add(hist + ((u >> shift) & 255u), 1u, __ATOMIC_RELAXED, __HIP_MEMORY_SCOPE_WORKGROUP); } }
                LDS_WAIT(); asm volatile("" ::: "memory");
                const int h0 = (int)hist[4 * lane], h1 = (int)hist[4 * lane + 1], h2 = (int)hist[4 * lane + 2], h3 = (int)hist[4 * lane + 3];
                const int tot = (h0 + h1) + (h2 + h3); int incl = tot;
#pragma unroll
                for (int o = 1; o < 64; o <<= 1) { const int v = __shfl_down(incl, o); if (lane + o < 64) incl += v; }
                int run = incl - tot, found = -1, newk = 0;
                if (run < kk && run + h3 >= kk) { found = 4 * lane + 3; newk = kk - run; } run += h3;
                if (found < 0 && run < kk && run + h2 >= kk) { found = 4 * lane + 2; newk = kk - run; } run += h2;
                if (found < 0 && run < kk && run + h1 >= kk) { found = 4 * lane + 1; newk = kk - run; } run += h1;
                if (found < 0 && run < kk && run + h0 >= kk) { found = 4 * lane; newk = kk - run; }
                const unsigned long long ball = __ballot(found >= 0); const int src = __ffsll((long long)ball) - 1;
                const int bin = __shfl(found, src); kk = __shfl(newk, src);
                prefix |= (unsigned)bin << shift; pmask |= 255u << shift;
                LDS_WAIT(); asm volatile("" ::: "memory");
            }
            int eqseen = 0, cnt = 0;
            for (int k0 = 0; k0 < n; k0 += 64) { const int key = k0 + lane; const bool inb = key < n; const unsigned u = inb ? fkey(sc[key]) : 0u;
                const bool gt = inb && u > prefix, eq = inb && u == prefix;
                const unsigned long long be = __ballot(eq); const bool sel = gt || (eq && (eqseen + mbcnt64(be)) < kk);
                const unsigned long long bs = __ballot(sel); if (sel) idx[cnt + mbcnt64(bs)] = (unsigned short)key;
#ifdef FLASH_DSA
                if (lane == 0) ((unsigned long long*)(F.ws + WS_DSAMASK))[(size_t)row * 64 + (k0 >> 6)] = bs;
#endif
                eqseen += __popcll(be); cnt += __popcll(bs); }
            nsel = cnt;
            LDS_WAIT(); asm volatile("" ::: "memory");
        }
#ifdef FLASH_DSA
        if (n <= 256) { for (int k0 = 0; k0 < n; k0 += 64) if (lane == 0) ((unsigned long long*)(F.ws + WS_DSAMASK))[(size_t)row * 64 + (k0 >> 6)] = causal_word(t - k0); }
        continue;
#endif
        int kidx[4];
#pragma unroll
        for (int k = 0; k < 4; ++k) { const int p = lane + 64 * k; kidx[k] = p < nsel ? base + (n > 256 ? (int)idx[p] : p) : -1; }
        LDS_WAIT(); asm volatile("" ::: "memory");
#pragma unroll 1
        for (int h = 0; h < 4; ++h) {
            LDS_WAIT(); asm volatile("" ::: "memory");
            xq[lane] = bf2f(QD[(size_t)row * 256 + h * 64 + lane]);
            LDS_WAIT(); asm volatile("" ::: "memory");
            KVbf kd{(const bf16*)(F.ws + WS_KD), (const bf16*)(F.ws + WS_VD), 64, 64};
            auto keyf = [&](int s) { return s == 0 ? kidx[0] : s == 1 ? kidx[1] : s == 2 ? kidx[2] : kidx[3]; };
            const float r = wave_attend<64>(xq, 0.125f, 4, keyf, kd, lane);
            Y[(size_t)row * 1024 + 768 + h * 64 + lane] = (bf16)f2bf(r);
        }
        LDS_WAIT(); asm volatile("" ::: "memory");
    }
}
typedef float f32x16 __attribute__((ext_vector_type(16)));
__device__ __forceinline__ float xhalf_max(float v) { const auto rr = __builtin_amdgcn_permlane32_swap(__float_as_uint(v), __float_as_uint(v), false, false); return fmaxf(__uint_as_float(rr[0]), __uint_as_float(rr[1])); }
__device__ __forceinline__ float xhalf_sum(float v) { const auto rr = __builtin_amdgcn_permlane32_swap(__float_as_uint(v), __float_as_uint(v), false, false); return __uint_as_float(rr[0]) + __uint_as_float(rr[1]); }
__device__ __forceinline__ float xhalf_other(float v, int hh) { const auto rr = __builtin_amdgcn_permlane32_swap(__float_as_uint(v), __float_as_uint(v), false, false); return __uint_as_float(hh ? rr[0] : rr[1]); }
constexpr int FL_KP96 = 208, FL_KP64 = 144, FL_VP = 144;
constexpr int FL_KBUF = 0, FL_KBUF_SZ = 64 * FL_KP96, FL_VBUF = 2 * FL_KBUF_SZ, FL_VBUF_SZ = 64 * FL_VP;
constexpr int FL_TL = FL_VBUF + 2 * FL_VBUF_SZ, FL_TLN = FL_TL + 64, FL_ORM = FL_TLN + 8, FL_SEL = FL_TL + 128;
constexpr int FL_END = FL_SEL + 512;
static_assert(FL_END <= RING_BYTES, "flash LDS map");
struct FlashKV { const bf16* K; const bf16* V; int kp, vp; };


template <int MODE>
__device__ __forceinline__ void fl_softmax(f32x16& p0, f32x16& p1, const unsigned long long word, const int h, const float sc2, float& m, float& lsum, float& alpha) {
    p0[0] = __builtin_fmaxf(p0[0], -3.0e38f); p1[0] = __builtin_fmaxf(p1[0], -3.0e38f);
    float mx, mx2;
    asm("v_max3_f32 %0, %1, %2, %3" : "=v"(mx) : "v"(p0[0]), "v"(p0[1]), "v"(p0[2]));
    asm("v_max3_f32 %0, %1, %2, %3" : "=v"(mx2) : "v"(p1[0]), "v"(p1[1]), "v"(p1[2]));
#pragma unroll
    for (int i = 3; i < 15; i += 2) { asm("v_max3_f32 %0, %1, %2, %3" : "=v"(mx) : "v"(mx), "v"(p0[i]), "v"(p0[i + 1])); asm("v_max3_f32 %0, %1, %2, %3" : "=v"(mx2) : "v"(mx2), "v"(p1[i]), "v"(p1[i + 1])); }
    asm("v_max3_f32 %0, %1, %2, %3" : "=v"(mx) : "v"(mx), "v"(p0[15]), "v"(p1[15]));
    mx = fmaxf(mx, mx2);
    mx = xhalf_max(mx);
    const float mn = fmaxf(m, mx * sc2);
    alpha = __builtin_amdgcn_exp2f(m - mn); lsum *= alpha;
    m = mn;
    typedef float f32x2_ __attribute__((ext_vector_type(2)));
    const float nm1 = (MODE == 1 && word == 0ull) ? -INFINITY : -mn;
    const f32x2_ scv = {sc2, sc2}, nmv = {nm1, nm1};
    f32x2_ psv = {0.f, 0.f};
    const int wlo = (int)((unsigned)word >> (4 * h)), whi = (int)((unsigned)(word >> 32) >> (4 * h));
#pragma unroll
    for (int i = 0; i < 16; i += 2) {
        const f32x2_ a0 = (f32x2_){p0[i], p0[i + 1]} * scv + nmv, a1 = (f32x2_){p1[i], p1[i + 1]} * scv + nmv;
        float e00 = __builtin_amdgcn_exp2f(a0.x), e01 = __builtin_amdgcn_exp2f(a0.y), e10 = __builtin_amdgcn_exp2f(a1.x), e11 = __builtin_amdgcn_exp2f(a1.y);
        if (MODE == 2) { const int bit = (i & 3) + 8 * (i >> 2);
            int k00, k01, k10, k11;
            asm("v_bfe_i32 %0, %1, %2, 1" : "=v"(k00) : "v"(wlo), "n"(bit)); asm("v_bfe_i32 %0, %1, %2, 1" : "=v"(k01) : "v"(wlo), "n"(bit + 1));
            asm("v_bfe_i32 %0, %1, %2, 1" : "=v"(k10) : "v"(whi), "n"(bit)); asm("v_bfe_i32 %0, %1, %2, 1" : "=v"(k11) : "v"(whi), "n"(bit + 1));
            e00 = __int_as_float(__float_as_int(e00) & k00); e01 = __int_as_float(__float_as_int(e01) & k01); e10 = __int_as_float(__float_as_int(e10) & k10); e11 = __int_as_float(__float_as_int(e11) & k11); }
        p0[i] = e00; p0[i + 1] = e01; p1[i] = e10; p1[i + 1] = e11;
        psv += (f32x2_){e00, e01} + (f32x2_){e10, e11};
    }
    const float ps = psv.x + psv.y;
    lsum += ps;
}
template <int DQK, class MaskFn>
__device__ __forceinline__ void flash_unit(LAS unsigned char* lds, const FlashKV kv, const bf16* qrow, const float sc2  , const int ntiles,
                                           const MaskFn& maskf, f32x16& o0, f32x16& o1, float& lsum) {
    constexpr int KP = (DQK == 96) ? FL_KP96 : FL_KP64, NKS = DQK / 16, CPR = DQK / 8;
    const int tid = cur_tid(), lane = tid & 63, r = lane & 31, h = lane >> 5;
    const LAS unsigned char* tl = lds + FL_TL;
    bf16x8 qf[NKS];
#pragma unroll
    for (int ks = 0; ks < NKS; ++ks) qf[ks] = *(const GAS bf16x8*)(qrow + 16 * ks + 8 * h);
    const int kr0 = tid / CPR, kc0 = tid - kr0 * CPR;
    const int kr1 = (tid + 512) / CPR, kc1 = (tid + 512) - kr1 * CPR;
    const bool has2 = (DQK == 96) && (tid < 256);
    const int vr = tid >> 3, vc = tid & 7;
    struct StageRegs { v4u k0, k1, v; };
    StageRegs S0, S1; S0.k1 = (v4u){0u, 0u, 0u, 0u}; S1.k1 = (v4u){0u, 0u, 0u, 0u};
    auto gload = [&](StageRegs& S, int tile) {
        const size_t rowb = (size_t)tile * 64;
        S.k0 = *(const GAS v4u*)(kv.K + (rowb + kr0) * kv.kp + 8 * kc0);
        if (DQK == 96) S.k1 = *(const GAS v4u*)(kv.K + (rowb + (has2 ? kr1 : kr0)) * kv.kp + 8 * (has2 ? kc1 : kc0));
        S.v = *(const GAS v4u*)(kv.V + (rowb + vr) * kv.vp + 8 * vc);
    };
    auto lstore = [&](const StageRegs& S, int buf) {
        LAS unsigned char* Kb = lds + FL_KBUF + buf * FL_KBUF_SZ; LAS unsigned char* Vb = lds + FL_VBUF + buf * FL_VBUF_SZ;
        *(LAS v4u*)(Kb + kr0 * KP + 16 * kc0) = S.k0;
        if (has2) *(LAS v4u*)(Kb + kr1 * KP + 16 * kc1) = S.k1;
        *(LAS v4u*)(Vb + vr * FL_VP + 16 * vc) = S.v;
    };
    float m = -1e30f; lsum = 0.f;
    __syncthreads();
#pragma unroll
    for (int i = 0; i < 16; ++i) { o0[i] = 0.f; o1[i] = 0.f; }
    unsigned long long wnext = 0ull;
    if (ntiles > 0) { wnext = maskf((int)tl[0]); gload(S0, (int)tl[0]); lstore(S0, 0); }
    if (ntiles > 0) gload(S1, (int)tl[ntiles > 1 ? 1 : 0]);
#pragma unroll
    for (int ks = 0; ks < NKS; ++ks) asm volatile("" :: "v"(qf[ks]));
    __syncthreads();
    auto step = [&](const int it, StageRegs& Sload, const StageRegs& Sstore) __attribute__((always_inline)) {
        const int cur = it & 1;
        const unsigned long long word = wnext;
        wnext = maskf((int)tl[it + 1 < ntiles ? it + 1 : ntiles - 1]);
        gload(Sload, (int)tl[it + 2 < ntiles ? it + 2 : ntiles - 1]);
        if (!__all(word == 0ull)) {
            const LAS unsigned char* Kb = lds + FL_KBUF + cur * FL_KBUF_SZ; const LAS unsigned char* Vb = lds + FL_VBUF + cur * FL_VBUF_SZ;
            f32x16 p0, p1;
#pragma unroll
            for (int i = 0; i < 16; ++i) { p0[i] = 0.f; p1[i] = 0.f; }
#pragma unroll
            for (int ks = 0; ks < NKS; ++ks) {
                const bf16x8 a0 = *(const LAS bf16x8*)(Kb + r * KP + (16 * ks + 8 * h) * 2), a1 = *(const LAS bf16x8*)(Kb + (32 + r) * KP + (16 * ks + 8 * h) * 2);
                p0 = __builtin_amdgcn_mfma_f32_32x32x16_bf16(a0, qf[ks], p0, 0, 0, 0);
                p1 = __builtin_amdgcn_mfma_f32_32x32x16_bf16(a1, qf[ks], p1, 0, 0, 0);
            }
            float alpha;
            if (__all(word == ~0ull)) fl_softmax<0>(p0, p1, word, h, sc2, m, lsum, alpha);
            else if (__all(word == ~0ull || word == 0ull)) fl_softmax<1>(p0, p1, word, h, sc2, m, lsum, alpha);
            else fl_softmax<2>(p0, p1, word, h, sc2, m, lsum, alpha);
#pragma unroll
            for (int i = 0; i < 16; ++i) { o0[i] *= alpha; o1[i] *= alpha; }
            bf16x8 pf[4];
#pragma unroll
            for (int s = 0; s < 4; ++s) { v4u w;
                if (s < 2) { w.x = pg8::cvt_pk_bf16(p0[8 * s], p0[8 * s + 1]); w.y = pg8::cvt_pk_bf16(p0[8 * s + 2], p0[8 * s + 3]); w.z = pg8::cvt_pk_bf16(p0[8 * s + 4], p0[8 * s + 5]); w.w = pg8::cvt_pk_bf16(p0[8 * s + 6], p0[8 * s + 7]); }
                else { const int s2 = s - 2; w.x = pg8::cvt_pk_bf16(p1[8 * s2], p1[8 * s2 + 1]); w.y = pg8::cvt_pk_bf16(p1[8 * s2 + 2], p1[8 * s2 + 3]); w.z = pg8::cvt_pk_bf16(p1[8 * s2 + 4], p1[8 * s2 + 5]); w.w = pg8::cvt_pk_bf16(p1[8 * s2 + 6], p1[8 * s2 + 7]); }
                pf[s] = __builtin_bit_cast(bf16x8, w); }
            {
                typedef short v4i16_t __attribute__((ext_vector_type(4)));
                const LAS unsigned char* vbase = Vb + (4 * h + ((lane & 15) >> 2)) * FL_VP + (16 * ((lane >> 4) & 1) + 4 * (lane & 3)) * 2;
#pragma unroll
                for (int s = 0; s < 4; ++s) {
#pragma unroll
                    for (int db = 0; db < 2; ++db) {
                        const LAS unsigned char* vp_ = vbase + (32 * (s >> 1) + 16 * (s & 1)) * FL_VP + 64 * db;
                        const v4i16_t lo = __builtin_amdgcn_ds_read_tr16_b64_v4i16((LAS v4i16_t*)vp_), hi = __builtin_amdgcn_ds_read_tr16_b64_v4i16((LAS v4i16_t*)(vp_ + 8 * FL_VP));
                        const bf16x8 a = {lo[0], lo[1], lo[2], lo[3], hi[0], hi[1], hi[2], hi[3]};
                        if (db == 0) o0 = __builtin_amdgcn_mfma_f32_32x32x16_bf16(a, pf[s], o0, 0, 0, 0);
                        else o1 = __builtin_amdgcn_mfma_f32_32x32x16_bf16(a, pf[s], o1, 0, 0, 0);
                    }
                }
            }
        }
        if (it + 1 < ntiles) lstore(Sstore, cur ^ 1);
        __syncthreads();
    };
    for (int it = 0; it < ntiles; it += 2) { step(it, S0, S1); if (it + 1 < ntiles) step(it + 1, S1, S0); }
}
__device__ __forceinline__ void flash_store(bf16* yrow  , const f32x16& o0, const f32x16& o1, float inv, int h) {
#pragma unroll
    for (int g = 0; g < 4; g += 2) {
#pragma unroll
        for (int half = 0; half < 2; ++half) {
            const f32x16& o = half ? o1 : o0;
            const unsigned ax = pg8::cvt_pk_bf16(o[4 * g] * inv, o[4 * g + 1] * inv), ay = pg8::cvt_pk_bf16(o[4 * g + 2] * inv, o[4 * g + 3] * inv);
            const unsigned bx = pg8::cvt_pk_bf16(o[4 * g + 4] * inv, o[4 * g + 5] * inv), by = pg8::cvt_pk_bf16(o[4 * g + 6] * inv, o[4 * g + 7] * inv);
            asm volatile("s_nop 1");
            const auto sx = __builtin_amdgcn_permlane32_swap(ax, bx, false, false); const auto sy = __builtin_amdgcn_permlane32_swap(ay, by, false, false);
            const v4u w = {sx[0], sy[0], sx[1], sy[1]};
            *(v4u*)(yrow + 32 * half + 8 * (g + h)) = w;
        }
    }
}

__device__ __forceinline__ void mla_flash_phase(Frame& F) {
    const int tid = cur_tid(), wave = cur_wave(), lane = tid & 63, r = lane & 31, h2 = lane >> 5;
    bf16* Y = (bf16*)F.out + (size_t)M * D;
    for (int pass = 0; pass < 2; ++pass) {
        for (int u0 = blockIdx.x; u0 < 256; u0 += F.G) {
            const int u = pass ? 511 - u0 : u0, qb = u >> 5, bh = u & 31, b = bh >> 2, hd = bh & 3;
            const int t = 256 * qb + 32 * wave + r; const size_t row = (size_t)b * T + t;
            LAS unsigned char* tl = F.lds + FL_TL;
            if (tid < 64) tl[tid] = (unsigned char)tid;
            const int ntiles = 4 * qb + 4;
            FlashKV kv{(const bf16*)(F.ws + WS_KMLA) + (size_t)b * T * 384 + hd * 96, (const bf16*)(F.ws + WS_VMLA) + (size_t)b * T * 256 + hd * 64, 384, 256};
            auto maskf = [&](int tile) { return causal_word(t - 64 * tile); };
            f32x16 o0, o1; float ls;
            flash_unit<96>(F.lds, kv, (const bf16*)(F.ws + WS_QMLA) + row * 384 + hd * 96, 0.10206207261596577f * 1.4426950408889634f, ntiles, maskf, o0, o1, ls);
            ls = xhalf_sum(ls);
            flash_store(Y + row * 1024 + 256 + hd * 64, o0, o1, ls > 0.f ? 1.0f / ls : 0.f, h2);
        }
    }
}

__device__ __forceinline__ void moba_flash_phase(Frame& F) {
    const int tid = cur_tid(), wave = cur_wave(), lane = tid & 63, r = lane & 31, h2 = lane >> 5;
    bf16* Y = (bf16*)F.out + (size_t)M * D;
    const bf16* QF = (const bf16*)(F.ws + WS_QM_BF); const float* kmean = (const float*)(F.ws + WS_KMEAN);
    LAS unsigned short* msel = (LAS unsigned short*)(F.lds + FL_SEL); LAS unsigned* orm = (LAS unsigned*)(F.lds + FL_ORM); LAS unsigned char* tl = F.lds + FL_TL; LAS int* tln = (LAS int*)(F.lds + FL_TLN);
    for (int pass = 0; pass < 2; ++pass) {
        for (int u0 = blockIdx.x; u0 < 256; u0 += F.G) {
            const int u = pass ? 511 - u0 : u0, own = u >> 5, bh = u & 31, b = bh >> 2, hd = bh & 3;
            if (tid == 0) orm[0] = 0u;
            __syncthreads();
            if (tid < 256) {
                const bf16* qp = QF + ((size_t)b * T + 256 * own + tid) * 256 + hd * 64;
                const float* km = kmean + (size_t)((b * 4 + hd) * 16) * 64;
                f32x4 qv[16];
#pragma unroll
                for (int c = 0; c < 8; ++c) { const v4u w = *(const v4u*)(qp + 8 * c); float t8[8]; unpack8(w, t8);
                    qv[2 * c] = (f32x4){t8[0], t8[1], t8[2], t8[3]}; qv[2 * c + 1] = (f32x4){t8[4], t8[5], t8[6], t8[7]}; }
                float g[15];
#pragma unroll
                for (int j = 0; j < 15; ++j) { g[j] = 0.f;
                    if (j < own) { float a = 0.f;
#pragma unroll
                        for (int c = 0; c < 16; ++c) { const f32x4 kv4 = *(const f32x4*)(km + j * 64 + 4 * c); a += (qv[c].x * kv4.x + qv[c].y * kv4.y) + (qv[c].z * kv4.z + qv[c].w * kv4.w); }
                        g[j] = a; } }
                unsigned sel = 0u;
#pragma unroll
                for (int rr = 0; rr < 3; ++rr) { float best = -INFINITY; int bi = -1;
#pragma unroll
                    for (int j = 0; j < 15; ++j) if (j < own && !((sel >> j) & 1u) && g[j] > best) { best = g[j]; bi = j; }
                    if (bi >= 0) sel |= 1u << bi; }
                msel[tid] = (unsigned short)sel;
                __hip_atomic_fetch_or(orm, sel, __ATOMIC_RELAXED, __HIP_MEMORY_SCOPE_WORKGROUP);
            }
            __syncthreads();
            if (tid == 0) { const unsigned om = orm[0]; int n = 0;
                for (int j = 0; j < own; ++j) if ((om >> j) & 1u) { for (int q4 = 0; q4 < 4; ++q4) tl[n++] = (unsigned char)(4 * j + q4); }
                for (int q4 = 0; q4 < 4; ++q4) tl[n++] = (unsigned char)(4 * own + q4);
                tln[0] = n; }
            __syncthreads();
            const int ntiles = tln[0];
            const int tq = 32 * wave + r, t = 256 * own + tq; const size_t row = (size_t)b * T + t;
            const unsigned mysel = msel[tq];
            FlashKV kv{(const bf16*)(F.ws + WS_KM_BF) + (size_t)b * T * 256 + hd * 64, (const bf16*)(F.ws + WS_VM_BF) + (size_t)b * T * 256 + hd * 64, 256, 256};
            auto maskf = [&](int tile) { const int blk = tile >> 2; return blk == own ? causal_word(t - 64 * tile) : (((mysel >> blk) & 1u) ? ~0ull : 0ull); };
            f32x16 o0, o1; float ls;
            flash_unit<64>(F.lds, kv, (const bf16*)(F.ws + WS_QM_BF) + row * 256 + hd * 64, 0.125f * 1.4426950408889634f, ntiles, maskf, o0, o1, ls);
            ls = xhalf_sum(ls);
            flash_store(Y + row * 1024 + hd * 64, o0, o1, ls > 0.f ? 1.0f / ls : 0.f, h2);
        }
    }
}
__device__ __forceinline__ void dsa_flash_phase(Frame& F) {
    const int tid = cur_tid(), wave = cur_wave(), lane = tid & 63, r = lane & 31, h2 = lane >> 5;
    bf16* Y = (bf16*)F.out + (size_t)M * D;
    const unsigned long long* BM = (const unsigned long long*)(F.ws + WS_DSAMASK);
    for (int pass = 0; pass < 2; ++pass) {
        for (int u0 = blockIdx.x; u0 < 256; u0 += F.G) {
            const int u = pass ? 511 - u0 : u0, tb = u >> 3, b = u & 7, hd = wave >> 1;
            const int t = 64 * tb + 32 * (wave & 1) + r; const size_t row = (size_t)b * T + t;
            LAS unsigned char* tl = F.lds + FL_TL;
            __syncthreads();
            if (tid < 64) tl[tid] = (unsigned char)tid;
            const int ntiles = tb + 1;
            FlashKV kv{(const bf16*)(F.ws + WS_KD) + (size_t)b * T * 64, (const bf16*)(F.ws + WS_VD) + (size_t)b * T * 64, 64, 64};
            const unsigned long long* bmrow = BM + row * 64;
            auto maskf = [&](int tile) { return bmrow[tile]; };
            f32x16 o0, o1; float ls;
            flash_unit<64>(F.lds, kv, (const bf16*)(F.ws + WS_QD) + row * 256 + hd * 64, 0.125f * 1.4426950408889634f, ntiles, maskf, o0, o1, ls);
            ls = xhalf_sum(ls);
            flash_store(Y + row * 1024 + 768 + hd * 64, o0, o1, ls > 0.f ? 1.0f / ls : 0.f, h2);
        }
    }
}
__device__ __forceinline__ void nsa_flash_phase(Frame& F) {
    const int tid = cur_tid(), wave = cur_wave(), lane = tid & 63, r = lane & 31, h2 = lane >> 5;
    bf16* Y = (bf16*)F.out + (size_t)M * D;
    const unsigned long long* NSEL = (const unsigned long long*)(F.ws + WS_NSEL); const bf16* OC = (const bf16*)(F.ws + WS_OC); const float* GWp = (const float*)(F.ws + WS_GW);
    LAS unsigned* orm = (LAS unsigned*)(F.lds + FL_ORM); LAS unsigned char* tl = F.lds + FL_TL; LAS int* tln = (LAS int*)(F.lds + FL_TLN);
    for (int pass = 0; pass < 2; ++pass) {
        for (int u0 = blockIdx.x; u0 < 256; u0 += F.G) {
            const int u = pass ? 511 - u0 : u0, tb = u >> 3, b = u & 7, hd = wave >> 1;
            const int t = 64 * tb + 32 * (wave & 1) + r; const size_t row = (size_t)b * T + t;
            const unsigned long long mysel = NSEL[row];
            __syncthreads();
            if (tid < 2) orm[tid] = 0u;
            __syncthreads();
            if (wave < 2) { __hip_atomic_fetch_or(orm, (unsigned)mysel, __ATOMIC_RELAXED, __HIP_MEMORY_SCOPE_WORKGROUP); __hip_atomic_fetch_or(orm + 1, (unsigned)(mysel >> 32), __ATOMIC_RELAXED, __HIP_MEMORY_SCOPE_WORKGROUP); }
            __syncthreads();
            if (tid == 0) { const unsigned long long om = (unsigned long long)orm[0] | ((unsigned long long)orm[1] << 32); int n = 0;
                for (int j = 0; j <= tb; ++j) if ((om >> j) & 1ull) tl[n++] = (unsigned char)j;
                tln[0] = n; }
            __syncthreads();
            const int nsel_tiles = tln[0];
            const bf16* qrow = (const bf16*)(F.ws + WS_QN) + row * 256 + hd * 64;
            const float* gp = GWp + row * 32 + hd * 3;
            const float g0 = sigmoid_f(gp[0]), g1 = sigmoid_f(gp[1]), g2 = sigmoid_f(gp[2]);
            LAS float* stash = (LAS float*)(F.lds + 49152) + wave * 2048 + lane;
            {
                FlashKV kv{(const bf16*)(F.ws + WS_KS) + (size_t)b * T * 64, (const bf16*)(F.ws + WS_VS) + (size_t)b * T * 64, 64, 64};
                auto maskf = [&](int tile) { return ((mysel >> tile) & 1ull) ? causal_word(t - 64 * tile) : 0ull; };
                f32x16 o0, o1; float ls;
                flash_unit<64>(F.lds, kv, qrow, 0.125f * 1.4426950408889634f, nsel_tiles, maskf, o0, o1, ls);
                ls = xhalf_sum(ls); const float sc = ls > 0.f ? g1 / ls : 0.f;
                const bf16* ocr = OC + row * 256 + hd * 64;
#pragma unroll
                for (int g = 0; g < 4; ++g) { const unsigned long long w0 = *(const unsigned long long*)(ocr + 8 * g + 4 * h2), w1 = *(const unsigned long long*)(ocr + 32 + 8 * g + 4 * h2);
                    stash[(4 * g) * 64] = sc * o0[4 * g] + g0 * __uint_as_float((unsigned)w0 << 16); stash[(4 * g + 1) * 64] = sc * o0[4 * g + 1] + g0 * __uint_as_float((unsigned)w0 & 0xffff0000u);
                    stash[(4 * g + 2) * 64] = sc * o0[4 * g + 2] + g0 * __uint_as_float((unsigned)(w0 >> 32) << 16); stash[(4 * g + 3) * 64] = sc * o0[4 * g + 3] + g0 * __uint_as_float((unsigned)(w0 >> 32) & 0xffff0000u);
                    stash[(16 + 4 * g) * 64] = sc * o1[4 * g] + g0 * __uint_as_float((unsigned)w1 << 16); stash[(16 + 4 * g + 1) * 64] = sc * o1[4 * g + 1] + g0 * __uint_as_float((unsigned)w1 & 0xffff0000u);
                    stash[(16 + 4 * g + 2) * 64] = sc * o1[4 * g + 2] + g0 * __uint_as_float((unsigned)(w1 >> 32) << 16); stash[(16 + 4 * g + 3) * 64] = sc * o1[4 * g + 3] + g0 * __uint_as_float((unsigned)(w1 >> 32) & 0xffff0000u); }
            }
            f32x16 a0, a1;
            {
                __syncthreads();
                const int t0 = tb >= 8 ? tb - 8 : 0;
                if (tid < 64) tl[tid] = (unsigned char)(t0 + tid);
                FlashKV kv{(const bf16*)(F.ws + WS_KW) + (size_t)b * T * 64, (const bf16*)(F.ws + WS_VW) + (size_t)b * T * 64, 64, 64};
                auto maskf = [&](int tile) { return causal_word(t - 64 * tile) & ~causal_word(t - 512 - 64 * tile); };
                f32x16 o0, o1; float ls;
                flash_unit<64>(F.lds, kv, qrow, 0.125f * 1.4426950408889634f, tb - t0 + 1, maskf, o0, o1, ls);
                ls = xhalf_sum(ls); const float sc = ls > 0.f ? g2 / ls : 0.f;
#pragma unroll
                for (int i = 0; i < 16; ++i) { a0[i] = sc * o0[i] + stash[i * 64]; a1[i] = sc * o1[i] + stash[(16 + i) * 64]; }
            }
            flash_store(Y + row * 1024 + 512 + hd * 64, a0, a1, 1.0f, h2);
        }
    }
}

__device__ __forceinline__ int hist_pick(LAS unsigned* hist, int& kk, const int lane) {
    const int h0 = (int)hist[4 * lane], h1 = (int)hist[4 * lane + 1], h2 = (int)hist[4 * lane + 2], h3 = (int)hist[4 * lane + 3];
    const int tot = (h0 + h1) + (h2 + h3);
    int incl = tot;
    incl += __builtin_amdgcn_update_dpp(0, incl, 0x101, 0xf, 0xf, false); incl += __builtin_amdgcn_update_dpp(0, incl, 0x102, 0xf, 0xf, false);
    incl += __builtin_amdgcn_update_dpp(0, incl, 0x104, 0xf, 0xf, false); incl += __builtin_amdgcn_update_dpp(0, incl, 0x108, 0xf, 0xf, false);
    { const int t1 = __builtin_amdgcn_readlane(incl, 16), t2 = __builtin_amdgcn_readlane(incl, 32), t3 = __builtin_amdgcn_readlane(incl, 48); const int rowi = lane >> 4;
      incl += rowi == 0 ? t1 + t2 + t3 : rowi == 1 ? t2 + t3 : rowi == 2 ? t3 : 0; }
    int run = incl - tot, found = -1, newk = 0;
    if (run < kk && run + h3 >= kk) { found = 4 * lane + 3; newk = kk - run; } run += h3;
    if (found < 0 && run < kk && run + h2 >= kk) { found = 4 * lane + 2; newk = kk - run; } run += h2;
    if (found < 0 && run < kk && run + h1 >= kk) { found = 4 * lane + 1; newk = kk - run; } run += h1;
    if (found < 0 && run < kk && run + h0 >= kk) { found = 4 * lane; newk = kk - run; }
    const unsigned long long ball = __ballot(found >= 0); const int src = __builtin_amdgcn_readfirstlane(__ffsll((long long)ball) - 1);
    const int bin = __builtin_amdgcn_readlane(found, src); kk = __builtin_amdgcn_readlane(newk, src);
    return bin;
}
__device__ __forceinline__ float unfkey(unsigned u) { return __uint_as_float((u & 0x80000000u) ? (u ^ 0x80000000u) : ~u); }
__device__ __forceinline__ void radix_select_write(LAS float* sc, LAS unsigned* hist, unsigned long long* bmrow, const int t, const int lane) {
    const int n = t + 1;
    if (n <= 256) { for (int k0 = 0; k0 < n; k0 += 64) if (lane == 0) bmrow[k0 >> 6] = causal_word(t - k0); return; }
    for (int k = n + lane; k < ((n + 255) & ~255); k += 64) sc[k] = -INFINITY;
    LDS_WAIT(); asm volatile("" ::: "memory");
#define RS_LOAD4(k0) float x_[4]; { _Pragma("unroll") for (int j_ = 0; j_ < 4; ++j_) x_[j_] = sc[(k0) + 64 * j_ + lane]; }
    float m4[4] = {-INFINITY, -INFINITY, -INFINITY, -INFINITY};
    for (int k0 = 0; k0 < n; k0 += 256) { RS_LOAD4(k0);
#pragma unroll
        for (int j = 0; j < 4; ++j) m4[j] = fmaxf(m4[j], x_[j]); }
    float mx = fmaxf(fmaxf(m4[0], m4[1]), fmaxf(m4[2], m4[3])), mn = fminf(fminf(m4[0], m4[1]), fminf(m4[2], m4[3]));
    mn = -wave_max(-mn); mx = wave_max(mx);
    const float qs = mx > mn ? 255.99f / (mx - mn) : 1.0f, qo = -mn * qs;
#pragma unroll
    for (int k = 0; k < 4; ++k) hist[lane + 64 * k] = 0u;
    LDS_WAIT(); asm volatile("" ::: "memory");
#ifdef SEL_DUP_HIST
    for (int rep3_ = 0; rep3_ < 2; ++rep3_) {
#pragma unroll
    for (int k = 0; k < 4; ++k) hist[lane + 64 * k] = 0u;
    LDS_WAIT(); asm volatile("" ::: "memory");
#endif
    for (int k0 = 0; k0 < n; k0 += 256) { RS_LOAD4(k0);
#pragma unroll
        for (int j = 0; j < 4; ++j) { int q = (int)__builtin_fmaf(x_[j], qs, qo); q = q > 255 ? 255 : q;
            __hip_atomic_fetch_add(hist + (q < 0 ? 256 + lane : q), 1u, __ATOMIC_RELAXED, __HIP_MEMORY_SCOPE_WORKGROUP); } }
    LDS_WAIT(); asm volatile("" ::: "memory");
#ifdef SEL_DUP_HIST
    }
#endif
    int kk = 256;
    const int B = hist_pick(hist, kk, lane);
    const int cntB = (int)hist[B];
    LDS_WAIT(); asm volatile("" ::: "memory");
#ifdef FORCE_FALLBACK
    if (cntB > 0) {
#else
    if (cntB > 128) {
#endif
        unsigned prefix = 0u, pmask = 0u;
#pragma unroll 1
        for (int pass = 0; pass < 4; ++pass) {
            const int shift = 24 - 8 * pass;
#pragma unroll
            for (int k = 0; k < 4; ++k) hist[lane + 64 * k] = 0u;
            LDS_WAIT(); asm volatile("" ::: "memory");
            for (int k0 = 0; k0 < n; k0 += 256) { RS_LOAD4(k0);
#pragma unroll
                for (int j = 0; j < 4; ++j) { int q = (int)__builtin_fmaf(x_[j], qs, qo); q = q > 255 ? 255 : q;
                    if (q == B) { const unsigned u = fkey(x_[j]); if ((u & pmask) == prefix) __hip_atomic_fetch_add(hist + ((u >> shift) & 255u), 1u, __ATOMIC_RELAXED, __HIP_MEMORY_SCOPE_WORKGROUP); } } }
            LDS_WAIT(); asm volatile("" ::: "memory");
            const int bin = hist_pick(hist, kk, lane);
            prefix |= (unsigned)bin << shift; pmask |= 255u << shift;
            LDS_WAIT(); asm volatile("" ::: "memory");
        }
        int eqseen = 0;
        for (int k0 = 0; k0 < n; k0 += 256) { RS_LOAD4(k0);
#pragma unroll
            for (int j = 0; j < 4; ++j) { int q = (int)__builtin_fmaf(x_[j], qs, qo); q = q > 255 ? 255 : q;
                const unsigned u = fkey(x_[j]); const bool valid = x_[j] > -INFINITY;
                const bool gt = valid && (q > B || (q == B && u > prefix)), eq = valid && q == B && u == prefix;
                const unsigned long long be = __ballot(eq); const bool sel = gt || (eq && (eqseen + mbcnt64(be)) < kk);
                const unsigned long long bs = __ballot(sel);
                if (lane == 0 && k0 + 64 * j < n) bmrow[(k0 >> 6) + j] = bs;
                eqseen += __popcll(be); } }
        return;
    }
    LAS unsigned* bmw = hist + 256;
    LAS unsigned* cand = (LAS unsigned*)sc;
    int ncand = 0;
    unsigned mylo = 0u, myhi = 0u;
    for (int k0 = 0; k0 < n; k0 += 256) { RS_LOAD4(k0);
        asm volatile("" ::: "memory");
#pragma unroll
        for (int j = 0; j < 4; ++j) { int q = (int)__builtin_fmaf(x_[j], qs, qo); q = q > 255 ? 255 : q;
            const bool gt = q > B, inb = q == B;
            const unsigned long long bg = __ballot(gt), bi = __ballot(inb);
            { const bool mine = lane == (k0 >> 6) + j; mylo = mine ? (unsigned)bg : mylo; myhi = mine ? (unsigned)(bg >> 32) : myhi; }
            if (inb) { const int c = ncand + mbcnt64(bi); cand[2 * c] = (unsigned)(k0 + 64 * j + lane); cand[2 * c + 1] = fkey(x_[j]); }
            ncand += __popcll(bi); }
        LDS_WAIT(); asm volatile("" ::: "memory"); }
    bmw[2 * lane] = mylo; bmw[2 * lane + 1] = myhi;
    LDS_WAIT(); asm volatile("" ::: "memory");
#undef RS_LOAD4
    {
        const int c0 = lane, c1 = lane + 64;
        const unsigned k0_ = c0 < ncand ? cand[2 * c0 + 1] : 0u, k1_ = c1 < ncand ? cand[2 * c1 + 1] : 0u;
        const unsigned i0_ = c0 < ncand ? cand[2 * c0] : 0u, i1_ = c1 < ncand ? cand[2 * c1] : 0u;
        int r0 = 0, r1 = 0;
#ifdef SEL_DUP_RANK
        for (int rep3_ = 0; rep3_ < 2; ++rep3_) { r0 = 0; r1 = 0;
#endif
        for (int j = 0; j < ncand; ++j) { const unsigned kj = cand[2 * j + 1];
            r0 += (kj > k0_ || (kj == k0_ && j < c0)) ? 1 : 0; r1 += (kj > k1_ || (kj == k1_ && j < c1)) ? 1 : 0; }
#ifdef SEL_DUP_RANK
        asm volatile("" : "+v"(r0), "+v"(r1)); }
#endif
        if (c0 < ncand && r0 < kk) __hip_atomic_fetch_or(bmw + 2 * (i0_ >> 6) + ((i0_ >> 5) & 1u), 1u << (i0_ & 31u), __ATOMIC_RELAXED, __HIP_MEMORY_SCOPE_WORKGROUP);
        if (c1 < ncand && r1 < kk) __hip_atomic_fetch_or(bmw + 2 * (i1_ >> 6) + ((i1_ >> 5) & 1u), 1u << (i1_ & 31u), __ATOMIC_RELAXED, __HIP_MEMORY_SCOPE_WORKGROUP);
    }
    LDS_WAIT(); asm volatile("" ::: "memory");
    if (lane < ((n + 63) >> 6)) bmrow[lane] = (unsigned long long)bmw[2 * lane] | ((unsigned long long)bmw[2 * lane + 1] << 32);
    LDS_WAIT(); asm volatile("" ::: "memory");
}
__device__ __forceinline__ void split8(const f32x4 a, const f32x4 b, bf16x8& hi, bf16x8& lo) {
    v4u h, l;
    h.x = pg8::cvt_pk_bf16(a.x, a.y); h.y = pg8::cvt_pk_bf16(a.z, a.w); h.z = pg8::cvt_pk_bf16(b.x, b.y); h.w = pg8::cvt_pk_bf16(b.z, b.w);
    l.x = pg8::cvt_pk_bf16(a.x - __uint_as_float(h.x << 16), a.y - __uint_as_float(h.x & 0xffff0000u)); l.y = pg8::cvt_pk_bf16(a.z - __uint_as_float(h.y << 16), a.w - __uint_as_float(h.y & 0xffff0000u));
    l.z = pg8::cvt_pk_bf16(b.x - __uint_as_float(h.z << 16), b.y - __uint_as_float(h.z & 0xffff0000u)); l.w = pg8::cvt_pk_bf16(b.z - __uint_as_float(h.w << 16), b.w - __uint_as_float(h.w & 0xffff0000u));
    hi = __builtin_bit_cast(bf16x8, h); lo = __builtin_bit_cast(bf16x8, l);
}
__device__ __forceinline__ void dsa_select_phase(Frame& F, const int l, const int maxu) {
    const int tid = cur_tid(), wave = cur_wave(), lane = tid & 63, r = lane & 31, hh = lane >> 5;
    const bf16* IQ = (const bf16*)(F.ws + WS_IQ); const bf16* IK = (const bf16*)(F.ws + WS_IK); const float* GWp = (const float*)(F.ws + WS_GW);
    LAS float* sc = (LAS float*)(F.lds + RING_OFF);
    LAS unsigned* hist = (LAS unsigned*)(F.lds + XTRA_OFF + wave * XTRA_WAVE);
    bf16x8 araw[2][2]; f32x4 wraw[2][4];
    auto load_a = [&](int g_) {
        const int b_ = g_ & 7, tb8_ = 511 - (g_ >> 3); const size_t rowb = (size_t)b_ * T + 8 * tb8_;
#pragma unroll
        for (int gq = 0; gq < 2; ++gq) {
            const bf16* qp = IQ + (rowb + 4 * gq + 2 * ((r >> 2) & 1) + (r >> 4)) * 256 + (4 * ((r >> 3) & 1) + (r & 3)) * 32 + 8 * hh;
#pragma unroll
            for (int ks = 0; ks < 2; ++ks) araw[gq][ks] = *(const bf16x8*)(qp + 16 * ks);
#pragma unroll
            for (int tk = 0; tk < 4; ++tk) wraw[gq][tk] = *(const f32x4*)(GWp + (rowb + 4 * gq + 2 * hh + (tk >> 1)) * 32 + 12 + 4 * (tk & 1));
        }
    };
    unsigned* qctr = (unsigned*)(F.ctl + CW_DSAQ) + l;
    volatile LAS int* qs = (volatile LAS int*)(F.MISC + 16);
    int nf = 0;
    __syncthreads();
    if (tid == 0) { qs[0] = maxu > 0 ? (int)__hip_atomic_fetch_add(qctr, 1u, __ATOMIC_RELAXED, __HIP_MEMORY_SCOPE_AGENT) : 4096; qs[1] = maxu > 1 ? (int)__hip_atomic_fetch_add(qctr, 1u, __ATOMIC_RELAXED, __HIP_MEMORY_SCOPE_AGENT) : 4096; }
    nf = 2;
    __syncthreads();
    int gcur = qs[0], gnext = qs[1];
    if (gcur < 4096) load_a(gcur);
    {
        for (int iter = 0; gcur < 4096; ++iter) {
            int gfetch = 4096;
            if (tid == 0 && nf < maxu) gfetch = (int)__hip_atomic_fetch_add(qctr, 1u, __ATOMIC_RELAXED, __HIP_MEMORY_SCOPE_AGENT);
            ++nf;
            const int b = gcur & 7, tb8 = 511 - (gcur >> 3), t0 = 8 * tb8, nmax = t0 + 8;
            const size_t base = (size_t)b * T;
            bf16x8 ahi[2][2]; float iw[2][4][4];
#pragma unroll
            for (int gq = 0; gq < 2; ++gq) {
#pragma unroll
                for (int ks = 0; ks < 2; ++ks) ahi[gq][ks] = araw[gq][ks];
#pragma unroll
                for (int tk = 0; tk < 4; ++tk) { const f32x4 w4 = wraw[gq][tk]; iw[gq][tk][0] = w4.x; iw[gq][tk][1] = w4.y; iw[gq][tk][2] = w4.z; iw[gq][tk][3] = w4.w; }
            }
            const int nkb = (nmax + 31) >> 5;
            bf16x8 nbA[2], nbB[2];
#define DS_LOADB(dst, kb_) do { const GAS bf16* kp_ = (const GAS bf16*)(IK + (base + 32 * (kb_) + r) * 32 + 8 * hh); dst[0] = *(const GAS bf16x8*)kp_; dst[1] = *(const GAS bf16x8*)(kp_ + 16); } while (0)
#ifdef DSA_DUP_SCORE
            for (int rep2_ = 0; rep2_ < 2; ++rep2_) {
#endif
            if (wave < nkb) DS_LOADB(nbA, wave);
            if (wave + 8 < nkb) DS_LOADB(nbB, wave + 8);
            for (int kb = wave; kb < nkb; kb += 16) {
                const bool hasB = kb + 8 < nkb;
                bf16x8 bhiA[2], bhiB[2];
                bhiA[0] = nbA[0]; bhiA[1] = nbA[1];
                if (hasB) { bhiB[0] = nbB[0]; bhiB[1] = nbB[1]; } else { bhiB[0] = bhiA[0]; bhiB[1] = bhiA[1]; }
                if (kb + 16 < nkb) DS_LOADB(nbA, kb + 16);
                if (kb + 24 < nkb) DS_LOADB(nbB, kb + 24);
                f32x16 cA0, cA1, cB0, cB1;
#pragma unroll
                for (int i = 0; i < 16; ++i) { cA0[i] = 0.f; cA1[i] = 0.f; cB0[i] = 0.f; cB1[i] = 0.f; }
#pragma unroll
                for (int ks = 0; ks < 2; ++ks) {
                    cA0 = __builtin_amdgcn_mfma_f32_32x32x16_bf16(ahi[0][ks], bhiA[ks], cA0, 0, 0, 0); cA1 = __builtin_amdgcn_mfma_f32_32x32x16_bf16(ahi[1][ks], bhiA[ks], cA1, 0, 0, 0);
                    cB0 = __builtin_amdgcn_mfma_f32_32x32x16_bf16(ahi[0][ks], bhiB[ks], cB0, 0, 0, 0); cB1 = __builtin_amdgcn_mfma_f32_32x32x16_bf16(ahi[1][ks], bhiB[ks], cB1, 0, 0, 0);
                }
#define DS_EPI(c, gq, kb_) do { typedef float f32x2_ __attribute__((ext_vector_type(2))); f32x2_ a0_ = {0.f, 0.f}, a1_ = {0.f, 0.f}; _Pragma("unroll") for (int tk = 0; tk < 2; ++tk) { _Pragma("unroll") for (int j2 = 0; j2 < 2; ++j2) { \
                        a0_ = (f32x2_){fmaxf(c[4 * tk + 2 * j2], 0.f), fmaxf(c[4 * tk + 2 * j2 + 1], 0.f)} * (f32x2_){iw[gq][tk][2 * j2], iw[gq][tk][2 * j2 + 1]} + a0_; \
                        a1_ = (f32x2_){fmaxf(c[8 + 4 * tk + 2 * j2], 0.f), fmaxf(c[8 + 4 * tk + 2 * j2 + 1], 0.f)} * (f32x2_){iw[gq][2 + tk][2 * j2], iw[gq][2 + tk][2 * j2 + 1]} + a1_; } } \
                    LAS float* dst_ = sc + (4 * (gq) + 2 * hh) * 4096 + 32 * (kb_) + r; dst_[0] = (a0_.x + a0_.y) * 0.0625f; dst_[4096] = (a1_.x + a1_.y) * 0.0625f; } while (0)
                DS_EPI(cA0, 0, kb); DS_EPI(cA1, 1, kb);
                if (hasB) { DS_EPI(cB0, 0, kb + 8); DS_EPI(cB1, 1, kb + 8); }
#undef DS_EPI
            }
#ifdef DSA_DUP_SCORE
            }
#endif
#undef DS_LOADB
            if (gnext < 4096) load_a(gnext);
            if (tid == 0) qs[2 + (iter & 1)] = gfetch;
            __syncthreads();
#ifdef DSA_DUP_SEL
            for (int rep2_ = 0; rep2_ < 2; ++rep2_)
#endif
            radix_select_write(sc + wave * 4096, hist, (unsigned long long*)(F.ws + WS_DSAMASK) + (base + t0 + wave) * 64, t0 + wave, lane);
            __syncthreads();
            gcur = gnext; gnext = qs[2 + (iter & 1)];
        }
    }
}

constexpr int NS_K = 0, NS_KP = 144, NS_V = 256 * NS_KP, NS_VP = 520, NS_IMP = NS_V + 64 * NS_VP, NS_IP = 68, NS_END = NS_IMP + 64 * NS_IP * 4;
static_assert(NS_END <= RING_BYTES, "nsa select LDS map");
__device__ __forceinline__ void nsa_select_phase(Frame& F) {
    const int tid = cur_tid(), wave = cur_wave(), lane = tid & 63, r = lane & 31, hh = lane >> 5;
    LAS unsigned char* lds = F.lds;
    LAS float* imp = (LAS float*)(lds + NS_IMP);
    for (int pass = 0; pass < 2; ++pass) {
        for (int u0 = blockIdx.x; u0 < 256; u0 += F.G) {
            const int u = pass ? 511 - u0 : u0, tb = u >> 3, b = u & 7;
            __syncthreads();
            {
                const bf16* Kc = (const bf16*)(F.ws + WS_KCMPB) + (size_t)b * 256 * 64; const bf16* Vc = (const bf16*)(F.ws + WS_VCMPB) + (size_t)b * 256 * 64;
#pragma unroll
                for (int j = 0; j < 4; ++j) { const int ch = tid + 512 * j, row = ch >> 3, c8 = ch & 7;
                    *(LAS v4u*)(lds + NS_K + row * NS_KP + 16 * c8) = *(const v4u*)(Kc + row * 64 + 8 * c8);
                    const v4u vv = *(const v4u*)(Vc + row * 64 + 8 * c8);
                    LAS unsigned short* vt = (LAS unsigned short*)(lds + NS_V + (8 * c8) * NS_VP) + row;
                    vt[0 * (NS_VP / 2)] = (unsigned short)(vv.x & 0xffffu); vt[1 * (NS_VP / 2)] = (unsigned short)(vv.x >> 16); vt[2 * (NS_VP / 2)] = (unsigned short)(vv.y & 0xffffu); vt[3 * (NS_VP / 2)] = (unsigned short)(vv.y >> 16);
                    vt[4 * (NS_VP / 2)] = (unsigned short)(vv.z & 0xffffu); vt[5 * (NS_VP / 2)] = (unsigned short)(vv.z >> 16); vt[6 * (NS_VP / 2)] = (unsigned short)(vv.w & 0xffffu); vt[7 * (NS_VP / 2)] = (unsigned short)(vv.w >> 16); }
                for (int i = tid; i < 64 * NS_IP; i += 512) imp[i] = 0.f;
            }
            __syncthreads();
            const int tl_ = 8 * wave + (r >> 2), hd = r & 3, t = 64 * tb + tl_; const size_t row = (size_t)b * T + t;
            const bf16* qrow = (const bf16*)(F.ws + WS_QN) + row * 256 + hd * 64;
            bf16x8 qf[4];
#pragma unroll
            for (int ks = 0; ks < 4; ++ks) qf[ks] = *(const bf16x8*)(qrow + 16 * ks + 8 * hh);
            const int nmax = (t - 31) >> 4;
            const int ntile = ((4 * tb + 2) >> 6) + 1;
            const float sc2 = 0.125f * 1.4426950408889634f;
            auto scores = [&](int tile, f32x16& p0, f32x16& p1) {
#pragma unroll
                for (int i = 0; i < 16; ++i) { p0[i] = 0.f; p1[i] = 0.f; }
                const LAS unsigned char* Kb = lds + NS_K + (64 * tile) * NS_KP;
#pragma unroll
                for (int ks = 0; ks < 4; ++ks) {
                    const bf16x8 a0 = *(const LAS bf16x8*)(Kb + r * NS_KP + (16 * ks + 8 * hh) * 2), a1 = *(const LAS bf16x8*)(Kb + (32 + r) * NS_KP + (16 * ks + 8 * hh) * 2);
                    p0 = __builtin_amdgcn_mfma_f32_32x32x16_bf16(a0, qf[ks], p0, 0, 0, 0);
                    p1 = __builtin_amdgcn_mfma_f32_32x32x16_bf16(a1, qf[ks], p1, 0, 0, 0);
                }
            };
            float m = -1e30f, l = 0.f;
            for (int tile = 0; tile < ntile; ++tile) {
                const unsigned long long word = causal_word(nmax - 64 * tile);
                f32x16 p0, p1; scores(tile, p0, p1);
                const unsigned wlo = (unsigned)word >> (4 * hh), whi = (unsigned)(word >> 32) >> (4 * hh);
                float mx = -1e30f;
#pragma unroll
                for (int i = 0; i < 16; ++i) { const int bit = (i & 3) + 8 * (i >> 2);
                    p0[i] = ((wlo >> bit) & 1u) ? p0[i] * sc2 : -1e30f; p1[i] = ((whi >> bit) & 1u) ? p1[i] * sc2 : -1e30f; mx = fmaxf(mx, fmaxf(p0[i], p1[i])); }
                mx = xhalf_max(mx);
                const float mn = fmaxf(m, mx), alpha = __builtin_amdgcn_exp2f(m - mn); m = mn;
                float ps = 0.f;
#pragma unroll
                for (int i = 0; i < 16; ++i) { const int bit = (i & 3) + 8 * (i >> 2);
                    ps += (((wlo >> bit) & 1u) ? __builtin_amdgcn_exp2f(p0[i] - mn) : 0.f) + (((whi >> bit) & 1u) ? __builtin_amdgcn_exp2f(p1[i] - mn) : 0.f); }
                l = l * alpha + ps;
            }
            l = xhalf_sum(l);
            const float inv = l > 0.f ? 1.0f / l : 0.f;
            f32x16 o0, o1;
#pragma unroll
            for (int i = 0; i < 16; ++i) { o0[i] = 0.f; o1[i] = 0.f; }
            float carry = 0.f;
            for (int tile = 0; tile < ntile; ++tile) {
                const unsigned long long word = causal_word(nmax - 64 * tile);
                f32x16 p0, p1; scores(tile, p0, p1);
                const unsigned wlo = (unsigned)word >> (4 * hh), whi = (unsigned)(word >> 32) >> (4 * hh);
#pragma unroll
                for (int i = 0; i < 16; ++i) { const int bit = (i & 3) + 8 * (i >> 2);
                    p0[i] = ((wlo >> bit) & 1u) ? __builtin_amdgcn_exp2f(p0[i] * sc2 - m) * inv : 0.f; p1[i] = ((whi >> bit) & 1u) ? __builtin_amdgcn_exp2f(p1[i] * sc2 - m) * inv : 0.f; }
#pragma unroll
                for (int blk = 0; blk < 2; ++blk) {
                    float tot[4];
#pragma unroll
                    for (int g = 0; g < 4; ++g) {
                        const float a = blk ? p1[4 * g] : p0[4 * g], b1 = blk ? p1[4 * g + 1] : p0[4 * g + 1], c1 = blk ? p1[4 * g + 2] : p0[4 * g + 2], d1 = blk ? p1[4 * g + 3] : p0[4 * g + 3];
                        const float mainv = (a + b1) + (c1 + d1);
                        const float recv = xhalf_other(d1, hh);
                        const float below = hh ? recv : carry;
                        tot[g] = mainv + below;
                        carry = recv;
                    }
#pragma unroll
                    for (int g = 0; g < 4; ++g) { float v = tot[g]; v += dpp_f<0xB1>(v); v += dpp_f<0x4E>(v);
                        if (hd == 0) imp[tl_ * NS_IP + 16 * tile + 8 * blk + 2 * g + hh] = v; }
                }
                bf16x8 pf[4];
#pragma unroll
                for (int s = 0; s < 4; ++s) { v4u w;
                    if (s < 2) { w.x = pg8::cvt_pk_bf16(p0[8 * s], p0[8 * s + 1]); w.y = pg8::cvt_pk_bf16(p0[8 * s + 2], p0[8 * s + 3]); w.z = pg8::cvt_pk_bf16(p0[8 * s + 4], p0[8 * s + 5]); w.w = pg8::cvt_pk_bf16(p0[8 * s + 6], p0[8 * s + 7]); }
                    else { const int s2 = s - 2; w.x = pg8::cvt_pk_bf16(p1[8 * s2], p1[8 * s2 + 1]); w.y = pg8::cvt_pk_bf16(p1[8 * s2 + 2], p1[8 * s2 + 3]); w.z = pg8::cvt_pk_bf16(p1[8 * s2 + 4], p1[8 * s2 + 5]); w.w = pg8::cvt_pk_bf16(p1[8 * s2 + 6], p1[8 * s2 + 7]); }
                    pf[s] = __builtin_bit_cast(bf16x8, w); }
#pragma unroll
                for (int s = 0; s < 4; ++s) {
                    const int kb = 64 * tile + 32 * (s >> 1) + 16 * (s & 1) + 4 * hh;
#pragma unroll
                    for (int db = 0; db < 2; ++db) {
                        const LAS unsigned char* vp_ = lds + NS_V + (32 * db + r) * NS_VP + kb * 2;
                        typedef unsigned u32x2v __attribute__((ext_vector_type(2)));
                        const u32x2v lo = *(const LAS u32x2v*)vp_, hi = *(const LAS u32x2v*)(vp_ + 16);
                        v4u aw; aw.x = lo.x; aw.y = lo.y; aw.z = hi.x; aw.w = hi.y;
                        const bf16x8 a = __builtin_bit_cast(bf16x8, aw);
                        if (db == 0) o0 = __builtin_amdgcn_mfma_f32_32x32x16_bf16(a, pf[s], o0, 0, 0, 0);
                        else o1 = __builtin_amdgcn_mfma_f32_32x32x16_bf16(a, pf[s], o1, 0, 0, 0);
                    }
                }
            }
            flash_store((bf16*)(F.ws + WS_OC) + row * 256 + hd * 64, o0, o1, 1.0f, hh);
            LDS_WAIT(); asm volatile("" ::: "memory");
            for (int k = 0; k < 8; ++k) {
                const int tk = 64 * tb + 8 * wave + k, own = tk >> 6;
                const float iv = imp[(8 * wave + k) * NS_IP + lane];
                const bool causal = lane <= own, forced = causal && (lane == 0 || lane >= own - 1);
                const float val = forced ? 1e4f : (causal ? iv : -INFINITY);
                const unsigned kv_ = fkey(val); const unsigned klo = (kv_ << 6) | (unsigned)(63 - lane), khi = kv_ >> 26;
                int rank = 0;
#pragma unroll
                for (int j = 0; j < 64; ++j) { const unsigned jlo = (unsigned)__builtin_amdgcn_readlane((int)klo, j), jhi = (unsigned)__builtin_amdgcn_readlane((int)khi, j);
                    rank += (jhi > khi || (jhi == khi && jlo > klo)) ? 1 : 0; }
                const unsigned long long selm = __ballot(causal && rank < 16);
                if (lane == 0) ((unsigned long long*)(F.ws + WS_NSEL))[(size_t)b * T + tk] = selm;
            }
        }
    }
}
#ifndef DSA_EARLY_UNITS
#define DSA_EARLY_UNITS 2
#endif
#ifndef PHMASK
#define PHMASK 0xFFFFFFFFu
#endif
#define EN(b) ((PHMASK >> (b)) & 1u)
#ifndef DUPMASK
#define DUPMASK 0u
#endif
#define REP(b) for (int rep_ = 0; rep_ < (((DUPMASK >> (b)) & 1u) ? 2 : 1); ++rep_)
__global__ void __launch_bounds__(NWAVES * 64, 2) fwd_kernel(Args args) {
    extern __shared__ __attribute__((aligned(16))) unsigned char lds[];
    Frame F;
    F.lds = (LAS unsigned char*)lds;
    F.MISC = (volatile LAS unsigned*)(F.lds + MISC_OFF);
    F.G = gridDim.x;
    F.ws = args.ws; F.ctl = (gu32*)(args.ws + WS_CTL); F.out = args.out;
    F.A = &args;
    for (int u = threadIdx.x; u < (XTRA_OFF - LDSCTL_OFF) / 4; u += NWAVES * 64) ((LAS unsigned*)(F.lds + LDSCTL_OFF))[u] = 0u;
    __syncthreads();
    XcdBarrier bar = xcd_barrier_post((unsigned*)(F.ctl + CW_BAR), F.MISC + 8);
#ifdef PHASE_RANGES
    const int lo = args.ph_lo, hi = args.ph_hi;
#endif
#ifdef PHASE_RANGES
#define IN(k) (lo <= (k) && (k) < hi)
#else
#define IN(k) true
#endif
#ifdef STAMP_DUR
    long long tprev_ = wall_clock64();
#define SEAM(k) do { xcd_barrier(bar); if (blockIdx.x == 0) { const long long tn_ = wall_clock64(); if ((k) == STAMP_DUR) { const long long dt_ = 8 * (tn_ - tprev_); while (wall_clock64() - tn_ < dt_) __builtin_amdgcn_s_sleep(8); } tprev_ = wall_clock64(); } } while (0)
#define SEAMX(id) do { if (s == 0) { xcd_barrier(bar); if (blockIdx.x == 0) { const long long tn_ = wall_clock64(); if ((id) == STAMP_DUR) { const long long dt_ = 8 * (tn_ - tprev_); while (wall_clock64() - tn_ < dt_) __builtin_amdgcn_s_sleep(8); } tprev_ = wall_clock64(); } } } while (0)
#elif defined(DUP_BAR)
#define SEAM(k) do { if (IN(k) && IN((k) + 1)) { xcd_barrier(bar); xcd_barrier(bar); } } while (0)
#else
#define SEAM(k) do { if (IN(k) && IN((k) + 1)) xcd_barrier(bar); } while (0)
#endif
#ifndef SEAMX
#define SEAMX(id) do { } while (0)
#endif
    unsigned char* ws = F.ws;
    bf16 *H; signed char* HID; const float *cs64, *cs32, *ada;

    if (EN(0) && IN(0)) REP(0) p0_prologue(F);
    SEAM(0);
    int ph = 1;
    auto half_layer = [&](const int s) __attribute__((always_inline)) {
        const int l = s >> 1, second = s & 1;
        { unsigned char* w_ = args.ws; asm volatile("" : "+s"(w_)); ws = w_; F.ws = w_; }
        H = (bf16*)F.out + (size_t)M * D; HID = (signed char*)(ws + WS_HID); cs64 = (const float*)(ws + WS_CS64); cs32 = (const float*)(ws + WS_CS32); ada = (const float*)(ws + WS_ADA);
        const unsigned char* wl = ws + WS_WTS + (size_t)l * WTS_LAYER;
        const float* adal = ada + (size_t)l * 8 * 9216;
        bf16* XB = (bf16*)(ws + WS_XB);
        if (EN(1) && IN(ph)) {
            if (s == 0) { wgu8_convert(F); norm_mod_phase<false, true>(F, args.in[I_X], args.in[I_F1N] + l * D, adal + 0 * 1024, adal + 1 * 1024, H); }
            else norm_mod_phase<true, true>(F, XB, args.in[second ? I_F2N : I_F1N] + l * D, adal + (second ? 6 : 0) * 1024, adal + (second ? 7 : 1) * 1024, H);
        }
        SEAM(ph); ++ph;
        if (EN(2) && IN(ph)) REP(2) {
            pg8::Gemm g{H, (const bf16*)(wl + (second ? WO_GU2 : WO_GU1)), M, NGU, D / 2, 64, (size_t)M * 128}; pg8::StaticOrder S; S.init(M, NGU, F.G, (int)blockIdx.x);
            const float wmax = __uint_as_float(__hip_atomic_load((unsigned*)(F.ctl + CW_WMAX) + 2 * l + second, __ATOMIC_RELAXED, __HIP_MEMORY_SCOPE_AGENT));
            pg8::EpiSwiGLU8 E{HID, 128, (ACT_CLIP / 127.0f) * (wmax / 127.0f), (size_t)M * 128};
            pg8::gemm_phase<pg8::EpiSwiGLU8, pg8::StaticOrder, true, true, true>(F.lds + RING_OFF, g, S, E);
        }
        SEAM(ph); ++ph;
        if (EN(3) && IN(ph)) {
            pg8::Gemm g{(const bf16*)HID, (const bf16*)(wl + (second ? WO_D2 : WO_D1)), M, D, FF / 2, 64, (size_t)M * 128}; pg8::StaticOrder S; S.init(M, D, F.G, (int)blockIdx.x);
            const float wmaxd = __uint_as_float(__hip_atomic_load((unsigned*)(F.ctl + CW_WMAX) + 4 + 2 * l + second, __ATOMIC_RELAXED, __HIP_MEMORY_SCOPE_AGENT));
            const float cf = 0.5f * (pg8::HID_CLIP / 127.0f) * (wmaxd / 127.0f);
            if (s == 0) { pg8::EpiResid<false, true> E{args.in[I_X], XB, adal + 2 * 1024, cf};
                pg8::gemm_phase<pg8::EpiResid<false, true>, pg8::StaticOrder, true, true, true>(F.lds + RING_OFF, g, S, E); }
            else { pg8::EpiResid<true, true> E{XB, XB, adal + (second ? 8 : 2) * 1024, cf};
                pg8::gemm_phase<pg8::EpiResid<true, true>, pg8::StaticOrder, true, true, true>(F.lds + RING_OFF, g, S, E); }
        }
        SEAM(ph); ++ph;
        if (second) return;
        if (EN(4) && IN(ph)) norm_mod_phase<true, false>(F, XB, args.in[I_MIXN] + l * D, adal + 3 * 1024, adal + 4 * 1024, H);
        SEAM(ph); ++ph;
        if (EN(5) && IN(ph)) REP(5) {
            pg8::Gemm g{H, (const bf16*)(wl + WO_IN), M, NINP, D}; pg8::StaticOrder S; S.init(M, NINP, F.G, (int)blockIdx.x);
            pg8::EpiProj<WinDesc> E{WinDesc{ws}, cs64, cs32, nullptr};
            pg8::gemm_phase<pg8::EpiProj<WinDesc>, pg8::StaticOrder, true, true>(F.lds + RING_OFF, g, S, E);
        }
        SEAM(ph); ++ph;
        if (EN(6) && IN(ph)) REP(6) {
            m1_phase(F, l);
            { int kq = 2048; asm volatile("" : "+s"(kq)); pg8::Gemm g{(const bf16*)(ws + WS_KC), (const bf16*)(wl + WO_C1K), 2048, 256, kq, 1024}; pg8::RangeOrder S{8, 0};
              pg8::EpiCmpH E{(float*)(ws + WS_CMPH), (const float*)(ws + WS_CMPB) + (l * 2 + 0) * 256};
              pg8::gemm_phase<pg8::EpiCmpH, pg8::RangeOrder, false, true>(F.lds + RING_OFF, g, S, E); }
            { int kq = 2048; asm volatile("" : "+s"(kq)); pg8::Gemm g{(const bf16*)(ws + WS_VC), (const bf16*)(wl + WO_C1V), 2048, 256, kq, 1024}; pg8::RangeOrder S{8, 8};
              pg8::EpiCmpH E{(float*)(ws + WS_CMPH) + (size_t)8 * 256 * 256, (const float*)(ws + WS_CMPB) + (l * 2 + 1) * 256};
              pg8::gemm_phase<pg8::EpiCmpH, pg8::RangeOrder, false, true>(F.lds + RING_OFF, g, S, E); }
#ifdef FLASH_DSA
            if (EN(10) && blockIdx.x >= 16) dsa_select_phase(F, l, DSA_EARLY_UNITS);
#endif
        }
        SEAM(ph); ++ph;
        if (IN(ph)) {
            if (EN(7)) REP(7) { int kq = 256; asm volatile("" : "+s"(kq)); pg8::Gemm g{(const bf16*)(ws + WS_CQ), (const bf16*)(wl + WO_UQ), M, 512, kq}; pg8::StaticOrder S; S.init(M, 512, F.G, (int)blockIdx.x);
              pg8::EpiProj<MlaQDesc> E{MlaQDesc{ws}, cs64, cs32, (const float*)(ws + WS_RSTDQ)};
              pg8::gemm_phase<pg8::EpiProj<MlaQDesc>, pg8::StaticOrder, true, true>(F.lds + RING_OFF, g, S, E); }
            if (EN(8)) REP(7) { int kq = 128; asm volatile("" : "+s"(kq)); pg8::Gemm g{(const bf16*)(ws + WS_CKV), (const bf16*)(wl + WO_UKV), M, 512, kq}; pg8::StaticOrder S; S.init(M, 512, F.G, (int)blockIdx.x);
              pg8::EpiProj<MlaKvDesc> E{MlaKvDesc{ws}, cs64, cs32, (const float*)(ws + WS_RSTDKV)};
              pg8::gemm_phase<pg8::EpiProj<MlaKvDesc>, pg8::StaticOrder, true, true>(F.lds + RING_OFF, g, S, E); }
            if (EN(9)) REP(9) cmp2_phase(F, l);
#ifdef FLASH_DSA
            if (EN(10)) REP(10) dsa_select_phase(F, l, 1 << 30);
#else
            if (EN(10)) REP(10) dsa_tokens_phase(F);
#endif
        }
        SEAM(ph); ++ph;
#ifdef FLASH_NSA
        if (IN(ph)) { if (EN(13)) REP(13) nsa_select_phase(F); }
        SEAM(ph); ++ph;
#endif
        if (IN(ph)) {
#ifdef FLASH_MOBA
            if (EN(11)) REP(11) moba_flash_phase(F);
            SEAMX(100);
#else
            if (EN(11)) moba_rows_phase(F);
#endif
#ifdef FLASH_MLA
            if (EN(12)) REP(12) mla_flash_phase(F);
            SEAMX(101);
#else
            if (EN(12)) mla_rows_phase(F);
#endif
#ifdef FLASH_NSA
            if (EN(13)) REP(14) nsa_flash_phase(F);
            SEAMX(102);
#else
            if (EN(13)) nsa_tokens_phase(F);
#endif
#ifdef FLASH_DSA
            if (EN(10)) REP(15) dsa_flash_phase(F);
#endif
        }
        SEAM(ph); ++ph;
        if (EN(14) && IN(ph)) group_norm_phase(F, H, args.in[I_GN] + l * 1024);
        SEAM(ph); ++ph;
        if (EN(15) && IN(ph)) {
            pg8::Gemm g{H, (const bf16*)(wl + WO_OUT), M, D, D}; pg8::StaticOrder S; S.init(M, D, F.G, (int)blockIdx.x);
            pg8::EpiResid<true> E{XB, XB, adal + 5 * 1024, 1.0f};
            pg8::gemm_phase<pg8::EpiResid<true>, pg8::StaticOrder, true, true>(F.lds + RING_OFF, g, S, E);
        }
        SEAM(ph); ++ph;
    };
    half_layer(0); half_layer(1);
#ifdef DUP_LAYER0
    half_layer(0); half_layer(1);
#endif
    half_layer(2); half_layer(3);
    if (EN(16) && IN(ph)) final_norm_phase(F, (const bf16*)(args.ws + WS_XB), F.out, args.in[I_FINN]);
#undef IN
#undef SEAM
}
#ifdef FLASH_NSA
constexpr int N_PHASES = 1 + 4 * 3 + 2 * 8 + 1;
#else
constexpr int N_PHASES = 1 + 4 * 3 + 2 * 7 + 1;
#endif

extern "C" void kernel_launch(void* const* d_in, const int* in_sizes, int n_in, void* d_out, int out_size, void* d_ws, size_t ws_size, hipStream_t stream) {
    static int grid = 0;
    if (grid == 0) {
        if (n_in != 28 || in_sizes[0] != M * D || out_size != M * D || ws_size < WS_END) { fprintf(stderr, "kernel_launch: unexpected problem shape (n_in %d, in0 %d, out %d, ws %zu); nothing launched\n", n_in, n_in > 0 ? in_sizes[0] : -1, out_size, ws_size); grid = -1; return; }
        int dev = 0, cus = 0, per_cu = 0;
        if (hipGetDevice(&dev) != hipSuccess || hipDeviceGetAttribute(&cus, hipDeviceAttributeMultiprocessorCount, dev) != hipSuccess) { grid = -1; return; }
        if (hipFuncSetAttribute((const void*)fwd_kernel, hipFuncAttributeMaxDynamicSharedMemorySize, LDS_BYTES) != hipSuccess) { fprintf(stderr, "kernel_launch: hipFuncSetAttribute failed\n"); grid = -1; return; }
        if (hipOccupancyMaxActiveBlocksPerMultiprocessor(&per_cu, (const void*)fwd_kernel, NWAVES * 64, LDS_BYTES) != hipSuccess || per_cu < 1) { fprintf(stderr, "kernel_launch: occupancy query says %d\n", per_cu); }
        (void)hipGetLastError();
        grid = cus;
    }
    if (grid < 0) return;
    if (hipMemsetAsync((char*)d_ws + WS_CTL, 0, CTL_ZERO_BYTES, stream) != hipSuccess) return;
    Args a{};
    for (int i = 0; i < 28; ++i) a.in[i] = (const float*)d_in[i];
    a.out = (float*)d_out; a.ws = (unsigned char*)d_ws; a.ph_lo = 0; a.ph_hi = N_PHASES + 64;
    hipLaunchKernelGGL(fwd_kernel, dim3(grid), dim3(NWAVES * 64), LDS_BYTES, stream, a);
}
```
